# Optimizing an MI355X kernel written in HIP

```python
import math
import jax, jax.numpy as jnp
from jax import lax
import numpy as np

D_MODEL = 1024
BATCH = 4
SEQ = 8192
DEPTH = 1

ATTN_HEADS = 8
ATTN_KV_HEADS = 2
ATTN_HEAD_DIM = 64
WINDOW = 128
ATTN_BLOCK = 128
ROPE_THETA = 10000.0
DN_HEADS = 4
DN_HEAD_DIM = 128
DN_CONV = 4
DN_CHUNK = 64
ATTN_Q = ATTN_HEADS * ATTN_HEAD_DIM
ATTN_KV = ATTN_KV_HEADS * ATTN_HEAD_DIM
DN_DIM = DN_HEADS * DN_HEAD_DIM
MIX_WIDTH = ATTN_Q + DN_DIM
SPLITS = (ATTN_Q, ATTN_KV, ATTN_KV, DN_DIM, DN_DIM, DN_DIM, DN_HEADS, DN_HEADS, DN_DIM)
IN_WIDTH = ATTN_Q + 2 * ATTN_KV + 4 * DN_DIM + 2 * DN_HEADS
PEER_HEADS = 8
PEER_N_KEYS = 128
PEER_N_EXPERTS = PEER_N_KEYS * PEER_N_KEYS
PEER_QUERY_DIM = 256
PEER_TOPK = 16
PEER_TOKEN_BLOCK = 128
DEEPNORM_ALPHA = (2.0 * DEPTH) ** 0.25
DEEPNORM_BETA = (8.0 * DEPTH) ** -0.25
LN_EPS = 1e-5
RMS_EPS = 1e-6
L2_EPS = 1e-6
NEG_INF = -1e30

kernel_name = 'hymba_swa_sink_gdn_peer_deepnorm'


def layer_norm(x, g, b):
    xf = x.astype(jnp.float32)
    mu = jnp.mean(xf, axis=-1, keepdims=True)
    var = jnp.mean(jnp.square(xf - mu), axis=-1, keepdims=True)
    return ((xf - mu) * lax.rsqrt(var + LN_EPS) * g.astype(jnp.float32) + b.astype(jnp.float32)).astype(x.dtype)


def rope(x, positions):
    half = x.shape[-1] // 2
    inv_freq = ROPE_THETA ** (-jnp.arange(half, dtype=jnp.float32) / half)
    ang = positions.astype(jnp.float32)[..., None] * inv_freq
    cos = jnp.cos(ang)[:, :, None, :]
    sin = jnp.sin(ang)[:, :, None, :]
    xf = x.astype(jnp.float32)
    x1, x2 = xf[..., :half], xf[..., half:]
    return jnp.concatenate([x1 * cos - x2 * sin, x2 * cos + x1 * sin], axis=-1).astype(x.dtype)


def sliding_window_sink_attention(q, k, v, sinks):
    B, T, _, hd = q.shape
    L = ATTN_BLOCK
    nb = T // L
    G = ATTN_HEADS // ATTN_KV_HEADS
    qb = q.reshape(B, nb, L, ATTN_KV_HEADS, G, hd)

    def with_prev(a):
        ab = a.reshape(B, nb, L, ATTN_KV_HEADS, hd)
        prev = jnp.pad(ab[:, :-1], ((0, 0), (1, 0), (0, 0), (0, 0), (0, 0)))
        return jnp.concatenate([prev, ab], axis=2)

    kb, vb = with_prev(k), with_prev(v)
    s = jnp.einsum('bnqhgd,bnkhd->bnhgqk', qb, kb, preferred_element_type=jnp.float32) * (hd ** -0.5)
    blk = jnp.arange(nb)[:, None] * L
    qpos = blk + jnp.arange(L)[None, :]
    kpos = blk - L + jnp.arange(2 * L)[None, :]
    delta = qpos[:, :, None] - kpos[:, None, :]
    allowed = (delta >= 0) & (delta < WINDOW) & (kpos[:, None, :] >= 0)
    s = jnp.where(allowed[None, :, None, None], s, NEG_INF)
    sink_col = jnp.broadcast_to(
        sinks.astype(jnp.float32).reshape(1, 1, ATTN_KV_HEADS, G, 1, 1), s.shape[:-1] + (1,))
    p = jax.nn.softmax(jnp.concatenate([s, sink_col], axis=-1), axis=-1)[..., :-1]
    o = jnp.einsum('bnhgqk,bnkhd->bnqhgd', p.astype(v.dtype), vb)
    return o.reshape(B, T, ATTN_HEADS * hd)


def causal_short_conv(x, w):
    K, C = w.shape
    y = lax.conv_general_dilated(
        x, w[:, None, :].astype(x.dtype), window_strides=(1,), padding=[(K - 1, 0)],
        dimension_numbers=('NWC', 'WIO', 'NWC'), feature_group_count=C)
    return jax.nn.silu(y)


def gated_delta_rule(q, k, v, g, beta):
    B, H, T, dk = q.shape
    dv = v.shape[-1]
    C = DN_CHUNK
    N = T // C
    q = q * (dk ** -0.5)
    q, k, v = (a.reshape(B, H, N, C, a.shape[-1]) for a in (q, k, v))
    g, beta = (a.reshape(B, H, N, C) for a in (g, beta))
    gc = jnp.cumsum(g, axis=-1)
    causal = jnp.tril(jnp.ones((C, C), dtype=bool))
    strict = jnp.tril(jnp.ones((C, C), dtype=bool), -1)
    diff = gc[..., :, None] - gc[..., None, :]
    decay = jnp.where(causal, jnp.exp(jnp.where(causal, diff, 0.0)), 0.0)
    k_beta = k * beta[..., None]
    a_mat = jnp.where(strict, jnp.einsum('bhnid,bhnjd->bhnij', k_beta, k) * decay, 0.0)
    eye = jnp.eye(C, dtype=q.dtype)
    rhs = jnp.concatenate([v * beta[..., None], k_beta * jnp.exp(gc)[..., None]], axis=-1)
    sol = lax.linalg.triangular_solve(eye + a_mat, rhs, left_side=True, lower=True, unit_diagonal=True)
    u, w = sol[..., :dv], sol[..., dv:]
    qk = jnp.einsum('bhnid,bhnjd->bhnij', q, k) * decay
    q_dec = q * jnp.exp(gc)[..., None]
    k_dec = k * jnp.exp(gc[..., -1:] - gc)[..., None]
    g_last = jnp.exp(gc[..., -1])

    def step(S, xs):
        qk_i, qd_i, kd_i, u_i, w_i, gl_i = xs
        v_new = u_i - jnp.einsum('bhid,bhde->bhie', w_i, S)
        o_i = jnp.einsum('bhid,bhde->bhie', qd_i, S) + jnp.einsum('bhij,bhje->bhie', qk_i, v_new)
        S = S * gl_i[..., None, None] + jnp.einsum('bhid,bhie->bhde', kd_i, v_new)
        return S, o_i

    xs = tuple(jnp.moveaxis(a, 2, 0) for a in (qk, q_dec, k_dec, u, w, g_last))
    S0 = jnp.zeros((B, H, dk, dv), q.dtype)
    _, o = lax.scan(step, S0, xs)
    return jnp.moveaxis(o, 0, 2).reshape(B, H, T, dv)


def l2_normalize(a):
    return a * lax.rsqrt(jnp.sum(jnp.square(a), axis=-1, keepdims=True) + L2_EPS)


def hybrid_mixer(x, positions, w_in, attn_sinks, conv_w, a_log, dt_bias, dn_norm_g, w_out):
    B, T, _ = x.shape
    proj = x @ w_in
    offsets = np.cumsum(SPLITS)[:-1].tolist()
    q_a, k_a, v_a, q_d, k_d, v_d, b_d, a_d, z_d = jnp.split(proj, offsets, axis=-1)

    q_a = rope(q_a.reshape(B, T, ATTN_HEADS, ATTN_HEAD_DIM), positions)
    k_a = rope(k_a.reshape(B, T, ATTN_KV_HEADS, ATTN_HEAD_DIM), positions)
    v_a = v_a.reshape(B, T, ATTN_KV_HEADS, ATTN_HEAD_DIM)
    o_attn = sliding_window_sink_attention(q_a, k_a, v_a, attn_sinks)

    qkv = causal_short_conv(jnp.concatenate([q_d, k_d, v_d], axis=-1), conv_w).astype(jnp.float32)
    q_d, k_d, v_d = jnp.split(qkv, 3, axis=-1)
    to_heads = lambda a: jnp.transpose(a.reshape(B, T, DN_HEADS, DN_HEAD_DIM), (0, 2, 1, 3))
    q_d, k_d, v_d = l2_normalize(to_heads(q_d)), l2_normalize(to_heads(k_d)), to_heads(v_d)
    beta = jnp.transpose(jax.nn.sigmoid(b_d.astype(jnp.float32)), (0, 2, 1))
    g = -jnp.exp(a_log.astype(jnp.float32)) * jax.nn.softplus(
        a_d.astype(jnp.float32) + dt_bias.astype(jnp.float32))
    g = jnp.transpose(g, (0, 2, 1))
    o_dn = jnp.transpose(gated_delta_rule(q_d, k_d, v_d, g, beta), (0, 2, 1, 3))
    o_dn = o_dn * lax.rsqrt(jnp.mean(jnp.square(o_dn), axis=-1, keepdims=True) + RMS_EPS)
    o_dn = o_dn * dn_norm_g.astype(jnp.float32) * jax.nn.silu(
        z_d.reshape(B, T, DN_HEADS, DN_HEAD_DIM).astype(jnp.float32))
    o_dn = o_dn.reshape(B, T, DN_DIM).astype(x.dtype)

    return jnp.concatenate([o_attn, o_dn], axis=-1) @ w_out


def peer_ffn(x, w_query, sub_keys, expert_u, expert_v):
    B, T, D = x.shape
    L = PEER_TOKEN_BLOCK
    K = PEER_TOPK
    xt = x.reshape(-1, L, D)

    def one_block(xb):
        q = (xb @ w_query).reshape(L, PEER_HEADS, 2, PEER_QUERY_DIM // 2)
        s = jnp.einsum('lhpd,hpkd->lhpk', q, sub_keys, preferred_element_type=jnp.float32)
        vals, idx = lax.top_k(s, K)
        cand = (vals[..., 0, :, None] + vals[..., 1, None, :]).reshape(L, PEER_HEADS, K * K)
        cidx = (idx[..., 0, :, None] * PEER_N_KEYS + idx[..., 1, None, :]).reshape(L, PEER_HEADS, K * K)
        best, pos = lax.top_k(cand, K)
        expert = jnp.take_along_axis(cidx, pos, axis=-1)
        gate = jax.nn.softmax(best, axis=-1)
        u = expert_u[expert]
        v = expert_v[expert]
        h = jax.nn.gelu(jnp.einsum('ld,lhkd->lhk', xb, u), approximate=False)
        return jnp.einsum('lhk,lhkd->ld', (h * gate).astype(xb.dtype), v)

    return lax.map(one_block, xt).reshape(B, T, D)


def setup_inputs(seed: int = 0) -> dict:
    key = jax.random.key(seed)
    ks = jax.random.split(key, 20)
    f32 = jnp.float32
    nrm = lambda k, shape, std: jax.random.normal(k, shape, f32) * std
    x = nrm(ks[0], (BATCH, SEQ, D_MODEL), 1.0)
    positions = jnp.broadcast_to(jnp.arange(SEQ, dtype=jnp.int32)[None, :], (BATCH, SEQ))
    w_in = nrm(ks[1], (D_MODEL, IN_WIDTH), D_MODEL ** -0.5)
    attn_sinks = nrm(ks[2], (ATTN_HEADS,), 0.5)
    conv_w = nrm(ks[3], (DN_CONV, 3 * DN_DIM), DN_CONV ** -0.5)
    a_log = jnp.log(jax.random.uniform(ks[4], (DN_HEADS,), f32, 1.0, 16.0))
    dt = jnp.exp(jax.random.uniform(ks[5], (DN_HEADS,), f32, math.log(1e-3), math.log(1e-1)))
    dt_bias = dt + jnp.log(-jnp.expm1(-dt))
    dn_norm_g = 1.0 + nrm(ks[6], (DN_HEAD_DIM,), 0.02)
    w_out = nrm(ks[7], (MIX_WIDTH, D_MODEL), MIX_WIDTH ** -0.5 * DEEPNORM_BETA)
    ln1_g = 1.0 + nrm(ks[8], (D_MODEL,), 0.02)
    ln1_b = nrm(ks[9], (D_MODEL,), 0.02)
    peer_w_query = nrm(ks[10], (D_MODEL, PEER_HEADS * PEER_QUERY_DIM), D_MODEL ** -0.5)
    peer_sub_keys = nrm(ks[11], (PEER_HEADS, 2, PEER_N_KEYS, PEER_QUERY_DIM // 2), (PEER_QUERY_DIM // 2) ** -0.5)
    peer_u = nrm(ks[12], (PEER_N_EXPERTS, D_MODEL), D_MODEL ** -0.5)
    peer_v = nrm(ks[13], (PEER_N_EXPERTS, D_MODEL), DEEPNORM_BETA)
    ln2_g = 1.0 + nrm(ks[14], (D_MODEL,), 0.02)
    ln2_b = nrm(ks[15], (D_MODEL,), 0.02)
    return {'x': x, 'positions': positions, 'w_in': w_in, 'attn_sinks': attn_sinks,
            'conv_w': conv_w, 'a_log': a_log, 'dt_bias': dt_bias, 'dn_norm_g': dn_norm_g,
            'w_out': w_out, 'ln1_g': ln1_g, 'ln1_b': ln1_b, 'peer_w_query': peer_w_query,
            'peer_sub_keys': peer_sub_keys, 'peer_u': peer_u, 'peer_v': peer_v,
            'ln2_g': ln2_g, 'ln2_b': ln2_b}


def reference(x, positions, w_in, attn_sinks, conv_w, a_log, dt_bias, dn_norm_g, w_out,
              ln1_g, ln1_b, peer_w_query, peer_sub_keys, peer_u, peer_v, ln2_g, ln2_b):
    h = x
    for _ in range(DEPTH):
        mix = hybrid_mixer(h, positions, w_in, attn_sinks, conv_w, a_log, dt_bias, dn_norm_g, w_out)
        h = layer_norm(DEEPNORM_ALPHA * h + mix, ln1_g, ln1_b)
        ffn = peer_ffn(h, peer_w_query, peer_sub_keys, peer_u, peer_v)
        h = layer_norm(DEEPNORM_ALPHA * h + ffn, ln2_g, ln2_b)
    return h
```

```cpp
#include <hip/hip_runtime.h>
#include <cstdio>
#include <cstdint>
#include <math.h>

namespace {
constexpr int D_MODEL = 1024, BATCH = 4, SEQ = 8192, M_TOK = BATCH * SEQ;
constexpr int IN_WIDTH = 2824;
constexpr int C_AQ = 0, C_AK = 512, C_AV = 640, C_DQ = 768, C_DK = 1280, C_DV = 1792, C_B = 2304, C_A = 2308, C_Z = 2312;
constexpr float ALPHA = 1.189207115002721f;
constexpr float LN_EPS = 1e-5f, RMS_EPS = 1e-6f, L2_EPS = 1e-6f;

__device__ __forceinline__ float wave_sum(float v) {
#pragma unroll
    for (int o = 1; o < 64; o <<= 1) v += __shfl_xor(v, o);
    return v;
}
__device__ __forceinline__ float wave_max(float v) {
#pragma unroll
    for (int o = 1; o < 64; o <<= 1) v = fmaxf(v, __shfl_xor(v, o));
    return v;
}

__global__ void __launch_bounds__(256) gemm_f32(const float* __restrict__ A, const float* __restrict__ B, float* __restrict__ C, int M, int N, int K) {
    __shared__ float As[8][132];
    __shared__ float Bs[8][132];
    const int tid = threadIdx.x, tx = tid & 15, ty = tid >> 4;
    const int m0 = blockIdx.y * 128, n0 = blockIdx.x * 128;
    float acc[8][8];
#pragma unroll
    for (int i = 0; i < 8; ++i)
#pragma unroll
        for (int j = 0; j < 8; ++j) acc[i][j] = 0.f;
    const int ar = tid >> 1, ac = (tid & 1) * 4;
    const int br = tid >> 5, bc = (tid & 31) * 4;
    for (int k0 = 0; k0 < K; k0 += 8) {
        const float4 av = *(const float4*)(A + (size_t)(m0 + ar) * K + k0 + ac);
        float4 bv = make_float4(0.f, 0.f, 0.f, 0.f);
        if (n0 + bc < N) bv = *(const float4*)(B + (size_t)(k0 + br) * N + n0 + bc);
        __syncthreads();
        As[ac + 0][ar] = av.x; As[ac + 1][ar] = av.y; As[ac + 2][ar] = av.z; As[ac + 3][ar] = av.w;
        *(float4*)&Bs[br][bc] = bv;
        __syncthreads();
#pragma unroll
        for (int kk = 0; kk < 8; ++kk) {
            float a[8], b[8];
            *(float4*)&a[0] = *(const float4*)&As[kk][ty * 4];
            *(float4*)&a[4] = *(const float4*)&As[kk][64 + ty * 4];
            *(float4*)&b[0] = *(const float4*)&Bs[kk][tx * 4];
            *(float4*)&b[4] = *(const float4*)&Bs[kk][64 + tx * 4];
#pragma unroll
            for (int i = 0; i < 8; ++i)
#pragma unroll
                for (int j = 0; j < 8; ++j) acc[i][j] = fmaf(a[i], b[j], acc[i][j]);
        }
    }
#pragma unroll
    for (int i = 0; i < 8; ++i) {
        const int r = m0 + (i < 4 ? ty * 4 + i : 64 + ty * 4 + i - 4);
#pragma unroll
        for (int jj = 0; jj < 2; ++jj) {
            const int c = n0 + jj * 64 + tx * 4;
            if (c < N) *(float4*)(C + (size_t)r * N + c) = make_float4(acc[i][jj * 4 + 0], acc[i][jj * 4 + 1], acc[i][jj * 4 + 2], acc[i][jj * 4 + 3]);
        }
    }
}

__global__ void __launch_bounds__(256) rope_inplace(float* __restrict__ proj, const int* __restrict__ positions) {
    const int m = blockIdx.x, tid = threadIdx.x;
    float* pr = proj + (size_t)m * IN_WIDTH;
    const float pos = (float)positions[m];
    for (int p = tid; p < 320; p += 256) {
        const int head = p >> 5, i = p & 31;
        const float inv_freq = powf(10000.0f, -(float)i / 32.0f);
        const float ang = pos * inv_freq;
        const float c = cosf(ang), s = sinf(ang);
        const float x1 = pr[head * 64 + i], x2 = pr[head * 64 + 32 + i];
        pr[head * 64 + i] = x1 * c - x2 * s;
        pr[head * 64 + 32 + i] = x2 * c + x1 * s;
    }
}

__global__ void __launch_bounds__(128) attn_naive(const float* __restrict__ proj, const float* __restrict__ sinks, float* __restrict__ mixin) {
    __shared__ float qs[64];
    __shared__ float ps[128];
    __shared__ float red[4];
    const int m = blockIdx.x >> 3, head = blockIdx.x & 7, kvh = head >> 2, t = m % SEQ, tid = threadIdx.x;
    if (tid < 64) qs[tid] = proj[(size_t)m * IN_WIDTH + C_AQ + head * 64 + tid];
    __syncthreads();
    const int k = tid; const bool valid = (t - k) >= 0;
    float s = -1e30f;
    if (valid) {
        const float* kr = proj + (size_t)(m - k) * IN_WIDTH + C_AK + kvh * 64;
        float a = 0.f;
#pragma unroll 8
        for (int d = 0; d < 64; ++d) a = fmaf(qs[d], kr[d], a);
        s = a * 0.125f;
    }
    float mx = wave_max(s);
    if ((tid & 63) == 0) red[tid >> 6] = mx;
    __syncthreads();
    const float sink = sinks[head];
    mx = fmaxf(fmaxf(red[0], red[1]), sink);
    const float p = valid ? expf(s - mx) : 0.f;
    float sm = wave_sum(p);
    if ((tid & 63) == 0) red[2 + (tid >> 6)] = sm;
    __syncthreads();
    const float denom = red[2] + red[3] + expf(sink - mx);
    ps[k] = p / denom;
    __syncthreads();
    if (tid < 64) {
        float o = 0.f;
        const int kmax = t < 127 ? t : 127;
        for (int kk = 0; kk <= kmax; ++kk) o = fmaf(ps[kk], proj[(size_t)(m - kk) * IN_WIDTH + C_AV + kvh * 64 + tid], o);
        mixin[(size_t)m * D_MODEL + head * 64 + tid] = o;
    }
}

__device__ __forceinline__ float silu_f(float y) { return y / (1.f + expf(-y)); }
__global__ void __launch_bounds__(128) dn_naive(const float* __restrict__ proj, const float* __restrict__ conv_w, const float* __restrict__ a_log,
                                                const float* __restrict__ dt_bias, float* __restrict__ odn_raw) {
    __shared__ __attribute__((aligned(16))) float ks[128];
    __shared__ __attribute__((aligned(16))) float qs[128];
    __shared__ float red[4];
    const int b = blockIdx.x >> 2, h = blockIdx.x & 3, tid = threadIdx.x;
    float s[128];
#pragma unroll
    for (int d = 0; d < 128; ++d) s[d] = 0.f;
    float wq[4], wk[4], wv[4];
#pragma unroll
    for (int j = 0; j < 4; ++j) { wq[j] = conv_w[j * 1536 + h * 128 + tid]; wk[j] = conv_w[j * 1536 + 512 + h * 128 + tid]; wv[j] = conv_w[j * 1536 + 1024 + h * 128 + tid]; }
    float xq[3] = {0.f, 0.f, 0.f}, xk[3] = {0.f, 0.f, 0.f}, xv[3] = {0.f, 0.f, 0.f};
    const float neg_a = -expf(a_log[h]), dtb = dt_bias[h];
    const float* pr = proj + (size_t)b * SEQ * IN_WIDTH;
    float nq = pr[C_DQ + h * 128 + tid], nk = pr[C_DK + h * 128 + tid], nv = pr[C_DV + h * 128 + tid], nb = pr[C_B + h], na = pr[C_A + h];
    for (int t = 0; t < SEQ; ++t) {
        const float cq = nq, ck = nk, cv = nv, cb = nb, ca = na;
        if (t + 1 < SEQ) { const float* p2 = pr + (size_t)(t + 1) * IN_WIDTH; nq = p2[C_DQ + h * 128 + tid]; nk = p2[C_DK + h * 128 + tid]; nv = p2[C_DV + h * 128 + tid]; nb = p2[C_B + h]; na = p2[C_A + h]; }
        float q = silu_f(wq[0] * xq[0] + wq[1] * xq[1] + wq[2] * xq[2] + wq[3] * cq);
        float k = silu_f(wk[0] * xk[0] + wk[1] * xk[1] + wk[2] * xk[2] + wk[3] * ck);
        const float v = silu_f(wv[0] * xv[0] + wv[1] * xv[1] + wv[2] * xv[2] + wv[3] * cv);
        xq[0] = xq[1]; xq[1] = xq[2]; xq[2] = cq; xk[0] = xk[1]; xk[1] = xk[2]; xk[2] = ck; xv[0] = xv[1]; xv[1] = xv[2]; xv[2] = cv;
        float sq = wave_sum(q * q), sk = wave_sum(k * k);
        if ((tid & 63) == 0) { red[tid >> 6] = sq; red[2 + (tid >> 6)] = sk; }
        __syncthreads();
        sq = red[0] + red[1]; sk = red[2] + red[3];
        q = q * rsqrtf(sq + L2_EPS) * 0.08838834764831845f;
        k = k * rsqrtf(sk + L2_EPS);
        ks[tid] = k; qs[tid] = q;
        __syncthreads();
        const float beta = 1.f / (1.f + expf(-cb));
        const float xx = ca + dtb;
        const float sp = xx > 20.f ? xx : log1pf(expf(xx));
        const float gt = expf(neg_a * sp);
        float kS = 0.f;
#pragma unroll
        for (int d = 0; d < 128; d += 4) { const float4 k4 = *(const float4*)&ks[d]; kS = fmaf(k4.x, s[d], kS); kS = fmaf(k4.y, s[d + 1], kS); kS = fmaf(k4.z, s[d + 2], kS); kS = fmaf(k4.w, s[d + 3], kS); }
        const float c = beta * (v - gt * kS);
        float o = 0.f;
#pragma unroll
        for (int d = 0; d < 128; d += 4) {
            const float4 k4 = *(const float4*)&ks[d]; const float4 q4 = *(const float4*)&qs[d];
            s[d] = fmaf(gt, s[d], k4.x * c); o = fmaf(s[d], q4.x, o);
            s[d + 1] = fmaf(gt, s[d + 1], k4.y * c); o = fmaf(s[d + 1], q4.y, o);
            s[d + 2] = fmaf(gt, s[d + 2], k4.z * c); o = fmaf(s[d + 2], q4.z, o);
            s[d + 3] = fmaf(gt, s[d + 3], k4.w * c); o = fmaf(s[d + 3], q4.w, o);
        }
        odn_raw[((size_t)b * SEQ + t) * 512 + h * 128 + tid] = o;
    }
}

__global__ void __launch_bounds__(128) dn_norm_gate(const float* __restrict__ odn_raw, const float* __restrict__ proj, const float* __restrict__ norm_g, float* __restrict__ mixin) {
    __shared__ float red[2];
    const int m = blockIdx.x >> 2, h = blockIdx.x & 3, tid = threadIdx.x;
    const float o = odn_raw[(size_t)m * 512 + h * 128 + tid];
    const float ss = wave_sum(o * o);
    if ((tid & 63) == 0) red[tid >> 6] = ss;
    __syncthreads();
    const float r = rsqrtf((red[0] + red[1]) * (1.f / 128.f) + RMS_EPS);
    const float z = proj[(size_t)m * IN_WIDTH + C_Z + h * 128 + tid];
    mixin[(size_t)m * D_MODEL + 512 + h * 128 + tid] = o * r * norm_g[tid] * silu_f(z);
}

__global__ void __launch_bounds__(256) ln_res(const float* __restrict__ a, const float* __restrict__ bsrc, const float* __restrict__ g, const float* __restrict__ be, float* __restrict__ out) {
    __shared__ float red[8];
    const int m = blockIdx.x, tid = threadIdx.x;
    const float4 av = *(const float4*)(a + (size_t)m * D_MODEL + tid * 4), bv = *(const float4*)(bsrc + (size_t)m * D_MODEL + tid * 4);
    float y[4] = {ALPHA * av.x + bv.x, ALPHA * av.y + bv.y, ALPHA * av.z + bv.z, ALPHA * av.w + bv.w};
    float s = wave_sum(y[0] + y[1] + y[2] + y[3]);
    if ((tid & 63) == 0) red[tid >> 6] = s;
    __syncthreads();
    const float mean = (red[0] + red[1] + red[2] + red[3]) * (1.f / D_MODEL);
    float q = 0.f;
#pragma unroll
    for (int i = 0; i < 4; ++i) { y[i] -= mean; q += y[i] * y[i]; }
    q = wave_sum(q);
    if ((tid & 63) == 0) red[4 + (tid >> 6)] = q;
    __syncthreads();
    const float rstd = rsqrtf((red[4] + red[5] + red[6] + red[7]) * (1.f / D_MODEL) + LN_EPS);
    const float4 gv = *(const float4*)(g + tid * 4), bb = *(const float4*)(be + tid * 4);
    *(float4*)(out + (size_t)m * D_MODEL + tid * 4) = make_float4(y[0] * rstd * gv.x + bb.x, y[1] * rstd * gv.y + bb.y, y[2] * rstd * gv.z + bb.z, y[3] * rstd * gv.w + bb.w);
}

__device__ __forceinline__ void wave_argmax(float& v, int& i) {
#pragma unroll
    for (int o = 1; o < 64; o <<= 1) {
        const float ov = __shfl_xor(v, o); const int oi = __shfl_xor(i, o);
        if (ov > v || (ov == v && oi < i)) { v = ov; i = oi; }
    }
}
__global__ void __launch_bounds__(256) route_naive(const float* __restrict__ q, const float* __restrict__ sub_keys, int* __restrict__ ids, float* __restrict__ gates) {
    __shared__ __attribute__((aligned(16))) float qs[2048];
    __shared__ float sc[16][128];
    __shared__ float tv[16][16];
    __shared__ int ti[16][16];
    const int m = blockIdx.x, tid = threadIdx.x, lane = tid & 63, w = tid >> 6;
    for (int i = tid; i < 2048; i += 256) qs[i] = q[(size_t)m * 2048 + i];
    __syncthreads();
    for (int e = tid; e < 2048; e += 256) {
        const int grp = e >> 7, key = e & 127;
        const float* kr = sub_keys + ((size_t)grp * 128 + key) * 128;
        const float* qq = qs + grp * 128;
        float a = 0.f;
#pragma unroll 8
        for (int d = 0; d < 128; d += 4) { const float4 k4 = *(const float4*)(kr + d); a = fmaf(qq[d], k4.x, a); a = fmaf(qq[d + 1], k4.y, a); a = fmaf(qq[d + 2], k4.z, a); a = fmaf(qq[d + 3], k4.w, a); }
        sc[grp][key] = a;
    }
    __syncthreads();
    for (int grp = w; grp < 16; grp += 4) {
        float v0 = sc[grp][lane], v1 = sc[grp][lane + 64];
        for (int r = 0; r < 16; ++r) {
            float bv; int bi;
            if (v0 >= v1) { bv = v0; bi = lane; } else { bv = v1; bi = lane + 64; }
            wave_argmax(bv, bi);
            if (lane == 0) { tv[grp][r] = bv; ti[grp][r] = bi; }
            if (bi == lane) v0 = -INFINITY; else if (bi == lane + 64) v1 = -INFINITY;
        }
    }
    __syncthreads();
    for (int h = w; h < 8; h += 4) {
        float cv[4]; int ci[4];
#pragma unroll
        for (int j = 0; j < 4; ++j) { const int c = lane + 64 * j, i0 = c >> 4, i1 = c & 15; cv[j] = tv[h * 2][i0] + tv[h * 2 + 1][i1]; ci[j] = ti[h * 2][i0] * 128 + ti[h * 2 + 1][i1]; }
        float bestv = 0.f; int beste = 0; float mx = 0.f;
        for (int r = 0; r < 16; ++r) {
            float bv = cv[0]; int bj = 0;
#pragma unroll
            for (int j = 1; j < 4; ++j) if (cv[j] > bv) { bv = cv[j]; bj = j; }
            int bi = lane + 64 * bj;
            wave_argmax(bv, bi);
            const int src = bi & 63, sj = bi >> 6;
            int e = 0;
#pragma unroll
            for (int j = 0; j < 4; ++j) if (sj == j) e = ci[j];
            e = __shfl(e, src);
            if (lane == src) {
#pragma unroll
                for (int j = 0; j < 4; ++j) if (sj == j) cv[j] = -INFINITY;
            }
            if (r == 0) mx = bv;
            if (lane == r) { bestv = bv; beste = e; }
        }
        const float ex = lane < 16 ? expf(bestv - mx) : 0.f;
        const float den = wave_sum(ex);
        if (lane < 16) { ids[(size_t)m * 128 + h * 16 + lane] = beste; gates[(size_t)m * 128 + h * 16 + lane] = ex / den; }
    }
}

__global__ void __launch_bounds__(256) peer_naive(const float* __restrict__ x1, const int* __restrict__ ids, const float* __restrict__ gates, const float* __restrict__ eu, const float* __restrict__ ev,
                                                  const float* __restrict__ g, const float* __restrict__ be, float* __restrict__ out) {
    __shared__ __attribute__((aligned(16))) float part[4][1024];
    __shared__ float red[8];
    const int m = blockIdx.x, tid = threadIdx.x, lane = tid & 63, w = tid >> 6;
    float4 xr[4];
#pragma unroll
    for (int j = 0; j < 4; ++j) xr[j] = *(const float4*)(x1 + (size_t)m * D_MODEL + j * 256 + lane * 4);
    float4 acc[4];
#pragma unroll
    for (int j = 0; j < 4; ++j) acc[j] = make_float4(0.f, 0.f, 0.f, 0.f);
    for (int k = w; k < 128; k += 4) {
        const int e = ids[(size_t)m * 128 + k]; const float gt = gates[(size_t)m * 128 + k];
        const float* ur = eu + (size_t)e * D_MODEL; const float* vr = ev + (size_t)e * D_MODEL;
        float d = 0.f;
        float4 vv[4];
#pragma unroll
        for (int j = 0; j < 4; ++j) { const float4 u4 = *(const float4*)(ur + j * 256 + lane * 4); vv[j] = *(const float4*)(vr + j * 256 + lane * 4);
            d += xr[j].x * u4.x + xr[j].y * u4.y + xr[j].z * u4.z + xr[j].w * u4.w; }
        d = wave_sum(d);
        const float wgt = 0.5f * d * (1.f + erff(d * 0.7071067811865476f)) * gt;
#pragma unroll
        for (int j = 0; j < 4; ++j) { acc[j].x = fmaf(wgt, vv[j].x, acc[j].x); acc[j].y = fmaf(wgt, vv[j].y, acc[j].y); acc[j].z = fmaf(wgt, vv[j].z, acc[j].z); acc[j].w = fmaf(wgt, vv[j].w, acc[j].w); }
    }
#pragma unroll
    for (int j = 0; j < 4; ++j) *(float4*)&part[w][j * 256 + lane * 4] = acc[j];
    __syncthreads();
    const float4 xv = *(const float4*)(x1 + (size_t)m * D_MODEL + tid * 4);
    float y[4] = {ALPHA * xv.x, ALPHA * xv.y, ALPHA * xv.z, ALPHA * xv.w};
#pragma unroll
    for (int ww = 0; ww < 4; ++ww) { const float4 p = *(const float4*)&part[ww][tid * 4]; y[0] += p.x; y[1] += p.y; y[2] += p.z; y[3] += p.w; }
    float s = wave_sum(y[0] + y[1] + y[2] + y[3]);
    if (lane == 0) red[w] = s;
    __syncthreads();
    const float mean = (red[0] + red[1] + red[2] + red[3]) * (1.f / D_MODEL);
    float qq = 0.f;
#pragma unroll
    for (int i = 0; i < 4; ++i) { y[i] -= mean; qq += y[i] * y[i]; }
    qq = wave_sum(qq);
    if (lane == 0) red[4 + w] = qq;
    __syncthreads();
    const float rstd = rsqrtf((red[4] + red[5] + red[6] + red[7]) * (1.f / D_MODEL) + LN_EPS);
    const float4 gv = *(const float4*)(g + tid * 4), bb = *(const float4*)(be + tid * 4);
    *(float4*)(out + (size_t)m * D_MODEL + tid * 4) = make_float4(y[0] * rstd * gv.x + bb.x, y[1] * rstd * gv.y + bb.y, y[2] * rstd * gv.z + bb.z, y[3] * rstd * gv.w + bb.w);
}
}

extern "C" void kernel_launch(void* const* d_in, const int* in_sizes, int n_in, void* d_out, int out_size, void* d_ws, size_t ws_size, hipStream_t stream) {
    const float* x = (const float*)d_in[0]; const int* positions = (const int*)d_in[1]; const float* w_in = (const float*)d_in[2];
    const float* sinks = (const float*)d_in[3]; const float* conv_w = (const float*)d_in[4]; const float* a_log = (const float*)d_in[5];
    const float* dt_bias = (const float*)d_in[6]; const float* dn_norm_g = (const float*)d_in[7]; const float* w_out = (const float*)d_in[8];
    const float* ln1_g = (const float*)d_in[9]; const float* ln1_b = (const float*)d_in[10]; const float* w_query = (const float*)d_in[11];
    const float* sub_keys = (const float*)d_in[12]; const float* peer_u = (const float*)d_in[13]; const float* peer_v = (const float*)d_in[14];
    const float* ln2_g = (const float*)d_in[15]; const float* ln2_b = (const float*)d_in[16];
    float* out = (float*)d_out;
    char* ws = (char*)d_ws;
    const size_t R0 = 0, R0_BYTES = (size_t)M_TOK * IN_WIDTH * 4;
    const size_t R1 = R0 + R0_BYTES, R1_BYTES = (size_t)M_TOK * D_MODEL * 4;
    if (ws_size < R1 + R1_BYTES) { fprintf(stderr, "kernel_launch: workspace too small (%zu < %zu)\n", ws_size, R1 + R1_BYTES); return; }
    float* proj = (float*)(ws + R0);
    float* mixin = (float*)(ws + R1);
    float* odn_raw = out;
    float* mix = out;
    float* x1 = mixin;
    float* q = proj;
    int* ids = (int*)(ws + R0 + (size_t)M_TOK * 2048 * 4);
    float* gates = (float*)(ws + R0 + (size_t)M_TOK * 2048 * 4 + (size_t)M_TOK * 128 * 4);

    gemm_f32<<<dim3((IN_WIDTH + 127) / 128, M_TOK / 128), 256, 0, stream>>>(x, w_in, proj, M_TOK, IN_WIDTH, D_MODEL);
    rope_inplace<<<M_TOK, 256, 0, stream>>>(proj, positions);
    attn_naive<<<M_TOK * 8, 128, 0, stream>>>(proj, sinks, mixin);
    dn_naive<<<16, 128, 0, stream>>>(proj, conv_w, a_log, dt_bias, odn_raw);
    dn_norm_gate<<<M_TOK * 4, 128, 0, stream>>>(odn_raw, proj, dn_norm_g, mixin);
    gemm_f32<<<dim3(D_MODEL / 128, M_TOK / 128), 256, 0, stream>>>(mixin, w_out, mix, M_TOK, D_MODEL, D_MODEL);
    ln_res<<<M_TOK, 256, 0, stream>>>(x, mix, ln1_g, ln1_b, x1);
    gemm_f32<<<dim3(2048 / 128, M_TOK / 128), 256, 0, stream>>>(x1, w_query, q, M_TOK, 2048, D_MODEL);
    route_naive<<<M_TOK, 256, 0, stream>>>(q, sub_keys, ids, gates);
    peer_naive<<<M_TOK, 256, 0, stream>>>(x1, ids, gates, peer_u, peer_v, ln2_g, ln2_b, out);
}
```

```cpp
#include <hip/hip_runtime.h>
#include <cstdio>
#include <cstdint>
#include <math.h>

namespace {
constexpr int D_MODEL = 1024, BATCH = 4, SEQ = 8192, M_TOK = BATCH * SEQ;
constexpr int IN_WIDTH = 2824, NP_IN = 3072;
constexpr int P_AQ = 0, P_AK = 512, P_AV = 640, P_DQ = 768, P_DK = 1280, P_DV = 1792, P_Z = 2304, P_B = 2816, P_A = 2820;
constexpr float ALPHA = 1.189207115002721f;
constexpr float LN_EPS = 1e-5f, RMS_EPS = 1e-6f, L2_EPS = 1e-6f;
constexpr int NTHREADS = 512;

typedef unsigned short bf16_t;
typedef short bf16x8 __attribute__((ext_vector_type(8)));
typedef float f32x16 __attribute__((ext_vector_type(16)));
typedef float f32x4 __attribute__((ext_vector_type(4)));
typedef unsigned u32x4 __attribute__((ext_vector_type(4)));
typedef unsigned u32x2 __attribute__((ext_vector_type(2)));

struct Params {
    const float* x; const int* positions; const float* w_in; const float* sinks; const float* conv_w; const float* a_log; const float* dt_bias;
    const float* dn_norm_g; const float* w_out; const float* ln1_g; const float* ln1_b; const float* w_query; const float* sub_keys;
    const float* peer_u; const float* peer_v; const float* ln2_g; const float* ln2_b;
    float* out;
    bf16_t* xb;
    bf16_t* proj_b;
    float* odn_raw;
    int* ids; float* gates;
    bf16_t* wt_in; bf16_t* wt_out; bf16_t* wt_q;
    float* rope_cs;
    unsigned* bar;
    int ph_lo, ph_hi;
};

__device__ __forceinline__ float wave_sum(float v) {
#pragma unroll
    for (int o = 1; o < 64; o <<= 1) v += __shfl_xor(v, o);
    return v;
}
__device__ __forceinline__ float wave_max(float v) {
#pragma unroll
    for (int o = 1; o < 64; o <<= 1) v = fmaxf(v, __shfl_xor(v, o));
    return v;
}
__device__ __forceinline__ float bf2f(bf16_t u) { return __uint_as_float((unsigned)u << 16); }
__device__ __forceinline__ float bflo(unsigned u) { return __uint_as_float(u << 16); }
__device__ __forceinline__ float bfhi(unsigned u) { return __uint_as_float(u & 0xffff0000u); }
typedef __bf16 bf16x2_n __attribute__((ext_vector_type(2)));
__device__ __forceinline__ unsigned pk_bf16(float lo, float hi) { bf16x2_n v; v.x = (__bf16)lo; v.y = (__bf16)hi; return __builtin_bit_cast(unsigned, v); }
__device__ __forceinline__ float silu_f(float y) { return y / (1.f + __expf(-y)); }


#define XB_TMO      128
#define XB_XCNT(j)  (256  + 64 * (j))
#define XB_XSUB(j)  (1280 + 64 * (j))
#define XB_XGEN(j)  (2304 + 64 * (j))
#define XB_TOP      3328
#define XB_TOPGEN   3392
#define XCD_BAR_WORDS 3456
#define XB_SPIN_CAP (1u << 27)
#define LAS __attribute__((address_space(3)))
__device__ __forceinline__ unsigned xb_ld(unsigned* p)              { return __hip_atomic_load(p, __ATOMIC_RELAXED, __HIP_MEMORY_SCOPE_AGENT); }
__device__ __forceinline__ unsigned xb_add(unsigned* p, unsigned v) { return __hip_atomic_fetch_add(p, v, __ATOMIC_RELAXED, __HIP_MEMORY_SCOPE_AGENT); }
__device__ __forceinline__ unsigned xb_xcc_id() { return (unsigned)__builtin_amdgcn_s_getreg((3 << 11) | 20) & 0xFu; }
#define XB_SPIN(cond, bar) do { unsigned _sp = 0; while (cond) { __builtin_amdgcn_s_sleep(1); \
    if ((++_sp & 255u) == 0u) { if (xb_ld(&(bar)[XB_TMO])) break; if (_sp > XB_SPIN_CAP) { atomicAdd(&(bar)[XB_TMO], 1u); break; } } } } while (0)
struct XcdBarrier { unsigned* bar; unsigned x; volatile LAS unsigned* st; };
__device__ __forceinline__ XcdBarrier xcd_barrier_post(unsigned* bar, volatile LAS unsigned* st) {
    XcdBarrier b; b.bar = bar; b.x = xb_xcc_id(); b.st = st;
    if (threadIdx.x == 0) (void)xb_add(&bar[XB_XCNT(b.x)], 1u);
    return b;
}
__device__ __forceinline__ void xcd_barrier_complete(unsigned* bar, unsigned x, unsigned& nloc, unsigned& nx) {
    const unsigned G = gridDim.x * gridDim.y * gridDim.z;
    unsigned sum, cnt, mine, sp = 0u;
    for (;;) {
        sum = 0u; cnt = 0u; mine = 0u;
#pragma unroll
        for (unsigned j = 0; j < 16; ++j) { const unsigned c = xb_ld(&bar[XB_XCNT(j)]); sum += c; cnt += (c > 0u) ? 1u : 0u; mine = (j == x) ? c : mine; }
        if (sum == G) break;
        __builtin_amdgcn_s_sleep(1);
        if ((++sp & 255u) == 0u) { if (xb_ld(&bar[XB_TMO])) break; if (sp > XB_SPIN_CAP) { atomicAdd(&bar[XB_TMO], 1u); break; } }
    }
    nloc = mine > 0u ? mine : 1u; nx = cnt > 0u ? cnt : 1u;
}
__device__ __forceinline__ void xcd_barrier(const XcdBarrier& b) {
    asm volatile("s_waitcnt vmcnt(0)" ::: "memory");
    __syncthreads();
    if (threadIdx.x == 0) {
        unsigned* bar = b.bar;
        __builtin_amdgcn_s_waitcnt(0);
        unsigned nloc = b.st[0], nx = b.st[1];
        if (nloc == 0u) { xcd_barrier_complete(bar, b.x, nloc, nx); b.st[0] = nloc; b.st[1] = nx; }
        const unsigned old = xb_add(&bar[XB_XSUB(b.x)], 1u);
        const unsigned gen = old / nloc;
        if (old + 1u == (gen + 1u) * nloc) {
            __builtin_amdgcn_fence(__ATOMIC_RELEASE, "agent");
            asm volatile("s_waitcnt vmcnt(0)" ::: "memory");
            const unsigned og = xb_add(&bar[XB_TOP], 1u);
            const unsigned tg = og / nx;
            if (og + 1u == (tg + 1u) * nx) xb_add(&bar[XB_TOPGEN], 1u);
            else XB_SPIN(xb_ld(&bar[XB_TOPGEN]) == tg, bar);
            __builtin_amdgcn_fence(__ATOMIC_ACQUIRE, "agent");
            xb_add(&bar[XB_XGEN(b.x)], 1u);
            asm volatile("s_waitcnt vmcnt(0)" ::: "memory");
        } else {
            XB_SPIN(xb_ld(&bar[XB_XGEN(b.x)]) == gen, bar);
            __builtin_amdgcn_fence(__ATOMIC_ACQUIRE, "agent");
            asm volatile("s_waitcnt vmcnt(0)" ::: "memory");
        }
    }
    __syncthreads();
}

__device__ __forceinline__ int inproj_old_col(int n) {
    if (n < 2304) return n;
    if (n < 2816) return 2312 + (n - 2304);
    if (n < 2824) return 2304 + (n - 2816);
    return -1;
}
__device__ void transpose_item(const float* __restrict__ W, int N_src, bf16_t* __restrict__ WT, int K, int kb, int nb, bool permute, float* scr) {
    const int tid = threadIdx.x;
    const int nn = tid & 63, k8 = tid >> 6;
    const int n = nb * 64 + nn;
    const int oc = permute ? inproj_old_col(n) : n;
#pragma unroll
    for (int i = 0; i < 8; ++i) { const int kk = k8 + 8 * i; scr[kk * 65 + nn] = (oc >= 0) ? W[(size_t)(kb * 64 + kk) * N_src + oc] : 0.f; }
    __syncthreads();
    const int n2 = tid >> 3, c = tid & 7;
    const float* s = scr + (c * 8) * 65 + n2;
    u32x4 o; o.x = pk_bf16(s[0], s[65]); o.y = pk_bf16(s[2 * 65], s[3 * 65]); o.z = pk_bf16(s[4 * 65], s[5 * 65]); o.w = pk_bf16(s[6 * 65], s[7 * 65]);
    *(u32x4*)(WT + (size_t)(nb * 64 + n2) * K + kb * 64 + c * 8) = o;
    __syncthreads();
}
__device__ void phase_prep(const Params& p, unsigned char* smem) {
    const int tid = threadIdx.x, G = gridDim.x, bid = blockIdx.x;
    float* scr = (float*)smem;
    constexpr int I_IN = 16 * (NP_IN / 64), I_OUT = 16 * 16, I_Q = 16 * 32;
    for (int it = bid; it < I_IN + I_OUT + I_Q; it += G) {
        int r = it;
        if (r < I_IN) { transpose_item(p.w_in, IN_WIDTH, p.wt_in, 1024, r / (NP_IN / 64), r % (NP_IN / 64), true, scr); continue; } r -= I_IN;
        if (r < I_OUT) { transpose_item(p.w_out, 1024, p.wt_out, 1024, r / 16, r % 16, false, scr); continue; } r -= I_OUT;
        transpose_item(p.w_query, 2048, p.wt_q, 1024, r / 32, r % 32, false, scr);
    }
    const size_t gt = (size_t)bid * NTHREADS + tid, GT = (size_t)G * NTHREADS;
    for (size_t i = gt; i < (size_t)M_TOK * 1024 / 8; i += GT) {
        const float4 a = *(const float4*)(p.x + i * 8), b = *(const float4*)(p.x + i * 8 + 4);
        u32x4 o; o.x = pk_bf16(a.x, a.y); o.y = pk_bf16(a.z, a.w); o.z = pk_bf16(b.x, b.y); o.w = pk_bf16(b.z, b.w);
        *(u32x4*)(p.xb + i * 8) = o;
    }
    for (size_t i = gt; i < (size_t)M_TOK * 32; i += GT) {
        const int m = (int)(i >> 5), j = (int)(i & 31);
        const float inv_freq = powf(10000.0f, -(float)j / 32.0f);
        const float ang = (float)p.positions[m] * inv_freq;
        p.rope_cs[i] = cosf(ang); p.rope_cs[(size_t)M_TOK * 32 + i] = sinf(ang);
    }
}

constexpr int GK = 1024, GBK = 64, G_TILE_BYTES = 256 * 128;
constexpr int STG_STRIDE = 260;
constexpr int SMEM_BYTES = 256 * STG_STRIDE * 2 + 64;

__device__ __forceinline__ int swz(int row, int chunk) { return row * 128 + ((chunk ^ ((row >> 1) & 7)) << 4); }

struct EpiInProj {
    bf16_t* out; const float* cs;
    __device__ __forceinline__ void operator()(int m, int pn, int c8, const unsigned char* stg_row) const {
        const int col = pn * 256 + c8 * 8;
        u32x2 a0 = *(const u32x2*)(stg_row + c8 * 16), a1 = *(const u32x2*)(stg_row + c8 * 16 + 8);
        u32x4 o; o.x = a0.x; o.y = a0.y; o.z = a1.x; o.w = a1.y;
        if (col < P_AV) {
            const int d0 = col & 63, i0 = d0 & 31; const bool second = d0 >= 32;
            const int pc8 = second ? c8 - 4 : c8 + 4;
            const u32x2 b0 = *(const u32x2*)(stg_row + pc8 * 16), b1 = *(const u32x2*)(stg_row + pc8 * 16 + 8);
            const unsigned mine[4] = {a0.x, a0.y, a1.x, a1.y}, oth[4] = {b0.x, b0.y, b1.x, b1.y};
            const float* cp = cs + (size_t)m * 32 + i0; const float* sp = cs + (size_t)M_TOK * 32 + (size_t)m * 32 + i0;
            const float4 c0 = *(const float4*)cp, c1 = *(const float4*)(cp + 4), s0 = *(const float4*)sp, s1 = *(const float4*)(sp + 4);
            const float cc[8] = {c0.x, c0.y, c0.z, c0.w, c1.x, c1.y, c1.z, c1.w}, ss[8] = {s0.x, s0.y, s0.z, s0.w, s1.x, s1.y, s1.z, s1.w};
            const float scale = col < P_AK ? 0.125f : 1.f;
            float r[8];
#pragma unroll
            for (int j = 0; j < 8; ++j) {
                const float me = (j & 1) ? bfhi(mine[j >> 1]) : bflo(mine[j >> 1]);
                const float ot = (j & 1) ? bfhi(oth[j >> 1]) : bflo(oth[j >> 1]);
                r[j] = (second ? (me * cc[j] + ot * ss[j]) : (me * cc[j] - ot * ss[j])) * scale;
            }
            o.x = pk_bf16(r[0], r[1]); o.y = pk_bf16(r[2], r[3]); o.z = pk_bf16(r[4], r[5]); o.w = pk_bf16(r[6], r[7]);
        }
        *(u32x4*)(out + (size_t)m * NP_IN + col) = o;
    }
};
struct EpiOutProj {
    float* y; const float* x;
    __device__ __forceinline__ void operator()(int m, int pn, int c8, const unsigned char* stg_row) const {
        const int col = pn * 256 + c8 * 8;
        const u32x2 a0 = *(const u32x2*)(stg_row + c8 * 16), a1 = *(const u32x2*)(stg_row + c8 * 16 + 8);
        const float4 x0 = *(const float4*)(x + (size_t)m * 1024 + col), x1 = *(const float4*)(x + (size_t)m * 1024 + col + 4);
        *(float4*)(y + (size_t)m * 1024 + col) = make_float4(ALPHA * x0.x + bflo(a0.x), ALPHA * x0.y + bfhi(a0.x), ALPHA * x0.z + bflo(a0.y), ALPHA * x0.w + bfhi(a0.y));
        *(float4*)(y + (size_t)m * 1024 + col + 4) = make_float4(ALPHA * x1.x + bflo(a1.x), ALPHA * x1.y + bfhi(a1.x), ALPHA * x1.z + bflo(a1.y), ALPHA * x1.w + bfhi(a1.y));
    }
};
struct EpiBf16 {
    bf16_t* out; int ldc;
    __device__ __forceinline__ void operator()(int m, int pn, int c8, const unsigned char* stg_row) const {
        const int col = pn * 256 + c8 * 8;
        const u32x2 a0 = *(const u32x2*)(stg_row + c8 * 16), a1 = *(const u32x2*)(stg_row + c8 * 16 + 8);
        u32x4 o; o.x = a0.x; o.y = a0.y; o.z = a1.x; o.w = a1.y;
        *(u32x4*)(out + (size_t)m * ldc + col) = o;
    }
};

template <class EPI>
__device__ void gemm_phase(const bf16_t* __restrict__ A, const bf16_t* __restrict__ Bt, int M, int N, const EPI& epi, unsigned char* smem) {
    const int tid = threadIdx.x, lane = tid & 63, wave = tid >> 6, r = lane & 31, h = lane >> 5;
    const int wm = wave >> 2, wn = wave & 3;
    const int nM = M / 256, nN = N / 256, ntiles = nM * nN;
    for (int t = blockIdx.x; t < ntiles; t += gridDim.x) {
        const int pm = t / nN, pn = t % nN;
        const bf16_t* Ag = A + (size_t)pm * 256 * GK; const bf16_t* Bg = Bt + (size_t)pn * 256 * GK;
        f32x16 acc[2][4];
#pragma unroll
        for (int j = 0; j < 2; ++j)
#pragma unroll
            for (int i = 0; i < 4; ++i)
#pragma unroll
                for (int e = 0; e < 16; ++e) acc[j][i][e] = 0.f;
        u32x4 sa[4], sb[4];
        const int lrow = tid >> 3, lch = tid & 7;
#pragma unroll
        for (int i = 0; i < 4; ++i) { sa[i] = *(const u32x4*)(Ag + (size_t)(lrow + 64 * i) * GK + lch * 8); sb[i] = *(const u32x4*)(Bg + (size_t)(lrow + 64 * i) * GK + lch * 8); }
        __syncthreads();
#pragma unroll
        for (int i = 0; i < 4; ++i) { *(u32x4*)(smem + swz(lrow + 64 * i, lch)) = sa[i]; *(u32x4*)(smem + G_TILE_BYTES + swz(lrow + 64 * i, lch)) = sb[i]; }
        __syncthreads();
        int cur = 0;
        for (int kt = 0; kt < GK / GBK; ++kt) {
            if (kt + 1 < GK / GBK) {
                const int k0 = (kt + 1) * GBK;
#pragma unroll
                for (int i = 0; i < 4; ++i) { sa[i] = *(const u32x4*)(Ag + (size_t)(lrow + 64 * i) * GK + k0 + lch * 8); sb[i] = *(const u32x4*)(Bg + (size_t)(lrow + 64 * i) * GK + k0 + lch * 8); }
            }
            const unsigned char* la = smem + cur * 2 * G_TILE_BYTES; const unsigned char* lb = la + G_TILE_BYTES;
#pragma unroll
            for (int ks = 0; ks < 4; ++ks) {
                bf16x8 af[4], bf[2];
#pragma unroll
                for (int i = 0; i < 4; ++i) af[i] = *(const bf16x8*)(la + swz(wm * 128 + i * 32 + r, ks * 2 + h));
#pragma unroll
                for (int j = 0; j < 2; ++j) bf[j] = *(const bf16x8*)(lb + swz(wn * 64 + j * 32 + r, ks * 2 + h));
#pragma unroll
                for (int j = 0; j < 2; ++j)
#pragma unroll
                    for (int i = 0; i < 4; ++i) acc[j][i] = __builtin_amdgcn_mfma_f32_32x32x16_bf16(bf[j], af[i], acc[j][i], 0, 0, 0);
            }
            if (kt + 1 < GK / GBK) {
                unsigned char* na = smem + (cur ^ 1) * 2 * G_TILE_BYTES;
#pragma unroll
                for (int i = 0; i < 4; ++i) { *(u32x4*)(na + swz(lrow + 64 * i, lch)) = sa[i]; *(u32x4*)(na + G_TILE_BYTES + swz(lrow + 64 * i, lch)) = sb[i]; }
            }
            __syncthreads();
            cur ^= 1;
        }
#pragma unroll
        for (int j = 0; j < 2; ++j)
#pragma unroll
            for (int i = 0; i < 4; ++i)
#pragma unroll
                for (int g = 0; g < 4; ++g) {
                    u32x2 v; v.x = pk_bf16(acc[j][i][4 * g], acc[j][i][4 * g + 1]); v.y = pk_bf16(acc[j][i][4 * g + 2], acc[j][i][4 * g + 3]);
                    *(u32x2*)(smem + (size_t)(wm * 128 + i * 32 + r) * (STG_STRIDE * 2) + (wn * 64 + j * 32 + 8 * g + 4 * h) * 2) = v;
                }
        __syncthreads();
        const int erow = tid >> 5, ec8 = tid & 31;
#pragma unroll 4
        for (int ps = 0; ps < 16; ++ps) { const int row = ps * 16 + erow; epi(pm * 256 + row, pn, ec8, smem + (size_t)row * (STG_STRIDE * 2)); }
    }
    __syncthreads();
}

__device__ void phase_attn_simple(const Params& p, unsigned char* smem, int first_block) {
    const int tid = threadIdx.x, sub = tid >> 7, st = tid & 127;
    float* qs = (float*)smem + sub * 256; float* ps = qs + 64; float* red = qs + 192;
    const int nblk = gridDim.x - first_block;
    const bf16_t* pb = p.proj_b;
    for (int base = (blockIdx.x - first_block) * 4; base < M_TOK * 8; base += nblk * 4) {
        const int item = base + sub, m = item >> 3, head = item & 7, kvh = head >> 2, t = m % SEQ;
        __syncthreads();
        if (st < 64) qs[st] = bf2f(pb[(size_t)m * NP_IN + P_AQ + head * 64 + st]);
        __syncthreads();
        const int k = st; const bool valid = (t - k) >= 0;
        float s = -1e30f;
        if (valid) {
            const u32x4* kr = (const u32x4*)(pb + (size_t)(m - k) * NP_IN + P_AK + kvh * 64);
            float a = 0.f;
#pragma unroll
            for (int c = 0; c < 8; ++c) { const u32x4 kk = kr[c]; const float* q8 = qs + c * 8;
                a += q8[0] * bflo(kk.x) + q8[1] * bfhi(kk.x) + q8[2] * bflo(kk.y) + q8[3] * bfhi(kk.y) + q8[4] * bflo(kk.z) + q8[5] * bfhi(kk.z) + q8[6] * bflo(kk.w) + q8[7] * bfhi(kk.w); }
            s = a;
        }
        float mx = wave_max(s);
        if ((st & 63) == 0) red[st >> 6] = mx;
        __syncthreads();
        const float sink = p.sinks[head];
        mx = fmaxf(fmaxf(red[0], red[1]), sink);
        const float pe = valid ? __expf(s - mx) : 0.f;
        float sm = wave_sum(pe);
        if ((st & 63) == 0) red[2 + (st >> 6)] = sm;
        __syncthreads();
        const float denom = red[2] + red[3] + __expf(sink - mx);
        ps[k] = pe / denom;
        __syncthreads();
        if (st < 64) {
            float o = 0.f;
            const int kmax = t < 127 ? t : 127;
            for (int kk = 0; kk <= kmax; ++kk) o = fmaf(ps[kk], bf2f(pb[(size_t)(m - kk) * NP_IN + P_AV + kvh * 64 + st]), o);
            p.xb[(size_t)m * D_MODEL + head * 64 + st] = (bf16_t)(pk_bf16(o, 0.f) & 0xffffu);
        }
    }
    __syncthreads();
}

__device__ void phase_dn_simple(const Params& p, unsigned char* smem) {
    const int tid = threadIdx.x, lane = tid & 63;
    float* ks = (float*)smem; float* qs = ks + 128; float* red = qs + 128;
    const int b = blockIdx.x >> 2, h = blockIdx.x & 3;
    const bool act = tid < 256;
    const int kind = (tid >> 7) & 1, c = tid & 127;
    const int e = ((tid >> 6) & 3) * 32 + (lane & 31), half = lane >> 5;
    float s[64];
#pragma unroll
    for (int d = 0; d < 64; ++d) s[d] = 0.f;
    float wa[4], wv[4];
#pragma unroll
    for (int j = 0; j < 4; ++j) { wa[j] = p.conv_w[j * 1536 + kind * 512 + h * 128 + c]; wv[j] = p.conv_w[j * 1536 + 1024 + h * 128 + e]; }
    float xa[3] = {0.f, 0.f, 0.f}, xv[3] = {0.f, 0.f, 0.f};
    const float neg_a = -expf(p.a_log[h]), dtb = p.dt_bias[h];
    const bf16_t* pr = p.proj_b + (size_t)b * SEQ * NP_IN;
    const int ca_off = (kind ? P_DK : P_DQ) + h * 128 + c, cv_off = P_DV + h * 128 + e;
    float na = bf2f(pr[ca_off]), nv = bf2f(pr[cv_off]), nb = bf2f(pr[P_B + h]), ng = bf2f(pr[P_A + h]);
    for (int t = 0; t < SEQ; ++t) {
        const float ca = na, cv = nv, cb = nb, cg_ = ng;
        if (t + 1 < SEQ) { const bf16_t* p2 = pr + (size_t)(t + 1) * NP_IN; na = bf2f(p2[ca_off]); nv = bf2f(p2[cv_off]); nb = bf2f(p2[P_B + h]); ng = bf2f(p2[P_A + h]); }
        float a = silu_f(wa[0] * xa[0] + wa[1] * xa[1] + wa[2] * xa[2] + wa[3] * ca);
        const float v = silu_f(wv[0] * xv[0] + wv[1] * xv[1] + wv[2] * xv[2] + wv[3] * cv);
        xa[0] = xa[1]; xa[1] = xa[2]; xa[2] = ca; xv[0] = xv[1]; xv[1] = xv[2]; xv[2] = cv;
        const float ss = wave_sum(a * a);
        if (act && lane == 0) red[tid >> 6] = ss;
        __syncthreads();
        if (act) {
            const float tot = kind ? (red[2] + red[3]) : (red[0] + red[1]);
            a = a * rsqrtf(tot + L2_EPS) * (kind ? 1.f : 0.08838834764831845f);
            if (kind) ks[c] = a; else qs[c] = a;
        }
        __syncthreads();
        if (act) {
            const float beta = 1.f / (1.f + expf(-cb));
            const float xx = cg_ + dtb;
            const float sp = xx > 20.f ? xx : log1pf(expf(xx));
            const float gt = expf(neg_a * sp);
            const float* kh = ks + half * 64; const float* qh = qs + half * 64;
            float kS = 0.f;
#pragma unroll
            for (int d = 0; d < 64; d += 4) { const float4 k4 = *(const float4*)&kh[d]; kS = fmaf(k4.x, s[d], kS); kS = fmaf(k4.y, s[d + 1], kS); kS = fmaf(k4.z, s[d + 2], kS); kS = fmaf(k4.w, s[d + 3], kS); }
            kS += __shfl_xor(kS, 32);
            const float cc = beta * (v - gt * kS);
            float o = 0.f;
#pragma unroll
            for (int d = 0; d < 64; d += 4) {
                const float4 k4 = *(const float4*)&kh[d]; const float4 q4 = *(const float4*)&qh[d];
                s[d] = fmaf(gt, s[d], k4.x * cc); o = fmaf(s[d], q4.x, o);
                s[d + 1] = fmaf(gt, s[d + 1], k4.y * cc); o = fmaf(s[d + 1], q4.y, o);
                s[d + 2] = fmaf(gt, s[d + 2], k4.z * cc); o = fmaf(s[d + 2], q4.z, o);
                s[d + 3] = fmaf(gt, s[d + 3], k4.w * cc); o = fmaf(s[d + 3], q4.w, o);
            }
            o += __shfl_xor(o, 32);
            if (half == 0) p.odn_raw[((size_t)b * SEQ + t) * 512 + h * 128 + e] = o;
        }
    }
    __syncthreads();
}

__device__ void phase_dn_norm(const Params& p) {
    const int lane = threadIdx.x & 63, gw = blockIdx.x * (NTHREADS / 64) + (threadIdx.x >> 6), GW = gridDim.x * (NTHREADS / 64);
    for (int it = gw; it < M_TOK * 4; it += GW) {
        const int m = it >> 2, h = it & 3;
        const float2 o = *(const float2*)(p.odn_raw + (size_t)m * 512 + h * 128 + lane * 2);
        const float ss = wave_sum(o.x * o.x + o.y * o.y);
        const float rr = rsqrtf(ss * (1.f / 128.f) + RMS_EPS);
        const unsigned z = *(const unsigned*)(p.proj_b + (size_t)m * NP_IN + P_Z + h * 128 + lane * 2);
        const float2 g = *(const float2*)(p.dn_norm_g + lane * 2);
        *(unsigned*)(p.xb + (size_t)m * D_MODEL + 512 + h * 128 + lane * 2) = pk_bf16(o.x * rr * g.x * silu_f(bflo(z)), o.y * rr * g.y * silu_f(bfhi(z)));
    }
}

__device__ void phase_ln1(const Params& p, bf16_t* x1b) {
    const int lane = threadIdx.x & 63, gw = blockIdx.x * (NTHREADS / 64) + (threadIdx.x >> 6), GW = gridDim.x * (NTHREADS / 64);
    for (int m = gw; m < M_TOK; m += GW) {
        float* row = p.out + (size_t)m * D_MODEL;
        float4 v[4]; float s = 0.f;
#pragma unroll
        for (int j = 0; j < 4; ++j) { v[j] = *(const float4*)(row + j * 256 + lane * 4); s += (v[j].x + v[j].y) + (v[j].z + v[j].w); }
        const float mean = wave_sum(s) * (1.f / D_MODEL); float q = 0.f;
#pragma unroll
        for (int j = 0; j < 4; ++j) { v[j].x -= mean; v[j].y -= mean; v[j].z -= mean; v[j].w -= mean; q += (v[j].x * v[j].x + v[j].y * v[j].y) + (v[j].z * v[j].z + v[j].w * v[j].w); }
        const float rstd = rsqrtf(wave_sum(q) * (1.f / D_MODEL) + LN_EPS);
#pragma unroll
        for (int j = 0; j < 4; ++j) {
            const float4 g = *(const float4*)(p.ln1_g + j * 256 + lane * 4), bb = *(const float4*)(p.ln1_b + j * 256 + lane * 4);
            const float4 o = make_float4(v[j].x * rstd * g.x + bb.x, v[j].y * rstd * g.y + bb.y, v[j].z * rstd * g.z + bb.z, v[j].w * rstd * g.w + bb.w);
            *(float4*)(row + j * 256 + lane * 4) = o;
            u32x2 ob; ob.x = pk_bf16(o.x, o.y); ob.y = pk_bf16(o.z, o.w);
            *(u32x2*)(x1b + (size_t)m * D_MODEL + j * 256 + lane * 4) = ob;
        }
    }
}

__device__ __forceinline__ void wave_argmax(float& v, int& i) {
#pragma unroll
    for (int o = 1; o < 64; o <<= 1) {
        const float ov = __shfl_xor(v, o); const int oi = __shfl_xor(i, o);
        if (ov > v || (ov == v && oi < i)) { v = ov; i = oi; }
    }
}
__device__ void phase_route_simple(const Params& p, const bf16_t* qb, unsigned char* smem) {
    const int tid = threadIdx.x, sub = tid >> 8, st = tid & 255, lane = tid & 63, w = st >> 6;
    float* base_s = (float*)smem + sub * 4608;
    float* qs = base_s;
    float* sc = qs + 2048;
    float* tv = sc + 2048;
    int* ti = (int*)(tv + 256);
    for (int mb = blockIdx.x * 2; mb < M_TOK; mb += gridDim.x * 2) {
        const int m = mb + sub;
        __syncthreads();
        for (int i = st; i < 2048; i += 256) qs[i] = bf2f(qb[(size_t)m * 2048 + i]);
        __syncthreads();
        for (int e = st; e < 2048; e += 256) {
            const int grp = e >> 7, key = e & 127;
            const float* kr = p.sub_keys + ((size_t)grp * 128 + key) * 128;
            const float* qq = qs + grp * 128;
            float a = 0.f;
#pragma unroll 8
            for (int d = 0; d < 128; d += 4) { const float4 k4 = *(const float4*)(kr + d); a = fmaf(qq[d], k4.x, a); a = fmaf(qq[d + 1], k4.y, a); a = fmaf(qq[d + 2], k4.z, a); a = fmaf(qq[d + 3], k4.w, a); }
            sc[grp * 128 + key] = a;
        }
        __syncthreads();
        for (int grp = w; grp < 16; grp += 4) {
            float v0 = sc[grp * 128 + lane], v1 = sc[grp * 128 + lane + 64];
            for (int rr = 0; rr < 16; ++rr) {
                float bv; int bi;
                if (v0 >= v1) { bv = v0; bi = lane; } else { bv = v1; bi = lane + 64; }
                wave_argmax(bv, bi);
                if (lane == 0) { tv[grp * 16 + rr] = bv; ti[grp * 16 + rr] = bi; }
                if (bi == lane) v0 = -INFINITY; else if (bi == lane + 64) v1 = -INFINITY;
            }
        }
        __syncthreads();
        for (int hh = w; hh < 8; hh += 4) {
            float cv[4]; int ci[4];
#pragma unroll
            for (int j = 0; j < 4; ++j) { const int c = lane + 64 * j, i0 = c >> 4, i1 = c & 15; cv[j] = tv[(hh * 2) * 16 + i0] + tv[(hh * 2 + 1) * 16 + i1]; ci[j] = ti[(hh * 2) * 16 + i0] * 128 + ti[(hh * 2 + 1) * 16 + i1]; }
            float bestv = 0.f; int beste = 0; float mx = 0.f;
            for (int rr = 0; rr < 16; ++rr) {
                float bv = cv[0]; int bj = 0;
#pragma unroll
                for (int j = 1; j < 4; ++j) if (cv[j] > bv) { bv = cv[j]; bj = j; }
                int bi = lane + 64 * bj;
                wave_argmax(bv, bi);
                const int src = bi & 63, sj = bi >> 6;
                int e = 0;
#pragma unroll
                for (int j = 0; j < 4; ++j) if (sj == j) e = ci[j];
                e = __shfl(e, src);
                if (lane == src) {
#pragma unroll
                    for (int j = 0; j < 4; ++j) if (sj == j) cv[j] = -INFINITY;
                }
                if (rr == 0) mx = bv;
                if (lane == rr) { bestv = bv; beste = e; }
            }
            const float ex = lane < 16 ? expf(bestv - mx) : 0.f;
            const float den = wave_sum(ex);
            if (lane < 16) { p.ids[(size_t)m * 128 + hh * 16 + lane] = beste; p.gates[(size_t)m * 128 + hh * 16 + lane] = ex / den; }
        }
    }
    __syncthreads();
}

__device__ void phase_peer_simple(const Params& p) {
    const int lane = threadIdx.x & 63, gw = blockIdx.x * (NTHREADS / 64) + (threadIdx.x >> 6), GW = gridDim.x * (NTHREADS / 64);
    for (int m = gw; m < M_TOK; m += GW) {
        float* row = p.out + (size_t)m * D_MODEL;
        float4 xr[4], acc[4];
#pragma unroll
        for (int j = 0; j < 4; ++j) { xr[j] = *(const float4*)(row + j * 256 + lane * 4); acc[j] = make_float4(0.f, 0.f, 0.f, 0.f); }
        const int e0 = p.ids[(size_t)m * 128 + lane], e1 = p.ids[(size_t)m * 128 + 64 + lane];
        const float g0 = p.gates[(size_t)m * 128 + lane], g1 = p.gates[(size_t)m * 128 + 64 + lane];
        for (int k = 0; k < 128; ++k) {
            const int e = __shfl(k < 64 ? e0 : e1, k & 63); const float gt = __shfl(k < 64 ? g0 : g1, k & 63);
            const float* ur = p.peer_u + (size_t)e * D_MODEL; const float* vr = p.peer_v + (size_t)e * D_MODEL;
            float d = 0.f; float4 vv[4];
#pragma unroll
            for (int j = 0; j < 4; ++j) { const float4 u4 = *(const float4*)(ur + j * 256 + lane * 4); vv[j] = *(const float4*)(vr + j * 256 + lane * 4);
                d += xr[j].x * u4.x + xr[j].y * u4.y + xr[j].z * u4.z + xr[j].w * u4.w; }
            d = wave_sum(d);
            const float wgt = 0.5f * d * (1.f + erff(d * 0.7071067811865476f)) * gt;
#pragma unroll
            for (int j = 0; j < 4; ++j) { acc[j].x = fmaf(wgt, vv[j].x, acc[j].x); acc[j].y = fmaf(wgt, vv[j].y, acc[j].y); acc[j].z = fmaf(wgt, vv[j].z, acc[j].z); acc[j].w = fmaf(wgt, vv[j].w, acc[j].w); }
        }
        float s = 0.f;
#pragma unroll
        for (int j = 0; j < 4; ++j) { acc[j].x += ALPHA * xr[j].x; acc[j].y += ALPHA * xr[j].y; acc[j].z += ALPHA * xr[j].z; acc[j].w += ALPHA * xr[j].w; s += (acc[j].x + acc[j].y) + (acc[j].z + acc[j].w); }
        const float mean = wave_sum(s) * (1.f / D_MODEL); float q = 0.f;
#pragma unroll
        for (int j = 0; j < 4; ++j) { acc[j].x -= mean; acc[j].y -= mean; acc[j].z -= mean; acc[j].w -= mean; q += (acc[j].x * acc[j].x + acc[j].y * acc[j].y) + (acc[j].z * acc[j].z + acc[j].w * acc[j].w); }
        const float rstd = rsqrtf(wave_sum(q) * (1.f / D_MODEL) + LN_EPS);
#pragma unroll
        for (int j = 0; j < 4; ++j) {
            const float4 g = *(const float4*)(p.ln2_g + j * 256 + lane * 4), bb = *(const float4*)(p.ln2_b + j * 256 + lane * 4);
            *(float4*)(row + j * 256 + lane * 4) = make_float4(acc[j].x * rstd * g.x + bb.x, acc[j].y * rstd * g.y + bb.y, acc[j].z * rstd * g.z + bb.z, acc[j].w * rstd * g.w + bb.w);
        }
    }
}

constexpr int N_PHASES = 9;
__global__ void __launch_bounds__(NTHREADS) mega_fwd(Params p) {
    __shared__ __attribute__((aligned(16))) unsigned char smem[SMEM_BYTES];
    __shared__ uint4 xb_words;
    if (threadIdx.x == 0) xb_words = make_uint4(0u, 0u, 0u, 0u);
    __syncthreads();
    XcdBarrier bar; bar.bar = p.bar; bar.x = 0; bar.st = (volatile LAS unsigned*)&xb_words;
    if (p.ph_hi - p.ph_lo > 1) bar = xcd_barrier_post(p.bar, (volatile LAS unsigned*)&xb_words);
    bf16_t* qb = p.proj_b;
    bf16_t* x1b = p.proj_b + (size_t)M_TOK * 2048;
#define PH(k) (p.ph_lo <= (k) && (k) < p.ph_hi)
#define SYNC(k) do { if (PH(k) && PH((k) + 1)) xcd_barrier(bar); } while (0)
    if (PH(0)) phase_prep(p, smem);
    SYNC(0);
    if (PH(1)) { EpiInProj e{p.proj_b, p.rope_cs}; gemm_phase(p.xb, p.wt_in, M_TOK, NP_IN, e, smem); }
    SYNC(1);
    if (PH(2)) { if (blockIdx.x < 16) phase_dn_simple(p, smem); else phase_attn_simple(p, smem, 16); }
    SYNC(2);
    if (PH(3)) phase_dn_norm(p);
    SYNC(3);
    if (PH(4)) { EpiOutProj e{p.out, p.x}; gemm_phase(p.xb, p.wt_out, M_TOK, 1024, e, smem); }
    SYNC(4);
    if (PH(5)) phase_ln1(p, x1b);
    SYNC(5);
    if (PH(6)) { EpiBf16 e{qb, 2048}; gemm_phase(x1b, p.wt_q, M_TOK, 2048, e, smem); }
    SYNC(6);
    if (PH(7)) phase_route_simple(p, qb, smem);
    SYNC(7);
    if (PH(8)) phase_peer_simple(p);
#undef PH
#undef SYNC
}
}

#ifndef MK_LAUNCHES
#define MK_LAUNCHES 1
#endif

extern "C" void kernel_launch(void* const* d_in, const int* in_sizes, int n_in, void* d_out, int out_size, void* d_ws, size_t ws_size, hipStream_t stream) {
    static int grid_blocks = 0;
    if (!grid_blocks) {
        int dev = 0, cus = 0, per_cu = 0;
        (void)hipGetDevice(&dev);
        (void)hipDeviceGetAttribute(&cus, hipDeviceAttributeMultiprocessorCount, dev);
        (void)hipOccupancyMaxActiveBlocksPerMultiprocessor(&per_cu, mega_fwd, NTHREADS, 0);
        if (per_cu < 1) { fprintf(stderr, "kernel_launch: occupancy query reports %d blocks per CU\n", per_cu); per_cu = 1; }
        grid_blocks = cus * 1;
        (void)hipGetLastError();
    }
    Params p{};
    p.x = (const float*)d_in[0]; p.positions = (const int*)d_in[1]; p.w_in = (const float*)d_in[2]; p.sinks = (const float*)d_in[3];
    p.conv_w = (const float*)d_in[4]; p.a_log = (const float*)d_in[5]; p.dt_bias = (const float*)d_in[6]; p.dn_norm_g = (const float*)d_in[7];
    p.w_out = (const float*)d_in[8]; p.ln1_g = (const float*)d_in[9]; p.ln1_b = (const float*)d_in[10]; p.w_query = (const float*)d_in[11];
    p.sub_keys = (const float*)d_in[12]; p.peer_u = (const float*)d_in[13]; p.peer_v = (const float*)d_in[14]; p.ln2_g = (const float*)d_in[15]; p.ln2_b = (const float*)d_in[16];
    p.out = (float*)d_out;
    char* ws = (char*)d_ws; size_t off = 0;
    auto take = [&](size_t bytes) { char* r = ws + off; off += (bytes + 255) & ~(size_t)255; return r; };
    p.xb = (bf16_t*)take((size_t)M_TOK * 1024 * 2);
    p.proj_b = (bf16_t*)take((size_t)M_TOK * NP_IN * 2);
    p.odn_raw = (float*)take((size_t)M_TOK * 512 * 4);
    p.ids = (int*)take((size_t)M_TOK * 128 * 4);
    p.gates = (float*)take((size_t)M_TOK * 128 * 4);
    p.wt_in = (bf16_t*)take((size_t)NP_IN * 1024 * 2);
    p.wt_out = (bf16_t*)take((size_t)1024 * 1024 * 2);
    p.wt_q = (bf16_t*)take((size_t)2048 * 1024 * 2);
    p.rope_cs = (float*)take((size_t)M_TOK * 64 * 4);
    p.bar = (unsigned*)take((size_t)XCD_BAR_WORDS * 4);
    if (off > ws_size) { fprintf(stderr, "kernel_launch: workspace too small (%zu < %zu)\n", ws_size, off); return; }
    if (hipMemsetAsync(p.bar, 0, (size_t)XCD_BAR_WORDS * 4, stream) != hipSuccess) { fprintf(stderr, "kernel_launch: memset of barrier words failed\n"); return; }
#if MK_LAUNCHES == 1
    p.ph_lo = 0; p.ph_hi = N_PHASES;
    void* args[] = {&p};
    hipError_t e = hipLaunchCooperativeKernel((void*)mega_fwd, dim3(grid_blocks), dim3(NTHREADS), args, 0, stream);
    if (e != hipSuccess) fprintf(stderr, "cooperative launch failed: %s (grid %d)\n", hipGetErrorString(e), grid_blocks);
#else
    for (int k = 0; k < N_PHASES; ++k) { p.ph_lo = k; p.ph_hi = k + 1; hipLaunchKernelGGL(mega_fwd, dim3(grid_blocks), dim3(NTHREADS), 0, stream, p); }
#endif
}
```

```cpp
#include <hip/hip_runtime.h>
#include <cstdio>
#include <cstdint>
#include <math.h>

namespace {
constexpr int D_MODEL = 1024, BATCH = 4, SEQ = 8192, M_TOK = BATCH * SEQ;
constexpr int IN_WIDTH = 2824, NP_IN = 3072;
constexpr int P_AQ = 0, P_AK = 512, P_AV = 640, P_DQ = 768, P_DK = 1280, P_DV = 1792, P_Z = 2304, P_B = 2816, P_A = 2820;
constexpr float ALPHA = 1.189207115002721f;
constexpr float LN_EPS = 1e-5f, RMS_EPS = 1e-6f, L2_EPS = 1e-6f;
constexpr int NTHREADS = 512;

typedef unsigned short bf16_t;
typedef short bf16x8 __attribute__((ext_vector_type(8)));
typedef float f32x16 __attribute__((ext_vector_type(16)));
typedef float f32x4 __attribute__((ext_vector_type(4)));
typedef unsigned u32x4 __attribute__((ext_vector_type(4)));
typedef unsigned u32x2 __attribute__((ext_vector_type(2)));

struct Params {
    const float* x; const int* positions; const float* w_in; const float* sinks; const float* conv_w; const float* a_log; const float* dt_bias;
    const float* dn_norm_g; const float* w_out; const float* ln1_g; const float* ln1_b; const float* w_query; const float* sub_keys;
    const float* peer_u; const float* peer_v; const float* ln2_g; const float* ln2_b;
    float* out;
    bf16_t* xb;
    bf16_t* proj_b;
    float* odn_raw;
    int* ids; float* gates;
    bf16_t* wt_in; bf16_t* wt_out; bf16_t* wt_q;
    float* rope_cs;
    bf16_t* dn_negw; bf16_t* dn_qd; bf16_t* dn_kdt; bf16_t* dn_qk; float* dn_u; float* dn_gl;
    bf16_t* sk_frag;
    bf16_t* tab_u;
    unsigned* bar;
    int ph_lo, ph_hi;
};

__device__ __forceinline__ float wave_sum(float v) {
#pragma unroll
    for (int o = 1; o < 64; o <<= 1) v += __shfl_xor(v, o);
    return v;
}
__device__ __forceinline__ float wave_max(float v) {
#pragma unroll
    for (int o = 1; o < 64; o <<= 1) v = fmaxf(v, __shfl_xor(v, o));
    return v;
}
__device__ __forceinline__ float bf2f(bf16_t u) { return __uint_as_float((unsigned)u << 16); }
__device__ __forceinline__ float bflo(unsigned u) { return __uint_as_float(u << 16); }
__device__ __forceinline__ float bfhi(unsigned u) { return __uint_as_float(u & 0xffff0000u); }
typedef __bf16 bf16x2_n __attribute__((ext_vector_type(2)));
__device__ __forceinline__ unsigned pk_bf16(float lo, float hi) { bf16x2_n v; v.x = (__bf16)lo; v.y = (__bf16)hi; return __builtin_bit_cast(unsigned, v); }
__device__ __forceinline__ float silu_f(float y) { return y / (1.f + __expf(-y)); }


#define XB_TMO      128
#define XB_XCNT(j)  (256  + 64 * (j))
#define XB_XSUB(j)  (1280 + 64 * (j))
#define XB_XGEN(j)  (2304 + 64 * (j))
#define XB_TOP      3328
#define XB_TOPGEN   3392
#define XCD_BAR_WORDS 3456
#define XB_SPIN_CAP (1u << 27)
#define LAS __attribute__((address_space(3)))
__device__ __forceinline__ unsigned xb_ld(unsigned* p)              { return __hip_atomic_load(p, __ATOMIC_RELAXED, __HIP_MEMORY_SCOPE_AGENT); }
__device__ __forceinline__ unsigned xb_add(unsigned* p, unsigned v) { return __hip_atomic_fetch_add(p, v, __ATOMIC_RELAXED, __HIP_MEMORY_SCOPE_AGENT); }
__device__ __forceinline__ unsigned xb_xcc_id() { return (unsigned)__builtin_amdgcn_s_getreg((3 << 11) | 20) & 0xFu; }
#define XB_SPIN(cond, bar) do { unsigned _sp = 0; while (cond) { __builtin_amdgcn_s_sleep(1); \
    if ((++_sp & 255u) == 0u) { if (xb_ld(&(bar)[XB_TMO])) break; if (_sp > XB_SPIN_CAP) { atomicAdd(&(bar)[XB_TMO], 1u); break; } } } } while (0)
struct XcdBarrier { unsigned* bar; unsigned x; volatile LAS unsigned* st; };
__device__ __forceinline__ XcdBarrier xcd_barrier_post(unsigned* bar, volatile LAS unsigned* st) {
    XcdBarrier b; b.bar = bar; b.x = xb_xcc_id(); b.st = st;
    if (threadIdx.x == 0) (void)xb_add(&bar[XB_XCNT(b.x)], 1u);
    return b;
}
__device__ __forceinline__ void xcd_barrier_complete(unsigned* bar, unsigned x, unsigned& nloc, unsigned& nx) {
    const unsigned G = gridDim.x * gridDim.y * gridDim.z;
    unsigned sum, cnt, mine, sp = 0u;
    for (;;) {
        sum = 0u; cnt = 0u; mine = 0u;
#pragma unroll
        for (unsigned j = 0; j < 16; ++j) { const unsigned c = xb_ld(&bar[XB_XCNT(j)]); sum += c; cnt += (c > 0u) ? 1u : 0u; mine = (j == x) ? c : mine; }
        if (sum == G) break;
        __builtin_amdgcn_s_sleep(1);
        if ((++sp & 255u) == 0u) { if (xb_ld(&bar[XB_TMO])) break; if (sp > XB_SPIN_CAP) { atomicAdd(&bar[XB_TMO], 1u); break; } }
    }
    nloc = mine > 0u ? mine : 1u; nx = cnt > 0u ? cnt : 1u;
}
__device__ __forceinline__ void xcd_barrier(const XcdBarrier& b) {
    asm volatile("s_waitcnt vmcnt(0)" ::: "memory");
    __syncthreads();
    if (threadIdx.x == 0) {
        unsigned* bar = b.bar;
        __builtin_amdgcn_s_waitcnt(0);
        unsigned nloc = b.st[0], nx = b.st[1];
        if (nloc == 0u) { xcd_barrier_complete(bar, b.x, nloc, nx); b.st[0] = nloc; b.st[1] = nx; }
        const unsigned old = xb_add(&bar[XB_XSUB(b.x)], 1u);
        const unsigned gen = old / nloc;
        if (old + 1u == (gen + 1u) * nloc) {
            __builtin_amdgcn_fence(__ATOMIC_RELEASE, "agent");
            asm volatile("s_waitcnt vmcnt(0)" ::: "memory");
            const unsigned og = xb_add(&bar[XB_TOP], 1u);
            const unsigned tg = og / nx;
            if (og + 1u == (tg + 1u) * nx) xb_add(&bar[XB_TOPGEN], 1u);
            else XB_SPIN(xb_ld(&bar[XB_TOPGEN]) == tg, bar);
            __builtin_amdgcn_fence(__ATOMIC_ACQUIRE, "agent");
            xb_add(&bar[XB_XGEN(b.x)], 1u);
            asm volatile("s_waitcnt vmcnt(0)" ::: "memory");
        } else {
            XB_SPIN(xb_ld(&bar[XB_XGEN(b.x)]) == gen, bar);
            __builtin_amdgcn_fence(__ATOMIC_ACQUIRE, "agent");
            asm volatile("s_waitcnt vmcnt(0)" ::: "memory");
        }
    }
    __syncthreads();
}

__device__ __forceinline__ int inproj_old_col(int n) {
    if (n < 2304) return n;
    if (n < 2816) return 2312 + (n - 2304);
    if (n < 2824) return 2304 + (n - 2816);
    return -1;
}
__device__ __forceinline__ void transpose_item(const float* __restrict__ W, int N_src, bf16_t* __restrict__ WT, int K, int kb, int nb, bool permute, float* scr) {
    const int tid = threadIdx.x;
    const int nn = tid & 63, k8 = tid >> 6;
    const int n = nb * 64 + nn;
    const int oc = permute ? inproj_old_col(n) : n;
#pragma unroll
    for (int i = 0; i < 8; ++i) { const int kk = k8 + 8 * i; scr[kk * 65 + nn] = (oc >= 0) ? W[(size_t)(kb * 64 + kk) * N_src + oc] : 0.f; }
    __syncthreads();
    const int n2 = tid >> 3, c = tid & 7;
    const float* s = scr + (c * 8) * 65 + n2;
    u32x4 o; o.x = pk_bf16(s[0], s[65]); o.y = pk_bf16(s[2 * 65], s[3 * 65]); o.z = pk_bf16(s[4 * 65], s[5 * 65]); o.w = pk_bf16(s[6 * 65], s[7 * 65]);
    *(u32x4*)(WT + (size_t)(nb * 64 + n2) * K + kb * 64 + c * 8) = o;
    __syncthreads();
}
__device__ __forceinline__ void phase_prep(const Params& p, unsigned char* smem) {
    const int tid = threadIdx.x, G = gridDim.x, bid = blockIdx.x;
    float* scr = (float*)smem;
    constexpr int I_IN = 16 * (NP_IN / 64), I_OUT = 16 * 16, I_Q = 16 * 32;
    for (int it = bid; it < I_IN + I_OUT + I_Q; it += G) {
        int r = it;
        if (r < I_IN) { transpose_item(p.w_in, IN_WIDTH, p.wt_in, 1024, r / (NP_IN / 64), r % (NP_IN / 64), true, scr); continue; } r -= I_IN;
        if (r < I_OUT) { transpose_item(p.w_out, 1024, p.wt_out, 1024, r / 16, r % 16, false, scr); continue; } r -= I_OUT;
        transpose_item(p.w_query, 2048, p.wt_q, 1024, r / 32, r % 32, false, scr);
    }
    const size_t gt = (size_t)bid * NTHREADS + tid, GT = (size_t)G * NTHREADS;
    for (size_t i = gt; i < (size_t)M_TOK * 1024 / 8; i += GT) {
        const float4 a = *(const float4*)(p.x + i * 8), b = *(const float4*)(p.x + i * 8 + 4);
        u32x4 o; o.x = pk_bf16(a.x, a.y); o.y = pk_bf16(a.z, a.w); o.z = pk_bf16(b.x, b.y); o.w = pk_bf16(b.z, b.w);
        *(u32x4*)(p.xb + i * 8) = o;
    }
    for (size_t i = gt; i < (size_t)16 * 4 * 8 * 64; i += GT) {
        const int ln = (int)(i & 63), ks = (int)((i >> 6) & 7), kt = (int)((i >> 9) & 3), hp = (int)(i >> 11);
        const float* src = p.sub_keys + ((size_t)(hp * 128 + 32 * kt + (ln & 31))) * 128 + 16 * ks + 8 * (ln >> 5);
        const float4 a = *(const float4*)src, b = *(const float4*)(src + 4);
        u32x4 o; o.x = pk_bf16(a.x, a.y); o.y = pk_bf16(a.z, a.w); o.z = pk_bf16(b.x, b.y); o.w = pk_bf16(b.z, b.w);
        *(u32x4*)(p.sk_frag + i * 8) = o;
    }
    for (size_t i = gt; i < (size_t)M_TOK * 32; i += GT) {
        const int m = (int)(i >> 5), j = (int)(i & 31);
        const float inv_freq = powf(10000.0f, -(float)j / 32.0f);
        const float ang = (float)p.positions[m] * inv_freq;
        p.rope_cs[i] = cosf(ang); p.rope_cs[(size_t)M_TOK * 32 + i] = sinf(ang);
    }
}

constexpr int GK = 1024, GBK = 64, G_TILE_BYTES = 256 * 128;
constexpr int STG_STRIDE = 260;
constexpr int SMEM_BYTES = 159744;

__device__ __forceinline__ int swz(int row, int chunk) { return row * 128 + ((chunk ^ ((row >> 1) & 7)) << 4); }

struct EpiInProj {
    bf16_t* out; const float* cs;
    __device__ __forceinline__ void operator()(int m, int pn, int c8, const unsigned char* stg_row) const {
        const int col = pn * 256 + c8 * 8;
        u32x2 a0 = *(const u32x2*)(stg_row + c8 * 16), a1 = *(const u32x2*)(stg_row + c8 * 16 + 8);
        u32x4 o; o.x = a0.x; o.y = a0.y; o.z = a1.x; o.w = a1.y;
        if (col < P_AV) {
            const int d0 = col & 63, i0 = d0 & 31; const bool second = d0 >= 32;
            const int pc8 = second ? c8 - 4 : c8 + 4;
            const u32x2 b0 = *(const u32x2*)(stg_row + pc8 * 16), b1 = *(const u32x2*)(stg_row + pc8 * 16 + 8);
            const unsigned mine[4] = {a0.x, a0.y, a1.x, a1.y}, oth[4] = {b0.x, b0.y, b1.x, b1.y};
            const float* cp = cs + (size_t)m * 32 + i0; const float* sp = cs + (size_t)M_TOK * 32 + (size_t)m * 32 + i0;
            const float4 c0 = *(const float4*)cp, c1 = *(const float4*)(cp + 4), s0 = *(const float4*)sp, s1 = *(const float4*)(sp + 4);
            const float cc[8] = {c0.x, c0.y, c0.z, c0.w, c1.x, c1.y, c1.z, c1.w}, ss[8] = {s0.x, s0.y, s0.z, s0.w, s1.x, s1.y, s1.z, s1.w};
            const float scale = col < P_AK ? 0.125f : 1.f;
            float r[8];
#pragma unroll
            for (int j = 0; j < 8; ++j) {
                const float me = (j & 1) ? bfhi(mine[j >> 1]) : bflo(mine[j >> 1]);
                const float ot = (j & 1) ? bfhi(oth[j >> 1]) : bflo(oth[j >> 1]);
                r[j] = (second ? (me * cc[j] + ot * ss[j]) : (me * cc[j] - ot * ss[j])) * scale;
            }
            o.x = pk_bf16(r[0], r[1]); o.y = pk_bf16(r[2], r[3]); o.z = pk_bf16(r[4], r[5]); o.w = pk_bf16(r[6], r[7]);
        }
        *(u32x4*)(out + (size_t)m * NP_IN + col) = o;
    }
};
struct EpiOutProj {
    float* y; const float* x;
    __device__ __forceinline__ void operator()(int m, int pn, int c8, const unsigned char* stg_row) const {
        const int col = pn * 256 + c8 * 8;
        const u32x2 a0 = *(const u32x2*)(stg_row + c8 * 16), a1 = *(const u32x2*)(stg_row + c8 * 16 + 8);
        const float4 x0 = *(const float4*)(x + (size_t)m * 1024 + col), x1 = *(const float4*)(x + (size_t)m * 1024 + col + 4);
        *(float4*)(y + (size_t)m * 1024 + col) = make_float4(ALPHA * x0.x + bflo(a0.x), ALPHA * x0.y + bfhi(a0.x), ALPHA * x0.z + bflo(a0.y), ALPHA * x0.w + bfhi(a0.y));
        *(float4*)(y + (size_t)m * 1024 + col + 4) = make_float4(ALPHA * x1.x + bflo(a1.x), ALPHA * x1.y + bfhi(a1.x), ALPHA * x1.z + bflo(a1.y), ALPHA * x1.w + bfhi(a1.y));
    }
};
struct EpiBf16 {
    bf16_t* out; int ldc;
    __device__ __forceinline__ void operator()(int m, int pn, int c8, const unsigned char* stg_row) const {
        const int col = pn * 256 + c8 * 8;
        const u32x2 a0 = *(const u32x2*)(stg_row + c8 * 16), a1 = *(const u32x2*)(stg_row + c8 * 16 + 8);
        u32x4 o; o.x = a0.x; o.y = a0.y; o.z = a1.x; o.w = a1.y;
        *(u32x4*)(out + (size_t)m * ldc + col) = o;
    }
};

template <class EPI>
__device__ __forceinline__ void gemm_phase(const bf16_t* __restrict__ A, const bf16_t* __restrict__ Bt, int M, int N, const EPI& epi, unsigned char* smem) {
    const int tid = threadIdx.x, lane = tid & 63, wave = tid >> 6, r = lane & 31, h = lane >> 5;
    const int wm = wave >> 2, wn = wave & 3;
    const int nM = M / 256, nN = N / 256, ntiles = nM * nN;
    for (int t = blockIdx.x; t < ntiles; t += gridDim.x) {
        const int pm = t / nN, pn = t % nN;
        const bf16_t* Ag = A + (size_t)pm * 256 * GK; const bf16_t* Bg = Bt + (size_t)pn * 256 * GK;
        f32x16 acc[2][4];
#pragma unroll
        for (int j = 0; j < 2; ++j)
#pragma unroll
            for (int i = 0; i < 4; ++i)
#pragma unroll
                for (int e = 0; e < 16; ++e) acc[j][i][e] = 0.f;
        u32x4 sa[4], sb[4];
        const int lrow = tid >> 3, lch = tid & 7;
#pragma unroll
        for (int i = 0; i < 4; ++i) { sa[i] = *(const u32x4*)(Ag + (size_t)(lrow + 64 * i) * GK + lch * 8); sb[i] = *(const u32x4*)(Bg + (size_t)(lrow + 64 * i) * GK + lch * 8); }
        __syncthreads();
#pragma unroll
        for (int i = 0; i < 4; ++i) { *(u32x4*)(smem + swz(lrow + 64 * i, lch)) = sa[i]; *(u32x4*)(smem + G_TILE_BYTES + swz(lrow + 64 * i, lch)) = sb[i]; }
        __syncthreads();
        int cur = 0;
        for (int kt = 0; kt < GK / GBK; ++kt) {
            if (kt + 1 < GK / GBK) {
                const int k0 = (kt + 1) * GBK;
#pragma unroll
                for (int i = 0; i < 4; ++i) { sa[i] = *(const u32x4*)(Ag + (size_t)(lrow + 64 * i) * GK + k0 + lch * 8); sb[i] = *(const u32x4*)(Bg + (size_t)(lrow + 64 * i) * GK + k0 + lch * 8); }
            }
            const unsigned char* la = smem + cur * 2 * G_TILE_BYTES; const unsigned char* lb = la + G_TILE_BYTES;
#pragma unroll
            for (int ks = 0; ks < 4; ++ks) {
                bf16x8 af[4], bf[2];
#pragma unroll
                for (int i = 0; i < 4; ++i) af[i] = *(const bf16x8*)(la + swz(wm * 128 + i * 32 + r, ks * 2 + h));
#pragma unroll
                for (int j = 0; j < 2; ++j) bf[j] = *(const bf16x8*)(lb + swz(wn * 64 + j * 32 + r, ks * 2 + h));
#pragma unroll
                for (int j = 0; j < 2; ++j)
#pragma unroll
                    for (int i = 0; i < 4; ++i) acc[j][i] = __builtin_amdgcn_mfma_f32_32x32x16_bf16(bf[j], af[i], acc[j][i], 0, 0, 0);
            }
            if (kt + 1 < GK / GBK) {
                unsigned char* na = smem + (cur ^ 1) * 2 * G_TILE_BYTES;
#pragma unroll
                for (int i = 0; i < 4; ++i) { *(u32x4*)(na + swz(lrow + 64 * i, lch)) = sa[i]; *(u32x4*)(na + G_TILE_BYTES + swz(lrow + 64 * i, lch)) = sb[i]; }
            }
            __syncthreads();
            cur ^= 1;
        }
#pragma unroll
        for (int j = 0; j < 2; ++j)
#pragma unroll
            for (int i = 0; i < 4; ++i)
#pragma unroll
                for (int g = 0; g < 4; ++g) {
                    u32x2 v; v.x = pk_bf16(acc[j][i][4 * g], acc[j][i][4 * g + 1]); v.y = pk_bf16(acc[j][i][4 * g + 2], acc[j][i][4 * g + 3]);
                    *(u32x2*)(smem + (size_t)(wm * 128 + i * 32 + r) * (STG_STRIDE * 2) + (wn * 64 + j * 32 + 8 * g + 4 * h) * 2) = v;
                }
        __syncthreads();
        const int erow = tid >> 5, ec8 = tid & 31;
#pragma unroll 4
        for (int ps = 0; ps < 16; ++ps) { const int row = ps * 16 + erow; epi(pm * 256 + row, pn, ec8, smem + (size_t)row * (STG_STRIDE * 2)); }
    }
    __syncthreads();
}

__device__ __forceinline__ void phase_attn_simple(const Params& p, unsigned char* smem, int first_block) {
    const int tid = threadIdx.x, sub = tid >> 7, st = tid & 127;
    float* qs = (float*)smem + sub * 256; float* ps = qs + 64; float* red = qs + 192;
    const int nblk = gridDim.x - first_block;
    const bf16_t* pb = p.proj_b;
    for (int base = (blockIdx.x - first_block) * 4; base < M_TOK * 8; base += nblk * 4) {
        const int item = base + sub, m = item >> 3, head = item & 7, kvh = head >> 2, t = m % SEQ;
        __syncthreads();
        if (st < 64) qs[st] = bf2f(pb[(size_t)m * NP_IN + P_AQ + head * 64 + st]);
        __syncthreads();
        const int k = st; const bool valid = (t - k) >= 0;
        float s = -1e30f;
        if (valid) {
            const u32x4* kr = (const u32x4*)(pb + (size_t)(m - k) * NP_IN + P_AK + kvh * 64);
            float a = 0.f;
#pragma unroll
            for (int c = 0; c < 8; ++c) { const u32x4 kk = kr[c]; const float* q8 = qs + c * 8;
                a += q8[0] * bflo(kk.x) + q8[1] * bfhi(kk.x) + q8[2] * bflo(kk.y) + q8[3] * bfhi(kk.y) + q8[4] * bflo(kk.z) + q8[5] * bfhi(kk.z) + q8[6] * bflo(kk.w) + q8[7] * bfhi(kk.w); }
            s = a;
        }
        float mx = wave_max(s);
        if ((st & 63) == 0) red[st >> 6] = mx;
        __syncthreads();
        const float sink = p.sinks[head];
        mx = fmaxf(fmaxf(red[0], red[1]), sink);
        const float pe = valid ? __expf(s - mx) : 0.f;
        float sm = wave_sum(pe);
        if ((st & 63) == 0) red[2 + (st >> 6)] = sm;
        __syncthreads();
        const float denom = red[2] + red[3] + __expf(sink - mx);
        ps[k] = pe / denom;
        __syncthreads();
        if (st < 64) {
            float o = 0.f;
            const int kmax = t < 127 ? t : 127;
            for (int kk = 0; kk <= kmax; ++kk) o = fmaf(ps[kk], bf2f(pb[(size_t)(m - kk) * NP_IN + P_AV + kvh * 64 + st]), o);
            p.xb[(size_t)m * D_MODEL + head * 64 + st] = (bf16_t)(pk_bf16(o, 0.f) & 0xffffu);
        }
    }
    __syncthreads();
}

__device__ __forceinline__ void phase_dn_simple(const Params& p, unsigned char* smem) {
    const int tid = threadIdx.x, lane = tid & 63;
    float* ks = (float*)smem; float* qs = ks + 128; float* red = qs + 128;
    const int b = blockIdx.x >> 2, h = blockIdx.x & 3;
    const bool act = tid < 256;
    const int kind = (tid >> 7) & 1, c = tid & 127;
    const int e = ((tid >> 6) & 3) * 32 + (lane & 31), half = lane >> 5;
    float s[64];
#pragma unroll
    for (int d = 0; d < 64; ++d) s[d] = 0.f;
    float wa[4], wv[4];
#pragma unroll
    for (int j = 0; j < 4; ++j) { wa[j] = p.conv_w[j * 1536 + kind * 512 + h * 128 + c]; wv[j] = p.conv_w[j * 1536 + 1024 + h * 128 + e]; }
    float xa[3] = {0.f, 0.f, 0.f}, xv[3] = {0.f, 0.f, 0.f};
    const float neg_a = -expf(p.a_log[h]), dtb = p.dt_bias[h];
    const bf16_t* pr = p.proj_b + (size_t)b * SEQ * NP_IN;
    const int ca_off = (kind ? P_DK : P_DQ) + h * 128 + c, cv_off = P_DV + h * 128 + e;
    float na = bf2f(pr[ca_off]), nv = bf2f(pr[cv_off]), nb = bf2f(pr[P_B + h]), ng = bf2f(pr[P_A + h]);
    for (int t = 0; t < SEQ; ++t) {
        const float ca = na, cv = nv, cb = nb, cg_ = ng;
        if (t + 1 < SEQ) { const bf16_t* p2 = pr + (size_t)(t + 1) * NP_IN; na = bf2f(p2[ca_off]); nv = bf2f(p2[cv_off]); nb = bf2f(p2[P_B + h]); ng = bf2f(p2[P_A + h]); }
        float a = silu_f(wa[0] * xa[0] + wa[1] * xa[1] + wa[2] * xa[2] + wa[3] * ca);
        const float v = silu_f(wv[0] * xv[0] + wv[1] * xv[1] + wv[2] * xv[2] + wv[3] * cv);
        xa[0] = xa[1]; xa[1] = xa[2]; xa[2] = ca; xv[0] = xv[1]; xv[1] = xv[2]; xv[2] = cv;
        const float ss = wave_sum(a * a);
        if (act && lane == 0) red[tid >> 6] = ss;
        __syncthreads();
        if (act) {
            const float tot = kind ? (red[2] + red[3]) : (red[0] + red[1]);
            a = a * rsqrtf(tot + L2_EPS) * (kind ? 1.f : 0.08838834764831845f);
            if (kind) ks[c] = a; else qs[c] = a;
        }
        __syncthreads();
        if (act) {
            const float beta = 1.f / (1.f + expf(-cb));
            const float xx = cg_ + dtb;
            const float sp = xx > 20.f ? xx : log1pf(expf(xx));
            const float gt = expf(neg_a * sp);
            const float* kh = ks + half * 64; const float* qh = qs + half * 64;
            float kS = 0.f;
#pragma unroll
            for (int d = 0; d < 64; d += 4) { const float4 k4 = *(const float4*)&kh[d]; kS = fmaf(k4.x, s[d], kS); kS = fmaf(k4.y, s[d + 1], kS); kS = fmaf(k4.z, s[d + 2], kS); kS = fmaf(k4.w, s[d + 3], kS); }
            kS += __shfl_xor(kS, 32);
            const float cc = beta * (v - gt * kS);
            float o = 0.f;
#pragma unroll
            for (int d = 0; d < 64; d += 4) {
                const float4 k4 = *(const float4*)&kh[d]; const float4 q4 = *(const float4*)&qh[d];
                s[d] = fmaf(gt, s[d], k4.x * cc); o = fmaf(s[d], q4.x, o);
                s[d + 1] = fmaf(gt, s[d + 1], k4.y * cc); o = fmaf(s[d + 1], q4.y, o);
                s[d + 2] = fmaf(gt, s[d + 2], k4.z * cc); o = fmaf(s[d + 2], q4.z, o);
                s[d + 3] = fmaf(gt, s[d + 3], k4.w * cc); o = fmaf(s[d + 3], q4.w, o);
            }
            o += __shfl_xor(o, 32);
            if (half == 0) p.odn_raw[((size_t)b * SEQ + t) * 512 + h * 128 + e] = o;
        }
    }
    __syncthreads();
}


constexpr int DNP_QS = 0, DNP_KS = 16384, DNP_R = 32768, DNP_AM = 98304, DNP_KDT = 115712, DNP_QK = 133120, DNP_WI = 141824, DNP_SM = 158720;
constexpr int DN_CH_BYTES = 57344;


template <int I> __device__ __forceinline__ void solve_row(float (&X)[64], const float* Am) {
    float a = X[I];
#pragma unroll
    for (int j4 = 0; j4 < (I + 3) / 4; ++j4) {
        const float4 av = *(const float4*)(Am + I * 68 + 4 * j4);
        a = fmaf(-av.x, X[4 * j4], a);
        if (4 * j4 + 1 < I) a = fmaf(-av.y, X[4 * j4 + 1], a);
        if (4 * j4 + 2 < I) a = fmaf(-av.z, X[4 * j4 + 2], a);
        if (4 * j4 + 3 < I) a = fmaf(-av.w, X[4 * j4 + 3], a);
    }
    X[I] = a;
    asm volatile("" ::: "memory");
}
template <int I> struct SolveRows { static __device__ __forceinline__ void run(float (&X)[64], const float* Am) { SolveRows<I - 1>::run(X, Am); solve_row<I>(X, Am); } };
template <> struct SolveRows<0> { static __device__ __forceinline__ void run(float (&)[64], const float*) {} };

__device__ __forceinline__ void phase_dn_prep(const Params& p, unsigned char* smem) {
    const int tid0 = threadIdx.x;
    float* sbeta = (float*)(smem + DNP_SM); float* sgc = sbeta + 64; float* segc = sbeta + 128; float* sekd = sbeta + 192;
    float* Rm = (float*)(smem + DNP_R); float* Am = (float*)(smem + DNP_AM);
    bf16_t* kdt = (bf16_t*)(smem + DNP_KDT); bf16_t* qki = (bf16_t*)(smem + DNP_QK); bf16_t* wim = (bf16_t*)(smem + DNP_WI);
    for (int ci = blockIdx.x; ci < 16 * 128; ci += gridDim.x) {
        int tid = tid0; asm volatile("" : "+v"(tid));
        const int lane = tid & 63, wave = tid >> 6;
        const int bh = ci >> 7, n = ci & 127, b = bh >> 2, h = bh & 3;
        const bf16_t* prow = p.proj_b + (size_t)b * SEQ * NP_IN;
        if (wave == 0) {
            const size_t m = (size_t)(n * 64 + lane);
            const float braw = bf2f(prow[m * NP_IN + P_B + h]), araw = bf2f(prow[m * NP_IN + P_A + h]);
            const float beta = 1.f / (1.f + expf(-braw));
            const float xx = araw + p.dt_bias[h];
            const float sp = xx > 20.f ? xx : log1pf(expf(xx));
            float g = -expf(p.a_log[h]) * sp;
#pragma unroll
            for (int o = 1; o < 64; o <<= 1) { const float up = __shfl_up(g, o); if (lane >= o) g += up; }
            const float g63 = __shfl(g, 63);
            sbeta[lane] = beta; sgc[lane] = g; segc[lane] = expf(g); sekd[lane] = expf(g63 - g);
            if (lane == 63) p.dn_gl[ci] = expf(g63);
        }
        __syncthreads();
        {
            const int i = tid >> 3, sg = tid & 7, c0 = sg * 16;
            const float beta_i = sbeta[i], egc_i = segc[i], ekd_i = sekd[i];
            const int tt0 = n * 64 + i - 3;
#pragma unroll
            for (int mat = 0; mat < 3; ++mat) {
                const int colbase = (mat == 0 ? P_DQ : (mat == 1 ? P_DK : P_DV)) + h * 128 + c0;
                float acc[16];
#pragma unroll
                for (int cc = 0; cc < 16; ++cc) acc[cc] = 0.f;
#pragma unroll
                for (int j = 0; j < 4; ++j) {
                    const int tt = tt0 + j;
                    if (tt >= 0) {
                        const u32x4 x0 = *(const u32x4*)(prow + (size_t)tt * NP_IN + colbase), x1 = *(const u32x4*)(prow + (size_t)tt * NP_IN + colbase + 8);
                        const float* wp = p.conv_w + j * 1536 + mat * 512 + h * 128 + c0;
                        const float4 w0 = *(const float4*)wp, w1 = *(const float4*)(wp + 4), w2 = *(const float4*)(wp + 8), w3 = *(const float4*)(wp + 12);
                        acc[0] = fmaf(w0.x, bflo(x0.x), acc[0]); acc[1] = fmaf(w0.y, bfhi(x0.x), acc[1]); acc[2] = fmaf(w0.z, bflo(x0.y), acc[2]); acc[3] = fmaf(w0.w, bfhi(x0.y), acc[3]);
                        acc[4] = fmaf(w1.x, bflo(x0.z), acc[4]); acc[5] = fmaf(w1.y, bfhi(x0.z), acc[5]); acc[6] = fmaf(w1.z, bflo(x0.w), acc[6]); acc[7] = fmaf(w1.w, bfhi(x0.w), acc[7]);
                        acc[8] = fmaf(w2.x, bflo(x1.x), acc[8]); acc[9] = fmaf(w2.y, bfhi(x1.x), acc[9]); acc[10] = fmaf(w2.z, bflo(x1.y), acc[10]); acc[11] = fmaf(w2.w, bfhi(x1.y), acc[11]);
                        acc[12] = fmaf(w3.x, bflo(x1.z), acc[12]); acc[13] = fmaf(w3.y, bfhi(x1.z), acc[13]); acc[14] = fmaf(w3.z, bflo(x1.w), acc[14]); acc[15] = fmaf(w3.w, bfhi(x1.w), acc[15]);
                    }
                }
                float ss = 0.f;
#pragma unroll
                for (int cc = 0; cc < 16; ++cc) { acc[cc] = silu_f(acc[cc]); ss = fmaf(acc[cc], acc[cc], ss); }
                if (mat < 2) {
                    ss += __shfl_xor(ss, 1); ss += __shfl_xor(ss, 2); ss += __shfl_xor(ss, 4);
                    const float rs = rsqrtf(ss + L2_EPS) * (mat == 0 ? 0.08838834764831845f : 1.f);
#pragma unroll
                    for (int cc = 0; cc < 16; ++cc) acc[cc] *= rs;
                    unsigned char* img = smem + (mat == 0 ? DNP_QS : DNP_KS) + i * 256;
                    u32x4 c0v, c1v;
                    c0v.x = pk_bf16(acc[0], acc[1]); c0v.y = pk_bf16(acc[2], acc[3]); c0v.z = pk_bf16(acc[4], acc[5]); c0v.w = pk_bf16(acc[6], acc[7]);
                    c1v.x = pk_bf16(acc[8], acc[9]); c1v.y = pk_bf16(acc[10], acc[11]); c1v.z = pk_bf16(acc[12], acc[13]); c1v.w = pk_bf16(acc[14], acc[15]);
                    *(u32x4*)(img + (((2 * sg) ^ (i & 15)) << 4)) = c0v;
                    *(u32x4*)(img + (((2 * sg + 1) ^ (i & 15)) << 4)) = c1v;
                }
                if (mat == 0) {
                    u32x4 p0, p1;
                    p0.x = pk_bf16(acc[0] * egc_i, acc[1] * egc_i); p0.y = pk_bf16(acc[2] * egc_i, acc[3] * egc_i); p0.z = pk_bf16(acc[8] * egc_i, acc[9] * egc_i); p0.w = pk_bf16(acc[10] * egc_i, acc[11] * egc_i);
                    p1.x = pk_bf16(acc[4] * egc_i, acc[5] * egc_i); p1.y = pk_bf16(acc[6] * egc_i, acc[7] * egc_i); p1.z = pk_bf16(acc[12] * egc_i, acc[13] * egc_i); p1.w = pk_bf16(acc[14] * egc_i, acc[15] * egc_i);
                    bf16_t* dst = p.dn_qd + ((size_t)(ci * 16 + (i >> 5) * 8 + sg) * 64) * 8;
                    *(u32x4*)(dst + (size_t)(i & 31) * 8) = p0;
                    *(u32x4*)(dst + (size_t)(32 + (i & 31)) * 8) = p1;
                } else if (mat == 1) {
                    const float sc = beta_i * egc_i;
                    float* rr = Rm + i * 256 + 128 + c0;
#pragma unroll
                    for (int q4 = 0; q4 < 4; ++q4) *(float4*)(rr + 4 * q4) = make_float4(acc[4 * q4] * sc, acc[4 * q4 + 1] * sc, acc[4 * q4 + 2] * sc, acc[4 * q4 + 3] * sc);
#pragma unroll
                    for (int cc = 0; cc < 16; ++cc) kdt[(c0 + cc) * 68 + i] = (bf16_t)(pk_bf16(acc[cc] * ekd_i, 0.f) & 0xffffu);
                } else {
                    float* rr = Rm + i * 256 + c0;
#pragma unroll
                    for (int q4 = 0; q4 < 4; ++q4) *(float4*)(rr + 4 * q4) = make_float4(acc[4 * q4] * beta_i, acc[4 * q4 + 1] * beta_i, acc[4 * q4 + 2] * beta_i, acc[4 * q4 + 3] * beta_i);
                }
            }
        }
        __syncthreads();
        {
            const int mat = wave >> 2, ti = (wave >> 1) & 1, tj = wave & 1, r = lane & 31, hh = lane >> 5;
            const unsigned char* ai = smem + (mat ? DNP_QS : DNP_KS) + (ti * 32 + r) * 256;
            const unsigned char* bi = smem + DNP_KS + (tj * 32 + r) * 256;
            f32x16 d;
#pragma unroll
            for (int e = 0; e < 16; ++e) d[e] = 0.f;
#pragma unroll
            for (int ks = 0; ks < 8; ++ks) {
                const bf16x8 af = *(const bf16x8*)(ai + (((2 * ks + hh) ^ (r & 15)) << 4));
                const bf16x8 bf = *(const bf16x8*)(bi + (((2 * ks + hh) ^ (r & 15)) << 4));
                d = __builtin_amdgcn_mfma_f32_32x32x16_bf16(af, bf, d, 0, 0, 0);
            }
            const int j = tj * 32 + r; const float gcj = sgc[j];
#pragma unroll
            for (int e = 0; e < 16; ++e) {
                const int i = ti * 32 + (e & 3) + 8 * (e >> 2) + 4 * hh;
                const float dec = __expf(fminf(sgc[i] - gcj, 0.f));
                if (mat == 0) Am[i * 68 + j] = (j < i) ? sbeta[i] * d[e] * dec : 0.f;
                else qki[i * 68 + j] = (bf16_t)(pk_bf16((j <= i) ? d[e] * dec : 0.f, 0.f) & 0xffffu);
            }
        }
        __syncthreads();
        const int tc = tid;
        if (tc < 256) {
            float X[64];
#pragma unroll
            for (int i = 0; i < 64; ++i) X[i] = Rm[i * 256 + tc];
            SolveRows<63>::run(X, Am);
            if (tc < 128) {
                const int e = tc >> 5, r = tc & 31;
#pragma unroll
                for (int T = 0; T < 2; ++T)
#pragma unroll
                    for (int qd4 = 0; qd4 < 4; ++qd4)
#pragma unroll
                        for (int hh = 0; hh < 2; ++hh) {
                            const int i0 = 32 * T + 8 * qd4 + 4 * hh;
                            *(float4*)(p.dn_u + ((size_t)(((ci * 4 + e) * 2 + T) * 4 + qd4) * 64 + hh * 32 + r) * 4) = make_float4(X[i0], X[i0 + 1], X[i0 + 2], X[i0 + 3]);
                        }
            } else {
                const int dd = tc - 128;
#pragma unroll
                for (int i = 0; i < 64; ++i) wim[i * 132 + dd] = (bf16_t)(pk_bf16(-X[i], 0.f) & 0xffffu);
            }
        } else {
            const int t2 = tc - 256;
#pragma unroll
            for (int q = 0; q < 2; ++q) {
                const int pc = t2 + 256 * q, f = pc >> 6, ln = pc & 63, r = ln & 31, hh = ln >> 5, rt = f >> 2, ks = f & 3;
                const bf16_t* src = qki + (32 * rt + r) * 68 + 16 * ks + 4 * hh;
                const u32x2 lo = *(const u32x2*)src, hi = *(const u32x2*)(src + 8);
                u32x4 o; o.x = lo.x; o.y = lo.y; o.z = hi.x; o.w = hi.y;
                *(u32x4*)(p.dn_qk + ((size_t)(ci * 8 + f) * 64 + ln) * 8) = o;
            }
#pragma unroll
            for (int q = 0; q < 4; ++q) {
                const int pc = t2 + 256 * q, f = pc >> 6, ln = pc & 63, r = ln & 31, hh = ln >> 5, rt = f >> 2, ks = f & 3;
                const bf16_t* src = kdt + (32 * rt + r) * 68 + 16 * ks + 4 * hh;
                const u32x2 lo = *(const u32x2*)src, hi = *(const u32x2*)(src + 8);
                u32x4 o; o.x = lo.x; o.y = lo.y; o.z = hi.x; o.w = hi.y;
                *(u32x4*)(p.dn_kdt + ((size_t)(ci * 16 + f) * 64 + ln) * 8) = o;
            }
        }
        __syncthreads();
#pragma unroll
        for (int q = 0; q < 2; ++q) {
            const int pc = tid + 512 * q, f = pc >> 6, ln = pc & 63, r = ln & 31, hh = ln >> 5, rt = f >> 3, ks = f & 7;
            const bf16_t* src = wim + (32 * rt + r) * 132 + 16 * ks + 4 * hh;
            const u32x2 lo = *(const u32x2*)src, hi = *(const u32x2*)(src + 8);
            u32x4 o; o.x = lo.x; o.y = lo.y; o.z = hi.x; o.w = hi.y;
            *(u32x4*)(p.dn_negw + ((size_t)(ci * 16 + f) * 64 + ln) * 8) = o;
        }
        __syncthreads();
    }
}

__device__ __forceinline__ bf16x8 pack8(const f32x16& x, int s) {
    u32x4 v;
    v.x = pk_bf16(x[8 * s], x[8 * s + 1]); v.y = pk_bf16(x[8 * s + 2], x[8 * s + 3]); v.z = pk_bf16(x[8 * s + 4], x[8 * s + 5]); v.w = pk_bf16(x[8 * s + 6], x[8 * s + 7]);
    return __builtin_bit_cast(bf16x8, v);
}
__device__ __forceinline__ void phase_dn_scan(const Params& p, unsigned char* smem) {
    const int tid = threadIdx.x, lane = tid & 63, wave = tid >> 6, r = lane & 31, hh = lane >> 5;
    const int bh = blockIdx.x, b = bh >> 2, h = bh & 3, ci0 = bh * 128;
    {
#pragma unroll
        for (int q = 0; q < 7; ++q) {
            const int pc = tid + 512 * q;
            const bf16_t* src = pc < 1024 ? p.dn_negw + ((size_t)ci0 * 1024 + pc) * 8 : pc < 2048 ? p.dn_qd + ((size_t)ci0 * 1024 + (pc - 1024)) * 8
                              : pc < 3072 ? p.dn_kdt + ((size_t)ci0 * 1024 + (pc - 2048)) * 8 : p.dn_qk + ((size_t)ci0 * 512 + (pc - 3072)) * 8;
            *(u32x4*)(smem + pc * 16) = *(const u32x4*)src;
        }
    }
    __syncthreads();
    f32x16 S[4], ucur[2];
#pragma unroll
    for (int T = 0; T < 4; ++T)
#pragma unroll
        for (int e = 0; e < 16; ++e) S[T][e] = 0.f;
    if (wave < 4) {
#pragma unroll
        for (int T = 0; T < 2; ++T)
#pragma unroll
            for (int q4 = 0; q4 < 4; ++q4) {
                const float4 v = *(const float4*)(p.dn_u + ((size_t)(((ci0 * 4 + wave) * 2 + T) * 4 + q4) * 64 + lane) * 4);
                ucur[T][4 * q4] = v.x; ucur[T][4 * q4 + 1] = v.y; ucur[T][4 * q4 + 2] = v.z; ucur[T][4 * q4 + 3] = v.w;
            }
    }
    for (int n = 0; n < 128; ++n) {
        const int ci = ci0 + n;
        const unsigned char* buf = smem + (n & 1) * DN_CH_BYTES;
        if (wave >= 4) {
            if (n + 1 < 128) {
                const int t2 = tid - 256; unsigned char* nb = smem + ((n + 1) & 1) * DN_CH_BYTES;
                u32x4 st[14];
#pragma unroll
                for (int q = 0; q < 14; ++q) {
                    const int pc = t2 + 256 * q;
                    const bf16_t* src = pc < 1024 ? p.dn_negw + ((size_t)(ci + 1) * 1024 + pc) * 8 : pc < 2048 ? p.dn_qd + ((size_t)(ci + 1) * 1024 + (pc - 1024)) * 8
                                      : pc < 3072 ? p.dn_kdt + ((size_t)(ci + 1) * 1024 + (pc - 2048)) * 8 : p.dn_qk + ((size_t)(ci + 1) * 512 + (pc - 3072)) * 8;
                    st[q] = *(const u32x4*)src;
                }
#pragma unroll
                for (int q = 0; q < 14; ++q) *(u32x4*)(nb + (t2 + 256 * q) * 16) = st[q];
            }
        } else {
            const int e = wave;
            const float gl = p.dn_gl[ci];
            bf16x8 Sb[8];
#pragma unroll
            for (int T = 0; T < 4; ++T) { Sb[2 * T] = pack8(S[T], 0); Sb[2 * T + 1] = pack8(S[T], 1); }
            f32x16 vn[2];
#pragma unroll
            for (int T = 0; T < 2; ++T) {
                vn[T] = ucur[T];
#pragma unroll
                for (int ks = 0; ks < 8; ++ks) vn[T] = __builtin_amdgcn_mfma_f32_32x32x16_bf16(*(const bf16x8*)(buf + ((T * 8 + ks) * 64 + lane) * 16), Sb[ks], vn[T], 0, 0, 0);
            }
            bf16x8 vb[4];
#pragma unroll
            for (int T = 0; T < 2; ++T) { vb[2 * T] = pack8(vn[T], 0); vb[2 * T + 1] = pack8(vn[T], 1); }
            if (n + 1 < 128) {
#pragma unroll
                for (int T = 0; T < 2; ++T)
#pragma unroll
                    for (int q4 = 0; q4 < 4; ++q4) {
                        const float4 v = *(const float4*)(p.dn_u + ((size_t)((((ci + 1) * 4 + e) * 2 + T) * 4 + q4) * 64 + lane) * 4);
                        ucur[T][4 * q4] = v.x; ucur[T][4 * q4 + 1] = v.y; ucur[T][4 * q4 + 2] = v.z; ucur[T][4 * q4 + 3] = v.w;
                    }
            }
#pragma unroll
            for (int T = 0; T < 2; ++T) {
                f32x16 o;
#pragma unroll
                for (int e2 = 0; e2 < 16; ++e2) o[e2] = 0.f;
#pragma unroll
                for (int ks = 0; ks < 8; ++ks) o = __builtin_amdgcn_mfma_f32_32x32x16_bf16(*(const bf16x8*)(buf + 16384 + ((T * 8 + ks) * 64 + lane) * 16), Sb[ks], o, 0, 0, 0);
#pragma unroll
                for (int ks = 0; ks < 4; ++ks) o = __builtin_amdgcn_mfma_f32_32x32x16_bf16(*(const bf16x8*)(buf + 49152 + ((T * 4 + ks) * 64 + lane) * 16), vb[ks], o, 0, 0, 0);
                float* orow = p.odn_raw + ((size_t)b * SEQ + n * 64 + 32 * T + 4 * hh) * 512 + h * 128 + 32 * e + r;
#pragma unroll
                for (int e2 = 0; e2 < 16; ++e2) orow[(size_t)((e2 & 3) + 8 * (e2 >> 2)) * 512] = o[e2];
            }
#pragma unroll
            for (int T = 0; T < 4; ++T) {
#pragma unroll
                for (int e2 = 0; e2 < 16; ++e2) S[T][e2] *= gl;
#pragma unroll
                for (int ks = 0; ks < 4; ++ks) S[T] = __builtin_amdgcn_mfma_f32_32x32x16_bf16(*(const bf16x8*)(buf + 32768 + ((T * 4 + ks) * 64 + lane) * 16), vb[ks], S[T], 0, 0, 0);
            }
        }
        __syncthreads();
    }
}


constexpr int AT_VT = 32768, AT_VT_STRIDE = 260;
__device__ __forceinline__ void phase_attn(const Params& p, unsigned char* smem, int first_block) {
    const int tid0 = threadIdx.x;
    const int nblk = gridDim.x - first_block;
    const bf16_t* pb = p.proj_b;
    bf16_t* vt = (bf16_t*)(smem + AT_VT);
    for (int item = blockIdx.x - first_block; item < 1024; item += nblk) {
        int tid = tid0; asm volatile("" : "+v"(tid));
        const int lane = tid & 63, wave = tid >> 6, r = lane & 31, hh = lane >> 5;
        const int hp = item & 1, kvh = (item >> 1) & 1, nb = (item >> 2) & 63, b = item >> 8;
        const int m0 = b * SEQ + nb * 128;
        __syncthreads();
#pragma unroll
        for (int i = 0; i < 4; ++i) {
            const int idx = tid + 512 * i, key = idx >> 3, ch = idx & 7;
            const bool valid = (nb > 0) || (key >= 128);
            u32x4 kv = {0u, 0u, 0u, 0u}, vv = {0u, 0u, 0u, 0u};
            if (valid) { const bf16_t* src = pb + (size_t)(m0 - 128 + key) * NP_IN + kvh * 64 + ch * 8; kv = *(const u32x4*)(src + P_AK); vv = *(const u32x4*)(src + P_AV); }
            *(u32x4*)(smem + swz(key, ch)) = kv;
            bf16_t* vd = vt + (ch * 8) * AT_VT_STRIDE + key;
            vd[0] = (bf16_t)(vv.x & 0xffffu); vd[AT_VT_STRIDE] = (bf16_t)(vv.x >> 16); vd[2 * AT_VT_STRIDE] = (bf16_t)(vv.y & 0xffffu); vd[3 * AT_VT_STRIDE] = (bf16_t)(vv.y >> 16);
            vd[4 * AT_VT_STRIDE] = (bf16_t)(vv.z & 0xffffu); vd[5 * AT_VT_STRIDE] = (bf16_t)(vv.z >> 16); vd[6 * AT_VT_STRIDE] = (bf16_t)(vv.w & 0xffffu); vd[7 * AT_VT_STRIDE] = (bf16_t)(vv.w >> 16);
        }
        __syncthreads();
        const int head = kvh * 4 + hp * 2 + (wave >> 2), qt = wave & 3, qo = qt * 32;
        const bf16_t* qrow = pb + (size_t)(m0 + qo + r) * NP_IN + P_AQ + head * 64 + 8 * hh;
        bf16x8 qf[4];
#pragma unroll
        for (int ks = 0; ks < 4; ++ks) qf[ks] = *(const bf16x8*)(qrow + 16 * ks);
        f32x16 sc[5];
#pragma unroll
        for (int t = 0; t < 5; ++t) {
#pragma unroll
            for (int e = 0; e < 16; ++e) sc[t][e] = 0.f;
#pragma unroll
            for (int ks = 0; ks < 4; ++ks) sc[t] = __builtin_amdgcn_mfma_f32_32x32x16_bf16(*(const bf16x8*)(smem + swz((qt + t) * 32 + r, 2 * ks + hh)), qf[ks], sc[t], 0, 0, 0);
        }
        const float sink = p.sinks[head];
        float mx = -1e30f;
#pragma unroll
        for (int t = 0; t < 5; ++t)
#pragma unroll
            for (int e = 0; e < 16; ++e) {
                const int kf = 32 * (qt + t) + (e & 3) + 8 * (e >> 2) + 4 * hh;
                const bool ok = (kf >= qo + r + 1) && (kf <= qo + r + 128) && ((nb > 0) || (kf >= 128));
                sc[t][e] = ok ? sc[t][e] : -1e30f;
                mx = fmaxf(mx, sc[t][e]);
            }
        mx = fmaxf(mx, __shfl_xor(mx, 32));
        mx = fmaxf(mx, sink);
        float sum = 0.f;
#pragma unroll
        for (int t = 0; t < 5; ++t)
#pragma unroll
            for (int e = 0; e < 16; ++e) { const float pe = (sc[t][e] > -1e29f) ? __expf(sc[t][e] - mx) : 0.f; sc[t][e] = pe; sum += pe; }
        sum += __shfl_xor(sum, 32);
        const float inv = 1.f / (sum + __expf(sink - mx));
        f32x16 o[2];
#pragma unroll
        for (int dt = 0; dt < 2; ++dt)
#pragma unroll
            for (int e = 0; e < 16; ++e) o[dt][e] = 0.f;
#pragma unroll
        for (int t = 0; t < 5; ++t)
#pragma unroll
            for (int s2 = 0; s2 < 2; ++s2) {
                const bf16x8 pbv = pack8(sc[t], s2);
                const int kb = 32 * (qt + t) + 16 * s2 + 4 * hh;
#pragma unroll
                for (int dt = 0; dt < 2; ++dt) {
                    const bf16_t* vr = vt + (dt * 32 + r) * AT_VT_STRIDE + kb;
                    const u32x2 lo = *(const u32x2*)vr, hi = *(const u32x2*)(vr + 8);
                    u32x4 av; av.x = lo.x; av.y = lo.y; av.z = hi.x; av.w = hi.y;
                    o[dt] = __builtin_amdgcn_mfma_f32_32x32x16_bf16(__builtin_bit_cast(bf16x8, av), pbv, o[dt], 0, 0, 0);
                }
            }
        bf16_t* orow = p.xb + (size_t)(m0 + qo + r) * D_MODEL + head * 64 + 4 * hh;
#pragma unroll
        for (int dt = 0; dt < 2; ++dt)
#pragma unroll
            for (int q4 = 0; q4 < 4; ++q4) {
                u32x2 v; v.x = pk_bf16(o[dt][4 * q4] * inv, o[dt][4 * q4 + 1] * inv); v.y = pk_bf16(o[dt][4 * q4 + 2] * inv, o[dt][4 * q4 + 3] * inv);
                *(u32x2*)(orow + dt * 32 + 8 * q4) = v;
            }
    }
    __syncthreads();
}

__device__ __forceinline__ void phase_dn_norm(const Params& p) {
    const int lane = threadIdx.x & 63, gw = blockIdx.x * (NTHREADS / 64) + (threadIdx.x >> 6), GW = gridDim.x * (NTHREADS / 64);
    for (int it = gw; it < M_TOK * 4; it += GW) {
        const int m = it >> 2, h = it & 3;
        const float2 o = *(const float2*)(p.odn_raw + (size_t)m * 512 + h * 128 + lane * 2);
        const float ss = wave_sum(o.x * o.x + o.y * o.y);
        const float rr = rsqrtf(ss * (1.f / 128.f) + RMS_EPS);
        const unsigned z = *(const unsigned*)(p.proj_b + (size_t)m * NP_IN + P_Z + h * 128 + lane * 2);
        const float2 g = *(const float2*)(p.dn_norm_g + lane * 2);
        *(unsigned*)(p.xb + (size_t)m * D_MODEL + 512 + h * 128 + lane * 2) = pk_bf16(o.x * rr * g.x * silu_f(bflo(z)), o.y * rr * g.y * silu_f(bfhi(z)));
    }
}

__device__ __forceinline__ void phase_ln1(const Params& p, bf16_t* x1b) {
    const int lane = threadIdx.x & 63, gw = blockIdx.x * (NTHREADS / 64) + (threadIdx.x >> 6), GW = gridDim.x * (NTHREADS / 64);
    for (int m = gw; m < M_TOK; m += GW) {
        float* row = p.out + (size_t)m * D_MODEL;
        float4 v[4]; float s = 0.f;
#pragma unroll
        for (int j = 0; j < 4; ++j) { v[j] = *(const float4*)(row + j * 256 + lane * 4); s += (v[j].x + v[j].y) + (v[j].z + v[j].w); }
        const float mean = wave_sum(s) * (1.f / D_MODEL); float q = 0.f;
#pragma unroll
        for (int j = 0; j < 4; ++j) { v[j].x -= mean; v[j].y -= mean; v[j].z -= mean; v[j].w -= mean; q += (v[j].x * v[j].x + v[j].y * v[j].y) + (v[j].z * v[j].z + v[j].w * v[j].w); }
        const float rstd = rsqrtf(wave_sum(q) * (1.f / D_MODEL) + LN_EPS);
#pragma unroll
        for (int j = 0; j < 4; ++j) {
            const float4 g = *(const float4*)(p.ln1_g + j * 256 + lane * 4), bb = *(const float4*)(p.ln1_b + j * 256 + lane * 4);
            const float4 o = make_float4(v[j].x * rstd * g.x + bb.x, v[j].y * rstd * g.y + bb.y, v[j].z * rstd * g.z + bb.z, v[j].w * rstd * g.w + bb.w);
            *(float4*)(row + j * 256 + lane * 4) = o;
            u32x2 ob; ob.x = pk_bf16(o.x, o.y); ob.y = pk_bf16(o.z, o.w);
            *(u32x2*)(x1b + (size_t)m * D_MODEL + j * 256 + lane * 4) = ob;
        }
    }
}

__device__ __forceinline__ void wave_argmax(float& v, int& i) {
#pragma unroll
    for (int o = 1; o < 64; o <<= 1) {
        const float ov = __shfl_xor(v, o); const int oi = __shfl_xor(i, o);
        if (ov > v || (ov == v && oi < i)) { v = ov; i = oi; }
    }
}
__device__ __forceinline__ void phase_route_simple(const Params& p, const bf16_t* qb, unsigned char* smem) {
    const int tid = threadIdx.x, sub = tid >> 8, st = tid & 255, lane = tid & 63, w = st >> 6;
    float* base_s = (float*)smem + sub * 4608;
    float* qs = base_s;
    float* sc = qs + 2048;
    float* tv = sc + 2048;
    int* ti = (int*)(tv + 256);
    for (int mb = blockIdx.x * 2; mb < M_TOK; mb += gridDim.x * 2) {
        const int m = mb + sub;
        __syncthreads();
        for (int i = st; i < 2048; i += 256) qs[i] = bf2f(qb[(size_t)m * 2048 + i]);
        __syncthreads();
        for (int e = st; e < 2048; e += 256) {
            const int grp = e >> 7, key = e & 127;
            const float* kr = p.sub_keys + ((size_t)grp * 128 + key) * 128;
            const float* qq = qs + grp * 128;
            float a = 0.f;
#pragma unroll 8
            for (int d = 0; d < 128; d += 4) { const float4 k4 = *(const float4*)(kr + d); a = fmaf(qq[d], k4.x, a); a = fmaf(qq[d + 1], k4.y, a); a = fmaf(qq[d + 2], k4.z, a); a = fmaf(qq[d + 3], k4.w, a); }
            sc[grp * 128 + key] = a;
        }
        __syncthreads();
        for (int grp = w; grp < 16; grp += 4) {
            float v0 = sc[grp * 128 + lane], v1 = sc[grp * 128 + lane + 64];
            for (int rr = 0; rr < 16; ++rr) {
                float bv; int bi;
                if (v0 >= v1) { bv = v0; bi = lane; } else { bv = v1; bi = lane + 64; }
                wave_argmax(bv, bi);
                if (lane == 0) { tv[grp * 16 + rr] = bv; ti[grp * 16 + rr] = bi; }
                if (bi == lane) v0 = -INFINITY; else if (bi == lane + 64) v1 = -INFINITY;
            }
        }
        __syncthreads();
        for (int hh = w; hh < 8; hh += 4) {
            float cv[4]; int ci[4];
#pragma unroll
            for (int j = 0; j < 4; ++j) { const int c = lane + 64 * j, i0 = c >> 4, i1 = c & 15; cv[j] = tv[(hh * 2) * 16 + i0] + tv[(hh * 2 + 1) * 16 + i1]; ci[j] = ti[(hh * 2) * 16 + i0] * 128 + ti[(hh * 2 + 1) * 16 + i1]; }
            float bestv = 0.f; int beste = 0; float mx = 0.f;
            for (int rr = 0; rr < 16; ++rr) {
                float bv = cv[0]; int bj = 0;
#pragma unroll
                for (int j = 1; j < 4; ++j) if (cv[j] > bv) { bv = cv[j]; bj = j; }
                int bi = lane + 64 * bj;
                wave_argmax(bv, bi);
                const int src = bi & 63, sj = bi >> 6;
                int e = 0;
#pragma unroll
                for (int j = 0; j < 4; ++j) if (sj == j) e = ci[j];
                e = __shfl(e, src);
                if (lane == src) {
#pragma unroll
                    for (int j = 0; j < 4; ++j) if (sj == j) cv[j] = -INFINITY;
                }
                if (rr == 0) mx = bv;
                if (lane == rr) { bestv = bv; beste = e; }
            }
            const float ex = lane < 16 ? expf(bestv - mx) : 0.f;
            const float den = wave_sum(ex);
            if (lane < 16) { p.ids[(size_t)m * 128 + hh * 16 + lane] = beste; p.gates[(size_t)m * 128 + hh * 16 + lane] = ex / den; }
        }
    }
    __syncthreads();
}

__device__ __forceinline__ void phase_peer_simple(const Params& p) {
    const int lane = threadIdx.x & 63, gw = blockIdx.x * (NTHREADS / 64) + (threadIdx.x >> 6), GW = gridDim.x * (NTHREADS / 64);
    for (int m = gw; m < M_TOK; m += GW) {
        float* row = p.out + (size_t)m * D_MODEL;
        float4 xr[4], acc[4];
#pragma unroll
        for (int j = 0; j < 4; ++j) { xr[j] = *(const float4*)(row + j * 256 + lane * 4); acc[j] = make_float4(0.f, 0.f, 0.f, 0.f); }
        const int e0 = p.ids[(size_t)m * 128 + lane], e1 = p.ids[(size_t)m * 128 + 64 + lane];
        const float g0 = p.gates[(size_t)m * 128 + lane], g1 = p.gates[(size_t)m * 128 + 64 + lane];
        for (int k = 0; k < 128; ++k) {
            const int e = __shfl(k < 64 ? e0 : e1, k & 63); const float gt = __shfl(k < 64 ? g0 : g1, k & 63);
            const float* ur = p.peer_u + (size_t)e * D_MODEL; const float* vr = p.peer_v + (size_t)e * D_MODEL;
            float d = 0.f; float4 vv[4];
#pragma unroll
            for (int j = 0; j < 4; ++j) { const float4 u4 = *(const float4*)(ur + j * 256 + lane * 4); vv[j] = *(const float4*)(vr + j * 256 + lane * 4);
                d += xr[j].x * u4.x + xr[j].y * u4.y + xr[j].z * u4.z + xr[j].w * u4.w; }
            d = wave_sum(d);
            const float wgt = 0.5f * d * (1.f + erff(d * 0.7071067811865476f)) * gt;
#pragma unroll
            for (int j = 0; j < 4; ++j) { acc[j].x = fmaf(wgt, vv[j].x, acc[j].x); acc[j].y = fmaf(wgt, vv[j].y, acc[j].y); acc[j].z = fmaf(wgt, vv[j].z, acc[j].z); acc[j].w = fmaf(wgt, vv[j].w, acc[j].w); }
        }
        float s = 0.f;
#pragma unroll
        for (int j = 0; j < 4; ++j) { acc[j].x += ALPHA * xr[j].x; acc[j].y += ALPHA * xr[j].y; acc[j].z += ALPHA * xr[j].z; acc[j].w += ALPHA * xr[j].w; s += (acc[j].x + acc[j].y) + (acc[j].z + acc[j].w); }
        const float mean = wave_sum(s) * (1.f / D_MODEL); float q = 0.f;
#pragma unroll
        for (int j = 0; j < 4; ++j) { acc[j].x -= mean; acc[j].y -= mean; acc[j].z -= mean; acc[j].w -= mean; q += (acc[j].x * acc[j].x + acc[j].y * acc[j].y) + (acc[j].z * acc[j].z + acc[j].w * acc[j].w); }
        const float rstd = rsqrtf(wave_sum(q) * (1.f / D_MODEL) + LN_EPS);
#pragma unroll
        for (int j = 0; j < 4; ++j) {
            const float4 g = *(const float4*)(p.ln2_g + j * 256 + lane * 4), bb = *(const float4*)(p.ln2_b + j * 256 + lane * 4);
            *(float4*)(row + j * 256 + lane * 4) = make_float4(acc[j].x * rstd * g.x + bb.x, acc[j].y * rstd * g.y + bb.y, acc[j].z * rstd * g.z + bb.z, acc[j].w * rstd * g.w + bb.w);
        }
    }
}


typedef __bf16 bf16x2_v __attribute__((ext_vector_type(2)));
__device__ __forceinline__ float dot2bf(unsigned a, unsigned b, float c) { return __builtin_amdgcn_fdot2_f32_bf16(__builtin_bit_cast(bf16x2_v, a), __builtin_bit_cast(bf16x2_v, b), c, false); }
__device__ __forceinline__ void phase_tables(const Params& p) {
    const size_t gt = (size_t)blockIdx.x * NTHREADS + threadIdx.x, GT = (size_t)gridDim.x * NTHREADS;
    for (size_t i = gt; i < (size_t)2 * 16384 * 1024 / 8; i += GT) {
        const size_t half = (size_t)16384 * 1024 / 8;
        const float* src = (i < half) ? p.peer_u + i * 8 : p.peer_v + (i - half) * 8;
        const float4 a = *(const float4*)src, b = *(const float4*)(src + 4);
        u32x4 o; o.x = pk_bf16(a.x, a.y); o.y = pk_bf16(a.z, a.w); o.z = pk_bf16(b.x, b.y); o.w = pk_bf16(b.z, b.w);
        *(u32x4*)(p.tab_u + i * 8) = o;
    }
}
__device__ __forceinline__ void phase_peer(const Params& p, const bf16_t* x1b) {
    const int lane = threadIdx.x & 63, gw = blockIdx.x * (NTHREADS / 64) + (threadIdx.x >> 6), GW = gridDim.x * (NTHREADS / 64);
    const bf16_t* tab_v = p.tab_u + (size_t)16384 * 1024;
    for (int m = gw; m < M_TOK; m += GW) {
        const u32x4 xa = *(const u32x4*)(x1b + (size_t)m * 1024 + lane * 8), xb = *(const u32x4*)(x1b + (size_t)m * 1024 + 512 + lane * 8);
        const int id0 = p.ids[(size_t)m * 128 + lane], id1 = p.ids[(size_t)m * 128 + 64 + lane];
        const float g0 = p.gates[(size_t)m * 128 + lane], g1 = p.gates[(size_t)m * 128 + 64 + lane];
        float h0 = 0.f, h1 = 0.f;
#pragma unroll 1
        for (int g = 0; g < 16; ++g) {
            u32x4 ua[8], ub[8];
            const int idr = g < 8 ? id0 : id1;
#pragma unroll
            for (int kk = 0; kk < 8; ++kk) {
                const int e = __builtin_amdgcn_readlane(idr, (g * 8 + kk) & 63);
                const bf16_t* row = p.tab_u + (size_t)e * 1024;
                ua[kk] = *(const u32x4*)(row + lane * 8); ub[kk] = *(const u32x4*)(row + 512 + lane * 8);
            }
#pragma unroll
            for (int kk = 0; kk < 8; ++kk) {
                float d = dot2bf(ua[kk].x, xa.x, 0.f); d = dot2bf(ua[kk].y, xa.y, d); d = dot2bf(ua[kk].z, xa.z, d); d = dot2bf(ua[kk].w, xa.w, d);
                d = dot2bf(ub[kk].x, xb.x, d); d = dot2bf(ub[kk].y, xb.y, d); d = dot2bf(ub[kk].z, xb.z, d); d = dot2bf(ub[kk].w, xb.w, d);
                d = wave_sum(d);
                const int k = g * 8 + kk;
                if (lane == (k & 63)) { if (g < 8) h0 = d; else h1 = d; }
            }
        }
        const float w0 = 0.5f * h0 * (1.f + erff(h0 * 0.7071067811865476f)) * g0, w1 = 0.5f * h1 * (1.f + erff(h1 * 0.7071067811865476f)) * g1;
        float acc[16];
#pragma unroll
        for (int c = 0; c < 16; ++c) acc[c] = 0.f;
#pragma unroll 1
        for (int g = 0; g < 16; ++g) {
            u32x4 va[8], vb[8];
            const int idr = g < 8 ? id0 : id1; const float wr = g < 8 ? w0 : w1;
#pragma unroll
            for (int kk = 0; kk < 8; ++kk) {
                const int e = __builtin_amdgcn_readlane(idr, (g * 8 + kk) & 63);
                const bf16_t* row = tab_v + (size_t)e * 1024;
                va[kk] = *(const u32x4*)(row + lane * 8); vb[kk] = *(const u32x4*)(row + 512 + lane * 8);
            }
#pragma unroll
            for (int kk = 0; kk < 8; ++kk) {
                const float wk = __uint_as_float(__builtin_amdgcn_readlane(__float_as_uint(wr), (g * 8 + kk) & 63));
                acc[0] = fmaf(wk, bflo(va[kk].x), acc[0]); acc[1] = fmaf(wk, bfhi(va[kk].x), acc[1]); acc[2] = fmaf(wk, bflo(va[kk].y), acc[2]); acc[3] = fmaf(wk, bfhi(va[kk].y), acc[3]);
                acc[4] = fmaf(wk, bflo(va[kk].z), acc[4]); acc[5] = fmaf(wk, bfhi(va[kk].z), acc[5]); acc[6] = fmaf(wk, bflo(va[kk].w), acc[6]); acc[7] = fmaf(wk, bfhi(va[kk].w), acc[7]);
                acc[8] = fmaf(wk, bflo(vb[kk].x), acc[8]); acc[9] = fmaf(wk, bfhi(vb[kk].x), acc[9]); acc[10] = fmaf(wk, bflo(vb[kk].y), acc[10]); acc[11] = fmaf(wk, bfhi(vb[kk].y), acc[11]);
                acc[12] = fmaf(wk, bflo(vb[kk].z), acc[12]); acc[13] = fmaf(wk, bfhi(vb[kk].z), acc[13]); acc[14] = fmaf(wk, bflo(vb[kk].w), acc[14]); acc[15] = fmaf(wk, bfhi(vb[kk].w), acc[15]);
            }
        }
        float* row = p.out + (size_t)m * D_MODEL;
        float s = 0.f;
#pragma unroll
        for (int j = 0; j < 2; ++j)
#pragma unroll
            for (int q = 0; q < 2; ++q) {
                const float4 xv = *(const float4*)(row + 512 * j + lane * 8 + 4 * q);
                float* a = acc + 8 * j + 4 * q;
                a[0] += ALPHA * xv.x; a[1] += ALPHA * xv.y; a[2] += ALPHA * xv.z; a[3] += ALPHA * xv.w;
                s += (a[0] + a[1]) + (a[2] + a[3]);
            }
        const float mean = wave_sum(s) * (1.f / D_MODEL); float q2 = 0.f;
#pragma unroll
        for (int c = 0; c < 16; ++c) { acc[c] -= mean; q2 = fmaf(acc[c], acc[c], q2); }
        const float rstd = rsqrtf(wave_sum(q2) * (1.f / D_MODEL) + LN_EPS);
#pragma unroll
        for (int j = 0; j < 2; ++j)
#pragma unroll
            for (int q = 0; q < 2; ++q) {
                const int c0 = 512 * j + lane * 8 + 4 * q;
                const float4 gg = *(const float4*)(p.ln2_g + c0), bb = *(const float4*)(p.ln2_b + c0);
                const float* a = acc + 8 * j + 4 * q;
                *(float4*)(row + c0) = make_float4(a[0] * rstd * gg.x + bb.x, a[1] * rstd * gg.y + bb.y, a[2] * rstd * gg.z + bb.z, a[3] * rstd * gg.w + bb.w);
            }
    }
}


__device__ __forceinline__ void cas_d(float& a, float& b) { const float hi = fmaxf(a, b), lo = fminf(a, b); a = hi; b = lo; }
__device__ __forceinline__ void cas_a(float& a, float& b) { const float hi = fmaxf(a, b), lo = fminf(a, b); a = lo; b = hi; }
__device__ __forceinline__ void sort16_desc(f32x16& v) {
#pragma unroll
    for (int k = 2; k <= 16; k <<= 1)
#pragma unroll
        for (int j = k >> 1; j > 0; j >>= 1)
#pragma unroll
            for (int i = 0; i < 16; ++i) {
                const int l = i ^ j;
                if (l > i) { float a = v[i], b = v[l]; if ((i & k) == 0) cas_d(a, b); else cas_a(a, b); v[i] = a; v[l] = b; }
            }
}
__device__ __forceinline__ void bmerge16_desc(f32x16& v) {
#pragma unroll
    for (int j = 8; j > 0; j >>= 1)
#pragma unroll
        for (int i = 0; i < 16; ++i) { const int l = i ^ j; if (l > i) { float a = v[i], b = v[l]; cas_d(a, b); v[i] = a; v[l] = b; } }
}
__device__ __forceinline__ f32x16 merge_top16(const f32x16& a, const f32x16& b) {
    f32x16 c;
#pragma unroll
    for (int i = 0; i < 16; ++i) c[i] = fmaxf(a[i], b[15 - i]);
    bmerge16_desc(c);
    return c;
}
__device__ __forceinline__ void pcas_d(float& va, int& ia, float& vb, int& ib) {
    const bool sw = vb > va; const float tv = sw ? vb : va; const int ti = sw ? ib : ia;
    vb = sw ? va : vb; ib = sw ? ia : ib; va = tv; ia = ti;
}
__device__ __forceinline__ void psort16_desc(float (&v)[16], int (&id)[16]) {
#pragma unroll
    for (int k = 2; k <= 16; k <<= 1)
#pragma unroll
        for (int j = k >> 1; j > 0; j >>= 1)
#pragma unroll
            for (int i = 0; i < 16; ++i) {
                const int l = i ^ j;
                if (l > i) { if ((i & k) == 0) pcas_d(v[i], id[i], v[l], id[l]); else pcas_d(v[l], id[l], v[i], id[i]); }
            }
}
__device__ __forceinline__ void pmerge_top16(float (&a)[16], int (&ia)[16], const float (&b)[16], const int (&ib)[16]) {
#pragma unroll
    for (int i = 0; i < 16; ++i) { const bool sw = b[15 - i] > a[i]; a[i] = sw ? b[15 - i] : a[i]; ia[i] = sw ? ib[15 - i] : ia[i]; }
#pragma unroll
    for (int j = 8; j > 0; j >>= 1)
#pragma unroll
        for (int i = 0; i < 16; ++i) { const int l = i ^ j; if (l > i) pcas_d(a[i], ia[i], a[l], ia[l]); }
}
__device__ __forceinline__ void phase_route(const Params& p, const bf16_t* qb) {
    constexpr int CI[50] = {0,0,0,0,0,0,0,0,0,0,0,0,0,0,0,0,1,1,1,1,1,1,1,1,2,2,2,2,2,3,3,3,3,4,4,4,5,5,6,6,7,7,8,9,10,11,12,13,14,15};
    constexpr int CJ[50] = {0,1,2,3,4,5,6,7,8,9,10,11,12,13,14,15,0,1,2,3,4,5,6,7,0,1,2,3,4,0,1,2,3,0,1,2,0,1,0,1,0,1,0,0,0,0,0,0,0,0};
    const int lane0 = threadIdx.x & 63, gw = blockIdx.x * (NTHREADS / 64) + (threadIdx.x >> 6), GW = gridDim.x * (NTHREADS / 64);
    for (int task = gw; task < (M_TOK / 32) * 8; task += GW) {
        int lane = lane0; asm volatile("" : "+v"(lane));
        const int r = lane & 31, hh = lane >> 5;
        const int h = task & 7, tok0 = (task >> 3) * 32;
        f32x16 top[2];
#pragma unroll
        for (int pp = 0; pp < 2; ++pp) {
            const bf16_t* qrow = qb + (size_t)(tok0 + r) * 2048 + h * 256 + pp * 128 + 8 * hh;
            bf16x8 qf[8];
#pragma unroll
            for (int ks = 0; ks < 8; ++ks) qf[ks] = *(const bf16x8*)(qrow + 16 * ks);
            f32x16 sc[4];
#pragma unroll
            for (int kt = 0; kt < 4; ++kt) {
                const bf16_t* af = p.sk_frag + ((size_t)(((h * 2 + pp) * 4 + kt) * 8) * 64 + lane) * 8;
                bf16x8 a[8];
#pragma unroll
                for (int ks = 0; ks < 8; ++ks) a[ks] = *(const bf16x8*)(af + (size_t)ks * 512);
#pragma unroll
                for (int e = 0; e < 16; ++e) sc[kt][e] = 0.f;
#pragma unroll
                for (int ks = 0; ks < 8; ++ks) sc[kt] = __builtin_amdgcn_mfma_f32_32x32x16_bf16(a[ks], qf[ks], sc[kt], 0, 0, 0);
            }
#pragma unroll
            for (int kt = 0; kt < 4; ++kt) {
#pragma unroll
                for (int e = 0; e < 16; ++e) {
                    const unsigned key = (unsigned)(32 * kt + (e & 3) + 8 * (e >> 2)) + 4u * (unsigned)hh;
                    sc[kt][e] = __uint_as_float((__float_as_uint(sc[kt][e]) & 0xffffff80u) | key);
                }
                sort16_desc(sc[kt]);
            }
            f32x16 m = merge_top16(merge_top16(sc[0], sc[1]), merge_top16(sc[2], sc[3]));
            f32x16 oth;
#pragma unroll
            for (int i = 0; i < 16; ++i) oth[i] = __shfl_xor(m[i], 32);
            top[pp] = merge_top16(m, oth);
        }
        int ia[16], ib[16];
#pragma unroll
        for (int i = 0; i < 16; ++i) { ia[i] = (int)(__float_as_uint(top[0][i]) & 127u); ib[i] = (int)(__float_as_uint(top[1][i]) & 127u); }
        float cv0[16], cv1[16]; int cd0[16], cd1[16];
#pragma unroll
        for (int c = 0; c < 32; ++c) {
            float v = -INFINITY; int id = 0;
            if (c < 25) {
                const float v0 = top[0][CI[2 * c]] + top[1][CJ[2 * c]], v1 = top[0][CI[2 * c + 1]] + top[1][CJ[2 * c + 1]];
                const int d0 = (ia[CI[2 * c]] << 7) | ib[CJ[2 * c]], d1 = (ia[CI[2 * c + 1]] << 7) | ib[CJ[2 * c + 1]];
                v = hh ? v1 : v0; id = hh ? d1 : d0;
            }
            if (c < 16) { cv0[c] = v; cd0[c] = id; } else { cv1[c - 16] = v; cd1[c - 16] = id; }
        }
        psort16_desc(cv0, cd0); psort16_desc(cv1, cd1);
        pmerge_top16(cv0, cd0, cv1, cd1);
        float ov[16]; int od[16];
#pragma unroll
        for (int i = 0; i < 16; ++i) { ov[i] = __shfl_xor(cv0[i], 32); od[i] = __shfl_xor(cd0[i], 32); }
        pmerge_top16(cv0, cd0, ov, od);
        float ex[16], den = 0.f;
#pragma unroll
        for (int i = 0; i < 16; ++i) { ex[i] = __expf(cv0[i] - cv0[0]); den += ex[i]; }
        const float inv = 1.f / den;
        if (hh == 0) {
            int* idp = p.ids + (size_t)(tok0 + r) * 128 + h * 16; float* gp = p.gates + (size_t)(tok0 + r) * 128 + h * 16;
#pragma unroll
            for (int q = 0; q < 4; ++q) {
                *(int4*)(idp + 4 * q) = make_int4(cd0[4 * q], cd0[4 * q + 1], cd0[4 * q + 2], cd0[4 * q + 3]);
                *(float4*)(gp + 4 * q) = make_float4(ex[4 * q] * inv, ex[4 * q + 1] * inv, ex[4 * q + 2] * inv, ex[4 * q + 3] * inv);
            }
        }
    }
}

constexpr int N_PHASES = 10;
__global__ void __launch_bounds__(NTHREADS) mega_fwd(Params p) {
    __shared__ __attribute__((aligned(16))) unsigned char smem[SMEM_BYTES];
    __shared__ uint4 xb_words;
    if (threadIdx.x == 0) xb_words = make_uint4(0u, 0u, 0u, 0u);
    __syncthreads();
    XcdBarrier bar; bar.bar = p.bar; bar.x = 0; bar.st = (volatile LAS unsigned*)&xb_words;
    if (p.ph_hi - p.ph_lo > 1) bar = xcd_barrier_post(p.bar, (volatile LAS unsigned*)&xb_words);
    bf16_t* qb = p.proj_b;
    bf16_t* x1b = p.proj_b + (size_t)M_TOK * 2048;
#define PH(k) (p.ph_lo <= (k) && (k) < p.ph_hi)
#define SYNC(k) do { if (PH(k) && PH((k) + 1)) xcd_barrier(bar); } while (0)
    if (PH(0)) phase_prep(p, smem);
    SYNC(0);
    if (PH(1)) { EpiInProj e{p.proj_b, p.rope_cs}; gemm_phase(p.xb, p.wt_in, M_TOK, NP_IN, e, smem); }
    SYNC(1);
    if (PH(2)) phase_dn_prep(p, smem);
    SYNC(2);
    if (PH(3)) { if (blockIdx.x < 16) phase_dn_scan(p, smem); else phase_attn(p, smem, 16); }
    SYNC(3);
    if (PH(4)) { phase_dn_norm(p); phase_tables(p); }
    SYNC(4);
    if (PH(5)) { EpiOutProj e{p.out, p.x}; gemm_phase(p.xb, p.wt_out, M_TOK, 1024, e, smem); }
    SYNC(5);
    if (PH(6)) phase_ln1(p, x1b);
    SYNC(6);
    if (PH(7)) { EpiBf16 e{qb, 2048}; gemm_phase(x1b, p.wt_q, M_TOK, 2048, e, smem); }
    SYNC(7);
    if (PH(8)) phase_route(p, qb);
    SYNC(8);
    if (PH(9)) phase_peer(p, x1b);
#undef PH
#undef SYNC
}
}

#ifndef MK_LAUNCHES
#define MK_LAUNCHES 1
#endif

extern "C" void kernel_launch(void* const* d_in, const int* in_sizes, int n_in, void* d_out, int out_size, void* d_ws, size_t ws_size, hipStream_t stream) {
    static int grid_blocks = 0;
    if (!grid_blocks) {
        int dev = 0, cus = 0, per_cu = 0;
        (void)hipGetDevice(&dev);
        (void)hipDeviceGetAttribute(&cus, hipDeviceAttributeMultiprocessorCount, dev);
        (void)hipOccupancyMaxActiveBlocksPerMultiprocessor(&per_cu, mega_fwd, NTHREADS, 0);
        if (per_cu < 1) { fprintf(stderr, "kernel_launch: occupancy query reports %d blocks per CU\n", per_cu); per_cu = 1; }
        grid_blocks = cus * 1;
        (void)hipGetLastError();
    }
    Params p{};
    p.x = (const float*)d_in[0]; p.positions = (const int*)d_in[1]; p.w_in = (const float*)d_in[2]; p.sinks = (const float*)d_in[3];
    p.conv_w = (const float*)d_in[4]; p.a_log = (const float*)d_in[5]; p.dt_bias = (const float*)d_in[6]; p.dn_norm_g = (const float*)d_in[7];
    p.w_out = (const float*)d_in[8]; p.ln1_g = (const float*)d_in[9]; p.ln1_b = (const float*)d_in[10]; p.w_query = (const float*)d_in[11];
    p.sub_keys = (const float*)d_in[12]; p.peer_u = (const float*)d_in[13]; p.peer_v = (const float*)d_in[14]; p.ln2_g = (const float*)d_in[15]; p.ln2_b = (const float*)d_in[16];
    p.out = (float*)d_out;
    char* ws = (char*)d_ws; size_t off = 0;
    auto take = [&](size_t bytes) { char* r = ws + off; off += (bytes + 255) & ~(size_t)255; return r; };
    p.xb = (bf16_t*)take((size_t)M_TOK * 1024 * 2);
    p.proj_b = (bf16_t*)take((size_t)M_TOK * NP_IN * 2);
    p.odn_raw = (float*)d_out;
    {
        char* dn = take((size_t)2048 * (16384 * 3 + 8192 + 32768) + 8192);
        p.ids = (int*)dn; p.gates = (float*)(dn + (size_t)M_TOK * 128 * 4);
        p.tab_u = (bf16_t*)(dn + (size_t)M_TOK * 128 * 8);
        p.dn_negw = (bf16_t*)dn; p.dn_qd = (bf16_t*)(dn + (size_t)2048 * 16384); p.dn_kdt = (bf16_t*)(dn + (size_t)2048 * 16384 * 2);
        p.dn_qk = (bf16_t*)(dn + (size_t)2048 * 16384 * 3); p.dn_u = (float*)(dn + (size_t)2048 * (16384 * 3 + 8192)); p.dn_gl = (float*)(dn + (size_t)2048 * (16384 * 3 + 8192 + 32768));
    }
    p.wt_in = (bf16_t*)take((size_t)NP_IN * 1024 * 2);
    p.wt_out = (bf16_t*)take((size_t)1024 * 1024 * 2);
    p.wt_q = (bf16_t*)take((size_t)2048 * 1024 * 2);
    p.rope_cs = (float*)take((size_t)M_TOK * 64 * 4);
    p.sk_frag = (bf16_t*)take((size_t)16 * 128 * 128 * 2);
    p.bar = (unsigned*)take((size_t)XCD_BAR_WORDS * 4);
    if (off > ws_size) { fprintf(stderr, "kernel_launch: workspace too small (%zu < %zu)\n", ws_size, off); return; }
    if (hipMemsetAsync(p.bar, 0, (size_t)XCD_BAR_WORDS * 4, stream) != hipSuccess) { fprintf(stderr, "kernel_launch: memset of barrier words failed\n"); return; }
#if MK_LAUNCHES == 1
    p.ph_lo = 0; p.ph_hi = N_PHASES;
    void* args[] = {&p};
    hipError_t e = hipLaunchCooperativeKernel((void*)mega_fwd, dim3(grid_blocks), dim3(NTHREADS), args, 0, stream);
    if (e != hipSuccess) fprintf(stderr, "cooperative launch failed: %s (grid %d)\n", hipGetErrorString(e), grid_blocks);
#else
    for (int k = 0; k < N_PHASES; ++k) { p.ph_lo = k; p.ph_hi = k + 1; hipLaunchKernelGGL(mega_fwd, dim3(grid_blocks), dim3(NTHREADS), 0, stream, p); }
#endif
}
```

```cpp
#include <hip/hip_runtime.h>
#include <cstdio>
#include <cstdint>
#include <math.h>

namespace {
constexpr int D_MODEL = 1024, BATCH = 4, SEQ = 8192, M_TOK = BATCH * SEQ;
constexpr int IN_WIDTH = 2824, NP_IN = 3072;
constexpr int P_AQ = 0, P_AK = 512, P_AV = 640, P_DQ = 768, P_DK = 1280, P_DV = 1792, P_Z = 2304, P_B = 2816, P_A = 2820;
constexpr float ALPHA = 1.189207115002721f;
constexpr float LN_EPS = 1e-5f, RMS_EPS = 1e-6f, L2_EPS = 1e-6f;
constexpr int NTHREADS = 512;

typedef unsigned short bf16_t;
typedef short bf16x8 __attribute__((ext_vector_type(8)));
typedef float f32x16 __attribute__((ext_vector_type(16)));
typedef float f32x4 __attribute__((ext_vector_type(4)));
typedef unsigned u32x4 __attribute__((ext_vector_type(4)));
typedef unsigned u32x2 __attribute__((ext_vector_type(2)));

struct Params {
    const float* x; const int* positions; const float* w_in; const float* sinks; const float* conv_w; const float* a_log; const float* dt_bias;
    const float* dn_norm_g; const float* w_out; const float* ln1_g; const float* ln1_b; const float* w_query; const float* sub_keys;
    const float* peer_u; const float* peer_v; const float* ln2_g; const float* ln2_b;
    float* out;
    bf16_t* xb;
    bf16_t* proj_b;
    float* odn_raw;
    int* ids; float* gates;
    bf16_t* wt_in; bf16_t* wt_out; bf16_t* wt_q;
    float* rope_cs;
    bf16_t* dn_negw; bf16_t* dn_qd; bf16_t* dn_kdt; bf16_t* dn_qk; float* dn_u; float* dn_gl;
    bf16_t* sk_frag;
    unsigned char* tab8; float* isc; float* wbuf;
    unsigned* bar;
    int ph_lo, ph_hi;
};

__device__ __forceinline__ float wave_sum(float v) {
#pragma unroll
    for (int o = 1; o < 64; o <<= 1) v += __shfl_xor(v, o);
    return v;
}
__device__ __forceinline__ float wave_max(float v) {
#pragma unroll
    for (int o = 1; o < 64; o <<= 1) v = fmaxf(v, __shfl_xor(v, o));
    return v;
}
__device__ __forceinline__ float bf2f(bf16_t u) { return __uint_as_float((unsigned)u << 16); }
__device__ __forceinline__ float bflo(unsigned u) { return __uint_as_float(u << 16); }
__device__ __forceinline__ float bfhi(unsigned u) { return __uint_as_float(u & 0xffff0000u); }
typedef __bf16 bf16x2_n __attribute__((ext_vector_type(2)));
__device__ __forceinline__ unsigned pk_bf16(float lo, float hi) { bf16x2_n v; v.x = (__bf16)lo; v.y = (__bf16)hi; return __builtin_bit_cast(unsigned, v); }
__device__ __forceinline__ float silu_f(float y) { return y / (1.f + __expf(-y)); }


#define XB_TMO      128
#define XB_XCNT(j)  (256  + 64 * (j))
#define XB_XSUB(j)  (1280 + 64 * (j))
#define XB_XGEN(j)  (2304 + 64 * (j))
#define XB_TOP      3328
#define XB_TOPGEN   3392
#define XCD_BAR_WORDS 3456
#define XB_SPIN_CAP (1u << 27)
#define LAS __attribute__((address_space(3)))
__device__ __forceinline__ unsigned xb_ld(unsigned* p)              { return __hip_atomic_load(p, __ATOMIC_RELAXED, __HIP_MEMORY_SCOPE_AGENT); }
__device__ __forceinline__ unsigned xb_add(unsigned* p, unsigned v) { return __hip_atomic_fetch_add(p, v, __ATOMIC_RELAXED, __HIP_MEMORY_SCOPE_AGENT); }
__device__ __forceinline__ unsigned xb_xcc_id() { return (unsigned)__builtin_amdgcn_s_getreg((3 << 11) | 20) & 0xFu; }
#define XB_SPIN(cond, bar) do { unsigned _sp = 0; while (cond) { __builtin_amdgcn_s_sleep(1); \
    if ((++_sp & 255u) == 0u) { if (xb_ld(&(bar)[XB_TMO])) break; if (_sp > XB_SPIN_CAP) { atomicAdd(&(bar)[XB_TMO], 1u); break; } } } } while (0)
struct XcdBarrier { unsigned* bar; unsigned x; volatile LAS unsigned* st; };
__device__ __forceinline__ XcdBarrier xcd_barrier_post(unsigned* bar, volatile LAS unsigned* st) {
    XcdBarrier b; b.bar = bar; b.x = xb_xcc_id(); b.st = st;
    if (threadIdx.x == 0) (void)xb_add(&bar[XB_XCNT(b.x)], 1u);
    return b;
}
__device__ __forceinline__ void xcd_barrier_complete(unsigned* bar, unsigned x, unsigned& nloc, unsigned& nx) {
    const unsigned G = gridDim.x * gridDim.y * gridDim.z;
    unsigned sum, cnt, mine, sp = 0u;
    for (;;) {
        sum = 0u; cnt = 0u; mine = 0u;
#pragma unroll
        for (unsigned j = 0; j < 16; ++j) { const unsigned c = xb_ld(&bar[XB_XCNT(j)]); sum += c; cnt += (c > 0u) ? 1u : 0u; mine = (j == x) ? c : mine; }
        if (sum == G) break;
        __builtin_amdgcn_s_sleep(1);
        if ((++sp & 255u) == 0u) { if (xb_ld(&bar[XB_TMO])) break; if (sp > XB_SPIN_CAP) { atomicAdd(&bar[XB_TMO], 1u); break; } }
    }
    nloc = mine > 0u ? mine : 1u; nx = cnt > 0u ? cnt : 1u;
}
__device__ __forceinline__ void xcd_barrier(const XcdBarrier& b) {
    asm volatile("s_waitcnt vmcnt(0)" ::: "memory");
    __syncthreads();
    if (threadIdx.x == 0) {
        unsigned* bar = b.bar;
        __builtin_amdgcn_s_waitcnt(0);
        unsigned nloc = b.st[0], nx = b.st[1];
        if (nloc == 0u) { xcd_barrier_complete(bar, b.x, nloc, nx); b.st[0] = nloc; b.st[1] = nx; }
        const unsigned old = xb_add(&bar[XB_XSUB(b.x)], 1u);
        const unsigned gen = old / nloc;
        if (old + 1u == (gen + 1u) * nloc) {
            __builtin_amdgcn_fence(__ATOMIC_RELEASE, "agent");
            asm volatile("s_waitcnt vmcnt(0)" ::: "memory");
            const unsigned og = xb_add(&bar[XB_TOP], 1u);
            const unsigned tg = og / nx;
            if (og + 1u == (tg + 1u) * nx) xb_add(&bar[XB_TOPGEN], 1u);
            else XB_SPIN(xb_ld(&bar[XB_TOPGEN]) == tg, bar);
            __builtin_amdgcn_fence(__ATOMIC_ACQUIRE, "agent");
            xb_add(&bar[XB_XGEN(b.x)], 1u);
            asm volatile("s_waitcnt vmcnt(0)" ::: "memory");
        } else {
            XB_SPIN(xb_ld(&bar[XB_XGEN(b.x)]) == gen, bar);
            __builtin_amdgcn_fence(__ATOMIC_ACQUIRE, "agent");
            asm volatile("s_waitcnt vmcnt(0)" ::: "memory");
        }
    }
    __syncthreads();
}

__device__ __forceinline__ int inproj_old_col(int n) {
    if (n < 2304) return n;
    if (n < 2816) return 2312 + (n - 2304);
    if (n < 2824) return 2304 + (n - 2816);
    return -1;
}
__device__ __forceinline__ void transpose_item(const float* __restrict__ W, int N_src, bf16_t* __restrict__ WT, int K, int kb, int nb, bool permute, float* scr) {
    const int tid = threadIdx.x;
    const int nn = tid & 63, k8 = tid >> 6;
    const int n = nb * 64 + nn;
    const int oc = permute ? inproj_old_col(n) : n;
#pragma unroll
    for (int i = 0; i < 8; ++i) { const int kk = k8 + 8 * i; scr[kk * 65 + nn] = (oc >= 0) ? W[(size_t)(kb * 64 + kk) * N_src + oc] : 0.f; }
    __syncthreads();
    const int n2 = tid >> 3, c = tid & 7;
    const float* s = scr + (c * 8) * 65 + n2;
    u32x4 o; o.x = pk_bf16(s[0], s[65]); o.y = pk_bf16(s[2 * 65], s[3 * 65]); o.z = pk_bf16(s[4 * 65], s[5 * 65]); o.w = pk_bf16(s[6 * 65], s[7 * 65]);
    *(u32x4*)(WT + (size_t)(nb * 64 + n2) * K + kb * 64 + c * 8) = o;
    __syncthreads();
}
__device__ __forceinline__ void phase_prep(const Params& p, unsigned char* smem) {
    const int tid = threadIdx.x, G = gridDim.x, bid = blockIdx.x;
    float* scr = (float*)smem;
    constexpr int I_IN = 16 * (NP_IN / 64), I_OUT = 16 * 16, I_Q = 16 * 32;
    for (int it = bid; it < I_IN + I_OUT + I_Q; it += G) {
        int r = it;
        if (r < I_IN) { transpose_item(p.w_in, IN_WIDTH, p.wt_in, 1024, r / (NP_IN / 64), r % (NP_IN / 64), true, scr); continue; } r -= I_IN;
        if (r < I_OUT) { transpose_item(p.w_out, 1024, p.wt_out, 1024, r / 16, r % 16, false, scr); continue; } r -= I_OUT;
        transpose_item(p.w_query, 2048, p.wt_q, 1024, r / 32, r % 32, false, scr);
    }
    const size_t gt = (size_t)bid * NTHREADS + tid, GT = (size_t)G * NTHREADS;
    for (size_t i = gt; i < (size_t)M_TOK * 1024 / 8; i += GT) {
        const float4 a = *(const float4*)(p.x + i * 8), b = *(const float4*)(p.x + i * 8 + 4);
        u32x4 o; o.x = pk_bf16(a.x, a.y); o.y = pk_bf16(a.z, a.w); o.z = pk_bf16(b.x, b.y); o.w = pk_bf16(b.z, b.w);
        *(u32x4*)(p.xb + i * 8) = o;
    }
    for (size_t i = gt; i < (size_t)16 * 4 * 8 * 64; i += GT) {
        const int ln = (int)(i & 63), ks = (int)((i >> 6) & 7), kt = (int)((i >> 9) & 3), hp = (int)(i >> 11);
        const float* src = p.sub_keys + ((size_t)(hp * 128 + 32 * kt + (ln & 31))) * 128 + 16 * ks + 8 * (ln >> 5);
        const float4 a = *(const float4*)src, b = *(const float4*)(src + 4);
        u32x4 o; o.x = pk_bf16(a.x, a.y); o.y = pk_bf16(a.z, a.w); o.z = pk_bf16(b.x, b.y); o.w = pk_bf16(b.z, b.w);
        *(u32x4*)(p.sk_frag + i * 8) = o;
    }
    for (size_t i = gt; i < (size_t)M_TOK * 32; i += GT) {
        const int m = (int)(i >> 5), j = (int)(i & 31);
        const float inv_freq = powf(10000.0f, -(float)j / 32.0f);
        const float ang = (float)p.positions[m] * inv_freq;
        p.rope_cs[i] = cosf(ang); p.rope_cs[(size_t)M_TOK * 32 + i] = sinf(ang);
    }
}

constexpr int GK = 1024, GBK = 64, G_TILE_BYTES = 256 * 128;
constexpr int STG_STRIDE = 260;
constexpr int SMEM_BYTES = 159744;

__device__ __forceinline__ int swz(int row, int chunk) { return row * 128 + ((chunk ^ ((row >> 1) & 7)) << 4); }

struct EpiInProj {
    bf16_t* out; const float* cs;
    __device__ __forceinline__ void operator()(int m, int pn, int c8, const unsigned char* stg_row) const {
        const int col = pn * 256 + c8 * 8;
        u32x2 a0 = *(const u32x2*)(stg_row + c8 * 16), a1 = *(const u32x2*)(stg_row + c8 * 16 + 8);
        u32x4 o; o.x = a0.x; o.y = a0.y; o.z = a1.x; o.w = a1.y;
        if (col < P_AV) {
            const int d0 = col & 63, i0 = d0 & 31; const bool second = d0 >= 32;
            const int pc8 = second ? c8 - 4 : c8 + 4;
            const u32x2 b0 = *(const u32x2*)(stg_row + pc8 * 16), b1 = *(const u32x2*)(stg_row + pc8 * 16 + 8);
            const unsigned mine[4] = {a0.x, a0.y, a1.x, a1.y}, oth[4] = {b0.x, b0.y, b1.x, b1.y};
            const float* cp = cs + (size_t)m * 32 + i0; const float* sp = cs + (size_t)M_TOK * 32 + (size_t)m * 32 + i0;
            const float4 c0 = *(const float4*)cp, c1 = *(const float4*)(cp + 4), s0 = *(const float4*)sp, s1 = *(const float4*)(sp + 4);
            const float cc[8] = {c0.x, c0.y, c0.z, c0.w, c1.x, c1.y, c1.z, c1.w}, ss[8] = {s0.x, s0.y, s0.z, s0.w, s1.x, s1.y, s1.z, s1.w};
            const float scale = col < P_AK ? 0.125f : 1.f;
            float r[8];
#pragma unroll
            for (int j = 0; j < 8; ++j) {
                const float me = (j & 1) ? bfhi(mine[j >> 1]) : bflo(mine[j >> 1]);
                const float ot = (j & 1) ? bfhi(oth[j >> 1]) : bflo(oth[j >> 1]);
                r[j] = (second ? (me * cc[j] + ot * ss[j]) : (me * cc[j] - ot * ss[j])) * scale;
            }
            o.x = pk_bf16(r[0], r[1]); o.y = pk_bf16(r[2], r[3]); o.z = pk_bf16(r[4], r[5]); o.w = pk_bf16(r[6], r[7]);
        }
        *(u32x4*)(out + (size_t)m * NP_IN + col) = o;
    }
};
struct EpiOutProj {
    float* y; const float* x;
    __device__ __forceinline__ void operator()(int m, int pn, int c8, const unsigned char* stg_row) const {
        const int col = pn * 256 + c8 * 8;
        const u32x2 a0 = *(const u32x2*)(stg_row + c8 * 16), a1 = *(const u32x2*)(stg_row + c8 * 16 + 8);
        const float4 x0 = *(const float4*)(x + (size_t)m * 1024 + col), x1 = *(const float4*)(x + (size_t)m * 1024 + col + 4);
        *(float4*)(y + (size_t)m * 1024 + col) = make_float4(ALPHA * x0.x + bflo(a0.x), ALPHA * x0.y + bfhi(a0.x), ALPHA * x0.z + bflo(a0.y), ALPHA * x0.w + bfhi(a0.y));
        *(float4*)(y + (size_t)m * 1024 + col + 4) = make_float4(ALPHA * x1.x + bflo(a1.x), ALPHA * x1.y + bfhi(a1.x), ALPHA * x1.z + bflo(a1.y), ALPHA * x1.w + bfhi(a1.y));
    }
};
struct EpiBf16 {
    bf16_t* out; int ldc;
    __device__ __forceinline__ void operator()(int m, int pn, int c8, const unsigned char* stg_row) const {
        const int col = pn * 256 + c8 * 8;
        const u32x2 a0 = *(const u32x2*)(stg_row + c8 * 16), a1 = *(const u32x2*)(stg_row + c8 * 16 + 8);
        u32x4 o; o.x = a0.x; o.y = a0.y; o.z = a1.x; o.w = a1.y;
        *(u32x4*)(out + (size_t)m * ldc + col) = o;
    }
};

template <class EPI>
__device__ __forceinline__ void gemm_phase(const bf16_t* __restrict__ A, const bf16_t* __restrict__ Bt, int M, int N, const EPI& epi, unsigned char* smem) {
    const int tid = threadIdx.x, lane = tid & 63, wave = tid >> 6, r = lane & 31, h = lane >> 5;
    const int wm = wave >> 2, wn = wave & 3;
    const int nM = M / 256, nN = N / 256, ntiles = nM * nN;
    for (int t = blockIdx.x; t < ntiles; t += gridDim.x) {
        const int pm = t / nN, pn = t % nN;
        const bf16_t* Ag = A + (size_t)pm * 256 * GK; const bf16_t* Bg = Bt + (size_t)pn * 256 * GK;
        f32x16 acc[2][4];
#pragma unroll
        for (int j = 0; j < 2; ++j)
#pragma unroll
            for (int i = 0; i < 4; ++i)
#pragma unroll
                for (int e = 0; e < 16; ++e) acc[j][i][e] = 0.f;
        u32x4 sa[4], sb[4];
        const int lrow = tid >> 3, lch = tid & 7;
#pragma unroll
        for (int i = 0; i < 4; ++i) { sa[i] = *(const u32x4*)(Ag + (size_t)(lrow + 64 * i) * GK + lch * 8); sb[i] = *(const u32x4*)(Bg + (size_t)(lrow + 64 * i) * GK + lch * 8); }
        __syncthreads();
#pragma unroll
        for (int i = 0; i < 4; ++i) { *(u32x4*)(smem + swz(lrow + 64 * i, lch)) = sa[i]; *(u32x4*)(smem + G_TILE_BYTES + swz(lrow + 64 * i, lch)) = sb[i]; }
        __syncthreads();
        int cur = 0;
        for (int kt = 0; kt < GK / GBK; ++kt) {
            if (kt + 1 < GK / GBK) {
                const int k0 = (kt + 1) * GBK;
#pragma unroll
                for (int i = 0; i < 4; ++i) { sa[i] = *(const u32x4*)(Ag + (size_t)(lrow + 64 * i) * GK + k0 + lch * 8); sb[i] = *(const u32x4*)(Bg + (size_t)(lrow + 64 * i) * GK + k0 + lch * 8); }
            }
            const unsigned char* la = smem + cur * 2 * G_TILE_BYTES; const unsigned char* lb = la + G_TILE_BYTES;
#pragma unroll
            for (int ks = 0; ks < 4; ++ks) {
                bf16x8 af[4], bf[2];
#pragma unroll
                for (int i = 0; i < 4; ++i) af[i] = *(const bf16x8*)(la + swz(wm * 128 + i * 32 + r, ks * 2 + h));
#pragma unroll
                for (int j = 0; j < 2; ++j) bf[j] = *(const bf16x8*)(lb + swz(wn * 64 + j * 32 + r, ks * 2 + h));
#pragma unroll
                for (int j = 0; j < 2; ++j)
#pragma unroll
                    for (int i = 0; i < 4; ++i) acc[j][i] = __builtin_amdgcn_mfma_f32_32x32x16_bf16(bf[j], af[i], acc[j][i], 0, 0, 0);
            }
            if (kt + 1 < GK / GBK) {
                unsigned char* na = smem + (cur ^ 1) * 2 * G_TILE_BYTES;
#pragma unroll
                for (int i = 0; i < 4; ++i) { *(u32x4*)(na + swz(lrow + 64 * i, lch)) = sa[i]; *(u32x4*)(na + G_TILE_BYTES + swz(lrow + 64 * i, lch)) = sb[i]; }
            }
            __syncthreads();
            cur ^= 1;
        }
#pragma unroll
        for (int j = 0; j < 2; ++j)
#pragma unroll
            for (int i = 0; i < 4; ++i)
#pragma unroll
                for (int g = 0; g < 4; ++g) {
                    u32x2 v; v.x = pk_bf16(acc[j][i][4 * g], acc[j][i][4 * g + 1]); v.y = pk_bf16(acc[j][i][4 * g + 2], acc[j][i][4 * g + 3]);
                    *(u32x2*)(smem + (size_t)(wm * 128 + i * 32 + r) * (STG_STRIDE * 2) + (wn * 64 + j * 32 + 8 * g + 4 * h) * 2) = v;
                }
        __syncthreads();
        const int erow = tid >> 5, ec8 = tid & 31;
#pragma unroll 4
        for (int ps = 0; ps < 16; ++ps) { const int row = ps * 16 + erow; epi(pm * 256 + row, pn, ec8, smem + (size_t)row * (STG_STRIDE * 2)); }
    }
    __syncthreads();
}

__device__ __forceinline__ void phase_attn_simple(const Params& p, unsigned char* smem, int first_block) {
    const int tid = threadIdx.x, sub = tid >> 7, st = tid & 127;
    float* qs = (float*)smem + sub * 256; float* ps = qs + 64; float* red = qs + 192;
    const int nblk = gridDim.x - first_block;
    const bf16_t* pb = p.proj_b;
    for (int base = (blockIdx.x - first_block) * 4; base < M_TOK * 8; base += nblk * 4) {
        const int item = base + sub, m = item >> 3, head = item & 7, kvh = head >> 2, t = m % SEQ;
        __syncthreads();
        if (st < 64) qs[st] = bf2f(pb[(size_t)m * NP_IN + P_AQ + head * 64 + st]);
        __syncthreads();
        const int k = st; const bool valid = (t - k) >= 0;
        float s = -1e30f;
        if (valid) {
            const u32x4* kr = (const u32x4*)(pb + (size_t)(m - k) * NP_IN + P_AK + kvh * 64);
            float a = 0.f;
#pragma unroll
            for (int c = 0; c < 8; ++c) { const u32x4 kk = kr[c]; const float* q8 = qs + c * 8;
                a += q8[0] * bflo(kk.x) + q8[1] * bfhi(kk.x) + q8[2] * bflo(kk.y) + q8[3] * bfhi(kk.y) + q8[4] * bflo(kk.z) + q8[5] * bfhi(kk.z) + q8[6] * bflo(kk.w) + q8[7] * bfhi(kk.w); }
            s = a;
        }
        float mx = wave_max(s);
        if ((st & 63) == 0) red[st >> 6] = mx;
        __syncthreads();
        const float sink = p.sinks[head];
        mx = fmaxf(fmaxf(red[0], red[1]), sink);
        const float pe = valid ? __expf(s - mx) : 0.f;
        float sm = wave_sum(pe);
        if ((st & 63) == 0) red[2 + (st >> 6)] = sm;
        __syncthreads();
        const float denom = red[2] + red[3] + __expf(sink - mx);
        ps[k] = pe / denom;
        __syncthreads();
        if (st < 64) {
            float o = 0.f;
            const int kmax = t < 127 ? t : 127;
            for (int kk = 0; kk <= kmax; ++kk) o = fmaf(ps[kk], bf2f(pb[(size_t)(m - kk) * NP_IN + P_AV + kvh * 64 + st]), o);
            p.xb[(size_t)m * D_MODEL + head * 64 + st] = (bf16_t)(pk_bf16(o, 0.f) & 0xffffu);
        }
    }
    __syncthreads();
}

__device__ __forceinline__ void phase_dn_simple(const Params& p, unsigned char* smem) {
    const int tid = threadIdx.x, lane = tid & 63;
    float* ks = (float*)smem; float* qs = ks + 128; float* red = qs + 128;
    const int b = blockIdx.x >> 2, h = blockIdx.x & 3;
    const bool act = tid < 256;
    const int kind = (tid >> 7) & 1, c = tid & 127;
    const int e = ((tid >> 6) & 3) * 32 + (lane & 31), half = lane >> 5;
    float s[64];
#pragma unroll
    for (int d = 0; d < 64; ++d) s[d] = 0.f;
    float wa[4], wv[4];
#pragma unroll
    for (int j = 0; j < 4; ++j) { wa[j] = p.conv_w[j * 1536 + kind * 512 + h * 128 + c]; wv[j] = p.conv_w[j * 1536 + 1024 + h * 128 + e]; }
    float xa[3] = {0.f, 0.f, 0.f}, xv[3] = {0.f, 0.f, 0.f};
    const float neg_a = -expf(p.a_log[h]), dtb = p.dt_bias[h];
    const bf16_t* pr = p.proj_b + (size_t)b * SEQ * NP_IN;
    const int ca_off = (kind ? P_DK : P_DQ) + h * 128 + c, cv_off = P_DV + h * 128 + e;
    float na = bf2f(pr[ca_off]), nv = bf2f(pr[cv_off]), nb = bf2f(pr[P_B + h]), ng = bf2f(pr[P_A + h]);
    for (int t = 0; t < SEQ; ++t) {
        const float ca = na, cv = nv, cb = nb, cg_ = ng;
        if (t + 1 < SEQ) { const bf16_t* p2 = pr + (size_t)(t + 1) * NP_IN; na = bf2f(p2[ca_off]); nv = bf2f(p2[cv_off]); nb = bf2f(p2[P_B + h]); ng = bf2f(p2[P_A + h]); }
        float a = silu_f(wa[0] * xa[0] + wa[1] * xa[1] + wa[2] * xa[2] + wa[3] * ca);
        const float v = silu_f(wv[0] * xv[0] + wv[1] * xv[1] + wv[2] * xv[2] + wv[3] * cv);
        xa[0] = xa[1]; xa[1] = xa[2]; xa[2] = ca; xv[0] = xv[1]; xv[1] = xv[2]; xv[2] = cv;
        const float ss = wave_sum(a * a);
        if (act && lane == 0) red[tid >> 6] = ss;
        __syncthreads();
        if (act) {
            const float tot = kind ? (red[2] + red[3]) : (red[0] + red[1]);
            a = a * rsqrtf(tot + L2_EPS) * (kind ? 1.f : 0.08838834764831845f);
            if (kind) ks[c] = a; else qs[c] = a;
        }
        __syncthreads();
        if (act) {
            const float beta = 1.f / (1.f + expf(-cb));
            const float xx = cg_ + dtb;
            const float sp = xx > 20.f ? xx : log1pf(expf(xx));
            const float gt = expf(neg_a * sp);
            const float* kh = ks + half * 64; const float* qh = qs + half * 64;
            float kS = 0.f;
#pragma unroll
            for (int d = 0; d < 64; d += 4) { const float4 k4 = *(const float4*)&kh[d]; kS = fmaf(k4.x, s[d], kS); kS = fmaf(k4.y, s[d + 1], kS); kS = fmaf(k4.z, s[d + 2], kS); kS = fmaf(k4.w, s[d + 3], kS); }
            kS += __shfl_xor(kS, 32);
            const float cc = beta * (v - gt * kS);
            float o = 0.f;
#pragma unroll
            for (int d = 0; d < 64; d += 4) {
                const float4 k4 = *(const float4*)&kh[d]; const float4 q4 = *(const float4*)&qh[d];
                s[d] = fmaf(gt, s[d], k4.x * cc); o = fmaf(s[d], q4.x, o);
                s[d + 1] = fmaf(gt, s[d + 1], k4.y * cc); o = fmaf(s[d + 1], q4.y, o);
                s[d + 2] = fmaf(gt, s[d + 2], k4.z * cc); o = fmaf(s[d + 2], q4.z, o);
                s[d + 3] = fmaf(gt, s[d + 3], k4.w * cc); o = fmaf(s[d + 3], q4.w, o);
            }
            o += __shfl_xor(o, 32);
            if (half == 0) p.odn_raw[((size_t)b * SEQ + t) * 512 + h * 128 + e] = o;
        }
    }
    __syncthreads();
}


constexpr int DNP_QS = 0, DNP_KS = 16384, DNP_R = 32768, DNP_AM = 98304, DNP_KDT = 115712, DNP_QK = 133120, DNP_WI = 141824, DNP_SM = 158720;
constexpr int DN_CH_BYTES = 57344;


template <int I> __device__ __forceinline__ void solve_row(float (&X)[64], const float* Am) {
    float a = X[I];
#pragma unroll
    for (int j4 = 0; j4 < (I + 3) / 4; ++j4) {
        const float4 av = *(const float4*)(Am + I * 68 + 4 * j4);
        a = fmaf(-av.x, X[4 * j4], a);
        if (4 * j4 + 1 < I) a = fmaf(-av.y, X[4 * j4 + 1], a);
        if (4 * j4 + 2 < I) a = fmaf(-av.z, X[4 * j4 + 2], a);
        if (4 * j4 + 3 < I) a = fmaf(-av.w, X[4 * j4 + 3], a);
    }
    X[I] = a;
    asm volatile("" ::: "memory");
}
template <int I> struct SolveRows { static __device__ __forceinline__ void run(float (&X)[64], const float* Am) { SolveRows<I - 1>::run(X, Am); solve_row<I>(X, Am); } };
template <> struct SolveRows<0> { static __device__ __forceinline__ void run(float (&)[64], const float*) {} };

__device__ __forceinline__ void phase_dn_prep(const Params& p, unsigned char* smem) {
    const int tid0 = threadIdx.x;
    float* sbeta = (float*)(smem + DNP_SM); float* sgc = sbeta + 64; float* segc = sbeta + 128; float* sekd = sbeta + 192;
    float* Rm = (float*)(smem + DNP_R); float* Am = (float*)(smem + DNP_AM);
    bf16_t* kdt = (bf16_t*)(smem + DNP_KDT); bf16_t* qki = (bf16_t*)(smem + DNP_QK); bf16_t* wim = (bf16_t*)(smem + DNP_WI);
    for (int ci = blockIdx.x; ci < 16 * 128; ci += gridDim.x) {
        int tid = tid0; asm volatile("" : "+v"(tid));
        const int lane = tid & 63, wave = tid >> 6;
        const int bh = ci >> 7, n = ci & 127, b = bh >> 2, h = bh & 3;
        const bf16_t* prow = p.proj_b + (size_t)b * SEQ * NP_IN;
        if (wave == 0) {
            const size_t m = (size_t)(n * 64 + lane);
            const float braw = bf2f(prow[m * NP_IN + P_B + h]), araw = bf2f(prow[m * NP_IN + P_A + h]);
            const float beta = 1.f / (1.f + expf(-braw));
            const float xx = araw + p.dt_bias[h];
            const float sp = xx > 20.f ? xx : log1pf(expf(xx));
            float g = -expf(p.a_log[h]) * sp;
#pragma unroll
            for (int o = 1; o < 64; o <<= 1) { const float up = __shfl_up(g, o); if (lane >= o) g += up; }
            const float g63 = __shfl(g, 63);
            sbeta[lane] = beta; sgc[lane] = g; segc[lane] = expf(g); sekd[lane] = expf(g63 - g);
            if (lane == 63) p.dn_gl[ci] = expf(g63);
        }
        __syncthreads();
        {
            const int i = tid >> 3, sg = tid & 7, c0 = sg * 16;
            const float beta_i = sbeta[i], egc_i = segc[i], ekd_i = sekd[i];
            const int tt0 = n * 64 + i - 3;
#pragma unroll
            for (int mat = 0; mat < 3; ++mat) {
                const int colbase = (mat == 0 ? P_DQ : (mat == 1 ? P_DK : P_DV)) + h * 128 + c0;
                float acc[16];
#pragma unroll
                for (int cc = 0; cc < 16; ++cc) acc[cc] = 0.f;
#pragma unroll
                for (int j = 0; j < 4; ++j) {
                    const int tt = tt0 + j;
                    if (tt >= 0) {
                        const u32x4 x0 = *(const u32x4*)(prow + (size_t)tt * NP_IN + colbase), x1 = *(const u32x4*)(prow + (size_t)tt * NP_IN + colbase + 8);
                        const float* wp = p.conv_w + j * 1536 + mat * 512 + h * 128 + c0;
                        const float4 w0 = *(const float4*)wp, w1 = *(const float4*)(wp + 4), w2 = *(const float4*)(wp + 8), w3 = *(const float4*)(wp + 12);
                        acc[0] = fmaf(w0.x, bflo(x0.x), acc[0]); acc[1] = fmaf(w0.y, bfhi(x0.x), acc[1]); acc[2] = fmaf(w0.z, bflo(x0.y), acc[2]); acc[3] = fmaf(w0.w, bfhi(x0.y), acc[3]);
                        acc[4] = fmaf(w1.x, bflo(x0.z), acc[4]); acc[5] = fmaf(w1.y, bfhi(x0.z), acc[5]); acc[6] = fmaf(w1.z, bflo(x0.w), acc[6]); acc[7] = fmaf(w1.w, bfhi(x0.w), acc[7]);
                        acc[8] = fmaf(w2.x, bflo(x1.x), acc[8]); acc[9] = fmaf(w2.y, bfhi(x1.x), acc[9]); acc[10] = fmaf(w2.z, bflo(x1.y), acc[10]); acc[11] = fmaf(w2.w, bfhi(x1.y), acc[11]);
                        acc[12] = fmaf(w3.x, bflo(x1.z), acc[12]); acc[13] = fmaf(w3.y, bfhi(x1.z), acc[13]); acc[14] = fmaf(w3.z, bflo(x1.w), acc[14]); acc[15] = fmaf(w3.w, bfhi(x1.w), acc[15]);
                    }
                }
                float ss = 0.f;
#pragma unroll
                for (int cc = 0; cc < 16; ++cc) { acc[cc] = silu_f(acc[cc]); ss = fmaf(acc[cc], acc[cc], ss); }
                if (mat < 2) {
                    ss += __shfl_xor(ss, 1); ss += __shfl_xor(ss, 2); ss += __shfl_xor(ss, 4);
                    const float rs = rsqrtf(ss + L2_EPS) * (mat == 0 ? 0.08838834764831845f : 1.f);
#pragma unroll
                    for (int cc = 0; cc < 16; ++cc) acc[cc] *= rs;
                    unsigned char* img = smem + (mat == 0 ? DNP_QS : DNP_KS) + i * 256;
                    u32x4 c0v, c1v;
                    c0v.x = pk_bf16(acc[0], acc[1]); c0v.y = pk_bf16(acc[2], acc[3]); c0v.z = pk_bf16(acc[4], acc[5]); c0v.w = pk_bf16(acc[6], acc[7]);
                    c1v.x = pk_bf16(acc[8], acc[9]); c1v.y = pk_bf16(acc[10], acc[11]); c1v.z = pk_bf16(acc[12], acc[13]); c1v.w = pk_bf16(acc[14], acc[15]);
                    *(u32x4*)(img + (((2 * sg) ^ (i & 15)) << 4)) = c0v;
                    *(u32x4*)(img + (((2 * sg + 1) ^ (i & 15)) << 4)) = c1v;
                }
                if (mat == 0) {
                    u32x4 p0, p1;
                    p0.x = pk_bf16(acc[0] * egc_i, acc[1] * egc_i); p0.y = pk_bf16(acc[2] * egc_i, acc[3] * egc_i); p0.z = pk_bf16(acc[8] * egc_i, acc[9] * egc_i); p0.w = pk_bf16(acc[10] * egc_i, acc[11] * egc_i);
                    p1.x = pk_bf16(acc[4] * egc_i, acc[5] * egc_i); p1.y = pk_bf16(acc[6] * egc_i, acc[7] * egc_i); p1.z = pk_bf16(acc[12] * egc_i, acc[13] * egc_i); p1.w = pk_bf16(acc[14] * egc_i, acc[15] * egc_i);
                    bf16_t* dst = p.dn_qd + ((size_t)(ci * 16 + (i >> 5) * 8 + sg) * 64) * 8;
                    *(u32x4*)(dst + (size_t)(i & 31) * 8) = p0;
                    *(u32x4*)(dst + (size_t)(32 + (i & 31)) * 8) = p1;
                } else if (mat == 1) {
                    const float sc = beta_i * egc_i;
                    float* rr = Rm + i * 256 + 128 + c0;
#pragma unroll
                    for (int q4 = 0; q4 < 4; ++q4) *(float4*)(rr + 4 * q4) = make_float4(acc[4 * q4] * sc, acc[4 * q4 + 1] * sc, acc[4 * q4 + 2] * sc, acc[4 * q4 + 3] * sc);
#pragma unroll
                    for (int cc = 0; cc < 16; ++cc) kdt[(c0 + cc) * 68 + i] = (bf16_t)(pk_bf16(acc[cc] * ekd_i, 0.f) & 0xffffu);
                } else {
                    float* rr = Rm + i * 256 + c0;
#pragma unroll
                    for (int q4 = 0; q4 < 4; ++q4) *(float4*)(rr + 4 * q4) = make_float4(acc[4 * q4] * beta_i, acc[4 * q4 + 1] * beta_i, acc[4 * q4 + 2] * beta_i, acc[4 * q4 + 3] * beta_i);
                }
            }
        }
        __syncthreads();
        {
            const int mat = wave >> 2, ti = (wave >> 1) & 1, tj = wave & 1, r = lane & 31, hh = lane >> 5;
            const unsigned char* ai = smem + (mat ? DNP_QS : DNP_KS) + (ti * 32 + r) * 256;
            const unsigned char* bi = smem + DNP_KS + (tj * 32 + r) * 256;
            f32x16 d;
#pragma unroll
            for (int e = 0; e < 16; ++e) d[e] = 0.f;
#pragma unroll
            for (int ks = 0; ks < 8; ++ks) {
                const bf16x8 af = *(const bf16x8*)(ai + (((2 * ks + hh) ^ (r & 15)) << 4));
                const bf16x8 bf = *(const bf16x8*)(bi + (((2 * ks + hh) ^ (r & 15)) << 4));
                d = __builtin_amdgcn_mfma_f32_32x32x16_bf16(af, bf, d, 0, 0, 0);
            }
            const int j = tj * 32 + r; const float gcj = sgc[j];
#pragma unroll
            for (int e = 0; e < 16; ++e) {
                const int i = ti * 32 + (e & 3) + 8 * (e >> 2) + 4 * hh;
                const float dec = __expf(fminf(sgc[i] - gcj, 0.f));
                if (mat == 0) Am[i * 68 + j] = (j < i) ? sbeta[i] * d[e] * dec : 0.f;
                else qki[i * 68 + j] = (bf16_t)(pk_bf16((j <= i) ? d[e] * dec : 0.f, 0.f) & 0xffffu);
            }
        }
        __syncthreads();
        const int tc = tid;
        if (tc < 256) {
            float X[64];
#pragma unroll
            for (int i = 0; i < 64; ++i) X[i] = Rm[i * 256 + tc];
            SolveRows<63>::run(X, Am);
            if (tc < 128) {
                const int e = tc >> 5, r = tc & 31;
#pragma unroll
                for (int T = 0; T < 2; ++T)
#pragma unroll
                    for (int qd4 = 0; qd4 < 4; ++qd4)
#pragma unroll
                        for (int hh = 0; hh < 2; ++hh) {
                            const int i0 = 32 * T + 8 * qd4 + 4 * hh;
                            *(float4*)(p.dn_u + ((size_t)(((ci * 4 + e) * 2 + T) * 4 + qd4) * 64 + hh * 32 + r) * 4) = make_float4(X[i0], X[i0 + 1], X[i0 + 2], X[i0 + 3]);
                        }
            } else {
                const int dd = tc - 128;
#pragma unroll
                for (int i = 0; i < 64; ++i) wim[i * 132 + dd] = (bf16_t)(pk_bf16(-X[i], 0.f) & 0xffffu);
            }
        } else {
            const int t2 = tc - 256;
#pragma unroll
            for (int q = 0; q < 2; ++q) {
                const int pc = t2 + 256 * q, f = pc >> 6, ln = pc & 63, r = ln & 31, hh = ln >> 5, rt = f >> 2, ks = f & 3;
                const bf16_t* src = qki + (32 * rt + r) * 68 + 16 * ks + 4 * hh;
                const u32x2 lo = *(const u32x2*)src, hi = *(const u32x2*)(src + 8);
                u32x4 o; o.x = lo.x; o.y = lo.y; o.z = hi.x; o.w = hi.y;
                *(u32x4*)(p.dn_qk + ((size_t)(ci * 8 + f) * 64 + ln) * 8) = o;
            }
#pragma unroll
            for (int q = 0; q < 4; ++q) {
                const int pc = t2 + 256 * q, f = pc >> 6, ln = pc & 63, r = ln & 31, hh = ln >> 5, rt = f >> 2, ks = f & 3;
                const bf16_t* src = kdt + (32 * rt + r) * 68 + 16 * ks + 4 * hh;
                const u32x2 lo = *(const u32x2*)src, hi = *(const u32x2*)(src + 8);
                u32x4 o; o.x = lo.x; o.y = lo.y; o.z = hi.x; o.w = hi.y;
                *(u32x4*)(p.dn_kdt + ((size_t)(ci * 16 + f) * 64 + ln) * 8) = o;
            }
        }
        __syncthreads();
#pragma unroll
        for (int q = 0; q < 2; ++q) {
            const int pc = tid + 512 * q, f = pc >> 6, ln = pc & 63, r = ln & 31, hh = ln >> 5, rt = f >> 3, ks = f & 7;
            const bf16_t* src = wim + (32 * rt + r) * 132 + 16 * ks + 4 * hh;
            const u32x2 lo = *(const u32x2*)src, hi = *(const u32x2*)(src + 8);
            u32x4 o; o.x = lo.x; o.y = lo.y; o.z = hi.x; o.w = hi.y;
            *(u32x4*)(p.dn_negw + ((size_t)(ci * 16 + f) * 64 + ln) * 8) = o;
        }
        __syncthreads();
    }
}

__device__ __forceinline__ bf16x8 pack8(const f32x16& x, int s) {
    u32x4 v;
    v.x = pk_bf16(x[8 * s], x[8 * s + 1]); v.y = pk_bf16(x[8 * s + 2], x[8 * s + 3]); v.z = pk_bf16(x[8 * s + 4], x[8 * s + 5]); v.w = pk_bf16(x[8 * s + 6], x[8 * s + 7]);
    return __builtin_bit_cast(bf16x8, v);
}
__device__ __forceinline__ void phase_dn_scan(const Params& p, unsigned char* smem) {
    const int tid = threadIdx.x, lane = tid & 63, wave = tid >> 6, r = lane & 31, hh = lane >> 5;
    const int bh = blockIdx.x, b = bh >> 2, h = bh & 3, ci0 = bh * 128;
    {
#pragma unroll
        for (int q = 0; q < 7; ++q) {
            const int pc = tid + 512 * q;
            const bf16_t* src = pc < 1024 ? p.dn_negw + ((size_t)ci0 * 1024 + pc) * 8 : pc < 2048 ? p.dn_qd + ((size_t)ci0 * 1024 + (pc - 1024)) * 8
                              : pc < 3072 ? p.dn_kdt + ((size_t)ci0 * 1024 + (pc - 2048)) * 8 : p.dn_qk + ((size_t)ci0 * 512 + (pc - 3072)) * 8;
            *(u32x4*)(smem + pc * 16) = *(const u32x4*)src;
        }
    }
    __syncthreads();
    f32x16 S[4], ucur[2];
#pragma unroll
    for (int T = 0; T < 4; ++T)
#pragma unroll
        for (int e = 0; e < 16; ++e) S[T][e] = 0.f;
    if (wave < 4) {
#pragma unroll
        for (int T = 0; T < 2; ++T)
#pragma unroll
            for (int q4 = 0; q4 < 4; ++q4) {
                const float4 v = *(const float4*)(p.dn_u + ((size_t)(((ci0 * 4 + wave) * 2 + T) * 4 + q4) * 64 + lane) * 4);
                ucur[T][4 * q4] = v.x; ucur[T][4 * q4 + 1] = v.y; ucur[T][4 * q4 + 2] = v.z; ucur[T][4 * q4 + 3] = v.w;
            }
    }
    for (int n = 0; n < 128; ++n) {
        const int ci = ci0 + n;
        const unsigned char* buf = smem + (n & 1) * DN_CH_BYTES;
        if (wave >= 4) {
            if (n + 1 < 128) {
                const int t2 = tid - 256; unsigned char* nb = smem + ((n + 1) & 1) * DN_CH_BYTES;
                u32x4 st[14];
#pragma unroll
                for (int q = 0; q < 14; ++q) {
                    const int pc = t2 + 256 * q;
                    const bf16_t* src = pc < 1024 ? p.dn_negw + ((size_t)(ci + 1) * 1024 + pc) * 8 : pc < 2048 ? p.dn_qd + ((size_t)(ci + 1) * 1024 + (pc - 1024)) * 8
                                      : pc < 3072 ? p.dn_kdt + ((size_t)(ci + 1) * 1024 + (pc - 2048)) * 8 : p.dn_qk + ((size_t)(ci + 1) * 512 + (pc - 3072)) * 8;
                    st[q] = *(const u32x4*)src;
                }
#pragma unroll
                for (int q = 0; q < 14; ++q) *(u32x4*)(nb + (t2 + 256 * q) * 16) = st[q];
            }
        } else {
            const int e = wave;
            const float gl = p.dn_gl[ci];
            bf16x8 Sb[8];
#pragma unroll
            for (int T = 0; T < 4; ++T) { Sb[2 * T] = pack8(S[T], 0); Sb[2 * T + 1] = pack8(S[T], 1); }
            f32x16 vn[2];
#pragma unroll
            for (int T = 0; T < 2; ++T) {
                vn[T] = ucur[T];
#pragma unroll
                for (int ks = 0; ks < 8; ++ks) vn[T] = __builtin_amdgcn_mfma_f32_32x32x16_bf16(*(const bf16x8*)(buf + ((T * 8 + ks) * 64 + lane) * 16), Sb[ks], vn[T], 0, 0, 0);
            }
            bf16x8 vb[4];
#pragma unroll
            for (int T = 0; T < 2; ++T) { vb[2 * T] = pack8(vn[T], 0); vb[2 * T + 1] = pack8(vn[T], 1); }
            if (n + 1 < 128) {
#pragma unroll
                for (int T = 0; T < 2; ++T)
#pragma unroll
                    for (int q4 = 0; q4 < 4; ++q4) {
                        const float4 v = *(const float4*)(p.dn_u + ((size_t)((((ci + 1) * 4 + e) * 2 + T) * 4 + q4) * 64 + lane) * 4);
                        ucur[T][4 * q4] = v.x; ucur[T][4 * q4 + 1] = v.y; ucur[T][4 * q4 + 2] = v.z; ucur[T][4 * q4 + 3] = v.w;
                    }
            }
#pragma unroll
            for (int T = 0; T < 2; ++T) {
                f32x16 o;
#pragma unroll
                for (int e2 = 0; e2 < 16; ++e2) o[e2] = 0.f;
#pragma unroll
                for (int ks = 0; ks < 8; ++ks) o = __builtin_amdgcn_mfma_f32_32x32x16_bf16(*(const bf16x8*)(buf + 16384 + ((T * 8 + ks) * 64 + lane) * 16), Sb[ks], o, 0, 0, 0);
#pragma unroll
                for (int ks = 0; ks < 4; ++ks) o = __builtin_amdgcn_mfma_f32_32x32x16_bf16(*(const bf16x8*)(buf + 49152 + ((T * 4 + ks) * 64 + lane) * 16), vb[ks], o, 0, 0, 0);
                float* orow = p.odn_raw + ((size_t)b * SEQ + n * 64 + 32 * T + 4 * hh) * 512 + h * 128 + 32 * e + r;
#pragma unroll
                for (int e2 = 0; e2 < 16; ++e2) orow[(size_t)((e2 & 3) + 8 * (e2 >> 2)) * 512] = o[e2];
            }
#pragma unroll
            for (int T = 0; T < 4; ++T) {
#pragma unroll
                for (int e2 = 0; e2 < 16; ++e2) S[T][e2] *= gl;
#pragma unroll
                for (int ks = 0; ks < 4; ++ks) S[T] = __builtin_amdgcn_mfma_f32_32x32x16_bf16(*(const bf16x8*)(buf + 32768 + ((T * 4 + ks) * 64 + lane) * 16), vb[ks], S[T], 0, 0, 0);
            }
        }
        __syncthreads();
    }
}


constexpr int AT_VT = 32768, AT_VT_STRIDE = 260;
__device__ __forceinline__ void phase_attn(const Params& p, unsigned char* smem, int first_block) {
    const int tid0 = threadIdx.x;
    const int nblk = gridDim.x - first_block;
    const bf16_t* pb = p.proj_b;
    bf16_t* vt = (bf16_t*)(smem + AT_VT);
    for (int item = blockIdx.x - first_block; item < 1024; item += nblk) {
        int tid = tid0; asm volatile("" : "+v"(tid));
        const int lane = tid & 63, wave = tid >> 6, r = lane & 31, hh = lane >> 5;
        const int hp = item & 1, kvh = (item >> 1) & 1, nb = (item >> 2) & 63, b = item >> 8;
        const int m0 = b * SEQ + nb * 128;
        __syncthreads();
#pragma unroll
        for (int i = 0; i < 4; ++i) {
            const int idx = tid + 512 * i, key = idx >> 3, ch = idx & 7;
            const bool valid = (nb > 0) || (key >= 128);
            u32x4 kv = {0u, 0u, 0u, 0u}, vv = {0u, 0u, 0u, 0u};
            if (valid) { const bf16_t* src = pb + (size_t)(m0 - 128 + key) * NP_IN + kvh * 64 + ch * 8; kv = *(const u32x4*)(src + P_AK); vv = *(const u32x4*)(src + P_AV); }
            *(u32x4*)(smem + swz(key, ch)) = kv;
            bf16_t* vd = vt + (ch * 8) * AT_VT_STRIDE + key;
            vd[0] = (bf16_t)(vv.x & 0xffffu); vd[AT_VT_STRIDE] = (bf16_t)(vv.x >> 16); vd[2 * AT_VT_STRIDE] = (bf16_t)(vv.y & 0xffffu); vd[3 * AT_VT_STRIDE] = (bf16_t)(vv.y >> 16);
            vd[4 * AT_VT_STRIDE] = (bf16_t)(vv.z & 0xffffu); vd[5 * AT_VT_STRIDE] = (bf16_t)(vv.z >> 16); vd[6 * AT_VT_STRIDE] = (bf16_t)(vv.w & 0xffffu); vd[7 * AT_VT_STRIDE] = (bf16_t)(vv.w >> 16);
        }
        __syncthreads();
        const int head = kvh * 4 + hp * 2 + (wave >> 2), qt = wave & 3, qo = qt * 32;
        const bf16_t* qrow = pb + (size_t)(m0 + qo + r) * NP_IN + P_AQ + head * 64 + 8 * hh;
        bf16x8 qf[4];
#pragma unroll
        for (int ks = 0; ks < 4; ++ks) qf[ks] = *(const bf16x8*)(qrow + 16 * ks);
        f32x16 sc[5];
#pragma unroll
        for (int t = 0; t < 5; ++t) {
#pragma unroll
            for (int e = 0; e < 16; ++e) sc[t][e] = 0.f;
#pragma unroll
            for (int ks = 0; ks < 4; ++ks) sc[t] = __builtin_amdgcn_mfma_f32_32x32x16_bf16(*(const bf16x8*)(smem + swz((qt + t) * 32 + r, 2 * ks + hh)), qf[ks], sc[t], 0, 0, 0);
        }
        const float sink = p.sinks[head];
        float mx = -1e30f;
#pragma unroll
        for (int t = 0; t < 5; ++t)
#pragma unroll
            for (int e = 0; e < 16; ++e) {
                const int kf = 32 * (qt + t) + (e & 3) + 8 * (e >> 2) + 4 * hh;
                const bool ok = (kf >= qo + r + 1) && (kf <= qo + r + 128) && ((nb > 0) || (kf >= 128));
                sc[t][e] = ok ? sc[t][e] : -1e30f;
                mx = fmaxf(mx, sc[t][e]);
            }
        mx = fmaxf(mx, __shfl_xor(mx, 32));
        mx = fmaxf(mx, sink);
        float sum = 0.f;
#pragma unroll
        for (int t = 0; t < 5; ++t)
#pragma unroll
            for (int e = 0; e < 16; ++e) { const float pe = (sc[t][e] > -1e29f) ? __expf(sc[t][e] - mx) : 0.f; sc[t][e] = pe; sum += pe; }
        sum += __shfl_xor(sum, 32);
        const float inv = 1.f / (sum + __expf(sink - mx));
        f32x16 o[2];
#pragma unroll
        for (int dt = 0; dt < 2; ++dt)
#pragma unroll
            for (int e = 0; e < 16; ++e) o[dt][e] = 0.f;
#pragma unroll
        for (int t = 0; t < 5; ++t)
#pragma unroll
            for (int s2 = 0; s2 < 2; ++s2) {
                const bf16x8 pbv = pack8(sc[t], s2);
                const int kb = 32 * (qt + t) + 16 * s2 + 4 * hh;
#pragma unroll
                for (int dt = 0; dt < 2; ++dt) {
                    const bf16_t* vr = vt + (dt * 32 + r) * AT_VT_STRIDE + kb;
                    const u32x2 lo = *(const u32x2*)vr, hi = *(const u32x2*)(vr + 8);
                    u32x4 av; av.x = lo.x; av.y = lo.y; av.z = hi.x; av.w = hi.y;
                    o[dt] = __builtin_amdgcn_mfma_f32_32x32x16_bf16(__builtin_bit_cast(bf16x8, av), pbv, o[dt], 0, 0, 0);
                }
            }
        bf16_t* orow = p.xb + (size_t)(m0 + qo + r) * D_MODEL + head * 64 + 4 * hh;
#pragma unroll
        for (int dt = 0; dt < 2; ++dt)
#pragma unroll
            for (int q4 = 0; q4 < 4; ++q4) {
                u32x2 v; v.x = pk_bf16(o[dt][4 * q4] * inv, o[dt][4 * q4 + 1] * inv); v.y = pk_bf16(o[dt][4 * q4 + 2] * inv, o[dt][4 * q4 + 3] * inv);
                *(u32x2*)(orow + dt * 32 + 8 * q4) = v;
            }
    }
    __syncthreads();
}

__device__ __forceinline__ void phase_dn_norm(const Params& p) {
    const int lane = threadIdx.x & 63, gw = blockIdx.x * (NTHREADS / 64) + (threadIdx.x >> 6), GW = gridDim.x * (NTHREADS / 64);
    for (int it = gw; it < M_TOK * 4; it += GW) {
        const int m = it >> 2, h = it & 3;
        const float2 o = *(const float2*)(p.odn_raw + (size_t)m * 512 + h * 128 + lane * 2);
        const float ss = wave_sum(o.x * o.x + o.y * o.y);
        const float rr = rsqrtf(ss * (1.f / 128.f) + RMS_EPS);
        const unsigned z = *(const unsigned*)(p.proj_b + (size_t)m * NP_IN + P_Z + h * 128 + lane * 2);
        const float2 g = *(const float2*)(p.dn_norm_g + lane * 2);
        *(unsigned*)(p.xb + (size_t)m * D_MODEL + 512 + h * 128 + lane * 2) = pk_bf16(o.x * rr * g.x * silu_f(bflo(z)), o.y * rr * g.y * silu_f(bfhi(z)));
    }
}

__device__ __forceinline__ void phase_ln1(const Params& p, bf16_t* x1b) {
    const int lane = threadIdx.x & 63, gw = blockIdx.x * (NTHREADS / 64) + (threadIdx.x >> 6), GW = gridDim.x * (NTHREADS / 64);
    for (int m = gw; m < M_TOK; m += GW) {
        float* row = p.out + (size_t)m * D_MODEL;
        float4 v[4]; float s = 0.f;
#pragma unroll
        for (int j = 0; j < 4; ++j) { v[j] = *(const float4*)(row + j * 256 + lane * 4); s += (v[j].x + v[j].y) + (v[j].z + v[j].w); }
        const float mean = wave_sum(s) * (1.f / D_MODEL); float q = 0.f;
#pragma unroll
        for (int j = 0; j < 4; ++j) { v[j].x -= mean; v[j].y -= mean; v[j].z -= mean; v[j].w -= mean; q += (v[j].x * v[j].x + v[j].y * v[j].y) + (v[j].z * v[j].z + v[j].w * v[j].w); }
        const float rstd = rsqrtf(wave_sum(q) * (1.f / D_MODEL) + LN_EPS);
#pragma unroll
        for (int j = 0; j < 4; ++j) {
            const float4 g = *(const float4*)(p.ln1_g + j * 256 + lane * 4), bb = *(const float4*)(p.ln1_b + j * 256 + lane * 4);
            const float4 o = make_float4(v[j].x * rstd * g.x + bb.x, v[j].y * rstd * g.y + bb.y, v[j].z * rstd * g.z + bb.z, v[j].w * rstd * g.w + bb.w);
            *(float4*)(row + j * 256 + lane * 4) = o;
            u32x2 ob; ob.x = pk_bf16(o.x, o.y); ob.y = pk_bf16(o.z, o.w);
            *(u32x2*)(x1b + (size_t)m * D_MODEL + j * 256 + lane * 4) = ob;
        }
    }
}

__device__ __forceinline__ void wave_argmax(float& v, int& i) {
#pragma unroll
    for (int o = 1; o < 64; o <<= 1) {
        const float ov = __shfl_xor(v, o); const int oi = __shfl_xor(i, o);
        if (ov > v || (ov == v && oi < i)) { v = ov; i = oi; }
    }
}
__device__ __forceinline__ void phase_route_simple(const Params& p, const bf16_t* qb, unsigned char* smem) {
    const int tid = threadIdx.x, sub = tid >> 8, st = tid & 255, lane = tid & 63, w = st >> 6;
    float* base_s = (float*)smem + sub * 4608;
    float* qs = base_s;
    float* sc = qs + 2048;
    float* tv = sc + 2048;
    int* ti = (int*)(tv + 256);
    for (int mb = blockIdx.x * 2; mb < M_TOK; mb += gridDim.x * 2) {
        const int m = mb + sub;
        __syncthreads();
        for (int i = st; i < 2048; i += 256) qs[i] = bf2f(qb[(size_t)m * 2048 + i]);
        __syncthreads();
        for (int e = st; e < 2048; e += 256) {
            const int grp = e >> 7, key = e & 127;
            const float* kr = p.sub_keys + ((size_t)grp * 128 + key) * 128;
            const float* qq = qs + grp * 128;
            float a = 0.f;
#pragma unroll 8
            for (int d = 0; d < 128; d += 4) { const float4 k4 = *(const float4*)(kr + d); a = fmaf(qq[d], k4.x, a); a = fmaf(qq[d + 1], k4.y, a); a = fmaf(qq[d + 2], k4.z, a); a = fmaf(qq[d + 3], k4.w, a); }
            sc[grp * 128 + key] = a;
        }
        __syncthreads();
        for (int grp = w; grp < 16; grp += 4) {
            float v0 = sc[grp * 128 + lane], v1 = sc[grp * 128 + lane + 64];
            for (int rr = 0; rr < 16; ++rr) {
                float bv; int bi;
                if (v0 >= v1) { bv = v0; bi = lane; } else { bv = v1; bi = lane + 64; }
                wave_argmax(bv, bi);
                if (lane == 0) { tv[grp * 16 + rr] = bv; ti[grp * 16 + rr] = bi; }
                if (bi == lane) v0 = -INFINITY; else if (bi == lane + 64) v1 = -INFINITY;
            }
        }
        __syncthreads();
        for (int hh = w; hh < 8; hh += 4) {
            float cv[4]; int ci[4];
#pragma unroll
            for (int j = 0; j < 4; ++j) { const int c = lane + 64 * j, i0 = c >> 4, i1 = c & 15; cv[j] = tv[(hh * 2) * 16 + i0] + tv[(hh * 2 + 1) * 16 + i1]; ci[j] = ti[(hh * 2) * 16 + i0] * 128 + ti[(hh * 2 + 1) * 16 + i1]; }
            float bestv = 0.f; int beste = 0; float mx = 0.f;
            for (int rr = 0; rr < 16; ++rr) {
                float bv = cv[0]; int bj = 0;
#pragma unroll
                for (int j = 1; j < 4; ++j) if (cv[j] > bv) { bv = cv[j]; bj = j; }
                int bi = lane + 64 * bj;
                wave_argmax(bv, bi);
                const int src = bi & 63, sj = bi >> 6;
                int e = 0;
#pragma unroll
                for (int j = 0; j < 4; ++j) if (sj == j) e = ci[j];
                e = __shfl(e, src);
                if (lane == src) {
#pragma unroll
                    for (int j = 0; j < 4; ++j) if (sj == j) cv[j] = -INFINITY;
                }
                if (rr == 0) mx = bv;
                if (lane == rr) { bestv = bv; beste = e; }
            }
            const float ex = lane < 16 ? expf(bestv - mx) : 0.f;
            const float den = wave_sum(ex);
            if (lane < 16) { p.ids[(size_t)m * 128 + hh * 16 + lane] = beste; p.gates[(size_t)m * 128 + hh * 16 + lane] = ex / den; }
        }
    }
    __syncthreads();
}

__device__ __forceinline__ void phase_peer_simple(const Params& p) {
    const int lane = threadIdx.x & 63, gw = blockIdx.x * (NTHREADS / 64) + (threadIdx.x >> 6), GW = gridDim.x * (NTHREADS / 64);
    for (int m = gw; m < M_TOK; m += GW) {
        float* row = p.out + (size_t)m * D_MODEL;
        float4 xr[4], acc[4];
#pragma unroll
        for (int j = 0; j < 4; ++j) { xr[j] = *(const float4*)(row + j * 256 + lane * 4); acc[j] = make_float4(0.f, 0.f, 0.f, 0.f); }
        const int e0 = p.ids[(size_t)m * 128 + lane], e1 = p.ids[(size_t)m * 128 + 64 + lane];
        const float g0 = p.gates[(size_t)m * 128 + lane], g1 = p.gates[(size_t)m * 128 + 64 + lane];
        for (int k = 0; k < 128; ++k) {
            const int e = __shfl(k < 64 ? e0 : e1, k & 63); const float gt = __shfl(k < 64 ? g0 : g1, k & 63);
            const float* ur = p.peer_u + (size_t)e * D_MODEL; const float* vr = p.peer_v + (size_t)e * D_MODEL;
            float d = 0.f; float4 vv[4];
#pragma unroll
            for (int j = 0; j < 4; ++j) { const float4 u4 = *(const float4*)(ur + j * 256 + lane * 4); vv[j] = *(const float4*)(vr + j * 256 + lane * 4);
                d += xr[j].x * u4.x + xr[j].y * u4.y + xr[j].z * u4.z + xr[j].w * u4.w; }
            d = wave_sum(d);
            const float wgt = 0.5f * d * (1.f + erff(d * 0.7071067811865476f)) * gt;
#pragma unroll
            for (int j = 0; j < 4; ++j) { acc[j].x = fmaf(wgt, vv[j].x, acc[j].x); acc[j].y = fmaf(wgt, vv[j].y, acc[j].y); acc[j].z = fmaf(wgt, vv[j].z, acc[j].z); acc[j].w = fmaf(wgt, vv[j].w, acc[j].w); }
        }
        float s = 0.f;
#pragma unroll
        for (int j = 0; j < 4; ++j) { acc[j].x += ALPHA * xr[j].x; acc[j].y += ALPHA * xr[j].y; acc[j].z += ALPHA * xr[j].z; acc[j].w += ALPHA * xr[j].w; s += (acc[j].x + acc[j].y) + (acc[j].z + acc[j].w); }
        const float mean = wave_sum(s) * (1.f / D_MODEL); float q = 0.f;
#pragma unroll
        for (int j = 0; j < 4; ++j) { acc[j].x -= mean; acc[j].y -= mean; acc[j].z -= mean; acc[j].w -= mean; q += (acc[j].x * acc[j].x + acc[j].y * acc[j].y) + (acc[j].z * acc[j].z + acc[j].w * acc[j].w); }
        const float rstd = rsqrtf(wave_sum(q) * (1.f / D_MODEL) + LN_EPS);
#pragma unroll
        for (int j = 0; j < 4; ++j) {
            const float4 g = *(const float4*)(p.ln2_g + j * 256 + lane * 4), bb = *(const float4*)(p.ln2_b + j * 256 + lane * 4);
            *(float4*)(row + j * 256 + lane * 4) = make_float4(acc[j].x * rstd * g.x + bb.x, acc[j].y * rstd * g.y + bb.y, acc[j].z * rstd * g.z + bb.z, acc[j].w * rstd * g.w + bb.w);
        }
    }
}


typedef __bf16 bf16x2_v __attribute__((ext_vector_type(2)));
__device__ __forceinline__ float dot2bf(unsigned a, unsigned b, float c) { return __builtin_amdgcn_fdot2_f32_bf16(__builtin_bit_cast(bf16x2_v, a), __builtin_bit_cast(bf16x2_v, b), c, false); }
__device__ __forceinline__ void cas_d(float& a, float& b) { const float hi = fmaxf(a, b), lo = fminf(a, b); a = hi; b = lo; }
__device__ __forceinline__ void cas_a(float& a, float& b) { const float hi = fmaxf(a, b), lo = fminf(a, b); a = lo; b = hi; }
__device__ __forceinline__ void sort16_desc(f32x16& v) {
#pragma unroll
    for (int k = 2; k <= 16; k <<= 1)
#pragma unroll
        for (int j = k >> 1; j > 0; j >>= 1)
#pragma unroll
            for (int i = 0; i < 16; ++i) {
                const int l = i ^ j;
                if (l > i) { float a = v[i], b = v[l]; if ((i & k) == 0) cas_d(a, b); else cas_a(a, b); v[i] = a; v[l] = b; }
            }
}
__device__ __forceinline__ void bmerge16_desc(f32x16& v) {
#pragma unroll
    for (int j = 8; j > 0; j >>= 1)
#pragma unroll
        for (int i = 0; i < 16; ++i) { const int l = i ^ j; if (l > i) { float a = v[i], b = v[l]; cas_d(a, b); v[i] = a; v[l] = b; } }
}
__device__ __forceinline__ f32x16 merge_top16(const f32x16& a, const f32x16& b) {
    f32x16 c;
#pragma unroll
    for (int i = 0; i < 16; ++i) c[i] = fmaxf(a[i], b[15 - i]);
    bmerge16_desc(c);
    return c;
}
__device__ __forceinline__ void pcas_d(float& va, int& ia, float& vb, int& ib) {
    const bool sw = vb > va; const float tv = sw ? vb : va; const int ti = sw ? ib : ia;
    vb = sw ? va : vb; ib = sw ? ia : ib; va = tv; ia = ti;
}
__device__ __forceinline__ void psort16_desc(float (&v)[16], int (&id)[16]) {
#pragma unroll
    for (int k = 2; k <= 16; k <<= 1)
#pragma unroll
        for (int j = k >> 1; j > 0; j >>= 1)
#pragma unroll
            for (int i = 0; i < 16; ++i) {
                const int l = i ^ j;
                if (l > i) { if ((i & k) == 0) pcas_d(v[i], id[i], v[l], id[l]); else pcas_d(v[l], id[l], v[i], id[i]); }
            }
}
__device__ __forceinline__ void pmerge_top16(float (&a)[16], int (&ia)[16], const float (&b)[16], const int (&ib)[16]) {
#pragma unroll
    for (int i = 0; i < 16; ++i) { const bool sw = b[15 - i] > a[i]; a[i] = sw ? b[15 - i] : a[i]; ia[i] = sw ? ib[15 - i] : ia[i]; }
#pragma unroll
    for (int j = 8; j > 0; j >>= 1)
#pragma unroll
        for (int i = 0; i < 16; ++i) { const int l = i ^ j; if (l > i) pcas_d(a[i], ia[i], a[l], ia[l]); }
}
__device__ __forceinline__ void phase_route(const Params& p, const bf16_t* qb) {
    constexpr int CI[50] = {0,0,0,0,0,0,0,0,0,0,0,0,0,0,0,0,1,1,1,1,1,1,1,1,2,2,2,2,2,3,3,3,3,4,4,4,5,5,6,6,7,7,8,9,10,11,12,13,14,15};
    constexpr int CJ[50] = {0,1,2,3,4,5,6,7,8,9,10,11,12,13,14,15,0,1,2,3,4,5,6,7,0,1,2,3,4,0,1,2,3,0,1,2,0,1,0,1,0,1,0,0,0,0,0,0,0,0};
    const int lane0 = threadIdx.x & 63, gw = blockIdx.x * (NTHREADS / 64) + (threadIdx.x >> 6), GW = gridDim.x * (NTHREADS / 64);
    for (int task = gw; task < (M_TOK / 32) * 8; task += GW) {
        int lane = lane0; asm volatile("" : "+v"(lane));
        const int r = lane & 31, hh = lane >> 5;
        const int h = task & 7, tok0 = (task >> 3) * 32;
        f32x16 top[2];
#pragma unroll
        for (int pp = 0; pp < 2; ++pp) {
            const bf16_t* qrow = qb + (size_t)(tok0 + r) * 2048 + h * 256 + pp * 128 + 8 * hh;
            bf16x8 qf[8];
#pragma unroll
            for (int ks = 0; ks < 8; ++ks) qf[ks] = *(const bf16x8*)(qrow + 16 * ks);
            f32x16 sc[4];
#pragma unroll
            for (int kt = 0; kt < 4; ++kt) {
                const bf16_t* af = p.sk_frag + ((size_t)(((h * 2 + pp) * 4 + kt) * 8) * 64 + lane) * 8;
                bf16x8 a[8];
#pragma unroll
                for (int ks = 0; ks < 8; ++ks) a[ks] = *(const bf16x8*)(af + (size_t)ks * 512);
#pragma unroll
                for (int e = 0; e < 16; ++e) sc[kt][e] = 0.f;
#pragma unroll
                for (int ks = 0; ks < 8; ++ks) sc[kt] = __builtin_amdgcn_mfma_f32_32x32x16_bf16(a[ks], qf[ks], sc[kt], 0, 0, 0);
            }
#pragma unroll
            for (int kt = 0; kt < 4; ++kt) {
#pragma unroll
                for (int e = 0; e < 16; ++e) {
                    const unsigned key = (unsigned)(32 * kt + (e & 3) + 8 * (e >> 2)) + 4u * (unsigned)hh;
                    sc[kt][e] = __uint_as_float((__float_as_uint(sc[kt][e]) & 0xffffff80u) | key);
                }
                sort16_desc(sc[kt]);
            }
            f32x16 m = merge_top16(merge_top16(sc[0], sc[1]), merge_top16(sc[2], sc[3]));
            f32x16 oth;
#pragma unroll
            for (int i = 0; i < 16; ++i) oth[i] = __shfl_xor(m[i], 32);
            top[pp] = merge_top16(m, oth);
        }
        int ia[16], ib[16];
#pragma unroll
        for (int i = 0; i < 16; ++i) { ia[i] = (int)(__float_as_uint(top[0][i]) & 127u); ib[i] = (int)(__float_as_uint(top[1][i]) & 127u); }
        float cv0[16], cv1[16]; int cd0[16], cd1[16];
#pragma unroll
        for (int c = 0; c < 32; ++c) {
            float v = -INFINITY; int id = 0;
            if (c < 25) {
                const float v0 = top[0][CI[2 * c]] + top[1][CJ[2 * c]], v1 = top[0][CI[2 * c + 1]] + top[1][CJ[2 * c + 1]];
                const int d0 = (ia[CI[2 * c]] << 7) | ib[CJ[2 * c]], d1 = (ia[CI[2 * c + 1]] << 7) | ib[CJ[2 * c + 1]];
                v = hh ? v1 : v0; id = hh ? d1 : d0;
            }
            if (c < 16) { cv0[c] = v; cd0[c] = id; } else { cv1[c - 16] = v; cd1[c - 16] = id; }
        }
        psort16_desc(cv0, cd0); psort16_desc(cv1, cd1);
        pmerge_top16(cv0, cd0, cv1, cd1);
        float ov[16]; int od[16];
#pragma unroll
        for (int i = 0; i < 16; ++i) { ov[i] = __shfl_xor(cv0[i], 32); od[i] = __shfl_xor(cd0[i], 32); }
        pmerge_top16(cv0, cd0, ov, od);
        float ex[16], den = 0.f;
#pragma unroll
        for (int i = 0; i < 16; ++i) { ex[i] = __expf(cv0[i] - cv0[0]); den += ex[i]; }
        const float inv = 1.f / den;
        if (hh == 0) {
            int* idp = p.ids + (size_t)(tok0 + r) * 128 + h * 16; float* gp = p.gates + (size_t)(tok0 + r) * 128 + h * 16;
#pragma unroll
            for (int q = 0; q < 4; ++q) {
                *(int4*)(idp + 4 * q) = make_int4(cd0[4 * q], cd0[4 * q + 1], cd0[4 * q + 2], cd0[4 * q + 3]);
                *(float4*)(gp + 4 * q) = make_float4(ex[4 * q] * inv, ex[4 * q + 1] * inv, ex[4 * q + 2] * inv, ex[4 * q + 3] * inv);
            }
        }
    }
}


typedef float f32x2 __attribute__((ext_vector_type(2)));
__device__ __forceinline__ void phase_tables8(const Params& p) {
    const int lane = threadIdx.x & 63, gw = blockIdx.x * (NTHREADS / 64) + (threadIdx.x >> 6), GW = gridDim.x * (NTHREADS / 64);
    for (int row = gw; row < 2 * 16384; row += GW) {
        const int table = row >> 14, e = row & 16383;
        const float* src = (table ? p.peer_v : p.peer_u) + (size_t)e * 1024 + lane * 16;
        float v[16];
#pragma unroll
        for (int q = 0; q < 4; ++q) { const float4 a = *(const float4*)(src + 4 * q); v[4 * q] = a.x; v[4 * q + 1] = a.y; v[4 * q + 2] = a.z; v[4 * q + 3] = a.w; }
        float am = 0.f;
#pragma unroll
        for (int c = 0; c < 16; ++c) am = fmaxf(am, fabsf(v[c]));
        am = wave_max(am);
        float sc = am > 0.f ? exp2f(floorf(log2f(448.f / am))) : 1.f;
        if (am * sc > 448.f) sc *= 0.5f;
        u32x4 o;
        int w;
        w = 0; w = __builtin_amdgcn_cvt_pk_fp8_f32(v[0] * sc, v[1] * sc, w, false); w = __builtin_amdgcn_cvt_pk_fp8_f32(v[2] * sc, v[3] * sc, w, true); o.x = (unsigned)w;
        w = 0; w = __builtin_amdgcn_cvt_pk_fp8_f32(v[4] * sc, v[5] * sc, w, false); w = __builtin_amdgcn_cvt_pk_fp8_f32(v[6] * sc, v[7] * sc, w, true); o.y = (unsigned)w;
        w = 0; w = __builtin_amdgcn_cvt_pk_fp8_f32(v[8] * sc, v[9] * sc, w, false); w = __builtin_amdgcn_cvt_pk_fp8_f32(v[10] * sc, v[11] * sc, w, true); o.z = (unsigned)w;
        w = 0; w = __builtin_amdgcn_cvt_pk_fp8_f32(v[12] * sc, v[13] * sc, w, false); w = __builtin_amdgcn_cvt_pk_fp8_f32(v[14] * sc, v[15] * sc, w, true); o.w = (unsigned)w;
        *(u32x4*)(p.tab8 + ((size_t)((table * 8 + (lane >> 3)) * 16384 + e)) * 128 + (lane & 7) * 16) = o;
        if (lane == 0) p.isc[row] = 1.f / sc;
    }
}
__device__ __forceinline__ void phase_peer_u(const Params& p, const bf16_t* x1b, float* ph) {
    const int lane0 = threadIdx.x & 63, wave = threadIdx.x >> 6;
    const int x = blockIdx.x & 7, nloc = (gridDim.x - x + 7) >> 3, wl = (blockIdx.x >> 3) * (NTHREADS / 64) + wave, NW = nloc * (NTHREADS / 64);
    const unsigned char* tab = p.tab8 + (size_t)x * 16384 * 128;
    for (int t = wl; t < M_TOK; t += NW) {
        int lane = lane0; asm volatile("" : "+v"(lane));
        const int j = lane & 7, g = lane >> 3;
        const bf16_t* xs = x1b + (size_t)t * 1024 + 128 * x + 16 * j;
        const u32x4 xa = *(const u32x4*)xs, xb = *(const u32x4*)(xs + 8);
        const float xf[16] = {bflo(xa.x), bfhi(xa.x), bflo(xa.y), bfhi(xa.y), bflo(xa.z), bfhi(xa.z), bflo(xa.w), bfhi(xa.w),
                              bflo(xb.x), bfhi(xb.x), bflo(xb.y), bfhi(xb.y), bflo(xb.z), bfhi(xb.z), bflo(xb.w), bfhi(xb.w)};
        const int id0 = p.ids[(size_t)t * 128 + lane], id1 = p.ids[(size_t)t * 128 + 64 + lane];
        u32x4 rows[16];
#pragma unroll
        for (int i = 0; i < 16; ++i) {
            const int e = __shfl(i < 8 ? id0 : id1, (8 * i + g) & 63);
            rows[i] = *(const u32x4*)(tab + (size_t)e * 128 + j * 16);
        }
        float res[16];
#pragma unroll
        for (int i = 0; i < 16; ++i) {
            const unsigned dw[4] = {rows[i].x, rows[i].y, rows[i].z, rows[i].w};
            float d = 0.f;
#pragma unroll
            for (int q = 0; q < 4; ++q) {
                const f32x2 lo = __builtin_amdgcn_cvt_pk_f32_fp8((int)dw[q], false), hi = __builtin_amdgcn_cvt_pk_f32_fp8((int)dw[q], true);
                d = fmaf(lo.x, xf[4 * q], d); d = fmaf(lo.y, xf[4 * q + 1], d); d = fmaf(hi.x, xf[4 * q + 2], d); d = fmaf(hi.y, xf[4 * q + 3], d);
            }
            d += __shfl_xor(d, 1); d += __shfl_xor(d, 2); d += __shfl_xor(d, 4);
            res[i] = d;
        }
        float r0 = res[0], r1 = res[1];
#pragma unroll
        for (int jj = 1; jj < 8; ++jj) { r0 = (j == jj) ? res[2 * jj] : r0; r1 = (j == jj) ? res[2 * jj + 1] : r1; }
        float* dst = ph + ((size_t)x * M_TOK + t) * 128 + 16 * j + g;
        dst[0] = r0; dst[8] = r1;
    }
}
__device__ __forceinline__ void phase_peer_w(const Params& p, const float* ph, float* wbuf) {
    const size_t gt = (size_t)blockIdx.x * NTHREADS + threadIdx.x, GT = (size_t)gridDim.x * NTHREADS;
    for (size_t idx = gt; idx < (size_t)M_TOK * 128; idx += GT) {
        const int e = p.ids[idx];
        float h = 0.f;
#pragma unroll
        for (int x = 0; x < 8; ++x) h += ph[(size_t)x * M_TOK * 128 + idx];
        h *= p.isc[e];
        wbuf[idx] = 0.5f * h * (1.f + erff(h * 0.7071067811865476f)) * p.gates[idx] * p.isc[16384 + e];
    }
}
__device__ __forceinline__ void phase_peer_v(const Params& p, const float* wbuf, float* ffn) {
    const int lane0 = threadIdx.x & 63, wave = threadIdx.x >> 6;
    const int x = blockIdx.x & 7, nloc = (gridDim.x - x + 7) >> 3, wl = (blockIdx.x >> 3) * (NTHREADS / 64) + wave, NW = nloc * (NTHREADS / 64);
    const unsigned char* tab = p.tab8 + (size_t)(8 + x) * 16384 * 128;
    for (int t = wl; t < M_TOK; t += NW) {
        int lane = lane0; asm volatile("" : "+v"(lane));
        const int j = lane & 7, g = lane >> 3;
        const int id0 = p.ids[(size_t)t * 128 + lane], id1 = p.ids[(size_t)t * 128 + 64 + lane];
        const float w0 = wbuf[(size_t)t * 128 + lane], w1 = wbuf[(size_t)t * 128 + 64 + lane];
        u32x4 rows[16];
#pragma unroll
        for (int i = 0; i < 16; ++i) {
            const int e = __shfl(i < 8 ? id0 : id1, (8 * i + g) & 63);
            rows[i] = *(const u32x4*)(tab + (size_t)e * 128 + j * 16);
        }
        float acc[16];
#pragma unroll
        for (int c = 0; c < 16; ++c) acc[c] = 0.f;
#pragma unroll
        for (int i = 0; i < 16; ++i) {
            const float wi = __shfl(i < 8 ? w0 : w1, (8 * i + g) & 63);
            const unsigned dw[4] = {rows[i].x, rows[i].y, rows[i].z, rows[i].w};
#pragma unroll
            for (int q = 0; q < 4; ++q) {
                const f32x2 lo = __builtin_amdgcn_cvt_pk_f32_fp8((int)dw[q], false), hi = __builtin_amdgcn_cvt_pk_f32_fp8((int)dw[q], true);
                acc[4 * q] = fmaf(wi, lo.x, acc[4 * q]); acc[4 * q + 1] = fmaf(wi, lo.y, acc[4 * q + 1]); acc[4 * q + 2] = fmaf(wi, hi.x, acc[4 * q + 2]); acc[4 * q + 3] = fmaf(wi, hi.y, acc[4 * q + 3]);
            }
        }
#pragma unroll
        for (int c = 0; c < 16; ++c) { acc[c] += __shfl_xor(acc[c], 8); acc[c] += __shfl_xor(acc[c], 16); acc[c] += __shfl_xor(acc[c], 32); }
        if (lane < 8) {
            float* dst = ffn + (size_t)t * 1024 + 128 * x + 16 * lane;
#pragma unroll
            for (int q = 0; q < 4; ++q) *(float4*)(dst + 4 * q) = make_float4(acc[4 * q], acc[4 * q + 1], acc[4 * q + 2], acc[4 * q + 3]);
        }
    }
}
__device__ __forceinline__ void phase_ln2(const Params& p, const float* ffn) {
    const int lane = threadIdx.x & 63, gw = blockIdx.x * (NTHREADS / 64) + (threadIdx.x >> 6), GW = gridDim.x * (NTHREADS / 64);
    for (int m = gw; m < M_TOK; m += GW) {
        float* row = p.out + (size_t)m * D_MODEL; const float* fr = ffn + (size_t)m * D_MODEL;
        float4 v[4]; float s = 0.f;
#pragma unroll
        for (int j = 0; j < 4; ++j) { const float4 a = *(const float4*)(row + j * 256 + lane * 4), f = *(const float4*)(fr + j * 256 + lane * 4);
            v[j] = make_float4(ALPHA * a.x + f.x, ALPHA * a.y + f.y, ALPHA * a.z + f.z, ALPHA * a.w + f.w); s += (v[j].x + v[j].y) + (v[j].z + v[j].w); }
        const float mean = wave_sum(s) * (1.f / D_MODEL); float q = 0.f;
#pragma unroll
        for (int j = 0; j < 4; ++j) { v[j].x -= mean; v[j].y -= mean; v[j].z -= mean; v[j].w -= mean; q += (v[j].x * v[j].x + v[j].y * v[j].y) + (v[j].z * v[j].z + v[j].w * v[j].w); }
        const float rstd = rsqrtf(wave_sum(q) * (1.f / D_MODEL) + LN_EPS);
#pragma unroll
        for (int j = 0; j < 4; ++j) {
            const float4 g = *(const float4*)(p.ln2_g + j * 256 + lane * 4), bb = *(const float4*)(p.ln2_b + j * 256 + lane * 4);
            *(float4*)(row + j * 256 + lane * 4) = make_float4(v[j].x * rstd * g.x + bb.x, v[j].y * rstd * g.y + bb.y, v[j].z * rstd * g.z + bb.z, v[j].w * rstd * g.w + bb.w);
        }
    }
}

constexpr int N_PHASES = 13;
__global__ void __launch_bounds__(NTHREADS) mega_fwd(Params p) {
    __shared__ __attribute__((aligned(16))) unsigned char smem[SMEM_BYTES];
    __shared__ uint4 xb_words;
    if (threadIdx.x == 0) xb_words = make_uint4(0u, 0u, 0u, 0u);
    __syncthreads();
    XcdBarrier bar; bar.bar = p.bar; bar.x = 0; bar.st = (volatile LAS unsigned*)&xb_words;
    if (p.ph_hi - p.ph_lo > 1) bar = xcd_barrier_post(p.bar, (volatile LAS unsigned*)&xb_words);
    bf16_t* qb = p.proj_b;
    bf16_t* x1b = p.proj_b + (size_t)M_TOK * 2048;
#define PH(k) (p.ph_lo <= (k) && (k) < p.ph_hi)
#define SYNC(k) do { if (PH(k) && PH((k) + 1)) xcd_barrier(bar); } while (0)
    if (PH(0)) phase_prep(p, smem);
    SYNC(0);
    if (PH(1)) { EpiInProj e{p.proj_b, p.rope_cs}; gemm_phase(p.xb, p.wt_in, M_TOK, NP_IN, e, smem); }
    SYNC(1);
    if (PH(2)) phase_dn_prep(p, smem);
    SYNC(2);
    if (PH(3)) { if (blockIdx.x < 16) phase_dn_scan(p, smem); else phase_attn(p, smem, 16); }
    SYNC(3);
    if (PH(4)) { phase_dn_norm(p); phase_tables8(p); }
    SYNC(4);
    if (PH(5)) { EpiOutProj e{p.out, p.x}; gemm_phase(p.xb, p.wt_out, M_TOK, 1024, e, smem); }
    SYNC(5);
    if (PH(6)) phase_ln1(p, x1b);
    SYNC(6);
    if (PH(7)) { EpiBf16 e{qb, 2048}; gemm_phase(x1b, p.wt_q, M_TOK, 2048, e, smem); }
    SYNC(7);
    if (PH(8)) phase_route(p, qb);
    SYNC(8);
    float* ph = (float*)qb;
    if (PH(9)) phase_peer_u(p, x1b, ph);
    SYNC(9);
    if (PH(10)) phase_peer_w(p, ph, p.wbuf);
    SYNC(10);
    if (PH(11)) phase_peer_v(p, p.wbuf, ph);
    SYNC(11);
    if (PH(12)) phase_ln2(p, ph);
#undef PH
#undef SYNC
}
}

#ifndef MK_LAUNCHES
#define MK_LAUNCHES 1
#endif

extern "C" void kernel_launch(void* const* d_in, const int* in_sizes, int n_in, void* d_out, int out_size, void* d_ws, size_t ws_size, hipStream_t stream) {
    static int grid_blocks = 0;
    if (!grid_blocks) {
        int dev = 0, cus = 0, per_cu = 0;
        (void)hipGetDevice(&dev);
        (void)hipDeviceGetAttribute(&cus, hipDeviceAttributeMultiprocessorCount, dev);
        (void)hipOccupancyMaxActiveBlocksPerMultiprocessor(&per_cu, mega_fwd, NTHREADS, 0);
        if (per_cu < 1) { fprintf(stderr, "kernel_launch: occupancy query reports %d blocks per CU\n", per_cu); per_cu = 1; }
        grid_blocks = cus * 1;
        (void)hipGetLastError();
    }
    Params p{};
    p.x = (const float*)d_in[0]; p.positions = (const int*)d_in[1]; p.w_in = (const float*)d_in[2]; p.sinks = (const float*)d_in[3];
    p.conv_w = (const float*)d_in[4]; p.a_log = (const float*)d_in[5]; p.dt_bias = (const float*)d_in[6]; p.dn_norm_g = (const float*)d_in[7];
    p.w_out = (const float*)d_in[8]; p.ln1_g = (const float*)d_in[9]; p.ln1_b = (const float*)d_in[10]; p.w_query = (const float*)d_in[11];
    p.sub_keys = (const float*)d_in[12]; p.peer_u = (const float*)d_in[13]; p.peer_v = (const float*)d_in[14]; p.ln2_g = (const float*)d_in[15]; p.ln2_b = (const float*)d_in[16];
    p.out = (float*)d_out;
    char* ws = (char*)d_ws; size_t off = 0;
    auto take = [&](size_t bytes) { char* r = ws + off; off += (bytes + 255) & ~(size_t)255; return r; };
    p.xb = (bf16_t*)take((size_t)M_TOK * 1024 * 2);
    p.proj_b = (bf16_t*)take((size_t)M_TOK * NP_IN * 2);
    p.odn_raw = (float*)d_out;
    {
        char* dn = take((size_t)2048 * (16384 * 3 + 8192 + 32768) + 8192);
        p.ids = (int*)dn; p.gates = (float*)(dn + (size_t)M_TOK * 128 * 4);
        p.tab8 = (unsigned char*)(dn + (size_t)M_TOK * 128 * 8);
        p.wbuf = (float*)(dn + (size_t)M_TOK * 128 * 8 + (size_t)32 * 1024 * 1024); p.isc = (float*)(dn + (size_t)M_TOK * 128 * 8 + (size_t)48 * 1024 * 1024);
        p.dn_negw = (bf16_t*)dn; p.dn_qd = (bf16_t*)(dn + (size_t)2048 * 16384); p.dn_kdt = (bf16_t*)(dn + (size_t)2048 * 16384 * 2);
        p.dn_qk = (bf16_t*)(dn + (size_t)2048 * 16384 * 3); p.dn_u = (float*)(dn + (size_t)2048 * (16384 * 3 + 8192)); p.dn_gl = (float*)(dn + (size_t)2048 * (16384 * 3 + 8192 + 32768));
    }
    p.wt_in = (bf16_t*)take((size_t)NP_IN * 1024 * 2);
    p.wt_out = (bf16_t*)take((size_t)1024 * 1024 * 2);
    p.wt_q = (bf16_t*)take((size_t)2048 * 1024 * 2);
    p.rope_cs = (float*)take((size_t)M_TOK * 64 * 4);
    p.sk_frag = (bf16_t*)take((size_t)16 * 128 * 128 * 2);
    p.bar = (unsigned*)take((size_t)XCD_BAR_WORDS * 4);
    if (off > ws_size) { fprintf(stderr, "kernel_launch: workspace too small (%zu < %zu)\n", ws_size, off); return; }
    if (hipMemsetAsync(p.bar, 0, (size_t)XCD_BAR_WORDS * 4, stream) != hipSuccess) { fprintf(stderr, "kernel_launch: memset of barrier words failed\n"); return; }
#if MK_LAUNCHES == 1
    p.ph_lo = 0; p.ph_hi = N_PHASES;
    void* args[] = {&p};
    hipError_t e = hipLaunchCooperativeKernel((void*)mega_fwd, dim3(grid_blocks), dim3(NTHREADS), args, 0, stream);
    if (e != hipSuccess) fprintf(stderr, "cooperative launch failed: %s (grid %d)\n", hipGetErrorString(e), grid_blocks);
#else
    for (int k = 0; k < N_PHASES; ++k) { p.ph_lo = k; p.ph_hi = k + 1; hipLaunchKernelGGL(mega_fwd, dim3(grid_blocks), dim3(NTHREADS), 0, stream, p); }
#endif
}
```

```cpp
#include <hip/hip_runtime.h>
#include <cstdio>
#include <cstdint>
#include <math.h>

namespace {
constexpr int D_MODEL = 1024, BATCH = 4, SEQ = 8192, M_TOK = BATCH * SEQ;
constexpr int IN_WIDTH = 2824, NP_IN = 3072;
constexpr int P_AQ = 0, P_AK = 512, P_AV = 640, P_DQ = 768, P_DK = 1280, P_DV = 1792, P_Z = 2304, P_B = 2816, P_A = 2820;
constexpr float ALPHA = 1.189207115002721f;
constexpr float LN_EPS = 1e-5f, RMS_EPS = 1e-6f, L2_EPS = 1e-6f;
constexpr int NTHREADS = 512;

typedef unsigned short bf16_t;
typedef short bf16x8 __attribute__((ext_vector_type(8)));
typedef float f32x16 __attribute__((ext_vector_type(16)));
typedef float f32x4 __attribute__((ext_vector_type(4)));
typedef unsigned u32x4 __attribute__((ext_vector_type(4)));
typedef unsigned u32x2 __attribute__((ext_vector_type(2)));

struct Params {
    const float* x; const int* positions; const float* w_in; const float* sinks; const float* conv_w; const float* a_log; const float* dt_bias;
    const float* dn_norm_g; const float* w_out; const float* ln1_g; const float* ln1_b; const float* w_query; const float* sub_keys;
    const float* peer_u; const float* peer_v; const float* ln2_g; const float* ln2_b;
    float* out;
    bf16_t* xb;
    bf16_t* proj_b;
    float* odn_raw;
    int* ids; float* gates;
    bf16_t* wt_in; bf16_t* wt_out; bf16_t* wt_q;
    float* rope_cs;
    bf16_t* dn_negw; bf16_t* dn_qd; bf16_t* dn_kdt; bf16_t* dn_qk; float* dn_u; float* dn_gl;
    bf16_t* sk_frag;
    unsigned char* tab8; float* isc; float* wbuf;
    unsigned* bar;
    int ph_lo, ph_hi;
};

__device__ __forceinline__ float wave_sum(float v) {
#pragma unroll
    for (int o = 1; o < 64; o <<= 1) v += __shfl_xor(v, o);
    return v;
}
__device__ __forceinline__ float wave_max(float v) {
#pragma unroll
    for (int o = 1; o < 64; o <<= 1) v = fmaxf(v, __shfl_xor(v, o));
    return v;
}
__device__ __forceinline__ float bf2f(bf16_t u) { return __uint_as_float((unsigned)u << 16); }
__device__ __forceinline__ float bflo(unsigned u) { return __uint_as_float(u << 16); }
__device__ __forceinline__ float bfhi(unsigned u) { return __uint_as_float(u & 0xffff0000u); }
typedef __bf16 bf16x2_n __attribute__((ext_vector_type(2)));
__device__ __forceinline__ unsigned pk_bf16(float lo, float hi) { bf16x2_n v; v.x = (__bf16)lo; v.y = (__bf16)hi; return __builtin_bit_cast(unsigned, v); }
__device__ __forceinline__ float silu_f(float y) { return y / (1.f + __expf(-y)); }


#define XB_TMO      128
#define XB_XCNT(j)  (256  + 64 * (j))
#define XB_XSUB(j)  (1280 + 64 * (j))
#define XB_XGEN(j)  (2304 + 64 * (j))
#define XB_TOP      3328
#define XB_TOPGEN   3392
#define XCD_BAR_WORDS 3456
#define XB_SPIN_CAP (1u << 27)
#define LAS __attribute__((address_space(3)))
__device__ __forceinline__ unsigned xb_ld(unsigned* p)              { return __hip_atomic_load(p, __ATOMIC_RELAXED, __HIP_MEMORY_SCOPE_AGENT); }
__device__ __forceinline__ unsigned xb_add(unsigned* p, unsigned v) { return __hip_atomic_fetch_add(p, v, __ATOMIC_RELAXED, __HIP_MEMORY_SCOPE_AGENT); }
__device__ __forceinline__ unsigned xb_xcc_id() { return (unsigned)__builtin_amdgcn_s_getreg((3 << 11) | 20) & 0xFu; }
#define XB_SPIN(cond, bar) do { unsigned _sp = 0; while (cond) { __builtin_amdgcn_s_sleep(1); \
    if ((++_sp & 255u) == 0u) { if (xb_ld(&(bar)[XB_TMO])) break; if (_sp > XB_SPIN_CAP) { atomicAdd(&(bar)[XB_TMO], 1u); break; } } } } while (0)
struct XcdBarrier { unsigned* bar; unsigned x; volatile LAS unsigned* st; };
__device__ __forceinline__ XcdBarrier xcd_barrier_post(unsigned* bar, volatile LAS unsigned* st) {
    XcdBarrier b; b.bar = bar; b.x = xb_xcc_id(); b.st = st;
    if (threadIdx.x == 0) (void)xb_add(&bar[XB_XCNT(b.x)], 1u);
    return b;
}
__device__ __forceinline__ void xcd_barrier_complete(unsigned* bar, unsigned x, unsigned& nloc, unsigned& nx) {
    const unsigned G = gridDim.x * gridDim.y * gridDim.z;
    unsigned sum, cnt, mine, sp = 0u;
    for (;;) {
        sum = 0u; cnt = 0u; mine = 0u;
#pragma unroll
        for (unsigned j = 0; j < 16; ++j) { const unsigned c = xb_ld(&bar[XB_XCNT(j)]); sum += c; cnt += (c > 0u) ? 1u : 0u; mine = (j == x) ? c : mine; }
        if (sum == G) break;
        __builtin_amdgcn_s_sleep(1);
        if ((++sp & 255u) == 0u) { if (xb_ld(&bar[XB_TMO])) break; if (sp > XB_SPIN_CAP) { atomicAdd(&bar[XB_TMO], 1u); break; } }
    }
    nloc = mine > 0u ? mine : 1u; nx = cnt > 0u ? cnt : 1u;
}
__device__ __forceinline__ void xcd_barrier(const XcdBarrier& b) {
    asm volatile("s_waitcnt vmcnt(0)" ::: "memory");
    __syncthreads();
    if (threadIdx.x == 0) {
        unsigned* bar = b.bar;
        __builtin_amdgcn_s_waitcnt(0);
        unsigned nloc = b.st[0], nx = b.st[1];
        if (nloc == 0u) { xcd_barrier_complete(bar, b.x, nloc, nx); b.st[0] = nloc; b.st[1] = nx; }
        const unsigned old = xb_add(&bar[XB_XSUB(b.x)], 1u);
        const unsigned gen = old / nloc;
        if (old + 1u == (gen + 1u) * nloc) {
            __builtin_amdgcn_fence(__ATOMIC_RELEASE, "agent");
            asm volatile("s_waitcnt vmcnt(0)" ::: "memory");
            const unsigned og = xb_add(&bar[XB_TOP], 1u);
            const unsigned tg = og / nx;
            if (og + 1u == (tg + 1u) * nx) xb_add(&bar[XB_TOPGEN], 1u);
            else XB_SPIN(xb_ld(&bar[XB_TOPGEN]) == tg, bar);
            __builtin_amdgcn_fence(__ATOMIC_ACQUIRE, "agent");
            xb_add(&bar[XB_XGEN(b.x)], 1u);
            asm volatile("s_waitcnt vmcnt(0)" ::: "memory");
        } else {
            XB_SPIN(xb_ld(&bar[XB_XGEN(b.x)]) == gen, bar);
            __builtin_amdgcn_fence(__ATOMIC_ACQUIRE, "agent");
            asm volatile("s_waitcnt vmcnt(0)" ::: "memory");
        }
    }
    __syncthreads();
}

__device__ __forceinline__ int inproj_old_col(int n) {
    if (n < 2304) return n;
    if (n < 2816) return 2312 + (n - 2304);
    if (n < 2824) return 2304 + (n - 2816);
    return -1;
}
__device__ __forceinline__ void transpose_item(const float* __restrict__ W, int N_src, bf16_t* __restrict__ WT, int K, int kb, int nb, bool permute, float* scr) {
    const int tid = threadIdx.x;
    const int nn = tid & 63, k8 = tid >> 6;
    const int n = nb * 64 + nn;
    const int oc = permute ? inproj_old_col(n) : n;
#pragma unroll
    for (int i = 0; i < 8; ++i) { const int kk = k8 + 8 * i; scr[kk * 65 + nn] = (oc >= 0) ? W[(size_t)(kb * 64 + kk) * N_src + oc] : 0.f; }
    __syncthreads();
    const int n2 = tid >> 3, c = tid & 7;
    const float* s = scr + (c * 8) * 65 + n2;
    u32x4 o; o.x = pk_bf16(s[0], s[65]); o.y = pk_bf16(s[2 * 65], s[3 * 65]); o.z = pk_bf16(s[4 * 65], s[5 * 65]); o.w = pk_bf16(s[6 * 65], s[7 * 65]);
    *(u32x4*)(WT + (size_t)(nb * 64 + n2) * K + kb * 64 + c * 8) = o;
    __syncthreads();
}
__device__ __forceinline__ void phase_prep(const Params& p, unsigned char* smem) {
    const int tid = threadIdx.x, G = gridDim.x, bid = blockIdx.x;
    float* scr = (float*)smem;
    constexpr int I_IN = 16 * (NP_IN / 64), I_OUT = 16 * 16, I_Q = 16 * 32;
    for (int it = bid; it < I_IN + I_OUT + I_Q; it += G) {
        int r = it;
        if (r < I_IN) { transpose_item(p.w_in, IN_WIDTH, p.wt_in, 1024, r / (NP_IN / 64), r % (NP_IN / 64), true, scr); continue; } r -= I_IN;
        if (r < I_OUT) { transpose_item(p.w_out, 1024, p.wt_out, 1024, r / 16, r % 16, false, scr); continue; } r -= I_OUT;
        transpose_item(p.w_query, 2048, p.wt_q, 1024, r / 32, r % 32, false, scr);
    }
    const size_t gt = (size_t)bid * NTHREADS + tid, GT = (size_t)G * NTHREADS;
    for (size_t i = gt; i < (size_t)M_TOK * 1024 / 8; i += GT) {
        const float4 a = *(const float4*)(p.x + i * 8), b = *(const float4*)(p.x + i * 8 + 4);
        u32x4 o; o.x = pk_bf16(a.x, a.y); o.y = pk_bf16(a.z, a.w); o.z = pk_bf16(b.x, b.y); o.w = pk_bf16(b.z, b.w);
        *(u32x4*)(p.xb + i * 8) = o;
    }
    for (size_t i = gt; i < (size_t)16 * 4 * 8 * 64; i += GT) {
        const int ln = (int)(i & 63), ks = (int)((i >> 6) & 7), kt = (int)((i >> 9) & 3), hp = (int)(i >> 11);
        const float* src = p.sub_keys + ((size_t)(hp * 128 + 32 * kt + (ln & 31))) * 128 + 16 * ks + 8 * (ln >> 5);
        const float4 a = *(const float4*)src, b = *(const float4*)(src + 4);
        u32x4 o; o.x = pk_bf16(a.x, a.y); o.y = pk_bf16(a.z, a.w); o.z = pk_bf16(b.x, b.y); o.w = pk_bf16(b.z, b.w);
        *(u32x4*)(p.sk_frag + i * 8) = o;
    }
    for (size_t i = gt; i < (size_t)M_TOK * 32; i += GT) {
        const int m = (int)(i >> 5), j = (int)(i & 31);
        const float inv_freq = powf(10000.0f, -(float)j / 32.0f);
        const float ang = (float)p.positions[m] * inv_freq;
        p.rope_cs[i] = cosf(ang); p.rope_cs[(size_t)M_TOK * 32 + i] = sinf(ang);
    }
}

constexpr int GK = 1024, GBK = 64, G_TILE_BYTES = 256 * 128;
constexpr int STG_STRIDE = 260;
constexpr int SMEM_BYTES = 133120;

__device__ __forceinline__ int swz(int row, int chunk) { return row * 128 + ((chunk ^ ((row >> 1) & 7)) << 4); }

struct EpiInProj {
    bf16_t* out; const float* cs;
    __device__ __forceinline__ void operator()(int m, int pn, int c8, const unsigned char* stg_row) const {
        const int col = pn * 256 + c8 * 8;
        u32x2 a0 = *(const u32x2*)(stg_row + c8 * 16), a1 = *(const u32x2*)(stg_row + c8 * 16 + 8);
        u32x4 o; o.x = a0.x; o.y = a0.y; o.z = a1.x; o.w = a1.y;
        if (col < P_AV) {
            const int d0 = col & 63, i0 = d0 & 31; const bool second = d0 >= 32;
            const int pc8 = second ? c8 - 4 : c8 + 4;
            const u32x2 b0 = *(const u32x2*)(stg_row + pc8 * 16), b1 = *(const u32x2*)(stg_row + pc8 * 16 + 8);
            const unsigned mine[4] = {a0.x, a0.y, a1.x, a1.y}, oth[4] = {b0.x, b0.y, b1.x, b1.y};
            const float* cp = cs + (size_t)m * 32 + i0; const float* sp = cs + (size_t)M_TOK * 32 + (size_t)m * 32 + i0;
            const float4 c0 = *(const float4*)cp, c1 = *(const float4*)(cp + 4), s0 = *(const float4*)sp, s1 = *(const float4*)(sp + 4);
            const float cc[8] = {c0.x, c0.y, c0.z, c0.w, c1.x, c1.y, c1.z, c1.w}, ss[8] = {s0.x, s0.y, s0.z, s0.w, s1.x, s1.y, s1.z, s1.w};
            const float scale = col < P_AK ? 0.125f : 1.f;
            float r[8];
#pragma unroll
            for (int j = 0; j < 8; ++j) {
                const float me = (j & 1) ? bfhi(mine[j >> 1]) : bflo(mine[j >> 1]);
                const float ot = (j & 1) ? bfhi(oth[j >> 1]) : bflo(oth[j >> 1]);
                r[j] = (second ? (me * cc[j] + ot * ss[j]) : (me * cc[j] - ot * ss[j])) * scale;
            }
            o.x = pk_bf16(r[0], r[1]); o.y = pk_bf16(r[2], r[3]); o.z = pk_bf16(r[4], r[5]); o.w = pk_bf16(r[6], r[7]);
        }
        *(u32x4*)(out + (size_t)m * NP_IN + col) = o;
    }
};
struct EpiOutProj {
    float* y; const float* x;
    __device__ __forceinline__ void operator()(int m, int pn, int c8, const unsigned char* stg_row) const {
        const int col = pn * 256 + c8 * 8;
        const u32x2 a0 = *(const u32x2*)(stg_row + c8 * 16), a1 = *(const u32x2*)(stg_row + c8 * 16 + 8);
        const float4 x0 = *(const float4*)(x + (size_t)m * 1024 + col), x1 = *(const float4*)(x + (size_t)m * 1024 + col + 4);
        *(float4*)(y + (size_t)m * 1024 + col) = make_float4(ALPHA * x0.x + bflo(a0.x), ALPHA * x0.y + bfhi(a0.x), ALPHA * x0.z + bflo(a0.y), ALPHA * x0.w + bfhi(a0.y));
        *(float4*)(y + (size_t)m * 1024 + col + 4) = make_float4(ALPHA * x1.x + bflo(a1.x), ALPHA * x1.y + bfhi(a1.x), ALPHA * x1.z + bflo(a1.y), ALPHA * x1.w + bfhi(a1.y));
    }
};
struct EpiBf16 {
    bf16_t* out; int ldc;
    __device__ __forceinline__ void operator()(int m, int pn, int c8, const unsigned char* stg_row) const {
        const int col = pn * 256 + c8 * 8;
        const u32x2 a0 = *(const u32x2*)(stg_row + c8 * 16), a1 = *(const u32x2*)(stg_row + c8 * 16 + 8);
        u32x4 o; o.x = a0.x; o.y = a0.y; o.z = a1.x; o.w = a1.y;
        *(u32x4*)(out + (size_t)m * ldc + col) = o;
    }
};

template <class EPI>
__device__ __forceinline__ void gemm_phase(const bf16_t* __restrict__ A, const bf16_t* __restrict__ Bt, int M, int N, const EPI& epi, unsigned char* smem) {
    const int tid = threadIdx.x, lane = tid & 63, wave = tid >> 6, r = lane & 31, h = lane >> 5;
    const int wm = wave >> 2, wn = wave & 3;
    const int nM = M / 256, nN = N / 256, ntiles = nM * nN;
    for (int t = blockIdx.x; t < ntiles; t += gridDim.x) {
        const int pm = t / nN, pn = t % nN;
        const bf16_t* Ag = A + (size_t)pm * 256 * GK; const bf16_t* Bg = Bt + (size_t)pn * 256 * GK;
        f32x16 acc[2][4];
#pragma unroll
        for (int j = 0; j < 2; ++j)
#pragma unroll
            for (int i = 0; i < 4; ++i)
#pragma unroll
                for (int e = 0; e < 16; ++e) acc[j][i][e] = 0.f;
        u32x4 sa[4], sb[4];
        const int lrow = tid >> 3, lch = tid & 7;
#pragma unroll
        for (int i = 0; i < 4; ++i) { sa[i] = *(const u32x4*)(Ag + (size_t)(lrow + 64 * i) * GK + lch * 8); sb[i] = *(const u32x4*)(Bg + (size_t)(lrow + 64 * i) * GK + lch * 8); }
        __syncthreads();
#pragma unroll
        for (int i = 0; i < 4; ++i) { *(u32x4*)(smem + swz(lrow + 64 * i, lch)) = sa[i]; *(u32x4*)(smem + G_TILE_BYTES + swz(lrow + 64 * i, lch)) = sb[i]; }
        __syncthreads();
        int cur = 0;
        for (int kt = 0; kt < GK / GBK; ++kt) {
            if (kt + 1 < GK / GBK) {
                const int k0 = (kt + 1) * GBK;
#pragma unroll
                for (int i = 0; i < 4; ++i) { sa[i] = *(const u32x4*)(Ag + (size_t)(lrow + 64 * i) * GK + k0 + lch * 8); sb[i] = *(const u32x4*)(Bg + (size_t)(lrow + 64 * i) * GK + k0 + lch * 8); }
            }
            const unsigned char* la = smem + cur * 2 * G_TILE_BYTES; const unsigned char* lb = la + G_TILE_BYTES;
#pragma unroll
            for (int ks = 0; ks < 4; ++ks) {
                bf16x8 af[4], bf[2];
#pragma unroll
                for (int i = 0; i < 4; ++i) af[i] = *(const bf16x8*)(la + swz(wm * 128 + i * 32 + r, ks * 2 + h));
#pragma unroll
                for (int j = 0; j < 2; ++j) bf[j] = *(const bf16x8*)(lb + swz(wn * 64 + j * 32 + r, ks * 2 + h));
#pragma unroll
                for (int j = 0; j < 2; ++j)
#pragma unroll
                    for (int i = 0; i < 4; ++i) acc[j][i] = __builtin_amdgcn_mfma_f32_32x32x16_bf16(bf[j], af[i], acc[j][i], 0, 0, 0);
            }
            if (kt + 1 < GK / GBK) {
                unsigned char* na = smem + (cur ^ 1) * 2 * G_TILE_BYTES;
#pragma unroll
                for (int i = 0; i < 4; ++i) { *(u32x4*)(na + swz(lrow + 64 * i, lch)) = sa[i]; *(u32x4*)(na + G_TILE_BYTES + swz(lrow + 64 * i, lch)) = sb[i]; }
            }
            __syncthreads();
            cur ^= 1;
        }
#pragma unroll
        for (int j = 0; j < 2; ++j)
#pragma unroll
            for (int i = 0; i < 4; ++i)
#pragma unroll
                for (int g = 0; g < 4; ++g) {
                    u32x2 v; v.x = pk_bf16(acc[j][i][4 * g], acc[j][i][4 * g + 1]); v.y = pk_bf16(acc[j][i][4 * g + 2], acc[j][i][4 * g + 3]);
                    *(u32x2*)(smem + (size_t)(wm * 128 + i * 32 + r) * (STG_STRIDE * 2) + (wn * 64 + j * 32 + 8 * g + 4 * h) * 2) = v;
                }
        __syncthreads();
        const int erow = tid >> 5, ec8 = tid & 31;
#pragma unroll 4
        for (int ps = 0; ps < 16; ++ps) { const int row = ps * 16 + erow; epi(pm * 256 + row, pn, ec8, smem + (size_t)row * (STG_STRIDE * 2)); }
    }
    __syncthreads();
}


constexpr int DN_CH_BYTES = 57344;

constexpr int DP_QS = 0, DP_KS = 16384, DP_TI = 0, DP_Q = 17408, DP_TB = 21632;
constexpr int DP_RT = 32768;
constexpr int DP_AM = 69632;
constexpr int DP_KDT = 87040;
constexpr int DP_QK = 104448;
constexpr int DP_WI = 113152;
constexpr int DP_SM = 130048;

__device__ __forceinline__ void phase_dn_prep(const Params& p, unsigned char* smem) {
    const int tid0 = threadIdx.x;
    float* sbeta = (float*)(smem + DP_SM); float* sgc = sbeta + 64; float* segc = sbeta + 128; float* sekd = sbeta + 192;
    float* Am = (float*)(smem + DP_AM); float* Ti = (float*)(smem + DP_TI); float* Qb = (float*)(smem + DP_Q);
    bf16_t* Tb = (bf16_t*)(smem + DP_TB); bf16_t* Rt = (bf16_t*)(smem + DP_RT);
    bf16_t* kdt = (bf16_t*)(smem + DP_KDT); bf16_t* qki = (bf16_t*)(smem + DP_QK); bf16_t* wim = (bf16_t*)(smem + DP_WI);
    for (int ci = blockIdx.x; ci < 16 * 128; ci += gridDim.x) {
        int tid = tid0; asm volatile("" : "+v"(tid));
        const int lane = tid & 63, wave = tid >> 6;
        const int bh = ci >> 7, n = ci & 127, b = bh >> 2, h = bh & 3;
        const bf16_t* prow = p.proj_b + (size_t)b * SEQ * NP_IN;
        if (wave == 0) {
            const size_t m = (size_t)(n * 64 + lane);
            const float braw = bf2f(prow[m * NP_IN + P_B + h]), araw = bf2f(prow[m * NP_IN + P_A + h]);
            const float beta = 1.f / (1.f + expf(-braw));
            const float xx = araw + p.dt_bias[h];
            const float sp = xx > 20.f ? xx : log1pf(expf(xx));
            float g = -expf(p.a_log[h]) * sp;
#pragma unroll
            for (int o = 1; o < 64; o <<= 1) { const float up = __shfl_up(g, o); if (lane >= o) g += up; }
            const float g63 = __shfl(g, 63);
            sbeta[lane] = beta; sgc[lane] = g; segc[lane] = expf(g); sekd[lane] = expf(g63 - g);
            if (lane == 63) p.dn_gl[ci] = expf(g63);
        }
        __syncthreads();
        {
            const int i = tid >> 3, sg = tid & 7, c0 = sg * 16;
            const float beta_i = sbeta[i], egc_i = segc[i], ekd_i = sekd[i];
            const int tt0 = n * 64 + i - 3;
#pragma unroll
            for (int mat = 0; mat < 3; ++mat) {
                const int colbase = (mat == 0 ? P_DQ : (mat == 1 ? P_DK : P_DV)) + h * 128 + c0;
                float acc[16];
#pragma unroll
                for (int cc = 0; cc < 16; ++cc) acc[cc] = 0.f;
#pragma unroll
                for (int j = 0; j < 4; ++j) {
                    const int tt = tt0 + j;
                    if (tt >= 0) {
                        const u32x4 x0 = *(const u32x4*)(prow + (size_t)tt * NP_IN + colbase), x1 = *(const u32x4*)(prow + (size_t)tt * NP_IN + colbase + 8);
                        const float* wp = p.conv_w + j * 1536 + mat * 512 + h * 128 + c0;
                        const float4 w0 = *(const float4*)wp, w1 = *(const float4*)(wp + 4), w2 = *(const float4*)(wp + 8), w3 = *(const float4*)(wp + 12);
                        acc[0] = fmaf(w0.x, bflo(x0.x), acc[0]); acc[1] = fmaf(w0.y, bfhi(x0.x), acc[1]); acc[2] = fmaf(w0.z, bflo(x0.y), acc[2]); acc[3] = fmaf(w0.w, bfhi(x0.y), acc[3]);
                        acc[4] = fmaf(w1.x, bflo(x0.z), acc[4]); acc[5] = fmaf(w1.y, bfhi(x0.z), acc[5]); acc[6] = fmaf(w1.z, bflo(x0.w), acc[6]); acc[7] = fmaf(w1.w, bfhi(x0.w), acc[7]);
                        acc[8] = fmaf(w2.x, bflo(x1.x), acc[8]); acc[9] = fmaf(w2.y, bfhi(x1.x), acc[9]); acc[10] = fmaf(w2.z, bflo(x1.y), acc[10]); acc[11] = fmaf(w2.w, bfhi(x1.y), acc[11]);
                        acc[12] = fmaf(w3.x, bflo(x1.z), acc[12]); acc[13] = fmaf(w3.y, bfhi(x1.z), acc[13]); acc[14] = fmaf(w3.z, bflo(x1.w), acc[14]); acc[15] = fmaf(w3.w, bfhi(x1.w), acc[15]);
                    }
                }
                float ss = 0.f;
#pragma unroll
                for (int cc = 0; cc < 16; ++cc) { acc[cc] = silu_f(acc[cc]); ss = fmaf(acc[cc], acc[cc], ss); }
                if (mat < 2) {
                    ss += __shfl_xor(ss, 1); ss += __shfl_xor(ss, 2); ss += __shfl_xor(ss, 4);
                    const float rs = rsqrtf(ss + L2_EPS) * (mat == 0 ? 0.08838834764831845f : 1.f);
#pragma unroll
                    for (int cc = 0; cc < 16; ++cc) acc[cc] *= rs;
                    unsigned char* img = smem + (mat == 0 ? DP_QS : DP_KS) + i * 256;
                    u32x4 c0v, c1v;
                    c0v.x = pk_bf16(acc[0], acc[1]); c0v.y = pk_bf16(acc[2], acc[3]); c0v.z = pk_bf16(acc[4], acc[5]); c0v.w = pk_bf16(acc[6], acc[7]);
                    c1v.x = pk_bf16(acc[8], acc[9]); c1v.y = pk_bf16(acc[10], acc[11]); c1v.z = pk_bf16(acc[12], acc[13]); c1v.w = pk_bf16(acc[14], acc[15]);
                    *(u32x4*)(img + (((2 * sg) ^ (i & 15)) << 4)) = c0v;
                    *(u32x4*)(img + (((2 * sg + 1) ^ (i & 15)) << 4)) = c1v;
                }
                if (mat == 0) {
                    u32x4 p0, p1;
                    p0.x = pk_bf16(acc[0] * egc_i, acc[1] * egc_i); p0.y = pk_bf16(acc[2] * egc_i, acc[3] * egc_i); p0.z = pk_bf16(acc[8] * egc_i, acc[9] * egc_i); p0.w = pk_bf16(acc[10] * egc_i, acc[11] * egc_i);
                    p1.x = pk_bf16(acc[4] * egc_i, acc[5] * egc_i); p1.y = pk_bf16(acc[6] * egc_i, acc[7] * egc_i); p1.z = pk_bf16(acc[12] * egc_i, acc[13] * egc_i); p1.w = pk_bf16(acc[14] * egc_i, acc[15] * egc_i);
                    bf16_t* dst = p.dn_qd + ((size_t)(ci * 16 + (i >> 5) * 8 + sg) * 64) * 8;
                    *(u32x4*)(dst + (size_t)(i & 31) * 8) = p0;
                    *(u32x4*)(dst + (size_t)(32 + (i & 31)) * 8) = p1;
                } else if (mat == 1) {
                    const float sc = beta_i * egc_i;
#pragma unroll
                    for (int cc = 0; cc < 16; ++cc) {
                        Rt[(128 + c0 + cc) * 72 + i] = (bf16_t)(pk_bf16(acc[cc] * sc, 0.f) & 0xffffu);
                        kdt[(c0 + cc) * 68 + i] = (bf16_t)(pk_bf16(acc[cc] * ekd_i, 0.f) & 0xffffu);
                    }
                } else {
#pragma unroll
                    for (int cc = 0; cc < 16; ++cc) Rt[(c0 + cc) * 72 + i] = (bf16_t)(pk_bf16(acc[cc] * beta_i, 0.f) & 0xffffu);
                }
            }
        }
        __syncthreads();
        {
            const int mat = wave >> 2, ti = (wave >> 1) & 1, tj = wave & 1, r = lane & 31, hh = lane >> 5;
            const unsigned char* ai = smem + (mat ? DP_QS : DP_KS) + (ti * 32 + r) * 256;
            const unsigned char* bi = smem + DP_KS + (tj * 32 + r) * 256;
            f32x16 d;
#pragma unroll
            for (int e = 0; e < 16; ++e) d[e] = 0.f;
#pragma unroll
            for (int ks = 0; ks < 8; ++ks) {
                const bf16x8 af = *(const bf16x8*)(ai + (((2 * ks + hh) ^ (r & 15)) << 4));
                const bf16x8 bf = *(const bf16x8*)(bi + (((2 * ks + hh) ^ (r & 15)) << 4));
                d = __builtin_amdgcn_mfma_f32_32x32x16_bf16(af, bf, d, 0, 0, 0);
            }
            const int j = tj * 32 + r; const float gcj = sgc[j];
#pragma unroll
            for (int e = 0; e < 16; ++e) {
                const int i = ti * 32 + (e & 3) + 8 * (e >> 2) + 4 * hh;
                const float dec = __expf(fminf(sgc[i] - gcj, 0.f));
                if (mat == 0) Am[i * 68 + j] = (j < i) ? sbeta[i] * d[e] * dec : 0.f;
                else qki[i * 68 + j] = (bf16_t)(pk_bf16((j <= i) ? d[e] * dec : 0.f, 0.f) & 0xffffu);
            }
        }
        __syncthreads();
        if (tid < 64) {
            const int bk = tid >> 4, c = tid & 15;
            const float* Ab = Am + (16 * bk) * 68 + 16 * bk;
            float X[16];
#pragma unroll
            for (int i = 0; i < 16; ++i) {
                float sacc = 0.f;
#pragma unroll
                for (int j = 0; j < i; ++j) sacc = fmaf(Ab[i * 68 + j], X[j], sacc);
                X[i] = ((i == c) ? 1.f : 0.f) - sacc;
            }
#pragma unroll
            for (int i = 0; i < 16; ++i) Ti[(16 * bk + i) * 68 + 16 * bk + c] = X[i];
        } else {
            for (int z = tid - 64; z < 6 * 256; z += 448) {
                const int blk = z >> 8, e2 = z & 255, bi = blk < 3 ? 0 : (blk < 5 ? 1 : 2), bj = blk < 3 ? blk + 1 : (blk < 5 ? blk - 1 : 3);
                Ti[(16 * bi + (e2 >> 4)) * 68 + 16 * bj + (e2 & 15)] = 0.f;
            }
        }
        __syncthreads();
        {
            const int w2 = tid >> 8, o = tid & 255, ri = o >> 4, cj = o & 15, r0 = 16 * (2 * w2 + 1), c0 = 16 * (2 * w2);
            float sacc = 0.f;
#pragma unroll
            for (int k = 0; k < 16; ++k) sacc = fmaf(Am[(r0 + ri) * 68 + c0 + k], Ti[(c0 + k) * 68 + c0 + cj], sacc);
            Qb[w2 * 272 + ri * 17 + cj] = sacc;
        }
        __syncthreads();
        {
            const int w2 = tid >> 8, o = tid & 255, ri = o >> 4, cj = o & 15, r0 = 16 * (2 * w2 + 1), c0 = 16 * (2 * w2);
            float sacc = 0.f;
#pragma unroll
            for (int k = 0; k < 16; ++k) sacc = fmaf(Ti[(r0 + ri) * 68 + r0 + k], Qb[w2 * 272 + k * 17 + cj], sacc);
            Ti[(r0 + ri) * 68 + c0 + cj] = -sacc;
        }
        __syncthreads();
        float q3[2];
#pragma unroll
        for (int q = 0; q < 2; ++q) {
            const int o = tid + 512 * q, ri = o >> 5, cj = o & 31;
            float sacc = 0.f;
#pragma unroll
            for (int k = 0; k < 32; ++k) sacc = fmaf(Am[(32 + ri) * 68 + k], Ti[k * 68 + cj], sacc);
            q3[q] = sacc;
        }
#pragma unroll
        for (int q = 0; q < 2; ++q) { const int o = tid + 512 * q; Qb[(o >> 5) * 33 + (o & 31)] = q3[q]; }
        __syncthreads();
#pragma unroll
        for (int q = 0; q < 2; ++q) {
            const int o = tid + 512 * q, ri = o >> 5, cj = o & 31;
            float sacc = 0.f;
#pragma unroll
            for (int k = 0; k < 32; ++k) sacc = fmaf(Ti[(32 + ri) * 68 + 32 + k], Qb[k * 33 + cj], sacc);
            q3[q] = -sacc;
        }
        __syncthreads();
#pragma unroll
        for (int q = 0; q < 2; ++q) { const int o = tid + 512 * q; Ti[(32 + (o >> 5)) * 68 + (o & 31)] = q3[q]; }
        __syncthreads();
#pragma unroll
        for (int q = 0; q < 4; ++q) {
            const int o2 = tid + 512 * q, ri = o2 >> 5, c2 = (o2 & 31) * 2;
            *(unsigned*)(Tb + ri * 72 + c2) = pk_bf16(Ti[ri * 68 + c2], Ti[ri * 68 + c2 + 1]);
        }
        __syncthreads();
        {
            const int ct = wave, r = lane & 31, hh = lane >> 5;
            f32x16 xacc[2];
#pragma unroll
            for (int T = 0; T < 2; ++T)
#pragma unroll
                for (int e = 0; e < 16; ++e) xacc[T][e] = 0.f;
#pragma unroll
            for (int ks = 0; ks < 4; ++ks) {
                const bf16x8 bfr = *(const bf16x8*)(Rt + (32 * ct + r) * 72 + 16 * ks + 8 * hh);
#pragma unroll
                for (int T = 0; T < 2; ++T) {
                    const bf16x8 afr = *(const bf16x8*)(Tb + (32 * T + r) * 72 + 16 * ks + 8 * hh);
                    xacc[T] = __builtin_amdgcn_mfma_f32_32x32x16_bf16(afr, bfr, xacc[T], 0, 0, 0);
                }
            }
            if (ct < 4) {
#pragma unroll
                for (int T = 0; T < 2; ++T)
#pragma unroll
                    for (int q4 = 0; q4 < 4; ++q4)
                        *(float4*)(p.dn_u + ((size_t)(((ci * 4 + ct) * 2 + T) * 4 + q4) * 64 + lane) * 4) = make_float4(xacc[T][4 * q4], xacc[T][4 * q4 + 1], xacc[T][4 * q4 + 2], xacc[T][4 * q4 + 3]);
            } else {
                const int dd = 32 * (ct - 4) + r;
#pragma unroll
                for (int T = 0; T < 2; ++T)
#pragma unroll
                    for (int e = 0; e < 16; ++e) wim[(32 * T + (e & 3) + 8 * (e >> 2) + 4 * hh) * 132 + dd] = (bf16_t)(pk_bf16(-xacc[T][e], 0.f) & 0xffffu);
            }
#pragma unroll
            for (int q = 0; q < 3; ++q) {
                const int pc = tid + 512 * q;
                if (pc < 512) {
                    const int f = pc >> 6, ln = pc & 63, r2 = ln & 31, h2 = ln >> 5, rt = f >> 2, ks = f & 3;
                    const bf16_t* src = qki + (32 * rt + r2) * 68 + 16 * ks + 4 * h2;
                    const u32x2 lo = *(const u32x2*)src, hi = *(const u32x2*)(src + 8);
                    u32x4 o; o.x = lo.x; o.y = lo.y; o.z = hi.x; o.w = hi.y;
                    *(u32x4*)(p.dn_qk + ((size_t)(ci * 8 + f) * 64 + ln) * 8) = o;
                } else {
                    const int pc2 = pc - 512, f = pc2 >> 6, ln = pc2 & 63, r2 = ln & 31, h2 = ln >> 5, rt = f >> 2, ks = f & 3;
                    const bf16_t* src = kdt + (32 * rt + r2) * 68 + 16 * ks + 4 * h2;
                    const u32x2 lo = *(const u32x2*)src, hi = *(const u32x2*)(src + 8);
                    u32x4 o; o.x = lo.x; o.y = lo.y; o.z = hi.x; o.w = hi.y;
                    *(u32x4*)(p.dn_kdt + ((size_t)(ci * 16 + f) * 64 + ln) * 8) = o;
                }
            }
        }
        __syncthreads();
#pragma unroll
        for (int q = 0; q < 2; ++q) {
            const int pc = tid + 512 * q, f = pc >> 6, ln = pc & 63, r = ln & 31, hh = ln >> 5, rt = f >> 3, ks = f & 7;
            const bf16_t* src = wim + (32 * rt + r) * 132 + 16 * ks + 4 * hh;
            const u32x2 lo = *(const u32x2*)src, hi = *(const u32x2*)(src + 8);
            u32x4 o; o.x = lo.x; o.y = lo.y; o.z = hi.x; o.w = hi.y;
            *(u32x4*)(p.dn_negw + ((size_t)(ci * 16 + f) * 64 + ln) * 8) = o;
        }
    }
    __syncthreads();
}

__device__ __forceinline__ bf16x8 pack8(const f32x16& x, int s) {
    u32x4 v;
    v.x = pk_bf16(x[8 * s], x[8 * s + 1]); v.y = pk_bf16(x[8 * s + 2], x[8 * s + 3]); v.z = pk_bf16(x[8 * s + 4], x[8 * s + 5]); v.w = pk_bf16(x[8 * s + 6], x[8 * s + 7]);
    return __builtin_bit_cast(bf16x8, v);
}
#define LDS_BARRIER() do { asm volatile("s_waitcnt lgkmcnt(0)" ::: "memory"); __builtin_amdgcn_s_barrier(); asm volatile("" ::: "memory"); } while (0)
__device__ __forceinline__ const bf16_t* dn_piece_src(const Params& p, int ci, int pc) {
    return pc < 1024 ? p.dn_negw + ((size_t)ci * 1024 + pc) * 8 : pc < 2048 ? p.dn_qd + ((size_t)ci * 1024 + (pc - 1024)) * 8
         : pc < 3072 ? p.dn_kdt + ((size_t)ci * 1024 + (pc - 2048)) * 8 : p.dn_qk + ((size_t)ci * 512 + (pc - 3072)) * 8;
}
__device__ __forceinline__ void phase_dn_scan(const Params& p, unsigned char* smem) {
    const int tid = threadIdx.x, lane = tid & 63, wave = tid >> 6, r = lane & 31, hh = lane >> 5;
    const int bh = blockIdx.x, b = bh >> 2, h = bh & 3, ci0 = bh * 128;
#pragma unroll
    for (int q = 0; q < 7; ++q) { const int pc = tid + 512 * q; *(u32x4*)(smem + pc * 16) = *(const u32x4*)dn_piece_src(p, ci0, pc); }
    __syncthreads();
    if (wave >= 4) {
        const int t2 = tid - 256;
        u32x4 st[14];
#pragma unroll
        for (int q = 0; q < 14; ++q) st[q] = *(const u32x4*)dn_piece_src(p, ci0 + 1, t2 + 256 * q);
        for (int n = 0; n < 128; ++n) {
            if (n + 1 < 128) {
                unsigned char* nb = smem + ((n + 1) & 1) * DN_CH_BYTES;
#pragma unroll
                for (int q = 0; q < 14; ++q) *(u32x4*)(nb + (t2 + 256 * q) * 16) = st[q];
                if (n + 2 < 128) {
#pragma unroll
                    for (int q = 0; q < 14; ++q) st[q] = *(const u32x4*)dn_piece_src(p, ci0 + n + 2, t2 + 256 * q);
                }
            }
            LDS_BARRIER();
        }
    } else {
        const int e = wave;
        f32x16 S[4], ucur[2];
#pragma unroll
        for (int T = 0; T < 4; ++T)
#pragma unroll
            for (int e2 = 0; e2 < 16; ++e2) S[T][e2] = 0.f;
#pragma unroll
        for (int T = 0; T < 2; ++T)
#pragma unroll
            for (int q4 = 0; q4 < 4; ++q4) {
                const float4 v = *(const float4*)(p.dn_u + ((size_t)(((ci0 * 4 + e) * 2 + T) * 4 + q4) * 64 + lane) * 4);
                ucur[T][4 * q4] = v.x; ucur[T][4 * q4 + 1] = v.y; ucur[T][4 * q4 + 2] = v.z; ucur[T][4 * q4 + 3] = v.w;
            }
        for (int n = 0; n < 128; ++n) {
            const int ci = ci0 + n;
            const unsigned char* buf = smem + (n & 1) * DN_CH_BYTES;
            const float gl = p.dn_gl[ci];
            bf16x8 Sb[8];
#pragma unroll
            for (int T = 0; T < 4; ++T) { Sb[2 * T] = pack8(S[T], 0); Sb[2 * T + 1] = pack8(S[T], 1); }
            f32x16 vn[2];
#pragma unroll
            for (int T = 0; T < 2; ++T) {
                vn[T] = ucur[T];
#pragma unroll
                for (int ks = 0; ks < 8; ++ks) vn[T] = __builtin_amdgcn_mfma_f32_32x32x16_bf16(*(const bf16x8*)(buf + ((T * 8 + ks) * 64 + lane) * 16), Sb[ks], vn[T], 0, 0, 0);
            }
            bf16x8 vb[4];
#pragma unroll
            for (int T = 0; T < 2; ++T) { vb[2 * T] = pack8(vn[T], 0); vb[2 * T + 1] = pack8(vn[T], 1); }
            if (n + 1 < 128) {
#pragma unroll
                for (int T = 0; T < 2; ++T)
#pragma unroll
                    for (int q4 = 0; q4 < 4; ++q4) {
                        const float4 v = *(const float4*)(p.dn_u + ((size_t)((((ci + 1) * 4 + e) * 2 + T) * 4 + q4) * 64 + lane) * 4);
                        ucur[T][4 * q4] = v.x; ucur[T][4 * q4 + 1] = v.y; ucur[T][4 * q4 + 2] = v.z; ucur[T][4 * q4 + 3] = v.w;
                    }
            }
#pragma unroll
            for (int T = 0; T < 2; ++T) {
                f32x16 o;
#pragma unroll
                for (int e2 = 0; e2 < 16; ++e2) o[e2] = 0.f;
#pragma unroll
                for (int ks = 0; ks < 8; ++ks) o = __builtin_amdgcn_mfma_f32_32x32x16_bf16(*(const bf16x8*)(buf + 16384 + ((T * 8 + ks) * 64 + lane) * 16), Sb[ks], o, 0, 0, 0);
#pragma unroll
                for (int ks = 0; ks < 4; ++ks) o = __builtin_amdgcn_mfma_f32_32x32x16_bf16(*(const bf16x8*)(buf + 49152 + ((T * 4 + ks) * 64 + lane) * 16), vb[ks], o, 0, 0, 0);
                float* orow = p.odn_raw + ((size_t)b * SEQ + n * 64 + 32 * T + 4 * hh) * 512 + h * 128 + 32 * e + r;
#pragma unroll
                for (int e2 = 0; e2 < 16; ++e2) orow[(size_t)((e2 & 3) + 8 * (e2 >> 2)) * 512] = o[e2];
            }
#pragma unroll
            for (int T = 0; T < 4; ++T) {
#pragma unroll
                for (int e2 = 0; e2 < 16; ++e2) S[T][e2] *= gl;
#pragma unroll
                for (int ks = 0; ks < 4; ++ks) S[T] = __builtin_amdgcn_mfma_f32_32x32x16_bf16(*(const bf16x8*)(buf + 32768 + ((T * 4 + ks) * 64 + lane) * 16), vb[ks], S[T], 0, 0, 0);
            }
            LDS_BARRIER();
        }
    }
    __syncthreads();
}

constexpr int AT_VT = 32768, AT_VT_STRIDE = 260;
__device__ __forceinline__ void phase_attn(const Params& p, unsigned char* smem, int first_block) {
    const int tid0 = threadIdx.x;
    const int nblk = gridDim.x - first_block;
    const bf16_t* pb = p.proj_b;
    bf16_t* vt = (bf16_t*)(smem + AT_VT);
    for (int item = blockIdx.x - first_block; item < 1024; item += nblk) {
        int tid = tid0; asm volatile("" : "+v"(tid));
        const int lane = tid & 63, wave = tid >> 6, r = lane & 31, hh = lane >> 5;
        const int hp = item & 1, kvh = (item >> 1) & 1, nb = (item >> 2) & 63, b = item >> 8;
        const int m0 = b * SEQ + nb * 128;
        __syncthreads();
#pragma unroll
        for (int i = 0; i < 4; ++i) {
            const int idx = tid + 512 * i, key = idx >> 3, ch = idx & 7;
            const bool valid = (nb > 0) || (key >= 128);
            u32x4 kv = {0u, 0u, 0u, 0u}, vv = {0u, 0u, 0u, 0u};
            if (valid) { const bf16_t* src = pb + (size_t)(m0 - 128 + key) * NP_IN + kvh * 64 + ch * 8; kv = *(const u32x4*)(src + P_AK); vv = *(const u32x4*)(src + P_AV); }
            *(u32x4*)(smem + swz(key, ch)) = kv;
            bf16_t* vd = vt + (ch * 8) * AT_VT_STRIDE + key;
            vd[0] = (bf16_t)(vv.x & 0xffffu); vd[AT_VT_STRIDE] = (bf16_t)(vv.x >> 16); vd[2 * AT_VT_STRIDE] = (bf16_t)(vv.y & 0xffffu); vd[3 * AT_VT_STRIDE] = (bf16_t)(vv.y >> 16);
            vd[4 * AT_VT_STRIDE] = (bf16_t)(vv.z & 0xffffu); vd[5 * AT_VT_STRIDE] = (bf16_t)(vv.z >> 16); vd[6 * AT_VT_STRIDE] = (bf16_t)(vv.w & 0xffffu); vd[7 * AT_VT_STRIDE] = (bf16_t)(vv.w >> 16);
        }
        __syncthreads();
        const int head = kvh * 4 + hp * 2 + (wave >> 2), qt = wave & 3, qo = qt * 32;
        const bf16_t* qrow = pb + (size_t)(m0 + qo + r) * NP_IN + P_AQ + head * 64 + 8 * hh;
        bf16x8 qf[4];
#pragma unroll
        for (int ks = 0; ks < 4; ++ks) qf[ks] = *(const bf16x8*)(qrow + 16 * ks);
        f32x16 sc[5];
#pragma unroll
        for (int t = 0; t < 5; ++t) {
#pragma unroll
            for (int e = 0; e < 16; ++e) sc[t][e] = 0.f;
#pragma unroll
            for (int ks = 0; ks < 4; ++ks) sc[t] = __builtin_amdgcn_mfma_f32_32x32x16_bf16(*(const bf16x8*)(smem + swz((qt + t) * 32 + r, 2 * ks + hh)), qf[ks], sc[t], 0, 0, 0);
        }
        const float sink = p.sinks[head];
        float mx = -1e30f;
#pragma unroll
        for (int t = 0; t < 5; ++t)
#pragma unroll
            for (int e = 0; e < 16; ++e) {
                const int kf = 32 * (qt + t) + (e & 3) + 8 * (e >> 2) + 4 * hh;
                const bool ok = (kf >= qo + r + 1) && (kf <= qo + r + 128) && ((nb > 0) || (kf >= 128));
                sc[t][e] = ok ? sc[t][e] : -1e30f;
                mx = fmaxf(mx, sc[t][e]);
            }
        mx = fmaxf(mx, __shfl_xor(mx, 32));
        mx = fmaxf(mx, sink);
        float sum = 0.f;
#pragma unroll
        for (int t = 0; t < 5; ++t)
#pragma unroll
            for (int e = 0; e < 16; ++e) { const float pe = (sc[t][e] > -1e29f) ? __expf(sc[t][e] - mx) : 0.f; sc[t][e] = pe; sum += pe; }
        sum += __shfl_xor(sum, 32);
        const float inv = 1.f / (sum + __expf(sink - mx));
        f32x16 o[2];
#pragma unroll
        for (int dt = 0; dt < 2; ++dt)
#pragma unroll
            for (int e = 0; e < 16; ++e) o[dt][e] = 0.f;
#pragma unroll
        for (int t = 0; t < 5; ++t)
#pragma unroll
            for (int s2 = 0; s2 < 2; ++s2) {
                const bf16x8 pbv = pack8(sc[t], s2);
                const int kb = 32 * (qt + t) + 16 * s2 + 4 * hh;
#pragma unroll
                for (int dt = 0; dt < 2; ++dt) {
                    const bf16_t* vr = vt + (dt * 32 + r) * AT_VT_STRIDE + kb;
                    const u32x2 lo = *(const u32x2*)vr, hi = *(const u32x2*)(vr + 8);
                    u32x4 av; av.x = lo.x; av.y = lo.y; av.z = hi.x; av.w = hi.y;
                    o[dt] = __builtin_amdgcn_mfma_f32_32x32x16_bf16(__builtin_bit_cast(bf16x8, av), pbv, o[dt], 0, 0, 0);
                }
            }
        bf16_t* orow = p.xb + (size_t)(m0 + qo + r) * D_MODEL + head * 64 + 4 * hh;
#pragma unroll
        for (int dt = 0; dt < 2; ++dt)
#pragma unroll
            for (int q4 = 0; q4 < 4; ++q4) {
                u32x2 v; v.x = pk_bf16(o[dt][4 * q4] * inv, o[dt][4 * q4 + 1] * inv); v.y = pk_bf16(o[dt][4 * q4 + 2] * inv, o[dt][4 * q4 + 3] * inv);
                *(u32x2*)(orow + dt * 32 + 8 * q4) = v;
            }
    }
    __syncthreads();
}

__device__ __forceinline__ void phase_dn_norm(const Params& p) {
    const int lane = threadIdx.x & 63, gw = blockIdx.x * (NTHREADS / 64) + (threadIdx.x >> 6), GW = gridDim.x * (NTHREADS / 64);
    for (int it = gw; it < M_TOK * 4; it += GW) {
        const int m = it >> 2, h = it & 3;
        const float2 o = *(const float2*)(p.odn_raw + (size_t)m * 512 + h * 128 + lane * 2);
        const float ss = wave_sum(o.x * o.x + o.y * o.y);
        const float rr = rsqrtf(ss * (1.f / 128.f) + RMS_EPS);
        const unsigned z = *(const unsigned*)(p.proj_b + (size_t)m * NP_IN + P_Z + h * 128 + lane * 2);
        const float2 g = *(const float2*)(p.dn_norm_g + lane * 2);
        *(unsigned*)(p.xb + (size_t)m * D_MODEL + 512 + h * 128 + lane * 2) = pk_bf16(o.x * rr * g.x * silu_f(bflo(z)), o.y * rr * g.y * silu_f(bfhi(z)));
    }
}

__device__ __forceinline__ void phase_ln1(const Params& p, bf16_t* x1b) {
    const int lane = threadIdx.x & 63, gw = blockIdx.x * (NTHREADS / 64) + (threadIdx.x >> 6), GW = gridDim.x * (NTHREADS / 64);
    for (int m = gw; m < M_TOK; m += GW) {
        float* row = p.out + (size_t)m * D_MODEL;
        float4 v[4]; float s = 0.f;
#pragma unroll
        for (int j = 0; j < 4; ++j) { v[j] = *(const float4*)(row + j * 256 + lane * 4); s += (v[j].x + v[j].y) + (v[j].z + v[j].w); }
        const float mean = wave_sum(s) * (1.f / D_MODEL); float q = 0.f;
#pragma unroll
        for (int j = 0; j < 4; ++j) { v[j].x -= mean; v[j].y -= mean; v[j].z -= mean; v[j].w -= mean; q += (v[j].x * v[j].x + v[j].y * v[j].y) + (v[j].z * v[j].z + v[j].w * v[j].w); }
        const float rstd = rsqrtf(wave_sum(q) * (1.f / D_MODEL) + LN_EPS);
#pragma unroll
        for (int j = 0; j < 4; ++j) {
            const float4 g = *(const float4*)(p.ln1_g + j * 256 + lane * 4), bb = *(const float4*)(p.ln1_b + j * 256 + lane * 4);
            const float4 o = make_float4(v[j].x * rstd * g.x + bb.x, v[j].y * rstd * g.y + bb.y, v[j].z * rstd * g.z + bb.z, v[j].w * rstd * g.w + bb.w);
            *(float4*)(row + j * 256 + lane * 4) = o;
            u32x2 ob; ob.x = pk_bf16(o.x, o.y); ob.y = pk_bf16(o.z, o.w);
            *(u32x2*)(x1b + (size_t)m * D_MODEL + j * 256 + lane * 4) = ob;
        }
    }
}


__device__ __forceinline__ void cas_d(float& a, float& b) { const float hi = fmaxf(a, b), lo = fminf(a, b); a = hi; b = lo; }
__device__ __forceinline__ void cas_a(float& a, float& b) { const float hi = fmaxf(a, b), lo = fminf(a, b); a = lo; b = hi; }
__device__ __forceinline__ void sort16_desc(f32x16& v) {
#pragma unroll
    for (int k = 2; k <= 16; k <<= 1)
#pragma unroll
        for (int j = k >> 1; j > 0; j >>= 1)
#pragma unroll
            for (int i = 0; i < 16; ++i) {
                const int l = i ^ j;
                if (l > i) { float a = v[i], b = v[l]; if ((i & k) == 0) cas_d(a, b); else cas_a(a, b); v[i] = a; v[l] = b; }
            }
}
__device__ __forceinline__ void bmerge16_desc(f32x16& v) {
#pragma unroll
    for (int j = 8; j > 0; j >>= 1)
#pragma unroll
        for (int i = 0; i < 16; ++i) { const int l = i ^ j; if (l > i) { float a = v[i], b = v[l]; cas_d(a, b); v[i] = a; v[l] = b; } }
}
__device__ __forceinline__ f32x16 merge_top16(const f32x16& a, const f32x16& b) {
    f32x16 c;
#pragma unroll
    for (int i = 0; i < 16; ++i) c[i] = fmaxf(a[i], b[15 - i]);
    bmerge16_desc(c);
    return c;
}
__device__ __forceinline__ void pcas_d(float& va, int& ia, float& vb, int& ib) {
    const bool sw = vb > va; const float tv = sw ? vb : va; const int ti = sw ? ib : ia;
    vb = sw ? va : vb; ib = sw ? ia : ib; va = tv; ia = ti;
}
__device__ __forceinline__ void psort16_desc(float (&v)[16], int (&id)[16]) {
#pragma unroll
    for (int k = 2; k <= 16; k <<= 1)
#pragma unroll
        for (int j = k >> 1; j > 0; j >>= 1)
#pragma unroll
            for (int i = 0; i < 16; ++i) {
                const int l = i ^ j;
                if (l > i) { if ((i & k) == 0) pcas_d(v[i], id[i], v[l], id[l]); else pcas_d(v[l], id[l], v[i], id[i]); }
            }
}
__device__ __forceinline__ void pmerge_top16(float (&a)[16], int (&ia)[16], const float (&b)[16], const int (&ib)[16]) {
#pragma unroll
    for (int i = 0; i < 16; ++i) { const bool sw = b[15 - i] > a[i]; a[i] = sw ? b[15 - i] : a[i]; ia[i] = sw ? ib[15 - i] : ia[i]; }
#pragma unroll
    for (int j = 8; j > 0; j >>= 1)
#pragma unroll
        for (int i = 0; i < 16; ++i) { const int l = i ^ j; if (l > i) pcas_d(a[i], ia[i], a[l], ia[l]); }
}
__device__ __forceinline__ void phase_route(const Params& p, const bf16_t* qb) {
    constexpr int CI[50] = {0,0,0,0,0,0,0,0,0,0,0,0,0,0,0,0,1,1,1,1,1,1,1,1,2,2,2,2,2,3,3,3,3,4,4,4,5,5,6,6,7,7,8,9,10,11,12,13,14,15};
    constexpr int CJ[50] = {0,1,2,3,4,5,6,7,8,9,10,11,12,13,14,15,0,1,2,3,4,5,6,7,0,1,2,3,4,0,1,2,3,0,1,2,0,1,0,1,0,1,0,0,0,0,0,0,0,0};
    const int lane0 = threadIdx.x & 63, gw = blockIdx.x * (NTHREADS / 64) + (threadIdx.x >> 6), GW = gridDim.x * (NTHREADS / 64);
    for (int task = gw; task < (M_TOK / 32) * 8; task += GW) {
        int lane = lane0; asm volatile("" : "+v"(lane));
        const int r = lane & 31, hh = lane >> 5;
        const int h = task & 7, tok0 = (task >> 3) * 32;
        f32x16 top[2];
#pragma unroll
        for (int pp = 0; pp < 2; ++pp) {
            const bf16_t* qrow = qb + (size_t)(tok0 + r) * 2048 + h * 256 + pp * 128 + 8 * hh;
            bf16x8 qf[8];
#pragma unroll
            for (int ks = 0; ks < 8; ++ks) qf[ks] = *(const bf16x8*)(qrow + 16 * ks);
            f32x16 sc[4];
#pragma unroll
            for (int kt = 0; kt < 4; ++kt) {
                const bf16_t* af = p.sk_frag + ((size_t)(((h * 2 + pp) * 4 + kt) * 8) * 64 + lane) * 8;
                bf16x8 a[8];
#pragma unroll
                for (int ks = 0; ks < 8; ++ks) a[ks] = *(const bf16x8*)(af + (size_t)ks * 512);
#pragma unroll
                for (int e = 0; e < 16; ++e) sc[kt][e] = 0.f;
#pragma unroll
                for (int ks = 0; ks < 8; ++ks) sc[kt] = __builtin_amdgcn_mfma_f32_32x32x16_bf16(a[ks], qf[ks], sc[kt], 0, 0, 0);
            }
#pragma unroll
            for (int kt = 0; kt < 4; ++kt) {
#pragma unroll
                for (int e = 0; e < 16; ++e) {
                    const unsigned key = (unsigned)(32 * kt + (e & 3) + 8 * (e >> 2)) + 4u * (unsigned)hh;
                    sc[kt][e] = __uint_as_float((__float_as_uint(sc[kt][e]) & 0xffffff80u) | key);
                }
                sort16_desc(sc[kt]);
            }
            f32x16 m = merge_top16(merge_top16(sc[0], sc[1]), merge_top16(sc[2], sc[3]));
            f32x16 oth;
#pragma unroll
            for (int i = 0; i < 16; ++i) oth[i] = __shfl_xor(m[i], 32);
            top[pp] = merge_top16(m, oth);
        }
        int ia[16], ib[16];
#pragma unroll
        for (int i = 0; i < 16; ++i) { ia[i] = (int)(__float_as_uint(top[0][i]) & 127u); ib[i] = (int)(__float_as_uint(top[1][i]) & 127u); }
        float cv0[16], cv1[16]; int cd0[16], cd1[16];
#pragma unroll
        for (int c = 0; c < 32; ++c) {
            float v = -INFINITY; int id = 0;
            if (c < 25) {
                const float v0 = top[0][CI[2 * c]] + top[1][CJ[2 * c]], v1 = top[0][CI[2 * c + 1]] + top[1][CJ[2 * c + 1]];
                const int d0 = (ia[CI[2 * c]] << 7) | ib[CJ[2 * c]], d1 = (ia[CI[2 * c + 1]] << 7) | ib[CJ[2 * c + 1]];
                v = hh ? v1 : v0; id = hh ? d1 : d0;
            }
            if (c < 16) { cv0[c] = v; cd0[c] = id; } else { cv1[c - 16] = v; cd1[c - 16] = id; }
        }
        psort16_desc(cv0, cd0); psort16_desc(cv1, cd1);
        pmerge_top16(cv0, cd0, cv1, cd1);
        float ov[16]; int od[16];
#pragma unroll
        for (int i = 0; i < 16; ++i) { ov[i] = __shfl_xor(cv0[i], 32); od[i] = __shfl_xor(cd0[i], 32); }
        pmerge_top16(cv0, cd0, ov, od);
        float ex[16], den = 0.f;
#pragma unroll
        for (int i = 0; i < 16; ++i) { ex[i] = __expf(cv0[i] - cv0[0]); den += ex[i]; }
        const float inv = 1.f / den;
        if (hh == 0) {
            int* idp = p.ids + (size_t)(tok0 + r) * 128 + h * 16; float* gp = p.gates + (size_t)(tok0 + r) * 128 + h * 16;
#pragma unroll
            for (int q = 0; q < 4; ++q) {
                *(int4*)(idp + 4 * q) = make_int4(cd0[4 * q], cd0[4 * q + 1], cd0[4 * q + 2], cd0[4 * q + 3]);
                *(float4*)(gp + 4 * q) = make_float4(ex[4 * q] * inv, ex[4 * q + 1] * inv, ex[4 * q + 2] * inv, ex[4 * q + 3] * inv);
            }
        }
    }
}


typedef float f32x2 __attribute__((ext_vector_type(2)));
__device__ __forceinline__ void phase_tables8(const Params& p) {
    const int lane = threadIdx.x & 63, gw = blockIdx.x * (NTHREADS / 64) + (threadIdx.x >> 6), GW = gridDim.x * (NTHREADS / 64);
    for (int row = gw; row < 2 * 16384; row += GW) {
        const int table = row >> 14, e = row & 16383;
        const float* src = (table ? p.peer_v : p.peer_u) + (size_t)e * 1024 + lane * 16;
        float v[16];
#pragma unroll
        for (int q = 0; q < 4; ++q) { const float4 a = *(const float4*)(src + 4 * q); v[4 * q] = a.x; v[4 * q + 1] = a.y; v[4 * q + 2] = a.z; v[4 * q + 3] = a.w; }
        float am = 0.f;
#pragma unroll
        for (int c = 0; c < 16; ++c) am = fmaxf(am, fabsf(v[c]));
        am = wave_max(am);
        float sc = am > 0.f ? exp2f(floorf(log2f(448.f / am))) : 1.f;
        if (am * sc > 448.f) sc *= 0.5f;
        u32x4 o;
        int w;
        w = 0; w = __builtin_amdgcn_cvt_pk_fp8_f32(v[0] * sc, v[1] * sc, w, false); w = __builtin_amdgcn_cvt_pk_fp8_f32(v[2] * sc, v[3] * sc, w, true); o.x = (unsigned)w;
        w = 0; w = __builtin_amdgcn_cvt_pk_fp8_f32(v[4] * sc, v[5] * sc, w, false); w = __builtin_amdgcn_cvt_pk_fp8_f32(v[6] * sc, v[7] * sc, w, true); o.y = (unsigned)w;
        w = 0; w = __builtin_amdgcn_cvt_pk_fp8_f32(v[8] * sc, v[9] * sc, w, false); w = __builtin_amdgcn_cvt_pk_fp8_f32(v[10] * sc, v[11] * sc, w, true); o.z = (unsigned)w;
        w = 0; w = __builtin_amdgcn_cvt_pk_fp8_f32(v[12] * sc, v[13] * sc, w, false); w = __builtin_amdgcn_cvt_pk_fp8_f32(v[14] * sc, v[15] * sc, w, true); o.w = (unsigned)w;
        *(u32x4*)(p.tab8 + ((size_t)((table * 8 + (lane >> 3)) * 16384 + e)) * 128 + (lane & 7) * 16) = o;
        if (lane == 0) p.isc[row] = 1.f / sc;
    }
}
struct PeerBuf { u32x4 rows[16]; u32x4 xa, xb; float w0, w1; };
__device__ __forceinline__ void peer_gather(PeerBuf& B, const unsigned char* tab, int id0, int id1, int j, int g) {
#pragma unroll
    for (int i = 0; i < 16; ++i) {
        const int e = __shfl(i < 8 ? id0 : id1, (8 * i + g) & 63);
        B.rows[i] = *(const u32x4*)(tab + (size_t)e * 128 + j * 16);
    }
}
__device__ __forceinline__ void phase_peer_u(const Params& p, const bf16_t* x1b, float* ph) {
    const int lane0 = threadIdx.x & 63, wave = threadIdx.x >> 6;
    const int x = blockIdx.x & 7, nloc = (gridDim.x - x + 7) >> 3, wl = (blockIdx.x >> 3) * (NTHREADS / 64) + wave, NW = nloc * (NTHREADS / 64);
    const unsigned char* tab = p.tab8 + (size_t)x * 16384 * 128;
    int lane = lane0; asm volatile("" : "+v"(lane));
    const int j = lane & 7, g = lane >> 3;
    auto tok = [&](int t) { return t < M_TOK ? t : M_TOK - 1; };
    auto issue = [&](PeerBuf& B, int t, int id0, int id1) {
        const bf16_t* xs = x1b + (size_t)t * 1024 + 128 * x + 16 * j;
        B.xa = *(const u32x4*)xs; B.xb = *(const u32x4*)(xs + 8);
        peer_gather(B, tab, id0, id1, j, g);
    };
    auto compute = [&](const PeerBuf& B, int t) {
        const f32x2 xf[8] = {{bflo(B.xa.x), bfhi(B.xa.x)}, {bflo(B.xa.y), bfhi(B.xa.y)}, {bflo(B.xa.z), bfhi(B.xa.z)}, {bflo(B.xa.w), bfhi(B.xa.w)},
                             {bflo(B.xb.x), bfhi(B.xb.x)}, {bflo(B.xb.y), bfhi(B.xb.y)}, {bflo(B.xb.z), bfhi(B.xb.z)}, {bflo(B.xb.w), bfhi(B.xb.w)}};
        float res[16];
#pragma unroll
        for (int i = 0; i < 16; ++i) {
            const unsigned dw[4] = {B.rows[i].x, B.rows[i].y, B.rows[i].z, B.rows[i].w};
            f32x2 d2 = {0.f, 0.f};
#pragma unroll
            for (int q = 0; q < 4; ++q) {
                const f32x2 lo = __builtin_amdgcn_cvt_pk_f32_fp8((int)dw[q], false), hi = __builtin_amdgcn_cvt_pk_f32_fp8((int)dw[q], true);
                d2 = lo * xf[2 * q] + d2; d2 = hi * xf[2 * q + 1] + d2;
            }
            float d = d2.x + d2.y;
            d += __shfl_xor(d, 1); d += __shfl_xor(d, 2); d += __shfl_xor(d, 4);
            res[i] = d;
        }
        float r0 = res[0], r1 = res[1];
#pragma unroll
        for (int jj = 1; jj < 8; ++jj) { r0 = (j == jj) ? res[2 * jj] : r0; r1 = (j == jj) ? res[2 * jj + 1] : r1; }
        float* dst = ph + ((size_t)x * M_TOK + t) * 128 + 16 * j + g;
        dst[0] = r0; dst[8] = r1;
    };
    PeerBuf A, Bb;
    int t = wl;
    if (t >= M_TOK) return;
    {
        const int c0 = p.ids[(size_t)t * 128 + lane], c1 = p.ids[(size_t)t * 128 + 64 + lane];
        issue(A, t, c0, c1);
    }
    int n0 = p.ids[(size_t)tok(t + NW) * 128 + lane], n1 = p.ids[(size_t)tok(t + NW) * 128 + 64 + lane];
    for (; t < M_TOK; t += 2 * NW) {
        const int m0 = p.ids[(size_t)tok(t + 2 * NW) * 128 + lane], m1 = p.ids[(size_t)tok(t + 2 * NW) * 128 + 64 + lane];
        issue(Bb, tok(t + NW), n0, n1);
        compute(A, t);
        n0 = p.ids[(size_t)tok(t + 3 * NW) * 128 + lane]; n1 = p.ids[(size_t)tok(t + 3 * NW) * 128 + 64 + lane];
        issue(A, tok(t + 2 * NW), m0, m1);
        if (t + NW < M_TOK) compute(Bb, t + NW);
    }
}
__device__ __forceinline__ void phase_peer_w(const Params& p, const float* ph, float* wbuf) {
    const size_t gt = (size_t)blockIdx.x * NTHREADS + threadIdx.x, GT = (size_t)gridDim.x * NTHREADS;
    for (size_t idx = gt; idx < (size_t)M_TOK * 128; idx += GT) {
        const int e = p.ids[idx];
        float h = 0.f;
#pragma unroll
        for (int x = 0; x < 8; ++x) h += ph[(size_t)x * M_TOK * 128 + idx];
        h *= p.isc[e];
        wbuf[idx] = 0.5f * h * (1.f + erff(h * 0.7071067811865476f)) * p.gates[idx] * p.isc[16384 + e];
    }
}
__device__ __forceinline__ void phase_peer_v(const Params& p, const float* wbuf, float* ffn) {
    const int lane0 = threadIdx.x & 63, wave = threadIdx.x >> 6;
    const int x = blockIdx.x & 7, nloc = (gridDim.x - x + 7) >> 3, wl = (blockIdx.x >> 3) * (NTHREADS / 64) + wave, NW = nloc * (NTHREADS / 64);
    const unsigned char* tab = p.tab8 + (size_t)(8 + x) * 16384 * 128;
    int lane = lane0; asm volatile("" : "+v"(lane));
    const int j = lane & 7, g = lane >> 3;
    auto tok = [&](int t) { return t < M_TOK ? t : M_TOK - 1; };
    auto issue = [&](PeerBuf& B, int t, int id0, int id1) {
        B.w0 = wbuf[(size_t)t * 128 + lane]; B.w1 = wbuf[(size_t)t * 128 + 64 + lane];
        peer_gather(B, tab, id0, id1, j, g);
    };
    auto compute = [&](const PeerBuf& B, int t) {
        f32x2 acc[8];
#pragma unroll
        for (int c = 0; c < 8; ++c) acc[c] = (f32x2){0.f, 0.f};
#pragma unroll
        for (int i = 0; i < 16; ++i) {
            const float wi = __shfl(i < 8 ? B.w0 : B.w1, (8 * i + g) & 63);
            const f32x2 w2 = {wi, wi};
            const unsigned dw[4] = {B.rows[i].x, B.rows[i].y, B.rows[i].z, B.rows[i].w};
#pragma unroll
            for (int q = 0; q < 4; ++q) {
                const f32x2 lo = __builtin_amdgcn_cvt_pk_f32_fp8((int)dw[q], false), hi = __builtin_amdgcn_cvt_pk_f32_fp8((int)dw[q], true);
                acc[2 * q] = lo * w2 + acc[2 * q]; acc[2 * q + 1] = hi * w2 + acc[2 * q + 1];
            }
        }
#pragma unroll
        for (int c = 0; c < 8; ++c) {
            acc[c].x += __shfl_xor(acc[c].x, 8); acc[c].y += __shfl_xor(acc[c].y, 8);
            acc[c].x += __shfl_xor(acc[c].x, 16); acc[c].y += __shfl_xor(acc[c].y, 16);
            acc[c].x += __shfl_xor(acc[c].x, 32); acc[c].y += __shfl_xor(acc[c].y, 32);
        }
        if (lane < 8) {
            float* dst = ffn + (size_t)t * 1024 + 128 * x + 16 * lane;
#pragma unroll
            for (int q = 0; q < 4; ++q) *(float4*)(dst + 4 * q) = make_float4(acc[2 * q].x, acc[2 * q].y, acc[2 * q + 1].x, acc[2 * q + 1].y);
        }
    };
    PeerBuf A, Bb;
    int t = wl;
    if (t >= M_TOK) return;
    {
        const int c0 = p.ids[(size_t)t * 128 + lane], c1 = p.ids[(size_t)t * 128 + 64 + lane];
        issue(A, t, c0, c1);
    }
    int n0 = p.ids[(size_t)tok(t + NW) * 128 + lane], n1 = p.ids[(size_t)tok(t + NW) * 128 + 64 + lane];
    for (; t < M_TOK; t += 2 * NW) {
        const int m0 = p.ids[(size_t)tok(t + 2 * NW) * 128 + lane], m1 = p.ids[(size_t)tok(t + 2 * NW) * 128 + 64 + lane];
        issue(Bb, tok(t + NW), n0, n1);
        compute(A, t);
        n0 = p.ids[(size_t)tok(t + 3 * NW) * 128 + lane]; n1 = p.ids[(size_t)tok(t + 3 * NW) * 128 + 64 + lane];
        issue(A, tok(t + 2 * NW), m0, m1);
        if (t + NW < M_TOK) compute(Bb, t + NW);
    }
}
__device__ __forceinline__ void phase_ln2(const Params& p, const float* ffn) {
    const int lane = threadIdx.x & 63, gw = blockIdx.x * (NTHREADS / 64) + (threadIdx.x >> 6), GW = gridDim.x * (NTHREADS / 64);
    for (int m = gw; m < M_TOK; m += GW) {
        float* row = p.out + (size_t)m * D_MODEL; const float* fr = ffn + (size_t)m * D_MODEL;
        float4 v[4]; float s = 0.f;
#pragma unroll
        for (int j = 0; j < 4; ++j) { const float4 a = *(const float4*)(row + j * 256 + lane * 4), f = *(const float4*)(fr + j * 256 + lane * 4);
            v[j] = make_float4(ALPHA * a.x + f.x, ALPHA * a.y + f.y, ALPHA * a.z + f.z, ALPHA * a.w + f.w); s += (v[j].x + v[j].y) + (v[j].z + v[j].w); }
        const float mean = wave_sum(s) * (1.f / D_MODEL); float q = 0.f;
#pragma unroll
        for (int j = 0; j < 4; ++j) { v[j].x -= mean; v[j].y -= mean; v[j].z -= mean; v[j].w -= mean; q += (v[j].x * v[j].x + v[j].y * v[j].y) + (v[j].z * v[j].z + v[j].w * v[j].w); }
        const float rstd = rsqrtf(wave_sum(q) * (1.f / D_MODEL) + LN_EPS);
#pragma unroll
        for (int j = 0; j < 4; ++j) {
            const float4 g = *(const float4*)(p.ln2_g + j * 256 + lane * 4), bb = *(const float4*)(p.ln2_b + j * 256 + lane * 4);
            *(float4*)(row + j * 256 + lane * 4) = make_float4(v[j].x * rstd * g.x + bb.x, v[j].y * rstd * g.y + bb.y, v[j].z * rstd * g.z + bb.z, v[j].w * rstd * g.w + bb.w);
        }
    }
}

constexpr int N_PHASES = 13;
__global__ void __launch_bounds__(NTHREADS) mega_fwd(Params p) {
    __shared__ __attribute__((aligned(16))) unsigned char smem[SMEM_BYTES];
    __shared__ uint4 xb_words;
    if (threadIdx.x == 0) xb_words = make_uint4(0u, 0u, 0u, 0u);
    __syncthreads();
    XcdBarrier bar; bar.bar = p.bar; bar.x = 0; bar.st = (volatile LAS unsigned*)&xb_words;
    if (p.ph_hi - p.ph_lo > 1) bar = xcd_barrier_post(p.bar, (volatile LAS unsigned*)&xb_words);
    bf16_t* qb = p.proj_b;
    bf16_t* x1b = p.proj_b + (size_t)M_TOK * 2048;
#ifndef DUP_PHASE
#define DUP_PHASE -1
#endif
#define PH(k) (p.ph_lo <= (k) && (k) < p.ph_hi)
#define SYNC(k) do { if (PH(k) && PH((k) + 1)) xcd_barrier(bar); } while (0)
#define RUN(k, ...) do { if (PH(k)) { __VA_ARGS__; if (DUP_PHASE == (k)) { xcd_barrier(bar); __VA_ARGS__; } } SYNC(k); } while (0)
    float* ph = (float*)qb;
    RUN(0, phase_prep(p, smem));
    RUN(1, { EpiInProj e{p.proj_b, p.rope_cs}; gemm_phase(p.xb, p.wt_in, M_TOK, NP_IN, e, smem); });
    RUN(2, phase_dn_prep(p, smem));
    RUN(3, { if (blockIdx.x < 16) phase_dn_scan(p, smem); else phase_attn(p, smem, 16); });
    RUN(4, { phase_dn_norm(p); phase_tables8(p); });
    RUN(5, { EpiOutProj e{p.out, p.x}; gemm_phase(p.xb, p.wt_out, M_TOK, 1024, e, smem); });
    RUN(6, phase_ln1(p, x1b));
    RUN(7, { EpiBf16 e{qb, 2048}; gemm_phase(x1b, p.wt_q, M_TOK, 2048, e, smem); });
    RUN(8, phase_route(p, qb));
    RUN(9, phase_peer_u(p, x1b, ph));
    RUN(10, phase_peer_w(p, ph, p.wbuf));
    RUN(11, phase_peer_v(p, p.wbuf, ph));
    RUN(12, phase_ln2(p, ph));
#undef RUN
#undef SYNC
#undef PH
}
}

#ifndef MK_LAUNCHES
#define MK_LAUNCHES 1
#endif

extern "C" void kernel_launch(void* const* d_in, const int* in_sizes, int n_in, void* d_out, int out_size, void* d_ws, size_t ws_size, hipStream_t stream) {
    static int grid_blocks = 0;
    if (!grid_blocks) {
        int dev = 0, cus = 0, per_cu = 0;
        (void)hipGetDevice(&dev);
        (void)hipDeviceGetAttribute(&cus, hipDeviceAttributeMultiprocessorCount, dev);
        (void)hipOccupancyMaxActiveBlocksPerMultiprocessor(&per_cu, mega_fwd, NTHREADS, 0);
        if (per_cu < 1) { fprintf(stderr, "kernel_launch: occupancy query reports %d blocks per CU\n", per_cu); per_cu = 1; }
        grid_blocks = cus * 1;
        (void)hipGetLastError();
    }
    Params p{};
    p.x = (const float*)d_in[0]; p.positions = (const int*)d_in[1]; p.w_in = (const float*)d_in[2]; p.sinks = (const float*)d_in[3];
    p.conv_w = (const float*)d_in[4]; p.a_log = (const float*)d_in[5]; p.dt_bias = (const float*)d_in[6]; p.dn_norm_g = (const float*)d_in[7];
    p.w_out = (const float*)d_in[8]; p.ln1_g = (const float*)d_in[9]; p.ln1_b = (const float*)d_in[10]; p.w_query = (const float*)d_in[11];
    p.sub_keys = (const float*)d_in[12]; p.peer_u = (const float*)d_in[13]; p.peer_v = (const float*)d_in[14]; p.ln2_g = (const float*)d_in[15]; p.ln2_b = (const float*)d_in[16];
    p.out = (float*)d_out;
    char* ws = (char*)d_ws; size_t off = 0;
    auto take = [&](size_t bytes) { char* r = ws + off; off += (bytes + 255) & ~(size_t)255; return r; };
    p.xb = (bf16_t*)take((size_t)M_TOK * 1024 * 2);
    p.proj_b = (bf16_t*)take((size_t)M_TOK * NP_IN * 2);
    p.odn_raw = (float*)d_out;
    {
        char* dn = take((size_t)2048 * (16384 * 3 + 8192 + 32768) + 8192);
        p.ids = (int*)dn; p.gates = (float*)(dn + (size_t)M_TOK * 128 * 4);
        p.tab8 = (unsigned char*)(dn + (size_t)M_TOK * 128 * 8);
        p.wbuf = (float*)(dn + (size_t)M_TOK * 128 * 8 + (size_t)32 * 1024 * 1024); p.isc = (float*)(dn + (size_t)M_TOK * 128 * 8 + (size_t)48 * 1024 * 1024);
        p.dn_negw = (bf16_t*)dn; p.dn_qd = (bf16_t*)(dn + (size_t)2048 * 16384); p.dn_kdt = (bf16_t*)(dn + (size_t)2048 * 16384 * 2);
        p.dn_qk = (bf16_t*)(dn + (size_t)2048 * 16384 * 3); p.dn_u = (float*)(dn + (size_t)2048 * (16384 * 3 + 8192)); p.dn_gl = (float*)(dn + (size_t)2048 * (16384 * 3 + 8192 + 32768));
    }
    p.wt_in = (bf16_t*)take((size_t)NP_IN * 1024 * 2);
    p.wt_out = (bf16_t*)take((size_t)1024 * 1024 * 2);
    p.wt_q = (bf16_t*)take((size_t)2048 * 1024 * 2);
    p.rope_cs = (float*)take((size_t)M_TOK * 64 * 4);
    p.sk_frag = (bf16_t*)take((size_t)16 * 128 * 128 * 2);
    p.bar = (unsigned*)take((size_t)XCD_BAR_WORDS * 4);
    if (off > ws_size) { fprintf(stderr, "kernel_launch: workspace too small (%zu < %zu)\n", ws_size, off); return; }
    if (hipMemsetAsync(p.bar, 0, (size_t)XCD_BAR_WORDS * 4, stream) != hipSuccess) { fprintf(stderr, "kernel_launch: memset of barrier words failed\n"); return; }
#if MK_LAUNCHES == 1
    p.ph_lo = 0; p.ph_hi = N_PHASES;
    void* args[] = {&p};
    hipError_t e = hipLaunchCooperativeKernel((void*)mega_fwd, dim3(grid_blocks), dim3(NTHREADS), args, 0, stream);
    if (e != hipSuccess) fprintf(stderr, "cooperative launch failed: %s (grid %d)\n", hipGetErrorString(e), grid_blocks);
#else
    for (int k = 0; k < N_PHASES; ++k) { p.ph_lo = k; p.ph_hi = k + 1; hipLaunchKernelGGL(mega_fwd, dim3(grid_blocks), dim3(NTHREADS), 0, stream, p); }
#endif
}
```

```cpp
#include <hip/hip_runtime.h>
#include <cstdio>
#include <cstdint>
#include <math.h>

namespace {
constexpr int D_MODEL = 1024, BATCH = 4, SEQ = 8192, M_TOK = BATCH * SEQ;
constexpr int IN_WIDTH = 2824, NP_IN = 3072;
constexpr int P_AQ = 0, P_AK = 512, P_AV = 640, P_DQ = 768, P_DK = 1280, P_DV = 1792, P_Z = 2304, P_B = 2816, P_A = 2820;
constexpr float ALPHA = 1.189207115002721f;
constexpr float LN_EPS = 1e-5f, RMS_EPS = 1e-6f, L2_EPS = 1e-6f;
constexpr int NTHREADS = 512;

typedef unsigned short bf16_t;
typedef short bf16x8 __attribute__((ext_vector_type(8)));
typedef float f32x16 __attribute__((ext_vector_type(16)));
typedef float f32x4 __attribute__((ext_vector_type(4)));
typedef unsigned u32x4 __attribute__((ext_vector_type(4)));
typedef unsigned u32x2 __attribute__((ext_vector_type(2)));

struct Params {
    const float* x; const int* positions; const float* w_in; const float* sinks; const float* conv_w; const float* a_log; const float* dt_bias;
    const float* dn_norm_g; const float* w_out; const float* ln1_g; const float* ln1_b; const float* w_query; const float* sub_keys;
    const float* peer_u; const float* peer_v; const float* ln2_g; const float* ln2_b;
    float* out;
    bf16_t* xb;
    bf16_t* proj_b;
    bf16_t* odn_raw;
    int* ids; float* gates;
    bf16_t* wt_in; bf16_t* wt_out; bf16_t* wt_q;
    float* rope_cs;
    bf16_t* dn_negw; bf16_t* dn_qd; bf16_t* dn_kdt; bf16_t* dn_qk; bf16_t* dn_u; float* dn_gl;
    bf16_t* sk_frag;
    float* ln1_stats;
    unsigned char* tab8; float* isc; float* wbuf;
    unsigned* bar;
    int ph_lo, ph_hi;
};

__device__ __forceinline__ float wave_sum(float v) {
#pragma unroll
    for (int o = 1; o < 64; o <<= 1) v += __shfl_xor(v, o);
    return v;
}
__device__ __forceinline__ float wave_max(float v) {
#pragma unroll
    for (int o = 1; o < 64; o <<= 1) v = fmaxf(v, __shfl_xor(v, o));
    return v;
}
__device__ __forceinline__ float bf2f(bf16_t u) { return __uint_as_float((unsigned)u << 16); }
__device__ __forceinline__ float bflo(unsigned u) { return __uint_as_float(u << 16); }
__device__ __forceinline__ float bfhi(unsigned u) { return __uint_as_float(u & 0xffff0000u); }
typedef __bf16 bf16x2_n __attribute__((ext_vector_type(2)));
__device__ __forceinline__ unsigned pk_bf16(float lo, float hi) { bf16x2_n v; v.x = (__bf16)lo; v.y = (__bf16)hi; return __builtin_bit_cast(unsigned, v); }
__device__ __forceinline__ float silu_f(float y) { return y / (1.f + __expf(-y)); }


#define XB_TMO      128
#define XB_XCNT(j)  (256  + 64 * (j))
#define XB_XSUB(j)  (1280 + 64 * (j))
#define XB_XGEN(j)  (2304 + 64 * (j))
#define XB_TOP      3328
#define XB_TOPGEN   3392
#define XCD_BAR_WORDS 3456
#define XB_SPIN_CAP (1u << 27)
#define LAS __attribute__((address_space(3)))
__device__ __forceinline__ unsigned xb_ld(unsigned* p)              { return __hip_atomic_load(p, __ATOMIC_RELAXED, __HIP_MEMORY_SCOPE_AGENT); }
__device__ __forceinline__ unsigned xb_add(unsigned* p, unsigned v) { return __hip_atomic_fetch_add(p, v, __ATOMIC_RELAXED, __HIP_MEMORY_SCOPE_AGENT); }
__device__ __forceinline__ unsigned xb_xcc_id() { return (unsigned)__builtin_amdgcn_s_getreg((3 << 11) | 20) & 0xFu; }
#define XB_SPIN(cond, bar) do { unsigned _sp = 0; while (cond) { __builtin_amdgcn_s_sleep(1); \
    if ((++_sp & 255u) == 0u) { if (xb_ld(&(bar)[XB_TMO])) break; if (_sp > XB_SPIN_CAP) { atomicAdd(&(bar)[XB_TMO], 1u); break; } } } } while (0)
struct XcdBarrier { unsigned* bar; unsigned x; volatile LAS unsigned* st; };
__device__ __forceinline__ XcdBarrier xcd_barrier_post(unsigned* bar, volatile LAS unsigned* st) {
    XcdBarrier b; b.bar = bar; b.x = xb_xcc_id(); b.st = st;
    if (threadIdx.x == 0) (void)xb_add(&bar[XB_XCNT(b.x)], 1u);
    return b;
}
__device__ __forceinline__ void xcd_barrier_complete(unsigned* bar, unsigned x, unsigned& nloc, unsigned& nx) {
    const unsigned G = gridDim.x * gridDim.y * gridDim.z;
    unsigned sum, cnt, mine, sp = 0u;
    for (;;) {
        sum = 0u; cnt = 0u; mine = 0u;
#pragma unroll
        for (unsigned j = 0; j < 16; ++j) { const unsigned c = xb_ld(&bar[XB_XCNT(j)]); sum += c; cnt += (c > 0u) ? 1u : 0u; mine = (j == x) ? c : mine; }
        if (sum == G) break;
        __builtin_amdgcn_s_sleep(1);
        if ((++sp & 255u) == 0u) { if (xb_ld(&bar[XB_TMO])) break; if (sp > XB_SPIN_CAP) { atomicAdd(&bar[XB_TMO], 1u); break; } }
    }
    nloc = mine > 0u ? mine : 1u; nx = cnt > 0u ? cnt : 1u;
}
__device__ __forceinline__ void xcd_barrier(const XcdBarrier& b) {
    asm volatile("s_waitcnt vmcnt(0)" ::: "memory");
    __syncthreads();
    if (threadIdx.x == 0) {
        unsigned* bar = b.bar;
        __builtin_amdgcn_s_waitcnt(0);
        unsigned nloc = b.st[0], nx = b.st[1];
        if (nloc == 0u) { xcd_barrier_complete(bar, b.x, nloc, nx); b.st[0] = nloc; b.st[1] = nx; }
        const unsigned old = xb_add(&bar[XB_XSUB(b.x)], 1u);
        const unsigned gen = old / nloc;
        if (old + 1u == (gen + 1u) * nloc) {
            __builtin_amdgcn_fence(__ATOMIC_RELEASE, "agent");
            asm volatile("s_waitcnt vmcnt(0)" ::: "memory");
            const unsigned og = xb_add(&bar[XB_TOP], 1u);
            const unsigned tg = og / nx;
            if (og + 1u == (tg + 1u) * nx) xb_add(&bar[XB_TOPGEN], 1u);
            else XB_SPIN(xb_ld(&bar[XB_TOPGEN]) == tg, bar);
            __builtin_amdgcn_fence(__ATOMIC_ACQUIRE, "agent");
            xb_add(&bar[XB_XGEN(b.x)], 1u);
            asm volatile("s_waitcnt vmcnt(0)" ::: "memory");
        } else {
            XB_SPIN(xb_ld(&bar[XB_XGEN(b.x)]) == gen, bar);
            __builtin_amdgcn_fence(__ATOMIC_ACQUIRE, "agent");
            asm volatile("s_waitcnt vmcnt(0)" ::: "memory");
        }
    }
    __syncthreads();
}

__device__ __forceinline__ int inproj_old_col(int n) {
    if (n < 2304) return n;
    if (n < 2816) return 2312 + (n - 2304);
    if (n < 2824) return 2304 + (n - 2816);
    return -1;
}
__device__ __forceinline__ void transpose_item(const float* __restrict__ W, int N_src, bf16_t* __restrict__ WT, int K, int kb, int nb, bool permute, float* scr) {
    const int tid = threadIdx.x;
    const int nn = tid & 63, k8 = tid >> 6;
    const int n = nb * 64 + nn;
    const int oc = permute ? inproj_old_col(n) : n;
#pragma unroll
    for (int i = 0; i < 8; ++i) { const int kk = k8 + 8 * i; scr[kk * 65 + nn] = (oc >= 0) ? W[(size_t)(kb * 64 + kk) * N_src + oc] : 0.f; }
    __syncthreads();
    const int n2 = tid >> 3, c = tid & 7;
    const float* s = scr + (c * 8) * 65 + n2;
    u32x4 o; o.x = pk_bf16(s[0], s[65]); o.y = pk_bf16(s[2 * 65], s[3 * 65]); o.z = pk_bf16(s[4 * 65], s[5 * 65]); o.w = pk_bf16(s[6 * 65], s[7 * 65]);
    *(u32x4*)(WT + (size_t)(nb * 64 + n2) * K + kb * 64 + c * 8) = o;
    __syncthreads();
}
__device__ __forceinline__ void phase_prep(const Params& p, unsigned char* smem) {
    const int tid = threadIdx.x, G = gridDim.x, bid = blockIdx.x;
    float* scr = (float*)smem;
    constexpr int I_IN = 16 * (NP_IN / 64), I_OUT = 16 * 16, I_Q = 16 * 32;
    for (int it = bid; it < I_IN + I_OUT + I_Q; it += G) {
        int r = it;
        if (r < I_IN) { transpose_item(p.w_in, IN_WIDTH, p.wt_in, 1024, r / (NP_IN / 64), r % (NP_IN / 64), true, scr); continue; } r -= I_IN;
        if (r < I_OUT) { transpose_item(p.w_out, 1024, p.wt_out, 1024, r / 16, r % 16, false, scr); continue; } r -= I_OUT;
        transpose_item(p.w_query, 2048, p.wt_q, 1024, r / 32, r % 32, false, scr);
    }
    const size_t gt = (size_t)bid * NTHREADS + tid, GT = (size_t)G * NTHREADS;
    for (size_t i0 = gt; i0 < (size_t)M_TOK * 1024 / 8; i0 += GT * 4) {
        float4 a[4], b[4];
#pragma unroll
        for (int u = 0; u < 4; ++u) { const size_t i = i0 + u * GT; if (i < (size_t)M_TOK * 1024 / 8) { a[u] = *(const float4*)(p.x + i * 8); b[u] = *(const float4*)(p.x + i * 8 + 4); } }
#pragma unroll
        for (int u = 0; u < 4; ++u) { const size_t i = i0 + u * GT; if (i < (size_t)M_TOK * 1024 / 8) {
            u32x4 o; o.x = pk_bf16(a[u].x, a[u].y); o.y = pk_bf16(a[u].z, a[u].w); o.z = pk_bf16(b[u].x, b[u].y); o.w = pk_bf16(b[u].z, b[u].w);
            *(u32x4*)(p.xb + i * 8) = o; } }
    }
    for (size_t i = gt; i < (size_t)16 * 4 * 8 * 64; i += GT) {
        const int ln = (int)(i & 63), ks = (int)((i >> 6) & 7), kt = (int)((i >> 9) & 3), hp = (int)(i >> 11);
        const float* src = p.sub_keys + ((size_t)(hp * 128 + 32 * kt + (ln & 31))) * 128 + 16 * ks + 8 * (ln >> 5);
        const float4 a = *(const float4*)src, b = *(const float4*)(src + 4);
        u32x4 o; o.x = pk_bf16(a.x, a.y); o.y = pk_bf16(a.z, a.w); o.z = pk_bf16(b.x, b.y); o.w = pk_bf16(b.z, b.w);
        *(u32x4*)(p.sk_frag + i * 8) = o;
    }
    for (size_t i = gt; i < (size_t)M_TOK * 32; i += GT) {
        const int m = (int)(i >> 5), j = (int)(i & 31);
        const float inv_freq = powf(10000.0f, -(float)j / 32.0f);
        const float ang = (float)p.positions[m] * inv_freq;
        p.rope_cs[i] = cosf(ang); p.rope_cs[(size_t)M_TOK * 32 + i] = sinf(ang);
    }
}

constexpr int GK = 1024, GBK = 64, G_TILE_BYTES = 256 * 128;
constexpr int STG_STRIDE = 260;
constexpr int SMEM_BYTES = 147456;

__device__ __forceinline__ int swz(int row, int chunk) { return row * 128 + ((chunk ^ ((row >> 1) & 7)) << 4); }

struct EpiInProj {
    bf16_t* out; const float* cs;
    __device__ __forceinline__ void operator()(int m, int pn, int c8, const unsigned char* stg_row) const {
        const int col = pn * 256 + c8 * 8;
        u32x2 a0 = *(const u32x2*)(stg_row + c8 * 16), a1 = *(const u32x2*)(stg_row + c8 * 16 + 8);
        u32x4 o; o.x = a0.x; o.y = a0.y; o.z = a1.x; o.w = a1.y;
        if (col < P_AV) {
            const int d0 = col & 63, i0 = d0 & 31; const bool second = d0 >= 32;
            const int pc8 = second ? c8 - 4 : c8 + 4;
            const u32x2 b0 = *(const u32x2*)(stg_row + pc8 * 16), b1 = *(const u32x2*)(stg_row + pc8 * 16 + 8);
            const unsigned mine[4] = {a0.x, a0.y, a1.x, a1.y}, oth[4] = {b0.x, b0.y, b1.x, b1.y};
            const float* cp = cs + (size_t)m * 32 + i0; const float* sp = cs + (size_t)M_TOK * 32 + (size_t)m * 32 + i0;
            const float4 c0 = *(const float4*)cp, c1 = *(const float4*)(cp + 4), s0 = *(const float4*)sp, s1 = *(const float4*)(sp + 4);
            const float cc[8] = {c0.x, c0.y, c0.z, c0.w, c1.x, c1.y, c1.z, c1.w}, ss[8] = {s0.x, s0.y, s0.z, s0.w, s1.x, s1.y, s1.z, s1.w};
            const float scale = col < P_AK ? 0.125f : 1.f;
            float r[8];
#pragma unroll
            for (int j = 0; j < 8; ++j) {
                const float me = (j & 1) ? bfhi(mine[j >> 1]) : bflo(mine[j >> 1]);
                const float ot = (j & 1) ? bfhi(oth[j >> 1]) : bflo(oth[j >> 1]);
                r[j] = (second ? (me * cc[j] + ot * ss[j]) : (me * cc[j] - ot * ss[j])) * scale;
            }
            o.x = pk_bf16(r[0], r[1]); o.y = pk_bf16(r[2], r[3]); o.z = pk_bf16(r[4], r[5]); o.w = pk_bf16(r[6], r[7]);
        }
        *(u32x4*)(out + (size_t)m * NP_IN + col) = o;
    }
};
struct EpiOutProj {
    float* y; const float* x;
    __device__ __forceinline__ void operator()(int m, int pn, int c8, const unsigned char* stg_row) const {
        const int col = pn * 256 + c8 * 8;
        const u32x2 a0 = *(const u32x2*)(stg_row + c8 * 16), a1 = *(const u32x2*)(stg_row + c8 * 16 + 8);
        const float4 x0 = *(const float4*)(x + (size_t)m * 1024 + col), x1 = *(const float4*)(x + (size_t)m * 1024 + col + 4);
        *(float4*)(y + (size_t)m * 1024 + col) = make_float4(ALPHA * x0.x + bflo(a0.x), ALPHA * x0.y + bfhi(a0.x), ALPHA * x0.z + bflo(a0.y), ALPHA * x0.w + bfhi(a0.y));
        *(float4*)(y + (size_t)m * 1024 + col + 4) = make_float4(ALPHA * x1.x + bflo(a1.x), ALPHA * x1.y + bfhi(a1.x), ALPHA * x1.z + bflo(a1.y), ALPHA * x1.w + bfhi(a1.y));
    }
};
struct EpiBf16 {
    bf16_t* out; int ldc;
    __device__ __forceinline__ void operator()(int m, int pn, int c8, const unsigned char* stg_row) const {
        const int col = pn * 256 + c8 * 8;
        const u32x2 a0 = *(const u32x2*)(stg_row + c8 * 16), a1 = *(const u32x2*)(stg_row + c8 * 16 + 8);
        u32x4 o; o.x = a0.x; o.y = a0.y; o.z = a1.x; o.w = a1.y;
        *(u32x4*)(out + (size_t)m * ldc + col) = o;
    }
};

template <class EPI>
__device__ __forceinline__ void gemm_phase(const bf16_t* __restrict__ A, const bf16_t* __restrict__ Bt, int M, int N, const EPI& epi, unsigned char* smem) {
    const int tid = threadIdx.x, lane = tid & 63, wave = tid >> 6, r = lane & 31, h = lane >> 5;
    const int wm = wave >> 2, wn = wave & 3;
    const int nM = M / 256, nN = N / 256, ntiles = nM * nN;
    const int gx = gridDim.x, nxg = (gx % 8 == 0 && ntiles % 8 == 0) ? 8 : 1, bpg = gx / nxg, tpg = ntiles / nxg;
    const int grp = blockIdx.x % nxg, bin = blockIdx.x / nxg;
    const int grow = 16 * wave + (lane >> 2), gch = (lane & 3) ^ ((grow >> 2) & 3);
    const unsigned goff = (unsigned)(grow * GK + gch * 8) * 2u;
    constexpr int NKT = GK / 32, STG = 32768;
#define G_STAGE(kt_, Ag_, Bg_) do { const unsigned char* ab_ = (const unsigned char*)(Ag_) + (kt_) * 64; const unsigned char* bb_ = (const unsigned char*)(Bg_) + (kt_) * 64; \
            unsigned char* la_ = smem + ((kt_) & 3) * STG + wave * 1024; \
            _Pragma("unroll") for (int i_ = 0; i_ < 2; ++i_) { \
                __builtin_amdgcn_global_load_lds((const unsigned*)(ab_ + i_ * (128 * GK * 2) + goff), (unsigned*)(la_ + i_ * 8192), 16, 0, 0); \
                __builtin_amdgcn_global_load_lds((const unsigned*)(bb_ + i_ * (128 * GK * 2) + goff), (unsigned*)(la_ + 16384 + i_ * 8192), 16, 0, 0); } } while (0)
#define G_SWZ32(row_, c_) ((row_) * 64 + ((((c_) ^ ((row_) >> 2)) & 3) << 4))
#define G_COMPUTE(kt_) do { const unsigned char* la_ = smem + ((kt_) & 3) * STG; const unsigned char* lb_ = la_ + 16384; \
            _Pragma("unroll") for (int ks_ = 0; ks_ < 2; ++ks_) { bf16x8 af_[4], bf_[2]; \
                _Pragma("unroll") for (int i_ = 0; i_ < 4; ++i_) af_[i_] = *(const bf16x8*)(la_ + G_SWZ32(wm * 128 + i_ * 32 + r, ks_ * 2 + h)); \
                _Pragma("unroll") for (int j_ = 0; j_ < 2; ++j_) bf_[j_] = *(const bf16x8*)(lb_ + G_SWZ32(wn * 64 + j_ * 32 + r, ks_ * 2 + h)); \
                _Pragma("unroll") for (int j_ = 0; j_ < 2; ++j_) _Pragma("unroll") for (int i_ = 0; i_ < 4; ++i_) acc[j_][i_] = __builtin_amdgcn_mfma_f32_32x32x16_bf16(bf_[j_], af_[i_], acc[j_][i_], 0, 0, 0); } } while (0)
#define G_RAWBAR() do { asm volatile("s_waitcnt lgkmcnt(0)" ::: "memory"); __builtin_amdgcn_s_barrier(); asm volatile("" ::: "memory"); } while (0)
    for (int tt = bin; tt < tpg; tt += bpg) {
        const int t = grp * tpg + tt;
        const int pm = t / nN, pn = t % nN;
        const bf16_t* Ag = A + (size_t)pm * 256 * GK; const bf16_t* Bg = Bt + (size_t)pn * 256 * GK;
        f32x16 acc[2][4];
#pragma unroll
        for (int j = 0; j < 2; ++j)
#pragma unroll
            for (int i = 0; i < 4; ++i)
#pragma unroll
                for (int e = 0; e < 16; ++e) acc[j][i][e] = 0.f;
        G_RAWBAR();
        G_STAGE(0, Ag, Bg); G_STAGE(1, Ag, Bg); G_STAGE(2, Ag, Bg);
        for (int kt = 0; kt < NKT; ++kt) {
            if (kt + 2 < NKT) asm volatile("s_waitcnt vmcnt(8)" ::: "memory");
            else if (kt + 1 < NKT) asm volatile("s_waitcnt vmcnt(4)" ::: "memory");
            else asm volatile("s_waitcnt vmcnt(0)" ::: "memory");
            G_RAWBAR();
            if (kt + 3 < NKT) G_STAGE(kt + 3, Ag, Bg);
            G_COMPUTE(kt);
        }
        G_RAWBAR();
#pragma unroll
        for (int j = 0; j < 2; ++j)
#pragma unroll
            for (int i = 0; i < 4; ++i)
#pragma unroll
                for (int g = 0; g < 4; ++g) {
                    u32x2 v; v.x = pk_bf16(acc[j][i][4 * g], acc[j][i][4 * g + 1]); v.y = pk_bf16(acc[j][i][4 * g + 2], acc[j][i][4 * g + 3]);
                    *(u32x2*)(smem + (size_t)(wm * 128 + i * 32 + r) * (STG_STRIDE * 2) + (wn * 64 + j * 32 + 8 * g + 4 * h) * 2) = v;
                }
        __syncthreads();
        const int erow = tid >> 5, ec8 = tid & 31;
#pragma unroll 4
        for (int ps = 0; ps < 16; ++ps) { const int row = ps * 16 + erow; epi(pm * 256 + row, pn, ec8, smem + (size_t)row * (STG_STRIDE * 2)); }
    }
#undef G_STAGE
#undef G_COMPUTE
#undef G_SWZ32
#undef G_RAWBAR
    __syncthreads();
}


constexpr int DN_CH_BYTES = 73728;

constexpr int DP_QS = 0, DP_KS = 16384, DP_TI = 0, DP_Q = 17408, DP_TB = 21632;
constexpr int DP_RT = 32768;
constexpr int DP_AM = 69632;
constexpr int DP_KDT = 87040;
constexpr int DP_QK = 104448;
constexpr int DP_WI = 113152;
constexpr int DP_SM = 130048;

__device__ __forceinline__ void phase_dn_prep(const Params& p, unsigned char* smem) {
    const int tid0 = threadIdx.x;
    float* sbeta = (float*)(smem + DP_SM); float* sgc = sbeta + 64; float* segc = sbeta + 128; float* sekd = sbeta + 192;
    float* Am = (float*)(smem + DP_AM); float* Ti = (float*)(smem + DP_TI); float* Qb = (float*)(smem + DP_Q);
    bf16_t* Tb = (bf16_t*)(smem + DP_TB); bf16_t* Rt = (bf16_t*)(smem + DP_RT);
    bf16_t* kdt = (bf16_t*)(smem + DP_KDT); bf16_t* qki = (bf16_t*)(smem + DP_QK); bf16_t* wim = (bf16_t*)(smem + DP_WI);
    for (int ci = blockIdx.x; ci < 16 * 128; ci += gridDim.x) {
        int tid = tid0; asm volatile("" : "+v"(tid));
        const int lane = tid & 63, wave = tid >> 6;
        const int bh = ci >> 7, n = ci & 127, b = bh >> 2, h = bh & 3;
        const bf16_t* prow = p.proj_b + (size_t)b * SEQ * NP_IN;
        if (wave == 0) {
            const size_t m = (size_t)(n * 64 + lane);
            const float braw = bf2f(prow[m * NP_IN + P_B + h]), araw = bf2f(prow[m * NP_IN + P_A + h]);
            const float beta = 1.f / (1.f + expf(-braw));
            const float xx = araw + p.dt_bias[h];
            const float sp = xx > 20.f ? xx : log1pf(expf(xx));
            float g = -expf(p.a_log[h]) * sp;
#pragma unroll
            for (int o = 1; o < 64; o <<= 1) { const float up = __shfl_up(g, o); if (lane >= o) g += up; }
            const float g63 = __shfl(g, 63);
            sbeta[lane] = beta; sgc[lane] = g; segc[lane] = expf(g); sekd[lane] = expf(g63 - g);
            if (lane == 63) p.dn_gl[ci] = expf(g63);
        }
        __syncthreads();
        {
            const int i = tid >> 3, sg = tid & 7, c0 = sg * 16;
            const float beta_i = sbeta[i], egc_i = segc[i], ekd_i = sekd[i];
            const int tt0 = n * 64 + i - 3;
#pragma unroll
            for (int mat = 0; mat < 3; ++mat) {
                const int colbase = (mat == 0 ? P_DQ : (mat == 1 ? P_DK : P_DV)) + h * 128 + c0;
                float acc[16];
#pragma unroll
                for (int cc = 0; cc < 16; ++cc) acc[cc] = 0.f;
#pragma unroll
                for (int j = 0; j < 4; ++j) {
                    const int tt = tt0 + j;
                    if (tt >= 0) {
                        const u32x4 x0 = *(const u32x4*)(prow + (size_t)tt * NP_IN + colbase), x1 = *(const u32x4*)(prow + (size_t)tt * NP_IN + colbase + 8);
                        const float* wp = p.conv_w + j * 1536 + mat * 512 + h * 128 + c0;
                        const float4 w0 = *(const float4*)wp, w1 = *(const float4*)(wp + 4), w2 = *(const float4*)(wp + 8), w3 = *(const float4*)(wp + 12);
                        acc[0] = fmaf(w0.x, bflo(x0.x), acc[0]); acc[1] = fmaf(w0.y, bfhi(x0.x), acc[1]); acc[2] = fmaf(w0.z, bflo(x0.y), acc[2]); acc[3] = fmaf(w0.w, bfhi(x0.y), acc[3]);
                        acc[4] = fmaf(w1.x, bflo(x0.z), acc[4]); acc[5] = fmaf(w1.y, bfhi(x0.z), acc[5]); acc[6] = fmaf(w1.z, bflo(x0.w), acc[6]); acc[7] = fmaf(w1.w, bfhi(x0.w), acc[7]);
                        acc[8] = fmaf(w2.x, bflo(x1.x), acc[8]); acc[9] = fmaf(w2.y, bfhi(x1.x), acc[9]); acc[10] = fmaf(w2.z, bflo(x1.y), acc[10]); acc[11] = fmaf(w2.w, bfhi(x1.y), acc[11]);
                        acc[12] = fmaf(w3.x, bflo(x1.z), acc[12]); acc[13] = fmaf(w3.y, bfhi(x1.z), acc[13]); acc[14] = fmaf(w3.z, bflo(x1.w), acc[14]); acc[15] = fmaf(w3.w, bfhi(x1.w), acc[15]);
                    }
                }
                float ss = 0.f;
#pragma unroll
                for (int cc = 0; cc < 16; ++cc) { acc[cc] = silu_f(acc[cc]); ss = fmaf(acc[cc], acc[cc], ss); }
                if (mat < 2) {
                    ss += __shfl_xor(ss, 1); ss += __shfl_xor(ss, 2); ss += __shfl_xor(ss, 4);
                    const float rs = rsqrtf(ss + L2_EPS) * (mat == 0 ? 0.08838834764831845f : 1.f);
#pragma unroll
                    for (int cc = 0; cc < 16; ++cc) acc[cc] *= rs;
                    unsigned char* img = smem + (mat == 0 ? DP_QS : DP_KS) + i * 256;
                    u32x4 c0v, c1v;
                    c0v.x = pk_bf16(acc[0], acc[1]); c0v.y = pk_bf16(acc[2], acc[3]); c0v.z = pk_bf16(acc[4], acc[5]); c0v.w = pk_bf16(acc[6], acc[7]);
                    c1v.x = pk_bf16(acc[8], acc[9]); c1v.y = pk_bf16(acc[10], acc[11]); c1v.z = pk_bf16(acc[12], acc[13]); c1v.w = pk_bf16(acc[14], acc[15]);
                    *(u32x4*)(img + (((2 * sg) ^ (i & 15)) << 4)) = c0v;
                    *(u32x4*)(img + (((2 * sg + 1) ^ (i & 15)) << 4)) = c1v;
                }
                if (mat == 0) {
                    u32x4 p0, p1;
                    p0.x = pk_bf16(acc[0] * egc_i, acc[1] * egc_i); p0.y = pk_bf16(acc[2] * egc_i, acc[3] * egc_i); p0.z = pk_bf16(acc[8] * egc_i, acc[9] * egc_i); p0.w = pk_bf16(acc[10] * egc_i, acc[11] * egc_i);
                    p1.x = pk_bf16(acc[4] * egc_i, acc[5] * egc_i); p1.y = pk_bf16(acc[6] * egc_i, acc[7] * egc_i); p1.z = pk_bf16(acc[12] * egc_i, acc[13] * egc_i); p1.w = pk_bf16(acc[14] * egc_i, acc[15] * egc_i);
                    bf16_t* dst = p.dn_qd + ((size_t)(ci * 16 + (i >> 5) * 8 + sg) * 64) * 8;
                    *(u32x4*)(dst + (size_t)(i & 31) * 8) = p0;
                    *(u32x4*)(dst + (size_t)(32 + (i & 31)) * 8) = p1;
                } else if (mat == 1) {
                    const float sc = beta_i * egc_i;
#pragma unroll
                    for (int cc = 0; cc < 16; ++cc) {
                        Rt[(128 + c0 + cc) * 72 + i] = (bf16_t)(pk_bf16(acc[cc] * sc, 0.f) & 0xffffu);
                        kdt[(c0 + cc) * 68 + i] = (bf16_t)(pk_bf16(acc[cc] * ekd_i, 0.f) & 0xffffu);
                    }
                } else {
#pragma unroll
                    for (int cc = 0; cc < 16; ++cc) Rt[(c0 + cc) * 72 + i] = (bf16_t)(pk_bf16(acc[cc] * beta_i, 0.f) & 0xffffu);
                }
            }
        }
        __syncthreads();
        {
            const int mat = wave >> 2, ti = (wave >> 1) & 1, tj = wave & 1, r = lane & 31, hh = lane >> 5;
            const unsigned char* ai = smem + (mat ? DP_QS : DP_KS) + (ti * 32 + r) * 256;
            const unsigned char* bi = smem + DP_KS + (tj * 32 + r) * 256;
            f32x16 d;
#pragma unroll
            for (int e = 0; e < 16; ++e) d[e] = 0.f;
#pragma unroll
            for (int ks = 0; ks < 8; ++ks) {
                const bf16x8 af = *(const bf16x8*)(ai + (((2 * ks + hh) ^ (r & 15)) << 4));
                const bf16x8 bf = *(const bf16x8*)(bi + (((2 * ks + hh) ^ (r & 15)) << 4));
                d = __builtin_amdgcn_mfma_f32_32x32x16_bf16(af, bf, d, 0, 0, 0);
            }
            const int j = tj * 32 + r; const float gcj = sgc[j];
#pragma unroll
            for (int e = 0; e < 16; ++e) {
                const int i = ti * 32 + (e & 3) + 8 * (e >> 2) + 4 * hh;
                const float dec = __expf(fminf(sgc[i] - gcj, 0.f));
                if (mat == 0) Am[i * 68 + j] = (j < i) ? sbeta[i] * d[e] * dec : 0.f;
                else qki[i * 68 + j] = (bf16_t)(pk_bf16((j <= i) ? d[e] * dec : 0.f, 0.f) & 0xffffu);
            }
        }
        __syncthreads();
        if (tid < 64) {
            const int bk = tid >> 4, c = tid & 15;
            const float* Ab = Am + (16 * bk) * 68 + 16 * bk;
            float X[16];
#pragma unroll
            for (int i = 0; i < 16; ++i) {
                float sacc = 0.f;
#pragma unroll
                for (int j = 0; j < i; ++j) sacc = fmaf(Ab[i * 68 + j], X[j], sacc);
                X[i] = ((i == c) ? 1.f : 0.f) - sacc;
            }
#pragma unroll
            for (int i = 0; i < 16; ++i) Ti[(16 * bk + i) * 68 + 16 * bk + c] = X[i];
        } else {
            for (int z = tid - 64; z < 6 * 256; z += 448) {
                const int blk = z >> 8, e2 = z & 255, bi = blk < 3 ? 0 : (blk < 5 ? 1 : 2), bj = blk < 3 ? blk + 1 : (blk < 5 ? blk - 1 : 3);
                Ti[(16 * bi + (e2 >> 4)) * 68 + 16 * bj + (e2 & 15)] = 0.f;
            }
        }
        __syncthreads();
        {
            const int w2 = tid >> 8, o = tid & 255, ri = o >> 4, cj = o & 15, r0 = 16 * (2 * w2 + 1), c0 = 16 * (2 * w2);
            float sacc = 0.f;
#pragma unroll
            for (int k = 0; k < 16; ++k) sacc = fmaf(Am[(r0 + ri) * 68 + c0 + k], Ti[(c0 + k) * 68 + c0 + cj], sacc);
            Qb[w2 * 272 + ri * 17 + cj] = sacc;
        }
        __syncthreads();
        {
            const int w2 = tid >> 8, o = tid & 255, ri = o >> 4, cj = o & 15, r0 = 16 * (2 * w2 + 1), c0 = 16 * (2 * w2);
            float sacc = 0.f;
#pragma unroll
            for (int k = 0; k < 16; ++k) sacc = fmaf(Ti[(r0 + ri) * 68 + r0 + k], Qb[w2 * 272 + k * 17 + cj], sacc);
            Ti[(r0 + ri) * 68 + c0 + cj] = -sacc;
        }
        __syncthreads();
        float q3[2];
#pragma unroll
        for (int q = 0; q < 2; ++q) {
            const int o = tid + 512 * q, ri = o >> 5, cj = o & 31;
            float sacc = 0.f;
#pragma unroll
            for (int k = 0; k < 32; ++k) sacc = fmaf(Am[(32 + ri) * 68 + k], Ti[k * 68 + cj], sacc);
            q3[q] = sacc;
        }
#pragma unroll
        for (int q = 0; q < 2; ++q) { const int o = tid + 512 * q; Qb[(o >> 5) * 33 + (o & 31)] = q3[q]; }
        __syncthreads();
#pragma unroll
        for (int q = 0; q < 2; ++q) {
            const int o = tid + 512 * q, ri = o >> 5, cj = o & 31;
            float sacc = 0.f;
#pragma unroll
            for (int k = 0; k < 32; ++k) sacc = fmaf(Ti[(32 + ri) * 68 + 32 + k], Qb[k * 33 + cj], sacc);
            q3[q] = -sacc;
        }
        __syncthreads();
#pragma unroll
        for (int q = 0; q < 2; ++q) { const int o = tid + 512 * q; Ti[(32 + (o >> 5)) * 68 + (o & 31)] = q3[q]; }
        __syncthreads();
#pragma unroll
        for (int q = 0; q < 4; ++q) {
            const int o2 = tid + 512 * q, ri = o2 >> 5, c2 = (o2 & 31) * 2;
            *(unsigned*)(Tb + ri * 72 + c2) = pk_bf16(Ti[ri * 68 + c2], Ti[ri * 68 + c2 + 1]);
        }
        __syncthreads();
        {
            const int ct = wave, r = lane & 31, hh = lane >> 5;
            f32x16 xacc[2];
#pragma unroll
            for (int T = 0; T < 2; ++T)
#pragma unroll
                for (int e = 0; e < 16; ++e) xacc[T][e] = 0.f;
#pragma unroll
            for (int ks = 0; ks < 4; ++ks) {
                const bf16x8 bfr = *(const bf16x8*)(Rt + (32 * ct + r) * 72 + 16 * ks + 8 * hh);
#pragma unroll
                for (int T = 0; T < 2; ++T) {
                    const bf16x8 afr = *(const bf16x8*)(Tb + (32 * T + r) * 72 + 16 * ks + 8 * hh);
                    xacc[T] = __builtin_amdgcn_mfma_f32_32x32x16_bf16(afr, bfr, xacc[T], 0, 0, 0);
                }
            }
            if (ct < 4) {
#pragma unroll
                for (int T = 0; T < 2; ++T)
#pragma unroll
                    for (int hf = 0; hf < 2; ++hf) {
                        u32x4 o; o.x = pk_bf16(xacc[T][8 * hf], xacc[T][8 * hf + 1]); o.y = pk_bf16(xacc[T][8 * hf + 2], xacc[T][8 * hf + 3]);
                        o.z = pk_bf16(xacc[T][8 * hf + 4], xacc[T][8 * hf + 5]); o.w = pk_bf16(xacc[T][8 * hf + 6], xacc[T][8 * hf + 7]);
                        *(u32x4*)(p.dn_u + ((size_t)(((ci * 4 + ct) * 2 + T) * 2 + hf) * 64 + lane) * 8) = o;
                    }
            } else {
                const int dd = 32 * (ct - 4) + r;
#pragma unroll
                for (int T = 0; T < 2; ++T)
#pragma unroll
                    for (int e = 0; e < 16; ++e) wim[(32 * T + (e & 3) + 8 * (e >> 2) + 4 * hh) * 132 + dd] = (bf16_t)(pk_bf16(-xacc[T][e], 0.f) & 0xffffu);
            }
#pragma unroll
            for (int q = 0; q < 3; ++q) {
                const int pc = tid + 512 * q;
                if (pc < 512) {
                    const int f = pc >> 6, ln = pc & 63, r2 = ln & 31, h2 = ln >> 5, rt = f >> 2, ks = f & 3;
                    const bf16_t* src = qki + (32 * rt + r2) * 68 + 16 * ks + 4 * h2;
                    const u32x2 lo = *(const u32x2*)src, hi = *(const u32x2*)(src + 8);
                    u32x4 o; o.x = lo.x; o.y = lo.y; o.z = hi.x; o.w = hi.y;
                    *(u32x4*)(p.dn_qk + ((size_t)(ci * 8 + f) * 64 + ln) * 8) = o;
                } else {
                    const int pc2 = pc - 512, f = pc2 >> 6, ln = pc2 & 63, r2 = ln & 31, h2 = ln >> 5, rt = f >> 2, ks = f & 3;
                    const bf16_t* src = kdt + (32 * rt + r2) * 68 + 16 * ks + 4 * h2;
                    const u32x2 lo = *(const u32x2*)src, hi = *(const u32x2*)(src + 8);
                    u32x4 o; o.x = lo.x; o.y = lo.y; o.z = hi.x; o.w = hi.y;
                    *(u32x4*)(p.dn_kdt + ((size_t)(ci * 16 + f) * 64 + ln) * 8) = o;
                }
            }
        }
        __syncthreads();
#pragma unroll
        for (int q = 0; q < 2; ++q) {
            const int pc = tid + 512 * q, f = pc >> 6, ln = pc & 63, r = ln & 31, hh = ln >> 5, rt = f >> 3, ks = f & 7;
            const bf16_t* src = wim + (32 * rt + r) * 132 + 16 * ks + 4 * hh;
            const u32x2 lo = *(const u32x2*)src, hi = *(const u32x2*)(src + 8);
            u32x4 o; o.x = lo.x; o.y = lo.y; o.z = hi.x; o.w = hi.y;
            *(u32x4*)(p.dn_negw + ((size_t)(ci * 16 + f) * 64 + ln) * 8) = o;
        }
    }
    __syncthreads();
}

__device__ __forceinline__ bf16x8 pack8(const f32x16& x, int s) {
    u32x4 v;
    v.x = pk_bf16(x[8 * s], x[8 * s + 1]); v.y = pk_bf16(x[8 * s + 2], x[8 * s + 3]); v.z = pk_bf16(x[8 * s + 4], x[8 * s + 5]); v.w = pk_bf16(x[8 * s + 6], x[8 * s + 7]);
    return __builtin_bit_cast(bf16x8, v);
}
#define LDS_BARRIER() do { asm volatile("s_waitcnt lgkmcnt(0)" ::: "memory"); __builtin_amdgcn_s_barrier(); asm volatile("" ::: "memory"); } while (0)
__device__ __forceinline__ const bf16_t* dn_piece_src(const Params& p, int ci, int pc) {
    return pc < 1024 ? p.dn_negw + ((size_t)ci * 1024 + pc) * 8 : pc < 2048 ? p.dn_qd + ((size_t)ci * 1024 + (pc - 1024)) * 8
         : pc < 3072 ? p.dn_kdt + ((size_t)ci * 1024 + (pc - 2048)) * 8 : pc < 3584 ? p.dn_qk + ((size_t)ci * 512 + (pc - 3072)) * 8 : p.dn_u + ((size_t)ci * 1024 + (pc - 3584)) * 8;
}
__device__ __forceinline__ void phase_dn_scan(const Params& p, unsigned char* smem) {
    const int tid = threadIdx.x, lane = tid & 63, wave = tid >> 6, r = lane & 31, hh = lane >> 5;
    const int bh = blockIdx.x, b = bh >> 2, h = bh & 3, ci0 = bh * 128;
#pragma unroll
    for (int q = 0; q < 9; ++q) { const int pc = tid + 512 * q; *(u32x4*)(smem + pc * 16) = *(const u32x4*)dn_piece_src(p, ci0, pc); }
    __syncthreads();
    if (wave >= 4) {
        const int t2 = tid - 256;
        unsigned* prog = p.bar + XCD_BAR_WORDS + 64 * bh;
        u32x4 sa[18], sb[18], sc[18];
#define DN_LD(dst, chunk) do { const int c_ = ci0 + ((chunk) < 127 ? (chunk) : 127); _Pragma("unroll") for (int q_ = 0; q_ < 18; ++q_) dst[q_] = *(const u32x4*)dn_piece_src(p, c_, t2 + 256 * q_); } while (0)
#define DN_WR(src, chunk) do { if ((chunk) < 128) { unsigned char* nb_ = smem + ((chunk) & 1) * DN_CH_BYTES; _Pragma("unroll") for (int q_ = 0; q_ < 18; ++q_) *(u32x4*)(nb_ + (t2 + 256 * q_) * 16) = src[q_]; } } while (0)
        DN_LD(sa, 1); DN_LD(sb, 2); DN_LD(sc, 3);
        for (int n = 0; n < 129; n += 3) {
            if (n < 128) { DN_WR(sa, n + 1); DN_LD(sa, n + 4); if (t2 == 0) __hip_atomic_store(prog, (unsigned)(n + 1), __ATOMIC_RELAXED, __HIP_MEMORY_SCOPE_AGENT); LDS_BARRIER(); }
            if (n + 1 < 128) { DN_WR(sb, n + 2); DN_LD(sb, n + 5); if (t2 == 0) __hip_atomic_store(prog, (unsigned)(n + 2), __ATOMIC_RELAXED, __HIP_MEMORY_SCOPE_AGENT); LDS_BARRIER(); }
            if (n + 2 < 128) { DN_WR(sc, n + 3); DN_LD(sc, n + 6); if (t2 == 0) __hip_atomic_store(prog, (unsigned)(n + 3), __ATOMIC_RELAXED, __HIP_MEMORY_SCOPE_AGENT); LDS_BARRIER(); }
        }
#undef DN_LD
#undef DN_WR
    } else {
        const int e = __builtin_amdgcn_readfirstlane(wave);
        const unsigned ooff = (unsigned)(4 * hh * 512 + r);
        f32x16 S[4];
#pragma unroll
        for (int T = 0; T < 4; ++T)
#pragma unroll
            for (int e2 = 0; e2 < 16; ++e2) S[T][e2] = 0.f;
        const float glr0 = p.dn_gl[ci0 + lane], glr1 = p.dn_gl[ci0 + 64 + lane];
#define DN_SB() __builtin_amdgcn_sched_barrier(0)
#define DN_RD8(dst, off) do { _Pragma("unroll") for (int q_ = 0; q_ < 8; ++q_) dst[q_] = *(const bf16x8*)(buf + (off) + q_ * 1024 + lane * 16); } while (0)
        bf16x8 Sb[8];
#pragma unroll
        for (int ks = 0; ks < 8; ++ks) Sb[ks] = (bf16x8){0, 0, 0, 0, 0, 0, 0, 0};
        for (int n = 0; n < 128; ++n) {
            const unsigned char* buf = smem + (n & 1) * DN_CH_BYTES;
            const float gl = __uint_as_float(__builtin_amdgcn_readlane(__float_as_uint(n < 64 ? glr0 : glr1), n & 63));
            bf16x8 fa[8], fb[8];
            DN_RD8(fa, 0);
            DN_RD8(fb, 8192);
            f32x16 vn0, vn1;
            {
                const unsigned char* ub = buf + 57344 + e * 4096 + lane * 16;
                const u32x4 u00 = *(const u32x4*)ub, u01 = *(const u32x4*)(ub + 1024), u10 = *(const u32x4*)(ub + 2048), u11 = *(const u32x4*)(ub + 3072);
                vn0[0] = bflo(u00.x); vn0[1] = bfhi(u00.x); vn0[2] = bflo(u00.y); vn0[3] = bfhi(u00.y); vn0[4] = bflo(u00.z); vn0[5] = bfhi(u00.z); vn0[6] = bflo(u00.w); vn0[7] = bfhi(u00.w);
                vn0[8] = bflo(u01.x); vn0[9] = bfhi(u01.x); vn0[10] = bflo(u01.y); vn0[11] = bfhi(u01.y); vn0[12] = bflo(u01.z); vn0[13] = bfhi(u01.z); vn0[14] = bflo(u01.w); vn0[15] = bfhi(u01.w);
                vn1[0] = bflo(u10.x); vn1[1] = bfhi(u10.x); vn1[2] = bflo(u10.y); vn1[3] = bfhi(u10.y); vn1[4] = bflo(u10.z); vn1[5] = bfhi(u10.z); vn1[6] = bflo(u10.w); vn1[7] = bfhi(u10.w);
                vn1[8] = bflo(u11.x); vn1[9] = bfhi(u11.x); vn1[10] = bflo(u11.y); vn1[11] = bfhi(u11.y); vn1[12] = bflo(u11.z); vn1[13] = bfhi(u11.z); vn1[14] = bflo(u11.w); vn1[15] = bfhi(u11.w);
            }
            DN_SB();
#pragma unroll
            for (int ks = 0; ks < 8; ++ks) vn0 = __builtin_amdgcn_mfma_f32_32x32x16_bf16(fa[ks], Sb[ks], vn0, 0, 0, 0);
            DN_SB();
            DN_RD8(fa, 16384);
            DN_SB();
#pragma unroll
            for (int ks = 0; ks < 8; ++ks) vn1 = __builtin_amdgcn_mfma_f32_32x32x16_bf16(fb[ks], Sb[ks], vn1, 0, 0, 0);
            DN_SB();
            DN_RD8(fb, 16384 + 8192);
            DN_SB();
            f32x16 o0, o1;
#pragma unroll
            for (int e2 = 0; e2 < 16; ++e2) { o0[e2] = 0.f; o1[e2] = 0.f; }
#pragma unroll
            for (int ks = 0; ks < 8; ++ks) o0 = __builtin_amdgcn_mfma_f32_32x32x16_bf16(fa[ks], Sb[ks], o0, 0, 0, 0);
            DN_SB();
            DN_RD8(fa, 32768);
            bf16x8 vb[4];
            vb[0] = pack8(vn0, 0); vb[1] = pack8(vn0, 1); vb[2] = pack8(vn1, 0); vb[3] = pack8(vn1, 1);
            DN_SB();
#pragma unroll
            for (int ks = 0; ks < 8; ++ks) o1 = __builtin_amdgcn_mfma_f32_32x32x16_bf16(fb[ks], Sb[ks], o1, 0, 0, 0);
            DN_SB();
            DN_RD8(fb, 32768 + 8192);
#pragma unroll
            for (int e2 = 0; e2 < 16; ++e2) { S[0][e2] *= gl; S[1][e2] *= gl; }
            DN_SB();
#pragma unroll
            for (int ks = 0; ks < 4; ++ks) S[0] = __builtin_amdgcn_mfma_f32_32x32x16_bf16(fa[ks], vb[ks], S[0], 0, 0, 0);
#pragma unroll
            for (int ks = 0; ks < 4; ++ks) S[1] = __builtin_amdgcn_mfma_f32_32x32x16_bf16(fa[4 + ks], vb[ks], S[1], 0, 0, 0);
            DN_SB();
            DN_RD8(fa, 49152);
#pragma unroll
            for (int e2 = 0; e2 < 16; ++e2) { S[2][e2] *= gl; S[3][e2] *= gl; }
            DN_SB();
#pragma unroll
            for (int ks = 0; ks < 4; ++ks) S[2] = __builtin_amdgcn_mfma_f32_32x32x16_bf16(fb[ks], vb[ks], S[2], 0, 0, 0);
#pragma unroll
            for (int ks = 0; ks < 4; ++ks) S[3] = __builtin_amdgcn_mfma_f32_32x32x16_bf16(fb[4 + ks], vb[ks], S[3], 0, 0, 0);
            DN_SB();
#pragma unroll
            for (int ks = 0; ks < 4; ++ks) o0 = __builtin_amdgcn_mfma_f32_32x32x16_bf16(fa[ks], vb[ks], o0, 0, 0, 0);
#pragma unroll
            for (int ks = 0; ks < 4; ++ks) o1 = __builtin_amdgcn_mfma_f32_32x32x16_bf16(fa[4 + ks], vb[ks], o1, 0, 0, 0);
            DN_SB();
#pragma unroll
            for (int T = 0; T < 4; ++T) { Sb[2 * T] = pack8(S[T], 0); Sb[2 * T + 1] = pack8(S[T], 1); }
            {
                bf16_t* ob = p.odn_raw + ((size_t)b * SEQ + n * 64) * 512 + h * 128 + 32 * e;
#pragma unroll
                for (int e2 = 0; e2 < 16; e2 += 2) {
                    const unsigned w0 = pk_bf16(o0[e2], o0[e2 + 1]), w1 = pk_bf16(o1[e2], o1[e2 + 1]);
                    (ob + ((e2 & 3) + 8 * (e2 >> 2)) * 512)[ooff] = (bf16_t)(w0 & 0xffffu); (ob + ((e2 & 3) + 1 + 8 * (e2 >> 2)) * 512)[ooff] = (bf16_t)(w0 >> 16);
                    (ob + (32 + (e2 & 3) + 8 * (e2 >> 2)) * 512)[ooff] = (bf16_t)(w1 & 0xffffu); (ob + (32 + (e2 & 3) + 1 + 8 * (e2 >> 2)) * 512)[ooff] = (bf16_t)(w1 >> 16);
                }
            }
            LDS_BARRIER();
        }
#undef DN_RD8
#undef DN_SB
    }
    __syncthreads();
}


__device__ __forceinline__ void phase_scan_l2_helper(const Params& p) {
    const int j = blockIdx.x, tid = threadIdx.x;
    const int bh = (j & 7) + 8 * ((j >> 3) & 1);
    const int hi = (j - 16) >> 4, nh = (gridDim.x - 16 + 15) >> 4;
    unsigned* prog = p.bar + XCD_BAR_WORDS + 64 * bh;
    constexpr int WIN = 10;
    unsigned acc = 0u;
    for (int m = 4 + hi; m < 128; m += nh) {
        unsigned spins = 0;
        for (;;) {
            const unsigned pr = __hip_atomic_load(prog, __ATOMIC_RELAXED, __HIP_MEMORY_SCOPE_AGENT);
            if ((int)pr + WIN >= m || ++spins > 200000u) break;
            __builtin_amdgcn_s_sleep(32);
        }
        const unsigned pr2 = __hip_atomic_load(prog, __ATOMIC_RELAXED, __HIP_MEMORY_SCOPE_AGENT);
        if ((int)pr2 + 3 >= m) continue;
        const int ci = bh * 128 + m;
#pragma unroll
        for (int q = 0; q < 9; ++q) { const u32x4 v = *(const u32x4*)dn_piece_src(p, ci, tid + 512 * q); acc ^= v.x ^ v.y ^ v.z ^ v.w; }
    }
    asm volatile("" :: "v"(acc));
}

constexpr int AT_VT = 32768, AT_VT_STRIDE = 260;
__device__ __forceinline__ void phase_attn(const Params& p, unsigned char* smem, int first_block) {
    const int tid0 = threadIdx.x;
    const int nblk = gridDim.x - first_block;
    const bf16_t* pb = p.proj_b;
    bf16_t* vt = (bf16_t*)(smem + AT_VT);
    for (int item = blockIdx.x - first_block; item < 1024; item += nblk) {
        int tid = tid0; asm volatile("" : "+v"(tid));
        const int lane = tid & 63, wave = tid >> 6, r = lane & 31, hh = lane >> 5;
        const int hp = item & 1, kvh = (item >> 1) & 1, nb = (item >> 2) & 63, b = item >> 8;
        const int m0 = b * SEQ + nb * 128;
        __syncthreads();
#pragma unroll
        for (int i = 0; i < 4; ++i) {
            const int idx = tid + 512 * i, key = idx >> 3, ch = idx & 7;
            const bool valid = (nb > 0) || (key >= 128);
            u32x4 kv = {0u, 0u, 0u, 0u}, vv = {0u, 0u, 0u, 0u};
            if (valid) { const bf16_t* src = pb + (size_t)(m0 - 128 + key) * NP_IN + kvh * 64 + ch * 8; kv = *(const u32x4*)(src + P_AK); vv = *(const u32x4*)(src + P_AV); }
            *(u32x4*)(smem + swz(key, ch)) = kv;
            bf16_t* vd = vt + (ch * 8) * AT_VT_STRIDE + key;
            vd[0] = (bf16_t)(vv.x & 0xffffu); vd[AT_VT_STRIDE] = (bf16_t)(vv.x >> 16); vd[2 * AT_VT_STRIDE] = (bf16_t)(vv.y & 0xffffu); vd[3 * AT_VT_STRIDE] = (bf16_t)(vv.y >> 16);
            vd[4 * AT_VT_STRIDE] = (bf16_t)(vv.z & 0xffffu); vd[5 * AT_VT_STRIDE] = (bf16_t)(vv.z >> 16); vd[6 * AT_VT_STRIDE] = (bf16_t)(vv.w & 0xffffu); vd[7 * AT_VT_STRIDE] = (bf16_t)(vv.w >> 16);
        }
        __syncthreads();
        const int head = kvh * 4 + hp * 2 + (wave >> 2), qt = wave & 3, qo = qt * 32;
        const bf16_t* qrow = pb + (size_t)(m0 + qo + r) * NP_IN + P_AQ + head * 64 + 8 * hh;
        bf16x8 qf[4];
#pragma unroll
        for (int ks = 0; ks < 4; ++ks) qf[ks] = *(const bf16x8*)(qrow + 16 * ks);
        f32x16 sc[5];
#pragma unroll
        for (int t = 0; t < 5; ++t) {
#pragma unroll
            for (int e = 0; e < 16; ++e) sc[t][e] = 0.f;
#pragma unroll
            for (int ks = 0; ks < 4; ++ks) sc[t] = __builtin_amdgcn_mfma_f32_32x32x16_bf16(*(const bf16x8*)(smem + swz((qt + t) * 32 + r, 2 * ks + hh)), qf[ks], sc[t], 0, 0, 0);
        }
        const float sink = p.sinks[head];
        float mx = -1e30f;
#pragma unroll
        for (int t = 0; t < 5; ++t)
#pragma unroll
            for (int e = 0; e < 16; ++e) {
                const int kf = 32 * (qt + t) + (e & 3) + 8 * (e >> 2) + 4 * hh;
                const bool ok = (kf >= qo + r + 1) && (kf <= qo + r + 128) && ((nb > 0) || (kf >= 128));
                sc[t][e] = ok ? sc[t][e] : -1e30f;
                mx = fmaxf(mx, sc[t][e]);
            }
        mx = fmaxf(mx, __shfl_xor(mx, 32));
        mx = fmaxf(mx, sink);
        float sum = 0.f;
#pragma unroll
        for (int t = 0; t < 5; ++t)
#pragma unroll
            for (int e = 0; e < 16; ++e) { const float pe = (sc[t][e] > -1e29f) ? __expf(sc[t][e] - mx) : 0.f; sc[t][e] = pe; sum += pe; }
        sum += __shfl_xor(sum, 32);
        const float inv = 1.f / (sum + __expf(sink - mx));
        f32x16 o[2];
#pragma unroll
        for (int dt = 0; dt < 2; ++dt)
#pragma unroll
            for (int e = 0; e < 16; ++e) o[dt][e] = 0.f;
#pragma unroll
        for (int t = 0; t < 5; ++t)
#pragma unroll
            for (int s2 = 0; s2 < 2; ++s2) {
                const bf16x8 pbv = pack8(sc[t], s2);
                const int kb = 32 * (qt + t) + 16 * s2 + 4 * hh;
#pragma unroll
                for (int dt = 0; dt < 2; ++dt) {
                    const bf16_t* vr = vt + (dt * 32 + r) * AT_VT_STRIDE + kb;
                    const u32x2 lo = *(const u32x2*)vr, hi = *(const u32x2*)(vr + 8);
                    u32x4 av; av.x = lo.x; av.y = lo.y; av.z = hi.x; av.w = hi.y;
                    o[dt] = __builtin_amdgcn_mfma_f32_32x32x16_bf16(__builtin_bit_cast(bf16x8, av), pbv, o[dt], 0, 0, 0);
                }
            }
        bf16_t* orow = p.xb + (size_t)(m0 + qo + r) * D_MODEL + head * 64 + 4 * hh;
#pragma unroll
        for (int dt = 0; dt < 2; ++dt)
#pragma unroll
            for (int q4 = 0; q4 < 4; ++q4) {
                u32x2 v; v.x = pk_bf16(o[dt][4 * q4] * inv, o[dt][4 * q4 + 1] * inv); v.y = pk_bf16(o[dt][4 * q4 + 2] * inv, o[dt][4 * q4 + 3] * inv);
                *(u32x2*)(orow + dt * 32 + 8 * q4) = v;
            }
    }
    __syncthreads();
}

__device__ __forceinline__ void phase_dn_norm(const Params& p) {
    const int lane = threadIdx.x & 63, gw = blockIdx.x * (NTHREADS / 64) + (threadIdx.x >> 6), GW = gridDim.x * (NTHREADS / 64);
    const float2 g = *(const float2*)(p.dn_norm_g + lane * 2);
    for (int m = gw; m < M_TOK; m += GW) {
        float2 o[4]; unsigned z[4];
#pragma unroll
        for (int h = 0; h < 4; ++h) { const unsigned ow = *(const unsigned*)(p.odn_raw + (size_t)m * 512 + h * 128 + lane * 2); o[h] = make_float2(bflo(ow), bfhi(ow)); z[h] = *(const unsigned*)(p.proj_b + (size_t)m * NP_IN + P_Z + h * 128 + lane * 2); }
#pragma unroll
        for (int h = 0; h < 4; ++h) {
            const float ss = wave_sum(o[h].x * o[h].x + o[h].y * o[h].y);
            const float rr = rsqrtf(ss * (1.f / 128.f) + RMS_EPS);
            *(unsigned*)(p.xb + (size_t)m * D_MODEL + 512 + h * 128 + lane * 2) = pk_bf16(o[h].x * rr * g.x * silu_f(bflo(z[h])), o[h].y * rr * g.y * silu_f(bfhi(z[h])));
        }
    }
}

__device__ __forceinline__ void phase_ln1(const Params& p, bf16_t* x1b) {
    const int lane = threadIdx.x & 63, gw = blockIdx.x * (NTHREADS / 64) + (threadIdx.x >> 6), GW = gridDim.x * (NTHREADS / 64);
    float4 g[4], bb[4];
#pragma unroll
    for (int j = 0; j < 4; ++j) { g[j] = *(const float4*)(p.ln1_g + j * 256 + lane * 4); bb[j] = *(const float4*)(p.ln1_b + j * 256 + lane * 4); }
    for (int m0 = gw * 4; m0 < M_TOK; m0 += GW * 4) {
        float4 v[4][4];
#pragma unroll
        for (int rr = 0; rr < 4; ++rr)
#pragma unroll
            for (int j = 0; j < 4; ++j) v[rr][j] = *(const float4*)(p.out + (size_t)(m0 + rr) * D_MODEL + j * 256 + lane * 4);
#pragma unroll
        for (int rr = 0; rr < 4; ++rr) {
            float s = 0.f;
#pragma unroll
            for (int j = 0; j < 4; ++j) s += (v[rr][j].x + v[rr][j].y) + (v[rr][j].z + v[rr][j].w);
            const float mean = wave_sum(s) * (1.f / D_MODEL); float q = 0.f;
#pragma unroll
            for (int j = 0; j < 4; ++j) { v[rr][j].x -= mean; v[rr][j].y -= mean; v[rr][j].z -= mean; v[rr][j].w -= mean; q += (v[rr][j].x * v[rr][j].x + v[rr][j].y * v[rr][j].y) + (v[rr][j].z * v[rr][j].z + v[rr][j].w * v[rr][j].w); }
            const float rstd = rsqrtf(wave_sum(q) * (1.f / D_MODEL) + LN_EPS);
            if (lane == 0) *(float2*)(p.ln1_stats + (size_t)(m0 + rr) * 2) = make_float2(mean, rstd);
#pragma unroll
            for (int j = 0; j < 4; ++j) {
                u32x2 ob; ob.x = pk_bf16(v[rr][j].x * rstd * g[j].x + bb[j].x, v[rr][j].y * rstd * g[j].y + bb[j].y); ob.y = pk_bf16(v[rr][j].z * rstd * g[j].z + bb[j].z, v[rr][j].w * rstd * g[j].w + bb[j].w);
                *(u32x2*)(x1b + (size_t)(m0 + rr) * D_MODEL + j * 256 + lane * 4) = ob;
            }
        }
    }
}

__device__ __forceinline__ void cas_d(float& a, float& b) { const float hi = fmaxf(a, b), lo = fminf(a, b); a = hi; b = lo; }
__device__ __forceinline__ void cas_a(float& a, float& b) { const float hi = fmaxf(a, b), lo = fminf(a, b); a = lo; b = hi; }
__device__ __forceinline__ void sort16_desc(f32x16& v) {
#pragma unroll
    for (int k = 2; k <= 16; k <<= 1)
#pragma unroll
        for (int j = k >> 1; j > 0; j >>= 1)
#pragma unroll
            for (int i = 0; i < 16; ++i) {
                const int l = i ^ j;
                if (l > i) { float a = v[i], b = v[l]; if ((i & k) == 0) cas_d(a, b); else cas_a(a, b); v[i] = a; v[l] = b; }
            }
}
__device__ __forceinline__ void bmerge16_desc(f32x16& v) {
#pragma unroll
    for (int j = 8; j > 0; j >>= 1)
#pragma unroll
        for (int i = 0; i < 16; ++i) { const int l = i ^ j; if (l > i) { float a = v[i], b = v[l]; cas_d(a, b); v[i] = a; v[l] = b; } }
}
__device__ __forceinline__ f32x16 merge_top16(const f32x16& a, const f32x16& b) {
    f32x16 c;
#pragma unroll
    for (int i = 0; i < 16; ++i) c[i] = fmaxf(a[i], b[15 - i]);
    bmerge16_desc(c);
    return c;
}
__device__ __forceinline__ void pcas_d(float& va, int& ia, float& vb, int& ib) {
    const bool sw = vb > va; const float tv = sw ? vb : va; const int ti = sw ? ib : ia;
    vb = sw ? va : vb; ib = sw ? ia : ib; va = tv; ia = ti;
}
__device__ __forceinline__ void psort16_desc(float (&v)[16], int (&id)[16]) {
#pragma unroll
    for (int k = 2; k <= 16; k <<= 1)
#pragma unroll
        for (int j = k >> 1; j > 0; j >>= 1)
#pragma unroll
            for (int i = 0; i < 16; ++i) {
                const int l = i ^ j;
                if (l > i) { if ((i & k) == 0) pcas_d(v[i], id[i], v[l], id[l]); else pcas_d(v[l], id[l], v[i], id[i]); }
            }
}
__device__ __forceinline__ void pmerge_top16(float (&a)[16], int (&ia)[16], const float (&b)[16], const int (&ib)[16]) {
#pragma unroll
    for (int i = 0; i < 16; ++i) { const bool sw = b[15 - i] > a[i]; a[i] = sw ? b[15 - i] : a[i]; ia[i] = sw ? ib[15 - i] : ia[i]; }
#pragma unroll
    for (int j = 8; j > 0; j >>= 1)
#pragma unroll
        for (int i = 0; i < 16; ++i) { const int l = i ^ j; if (l > i) pcas_d(a[i], ia[i], a[l], ia[l]); }
}
__device__ __forceinline__ void phase_route(const Params& p, const bf16_t* qb) {
    constexpr int CI[50] = {0,0,0,0,0,0,0,0,0,0,0,0,0,0,0,0,1,1,1,1,1,1,1,1,2,2,2,2,2,3,3,3,3,4,4,4,5,5,6,6,7,7,8,9,10,11,12,13,14,15};
    constexpr int CJ[50] = {0,1,2,3,4,5,6,7,8,9,10,11,12,13,14,15,0,1,2,3,4,5,6,7,0,1,2,3,4,0,1,2,3,0,1,2,0,1,0,1,0,1,0,0,0,0,0,0,0,0};
    const int lane0 = threadIdx.x & 63, gw = blockIdx.x * (NTHREADS / 64) + (threadIdx.x >> 6), GW = gridDim.x * (NTHREADS / 64);
    for (int task = gw; task < (M_TOK / 32) * 8; task += GW) {
        int lane = lane0; asm volatile("" : "+v"(lane));
        const int r = lane & 31, hh = lane >> 5;
        const int h = task & 7, tok0 = (task >> 3) * 32;
        f32x16 top[2];
#pragma unroll
        for (int pp = 0; pp < 2; ++pp) {
            const bf16_t* qrow = qb + (size_t)(tok0 + r) * 2048 + h * 256 + pp * 128 + 8 * hh;
            bf16x8 qf[8];
#pragma unroll
            for (int ks = 0; ks < 8; ++ks) qf[ks] = *(const bf16x8*)(qrow + 16 * ks);
            f32x16 sc[4];
#pragma unroll
            for (int kt = 0; kt < 4; ++kt) {
                const bf16_t* af = p.sk_frag + ((size_t)(((h * 2 + pp) * 4 + kt) * 8) * 64 + lane) * 8;
                bf16x8 a[8];
#pragma unroll
                for (int ks = 0; ks < 8; ++ks) a[ks] = *(const bf16x8*)(af + (size_t)ks * 512);
#pragma unroll
                for (int e = 0; e < 16; ++e) sc[kt][e] = 0.f;
#pragma unroll
                for (int ks = 0; ks < 8; ++ks) sc[kt] = __builtin_amdgcn_mfma_f32_32x32x16_bf16(a[ks], qf[ks], sc[kt], 0, 0, 0);
            }
#pragma unroll
            for (int kt = 0; kt < 4; ++kt) {
#pragma unroll
                for (int e = 0; e < 16; ++e) {
                    const unsigned key = (unsigned)(32 * kt + (e & 3) + 8 * (e >> 2)) + 4u * (unsigned)hh;
                    sc[kt][e] = __uint_as_float((__float_as_uint(sc[kt][e]) & 0xffffff80u) | key);
                }
                sort16_desc(sc[kt]);
            }
            f32x16 m = merge_top16(merge_top16(sc[0], sc[1]), merge_top16(sc[2], sc[3]));
            f32x16 oth;
#pragma unroll
            for (int i = 0; i < 16; ++i) oth[i] = __shfl_xor(m[i], 32);
            top[pp] = merge_top16(m, oth);
        }
        int ia[16], ib[16];
#pragma unroll
        for (int i = 0; i < 16; ++i) { ia[i] = (int)(__float_as_uint(top[0][i]) & 127u); ib[i] = (int)(__float_as_uint(top[1][i]) & 127u); }
        float cv0[16], cv1[16]; int cd0[16], cd1[16];
#pragma unroll
        for (int c = 0; c < 32; ++c) {
            float v = -INFINITY; int id = 0;
            if (c < 25) {
                const float v0 = top[0][CI[2 * c]] + top[1][CJ[2 * c]], v1 = top[0][CI[2 * c + 1]] + top[1][CJ[2 * c + 1]];
                const int d0 = (ia[CI[2 * c]] << 7) | ib[CJ[2 * c]], d1 = (ia[CI[2 * c + 1]] << 7) | ib[CJ[2 * c + 1]];
                v = hh ? v1 : v0; id = hh ? d1 : d0;
            }
            if (c < 16) { cv0[c] = v; cd0[c] = id; } else { cv1[c - 16] = v; cd1[c - 16] = id; }
        }
        psort16_desc(cv0, cd0); psort16_desc(cv1, cd1);
        pmerge_top16(cv0, cd0, cv1, cd1);
        float ov[16]; int od[16];
#pragma unroll
        for (int i = 0; i < 16; ++i) { ov[i] = __shfl_xor(cv0[i], 32); od[i] = __shfl_xor(cd0[i], 32); }
        pmerge_top16(cv0, cd0, ov, od);
        float ex[16], den = 0.f;
#pragma unroll
        for (int i = 0; i < 16; ++i) { ex[i] = __expf(cv0[i] - cv0[0]); den += ex[i]; }
        const float inv = 1.f / den;
        if (hh == 0) {
            int* idp = p.ids + (size_t)(tok0 + r) * 128 + h * 16; float* gp = p.gates + (size_t)(tok0 + r) * 128 + h * 16;
#pragma unroll
            for (int q = 0; q < 4; ++q) {
                *(int4*)(idp + 4 * q) = make_int4(cd0[4 * q], cd0[4 * q + 1], cd0[4 * q + 2], cd0[4 * q + 3]);
                *(float4*)(gp + 4 * q) = make_float4(ex[4 * q] * inv, ex[4 * q + 1] * inv, ex[4 * q + 2] * inv, ex[4 * q + 3] * inv);
            }
        }
    }
}


typedef float f32x2 __attribute__((ext_vector_type(2)));
__device__ __forceinline__ void phase_tables8(const Params& p, int first_block) {
    const int lane = threadIdx.x & 63, gw = (blockIdx.x - first_block) * (NTHREADS / 64) + (threadIdx.x >> 6), GW = (gridDim.x - first_block) * (NTHREADS / 64);
    for (int row0 = gw * 4; row0 < 2 * 16384; row0 += GW * 4) {
        float v[4][16];
#pragma unroll
        for (int rr = 0; rr < 4; ++rr) {
            const int row = row0 + rr, table = row >> 14, e = row & 16383;
            const float* src = (table ? p.peer_v : p.peer_u) + (size_t)e * 1024 + lane * 16;
#pragma unroll
            for (int q = 0; q < 4; ++q) { const float4 a = *(const float4*)(src + 4 * q); v[rr][4 * q] = a.x; v[rr][4 * q + 1] = a.y; v[rr][4 * q + 2] = a.z; v[rr][4 * q + 3] = a.w; }
        }
#pragma unroll
        for (int rr = 0; rr < 4; ++rr) {
            const int row = row0 + rr, table = row >> 14, e = row & 16383;
            float am = 0.f;
#pragma unroll
            for (int c = 0; c < 16; ++c) am = fmaxf(am, fabsf(v[rr][c]));
            am = wave_max(am);
            float sc = am > 0.f ? exp2f(floorf(log2f(448.f / am))) : 1.f;
            if (am * sc > 448.f) sc *= 0.5f;
            u32x4 o; int w;
            w = 0; w = __builtin_amdgcn_cvt_pk_fp8_f32(v[rr][0] * sc, v[rr][1] * sc, w, false); w = __builtin_amdgcn_cvt_pk_fp8_f32(v[rr][2] * sc, v[rr][3] * sc, w, true); o.x = (unsigned)w;
            w = 0; w = __builtin_amdgcn_cvt_pk_fp8_f32(v[rr][4] * sc, v[rr][5] * sc, w, false); w = __builtin_amdgcn_cvt_pk_fp8_f32(v[rr][6] * sc, v[rr][7] * sc, w, true); o.y = (unsigned)w;
            w = 0; w = __builtin_amdgcn_cvt_pk_fp8_f32(v[rr][8] * sc, v[rr][9] * sc, w, false); w = __builtin_amdgcn_cvt_pk_fp8_f32(v[rr][10] * sc, v[rr][11] * sc, w, true); o.z = (unsigned)w;
            w = 0; w = __builtin_amdgcn_cvt_pk_fp8_f32(v[rr][12] * sc, v[rr][13] * sc, w, false); w = __builtin_amdgcn_cvt_pk_fp8_f32(v[rr][14] * sc, v[rr][15] * sc, w, true); o.w = (unsigned)w;
            *(u32x4*)(p.tab8 + ((size_t)((table * 8 + (lane >> 3)) * 16384 + e)) * 128 + (lane & 7) * 16) = o;
            if (lane == 0) p.isc[row] = 1.f / sc;
        }
    }
}
typedef int i32x16 __attribute__((ext_vector_type(16)));
struct PeerBuf { u32x4 rows[16]; u32x4 xa, xb; f32x16 w; };
__device__ __forceinline__ float dpp_xor1(float v) { return __uint_as_float(__builtin_amdgcn_update_dpp(0u, __float_as_uint(v), 0xB1, 0xF, 0xF, true)); }
__device__ __forceinline__ float dpp_xor2(float v) { return __uint_as_float(__builtin_amdgcn_update_dpp(0u, __float_as_uint(v), 0x4E, 0xF, 0xF, true)); }
__device__ __forceinline__ float dpp_xor8(float v) { return __uint_as_float(__builtin_amdgcn_update_dpp(0u, __float_as_uint(v), 0x128, 0xF, 0xF, true)); }
__device__ __forceinline__ float swz_xor4(float v) { return __uint_as_float(__builtin_amdgcn_ds_swizzle(__float_as_uint(v), 0x101F)); }
__device__ __forceinline__ float swz_xor16(float v) { return __uint_as_float(__builtin_amdgcn_ds_swizzle(__float_as_uint(v), 0x401F)); }
__device__ __forceinline__ void peer_gather(PeerBuf& B, const unsigned char* tab, const i32x16& id, int j) {
#pragma unroll
    for (int i = 0; i < 16; ++i) B.rows[i] = *(const u32x4*)(tab + (size_t)id[i] * 128 + j * 16);
}
__device__ __forceinline__ void phase_peer_u(const Params& p, const bf16_t* x1b, float* ph) {
    const int lane0 = threadIdx.x & 63, wave = threadIdx.x >> 6;
    const int x = blockIdx.x & 7, nloc = (gridDim.x - x + 7) >> 3, wl = (blockIdx.x >> 3) * (NTHREADS / 64) + wave, NW = nloc * (NTHREADS / 64);
    const unsigned char* tab = p.tab8 + (size_t)x * 16384 * 128;
    int lane = lane0; asm volatile("" : "+v"(lane));
    const int j = lane & 7, g = lane >> 3;
    const bool b0 = j & 1, b1 = j & 2, b2 = j & 4;
    auto tok = [&](int t) { return t < M_TOK ? t : M_TOK - 1; };
    auto load_ids = [&](i32x16& id, int t) {
#pragma unroll
        for (int q = 0; q < 4; ++q) { const int4 v = *(const int4*)(p.ids + (size_t)t * 128 + 16 * g + 4 * q); id[4 * q] = v.x; id[4 * q + 1] = v.y; id[4 * q + 2] = v.z; id[4 * q + 3] = v.w; }
    };
    auto issue = [&](PeerBuf& B, int t, const i32x16& id) {
        const bf16_t* xs = x1b + (size_t)t * 1024 + 128 * x + 16 * j;
        B.xa = *(const u32x4*)xs; B.xb = *(const u32x4*)(xs + 8);
        peer_gather(B, tab, id, j);
    };
    auto compute = [&](const PeerBuf& B, int t) {
        const f32x2 xf[8] = {{bflo(B.xa.x), bfhi(B.xa.x)}, {bflo(B.xa.y), bfhi(B.xa.y)}, {bflo(B.xa.z), bfhi(B.xa.z)}, {bflo(B.xa.w), bfhi(B.xa.w)},
                             {bflo(B.xb.x), bfhi(B.xb.x)}, {bflo(B.xb.y), bfhi(B.xb.y)}, {bflo(B.xb.z), bfhi(B.xb.z)}, {bflo(B.xb.w), bfhi(B.xb.w)}};
        float res[16];
#pragma unroll
        for (int i = 0; i < 16; ++i) {
            const unsigned dw[4] = {B.rows[i].x, B.rows[i].y, B.rows[i].z, B.rows[i].w};
            f32x2 d2 = {0.f, 0.f};
#pragma unroll
            for (int q = 0; q < 4; ++q) {
                const f32x2 lo = __builtin_amdgcn_cvt_pk_f32_fp8((int)dw[q], false), hi = __builtin_amdgcn_cvt_pk_f32_fp8((int)dw[q], true);
                d2 = lo * xf[2 * q] + d2; d2 = hi * xf[2 * q + 1] + d2;
            }
            res[i] = d2.x + d2.y;
        }
        float r8[8], r4[4], r2[2];
#pragma unroll
        for (int m = 0; m < 8; ++m) { const float keep = b0 ? res[8 + m] : res[m], send = b0 ? res[m] : res[8 + m]; r8[m] = keep + dpp_xor1(send); }
#pragma unroll
        for (int m = 0; m < 4; ++m) { const float keep = b1 ? r8[4 + m] : r8[m], send = b1 ? r8[m] : r8[4 + m]; r4[m] = keep + dpp_xor2(send); }
#pragma unroll
        for (int m = 0; m < 2; ++m) { const float keep = b2 ? r4[2 + m] : r4[m], send = b2 ? r4[m] : r4[2 + m]; r2[m] = keep + swz_xor4(send); }
        const int i0 = 8 * (int)b0 + 4 * (int)b1 + 2 * (int)b2;
        *(float2*)(ph + ((size_t)x * M_TOK + t) * 128 + 16 * g + i0) = make_float2(r2[0], r2[1]);
    };
    PeerBuf A, Bb;
    int t = wl;
    if (t >= M_TOK) return;
    i32x16 idn;
    load_ids(idn, t);
    issue(A, t, idn);
    load_ids(idn, tok(t + NW));
    for (; t < M_TOK; t += 2 * NW) {
        issue(Bb, tok(t + NW), idn);
        load_ids(idn, tok(t + 2 * NW));
        compute(A, t);
        issue(A, tok(t + 2 * NW), idn);
        load_ids(idn, tok(t + 3 * NW));
        if (t + NW < M_TOK) compute(Bb, t + NW);
    }
}
__device__ __forceinline__ void phase_peer_w(const Params& p, const float* ph, float* wbuf) {
    const size_t gt = (size_t)blockIdx.x * NTHREADS + threadIdx.x, GT = (size_t)gridDim.x * NTHREADS;
    for (size_t i0 = gt; i0 < (size_t)M_TOK * 128; i0 += GT * 4) {
        int e[4]; float h[4], gg[4];
#pragma unroll
        for (int u = 0; u < 4; ++u) {
            const size_t idx = i0 + u * GT;
            e[u] = p.ids[idx]; gg[u] = p.gates[idx]; h[u] = 0.f;
#pragma unroll
            for (int x = 0; x < 8; ++x) h[u] += ph[(size_t)x * M_TOK * 128 + idx];
        }
#pragma unroll
        for (int u = 0; u < 4; ++u) {
            const float hv = h[u] * p.isc[e[u]];
            wbuf[i0 + u * GT] = 0.5f * hv * (1.f + erff(hv * 0.7071067811865476f)) * gg[u] * p.isc[16384 + e[u]];
        }
    }
}
__device__ __forceinline__ void phase_peer_v(const Params& p, const float* wbuf, bf16_t* ffn) {
    const int lane0 = threadIdx.x & 63, wave = threadIdx.x >> 6;
    const int x = blockIdx.x & 7, nloc = (gridDim.x - x + 7) >> 3, wl = (blockIdx.x >> 3) * (NTHREADS / 64) + wave, NW = nloc * (NTHREADS / 64);
    const unsigned char* tab = p.tab8 + (size_t)(8 + x) * 16384 * 128;
    int lane = lane0; asm volatile("" : "+v"(lane));
    const int j = lane & 7, g = lane >> 3;
    const bool b3 = g & 1, b4 = g & 2, b5 = g & 4;
    auto tok = [&](int t) { return t < M_TOK ? t : M_TOK - 1; };
    auto load_ids = [&](i32x16& id, int t) {
#pragma unroll
        for (int q = 0; q < 4; ++q) { const int4 v = *(const int4*)(p.ids + (size_t)t * 128 + 16 * g + 4 * q); id[4 * q] = v.x; id[4 * q + 1] = v.y; id[4 * q + 2] = v.z; id[4 * q + 3] = v.w; }
    };
    auto issue = [&](PeerBuf& B, int t, const i32x16& id) {
#pragma unroll
        for (int q = 0; q < 4; ++q) { const float4 v = *(const float4*)(wbuf + (size_t)t * 128 + 16 * g + 4 * q); B.w[4 * q] = v.x; B.w[4 * q + 1] = v.y; B.w[4 * q + 2] = v.z; B.w[4 * q + 3] = v.w; }
        peer_gather(B, tab, id, j);
    };
    auto compute = [&](const PeerBuf& B, int t) {
        f32x2 acc[8];
#pragma unroll
        for (int c = 0; c < 8; ++c) acc[c] = (f32x2){0.f, 0.f};
#pragma unroll
        for (int i = 0; i < 16; ++i) {
            const f32x2 w2 = {B.w[i], B.w[i]};
            const unsigned dw[4] = {B.rows[i].x, B.rows[i].y, B.rows[i].z, B.rows[i].w};
#pragma unroll
            for (int q = 0; q < 4; ++q) {
                const f32x2 lo = __builtin_amdgcn_cvt_pk_f32_fp8((int)dw[q], false), hi = __builtin_amdgcn_cvt_pk_f32_fp8((int)dw[q], true);
                acc[2 * q] = lo * w2 + acc[2 * q]; acc[2 * q + 1] = hi * w2 + acc[2 * q + 1];
            }
        }
        f32x2 a4[4], a2[2], a1;
#pragma unroll
        for (int m = 0; m < 4; ++m) { const f32x2 keep = b3 ? acc[4 + m] : acc[m], send = b3 ? acc[m] : acc[4 + m]; a4[m] = (f32x2){keep.x + dpp_xor8(send.x), keep.y + dpp_xor8(send.y)}; }
#pragma unroll
        for (int m = 0; m < 2; ++m) { const f32x2 keep = b4 ? a4[2 + m] : a4[m], send = b4 ? a4[m] : a4[2 + m]; a2[m] = (f32x2){keep.x + swz_xor16(send.x), keep.y + swz_xor16(send.y)}; }
        { const f32x2 keep = b5 ? a2[1] : a2[0], send = b5 ? a2[0] : a2[1]; a1 = (f32x2){keep.x + __shfl_xor(send.x, 32), keep.y + __shfl_xor(send.y, 32)}; }
        const int c0 = 8 * (int)b3 + 4 * (int)b4 + 2 * (int)b5;
        *(unsigned*)(ffn + (size_t)t * 1024 + 128 * x + 16 * j + c0) = pk_bf16(a1.x, a1.y);
    };
    PeerBuf A, Bb;
    int t = wl;
    if (t >= M_TOK) return;
    i32x16 idn;
    load_ids(idn, t);
    issue(A, t, idn);
    load_ids(idn, tok(t + NW));
    for (; t < M_TOK; t += 2 * NW) {
        issue(Bb, tok(t + NW), idn);
        load_ids(idn, tok(t + 2 * NW));
        compute(A, t);
        issue(A, tok(t + 2 * NW), idn);
        load_ids(idn, tok(t + 3 * NW));
        if (t + NW < M_TOK) compute(Bb, t + NW);
    }
}
__device__ __forceinline__ void phase_ln2(const Params& p, const bf16_t* ffn) {
    const int lane = threadIdx.x & 63, gw = blockIdx.x * (NTHREADS / 64) + (threadIdx.x >> 6), GW = gridDim.x * (NTHREADS / 64);
    for (int m0 = gw * 2; m0 < M_TOK; m0 += GW * 2) {
        float4 a[2][4]; u32x2 f[2][4]; float2 st[2];
#pragma unroll
        for (int rr = 0; rr < 2; ++rr) {
            st[rr] = *(const float2*)(p.ln1_stats + (size_t)(m0 + rr) * 2);
#pragma unroll
            for (int j = 0; j < 4; ++j) { a[rr][j] = *(const float4*)(p.out + (size_t)(m0 + rr) * D_MODEL + j * 256 + lane * 4); f[rr][j] = *(const u32x2*)(ffn + (size_t)(m0 + rr) * D_MODEL + j * 256 + lane * 4); }
        }
#pragma unroll
        for (int rr = 0; rr < 2; ++rr) {
            float* row = p.out + (size_t)(m0 + rr) * D_MODEL;
            float4 v[4]; float s = 0.f;
#pragma unroll
            for (int j = 0; j < 4; ++j) {
                const float4 g1 = *(const float4*)(p.ln1_g + j * 256 + lane * 4), b1 = *(const float4*)(p.ln1_b + j * 256 + lane * 4);
                v[j] = make_float4(ALPHA * ((a[rr][j].x - st[rr].x) * st[rr].y * g1.x + b1.x) + bflo(f[rr][j].x), ALPHA * ((a[rr][j].y - st[rr].x) * st[rr].y * g1.y + b1.y) + bfhi(f[rr][j].x),
                                   ALPHA * ((a[rr][j].z - st[rr].x) * st[rr].y * g1.z + b1.z) + bflo(f[rr][j].y), ALPHA * ((a[rr][j].w - st[rr].x) * st[rr].y * g1.w + b1.w) + bfhi(f[rr][j].y));
                s += (v[j].x + v[j].y) + (v[j].z + v[j].w);
            }
            const float mean = wave_sum(s) * (1.f / D_MODEL); float q = 0.f;
#pragma unroll
            for (int j = 0; j < 4; ++j) { v[j].x -= mean; v[j].y -= mean; v[j].z -= mean; v[j].w -= mean; q += (v[j].x * v[j].x + v[j].y * v[j].y) + (v[j].z * v[j].z + v[j].w * v[j].w); }
            const float rstd = rsqrtf(wave_sum(q) * (1.f / D_MODEL) + LN_EPS);
#pragma unroll
            for (int j = 0; j < 4; ++j) {
                const float4 g = *(const float4*)(p.ln2_g + j * 256 + lane * 4), bb = *(const float4*)(p.ln2_b + j * 256 + lane * 4);
                *(float4*)(row + j * 256 + lane * 4) = make_float4(v[j].x * rstd * g.x + bb.x, v[j].y * rstd * g.y + bb.y, v[j].z * rstd * g.z + bb.z, v[j].w * rstd * g.w + bb.w);
            }
        }
    }
}

constexpr int N_PHASES = 13;
__global__ void __launch_bounds__(NTHREADS) mega_fwd(Params p) {
    __shared__ __attribute__((aligned(1024))) unsigned char smem[SMEM_BYTES + 16];
    if (threadIdx.x == 0) *(uint4*)(smem + SMEM_BYTES) = make_uint4(0u, 0u, 0u, 0u);
    __syncthreads();
    XcdBarrier bar; bar.bar = p.bar; bar.x = 0; bar.st = (volatile LAS unsigned*)(smem + SMEM_BYTES);
    if (p.ph_hi - p.ph_lo > 1) bar = xcd_barrier_post(p.bar, (volatile LAS unsigned*)(smem + SMEM_BYTES));
    bf16_t* qb = p.proj_b;
    bf16_t* x1b = p.proj_b + (size_t)M_TOK * 2048;
#ifndef DUP_PHASE
#define DUP_PHASE -1
#endif
#define PH(k) (p.ph_lo <= (k) && (k) < p.ph_hi)
#define SYNC(k) do { if (PH(k) && PH((k) + 1)) xcd_barrier(bar); } while (0)
#define RUN(k, ...) do { if (PH(k)) { __VA_ARGS__; if (DUP_PHASE == (k)) { xcd_barrier(bar); __VA_ARGS__; } } SYNC(k); } while (0)
    float* ph = (float*)qb;
    RUN(0, phase_prep(p, smem));
    RUN(1, { EpiInProj e{p.proj_b, p.rope_cs}; gemm_phase(p.xb, p.wt_in, M_TOK, NP_IN, e, smem); });
    RUN(2, phase_dn_prep(p, smem));
#ifndef DUP_SCAN
#define DUP_SCAN 0
#endif
#ifndef DUP_ATTN
#define DUP_ATTN 0
#endif
    RUN(3, { if (blockIdx.x < 16) { phase_dn_scan(p, smem); if (DUP_SCAN) phase_dn_scan(p, smem); } else { phase_attn(p, smem, 16); if (DUP_ATTN) phase_attn(p, smem, 16); phase_tables8(p, 16); phase_scan_l2_helper(p); } });
    RUN(4, phase_dn_norm(p));
    RUN(5, { EpiOutProj e{p.out, p.x}; gemm_phase(p.xb, p.wt_out, M_TOK, 1024, e, smem); });
    RUN(6, phase_ln1(p, x1b));
    RUN(7, { EpiBf16 e{qb, 2048}; gemm_phase(x1b, p.wt_q, M_TOK, 2048, e, smem); });
    RUN(8, phase_route(p, qb));
    RUN(9, phase_peer_u(p, x1b, ph));
    RUN(10, phase_peer_w(p, ph, p.wbuf));
    RUN(11, phase_peer_v(p, p.wbuf, (bf16_t*)ph));
    RUN(12, phase_ln2(p, (const bf16_t*)ph));
#undef RUN
#undef SYNC
#undef PH
}
}

#ifndef MK_LAUNCHES
#define MK_LAUNCHES 1
#endif

extern "C" void kernel_launch(void* const* d_in, const int* in_sizes, int n_in, void* d_out, int out_size, void* d_ws, size_t ws_size, hipStream_t stream) {
    static int grid_blocks = 0;
    if (!grid_blocks) {
        int dev = 0, cus = 0, per_cu = 0;
        (void)hipGetDevice(&dev);
        (void)hipDeviceGetAttribute(&cus, hipDeviceAttributeMultiprocessorCount, dev);
        (void)hipOccupancyMaxActiveBlocksPerMultiprocessor(&per_cu, mega_fwd, NTHREADS, 0);
        if (per_cu < 1) { fprintf(stderr, "kernel_launch: occupancy query reports %d blocks per CU\n", per_cu); per_cu = 1; }
        grid_blocks = cus * 1;
        (void)hipGetLastError();
    }
    Params p{};
    p.x = (const float*)d_in[0]; p.positions = (const int*)d_in[1]; p.w_in = (const float*)d_in[2]; p.sinks = (const float*)d_in[3];
    p.conv_w = (const float*)d_in[4]; p.a_log = (const float*)d_in[5]; p.dt_bias = (const float*)d_in[6]; p.dn_norm_g = (const float*)d_in[7];
    p.w_out = (const float*)d_in[8]; p.ln1_g = (const float*)d_in[9]; p.ln1_b = (const float*)d_in[10]; p.w_query = (const float*)d_in[11];
    p.sub_keys = (const float*)d_in[12]; p.peer_u = (const float*)d_in[13]; p.peer_v = (const float*)d_in[14]; p.ln2_g = (const float*)d_in[15]; p.ln2_b = (const float*)d_in[16];
    p.out = (float*)d_out;
    char* ws = (char*)d_ws; size_t off = 0;
    auto take = [&](size_t bytes) { char* r = ws + off; off += (bytes + 255) & ~(size_t)255; return r; };
    p.xb = (bf16_t*)take((size_t)M_TOK * 1024 * 2);
    p.proj_b = (bf16_t*)take((size_t)M_TOK * NP_IN * 2);
    p.odn_raw = (bf16_t*)d_out;
    {
        char* dn = take((size_t)2048 * (16384 * 3 + 8192 + 32768) + 8192);
        p.ids = (int*)dn; p.gates = (float*)(dn + (size_t)M_TOK * 128 * 4);
        p.wbuf = (float*)(dn + (size_t)M_TOK * 128 * 8);
        p.dn_negw = (bf16_t*)dn; p.dn_qd = (bf16_t*)(dn + (size_t)2048 * 16384); p.dn_kdt = (bf16_t*)(dn + (size_t)2048 * 16384 * 2);
        p.dn_qk = (bf16_t*)(dn + (size_t)2048 * 16384 * 3); p.dn_u = (bf16_t*)(dn + (size_t)2048 * (16384 * 3 + 8192)); p.dn_gl = (float*)(dn + (size_t)2048 * (16384 * 3 + 8192 + 32768));
    }
    p.wt_in = (bf16_t*)take((size_t)NP_IN * 1024 * 2);
    p.wt_out = (bf16_t*)take((size_t)1024 * 1024 * 2);
    p.wt_q = (bf16_t*)take((size_t)2048 * 1024 * 2);
    p.rope_cs = (float*)take((size_t)M_TOK * 64 * 4);
    p.sk_frag = (bf16_t*)take((size_t)16 * 128 * 128 * 2);
    p.tab8 = (unsigned char*)take((size_t)2 * 16384 * 1024);
    p.isc = (float*)take((size_t)2 * 16384 * 4);
    p.ln1_stats = (float*)take((size_t)M_TOK * 2 * 4);
    p.bar = (unsigned*)take((size_t)(XCD_BAR_WORDS + 16 * 64) * 4);
    if (off > ws_size) { fprintf(stderr, "kernel_launch: workspace too small (%zu < %zu)\n", ws_size, off); return; }
    if (hipMemsetAsync(p.bar, 0, (size_t)(XCD_BAR_WORDS + 16 * 64) * 4, stream) != hipSuccess) { fprintf(stderr, "kernel_launch: memset of barrier words failed\n"); return; }
#if MK_LAUNCHES == 1
    p.ph_lo = 0; p.ph_hi = N_PHASES;
    void* args[] = {&p};
    hipError_t e = hipLaunchCooperativeKernel((void*)mega_fwd, dim3(grid_blocks), dim3(NTHREADS), args, 0, stream);
    if (e != hipSuccess) fprintf(stderr, "cooperative launch failed: %s (grid %d)\n", hipGetErrorString(e), grid_blocks);
#else
    for (int k = 0; k < N_PHASES; ++k) { p.ph_lo = k; p.ph_hi = k + 1; hipLaunchKernelGGL(mega_fwd, dim3(grid_blocks), dim3(NTHREADS), 0, stream, p); }
#endif
}
```

```cpp
#include <hip/hip_runtime.h>
#include <cstdio>
#include <cstdint>
#include <math.h>

namespace {
constexpr int D_MODEL = 1024, BATCH = 4, SEQ = 8192, M_TOK = BATCH * SEQ;
constexpr int IN_WIDTH = 2824, NP_IN = 3072;
constexpr int P_AQ = 0, P_AK = 512, P_AV = 640, P_DQ = 768, P_DK = 1280, P_DV = 1792, P_Z = 2304, P_B = 2816, P_A = 2820;
constexpr float ALPHA = 1.189207115002721f;
constexpr float LN_EPS = 1e-5f, RMS_EPS = 1e-6f, L2_EPS = 1e-6f;
constexpr int NTHREADS = 512;

typedef unsigned short bf16_t;
typedef short bf16x8 __attribute__((ext_vector_type(8)));
typedef float f32x16 __attribute__((ext_vector_type(16)));
typedef float f32x4 __attribute__((ext_vector_type(4)));
typedef unsigned u32x4 __attribute__((ext_vector_type(4)));
typedef unsigned u32x2 __attribute__((ext_vector_type(2)));

struct Params {
    const float* x; const int* positions; const float* w_in; const float* sinks; const float* conv_w; const float* a_log; const float* dt_bias;
    const float* dn_norm_g; const float* w_out; const float* ln1_g; const float* ln1_b; const float* w_query; const float* sub_keys;
    const float* peer_u; const float* peer_v; const float* ln2_g; const float* ln2_b;
    float* out;
    bf16_t* xb;
    bf16_t* proj_b;
    bf16_t* odn_raw;
    int* ids; float* gates;
    bf16_t* wt_in; bf16_t* wt_out; bf16_t* wt_q;
    float* rope_cs;
    bf16_t* dn_negw; bf16_t* dn_qd; bf16_t* dn_kdt; bf16_t* dn_qk; bf16_t* dn_u; float* dn_gl; float* dn_PB; float* dn_S0;
    bf16_t* sk_frag;
    float* ln1_stats;
    unsigned char* tab8; float* isc; float* wbuf;
    unsigned* bar;
    int ph_lo, ph_hi;
};

__device__ __forceinline__ float wave_sum(float v) {
#pragma unroll
    for (int o = 1; o < 64; o <<= 1) v += __shfl_xor(v, o);
    return v;
}
__device__ __forceinline__ float wave_max(float v) {
#pragma unroll
    for (int o = 1; o < 64; o <<= 1) v = fmaxf(v, __shfl_xor(v, o));
    return v;
}
__device__ __forceinline__ float bf2f(bf16_t u) { return __uint_as_float((unsigned)u << 16); }
__device__ __forceinline__ float bflo(unsigned u) { return __uint_as_float(u << 16); }
__device__ __forceinline__ float bfhi(unsigned u) { return __uint_as_float(u & 0xffff0000u); }
typedef __bf16 bf16x2_n __attribute__((ext_vector_type(2)));
__device__ __forceinline__ unsigned pk_bf16(float lo, float hi) { bf16x2_n v; v.x = (__bf16)lo; v.y = (__bf16)hi; return __builtin_bit_cast(unsigned, v); }
__device__ __forceinline__ float silu_f(float y) { return y / (1.f + __expf(-y)); }


#define XB_TMO      128
#define XB_XCNT(j)  (256  + 64 * (j))
#define XB_XSUB(j)  (1280 + 64 * (j))
#define XB_XGEN(j)  (2304 + 64 * (j))
#define XB_TOP      3328
#define XB_TOPGEN   3392
#define XCD_BAR_WORDS 3456
#define XB_SPIN_CAP (1u << 27)
#define LAS __attribute__((address_space(3)))
__device__ __forceinline__ unsigned xb_ld(unsigned* p)              { return __hip_atomic_load(p, __ATOMIC_RELAXED, __HIP_MEMORY_SCOPE_AGENT); }
__device__ __forceinline__ unsigned xb_add(unsigned* p, unsigned v) { return __hip_atomic_fetch_add(p, v, __ATOMIC_RELAXED, __HIP_MEMORY_SCOPE_AGENT); }
__device__ __forceinline__ unsigned xb_xcc_id() { return (unsigned)__builtin_amdgcn_s_getreg((3 << 11) | 20) & 0xFu; }
#define XB_SPIN(cond, bar) do { unsigned _sp = 0; while (cond) { __builtin_amdgcn_s_sleep(1); \
    if ((++_sp & 255u) == 0u) { if (xb_ld(&(bar)[XB_TMO])) break; if (_sp > XB_SPIN_CAP) { atomicAdd(&(bar)[XB_TMO], 1u); break; } } } } while (0)
struct XcdBarrier { unsigned* bar; unsigned x; volatile LAS unsigned* st; };
__device__ __forceinline__ XcdBarrier xcd_barrier_post(unsigned* bar, volatile LAS unsigned* st) {
    XcdBarrier b; b.bar = bar; b.x = xb_xcc_id(); b.st = st;
    if (threadIdx.x == 0) (void)xb_add(&bar[XB_XCNT(b.x)], 1u);
    return b;
}
__device__ __forceinline__ void xcd_barrier_complete(unsigned* bar, unsigned x, unsigned& nloc, unsigned& nx) {
    const unsigned G = gridDim.x * gridDim.y * gridDim.z;
    unsigned sum, cnt, mine, sp = 0u;
    for (;;) {
        sum = 0u; cnt = 0u; mine = 0u;
#pragma unroll
        for (unsigned j = 0; j < 16; ++j) { const unsigned c = xb_ld(&bar[XB_XCNT(j)]); sum += c; cnt += (c > 0u) ? 1u : 0u; mine = (j == x) ? c : mine; }
        if (sum == G) break;
        __builtin_amdgcn_s_sleep(1);
        if ((++sp & 255u) == 0u) { if (xb_ld(&bar[XB_TMO])) break; if (sp > XB_SPIN_CAP) { atomicAdd(&bar[XB_TMO], 1u); break; } }
    }
    nloc = mine > 0u ? mine : 1u; nx = cnt > 0u ? cnt : 1u;
}
__device__ __forceinline__ void xcd_barrier(const XcdBarrier& b) {
    asm volatile("s_waitcnt vmcnt(0)" ::: "memory");
    __syncthreads();
    if (threadIdx.x == 0) {
        unsigned* bar = b.bar;
        __builtin_amdgcn_s_waitcnt(0);
        unsigned nloc = b.st[0], nx = b.st[1];
        if (nloc == 0u) { xcd_barrier_complete(bar, b.x, nloc, nx); b.st[0] = nloc; b.st[1] = nx; }
        const unsigned old = xb_add(&bar[XB_XSUB(b.x)], 1u);
        const unsigned gen = old / nloc;
        if (old + 1u == (gen + 1u) * nloc) {
            __builtin_amdgcn_fence(__ATOMIC_RELEASE, "agent");
            asm volatile("s_waitcnt vmcnt(0)" ::: "memory");
            const unsigned og = xb_add(&bar[XB_TOP], 1u);
            const unsigned tg = og / nx;
            if (og + 1u == (tg + 1u) * nx) xb_add(&bar[XB_TOPGEN], 1u);
            else XB_SPIN(xb_ld(&bar[XB_TOPGEN]) == tg, bar);
            __builtin_amdgcn_fence(__ATOMIC_ACQUIRE, "agent");
            xb_add(&bar[XB_XGEN(b.x)], 1u);
            asm volatile("s_waitcnt vmcnt(0)" ::: "memory");
        } else {
            XB_SPIN(xb_ld(&bar[XB_XGEN(b.x)]) == gen, bar);
            __builtin_amdgcn_fence(__ATOMIC_ACQUIRE, "agent");
            asm volatile("s_waitcnt vmcnt(0)" ::: "memory");
        }
    }
    __syncthreads();
}

__device__ __forceinline__ int inproj_old_col(int n) {
    if (n < 2304) return n;
    if (n < 2816) return 2312 + (n - 2304);
    if (n < 2824) return 2304 + (n - 2816);
    return -1;
}
__device__ __forceinline__ void transpose_item(const float* __restrict__ W, int N_src, bf16_t* __restrict__ WT, int K, int kb, int nb, bool permute, float* scr) {
    const int tid = threadIdx.x;
    const int nn = tid & 63, k8 = tid >> 6;
    const int n = nb * 64 + nn;
    const int oc = permute ? inproj_old_col(n) : n;
#pragma unroll
    for (int i = 0; i < 8; ++i) { const int kk = k8 + 8 * i; scr[kk * 65 + nn] = (oc >= 0) ? W[(size_t)(kb * 64 + kk) * N_src + oc] : 0.f; }
    __syncthreads();
    const int n2 = tid >> 3, c = tid & 7;
    const float* s = scr + (c * 8) * 65 + n2;
    u32x4 o; o.x = pk_bf16(s[0], s[65]); o.y = pk_bf16(s[2 * 65], s[3 * 65]); o.z = pk_bf16(s[4 * 65], s[5 * 65]); o.w = pk_bf16(s[6 * 65], s[7 * 65]);
    *(u32x4*)(WT + (size_t)(nb * 64 + n2) * K + kb * 64 + c * 8) = o;
    __syncthreads();
}
__device__ __forceinline__ void phase_prep(const Params& p, unsigned char* smem) {
    const int tid = threadIdx.x, G = gridDim.x, bid = blockIdx.x;
    float* scr = (float*)smem;
    constexpr int I_IN = 16 * (NP_IN / 64), I_OUT = 16 * 16, I_Q = 16 * 32;
    for (int it = bid; it < I_IN + I_OUT + I_Q; it += G) {
        int r = it;
        if (r < I_IN) { transpose_item(p.w_in, IN_WIDTH, p.wt_in, 1024, r / (NP_IN / 64), r % (NP_IN / 64), true, scr); continue; } r -= I_IN;
        if (r < I_OUT) { transpose_item(p.w_out, 1024, p.wt_out, 1024, r / 16, r % 16, false, scr); continue; } r -= I_OUT;
        transpose_item(p.w_query, 2048, p.wt_q, 1024, r / 32, r % 32, false, scr);
    }
    const size_t gt = (size_t)bid * NTHREADS + tid, GT = (size_t)G * NTHREADS;
    for (size_t i0 = gt; i0 < (size_t)M_TOK * 1024 / 8; i0 += GT * 4) {
        float4 a[4], b[4];
#pragma unroll
        for (int u = 0; u < 4; ++u) { const size_t i = i0 + u * GT; if (i < (size_t)M_TOK * 1024 / 8) { a[u] = *(const float4*)(p.x + i * 8); b[u] = *(const float4*)(p.x + i * 8 + 4); } }
#pragma unroll
        for (int u = 0; u < 4; ++u) { const size_t i = i0 + u * GT; if (i < (size_t)M_TOK * 1024 / 8) {
            u32x4 o; o.x = pk_bf16(a[u].x, a[u].y); o.y = pk_bf16(a[u].z, a[u].w); o.z = pk_bf16(b[u].x, b[u].y); o.w = pk_bf16(b[u].z, b[u].w);
            *(u32x4*)(p.xb + i * 8) = o; } }
    }
    for (size_t i = gt; i < (size_t)16 * 4 * 8 * 64; i += GT) {
        const int ln = (int)(i & 63), ks = (int)((i >> 6) & 7), kt = (int)((i >> 9) & 3), hp = (int)(i >> 11);
        const float* src = p.sub_keys + ((size_t)(hp * 128 + 32 * kt + (ln & 31))) * 128 + 16 * ks + 8 * (ln >> 5);
        const float4 a = *(const float4*)src, b = *(const float4*)(src + 4);
        u32x4 o; o.x = pk_bf16(a.x, a.y); o.y = pk_bf16(a.z, a.w); o.z = pk_bf16(b.x, b.y); o.w = pk_bf16(b.z, b.w);
        *(u32x4*)(p.sk_frag + i * 8) = o;
    }
    for (size_t i = gt; i < (size_t)M_TOK * 32; i += GT) {
        const int m = (int)(i >> 5), j = (int)(i & 31);
        const float inv_freq = powf(10000.0f, -(float)j / 32.0f);
        const float ang = (float)p.positions[m] * inv_freq;
        p.rope_cs[i] = cosf(ang); p.rope_cs[(size_t)M_TOK * 32 + i] = sinf(ang);
    }
}

constexpr int GK = 1024, GBK = 64, G_TILE_BYTES = 256 * 128;
constexpr int STG_STRIDE = 260;
constexpr int SMEM_BYTES = 147456;

__device__ __forceinline__ int swz(int row, int chunk) { return row * 128 + ((chunk ^ ((row >> 1) & 7)) << 4); }

struct EpiInProj {
    bf16_t* out; const float* cs;
    __device__ __forceinline__ void operator()(int m, int pn, int c8, const unsigned char* stg_row) const {
        const int col = pn * 256 + c8 * 8;
        u32x2 a0 = *(const u32x2*)(stg_row + c8 * 16), a1 = *(const u32x2*)(stg_row + c8 * 16 + 8);
        u32x4 o; o.x = a0.x; o.y = a0.y; o.z = a1.x; o.w = a1.y;
        if (col < P_AV) {
            const int d0 = col & 63, i0 = d0 & 31; const bool second = d0 >= 32;
            const int pc8 = second ? c8 - 4 : c8 + 4;
            const u32x2 b0 = *(const u32x2*)(stg_row + pc8 * 16), b1 = *(const u32x2*)(stg_row + pc8 * 16 + 8);
            const unsigned mine[4] = {a0.x, a0.y, a1.x, a1.y}, oth[4] = {b0.x, b0.y, b1.x, b1.y};
            const float* cp = cs + (size_t)m * 32 + i0; const float* sp = cs + (size_t)M_TOK * 32 + (size_t)m * 32 + i0;
            const float4 c0 = *(const float4*)cp, c1 = *(const float4*)(cp + 4), s0 = *(const float4*)sp, s1 = *(const float4*)(sp + 4);
            const float cc[8] = {c0.x, c0.y, c0.z, c0.w, c1.x, c1.y, c1.z, c1.w}, ss[8] = {s0.x, s0.y, s0.z, s0.w, s1.x, s1.y, s1.z, s1.w};
            const float scale = col < P_AK ? 0.125f : 1.f;
            float r[8];
#pragma unroll
            for (int j = 0; j < 8; ++j) {
                const float me = (j & 1) ? bfhi(mine[j >> 1]) : bflo(mine[j >> 1]);
                const float ot = (j & 1) ? bfhi(oth[j >> 1]) : bflo(oth[j >> 1]);
                r[j] = (second ? (me * cc[j] + ot * ss[j]) : (me * cc[j] - ot * ss[j])) * scale;
            }
            o.x = pk_bf16(r[0], r[1]); o.y = pk_bf16(r[2], r[3]); o.z = pk_bf16(r[4], r[5]); o.w = pk_bf16(r[6], r[7]);
        }
        *(u32x4*)(out + (size_t)m * NP_IN + col) = o;
    }
};
struct EpiOutProj {
    float* y; const float* x;
    __device__ __forceinline__ void operator()(int m, int pn, int c8, const unsigned char* stg_row) const {
        const int col = pn * 256 + c8 * 8;
        const u32x2 a0 = *(const u32x2*)(stg_row + c8 * 16), a1 = *(const u32x2*)(stg_row + c8 * 16 + 8);
        const float4 x0 = *(const float4*)(x + (size_t)m * 1024 + col), x1 = *(const float4*)(x + (size_t)m * 1024 + col + 4);
        *(float4*)(y + (size_t)m * 1024 + col) = make_float4(ALPHA * x0.x + bflo(a0.x), ALPHA * x0.y + bfhi(a0.x), ALPHA * x0.z + bflo(a0.y), ALPHA * x0.w + bfhi(a0.y));
        *(float4*)(y + (size_t)m * 1024 + col + 4) = make_float4(ALPHA * x1.x + bflo(a1.x), ALPHA * x1.y + bfhi(a1.x), ALPHA * x1.z + bflo(a1.y), ALPHA * x1.w + bfhi(a1.y));
    }
};
struct EpiBf16 {
    bf16_t* out; int ldc;
    __device__ __forceinline__ void operator()(int m, int pn, int c8, const unsigned char* stg_row) const {
        const int col = pn * 256 + c8 * 8;
        const u32x2 a0 = *(const u32x2*)(stg_row + c8 * 16), a1 = *(const u32x2*)(stg_row + c8 * 16 + 8);
        u32x4 o; o.x = a0.x; o.y = a0.y; o.z = a1.x; o.w = a1.y;
        *(u32x4*)(out + (size_t)m * ldc + col) = o;
    }
};

template <class EPI>
__device__ __forceinline__ void gemm_phase(const bf16_t* __restrict__ A, const bf16_t* __restrict__ Bt, int M, int N, const EPI& epi, unsigned char* smem) {
    const int tid = threadIdx.x, lane = tid & 63, wave = tid >> 6, r = lane & 31, h = lane >> 5;
    const int wm = wave >> 2, wn = wave & 3;
    const int nM = M / 256, nN = N / 256, ntiles = nM * nN;
    const int gx = gridDim.x, nxg = (gx % 8 == 0 && ntiles % 8 == 0) ? 8 : 1, bpg = gx / nxg, tpg = ntiles / nxg;
    const int grp = blockIdx.x % nxg, bin = blockIdx.x / nxg;
    const int grow = 16 * wave + (lane >> 2), gch = (lane & 3) ^ ((grow >> 2) & 3);
    const unsigned goff = (unsigned)(grow * GK + gch * 8) * 2u;
    constexpr int NKT = GK / 32, STG = 32768;
#define G_STAGE(kt_, Ag_, Bg_) do { const unsigned char* ab_ = (const unsigned char*)(Ag_) + (kt_) * 64; const unsigned char* bb_ = (const unsigned char*)(Bg_) + (kt_) * 64; \
            unsigned char* la_ = smem + ((kt_) & 3) * STG + wave * 1024; \
            _Pragma("unroll") for (int i_ = 0; i_ < 2; ++i_) { \
                __builtin_amdgcn_global_load_lds((const unsigned*)(ab_ + i_ * (128 * GK * 2) + goff), (unsigned*)(la_ + i_ * 8192), 16, 0, 0); \
                __builtin_amdgcn_global_load_lds((const unsigned*)(bb_ + i_ * (128 * GK * 2) + goff), (unsigned*)(la_ + 16384 + i_ * 8192), 16, 0, 0); } } while (0)
#define G_SWZ32(row_, c_) ((row_) * 64 + ((((c_) ^ ((row_) >> 2)) & 3) << 4))
#define G_COMPUTE(kt_) do { const unsigned char* la_ = smem + ((kt_) & 3) * STG; const unsigned char* lb_ = la_ + 16384; \
            _Pragma("unroll") for (int ks_ = 0; ks_ < 2; ++ks_) { bf16x8 af_[4], bf_[2]; \
                _Pragma("unroll") for (int i_ = 0; i_ < 4; ++i_) af_[i_] = *(const bf16x8*)(la_ + G_SWZ32(wm * 128 + i_ * 32 + r, ks_ * 2 + h)); \
                _Pragma("unroll") for (int j_ = 0; j_ < 2; ++j_) bf_[j_] = *(const bf16x8*)(lb_ + G_SWZ32(wn * 64 + j_ * 32 + r, ks_ * 2 + h)); \
                _Pragma("unroll") for (int j_ = 0; j_ < 2; ++j_) _Pragma("unroll") for (int i_ = 0; i_ < 4; ++i_) acc[j_][i_] = __builtin_amdgcn_mfma_f32_32x32x16_bf16(bf_[j_], af_[i_], acc[j_][i_], 0, 0, 0); } } while (0)
#define G_RAWBAR() do { asm volatile("s_waitcnt lgkmcnt(0)" ::: "memory"); __builtin_amdgcn_s_barrier(); asm volatile("" ::: "memory"); } while (0)
    for (int tt = bin; tt < tpg; tt += bpg) {
        const int t = grp * tpg + tt;
        const int pm = t / nN, pn = t % nN;
        const bf16_t* Ag = A + (size_t)pm * 256 * GK; const bf16_t* Bg = Bt + (size_t)pn * 256 * GK;
        f32x16 acc[2][4];
#pragma unroll
        for (int j = 0; j < 2; ++j)
#pragma unroll
            for (int i = 0; i < 4; ++i)
#pragma unroll
                for (int e = 0; e < 16; ++e) acc[j][i][e] = 0.f;
        G_RAWBAR();
        G_STAGE(0, Ag, Bg); G_STAGE(1, Ag, Bg); G_STAGE(2, Ag, Bg);
        for (int kt = 0; kt < NKT; ++kt) {
            if (kt + 2 < NKT) asm volatile("s_waitcnt vmcnt(8)" ::: "memory");
            else if (kt + 1 < NKT) asm volatile("s_waitcnt vmcnt(4)" ::: "memory");
            else asm volatile("s_waitcnt vmcnt(0)" ::: "memory");
            G_RAWBAR();
            if (kt + 3 < NKT) G_STAGE(kt + 3, Ag, Bg);
            G_COMPUTE(kt);
        }
        G_RAWBAR();
#pragma unroll
        for (int j = 0; j < 2; ++j)
#pragma unroll
            for (int i = 0; i < 4; ++i)
#pragma unroll
                for (int g = 0; g < 4; ++g) {
                    u32x2 v; v.x = pk_bf16(acc[j][i][4 * g], acc[j][i][4 * g + 1]); v.y = pk_bf16(acc[j][i][4 * g + 2], acc[j][i][4 * g + 3]);
                    *(u32x2*)(smem + (size_t)(wm * 128 + i * 32 + r) * (STG_STRIDE * 2) + (wn * 64 + j * 32 + 8 * g + 4 * h) * 2) = v;
                }
        __syncthreads();
        const int erow = tid >> 5, ec8 = tid & 31;
#pragma unroll 4
        for (int ps = 0; ps < 16; ++ps) { const int row = ps * 16 + erow; epi(pm * 256 + row, pn, ec8, smem + (size_t)row * (STG_STRIDE * 2)); }
    }
#undef G_STAGE
#undef G_COMPUTE
#undef G_SWZ32
#undef G_RAWBAR
    __syncthreads();
}


constexpr int DN_CH_BYTES = 73728;

constexpr int DP_QS = 0, DP_KS = 16384, DP_TI = 0, DP_Q = 17408, DP_TB = 21632;
constexpr int DP_RT = 32768;
constexpr int DP_AM = 69632;
constexpr int DP_KDT = 87040;
constexpr int DP_QK = 104448;
constexpr int DP_WI = 113152;
constexpr int DP_SM = 130048;

__device__ __forceinline__ void phase_dn_prep(const Params& p, unsigned char* smem) {
    const int tid0 = threadIdx.x;
    float* sbeta = (float*)(smem + DP_SM); float* sgc = sbeta + 64; float* segc = sbeta + 128; float* sekd = sbeta + 192;
    float* Am = (float*)(smem + DP_AM); float* Ti = (float*)(smem + DP_TI); float* Qb = (float*)(smem + DP_Q);
    bf16_t* Tb = (bf16_t*)(smem + DP_TB); bf16_t* Rt = (bf16_t*)(smem + DP_RT);
    bf16_t* kdt = (bf16_t*)(smem + DP_KDT); bf16_t* qki = (bf16_t*)(smem + DP_QK); bf16_t* wim = (bf16_t*)(smem + DP_WI);
    for (int ci = blockIdx.x; ci < 16 * 128; ci += gridDim.x) {
        int tid = tid0; asm volatile("" : "+v"(tid));
        const int lane = tid & 63, wave = tid >> 6;
        const int bh = ci >> 7, n = ci & 127, b = bh >> 2, h = bh & 3;
        const bf16_t* prow = p.proj_b + (size_t)b * SEQ * NP_IN;
        if (wave == 0) {
            const size_t m = (size_t)(n * 64 + lane);
            const float braw = bf2f(prow[m * NP_IN + P_B + h]), araw = bf2f(prow[m * NP_IN + P_A + h]);
            const float beta = 1.f / (1.f + expf(-braw));
            const float xx = araw + p.dt_bias[h];
            const float sp = xx > 20.f ? xx : log1pf(expf(xx));
            float g = -expf(p.a_log[h]) * sp;
#pragma unroll
            for (int o = 1; o < 64; o <<= 1) { const float up = __shfl_up(g, o); if (lane >= o) g += up; }
            const float g63 = __shfl(g, 63);
            sbeta[lane] = beta; sgc[lane] = g; segc[lane] = expf(g); sekd[lane] = expf(g63 - g);
            if (lane == 63) p.dn_gl[ci] = expf(g63);
        }
        __syncthreads();
        {
            const int i = tid >> 3, sg = tid & 7, c0 = sg * 16;
            const float beta_i = sbeta[i], egc_i = segc[i], ekd_i = sekd[i];
            const int tt0 = n * 64 + i - 3;
#pragma unroll
            for (int mat = 0; mat < 3; ++mat) {
                const int colbase = (mat == 0 ? P_DQ : (mat == 1 ? P_DK : P_DV)) + h * 128 + c0;
                float acc[16];
#pragma unroll
                for (int cc = 0; cc < 16; ++cc) acc[cc] = 0.f;
#pragma unroll
                for (int j = 0; j < 4; ++j) {
                    const int tt = tt0 + j;
                    if (tt >= 0) {
                        const u32x4 x0 = *(const u32x4*)(prow + (size_t)tt * NP_IN + colbase), x1 = *(const u32x4*)(prow + (size_t)tt * NP_IN + colbase + 8);
                        const float* wp = p.conv_w + j * 1536 + mat * 512 + h * 128 + c0;
                        const float4 w0 = *(const float4*)wp, w1 = *(const float4*)(wp + 4), w2 = *(const float4*)(wp + 8), w3 = *(const float4*)(wp + 12);
                        acc[0] = fmaf(w0.x, bflo(x0.x), acc[0]); acc[1] = fmaf(w0.y, bfhi(x0.x), acc[1]); acc[2] = fmaf(w0.z, bflo(x0.y), acc[2]); acc[3] = fmaf(w0.w, bfhi(x0.y), acc[3]);
                        acc[4] = fmaf(w1.x, bflo(x0.z), acc[4]); acc[5] = fmaf(w1.y, bfhi(x0.z), acc[5]); acc[6] = fmaf(w1.z, bflo(x0.w), acc[6]); acc[7] = fmaf(w1.w, bfhi(x0.w), acc[7]);
                        acc[8] = fmaf(w2.x, bflo(x1.x), acc[8]); acc[9] = fmaf(w2.y, bfhi(x1.x), acc[9]); acc[10] = fmaf(w2.z, bflo(x1.y), acc[10]); acc[11] = fmaf(w2.w, bfhi(x1.y), acc[11]);
                        acc[12] = fmaf(w3.x, bflo(x1.z), acc[12]); acc[13] = fmaf(w3.y, bfhi(x1.z), acc[13]); acc[14] = fmaf(w3.z, bflo(x1.w), acc[14]); acc[15] = fmaf(w3.w, bfhi(x1.w), acc[15]);
                    }
                }
                float ss = 0.f;
#pragma unroll
                for (int cc = 0; cc < 16; ++cc) { acc[cc] = silu_f(acc[cc]); ss = fmaf(acc[cc], acc[cc], ss); }
                if (mat < 2) {
                    ss += __shfl_xor(ss, 1); ss += __shfl_xor(ss, 2); ss += __shfl_xor(ss, 4);
                    const float rs = rsqrtf(ss + L2_EPS) * (mat == 0 ? 0.08838834764831845f : 1.f);
#pragma unroll
                    for (int cc = 0; cc < 16; ++cc) acc[cc] *= rs;
                    unsigned char* img = smem + (mat == 0 ? DP_QS : DP_KS) + i * 256;
                    u32x4 c0v, c1v;
                    c0v.x = pk_bf16(acc[0], acc[1]); c0v.y = pk_bf16(acc[2], acc[3]); c0v.z = pk_bf16(acc[4], acc[5]); c0v.w = pk_bf16(acc[6], acc[7]);
                    c1v.x = pk_bf16(acc[8], acc[9]); c1v.y = pk_bf16(acc[10], acc[11]); c1v.z = pk_bf16(acc[12], acc[13]); c1v.w = pk_bf16(acc[14], acc[15]);
                    *(u32x4*)(img + (((2 * sg) ^ (i & 15)) << 4)) = c0v;
                    *(u32x4*)(img + (((2 * sg + 1) ^ (i & 15)) << 4)) = c1v;
                }
                if (mat == 0) {
                    u32x4 p0, p1;
                    p0.x = pk_bf16(acc[0] * egc_i, acc[1] * egc_i); p0.y = pk_bf16(acc[2] * egc_i, acc[3] * egc_i); p0.z = pk_bf16(acc[8] * egc_i, acc[9] * egc_i); p0.w = pk_bf16(acc[10] * egc_i, acc[11] * egc_i);
                    p1.x = pk_bf16(acc[4] * egc_i, acc[5] * egc_i); p1.y = pk_bf16(acc[6] * egc_i, acc[7] * egc_i); p1.z = pk_bf16(acc[12] * egc_i, acc[13] * egc_i); p1.w = pk_bf16(acc[14] * egc_i, acc[15] * egc_i);
                    bf16_t* dst = p.dn_qd + ((size_t)(ci * 16 + (i >> 5) * 8 + sg) * 64) * 8;
                    *(u32x4*)(dst + (size_t)(i & 31) * 8) = p0;
                    *(u32x4*)(dst + (size_t)(32 + (i & 31)) * 8) = p1;
                } else if (mat == 1) {
                    const float sc = beta_i * egc_i;
#pragma unroll
                    for (int cc = 0; cc < 16; ++cc) {
                        Rt[(128 + c0 + cc) * 72 + i] = (bf16_t)(pk_bf16(acc[cc] * sc, 0.f) & 0xffffu);
                        kdt[(c0 + cc) * 68 + i] = (bf16_t)(pk_bf16(acc[cc] * ekd_i, 0.f) & 0xffffu);
                    }
                } else {
#pragma unroll
                    for (int cc = 0; cc < 16; ++cc) Rt[(c0 + cc) * 72 + i] = (bf16_t)(pk_bf16(acc[cc] * beta_i, 0.f) & 0xffffu);
                }
            }
        }
        __syncthreads();
        {
            const int mat = wave >> 2, ti = (wave >> 1) & 1, tj = wave & 1, r = lane & 31, hh = lane >> 5;
            const unsigned char* ai = smem + (mat ? DP_QS : DP_KS) + (ti * 32 + r) * 256;
            const unsigned char* bi = smem + DP_KS + (tj * 32 + r) * 256;
            f32x16 d;
#pragma unroll
            for (int e = 0; e < 16; ++e) d[e] = 0.f;
#pragma unroll
            for (int ks = 0; ks < 8; ++ks) {
                const bf16x8 af = *(const bf16x8*)(ai + (((2 * ks + hh) ^ (r & 15)) << 4));
                const bf16x8 bf = *(const bf16x8*)(bi + (((2 * ks + hh) ^ (r & 15)) << 4));
                d = __builtin_amdgcn_mfma_f32_32x32x16_bf16(af, bf, d, 0, 0, 0);
            }
            const int j = tj * 32 + r; const float gcj = sgc[j];
#pragma unroll
            for (int e = 0; e < 16; ++e) {
                const int i = ti * 32 + (e & 3) + 8 * (e >> 2) + 4 * hh;
                const float dec = __expf(fminf(sgc[i] - gcj, 0.f));
                if (mat == 0) Am[i * 68 + j] = (j < i) ? sbeta[i] * d[e] * dec : 0.f;
                else qki[i * 68 + j] = (bf16_t)(pk_bf16((j <= i) ? d[e] * dec : 0.f, 0.f) & 0xffffu);
            }
        }
        __syncthreads();
        if (tid < 64) {
            const int bk = tid >> 4, c = tid & 15;
            const float* Ab = Am + (16 * bk) * 68 + 16 * bk;
            float X[16];
#pragma unroll
            for (int i = 0; i < 16; ++i) {
                float sacc = 0.f;
#pragma unroll
                for (int j = 0; j < i; ++j) sacc = fmaf(Ab[i * 68 + j], X[j], sacc);
                X[i] = ((i == c) ? 1.f : 0.f) - sacc;
            }
#pragma unroll
            for (int i = 0; i < 16; ++i) Ti[(16 * bk + i) * 68 + 16 * bk + c] = X[i];
        } else {
            for (int z = tid - 64; z < 6 * 256; z += 448) {
                const int blk = z >> 8, e2 = z & 255, bi = blk < 3 ? 0 : (blk < 5 ? 1 : 2), bj = blk < 3 ? blk + 1 : (blk < 5 ? blk - 1 : 3);
                Ti[(16 * bi + (e2 >> 4)) * 68 + 16 * bj + (e2 & 15)] = 0.f;
            }
        }
        __syncthreads();
        {
            const int w2 = tid >> 8, o = tid & 255, ri = o >> 4, cj = o & 15, r0 = 16 * (2 * w2 + 1), c0 = 16 * (2 * w2);
            float sacc = 0.f;
#pragma unroll
            for (int k = 0; k < 16; ++k) sacc = fmaf(Am[(r0 + ri) * 68 + c0 + k], Ti[(c0 + k) * 68 + c0 + cj], sacc);
            Qb[w2 * 272 + ri * 17 + cj] = sacc;
        }
        __syncthreads();
        {
            const int w2 = tid >> 8, o = tid & 255, ri = o >> 4, cj = o & 15, r0 = 16 * (2 * w2 + 1), c0 = 16 * (2 * w2);
            float sacc = 0.f;
#pragma unroll
            for (int k = 0; k < 16; ++k) sacc = fmaf(Ti[(r0 + ri) * 68 + r0 + k], Qb[w2 * 272 + k * 17 + cj], sacc);
            Ti[(r0 + ri) * 68 + c0 + cj] = -sacc;
        }
        __syncthreads();
        float q3[2];
#pragma unroll
        for (int q = 0; q < 2; ++q) {
            const int o = tid + 512 * q, ri = o >> 5, cj = o & 31;
            float sacc = 0.f;
#pragma unroll
            for (int k = 0; k < 32; ++k) sacc = fmaf(Am[(32 + ri) * 68 + k], Ti[k * 68 + cj], sacc);
            q3[q] = sacc;
        }
#pragma unroll
        for (int q = 0; q < 2; ++q) { const int o = tid + 512 * q; Qb[(o >> 5) * 33 + (o & 31)] = q3[q]; }
        __syncthreads();
#pragma unroll
        for (int q = 0; q < 2; ++q) {
            const int o = tid + 512 * q, ri = o >> 5, cj = o & 31;
            float sacc = 0.f;
#pragma unroll
            for (int k = 0; k < 32; ++k) sacc = fmaf(Ti[(32 + ri) * 68 + 32 + k], Qb[k * 33 + cj], sacc);
            q3[q] = -sacc;
        }
        __syncthreads();
#pragma unroll
        for (int q = 0; q < 2; ++q) { const int o = tid + 512 * q; Ti[(32 + (o >> 5)) * 68 + (o & 31)] = q3[q]; }
        __syncthreads();
#pragma unroll
        for (int q = 0; q < 4; ++q) {
            const int o2 = tid + 512 * q, ri = o2 >> 5, c2 = (o2 & 31) * 2;
            *(unsigned*)(Tb + ri * 72 + c2) = pk_bf16(Ti[ri * 68 + c2], Ti[ri * 68 + c2 + 1]);
        }
        __syncthreads();
        {
            const int ct = wave, r = lane & 31, hh = lane >> 5;
            f32x16 xacc[2];
#pragma unroll
            for (int T = 0; T < 2; ++T)
#pragma unroll
                for (int e = 0; e < 16; ++e) xacc[T][e] = 0.f;
#pragma unroll
            for (int ks = 0; ks < 4; ++ks) {
                const bf16x8 bfr = *(const bf16x8*)(Rt + (32 * ct + r) * 72 + 16 * ks + 8 * hh);
#pragma unroll
                for (int T = 0; T < 2; ++T) {
                    const bf16x8 afr = *(const bf16x8*)(Tb + (32 * T + r) * 72 + 16 * ks + 8 * hh);
                    xacc[T] = __builtin_amdgcn_mfma_f32_32x32x16_bf16(afr, bfr, xacc[T], 0, 0, 0);
                }
            }
            if (ct < 4) {
#pragma unroll
                for (int T = 0; T < 2; ++T)
#pragma unroll
                    for (int hf = 0; hf < 2; ++hf) {
                        u32x4 o; o.x = pk_bf16(xacc[T][8 * hf], xacc[T][8 * hf + 1]); o.y = pk_bf16(xacc[T][8 * hf + 2], xacc[T][8 * hf + 3]);
                        o.z = pk_bf16(xacc[T][8 * hf + 4], xacc[T][8 * hf + 5]); o.w = pk_bf16(xacc[T][8 * hf + 6], xacc[T][8 * hf + 7]);
                        *(u32x4*)(p.dn_u + ((size_t)(((ci * 4 + ct) * 2 + T) * 2 + hf) * 64 + lane) * 8) = o;
                    }
            } else {
                const int dd = 32 * (ct - 4) + r;
#pragma unroll
                for (int T = 0; T < 2; ++T)
#pragma unroll
                    for (int e = 0; e < 16; ++e) wim[(32 * T + (e & 3) + 8 * (e >> 2) + 4 * hh) * 132 + dd] = (bf16_t)(pk_bf16(-xacc[T][e], 0.f) & 0xffffu);
            }
#pragma unroll
            for (int q = 0; q < 3; ++q) {
                const int pc = tid + 512 * q;
                if (pc < 512) {
                    const int f = pc >> 6, ln = pc & 63, r2 = ln & 31, h2 = ln >> 5, rt = f >> 2, ks = f & 3;
                    const bf16_t* src = qki + (32 * rt + r2) * 68 + 16 * ks + 4 * h2;
                    const u32x2 lo = *(const u32x2*)src, hi = *(const u32x2*)(src + 8);
                    u32x4 o; o.x = lo.x; o.y = lo.y; o.z = hi.x; o.w = hi.y;
                    *(u32x4*)(p.dn_qk + ((size_t)(ci * 8 + f) * 64 + ln) * 8) = o;
                } else {
                    const int pc2 = pc - 512, f = pc2 >> 6, ln = pc2 & 63, r2 = ln & 31, h2 = ln >> 5, rt = f >> 2, ks = f & 3;
                    const bf16_t* src = kdt + (32 * rt + r2) * 68 + 16 * ks + 4 * h2;
                    const u32x2 lo = *(const u32x2*)src, hi = *(const u32x2*)(src + 8);
                    u32x4 o; o.x = lo.x; o.y = lo.y; o.z = hi.x; o.w = hi.y;
                    *(u32x4*)(p.dn_kdt + ((size_t)(ci * 16 + f) * 64 + ln) * 8) = o;
                }
            }
        }
        __syncthreads();
#pragma unroll
        for (int q = 0; q < 2; ++q) {
            const int pc = tid + 512 * q, f = pc >> 6, ln = pc & 63, r = ln & 31, hh = ln >> 5, rt = f >> 3, ks = f & 7;
            const bf16_t* src = wim + (32 * rt + r) * 132 + 16 * ks + 4 * hh;
            const u32x2 lo = *(const u32x2*)src, hi = *(const u32x2*)(src + 8);
            u32x4 o; o.x = lo.x; o.y = lo.y; o.z = hi.x; o.w = hi.y;
            *(u32x4*)(p.dn_negw + ((size_t)(ci * 16 + f) * 64 + ln) * 8) = o;
        }
    }
    __syncthreads();
}

__device__ __forceinline__ bf16x8 pack8(const f32x16& x, int s) {
    u32x4 v;
    v.x = pk_bf16(x[8 * s], x[8 * s + 1]); v.y = pk_bf16(x[8 * s + 2], x[8 * s + 3]); v.z = pk_bf16(x[8 * s + 4], x[8 * s + 5]); v.w = pk_bf16(x[8 * s + 6], x[8 * s + 7]);
    return __builtin_bit_cast(bf16x8, v);
}
#define LDS_BARRIER() do { asm volatile("s_waitcnt lgkmcnt(0)" ::: "memory"); __builtin_amdgcn_s_barrier(); asm volatile("" ::: "memory"); } while (0)
__device__ __forceinline__ const bf16_t* dn_piece_src(const Params& p, int ci, int pc) {
    return pc < 1024 ? p.dn_negw + ((size_t)ci * 1024 + pc) * 8 : pc < 2048 ? p.dn_qd + ((size_t)ci * 1024 + (pc - 1024)) * 8
         : pc < 3072 ? p.dn_kdt + ((size_t)ci * 1024 + (pc - 2048)) * 8 : pc < 3584 ? p.dn_qk + ((size_t)ci * 512 + (pc - 3072)) * 8 : p.dn_u + ((size_t)ci * 1024 + (pc - 3584)) * 8;
}
constexpr int DN_SEG = 32;
template <int PASS> __device__ __forceinline__ int dn_lpiece(int q) { return PASS == 0 ? q : (q < 1024 ? q : (q < 2048 ? q + 1024 : q + 1536)); }
template <int PASS>
__device__ __forceinline__ void dn_scan_seg(const Params& p, unsigned char* smem, int bh, int seg, int half) {
    constexpr int NPC = PASS == 0 ? 4608 : 3072, LPT = NPC / 256, PPT = NPC / 512;
    const int tid = threadIdx.x, lane = tid & 63, wave = tid >> 6, r = lane & 31, hh = lane >> 5;
    const int b = bh >> 2, h = bh & 3, ci0 = bh * 128 + seg * DN_SEG;
#pragma unroll
    for (int q = 0; q < PPT; ++q) { const int pc = dn_lpiece<PASS>(tid + 512 * q); *(u32x4*)(smem + pc * 16) = *(const u32x4*)dn_piece_src(p, ci0, pc); }
    __syncthreads();
    if (wave >= 4) {
        const int t2 = tid - 256;
        u32x4 sa[LPT], sb[LPT], sc[LPT];
#define DN_LD(dst, chunk) do { const int c_ = ci0 + ((chunk) < DN_SEG - 1 ? (chunk) : DN_SEG - 1); _Pragma("unroll") for (int q_ = 0; q_ < LPT; ++q_) dst[q_] = *(const u32x4*)dn_piece_src(p, c_, dn_lpiece<PASS>(t2 + 256 * q_)); } while (0)
#define DN_WR(src, chunk) do { if ((chunk) < DN_SEG) { unsigned char* nb_ = smem + ((chunk) & 1) * DN_CH_BYTES; _Pragma("unroll") for (int q_ = 0; q_ < LPT; ++q_) *(u32x4*)(nb_ + dn_lpiece<PASS>(t2 + 256 * q_) * 16) = src[q_]; } } while (0)
        DN_LD(sa, 1); DN_LD(sb, 2); DN_LD(sc, 3);
        for (int n = 0; n < DN_SEG + 1; n += 3) {
            if (n < DN_SEG) { DN_WR(sa, n + 1); DN_LD(sa, n + 4); LDS_BARRIER(); }
            if (n + 1 < DN_SEG) { DN_WR(sb, n + 2); DN_LD(sb, n + 5); LDS_BARRIER(); }
            if (n + 2 < DN_SEG) { DN_WR(sc, n + 3); DN_LD(sc, n + 6); LDS_BARRIER(); }
        }
#undef DN_LD
#undef DN_WR
    } else {
        const int e = __builtin_amdgcn_readfirstlane(wave);
        const int sl = 4 * half + e;
        const bool isP = sl < 4;
        f32x16 S[4];
#pragma unroll
        for (int T = 0; T < 4; ++T)
#pragma unroll
            for (int e2 = 0; e2 < 16; ++e2) {
                const int row = 32 * T + (e2 & 3) + 8 * (e2 >> 2) + 4 * hh;
                if (PASS == 0) S[T][e2] = seg > 0 ? p.dn_PB[((size_t)(bh * 3 + 0) * 128 + row) * 256 + 128 + 32 * e + r] : 0.f;
                else S[T][e2] = (isP && row == 32 * sl + r) ? 1.f : 0.f;
            }
        if (PASS == 0) {
            for (int sg = 1; sg < seg; ++sg) {
                const float* pseg = p.dn_PB + (size_t)(bh * 3 + sg) * 128 * 256;
                bf16x8 Xb[8];
#pragma unroll
                for (int T = 0; T < 4; ++T) { Xb[2 * T] = pack8(S[T], 0); Xb[2 * T + 1] = pack8(S[T], 1); }
#pragma unroll
                for (int T = 0; T < 4; ++T) {
                    f32x16 xn;
#pragma unroll
                    for (int e2 = 0; e2 < 16; ++e2) xn[e2] = pseg[(size_t)(32 * T + (e2 & 3) + 8 * (e2 >> 2) + 4 * hh) * 256 + 128 + 32 * e + r];
#pragma unroll
                    for (int ks = 0; ks < 8; ++ks) {
                        const float* pr = pseg + (size_t)(32 * T + r) * 256 + 16 * ks + 4 * hh;
                        const float4 lo = *(const float4*)pr, hi = *(const float4*)(pr + 8);
                        u32x4 av; av.x = pk_bf16(lo.x, lo.y); av.y = pk_bf16(lo.z, lo.w); av.z = pk_bf16(hi.x, hi.y); av.w = pk_bf16(hi.z, hi.w);
                        xn = __builtin_amdgcn_mfma_f32_32x32x16_bf16(__builtin_bit_cast(bf16x8, av), Xb[ks], xn, 0, 0, 0);
                        if (ks & 1) __builtin_amdgcn_sched_barrier(0);
                    }
                    S[T] = xn;
                    __builtin_amdgcn_sched_barrier(0);
                }
            }
        }
        const float glr = p.dn_gl[ci0 + (lane & 31)];
#define DN_SB() __builtin_amdgcn_sched_barrier(0)
#define DN_RD8(dst, off) do { _Pragma("unroll") for (int q_ = 0; q_ < 8; ++q_) dst[q_] = *(const bf16x8*)(buf + (off) + q_ * 1024 + lane * 16); } while (0)
        bf16x8 Sb[8];
#pragma unroll
        for (int T = 0; T < 4; ++T) { Sb[2 * T] = pack8(S[T], 0); Sb[2 * T + 1] = pack8(S[T], 1); }
        const unsigned ooff = (unsigned)(4 * hh * 512 + r);
        for (int n = 0; n < DN_SEG; ++n) {
            const unsigned char* buf = smem + (n & 1) * DN_CH_BYTES;
            const float gl = __uint_as_float(__builtin_amdgcn_readlane(__float_as_uint(glr), n));
            bf16x8 fa[8], fb[8];
            DN_RD8(fa, 0);
            DN_RD8(fb, 8192);
            f32x16 vn0, vn1;
            if (PASS == 0 || !isP) {
                const unsigned char* ub = buf + 57344 + (PASS == 0 ? e : sl - 4) * 4096 + lane * 16;
                const u32x4 u00 = *(const u32x4*)ub, u01 = *(const u32x4*)(ub + 1024), u10 = *(const u32x4*)(ub + 2048), u11 = *(const u32x4*)(ub + 3072);
                vn0[0] = bflo(u00.x); vn0[1] = bfhi(u00.x); vn0[2] = bflo(u00.y); vn0[3] = bfhi(u00.y); vn0[4] = bflo(u00.z); vn0[5] = bfhi(u00.z); vn0[6] = bflo(u00.w); vn0[7] = bfhi(u00.w);
                vn0[8] = bflo(u01.x); vn0[9] = bfhi(u01.x); vn0[10] = bflo(u01.y); vn0[11] = bfhi(u01.y); vn0[12] = bflo(u01.z); vn0[13] = bfhi(u01.z); vn0[14] = bflo(u01.w); vn0[15] = bfhi(u01.w);
                vn1[0] = bflo(u10.x); vn1[1] = bfhi(u10.x); vn1[2] = bflo(u10.y); vn1[3] = bfhi(u10.y); vn1[4] = bflo(u10.z); vn1[5] = bfhi(u10.z); vn1[6] = bflo(u10.w); vn1[7] = bfhi(u10.w);
                vn1[8] = bflo(u11.x); vn1[9] = bfhi(u11.x); vn1[10] = bflo(u11.y); vn1[11] = bfhi(u11.y); vn1[12] = bflo(u11.z); vn1[13] = bfhi(u11.z); vn1[14] = bflo(u11.w); vn1[15] = bfhi(u11.w);
            } else {
#pragma unroll
                for (int e2 = 0; e2 < 16; ++e2) { vn0[e2] = 0.f; vn1[e2] = 0.f; }
            }
            DN_SB();
#pragma unroll
            for (int ks = 0; ks < 8; ++ks) vn0 = __builtin_amdgcn_mfma_f32_32x32x16_bf16(fa[ks], Sb[ks], vn0, 0, 0, 0);
            DN_SB();
            if (PASS == 0) DN_RD8(fa, 16384); else DN_RD8(fa, 32768);
            DN_SB();
#pragma unroll
            for (int ks = 0; ks < 8; ++ks) vn1 = __builtin_amdgcn_mfma_f32_32x32x16_bf16(fb[ks], Sb[ks], vn1, 0, 0, 0);
            DN_SB();
            if (PASS == 0) DN_RD8(fb, 16384 + 8192); else DN_RD8(fb, 32768 + 8192);
            DN_SB();
            f32x16 o0, o1;
            if (PASS == 0) {
#pragma unroll
                for (int e2 = 0; e2 < 16; ++e2) { o0[e2] = 0.f; o1[e2] = 0.f; }
#pragma unroll
                for (int ks = 0; ks < 8; ++ks) o0 = __builtin_amdgcn_mfma_f32_32x32x16_bf16(fa[ks], Sb[ks], o0, 0, 0, 0);
                DN_SB();
                DN_RD8(fa, 32768);
            }
            bf16x8 vb[4];
            vb[0] = pack8(vn0, 0); vb[1] = pack8(vn0, 1); vb[2] = pack8(vn1, 0); vb[3] = pack8(vn1, 1);
            DN_SB();
            if (PASS == 0) {
#pragma unroll
                for (int ks = 0; ks < 8; ++ks) o1 = __builtin_amdgcn_mfma_f32_32x32x16_bf16(fb[ks], Sb[ks], o1, 0, 0, 0);
                DN_SB();
                DN_RD8(fb, 32768 + 8192);
            }
#pragma unroll
            for (int e2 = 0; e2 < 16; ++e2) { S[0][e2] *= gl; S[1][e2] *= gl; }
            DN_SB();
#pragma unroll
            for (int ks = 0; ks < 4; ++ks) S[0] = __builtin_amdgcn_mfma_f32_32x32x16_bf16(fa[ks], vb[ks], S[0], 0, 0, 0);
#pragma unroll
            for (int ks = 0; ks < 4; ++ks) S[1] = __builtin_amdgcn_mfma_f32_32x32x16_bf16(fa[4 + ks], vb[ks], S[1], 0, 0, 0);
            DN_SB();
            if (PASS == 0) DN_RD8(fa, 49152);
#pragma unroll
            for (int e2 = 0; e2 < 16; ++e2) { S[2][e2] *= gl; S[3][e2] *= gl; }
            DN_SB();
#pragma unroll
            for (int ks = 0; ks < 4; ++ks) S[2] = __builtin_amdgcn_mfma_f32_32x32x16_bf16(fb[ks], vb[ks], S[2], 0, 0, 0);
#pragma unroll
            for (int ks = 0; ks < 4; ++ks) S[3] = __builtin_amdgcn_mfma_f32_32x32x16_bf16(fb[4 + ks], vb[ks], S[3], 0, 0, 0);
            DN_SB();
            if (PASS == 0) {
#pragma unroll
                for (int ks = 0; ks < 4; ++ks) o0 = __builtin_amdgcn_mfma_f32_32x32x16_bf16(fa[ks], vb[ks], o0, 0, 0, 0);
#pragma unroll
                for (int ks = 0; ks < 4; ++ks) o1 = __builtin_amdgcn_mfma_f32_32x32x16_bf16(fa[4 + ks], vb[ks], o1, 0, 0, 0);
                DN_SB();
            }
#pragma unroll
            for (int T = 0; T < 4; ++T) { Sb[2 * T] = pack8(S[T], 0); Sb[2 * T + 1] = pack8(S[T], 1); }
            if (PASS == 0) {
                bf16_t* ob = p.odn_raw + ((size_t)b * SEQ + (seg * DN_SEG + n) * 64) * 512 + h * 128 + 32 * e;
#pragma unroll
                for (int e2 = 0; e2 < 16; e2 += 2) {
                    const unsigned w0 = pk_bf16(o0[e2], o0[e2 + 1]), w1 = pk_bf16(o1[e2], o1[e2 + 1]);
                    (ob + ((e2 & 3) + 8 * (e2 >> 2)) * 512)[ooff] = (bf16_t)(w0 & 0xffffu); (ob + ((e2 & 3) + 1 + 8 * (e2 >> 2)) * 512)[ooff] = (bf16_t)(w0 >> 16);
                    (ob + (32 + (e2 & 3) + 8 * (e2 >> 2)) * 512)[ooff] = (bf16_t)(w1 & 0xffffu); (ob + (32 + (e2 & 3) + 1 + 8 * (e2 >> 2)) * 512)[ooff] = (bf16_t)(w1 >> 16);
                }
            }
            LDS_BARRIER();
        }
#undef DN_RD8
#undef DN_SB
        if (PASS == 1) {
            float* pb = p.dn_PB + (size_t)(bh * 3 + seg) * 128 * 256 + 32 * sl + r;
#pragma unroll
            for (int T = 0; T < 4; ++T)
#pragma unroll
                for (int e2 = 0; e2 < 16; ++e2) pb[(size_t)(32 * T + (e2 & 3) + 8 * (e2 >> 2) + 4 * hh) * 256] = S[T][e2];
        }
    }
    __syncthreads();
}
__device__ __forceinline__ void phase_scan_l2_helper(const Params& p) {
    const int j = blockIdx.x - 64, tid = threadIdx.x;
    const int sj = (blockIdx.x & 7) + 8 * ((j >> 3) & 7), hi = (j >> 3) >> 3;
    const int bh = sj >> 2, seg = sj & 3, ci0 = bh * 128 + seg * DN_SEG;
    unsigned acc = 0u;
    for (int m = 4 + hi; m < DN_SEG; m += 3) {
#pragma unroll
        for (int q = 0; q < 9; ++q) { const u32x4 v = *(const u32x4*)dn_piece_src(p, ci0 + m, tid + 512 * q); acc ^= v.x ^ v.y ^ v.z ^ v.w; }
    }
    asm volatile("" :: "v"(acc));
}

constexpr int AT_VT = 32768, AT_VT_STRIDE = 260;
__device__ __forceinline__ void phase_attn(const Params& p, unsigned char* smem, int first_block) {
    const int tid0 = threadIdx.x;
    const int nblk = gridDim.x - first_block;
    const bf16_t* pb = p.proj_b;
    bf16_t* vt = (bf16_t*)(smem + AT_VT);
    for (int item = blockIdx.x - first_block; item < 1024; item += nblk) {
        int tid = tid0; asm volatile("" : "+v"(tid));
        const int lane = tid & 63, wave = tid >> 6, r = lane & 31, hh = lane >> 5;
        const int hp = item & 1, kvh = (item >> 1) & 1, nb = (item >> 2) & 63, b = item >> 8;
        const int m0 = b * SEQ + nb * 128;
        __syncthreads();
#pragma unroll
        for (int i = 0; i < 4; ++i) {
            const int idx = tid + 512 * i, key = idx >> 3, ch = idx & 7;
            const bool valid = (nb > 0) || (key >= 128);
            u32x4 kv = {0u, 0u, 0u, 0u}, vv = {0u, 0u, 0u, 0u};
            if (valid) { const bf16_t* src = pb + (size_t)(m0 - 128 + key) * NP_IN + kvh * 64 + ch * 8; kv = *(const u32x4*)(src + P_AK); vv = *(const u32x4*)(src + P_AV); }
            *(u32x4*)(smem + swz(key, ch)) = kv;
            bf16_t* vd = vt + (ch * 8) * AT_VT_STRIDE + key;
            vd[0] = (bf16_t)(vv.x & 0xffffu); vd[AT_VT_STRIDE] = (bf16_t)(vv.x >> 16); vd[2 * AT_VT_STRIDE] = (bf16_t)(vv.y & 0xffffu); vd[3 * AT_VT_STRIDE] = (bf16_t)(vv.y >> 16);
            vd[4 * AT_VT_STRIDE] = (bf16_t)(vv.z & 0xffffu); vd[5 * AT_VT_STRIDE] = (bf16_t)(vv.z >> 16); vd[6 * AT_VT_STRIDE] = (bf16_t)(vv.w & 0xffffu); vd[7 * AT_VT_STRIDE] = (bf16_t)(vv.w >> 16);
        }
        __syncthreads();
        const int head = kvh * 4 + hp * 2 + (wave >> 2), qt = wave & 3, qo = qt * 32;
        const bf16_t* qrow = pb + (size_t)(m0 + qo + r) * NP_IN + P_AQ + head * 64 + 8 * hh;
        bf16x8 qf[4];
#pragma unroll
        for (int ks = 0; ks < 4; ++ks) qf[ks] = *(const bf16x8*)(qrow + 16 * ks);
        f32x16 sc[5];
#pragma unroll
        for (int t = 0; t < 5; ++t) {
#pragma unroll
            for (int e = 0; e < 16; ++e) sc[t][e] = 0.f;
#pragma unroll
            for (int ks = 0; ks < 4; ++ks) sc[t] = __builtin_amdgcn_mfma_f32_32x32x16_bf16(*(const bf16x8*)(smem + swz((qt + t) * 32 + r, 2 * ks + hh)), qf[ks], sc[t], 0, 0, 0);
        }
        const float sink = p.sinks[head];
        float mx = -1e30f;
#pragma unroll
        for (int t = 0; t < 5; ++t)
#pragma unroll
            for (int e = 0; e < 16; ++e) {
                const int kf = 32 * (qt + t) + (e & 3) + 8 * (e >> 2) + 4 * hh;
                const bool ok = (kf >= qo + r + 1) && (kf <= qo + r + 128) && ((nb > 0) || (kf >= 128));
                sc[t][e] = ok ? sc[t][e] : -1e30f;
                mx = fmaxf(mx, sc[t][e]);
            }
        mx = fmaxf(mx, __shfl_xor(mx, 32));
        mx = fmaxf(mx, sink);
        float sum = 0.f;
#pragma unroll
        for (int t = 0; t < 5; ++t)
#pragma unroll
            for (int e = 0; e < 16; ++e) { const float pe = (sc[t][e] > -1e29f) ? __expf(sc[t][e] - mx) : 0.f; sc[t][e] = pe; sum += pe; }
        sum += __shfl_xor(sum, 32);
        const float inv = 1.f / (sum + __expf(sink - mx));
        f32x16 o[2];
#pragma unroll
        for (int dt = 0; dt < 2; ++dt)
#pragma unroll
            for (int e = 0; e < 16; ++e) o[dt][e] = 0.f;
#pragma unroll
        for (int t = 0; t < 5; ++t)
#pragma unroll
            for (int s2 = 0; s2 < 2; ++s2) {
                const bf16x8 pbv = pack8(sc[t], s2);
                const int kb = 32 * (qt + t) + 16 * s2 + 4 * hh;
#pragma unroll
                for (int dt = 0; dt < 2; ++dt) {
                    const bf16_t* vr = vt + (dt * 32 + r) * AT_VT_STRIDE + kb;
                    const u32x2 lo = *(const u32x2*)vr, hi = *(const u32x2*)(vr + 8);
                    u32x4 av; av.x = lo.x; av.y = lo.y; av.z = hi.x; av.w = hi.y;
                    o[dt] = __builtin_amdgcn_mfma_f32_32x32x16_bf16(__builtin_bit_cast(bf16x8, av), pbv, o[dt], 0, 0, 0);
                }
            }
        bf16_t* orow = p.xb + (size_t)(m0 + qo + r) * D_MODEL + head * 64 + 4 * hh;
#pragma unroll
        for (int dt = 0; dt < 2; ++dt)
#pragma unroll
            for (int q4 = 0; q4 < 4; ++q4) {
                u32x2 v; v.x = pk_bf16(o[dt][4 * q4] * inv, o[dt][4 * q4 + 1] * inv); v.y = pk_bf16(o[dt][4 * q4 + 2] * inv, o[dt][4 * q4 + 3] * inv);
                *(u32x2*)(orow + dt * 32 + 8 * q4) = v;
            }
    }
    __syncthreads();
}

__device__ __forceinline__ void phase_dn_norm(const Params& p) {
    const int lane = threadIdx.x & 63, gw = blockIdx.x * (NTHREADS / 64) + (threadIdx.x >> 6), GW = gridDim.x * (NTHREADS / 64);
    const float2 g = *(const float2*)(p.dn_norm_g + lane * 2);
    for (int m = gw; m < M_TOK; m += GW) {
        float2 o[4]; unsigned z[4];
#pragma unroll
        for (int h = 0; h < 4; ++h) { const unsigned ow = *(const unsigned*)(p.odn_raw + (size_t)m * 512 + h * 128 + lane * 2); o[h] = make_float2(bflo(ow), bfhi(ow)); z[h] = *(const unsigned*)(p.proj_b + (size_t)m * NP_IN + P_Z + h * 128 + lane * 2); }
#pragma unroll
        for (int h = 0; h < 4; ++h) {
            const float ss = wave_sum(o[h].x * o[h].x + o[h].y * o[h].y);
            const float rr = rsqrtf(ss * (1.f / 128.f) + RMS_EPS);
            *(unsigned*)(p.xb + (size_t)m * D_MODEL + 512 + h * 128 + lane * 2) = pk_bf16(o[h].x * rr * g.x * silu_f(bflo(z[h])), o[h].y * rr * g.y * silu_f(bfhi(z[h])));
        }
    }
}

__device__ __forceinline__ void phase_ln1(const Params& p, bf16_t* x1b) {
    const int lane = threadIdx.x & 63, gw = blockIdx.x * (NTHREADS / 64) + (threadIdx.x >> 6), GW = gridDim.x * (NTHREADS / 64);
    float4 g[4], bb[4];
#pragma unroll
    for (int j = 0; j < 4; ++j) { g[j] = *(const float4*)(p.ln1_g + j * 256 + lane * 4); bb[j] = *(const float4*)(p.ln1_b + j * 256 + lane * 4); }
    for (int m0 = gw * 4; m0 < M_TOK; m0 += GW * 4) {
        float4 v[4][4];
#pragma unroll
        for (int rr = 0; rr < 4; ++rr)
#pragma unroll
            for (int j = 0; j < 4; ++j) v[rr][j] = *(const float4*)(p.out + (size_t)(m0 + rr) * D_MODEL + j * 256 + lane * 4);
#pragma unroll
        for (int rr = 0; rr < 4; ++rr) {
            float s = 0.f;
#pragma unroll
            for (int j = 0; j < 4; ++j) s += (v[rr][j].x + v[rr][j].y) + (v[rr][j].z + v[rr][j].w);
            const float mean = wave_sum(s) * (1.f / D_MODEL); float q = 0.f;
#pragma unroll
            for (int j = 0; j < 4; ++j) { v[rr][j].x -= mean; v[rr][j].y -= mean; v[rr][j].z -= mean; v[rr][j].w -= mean; q += (v[rr][j].x * v[rr][j].x + v[rr][j].y * v[rr][j].y) + (v[rr][j].z * v[rr][j].z + v[rr][j].w * v[rr][j].w); }
            const float rstd = rsqrtf(wave_sum(q) * (1.f / D_MODEL) + LN_EPS);
            if (lane == 0) *(float2*)(p.ln1_stats + (size_t)(m0 + rr) * 2) = make_float2(mean, rstd);
#pragma unroll
            for (int j = 0; j < 4; ++j) {
                u32x2 ob; ob.x = pk_bf16(v[rr][j].x * rstd * g[j].x + bb[j].x, v[rr][j].y * rstd * g[j].y + bb[j].y); ob.y = pk_bf16(v[rr][j].z * rstd * g[j].z + bb[j].z, v[rr][j].w * rstd * g[j].w + bb[j].w);
                *(u32x2*)(x1b + (size_t)(m0 + rr) * D_MODEL + j * 256 + lane * 4) = ob;
            }
        }
    }
}

__device__ __forceinline__ void cas_d(float& a, float& b) { const float hi = fmaxf(a, b), lo = fminf(a, b); a = hi; b = lo; }
__device__ __forceinline__ void cas_a(float& a, float& b) { const float hi = fmaxf(a, b), lo = fminf(a, b); a = lo; b = hi; }
__device__ __forceinline__ void sort16_desc(f32x16& v) {
#pragma unroll
    for (int k = 2; k <= 16; k <<= 1)
#pragma unroll
        for (int j = k >> 1; j > 0; j >>= 1)
#pragma unroll
            for (int i = 0; i < 16; ++i) {
                const int l = i ^ j;
                if (l > i) { float a = v[i], b = v[l]; if ((i & k) == 0) cas_d(a, b); else cas_a(a, b); v[i] = a; v[l] = b; }
            }
}
__device__ __forceinline__ void bmerge16_desc(f32x16& v) {
#pragma unroll
    for (int j = 8; j > 0; j >>= 1)
#pragma unroll
        for (int i = 0; i < 16; ++i) { const int l = i ^ j; if (l > i) { float a = v[i], b = v[l]; cas_d(a, b); v[i] = a; v[l] = b; } }
}
__device__ __forceinline__ f32x16 merge_top16(const f32x16& a, const f32x16& b) {
    f32x16 c;
#pragma unroll
    for (int i = 0; i < 16; ++i) c[i] = fmaxf(a[i], b[15 - i]);
    bmerge16_desc(c);
    return c;
}
__device__ __forceinline__ void pcas_d(float& va, int& ia, float& vb, int& ib) {
    const bool sw = vb > va; const float tv = sw ? vb : va; const int ti = sw ? ib : ia;
    vb = sw ? va : vb; ib = sw ? ia : ib; va = tv; ia = ti;
}
__device__ __forceinline__ void psort16_desc(float (&v)[16], int (&id)[16]) {
#pragma unroll
    for (int k = 2; k <= 16; k <<= 1)
#pragma unroll
        for (int j = k >> 1; j > 0; j >>= 1)
#pragma unroll
            for (int i = 0; i < 16; ++i) {
                const int l = i ^ j;
                if (l > i) { if ((i & k) == 0) pcas_d(v[i], id[i], v[l], id[l]); else pcas_d(v[l], id[l], v[i], id[i]); }
            }
}
__device__ __forceinline__ void pmerge_top16(float (&a)[16], int (&ia)[16], const float (&b)[16], const int (&ib)[16]) {
#pragma unroll
    for (int i = 0; i < 16; ++i) { const bool sw = b[15 - i] > a[i]; a[i] = sw ? b[15 - i] : a[i]; ia[i] = sw ? ib[15 - i] : ia[i]; }
#pragma unroll
    for (int j = 8; j > 0; j >>= 1)
#pragma unroll
        for (int i = 0; i < 16; ++i) { const int l = i ^ j; if (l > i) pcas_d(a[i], ia[i], a[l], ia[l]); }
}
__device__ __forceinline__ void phase_route(const Params& p, const bf16_t* qb) {
    constexpr int CI[50] = {0,0,0,0,0,0,0,0,0,0,0,0,0,0,0,0,1,1,1,1,1,1,1,1,2,2,2,2,2,3,3,3,3,4,4,4,5,5,6,6,7,7,8,9,10,11,12,13,14,15};
    constexpr int CJ[50] = {0,1,2,3,4,5,6,7,8,9,10,11,12,13,14,15,0,1,2,3,4,5,6,7,0,1,2,3,4,0,1,2,3,0,1,2,0,1,0,1,0,1,0,0,0,0,0,0,0,0};
    const int lane0 = threadIdx.x & 63, gw = blockIdx.x * (NTHREADS / 64) + (threadIdx.x >> 6), GW = gridDim.x * (NTHREADS / 64);
    for (int task = gw; task < (M_TOK / 32) * 8; task += GW) {
        int lane = lane0; asm volatile("" : "+v"(lane));
        const int r = lane & 31, hh = lane >> 5;
        const int h = task & 7, tok0 = (task >> 3) * 32;
        f32x16 top[2];
#pragma unroll
        for (int pp = 0; pp < 2; ++pp) {
            const bf16_t* qrow = qb + (size_t)(tok0 + r) * 2048 + h * 256 + pp * 128 + 8 * hh;
            bf16x8 qf[8];
#pragma unroll
            for (int ks = 0; ks < 8; ++ks) qf[ks] = *(const bf16x8*)(qrow + 16 * ks);
            f32x16 sc[4];
#pragma unroll
            for (int kt = 0; kt < 4; ++kt) {
                const bf16_t* af = p.sk_frag + ((size_t)(((h * 2 + pp) * 4 + kt) * 8) * 64 + lane) * 8;
                bf16x8 a[8];
#pragma unroll
                for (int ks = 0; ks < 8; ++ks) a[ks] = *(const bf16x8*)(af + (size_t)ks * 512);
#pragma unroll
                for (int e = 0; e < 16; ++e) sc[kt][e] = 0.f;
#pragma unroll
                for (int ks = 0; ks < 8; ++ks) sc[kt] = __builtin_amdgcn_mfma_f32_32x32x16_bf16(a[ks], qf[ks], sc[kt], 0, 0, 0);
            }
#pragma unroll
            for (int kt = 0; kt < 4; ++kt) {
#pragma unroll
                for (int e = 0; e < 16; ++e) {
                    const unsigned key = (unsigned)(32 * kt + (e & 3) + 8 * (e >> 2)) + 4u * (unsigned)hh;
                    sc[kt][e] = __uint_as_float((__float_as_uint(sc[kt][e]) & 0xffffff80u) | key);
                }
                sort16_desc(sc[kt]);
            }
            f32x16 m = merge_top16(merge_top16(sc[0], sc[1]), merge_top16(sc[2], sc[3]));
            f32x16 oth;
#pragma unroll
            for (int i = 0; i < 16; ++i) oth[i] = __shfl_xor(m[i], 32);
            top[pp] = merge_top16(m, oth);
        }
        int ia[16], ib[16];
#pragma unroll
        for (int i = 0; i < 16; ++i) { ia[i] = (int)(__float_as_uint(top[0][i]) & 127u); ib[i] = (int)(__float_as_uint(top[1][i]) & 127u); }
        float cv0[16], cv1[16]; int cd0[16], cd1[16];
#pragma unroll
        for (int c = 0; c < 32; ++c) {
            float v = -INFINITY; int id = 0;
            if (c < 25) {
                const float v0 = top[0][CI[2 * c]] + top[1][CJ[2 * c]], v1 = top[0][CI[2 * c + 1]] + top[1][CJ[2 * c + 1]];
                const int d0 = (ia[CI[2 * c]] << 7) | ib[CJ[2 * c]], d1 = (ia[CI[2 * c + 1]] << 7) | ib[CJ[2 * c + 1]];
                v = hh ? v1 : v0; id = hh ? d1 : d0;
            }
            if (c < 16) { cv0[c] = v; cd0[c] = id; } else { cv1[c - 16] = v; cd1[c - 16] = id; }
        }
        psort16_desc(cv0, cd0); psort16_desc(cv1, cd1);
        pmerge_top16(cv0, cd0, cv1, cd1);
        float ov[16]; int od[16];
#pragma unroll
        for (int i = 0; i < 16; ++i) { ov[i] = __shfl_xor(cv0[i], 32); od[i] = __shfl_xor(cd0[i], 32); }
        pmerge_top16(cv0, cd0, ov, od);
        float ex[16], den = 0.f;
#pragma unroll
        for (int i = 0; i < 16; ++i) { ex[i] = __expf(cv0[i] - cv0[0]); den += ex[i]; }
        const float inv = 1.f / den;
        if (hh == 0) {
            int* idp = p.ids + (size_t)(tok0 + r) * 128 + h * 16; float* gp = p.gates + (size_t)(tok0 + r) * 128 + h * 16;
#pragma unroll
            for (int q = 0; q < 4; ++q) {
                *(int4*)(idp + 4 * q) = make_int4(cd0[4 * q], cd0[4 * q + 1], cd0[4 * q + 2], cd0[4 * q + 3]);
                *(float4*)(gp + 4 * q) = make_float4(ex[4 * q] * inv, ex[4 * q + 1] * inv, ex[4 * q + 2] * inv, ex[4 * q + 3] * inv);
            }
        }
    }
}


typedef float f32x2 __attribute__((ext_vector_type(2)));
__device__ __forceinline__ void phase_tables8(const Params& p, int first_block) {
    const int lane = threadIdx.x & 63, gw = (blockIdx.x - first_block) * (NTHREADS / 64) + (threadIdx.x >> 6), GW = (gridDim.x - first_block) * (NTHREADS / 64);
    for (int row0 = gw * 4; row0 < 2 * 16384; row0 += GW * 4) {
        float v[4][16];
#pragma unroll
        for (int rr = 0; rr < 4; ++rr) {
            const int row = row0 + rr, table = row >> 14, e = row & 16383;
            const float* src = (table ? p.peer_v : p.peer_u) + (size_t)e * 1024 + lane * 16;
#pragma unroll
            for (int q = 0; q < 4; ++q) { const float4 a = *(const float4*)(src + 4 * q); v[rr][4 * q] = a.x; v[rr][4 * q + 1] = a.y; v[rr][4 * q + 2] = a.z; v[rr][4 * q + 3] = a.w; }
        }
#pragma unroll
        for (int rr = 0; rr < 4; ++rr) {
            const int row = row0 + rr, table = row >> 14, e = row & 16383;
            float am = 0.f;
#pragma unroll
            for (int c = 0; c < 16; ++c) am = fmaxf(am, fabsf(v[rr][c]));
            am = wave_max(am);
            float sc = am > 0.f ? exp2f(floorf(log2f(448.f / am))) : 1.f;
            if (am * sc > 448.f) sc *= 0.5f;
            u32x4 o; int w;
            w = 0; w = __builtin_amdgcn_cvt_pk_fp8_f32(v[rr][0] * sc, v[rr][1] * sc, w, false); w = __builtin_amdgcn_cvt_pk_fp8_f32(v[rr][2] * sc, v[rr][3] * sc, w, true); o.x = (unsigned)w;
            w = 0; w = __builtin_amdgcn_cvt_pk_fp8_f32(v[rr][4] * sc, v[rr][5] * sc, w, false); w = __builtin_amdgcn_cvt_pk_fp8_f32(v[rr][6] * sc, v[rr][7] * sc, w, true); o.y = (unsigned)w;
            w = 0; w = __builtin_amdgcn_cvt_pk_fp8_f32(v[rr][8] * sc, v[rr][9] * sc, w, false); w = __builtin_amdgcn_cvt_pk_fp8_f32(v[rr][10] * sc, v[rr][11] * sc, w, true); o.z = (unsigned)w;
            w = 0; w = __builtin_amdgcn_cvt_pk_fp8_f32(v[rr][12] * sc, v[rr][13] * sc, w, false); w = __builtin_amdgcn_cvt_pk_fp8_f32(v[rr][14] * sc, v[rr][15] * sc, w, true); o.w = (unsigned)w;
            *(u32x4*)(p.tab8 + ((size_t)((table * 8 + (lane >> 3)) * 16384 + e)) * 128 + (lane & 7) * 16) = o;
            if (lane == 0) p.isc[row] = 1.f / sc;
        }
    }
}
typedef int i32x16 __attribute__((ext_vector_type(16)));
struct PeerBuf { u32x4 rows[16]; u32x4 xa, xb; f32x16 w; };
__device__ __forceinline__ float dpp_xor1(float v) { return __uint_as_float(__builtin_amdgcn_update_dpp(0u, __float_as_uint(v), 0xB1, 0xF, 0xF, true)); }
__device__ __forceinline__ float dpp_xor2(float v) { return __uint_as_float(__builtin_amdgcn_update_dpp(0u, __float_as_uint(v), 0x4E, 0xF, 0xF, true)); }
__device__ __forceinline__ float dpp_xor8(float v) { return __uint_as_float(__builtin_amdgcn_update_dpp(0u, __float_as_uint(v), 0x128, 0xF, 0xF, true)); }
__device__ __forceinline__ float swz_xor4(float v) { return __uint_as_float(__builtin_amdgcn_ds_swizzle(__float_as_uint(v), 0x101F)); }
__device__ __forceinline__ float swz_xor16(float v) { return __uint_as_float(__builtin_amdgcn_ds_swizzle(__float_as_uint(v), 0x401F)); }
__device__ __forceinline__ void peer_gather(PeerBuf& B, const unsigned char* tab, const i32x16& id, int j) {
#pragma unroll
    for (int i = 0; i < 16; ++i) B.rows[i] = *(const u32x4*)(tab + (size_t)id[i] * 128 + j * 16);
}
__device__ __forceinline__ void phase_peer_u(const Params& p, const bf16_t* x1b, float* ph) {
    const int lane0 = threadIdx.x & 63, wave = threadIdx.x >> 6;
    const int x = blockIdx.x & 7, nloc = (gridDim.x - x + 7) >> 3, wl = (blockIdx.x >> 3) * (NTHREADS / 64) + wave, NW = nloc * (NTHREADS / 64);
    const unsigned char* tab = p.tab8 + (size_t)x * 16384 * 128;
    int lane = lane0; asm volatile("" : "+v"(lane));
    const int j = lane & 7, g = lane >> 3;
    const bool b0 = j & 1, b1 = j & 2, b2 = j & 4;
    auto tok = [&](int t) { return t < M_TOK ? t : M_TOK - 1; };
    auto load_ids = [&](i32x16& id, int t) {
#pragma unroll
        for (int q = 0; q < 4; ++q) { const int4 v = *(const int4*)(p.ids + (size_t)t * 128 + 16 * g + 4 * q); id[4 * q] = v.x; id[4 * q + 1] = v.y; id[4 * q + 2] = v.z; id[4 * q + 3] = v.w; }
    };
    auto issue = [&](PeerBuf& B, int t, const i32x16& id) {
        const bf16_t* xs = x1b + (size_t)t * 1024 + 128 * x + 16 * j;
        B.xa = *(const u32x4*)xs; B.xb = *(const u32x4*)(xs + 8);
        peer_gather(B, tab, id, j);
    };
    auto compute = [&](const PeerBuf& B, int t) {
        const f32x2 xf[8] = {{bflo(B.xa.x), bfhi(B.xa.x)}, {bflo(B.xa.y), bfhi(B.xa.y)}, {bflo(B.xa.z), bfhi(B.xa.z)}, {bflo(B.xa.w), bfhi(B.xa.w)},
                             {bflo(B.xb.x), bfhi(B.xb.x)}, {bflo(B.xb.y), bfhi(B.xb.y)}, {bflo(B.xb.z), bfhi(B.xb.z)}, {bflo(B.xb.w), bfhi(B.xb.w)}};
        float res[16];
#pragma unroll
        for (int i = 0; i < 16; ++i) {
            const unsigned dw[4] = {B.rows[i].x, B.rows[i].y, B.rows[i].z, B.rows[i].w};
            f32x2 d2 = {0.f, 0.f};
#pragma unroll
            for (int q = 0; q < 4; ++q) {
                const f32x2 lo = __builtin_amdgcn_cvt_pk_f32_fp8((int)dw[q], false), hi = __builtin_amdgcn_cvt_pk_f32_fp8((int)dw[q], true);
                d2 = lo * xf[2 * q] + d2; d2 = hi * xf[2 * q + 1] + d2;
            }
            res[i] = d2.x + d2.y;
        }
        float r8[8], r4[4], r2[2];
#pragma unroll
        for (int m = 0; m < 8; ++m) { const float keep = b0 ? res[8 + m] : res[m], send = b0 ? res[m] : res[8 + m]; r8[m] = keep + dpp_xor1(send); }
#pragma unroll
        for (int m = 0; m < 4; ++m) { const float keep = b1 ? r8[4 + m] : r8[m], send = b1 ? r8[m] : r8[4 + m]; r4[m] = keep + dpp_xor2(send); }
#pragma unroll
        for (int m = 0; m < 2; ++m) { const float keep = b2 ? r4[2 + m] : r4[m], send = b2 ? r4[m] : r4[2 + m]; r2[m] = keep + swz_xor4(send); }
        const int i0 = 8 * (int)b0 + 4 * (int)b1 + 2 * (int)b2;
        *(float2*)(ph + ((size_t)x * M_TOK + t) * 128 + 16 * g + i0) = make_float2(r2[0], r2[1]);
    };
    PeerBuf A, Bb;
    int t = wl;
    if (t >= M_TOK) return;
    i32x16 idn;
    load_ids(idn, t);
    issue(A, t, idn);
    load_ids(idn, tok(t + NW));
    for (; t < M_TOK; t += 2 * NW) {
        issue(Bb, tok(t + NW), idn);
        load_ids(idn, tok(t + 2 * NW));
        compute(A, t);
        issue(A, tok(t + 2 * NW), idn);
        load_ids(idn, tok(t + 3 * NW));
        if (t + NW < M_TOK) compute(Bb, t + NW);
    }
}
__device__ __forceinline__ void phase_peer_w(const Params& p, const float* ph, float* wbuf) {
    const size_t gt = (size_t)blockIdx.x * NTHREADS + threadIdx.x, GT = (size_t)gridDim.x * NTHREADS;
    for (size_t i0 = gt; i0 < (size_t)M_TOK * 128; i0 += GT * 4) {
        int e[4]; float h[4], gg[4];
#pragma unroll
        for (int u = 0; u < 4; ++u) {
            const size_t idx = i0 + u * GT;
            e[u] = p.ids[idx]; gg[u] = p.gates[idx]; h[u] = 0.f;
#pragma unroll
            for (int x = 0; x < 8; ++x) h[u] += ph[(size_t)x * M_TOK * 128 + idx];
        }
#pragma unroll
        for (int u = 0; u < 4; ++u) {
            const float hv = h[u] * p.isc[e[u]];
            wbuf[i0 + u * GT] = 0.5f * hv * (1.f + erff(hv * 0.7071067811865476f)) * gg[u] * p.isc[16384 + e[u]];
        }
    }
}
__device__ __forceinline__ void phase_peer_v(const Params& p, const float* wbuf, bf16_t* ffn) {
    const int lane0 = threadIdx.x & 63, wave = threadIdx.x >> 6;
    const int x = blockIdx.x & 7, nloc = (gridDim.x - x + 7) >> 3, wl = (blockIdx.x >> 3) * (NTHREADS / 64) + wave, NW = nloc * (NTHREADS / 64);
    const unsigned char* tab = p.tab8 + (size_t)(8 + x) * 16384 * 128;
    int lane = lane0; asm volatile("" : "+v"(lane));
    const int j = lane & 7, g = lane >> 3;
    const bool b3 = g & 1, b4 = g & 2, b5 = g & 4;
    auto tok = [&](int t) { return t < M_TOK ? t : M_TOK - 1; };
    auto load_ids = [&](i32x16& id, int t) {
#pragma unroll
        for (int q = 0; q < 4; ++q) { const int4 v = *(const int4*)(p.ids + (size_t)t * 128 + 16 * g + 4 * q); id[4 * q] = v.x; id[4 * q + 1] = v.y; id[4 * q + 2] = v.z; id[4 * q + 3] = v.w; }
    };
    auto issue = [&](PeerBuf& B, int t, const i32x16& id) {
#pragma unroll
        for (int q = 0; q < 4; ++q) { const float4 v = *(const float4*)(wbuf + (size_t)t * 128 + 16 * g + 4 * q); B.w[4 * q] = v.x; B.w[4 * q + 1] = v.y; B.w[4 * q + 2] = v.z; B.w[4 * q + 3] = v.w; }
        peer_gather(B, tab, id, j);
    };
    auto compute = [&](const PeerBuf& B, int t) {
        f32x2 acc[8];
#pragma unroll
        for (int c = 0; c < 8; ++c) acc[c] = (f32x2){0.f, 0.f};
#pragma unroll
        for (int i = 0; i < 16; ++i) {
            const f32x2 w2 = {B.w[i], B.w[i]};
            const unsigned dw[4] = {B.rows[i].x, B.rows[i].y, B.rows[i].z, B.rows[i].w};
#pragma unroll
            for (int q = 0; q < 4; ++q) {
                const f32x2 lo = __builtin_amdgcn_cvt_pk_f32_fp8((int)dw[q], false), hi = __builtin_amdgcn_cvt_pk_f32_fp8((int)dw[q], true);
                acc[2 * q] = lo * w2 + acc[2 * q]; acc[2 * q + 1] = hi * w2 + acc[2 * q + 1];
            }
        }
        f32x2 a4[4], a2[2], a1;
#pragma unroll
        for (int m = 0; m < 4; ++m) { const f32x2 keep = b3 ? acc[4 + m] : acc[m], send = b3 ? acc[m] : acc[4 + m]; a4[m] = (f32x2){keep.x + dpp_xor8(send.x), keep.y + dpp_xor8(send.y)}; }
#pragma unroll
        for (int m = 0; m < 2; ++m) { const f32x2 keep = b4 ? a4[2 + m] : a4[m], send = b4 ? a4[m] : a4[2 + m]; a2[m] = (f32x2){keep.x + swz_xor16(send.x), keep.y + swz_xor16(send.y)}; }
        { const f32x2 keep = b5 ? a2[1] : a2[0], send = b5 ? a2[0] : a2[1]; a1 = (f32x2){keep.x + __shfl_xor(send.x, 32), keep.y + __shfl_xor(send.y, 32)}; }
        const int c0 = 8 * (int)b3 + 4 * (int)b4 + 2 * (int)b5;
        *(unsigned*)(ffn + (size_t)t * 1024 + 128 * x + 16 * j + c0) = pk_bf16(a1.x, a1.y);
    };
    PeerBuf A, Bb;
    int t = wl;
    if (t >= M_TOK) return;
    i32x16 idn;
    load_ids(idn, t);
    issue(A, t, idn);
    load_ids(idn, tok(t + NW));
    for (; t < M_TOK; t += 2 * NW) {
        issue(Bb, tok(t + NW), idn);
        load_ids(idn, tok(t + 2 * NW));
        compute(A, t);
        issue(A, tok(t + 2 * NW), idn);
        load_ids(idn, tok(t + 3 * NW));
        if (t + NW < M_TOK) compute(Bb, t + NW);
    }
}
__device__ __forceinline__ void phase_ln2(const Params& p, const bf16_t* ffn) {
    const int lane = threadIdx.x & 63, gw = blockIdx.x * (NTHREADS / 64) + (threadIdx.x >> 6), GW = gridDim.x * (NTHREADS / 64);
    for (int m0 = gw * 2; m0 < M_TOK; m0 += GW * 2) {
        float4 a[2][4]; u32x2 f[2][4]; float2 st[2];
#pragma unroll
        for (int rr = 0; rr < 2; ++rr) {
            st[rr] = *(const float2*)(p.ln1_stats + (size_t)(m0 + rr) * 2);
#pragma unroll
            for (int j = 0; j < 4; ++j) { a[rr][j] = *(const float4*)(p.out + (size_t)(m0 + rr) * D_MODEL + j * 256 + lane * 4); f[rr][j] = *(const u32x2*)(ffn + (size_t)(m0 + rr) * D_MODEL + j * 256 + lane * 4); }
        }
#pragma unroll
        for (int rr = 0; rr < 2; ++rr) {
            float* row = p.out + (size_t)(m0 + rr) * D_MODEL;
            float4 v[4]; float s = 0.f;
#pragma unroll
            for (int j = 0; j < 4; ++j) {
                const float4 g1 = *(const float4*)(p.ln1_g + j * 256 + lane * 4), b1 = *(const float4*)(p.ln1_b + j * 256 + lane * 4);
                v[j] = make_float4(ALPHA * ((a[rr][j].x - st[rr].x) * st[rr].y * g1.x + b1.x) + bflo(f[rr][j].x), ALPHA * ((a[rr][j].y - st[rr].x) * st[rr].y * g1.y + b1.y) + bfhi(f[rr][j].x),
                                   ALPHA * ((a[rr][j].z - st[rr].x) * st[rr].y * g1.z + b1.z) + bflo(f[rr][j].y), ALPHA * ((a[rr][j].w - st[rr].x) * st[rr].y * g1.w + b1.w) + bfhi(f[rr][j].y));
                s += (v[j].x + v[j].y) + (v[j].z + v[j].w);
            }
            const float mean = wave_sum(s) * (1.f / D_MODEL); float q = 0.f;
#pragma unroll
            for (int j = 0; j < 4; ++j) { v[j].x -= mean; v[j].y -= mean; v[j].z -= mean; v[j].w -= mean; q += (v[j].x * v[j].x + v[j].y * v[j].y) + (v[j].z * v[j].z + v[j].w * v[j].w); }
            const float rstd = rsqrtf(wave_sum(q) * (1.f / D_MODEL) + LN_EPS);
#pragma unroll
            for (int j = 0; j < 4; ++j) {
                const float4 g = *(const float4*)(p.ln2_g + j * 256 + lane * 4), bb = *(const float4*)(p.ln2_b + j * 256 + lane * 4);
                *(float4*)(row + j * 256 + lane * 4) = make_float4(v[j].x * rstd * g.x + bb.x, v[j].y * rstd * g.y + bb.y, v[j].z * rstd * g.z + bb.z, v[j].w * rstd * g.w + bb.w);
            }
        }
    }
}

constexpr int N_PHASES = 14;
__global__ void __launch_bounds__(NTHREADS) mega_fwd(Params p) {
    __shared__ __attribute__((aligned(1024))) unsigned char smem[SMEM_BYTES + 16];
    if (threadIdx.x == 0) *(uint4*)(smem + SMEM_BYTES) = make_uint4(0u, 0u, 0u, 0u);
    __syncthreads();
    XcdBarrier bar; bar.bar = p.bar; bar.x = 0; bar.st = (volatile LAS unsigned*)(smem + SMEM_BYTES);
    if (p.ph_hi - p.ph_lo > 1) bar = xcd_barrier_post(p.bar, (volatile LAS unsigned*)(smem + SMEM_BYTES));
    bf16_t* qb = p.proj_b;
    bf16_t* x1b = p.proj_b + (size_t)M_TOK * 2048;
#ifndef DUP_PHASE
#define DUP_PHASE -1
#endif
#define PH(k) (p.ph_lo <= (k) && (k) < p.ph_hi)
#define SYNC(k) do { if (PH(k) && PH((k) + 1)) xcd_barrier(bar); } while (0)
#define RUN(k, ...) do { if (PH(k)) { __VA_ARGS__; if (DUP_PHASE == (k)) { xcd_barrier(bar); __VA_ARGS__; } } SYNC(k); } while (0)
    float* ph = (float*)qb;
    RUN(0, phase_prep(p, smem));
    RUN(1, { EpiInProj e{p.proj_b, p.rope_cs}; gemm_phase(p.xb, p.wt_in, M_TOK, NP_IN, e, smem); });
    RUN(2, phase_dn_prep(p, smem));
    RUN(3, { if (blockIdx.x < 96) { const int j = blockIdx.x, rem = j % 6; dn_scan_seg<1>(p, smem, j / 6, rem >> 1, rem & 1); } else { phase_attn(p, smem, 96); } });
    RUN(4, { if (blockIdx.x < 64) dn_scan_seg<0>(p, smem, blockIdx.x >> 2, blockIdx.x & 3, 0); else { phase_scan_l2_helper(p); phase_tables8(p, 64); } });
    RUN(5, phase_dn_norm(p));
    RUN(6, { EpiOutProj e{p.out, p.x}; gemm_phase(p.xb, p.wt_out, M_TOK, 1024, e, smem); });
    RUN(7, phase_ln1(p, x1b));
    RUN(8, { EpiBf16 e{qb, 2048}; gemm_phase(x1b, p.wt_q, M_TOK, 2048, e, smem); });
    RUN(9, phase_route(p, qb));
    RUN(10, phase_peer_u(p, x1b, ph));
    RUN(11, phase_peer_w(p, ph, p.wbuf));
    RUN(12, phase_peer_v(p, p.wbuf, (bf16_t*)ph));
    RUN(13, phase_ln2(p, (const bf16_t*)ph));
#undef RUN
#undef SYNC
#undef PH
}
}

#ifndef MK_LAUNCHES
#define MK_LAUNCHES 1
#endif

extern "C" void kernel_launch(void* const* d_in, const int* in_sizes, int n_in, void* d_out, int out_size, void* d_ws, size_t ws_size, hipStream_t stream) {
    static int grid_blocks = 0;
    if (!grid_blocks) {
        int dev = 0, cus = 0, per_cu = 0;
        (void)hipGetDevice(&dev);
        (void)hipDeviceGetAttribute(&cus, hipDeviceAttributeMultiprocessorCount, dev);
        (void)hipOccupancyMaxActiveBlocksPerMultiprocessor(&per_cu, mega_fwd, NTHREADS, 0);
        if (per_cu < 1) { fprintf(stderr, "kernel_launch: occupancy query reports %d blocks per CU\n", per_cu); per_cu = 1; }
        grid_blocks = cus * 1;
        (void)hipGetLastError();
    }
    Params p{};
    p.x = (const float*)d_in[0]; p.positions = (const int*)d_in[1]; p.w_in = (const float*)d_in[2]; p.sinks = (const float*)d_in[3];
    p.conv_w = (const float*)d_in[4]; p.a_log = (const float*)d_in[5]; p.dt_bias = (const float*)d_in[6]; p.dn_norm_g = (const float*)d_in[7];
    p.w_out = (const float*)d_in[8]; p.ln1_g = (const float*)d_in[9]; p.ln1_b = (const float*)d_in[10]; p.w_query = (const float*)d_in[11];
    p.sub_keys = (const float*)d_in[12]; p.peer_u = (const float*)d_in[13]; p.peer_v = (const float*)d_in[14]; p.ln2_g = (const float*)d_in[15]; p.ln2_b = (const float*)d_in[16];
    p.out = (float*)d_out;
    char* ws = (char*)d_ws; size_t off = 0;
    auto take = [&](size_t bytes) { char* r = ws + off; off += (bytes + 255) & ~(size_t)255; return r; };
    p.xb = (bf16_t*)take((size_t)M_TOK * 1024 * 2);
    p.proj_b = (bf16_t*)take((size_t)M_TOK * NP_IN * 2);
    p.odn_raw = (bf16_t*)d_out;
    {
        char* dn = take((size_t)2048 * (16384 * 3 + 8192 + 32768) + 8192);
        p.ids = (int*)dn; p.gates = (float*)(dn + (size_t)M_TOK * 128 * 4);
        p.wbuf = (float*)(dn + (size_t)M_TOK * 128 * 8);
        p.dn_negw = (bf16_t*)dn; p.dn_qd = (bf16_t*)(dn + (size_t)2048 * 16384); p.dn_kdt = (bf16_t*)(dn + (size_t)2048 * 16384 * 2);
        p.dn_qk = (bf16_t*)(dn + (size_t)2048 * 16384 * 3); p.dn_u = (bf16_t*)(dn + (size_t)2048 * (16384 * 3 + 8192)); p.dn_gl = (float*)(dn + (size_t)2048 * (16384 * 3 + 8192 + 32768));
    }
    p.wt_in = (bf16_t*)take((size_t)NP_IN * 1024 * 2);
    p.wt_out = (bf16_t*)take((size_t)1024 * 1024 * 2);
    p.wt_q = (bf16_t*)take((size_t)2048 * 1024 * 2);
    p.rope_cs = (float*)take((size_t)M_TOK * 64 * 4);
    p.sk_frag = (bf16_t*)take((size_t)16 * 128 * 128 * 2);
    p.tab8 = (unsigned char*)take((size_t)2 * 16384 * 1024);
    p.isc = (float*)take((size_t)2 * 16384 * 4);
    p.ln1_stats = (float*)take((size_t)M_TOK * 2 * 4);
    p.dn_PB = (float*)take((size_t)48 * 128 * 256 * 4);
    p.dn_S0 = (float*)take((size_t)64 * 128 * 128 * 4);
    p.bar = (unsigned*)take((size_t)(XCD_BAR_WORDS + 16 * 64) * 4);
    if (off > ws_size) { fprintf(stderr, "kernel_launch: workspace too small (%zu < %zu)\n", ws_size, off); return; }
    if (hipMemsetAsync(p.bar, 0, (size_t)(XCD_BAR_WORDS + 16 * 64) * 4, stream) != hipSuccess) { fprintf(stderr, "kernel_launch: memset of barrier words failed\n"); return; }
#if MK_LAUNCHES == 1
    p.ph_lo = 0; p.ph_hi = N_PHASES;
    void* args[] = {&p};
    hipError_t e = hipLaunchCooperativeKernel((void*)mega_fwd, dim3(grid_blocks), dim3(NTHREADS), args, 0, stream);
    if (e != hipSuccess) fprintf(stderr, "cooperative launch failed: %s (grid %d)\n", hipGetErrorString(e), grid_blocks);
#else
    for (int k = 0; k < N_PHASES; ++k) { p.ph_lo = k; p.ph_hi = k + 1; hipLaunchKernelGGL(mega_fwd, dim3(grid_blocks), dim3(NTHREADS), 0, stream, p); }
#endif
}
```

```cpp
#include <hip/hip_runtime.h>
#include <cstdio>
#include <cstdint>
#include <math.h>

namespace {
constexpr int D_MODEL = 1024, BATCH = 4, SEQ = 8192, M_TOK = BATCH * SEQ;
constexpr int IN_WIDTH = 2824, NP_IN = 3072;
constexpr int P_AQ = 0, P_AK = 512, P_AV = 640, P_DQ = 768, P_DK = 1280, P_DV = 1792, P_Z = 2304, P_B = 2816, P_A = 2820;
constexpr float ALPHA = 1.189207115002721f;
constexpr float LN_EPS = 1e-5f, RMS_EPS = 1e-6f, L2_EPS = 1e-6f;
constexpr int NTHREADS = 512;

typedef unsigned short bf16_t;
typedef short bf16x8 __attribute__((ext_vector_type(8)));
typedef float f32x16 __attribute__((ext_vector_type(16)));
typedef float f32x4 __attribute__((ext_vector_type(4)));
typedef unsigned u32x4 __attribute__((ext_vector_type(4)));
typedef unsigned u32x2 __attribute__((ext_vector_type(2)));

struct Params {
    const float* x; const int* positions; const float* w_in; const float* sinks; const float* conv_w; const float* a_log; const float* dt_bias;
    const float* dn_norm_g; const float* w_out; const float* ln1_g; const float* ln1_b; const float* w_query; const float* sub_keys;
    const float* peer_u; const float* peer_v; const float* ln2_g; const float* ln2_b;
    float* out;
    bf16_t* xb;
    bf16_t* proj_b;
    bf16_t* odn_raw;
    int* ids; float* gates;
    bf16_t* wt_in; bf16_t* wt_out; bf16_t* wt_q;
    float* rope_cs;
    bf16_t* dn_negw; bf16_t* dn_qd; bf16_t* dn_kdt; bf16_t* dn_qk; bf16_t* dn_u; float* dn_gl; float* dn_PB; float* dn_S0;
    bf16_t* sk_frag;
    float* ln1_stats;
    unsigned char* tab8; float* isc; float* wbuf;
    unsigned* bar;
    int ph_lo, ph_hi;
};

__device__ __forceinline__ float wave_sum(float v) {
#pragma unroll
    for (int o = 1; o < 64; o <<= 1) v += __shfl_xor(v, o);
    return v;
}
__device__ __forceinline__ float wave_max(float v) {
#pragma unroll
    for (int o = 1; o < 64; o <<= 1) v = fmaxf(v, __shfl_xor(v, o));
    return v;
}
__device__ __forceinline__ float bf2f(bf16_t u) { return __uint_as_float((unsigned)u << 16); }
__device__ __forceinline__ float bflo(unsigned u) { return __uint_as_float(u << 16); }
__device__ __forceinline__ float bfhi(unsigned u) { return __uint_as_float(u & 0xffff0000u); }
typedef __bf16 bf16x2_n __attribute__((ext_vector_type(2)));
__device__ __forceinline__ unsigned pk_bf16(float lo, float hi) { bf16x2_n v; v.x = (__bf16)lo; v.y = (__bf16)hi; return __builtin_bit_cast(unsigned, v); }
__device__ __forceinline__ float silu_f(float y) { return y * __builtin_amdgcn_rcpf(1.f + __expf(-y)); }


#define XB_TMO      128
#define XB_XCNT(j)  (256  + 64 * (j))
#define XB_XSUB(j)  (1280 + 64 * (j))
#define XB_XGEN(j)  (2304 + 64 * (j))
#define XB_TOP      3328
#define XB_TOPGEN   3392
#define XCD_BAR_WORDS 3456
#define XB_SPIN_CAP (1u << 27)
#define LAS __attribute__((address_space(3)))
__device__ __forceinline__ unsigned xb_ld(unsigned* p)              { return __hip_atomic_load(p, __ATOMIC_RELAXED, __HIP_MEMORY_SCOPE_AGENT); }
__device__ __forceinline__ unsigned xb_add(unsigned* p, unsigned v) { return __hip_atomic_fetch_add(p, v, __ATOMIC_RELAXED, __HIP_MEMORY_SCOPE_AGENT); }
__device__ __forceinline__ unsigned xb_xcc_id() { return (unsigned)__builtin_amdgcn_s_getreg((3 << 11) | 20) & 0xFu; }
#define XB_SPIN(cond, bar) do { unsigned _sp = 0; while (cond) { __builtin_amdgcn_s_sleep(1); \
    if ((++_sp & 255u) == 0u) { if (xb_ld(&(bar)[XB_TMO])) break; if (_sp > XB_SPIN_CAP) { atomicAdd(&(bar)[XB_TMO], 1u); break; } } } } while (0)
struct XcdBarrier { unsigned* bar; unsigned x; volatile LAS unsigned* st; };
__device__ __forceinline__ XcdBarrier xcd_barrier_post(unsigned* bar, volatile LAS unsigned* st) {
    XcdBarrier b; b.bar = bar; b.x = xb_xcc_id(); b.st = st;
    if (threadIdx.x == 0) (void)xb_add(&bar[XB_XCNT(b.x)], 1u);
    return b;
}
__device__ __forceinline__ void xcd_barrier_complete(unsigned* bar, unsigned x, unsigned& nloc, unsigned& nx) {
    const unsigned G = gridDim.x * gridDim.y * gridDim.z;
    unsigned sum, cnt, mine, sp = 0u;
    for (;;) {
        sum = 0u; cnt = 0u; mine = 0u;
#pragma unroll
        for (unsigned j = 0; j < 16; ++j) { const unsigned c = xb_ld(&bar[XB_XCNT(j)]); sum += c; cnt += (c > 0u) ? 1u : 0u; mine = (j == x) ? c : mine; }
        if (sum == G) break;
        __builtin_amdgcn_s_sleep(1);
        if ((++sp & 255u) == 0u) { if (xb_ld(&bar[XB_TMO])) break; if (sp > XB_SPIN_CAP) { atomicAdd(&bar[XB_TMO], 1u); break; } }
    }
    nloc = mine > 0u ? mine : 1u; nx = cnt > 0u ? cnt : 1u;
}
__device__ __forceinline__ void xcd_barrier(const XcdBarrier& b) {
    asm volatile("s_waitcnt vmcnt(0)" ::: "memory");
    __syncthreads();
    if (threadIdx.x == 0) {
        unsigned* bar = b.bar;
        __builtin_amdgcn_s_waitcnt(0);
        unsigned nloc = b.st[0], nx = b.st[1];
        if (nloc == 0u) { xcd_barrier_complete(bar, b.x, nloc, nx); b.st[0] = nloc; b.st[1] = nx; }
        const unsigned old = xb_add(&bar[XB_XSUB(b.x)], 1u);
        const unsigned gen = old / nloc;
        if (old + 1u == (gen + 1u) * nloc) {
            __builtin_amdgcn_fence(__ATOMIC_RELEASE, "agent");
            asm volatile("s_waitcnt vmcnt(0)" ::: "memory");
            const unsigned og = xb_add(&bar[XB_TOP], 1u);
            const unsigned tg = og / nx;
            if (og + 1u == (tg + 1u) * nx) xb_add(&bar[XB_TOPGEN], 1u);
            else XB_SPIN(xb_ld(&bar[XB_TOPGEN]) == tg, bar);
            __builtin_amdgcn_fence(__ATOMIC_ACQUIRE, "agent");
            xb_add(&bar[XB_XGEN(b.x)], 1u);
            asm volatile("s_waitcnt vmcnt(0)" ::: "memory");
        } else {
            XB_SPIN(xb_ld(&bar[XB_XGEN(b.x)]) == gen, bar);
            __builtin_amdgcn_fence(__ATOMIC_ACQUIRE, "agent");
            asm volatile("s_waitcnt vmcnt(0)" ::: "memory");
        }
    }
    __syncthreads();
}

__device__ __forceinline__ int inproj_old_col(int n) {
    if (n < 2304) return n;
    if (n < 2816) return 2312 + (n - 2304);
    if (n < 2824) return 2304 + (n - 2816);
    return -1;
}
__device__ __forceinline__ void transpose_item(const float* __restrict__ W, int N_src, bf16_t* __restrict__ WT, int K, int kb, int nb, bool permute, float* scr) {
    const int tid = threadIdx.x;
    const int nn = tid & 63, k8 = tid >> 6;
    const int n = nb * 64 + nn;
    const int oc = permute ? inproj_old_col(n) : n;
#pragma unroll
    for (int i = 0; i < 8; ++i) { const int kk = k8 + 8 * i; scr[kk * 65 + nn] = (oc >= 0) ? W[(size_t)(kb * 64 + kk) * N_src + oc] : 0.f; }
    __syncthreads();
    const int n2 = tid >> 3, c = tid & 7;
    const float* s = scr + (c * 8) * 65 + n2;
    u32x4 o; o.x = pk_bf16(s[0], s[65]); o.y = pk_bf16(s[2 * 65], s[3 * 65]); o.z = pk_bf16(s[4 * 65], s[5 * 65]); o.w = pk_bf16(s[6 * 65], s[7 * 65]);
    *(u32x4*)(WT + (size_t)(nb * 64 + n2) * K + kb * 64 + c * 8) = o;
    __syncthreads();
}
__device__ __forceinline__ void phase_prep(const Params& p, unsigned char* smem) {
    const int tid = threadIdx.x, G = gridDim.x, bid = blockIdx.x;
    float* scr = (float*)smem;
    constexpr int I_IN = 16 * (NP_IN / 64), I_OUT = 16 * 16, I_Q = 16 * 32;
    for (int it = bid; it < I_IN + I_OUT + I_Q; it += G) {
        int r = it;
        if (r < I_IN) { transpose_item(p.w_in, IN_WIDTH, p.wt_in, 1024, r / (NP_IN / 64), r % (NP_IN / 64), true, scr); continue; } r -= I_IN;
        if (r < I_OUT) { transpose_item(p.w_out, 1024, p.wt_out, 1024, r / 16, r % 16, false, scr); continue; } r -= I_OUT;
        transpose_item(p.w_query, 2048, p.wt_q, 1024, r / 32, r % 32, false, scr);
    }
    const size_t gt = (size_t)bid * NTHREADS + tid, GT = (size_t)G * NTHREADS;
    for (size_t i0 = gt; i0 < (size_t)M_TOK * 1024 / 8; i0 += GT * 4) {
        float4 a[4], b[4];
#pragma unroll
        for (int u = 0; u < 4; ++u) { const size_t i = i0 + u * GT; if (i < (size_t)M_TOK * 1024 / 8) { a[u] = *(const float4*)(p.x + i * 8); b[u] = *(const float4*)(p.x + i * 8 + 4); } }
#pragma unroll
        for (int u = 0; u < 4; ++u) { const size_t i = i0 + u * GT; if (i < (size_t)M_TOK * 1024 / 8) {
            u32x4 o; o.x = pk_bf16(a[u].x, a[u].y); o.y = pk_bf16(a[u].z, a[u].w); o.z = pk_bf16(b[u].x, b[u].y); o.w = pk_bf16(b[u].z, b[u].w);
            *(u32x4*)(p.xb + i * 8) = o; } }
    }
    for (size_t i = gt; i < (size_t)16 * 4 * 8 * 64; i += GT) {
        const int ln = (int)(i & 63), ks = (int)((i >> 6) & 7), kt = (int)((i >> 9) & 3), hp = (int)(i >> 11);
        const float* src = p.sub_keys + ((size_t)(hp * 128 + 32 * kt + (ln & 31))) * 128 + 16 * ks + 8 * (ln >> 5);
        const float4 a = *(const float4*)src, b = *(const float4*)(src + 4);
        u32x4 o; o.x = pk_bf16(a.x, a.y); o.y = pk_bf16(a.z, a.w); o.z = pk_bf16(b.x, b.y); o.w = pk_bf16(b.z, b.w);
        *(u32x4*)(p.sk_frag + i * 8) = o;
    }
    for (size_t i = gt; i < (size_t)M_TOK * 32; i += GT) {
        const int m = (int)(i >> 5), j = (int)(i & 31);
        const float inv_freq = powf(10000.0f, -(float)j / 32.0f);
        const float ang = (float)p.positions[m] * inv_freq;
        p.rope_cs[i] = cosf(ang); p.rope_cs[(size_t)M_TOK * 32 + i] = sinf(ang);
    }
}

constexpr int GK = 1024, GBK = 64, G_TILE_BYTES = 256 * 128;
constexpr int STG_STRIDE = 260;
constexpr int SMEM_BYTES = 147456;

__device__ __forceinline__ int swz(int row, int chunk) { return row * 128 + ((chunk ^ ((row >> 1) & 7)) << 4); }

struct EpiInProj {
    bf16_t* out; const float* cs;
    __device__ __forceinline__ void operator()(int m, int pn, int c8, const unsigned char* stg_row) const {
        const int col = pn * 256 + c8 * 8;
        u32x2 a0 = *(const u32x2*)(stg_row + c8 * 16), a1 = *(const u32x2*)(stg_row + c8 * 16 + 8);
        u32x4 o; o.x = a0.x; o.y = a0.y; o.z = a1.x; o.w = a1.y;
        if (col < P_AV) {
            const int d0 = col & 63, i0 = d0 & 31; const bool second = d0 >= 32;
            const int pc8 = second ? c8 - 4 : c8 + 4;
            const u32x2 b0 = *(const u32x2*)(stg_row + pc8 * 16), b1 = *(const u32x2*)(stg_row + pc8 * 16 + 8);
            const unsigned mine[4] = {a0.x, a0.y, a1.x, a1.y}, oth[4] = {b0.x, b0.y, b1.x, b1.y};
            const float* cp = cs + (size_t)m * 32 + i0; const float* sp = cs + (size_t)M_TOK * 32 + (size_t)m * 32 + i0;
            const float4 c0 = *(const float4*)cp, c1 = *(const float4*)(cp + 4), s0 = *(const float4*)sp, s1 = *(const float4*)(sp + 4);
            const float cc[8] = {c0.x, c0.y, c0.z, c0.w, c1.x, c1.y, c1.z, c1.w}, ss[8] = {s0.x, s0.y, s0.z, s0.w, s1.x, s1.y, s1.z, s1.w};
            const float scale = col < P_AK ? 0.125f : 1.f;
            float r[8];
#pragma unroll
            for (int j = 0; j < 8; ++j) {
                const float me = (j & 1) ? bfhi(mine[j >> 1]) : bflo(mine[j >> 1]);
                const float ot = (j & 1) ? bfhi(oth[j >> 1]) : bflo(oth[j >> 1]);
                r[j] = (second ? (me * cc[j] + ot * ss[j]) : (me * cc[j] - ot * ss[j])) * scale;
            }
            o.x = pk_bf16(r[0], r[1]); o.y = pk_bf16(r[2], r[3]); o.z = pk_bf16(r[4], r[5]); o.w = pk_bf16(r[6], r[7]);
        }
        *(u32x4*)(out + (size_t)m * NP_IN + col) = o;
    }
};
struct EpiOutProj {
    float* y; const float* x;
    __device__ __forceinline__ void operator()(int m, int pn, int c8, const unsigned char* stg_row) const {
        const int col = pn * 256 + c8 * 8;
        const u32x2 a0 = *(const u32x2*)(stg_row + c8 * 16), a1 = *(const u32x2*)(stg_row + c8 * 16 + 8);
        const float4 x0 = *(const float4*)(x + (size_t)m * 1024 + col), x1 = *(const float4*)(x + (size_t)m * 1024 + col + 4);
        *(float4*)(y + (size_t)m * 1024 + col) = make_float4(ALPHA * x0.x + bflo(a0.x), ALPHA * x0.y + bfhi(a0.x), ALPHA * x0.z + bflo(a0.y), ALPHA * x0.w + bfhi(a0.y));
        *(float4*)(y + (size_t)m * 1024 + col + 4) = make_float4(ALPHA * x1.x + bflo(a1.x), ALPHA * x1.y + bfhi(a1.x), ALPHA * x1.z + bflo(a1.y), ALPHA * x1.w + bfhi(a1.y));
    }
};
struct EpiBf16 {
    bf16_t* out; int ldc;
    __device__ __forceinline__ void operator()(int m, int pn, int c8, const unsigned char* stg_row) const {
        const int col = pn * 256 + c8 * 8;
        const u32x2 a0 = *(const u32x2*)(stg_row + c8 * 16), a1 = *(const u32x2*)(stg_row + c8 * 16 + 8);
        u32x4 o; o.x = a0.x; o.y = a0.y; o.z = a1.x; o.w = a1.y;
        *(u32x4*)(out + (size_t)m * ldc + col) = o;
    }
};

template <class EPI>
__device__ __forceinline__ void gemm_phase(const bf16_t* __restrict__ A, const bf16_t* __restrict__ Bt, int M, int N, const EPI& epi, unsigned char* smem) {
    const int tid = threadIdx.x, lane = tid & 63, wave = tid >> 6, r = lane & 31, h = lane >> 5;
    const int wm = wave >> 2, wn = wave & 3;
    const int nM = M / 256, nN = N / 256, ntiles = nM * nN;
    const int gx = gridDim.x, nxg = (gx % 8 == 0 && ntiles % 8 == 0) ? 8 : 1, bpg = gx / nxg, tpg = ntiles / nxg;
    const int grp = blockIdx.x % nxg, bin = blockIdx.x / nxg;
    const int grow = 16 * wave + (lane >> 2), gch = (lane & 3) ^ ((grow >> 2) & 3);
    const unsigned goff = (unsigned)(grow * GK + gch * 8) * 2u;
    constexpr int NKT = GK / 32, STG = 32768;
#define G_STAGE(kt_, Ag_, Bg_) do { const unsigned char* ab_ = (const unsigned char*)(Ag_) + (kt_) * 64; const unsigned char* bb_ = (const unsigned char*)(Bg_) + (kt_) * 64; \
            unsigned char* la_ = smem + ((kt_) & 3) * STG + wave * 1024; \
            _Pragma("unroll") for (int i_ = 0; i_ < 2; ++i_) { \
                __builtin_amdgcn_global_load_lds((const unsigned*)(ab_ + i_ * (128 * GK * 2) + goff), (unsigned*)(la_ + i_ * 8192), 16, 0, 0); \
                __builtin_amdgcn_global_load_lds((const unsigned*)(bb_ + i_ * (128 * GK * 2) + goff), (unsigned*)(la_ + 16384 + i_ * 8192), 16, 0, 0); } } while (0)
#define G_SWZ32(row_, c_) ((row_) * 64 + ((((c_) ^ ((row_) >> 2)) & 3) << 4))
#define G_COMPUTE(kt_) do { const unsigned char* la_ = smem + ((kt_) & 3) * STG; const unsigned char* lb_ = la_ + 16384; \
            _Pragma("unroll") for (int ks_ = 0; ks_ < 2; ++ks_) { bf16x8 af_[4], bf_[2]; \
                _Pragma("unroll") for (int i_ = 0; i_ < 4; ++i_) af_[i_] = *(const bf16x8*)(la_ + G_SWZ32(wm * 128 + i_ * 32 + r, ks_ * 2 + h)); \
                _Pragma("unroll") for (int j_ = 0; j_ < 2; ++j_) bf_[j_] = *(const bf16x8*)(lb_ + G_SWZ32(wn * 64 + j_ * 32 + r, ks_ * 2 + h)); \
                _Pragma("unroll") for (int j_ = 0; j_ < 2; ++j_) _Pragma("unroll") for (int i_ = 0; i_ < 4; ++i_) acc[j_][i_] = __builtin_amdgcn_mfma_f32_32x32x16_bf16(bf_[j_], af_[i_], acc[j_][i_], 0, 0, 0); } } while (0)
#define G_RAWBAR() do { asm volatile("s_waitcnt lgkmcnt(0)" ::: "memory"); __builtin_amdgcn_s_barrier(); asm volatile("" ::: "memory"); } while (0)
    for (int tt = bin; tt < tpg; tt += bpg) {
        const int t = grp * tpg + tt;
        const int pm = t / nN, pn = t % nN;
        const bf16_t* Ag = A + (size_t)pm * 256 * GK; const bf16_t* Bg = Bt + (size_t)pn * 256 * GK;
        f32x16 acc[2][4];
#pragma unroll
        for (int j = 0; j < 2; ++j)
#pragma unroll
            for (int i = 0; i < 4; ++i)
#pragma unroll
                for (int e = 0; e < 16; ++e) acc[j][i][e] = 0.f;
        G_RAWBAR();
        G_STAGE(0, Ag, Bg); G_STAGE(1, Ag, Bg); G_STAGE(2, Ag, Bg);
        for (int kt = 0; kt < NKT; ++kt) {
            if (kt + 2 < NKT) asm volatile("s_waitcnt vmcnt(8)" ::: "memory");
            else if (kt + 1 < NKT) asm volatile("s_waitcnt vmcnt(4)" ::: "memory");
            else asm volatile("s_waitcnt vmcnt(0)" ::: "memory");
            G_RAWBAR();
            if (kt + 3 < NKT) G_STAGE(kt + 3, Ag, Bg);
            G_COMPUTE(kt);
        }
        G_RAWBAR();
#pragma unroll
        for (int j = 0; j < 2; ++j)
#pragma unroll
            for (int i = 0; i < 4; ++i)
#pragma unroll
                for (int g = 0; g < 4; ++g) {
                    u32x2 v; v.x = pk_bf16(acc[j][i][4 * g], acc[j][i][4 * g + 1]); v.y = pk_bf16(acc[j][i][4 * g + 2], acc[j][i][4 * g + 3]);
                    *(u32x2*)(smem + (size_t)(wm * 128 + i * 32 + r) * (STG_STRIDE * 2) + (wn * 64 + j * 32 + 8 * g + 4 * h) * 2) = v;
                }
        __syncthreads();
        const int erow = tid >> 5, ec8 = tid & 31;
#pragma unroll 4
        for (int ps = 0; ps < 16; ++ps) { const int row = ps * 16 + erow; epi(pm * 256 + row, pn, ec8, smem + (size_t)row * (STG_STRIDE * 2)); }
    }
#undef G_STAGE
#undef G_COMPUTE
#undef G_SWZ32
#undef G_RAWBAR
    __syncthreads();
}


constexpr int DN_CH_BYTES = 73728;

constexpr int DP_QS = 0, DP_KS = 16384, DP_TI = 0, DP_Q = 17408, DP_TB = 21632;
constexpr int DP_RT = 32768;
constexpr int DP_AM = 69632;
constexpr int DP_KDT = 87040;
constexpr int DP_QK = 104448;
constexpr int DP_WI = 113152;
constexpr int DP_SM = 130048;

__device__ __forceinline__ void phase_dn_prep(const Params& p, unsigned char* smem) {
    const int tid0 = threadIdx.x;
    float* sbeta = (float*)(smem + DP_SM); float* sgc = sbeta + 64; float* segc = sbeta + 128; float* sekd = sbeta + 192;
    float* Am = (float*)(smem + DP_AM); float* Ti = (float*)(smem + DP_TI); float* Qb = (float*)(smem + DP_Q);
    bf16_t* Tb = (bf16_t*)(smem + DP_TB); bf16_t* Rt = (bf16_t*)(smem + DP_RT);
    bf16_t* kdt = (bf16_t*)(smem + DP_KDT); bf16_t* qki = (bf16_t*)(smem + DP_QK); bf16_t* wim = (bf16_t*)(smem + DP_WI);
    u32x4 xin[7][2]; float pre_b = 0.f, pre_a = 0.f;
    auto dn_fetch = [&](int cj) {
        const int tq = tid0, bhj = cj >> 7, nj = cj & 127, hj = bhj & 3;
        const bf16_t* prj = p.proj_b + (size_t)(bhj >> 2) * SEQ * NP_IN;
        if (tq < 384) {
            const int mat = tq >> 7, rg = (tq >> 3) & 15, sg = tq & 7;
            const int colbase = (mat == 0 ? P_DQ : (mat == 1 ? P_DK : P_DV)) + hj * 128 + sg * 16;
#pragma unroll
            for (int rr = 0; rr < 7; ++rr) {
                const int tt = nj * 64 + 4 * rg - 3 + rr;
                if (tt >= 0) { xin[rr][0] = *(const u32x4*)(prj + (size_t)tt * NP_IN + colbase); xin[rr][1] = *(const u32x4*)(prj + (size_t)tt * NP_IN + colbase + 8); }
                else { xin[rr][0] = (u32x4){0u, 0u, 0u, 0u}; xin[rr][1] = (u32x4){0u, 0u, 0u, 0u}; }
            }
        }
        if (tq < 64) { const size_t m = (size_t)(nj * 64 + tq); pre_b = bf2f(prj[m * NP_IN + P_B + hj]); pre_a = bf2f(prj[m * NP_IN + P_A + hj]); }
    };
    if (blockIdx.x < 16 * 128) dn_fetch(blockIdx.x);
    for (int ci = blockIdx.x; ci < 16 * 128; ci += gridDim.x) {
        int tid = tid0; asm volatile("" : "+v"(tid));
        const int lane = tid & 63, wave = tid >> 6;
        const int bh = ci >> 7, n = ci & 127, b = bh >> 2, h = bh & 3;
        const bf16_t* prow = p.proj_b + (size_t)b * SEQ * NP_IN;
        if (wave == 0) {
            const float braw = pre_b, araw = pre_a;
            const float beta = 1.f / (1.f + expf(-braw));
            const float xx = araw + p.dt_bias[h];
            const float sp = xx > 20.f ? xx : log1pf(expf(xx));
            float g = -expf(p.a_log[h]) * sp;
#pragma unroll
            for (int o = 1; o < 64; o <<= 1) { const float up = __shfl_up(g, o); if (lane >= o) g += up; }
            const float g63 = __shfl(g, 63);
            sbeta[lane] = beta; sgc[lane] = g; segc[lane] = expf(g); sekd[lane] = expf(g63 - g);
            if (lane == 63) p.dn_gl[ci] = expf(g63);
        }
        __syncthreads();
        if (tid < 384) {
            const int mat = tid >> 7, rg = (tid >> 3) & 15, sg = tid & 7, c0 = sg * 16, i0 = 4 * rg;
            const int colbase = (mat == 0 ? P_DQ : (mat == 1 ? P_DK : P_DV)) + h * 128 + c0;
            float wgt[4][16];
#pragma unroll
            for (int j = 0; j < 4; ++j) {
                const float* wp = p.conv_w + j * 1536 + mat * 512 + h * 128 + c0;
#pragma unroll
                for (int q4 = 0; q4 < 4; ++q4) { const float4 w4 = *(const float4*)(wp + 4 * q4); wgt[j][4 * q4] = w4.x; wgt[j][4 * q4 + 1] = w4.y; wgt[j][4 * q4 + 2] = w4.z; wgt[j][4 * q4 + 3] = w4.w; }
            }
#pragma unroll
            for (int ro = 0; ro < 4; ++ro) {
                const int i = i0 + ro, ix = i ^ (sg << 3);
                float acc[16];
#pragma unroll
                for (int cc = 0; cc < 16; ++cc) acc[cc] = 0.f;
#pragma unroll
                for (int j = 0; j < 4; ++j) {
                    const u32x4 x0 = xin[ro + j][0], x1 = xin[ro + j][1];
                    const unsigned xs[8] = {x0.x, x0.y, x0.z, x0.w, x1.x, x1.y, x1.z, x1.w};
#pragma unroll
                    for (int c2 = 0; c2 < 8; ++c2) { acc[2 * c2] = fmaf(wgt[j][2 * c2], bflo(xs[c2]), acc[2 * c2]); acc[2 * c2 + 1] = fmaf(wgt[j][2 * c2 + 1], bfhi(xs[c2]), acc[2 * c2 + 1]); }
                }
                float ss = 0.f;
#pragma unroll
                for (int cc = 0; cc < 16; ++cc) { acc[cc] = silu_f(acc[cc]); ss = fmaf(acc[cc], acc[cc], ss); }
                const float beta_i = sbeta[i], egc_i = segc[i], ekd_i = sekd[i];
                if (mat < 2) {
                    ss += __shfl_xor(ss, 1); ss += __shfl_xor(ss, 2); ss += __shfl_xor(ss, 4);
                    const float rs = rsqrtf(ss + L2_EPS) * (mat == 0 ? 0.08838834764831845f : 1.f);
#pragma unroll
                    for (int cc = 0; cc < 16; ++cc) acc[cc] *= rs;
                    unsigned char* img = smem + (mat == 0 ? DP_QS : DP_KS) + i * 256;
                    u32x4 c0v, c1v;
                    c0v.x = pk_bf16(acc[0], acc[1]); c0v.y = pk_bf16(acc[2], acc[3]); c0v.z = pk_bf16(acc[4], acc[5]); c0v.w = pk_bf16(acc[6], acc[7]);
                    c1v.x = pk_bf16(acc[8], acc[9]); c1v.y = pk_bf16(acc[10], acc[11]); c1v.z = pk_bf16(acc[12], acc[13]); c1v.w = pk_bf16(acc[14], acc[15]);
                    *(u32x4*)(img + (((2 * sg) ^ (i & 15)) << 4)) = c0v;
                    *(u32x4*)(img + (((2 * sg + 1) ^ (i & 15)) << 4)) = c1v;
                }
                if (mat == 0) {
                    u32x4 p0, p1;
                    p0.x = pk_bf16(acc[0] * egc_i, acc[1] * egc_i); p0.y = pk_bf16(acc[2] * egc_i, acc[3] * egc_i); p0.z = pk_bf16(acc[8] * egc_i, acc[9] * egc_i); p0.w = pk_bf16(acc[10] * egc_i, acc[11] * egc_i);
                    p1.x = pk_bf16(acc[4] * egc_i, acc[5] * egc_i); p1.y = pk_bf16(acc[6] * egc_i, acc[7] * egc_i); p1.z = pk_bf16(acc[12] * egc_i, acc[13] * egc_i); p1.w = pk_bf16(acc[14] * egc_i, acc[15] * egc_i);
                    bf16_t* dst = p.dn_qd + ((size_t)(ci * 16 + (i >> 5) * 8 + sg) * 64) * 8;
                    *(u32x4*)(dst + (size_t)(i & 31) * 8) = p0;
                    *(u32x4*)(dst + (size_t)(32 + (i & 31)) * 8) = p1;
                } else if (mat == 1) {
                    const float sc = beta_i * egc_i;
#pragma unroll
                    for (int cc = 0; cc < 16; ++cc) {
                        Rt[(128 + c0 + cc) * 72 + ix] = (bf16_t)(pk_bf16(acc[cc] * sc, 0.f) & 0xffffu);
                        kdt[(c0 + cc) * 68 + ix] = (bf16_t)(pk_bf16(acc[cc] * ekd_i, 0.f) & 0xffffu);
                    }
                } else {
#pragma unroll
                    for (int cc = 0; cc < 16; ++cc) Rt[(c0 + cc) * 72 + ix] = (bf16_t)(pk_bf16(acc[cc] * beta_i, 0.f) & 0xffffu);
                }
            }
        }
        if (ci + (int)gridDim.x < 16 * 128) dn_fetch(ci + (int)gridDim.x);
        __syncthreads();
        {
            const int mat = wave >> 2, ti = (wave >> 1) & 1, tj = wave & 1, r = lane & 31, hh = lane >> 5;
            const unsigned char* ai = smem + (mat ? DP_QS : DP_KS) + (ti * 32 + r) * 256;
            const unsigned char* bi = smem + DP_KS + (tj * 32 + r) * 256;
            f32x16 d;
#pragma unroll
            for (int e = 0; e < 16; ++e) d[e] = 0.f;
#pragma unroll
            for (int ks = 0; ks < 8; ++ks) {
                const bf16x8 af = *(const bf16x8*)(ai + (((2 * ks + hh) ^ (r & 15)) << 4));
                const bf16x8 bf = *(const bf16x8*)(bi + (((2 * ks + hh) ^ (r & 15)) << 4));
                d = __builtin_amdgcn_mfma_f32_32x32x16_bf16(af, bf, d, 0, 0, 0);
            }
            const int j = tj * 32 + r; const float gcj = sgc[j];
#pragma unroll
            for (int e = 0; e < 16; ++e) {
                const int i = ti * 32 + (e & 3) + 8 * (e >> 2) + 4 * hh;
                const float dec = __expf(fminf(sgc[i] - gcj, 0.f));
                if (mat == 0) Am[i * 68 + j] = (j < i) ? sbeta[i] * d[e] * dec : 0.f;
                else qki[i * 68 + j] = (bf16_t)(pk_bf16((j <= i) ? d[e] * dec : 0.f, 0.f) & 0xffffu);
            }
        }
        __syncthreads();
        if (tid < 64) {
            const int bk = tid >> 4, c = tid & 15;
            const float* Ab = Am + (16 * bk) * 68 + 16 * bk;
            float X[16];
#pragma unroll
            for (int i = 0; i < 16; ++i) {
                float sacc = 0.f;
#pragma unroll
                for (int j = 0; j < i; ++j) sacc = fmaf(Ab[i * 68 + j], X[j], sacc);
                X[i] = ((i == c) ? 1.f : 0.f) - sacc;
            }
#pragma unroll
            for (int i = 0; i < 16; ++i) Ti[(16 * bk + i) * 68 + 16 * bk + c] = X[i];
        } else {
            for (int z = tid - 64; z < 6 * 256; z += 448) {
                const int blk = z >> 8, e2 = z & 255, bi = blk < 3 ? 0 : (blk < 5 ? 1 : 2), bj = blk < 3 ? blk + 1 : (blk < 5 ? blk - 1 : 3);
                Ti[(16 * bi + (e2 >> 4)) * 68 + 16 * bj + (e2 & 15)] = 0.f;
            }
        }
        __syncthreads();
        {
            const int w2 = tid >> 8, o = tid & 255, ri = o >> 4, cj = o & 15, r0 = 16 * (2 * w2 + 1), c0 = 16 * (2 * w2);
            float sacc = 0.f;
#pragma unroll
            for (int k = 0; k < 16; ++k) sacc = fmaf(Am[(r0 + ri) * 68 + c0 + k], Ti[(c0 + k) * 68 + c0 + cj], sacc);
            Qb[w2 * 272 + ri * 17 + cj] = sacc;
        }
        __syncthreads();
        {
            const int w2 = tid >> 8, o = tid & 255, ri = o >> 4, cj = o & 15, r0 = 16 * (2 * w2 + 1), c0 = 16 * (2 * w2);
            float sacc = 0.f;
#pragma unroll
            for (int k = 0; k < 16; ++k) sacc = fmaf(Ti[(r0 + ri) * 68 + r0 + k], Qb[w2 * 272 + k * 17 + cj], sacc);
            Ti[(r0 + ri) * 68 + c0 + cj] = -sacc;
        }
        __syncthreads();
        float q3[2];
#pragma unroll
        for (int q = 0; q < 2; ++q) {
            const int o = tid + 512 * q, ri = o >> 5, cj = o & 31;
            float sacc = 0.f;
#pragma unroll
            for (int k = 0; k < 32; ++k) sacc = fmaf(Am[(32 + ri) * 68 + k], Ti[k * 68 + cj], sacc);
            q3[q] = sacc;
        }
#pragma unroll
        for (int q = 0; q < 2; ++q) { const int o = tid + 512 * q; Qb[(o >> 5) * 33 + (o & 31)] = q3[q]; }
        __syncthreads();
#pragma unroll
        for (int q = 0; q < 2; ++q) {
            const int o = tid + 512 * q, ri = o >> 5, cj = o & 31;
            float sacc = 0.f;
#pragma unroll
            for (int k = 0; k < 32; ++k) sacc = fmaf(Ti[(32 + ri) * 68 + 32 + k], Qb[k * 33 + cj], sacc);
            q3[q] = -sacc;
        }
        __syncthreads();
#pragma unroll
        for (int q = 0; q < 2; ++q) { const int o = tid + 512 * q; Ti[(32 + (o >> 5)) * 68 + (o & 31)] = q3[q]; }
        __syncthreads();
#pragma unroll
        for (int q = 0; q < 4; ++q) {
            const int o2 = tid + 512 * q, ri = o2 >> 5, c2 = (o2 & 31) * 2;
            *(unsigned*)(Tb + ri * 72 + c2) = pk_bf16(Ti[ri * 68 + c2], Ti[ri * 68 + c2 + 1]);
        }
        __syncthreads();
        {
            const int ct = wave, r = lane & 31, hh = lane >> 5;
            f32x16 xacc[2];
#pragma unroll
            for (int T = 0; T < 2; ++T)
#pragma unroll
                for (int e = 0; e < 16; ++e) xacc[T][e] = 0.f;
#pragma unroll
            for (int ks = 0; ks < 4; ++ks) {
                const bf16x8 bfr = *(const bf16x8*)(Rt + (32 * ct + r) * 72 + (((2 * ks + hh) ^ (((32 * ct + r) >> 4) & 7)) << 3));
#pragma unroll
                for (int T = 0; T < 2; ++T) {
                    const bf16x8 afr = *(const bf16x8*)(Tb + (32 * T + r) * 72 + 16 * ks + 8 * hh);
                    xacc[T] = __builtin_amdgcn_mfma_f32_32x32x16_bf16(afr, bfr, xacc[T], 0, 0, 0);
                }
            }
            if (ct < 4) {
#pragma unroll
                for (int T = 0; T < 2; ++T)
#pragma unroll
                    for (int hf = 0; hf < 2; ++hf) {
                        u32x4 o; o.x = pk_bf16(xacc[T][8 * hf], xacc[T][8 * hf + 1]); o.y = pk_bf16(xacc[T][8 * hf + 2], xacc[T][8 * hf + 3]);
                        o.z = pk_bf16(xacc[T][8 * hf + 4], xacc[T][8 * hf + 5]); o.w = pk_bf16(xacc[T][8 * hf + 6], xacc[T][8 * hf + 7]);
                        *(u32x4*)(p.dn_u + ((size_t)(((ci * 4 + ct) * 2 + T) * 2 + hf) * 64 + lane) * 8) = o;
                    }
            } else {
                const int dd = 32 * (ct - 4) + r;
#pragma unroll
                for (int T = 0; T < 2; ++T)
#pragma unroll
                    for (int e = 0; e < 16; ++e) wim[(32 * T + (e & 3) + 8 * (e >> 2) + 4 * hh) * 132 + dd] = (bf16_t)(pk_bf16(-xacc[T][e], 0.f) & 0xffffu);
            }
#pragma unroll
            for (int q = 0; q < 3; ++q) {
                const int pc = tid + 512 * q;
                if (pc < 512) {
                    const int f = pc >> 6, ln = pc & 63, r2 = ln & 31, h2 = ln >> 5, rt = f >> 2, ks = f & 3;
                    const bf16_t* src = qki + (32 * rt + r2) * 68 + 16 * ks + 4 * h2;
                    const u32x2 lo = *(const u32x2*)src, hi = *(const u32x2*)(src + 8);
                    u32x4 o; o.x = lo.x; o.y = lo.y; o.z = hi.x; o.w = hi.y;
                    *(u32x4*)(p.dn_qk + ((size_t)(ci * 8 + f) * 64 + ln) * 8) = o;
                } else {
                    const int pc2 = pc - 512, f = pc2 >> 6, ln = pc2 & 63, r2 = ln & 31, h2 = ln >> 5, rt = f >> 2, ks = f & 3;
                    const int dd2 = 32 * rt + r2, sx = ((dd2 >> 4) & 7) << 3, i0 = 16 * ks + 4 * h2;
                    const u32x2 lo = *(const u32x2*)(kdt + dd2 * 68 + (i0 ^ sx)), hi = *(const u32x2*)(kdt + dd2 * 68 + ((i0 + 8) ^ sx));
                    u32x4 o; o.x = lo.x; o.y = lo.y; o.z = hi.x; o.w = hi.y;
                    *(u32x4*)(p.dn_kdt + ((size_t)(ci * 16 + f) * 64 + ln) * 8) = o;
                }
            }
        }
        __syncthreads();
#pragma unroll
        for (int q = 0; q < 2; ++q) {
            const int pc = tid + 512 * q, f = pc >> 6, ln = pc & 63, r = ln & 31, hh = ln >> 5, rt = f >> 3, ks = f & 7;
            const bf16_t* src = wim + (32 * rt + r) * 132 + 16 * ks + 4 * hh;
            const u32x2 lo = *(const u32x2*)src, hi = *(const u32x2*)(src + 8);
            u32x4 o; o.x = lo.x; o.y = lo.y; o.z = hi.x; o.w = hi.y;
            *(u32x4*)(p.dn_negw + ((size_t)(ci * 16 + f) * 64 + ln) * 8) = o;
        }
    }
    __syncthreads();
}

__device__ __forceinline__ bf16x8 pack8(const f32x16& x, int s) {
    u32x4 v;
    v.x = pk_bf16(x[8 * s], x[8 * s + 1]); v.y = pk_bf16(x[8 * s + 2], x[8 * s + 3]); v.z = pk_bf16(x[8 * s + 4], x[8 * s + 5]); v.w = pk_bf16(x[8 * s + 6], x[8 * s + 7]);
    return __builtin_bit_cast(bf16x8, v);
}
#define LDS_BARRIER() do { asm volatile("s_waitcnt lgkmcnt(0)" ::: "memory"); __builtin_amdgcn_s_barrier(); asm volatile("" ::: "memory"); } while (0)
__device__ __forceinline__ const bf16_t* dn_piece_src(const Params& p, int ci, int pc) {
    return pc < 1024 ? p.dn_negw + ((size_t)ci * 1024 + pc) * 8 : pc < 2048 ? p.dn_qd + ((size_t)ci * 1024 + (pc - 1024)) * 8
         : pc < 3072 ? p.dn_kdt + ((size_t)ci * 1024 + (pc - 2048)) * 8 : pc < 3584 ? p.dn_qk + ((size_t)ci * 512 + (pc - 3072)) * 8 : p.dn_u + ((size_t)ci * 1024 + (pc - 3584)) * 8;
}
constexpr int DN_SEG = 32;
template <int PASS> __device__ __forceinline__ int dn_lpiece(int q) { return PASS == 0 ? q : (q < 1024 ? q : (q < 2048 ? q + 1024 : q + 1536)); }
template <int PASS>
__device__ __forceinline__ void dn_scan_seg(const Params& p, unsigned char* smem, int bh, int seg, int half) {
    constexpr int NPC = PASS == 0 ? 4608 : 3072, LPT = NPC / 256, PPT = NPC / 512;
    const int tid = threadIdx.x, lane = tid & 63, wave = tid >> 6, r = lane & 31, hh = lane >> 5;
    const int b = bh >> 2, h = bh & 3, ci0 = bh * 128 + seg * DN_SEG;
#pragma unroll
    for (int q = 0; q < PPT; ++q) { const int pc = dn_lpiece<PASS>(tid + 512 * q); *(u32x4*)(smem + pc * 16) = *(const u32x4*)dn_piece_src(p, ci0, pc); }
    __syncthreads();
    if (wave >= 4) {
        const int t2 = tid - 256;
        u32x4 sa[LPT], sb[LPT], sc[LPT];
#define DN_LD(dst, chunk) do { const int c_ = ci0 + ((chunk) < DN_SEG - 1 ? (chunk) : DN_SEG - 1); _Pragma("unroll") for (int q_ = 0; q_ < LPT; ++q_) dst[q_] = *(const u32x4*)dn_piece_src(p, c_, dn_lpiece<PASS>(t2 + 256 * q_)); } while (0)
#define DN_WR(src, chunk) do { if ((chunk) < DN_SEG) { unsigned char* nb_ = smem + ((chunk) & 1) * DN_CH_BYTES; _Pragma("unroll") for (int q_ = 0; q_ < LPT; ++q_) *(u32x4*)(nb_ + dn_lpiece<PASS>(t2 + 256 * q_) * 16) = src[q_]; } } while (0)
        DN_LD(sa, 1); DN_LD(sb, 2); DN_LD(sc, 3);
        for (int n = 0; n < DN_SEG + 1; n += 3) {
            if (n < DN_SEG) { DN_WR(sa, n + 1); DN_LD(sa, n + 4); LDS_BARRIER(); }
            if (n + 1 < DN_SEG) { DN_WR(sb, n + 2); DN_LD(sb, n + 5); LDS_BARRIER(); }
            if (n + 2 < DN_SEG) { DN_WR(sc, n + 3); DN_LD(sc, n + 6); LDS_BARRIER(); }
        }
#undef DN_LD
#undef DN_WR
    } else {
        const int e = __builtin_amdgcn_readfirstlane(wave);
        const int sl = 4 * half + e;
        const bool isP = sl < 4;
        f32x16 S[4];
#pragma unroll
        for (int T = 0; T < 4; ++T)
#pragma unroll
            for (int e2 = 0; e2 < 16; ++e2) {
                const int row = 32 * T + (e2 & 3) + 8 * (e2 >> 2) + 4 * hh;
                if (PASS == 0) S[T][e2] = seg > 0 ? p.dn_PB[((size_t)(bh * 3 + 0) * 128 + row) * 256 + 128 + 32 * e + r] : 0.f;
                else S[T][e2] = (isP && row == 32 * sl + r) ? 1.f : 0.f;
            }
        if (PASS == 0) {
            for (int sg = 1; sg < seg; ++sg) {
                const float* pseg = p.dn_PB + (size_t)(bh * 3 + sg) * 128 * 256;
                bf16x8 Xb[8];
#pragma unroll
                for (int T = 0; T < 4; ++T) { Xb[2 * T] = pack8(S[T], 0); Xb[2 * T + 1] = pack8(S[T], 1); }
#pragma unroll
                for (int T = 0; T < 4; ++T) {
                    f32x16 xn;
#pragma unroll
                    for (int e2 = 0; e2 < 16; ++e2) xn[e2] = pseg[(size_t)(32 * T + (e2 & 3) + 8 * (e2 >> 2) + 4 * hh) * 256 + 128 + 32 * e + r];
#pragma unroll
                    for (int ks = 0; ks < 8; ++ks) {
                        const float* pr = pseg + (size_t)(32 * T + r) * 256 + 16 * ks + 4 * hh;
                        const float4 lo = *(const float4*)pr, hi = *(const float4*)(pr + 8);
                        u32x4 av; av.x = pk_bf16(lo.x, lo.y); av.y = pk_bf16(lo.z, lo.w); av.z = pk_bf16(hi.x, hi.y); av.w = pk_bf16(hi.z, hi.w);
                        xn = __builtin_amdgcn_mfma_f32_32x32x16_bf16(__builtin_bit_cast(bf16x8, av), Xb[ks], xn, 0, 0, 0);
                        if (ks & 1) __builtin_amdgcn_sched_barrier(0);
                    }
                    S[T] = xn;
                    __builtin_amdgcn_sched_barrier(0);
                }
            }
        }
        const float glr = p.dn_gl[ci0 + (lane & 31)];
#define DN_SB() __builtin_amdgcn_sched_barrier(0)
#define DN_RD8(dst, off) do { _Pragma("unroll") for (int q_ = 0; q_ < 8; ++q_) dst[q_] = *(const bf16x8*)(buf + (off) + q_ * 1024 + lane * 16); } while (0)
        bf16x8 Sb[8];
#pragma unroll
        for (int T = 0; T < 4; ++T) { Sb[2 * T] = pack8(S[T], 0); Sb[2 * T + 1] = pack8(S[T], 1); }
        const unsigned ooff = (unsigned)(4 * hh * 512 + r);
        for (int n = 0; n < DN_SEG; ++n) {
            const unsigned char* buf = smem + (n & 1) * DN_CH_BYTES;
            const float gl = __uint_as_float(__builtin_amdgcn_readlane(__float_as_uint(glr), n));
            bf16x8 fa[8], fb[8];
            DN_RD8(fa, 0);
            DN_RD8(fb, 8192);
            f32x16 vn0, vn1;
            if (PASS == 0 || !isP) {
                const unsigned char* ub = buf + 57344 + (PASS == 0 ? e : sl - 4) * 4096 + lane * 16;
                const u32x4 u00 = *(const u32x4*)ub, u01 = *(const u32x4*)(ub + 1024), u10 = *(const u32x4*)(ub + 2048), u11 = *(const u32x4*)(ub + 3072);
                vn0[0] = bflo(u00.x); vn0[1] = bfhi(u00.x); vn0[2] = bflo(u00.y); vn0[3] = bfhi(u00.y); vn0[4] = bflo(u00.z); vn0[5] = bfhi(u00.z); vn0[6] = bflo(u00.w); vn0[7] = bfhi(u00.w);
                vn0[8] = bflo(u01.x); vn0[9] = bfhi(u01.x); vn0[10] = bflo(u01.y); vn0[11] = bfhi(u01.y); vn0[12] = bflo(u01.z); vn0[13] = bfhi(u01.z); vn0[14] = bflo(u01.w); vn0[15] = bfhi(u01.w);
                vn1[0] = bflo(u10.x); vn1[1] = bfhi(u10.x); vn1[2] = bflo(u10.y); vn1[3] = bfhi(u10.y); vn1[4] = bflo(u10.z); vn1[5] = bfhi(u10.z); vn1[6] = bflo(u10.w); vn1[7] = bfhi(u10.w);
                vn1[8] = bflo(u11.x); vn1[9] = bfhi(u11.x); vn1[10] = bflo(u11.y); vn1[11] = bfhi(u11.y); vn1[12] = bflo(u11.z); vn1[13] = bfhi(u11.z); vn1[14] = bflo(u11.w); vn1[15] = bfhi(u11.w);
            } else {
#pragma unroll
                for (int e2 = 0; e2 < 16; ++e2) { vn0[e2] = 0.f; vn1[e2] = 0.f; }
            }
            DN_SB();
#pragma unroll
            for (int ks = 0; ks < 8; ++ks) vn0 = __builtin_amdgcn_mfma_f32_32x32x16_bf16(fa[ks], Sb[ks], vn0, 0, 0, 0);
            DN_SB();
            if (PASS == 0) DN_RD8(fa, 16384); else DN_RD8(fa, 32768);
            DN_SB();
#pragma unroll
            for (int ks = 0; ks < 8; ++ks) vn1 = __builtin_amdgcn_mfma_f32_32x32x16_bf16(fb[ks], Sb[ks], vn1, 0, 0, 0);
            DN_SB();
            if (PASS == 0) DN_RD8(fb, 16384 + 8192); else DN_RD8(fb, 32768 + 8192);
            DN_SB();
            f32x16 o0, o1;
            if (PASS == 0) {
#pragma unroll
                for (int e2 = 0; e2 < 16; ++e2) { o0[e2] = 0.f; o1[e2] = 0.f; }
#pragma unroll
                for (int ks = 0; ks < 8; ++ks) o0 = __builtin_amdgcn_mfma_f32_32x32x16_bf16(fa[ks], Sb[ks], o0, 0, 0, 0);
                DN_SB();
                DN_RD8(fa, 32768);
            }
            bf16x8 vb[4];
            vb[0] = pack8(vn0, 0); vb[1] = pack8(vn0, 1); vb[2] = pack8(vn1, 0); vb[3] = pack8(vn1, 1);
            DN_SB();
            if (PASS == 0) {
#pragma unroll
                for (int ks = 0; ks < 8; ++ks) o1 = __builtin_amdgcn_mfma_f32_32x32x16_bf16(fb[ks], Sb[ks], o1, 0, 0, 0);
                DN_SB();
                DN_RD8(fb, 32768 + 8192);
            }
#pragma unroll
            for (int e2 = 0; e2 < 16; ++e2) { S[0][e2] *= gl; S[1][e2] *= gl; }
            DN_SB();
#pragma unroll
            for (int ks = 0; ks < 4; ++ks) S[0] = __builtin_amdgcn_mfma_f32_32x32x16_bf16(fa[ks], vb[ks], S[0], 0, 0, 0);
#pragma unroll
            for (int ks = 0; ks < 4; ++ks) S[1] = __builtin_amdgcn_mfma_f32_32x32x16_bf16(fa[4 + ks], vb[ks], S[1], 0, 0, 0);
            DN_SB();
            if (PASS == 0) DN_RD8(fa, 49152);
#pragma unroll
            for (int e2 = 0; e2 < 16; ++e2) { S[2][e2] *= gl; S[3][e2] *= gl; }
            DN_SB();
#pragma unroll
            for (int ks = 0; ks < 4; ++ks) S[2] = __builtin_amdgcn_mfma_f32_32x32x16_bf16(fb[ks], vb[ks], S[2], 0, 0, 0);
#pragma unroll
            for (int ks = 0; ks < 4; ++ks) S[3] = __builtin_amdgcn_mfma_f32_32x32x16_bf16(fb[4 + ks], vb[ks], S[3], 0, 0, 0);
            DN_SB();
            if (PASS == 0) {
#pragma unroll
                for (int ks = 0; ks < 4; ++ks) o0 = __builtin_amdgcn_mfma_f32_32x32x16_bf16(fa[ks], vb[ks], o0, 0, 0, 0);
#pragma unroll
                for (int ks = 0; ks < 4; ++ks) o1 = __builtin_amdgcn_mfma_f32_32x32x16_bf16(fa[4 + ks], vb[ks], o1, 0, 0, 0);
                DN_SB();
            }
#pragma unroll
            for (int T = 0; T < 4; ++T) { Sb[2 * T] = pack8(S[T], 0); Sb[2 * T + 1] = pack8(S[T], 1); }
            if (PASS == 0) {
                bf16_t* ob = p.odn_raw + ((size_t)b * SEQ + (seg * DN_SEG + n) * 64) * 512 + h * 128 + 32 * e;
#pragma unroll
                for (int e2 = 0; e2 < 16; e2 += 2) {
                    const unsigned w0 = pk_bf16(o0[e2], o0[e2 + 1]), w1 = pk_bf16(o1[e2], o1[e2 + 1]);
                    (ob + ((e2 & 3) + 8 * (e2 >> 2)) * 512)[ooff] = (bf16_t)(w0 & 0xffffu); (ob + ((e2 & 3) + 1 + 8 * (e2 >> 2)) * 512)[ooff] = (bf16_t)(w0 >> 16);
                    (ob + (32 + (e2 & 3) + 8 * (e2 >> 2)) * 512)[ooff] = (bf16_t)(w1 & 0xffffu); (ob + (32 + (e2 & 3) + 1 + 8 * (e2 >> 2)) * 512)[ooff] = (bf16_t)(w1 >> 16);
                }
            }
            LDS_BARRIER();
        }
#undef DN_RD8
#undef DN_SB
        if (PASS == 1) {
            float* pb = p.dn_PB + (size_t)(bh * 3 + seg) * 128 * 256 + 32 * sl + r;
#pragma unroll
            for (int T = 0; T < 4; ++T)
#pragma unroll
                for (int e2 = 0; e2 < 16; ++e2) pb[(size_t)(32 * T + (e2 & 3) + 8 * (e2 >> 2) + 4 * hh) * 256] = S[T][e2];
        }
    }
    __syncthreads();
}
__device__ __forceinline__ void phase_scan_l2_helper(const Params& p) {
    const int j = blockIdx.x - 64, tid = threadIdx.x;
    const int sj = (blockIdx.x & 7) + 8 * ((j >> 3) & 7), hi = (j >> 3) >> 3;
    const int bh = sj >> 2, seg = sj & 3, ci0 = bh * 128 + seg * DN_SEG;
    unsigned acc = 0u;
    for (int m = 4 + hi; m < DN_SEG; m += 3) {
#pragma unroll
        for (int q = 0; q < 9; ++q) { const u32x4 v = *(const u32x4*)dn_piece_src(p, ci0 + m, tid + 512 * q); acc ^= v.x ^ v.y ^ v.z ^ v.w; }
    }
    asm volatile("" :: "v"(acc));
}

constexpr int AT_VT = 32768, AT_VT_STRIDE = 260;
__device__ __forceinline__ void phase_attn(const Params& p, unsigned char* smem, int first_block) {
    const int tid0 = threadIdx.x;
    const int nblk = gridDim.x - first_block;
    const bf16_t* pb = p.proj_b;
    bf16_t* vt = (bf16_t*)(smem + AT_VT);
    for (int item = blockIdx.x - first_block; item < 1024; item += nblk) {
        int tid = tid0; asm volatile("" : "+v"(tid));
        const int lane = tid & 63, wave = tid >> 6, r = lane & 31, hh = lane >> 5;
        const int hp = item & 1, kvh = (item >> 1) & 1, nb = (item >> 2) & 63, b = item >> 8;
        const int m0 = b * SEQ + nb * 128;
        __syncthreads();
#pragma unroll
        for (int i = 0; i < 4; ++i) {
            const int idx = tid + 512 * i, key = idx >> 3, ch = idx & 7;
            const bool valid = (nb > 0) || (key >= 128);
            u32x4 kv = {0u, 0u, 0u, 0u}, vv = {0u, 0u, 0u, 0u};
            if (valid) { const bf16_t* src = pb + (size_t)(m0 - 128 + key) * NP_IN + kvh * 64 + ch * 8; kv = *(const u32x4*)(src + P_AK); vv = *(const u32x4*)(src + P_AV); }
            *(u32x4*)(smem + swz(key, ch)) = kv;
            bf16_t* vd = vt + (ch * 8) * AT_VT_STRIDE + key;
            vd[0] = (bf16_t)(vv.x & 0xffffu); vd[AT_VT_STRIDE] = (bf16_t)(vv.x >> 16); vd[2 * AT_VT_STRIDE] = (bf16_t)(vv.y & 0xffffu); vd[3 * AT_VT_STRIDE] = (bf16_t)(vv.y >> 16);
            vd[4 * AT_VT_STRIDE] = (bf16_t)(vv.z & 0xffffu); vd[5 * AT_VT_STRIDE] = (bf16_t)(vv.z >> 16); vd[6 * AT_VT_STRIDE] = (bf16_t)(vv.w & 0xffffu); vd[7 * AT_VT_STRIDE] = (bf16_t)(vv.w >> 16);
        }
        __syncthreads();
        const int head = kvh * 4 + hp * 2 + (wave >> 2), qt = wave & 3, qo = qt * 32;
        const bf16_t* qrow = pb + (size_t)(m0 + qo + r) * NP_IN + P_AQ + head * 64 + 8 * hh;
        bf16x8 qf[4];
#pragma unroll
        for (int ks = 0; ks < 4; ++ks) qf[ks] = *(const bf16x8*)(qrow + 16 * ks);
        f32x16 sc[5];
#pragma unroll
        for (int t = 0; t < 5; ++t) {
#pragma unroll
            for (int e = 0; e < 16; ++e) sc[t][e] = 0.f;
#pragma unroll
            for (int ks = 0; ks < 4; ++ks) sc[t] = __builtin_amdgcn_mfma_f32_32x32x16_bf16(*(const bf16x8*)(smem + swz((qt + t) * 32 + r, 2 * ks + hh)), qf[ks], sc[t], 0, 0, 0);
        }
        const float sink = p.sinks[head];
        float mx = -1e30f;
#pragma unroll
        for (int t = 0; t < 5; ++t)
#pragma unroll
            for (int e = 0; e < 16; ++e) {
                const int kf = 32 * (qt + t) + (e & 3) + 8 * (e >> 2) + 4 * hh;
                const bool ok = (kf >= qo + r + 1) && (kf <= qo + r + 128) && ((nb > 0) || (kf >= 128));
                sc[t][e] = ok ? sc[t][e] : -1e30f;
                mx = fmaxf(mx, sc[t][e]);
            }
        mx = fmaxf(mx, __shfl_xor(mx, 32));
        mx = fmaxf(mx, sink);
        float sum = 0.f;
#pragma unroll
        for (int t = 0; t < 5; ++t)
#pragma unroll
            for (int e = 0; e < 16; ++e) { const float pe = (sc[t][e] > -1e29f) ? __expf(sc[t][e] - mx) : 0.f; sc[t][e] = pe; sum += pe; }
        sum += __shfl_xor(sum, 32);
        const float inv = 1.f / (sum + __expf(sink - mx));
        f32x16 o[2];
#pragma unroll
        for (int dt = 0; dt < 2; ++dt)
#pragma unroll
            for (int e = 0; e < 16; ++e) o[dt][e] = 0.f;
#pragma unroll
        for (int t = 0; t < 5; ++t)
#pragma unroll
            for (int s2 = 0; s2 < 2; ++s2) {
                const bf16x8 pbv = pack8(sc[t], s2);
                const int kb = 32 * (qt + t) + 16 * s2 + 4 * hh;
#pragma unroll
                for (int dt = 0; dt < 2; ++dt) {
                    const bf16_t* vr = vt + (dt * 32 + r) * AT_VT_STRIDE + kb;
                    const u32x2 lo = *(const u32x2*)vr, hi = *(const u32x2*)(vr + 8);
                    u32x4 av; av.x = lo.x; av.y = lo.y; av.z = hi.x; av.w = hi.y;
                    o[dt] = __builtin_amdgcn_mfma_f32_32x32x16_bf16(__builtin_bit_cast(bf16x8, av), pbv, o[dt], 0, 0, 0);
                }
            }
        bf16_t* orow = p.xb + (size_t)(m0 + qo + r) * D_MODEL + head * 64 + 4 * hh;
#pragma unroll
        for (int dt = 0; dt < 2; ++dt)
#pragma unroll
            for (int q4 = 0; q4 < 4; ++q4) {
                u32x2 v; v.x = pk_bf16(o[dt][4 * q4] * inv, o[dt][4 * q4 + 1] * inv); v.y = pk_bf16(o[dt][4 * q4 + 2] * inv, o[dt][4 * q4 + 3] * inv);
                *(u32x2*)(orow + dt * 32 + 8 * q4) = v;
            }
    }
    __syncthreads();
}

__device__ __forceinline__ void phase_dn_norm(const Params& p) {
    const int lane = threadIdx.x & 63, gw = blockIdx.x * (NTHREADS / 64) + (threadIdx.x >> 6), GW = gridDim.x * (NTHREADS / 64);
    const float2 g = *(const float2*)(p.dn_norm_g + lane * 2);
    for (int m = gw; m < M_TOK; m += GW) {
        float2 o[4]; unsigned z[4];
#pragma unroll
        for (int h = 0; h < 4; ++h) { const unsigned ow = *(const unsigned*)(p.odn_raw + (size_t)m * 512 + h * 128 + lane * 2); o[h] = make_float2(bflo(ow), bfhi(ow)); z[h] = *(const unsigned*)(p.proj_b + (size_t)m * NP_IN + P_Z + h * 128 + lane * 2); }
#pragma unroll
        for (int h = 0; h < 4; ++h) {
            const float ss = wave_sum(o[h].x * o[h].x + o[h].y * o[h].y);
            const float rr = rsqrtf(ss * (1.f / 128.f) + RMS_EPS);
            *(unsigned*)(p.xb + (size_t)m * D_MODEL + 512 + h * 128 + lane * 2) = pk_bf16(o[h].x * rr * g.x * silu_f(bflo(z[h])), o[h].y * rr * g.y * silu_f(bfhi(z[h])));
        }
    }
}

__device__ __forceinline__ void phase_ln1(const Params& p, bf16_t* x1b) {
    const int lane = threadIdx.x & 63, gw = blockIdx.x * (NTHREADS / 64) + (threadIdx.x >> 6), GW = gridDim.x * (NTHREADS / 64);
    float4 g[4], bb[4];
#pragma unroll
    for (int j = 0; j < 4; ++j) { g[j] = *(const float4*)(p.ln1_g + j * 256 + lane * 4); bb[j] = *(const float4*)(p.ln1_b + j * 256 + lane * 4); }
    for (int m0 = gw * 4; m0 < M_TOK; m0 += GW * 4) {
        float4 v[4][4];
#pragma unroll
        for (int rr = 0; rr < 4; ++rr)
#pragma unroll
            for (int j = 0; j < 4; ++j) v[rr][j] = *(const float4*)(p.out + (size_t)(m0 + rr) * D_MODEL + j * 256 + lane * 4);
#pragma unroll
        for (int rr = 0; rr < 4; ++rr) {
            float s = 0.f;
#pragma unroll
            for (int j = 0; j < 4; ++j) s += (v[rr][j].x + v[rr][j].y) + (v[rr][j].z + v[rr][j].w);
            const float mean = wave_sum(s) * (1.f / D_MODEL); float q = 0.f;
#pragma unroll
            for (int j = 0; j < 4; ++j) { v[rr][j].x -= mean; v[rr][j].y -= mean; v[rr][j].z -= mean; v[rr][j].w -= mean; q += (v[rr][j].x * v[rr][j].x + v[rr][j].y * v[rr][j].y) + (v[rr][j].z * v[rr][j].z + v[rr][j].w * v[rr][j].w); }
            const float rstd = rsqrtf(wave_sum(q) * (1.f / D_MODEL) + LN_EPS);
            if (lane == 0) *(float2*)(p.ln1_stats + (size_t)(m0 + rr) * 2) = make_float2(mean, rstd);
#pragma unroll
            for (int j = 0; j < 4; ++j) {
                u32x2 ob; ob.x = pk_bf16(v[rr][j].x * rstd * g[j].x + bb[j].x, v[rr][j].y * rstd * g[j].y + bb[j].y); ob.y = pk_bf16(v[rr][j].z * rstd * g[j].z + bb[j].z, v[rr][j].w * rstd * g[j].w + bb[j].w);
                *(u32x2*)(x1b + (size_t)(m0 + rr) * D_MODEL + j * 256 + lane * 4) = ob;
            }
        }
    }
}

__device__ __forceinline__ void cas_d(float& a, float& b) { const float hi = fmaxf(a, b), lo = fminf(a, b); a = hi; b = lo; }
__device__ __forceinline__ void cas_a(float& a, float& b) { const float hi = fmaxf(a, b), lo = fminf(a, b); a = lo; b = hi; }
__device__ __forceinline__ void sort16_desc(f32x16& v) {
#pragma unroll
    for (int k = 2; k <= 16; k <<= 1)
#pragma unroll
        for (int j = k >> 1; j > 0; j >>= 1)
#pragma unroll
            for (int i = 0; i < 16; ++i) {
                const int l = i ^ j;
                if (l > i) { float a = v[i], b = v[l]; if ((i & k) == 0) cas_d(a, b); else cas_a(a, b); v[i] = a; v[l] = b; }
            }
}
__device__ __forceinline__ void bmerge16_desc(f32x16& v) {
#pragma unroll
    for (int j = 8; j > 0; j >>= 1)
#pragma unroll
        for (int i = 0; i < 16; ++i) { const int l = i ^ j; if (l > i) { float a = v[i], b = v[l]; cas_d(a, b); v[i] = a; v[l] = b; } }
}
__device__ __forceinline__ f32x16 merge_top16(const f32x16& a, const f32x16& b) {
    f32x16 c;
#pragma unroll
    for (int i = 0; i < 16; ++i) c[i] = fmaxf(a[i], b[15 - i]);
    bmerge16_desc(c);
    return c;
}
__device__ __forceinline__ void pcas_d(float& va, int& ia, float& vb, int& ib) {
    const bool sw = vb > va; const float tv = sw ? vb : va; const int ti = sw ? ib : ia;
    vb = sw ? va : vb; ib = sw ? ia : ib; va = tv; ia = ti;
}
__device__ __forceinline__ void psort16_desc(float (&v)[16], int (&id)[16]) {
#pragma unroll
    for (int k = 2; k <= 16; k <<= 1)
#pragma unroll
        for (int j = k >> 1; j > 0; j >>= 1)
#pragma unroll
            for (int i = 0; i < 16; ++i) {
                const int l = i ^ j;
                if (l > i) { if ((i & k) == 0) pcas_d(v[i], id[i], v[l], id[l]); else pcas_d(v[l], id[l], v[i], id[i]); }
            }
}
__device__ __forceinline__ void pmerge_top16(float (&a)[16], int (&ia)[16], const float (&b)[16], const int (&ib)[16]) {
#pragma unroll
    for (int i = 0; i < 16; ++i) { const bool sw = b[15 - i] > a[i]; a[i] = sw ? b[15 - i] : a[i]; ia[i] = sw ? ib[15 - i] : ia[i]; }
#pragma unroll
    for (int j = 8; j > 0; j >>= 1)
#pragma unroll
        for (int i = 0; i < 16; ++i) { const int l = i ^ j; if (l > i) pcas_d(a[i], ia[i], a[l], ia[l]); }
}
__device__ __forceinline__ void phase_route(const Params& p, const bf16_t* qb) {
    constexpr int CI[50] = {0,0,0,0,0,0,0,0,0,0,0,0,0,0,0,0,1,1,1,1,1,1,1,1,2,2,2,2,2,3,3,3,3,4,4,4,5,5,6,6,7,7,8,9,10,11,12,13,14,15};
    constexpr int CJ[50] = {0,1,2,3,4,5,6,7,8,9,10,11,12,13,14,15,0,1,2,3,4,5,6,7,0,1,2,3,4,0,1,2,3,0,1,2,0,1,0,1,0,1,0,0,0,0,0,0,0,0};
    const int lane0 = threadIdx.x & 63, gw = blockIdx.x * (NTHREADS / 64) + (threadIdx.x >> 6), GW = gridDim.x * (NTHREADS / 64);
    for (int task = gw; task < (M_TOK / 32) * 8; task += GW) {
        int lane = lane0; asm volatile("" : "+v"(lane));
        const int r = lane & 31, hh = lane >> 5;
        const int h = task & 7, tok0 = (task >> 3) * 32;
        f32x16 top[2];
#pragma unroll
        for (int pp = 0; pp < 2; ++pp) {
            const bf16_t* qrow = qb + (size_t)(tok0 + r) * 2048 + h * 256 + pp * 128 + 8 * hh;
            bf16x8 qf[8];
#pragma unroll
            for (int ks = 0; ks < 8; ++ks) qf[ks] = *(const bf16x8*)(qrow + 16 * ks);
            f32x16 sc[4];
#pragma unroll
            for (int kt = 0; kt < 4; ++kt) {
                const bf16_t* af = p.sk_frag + ((size_t)(((h * 2 + pp) * 4 + kt) * 8) * 64 + lane) * 8;
                bf16x8 a[8];
#pragma unroll
                for (int ks = 0; ks < 8; ++ks) a[ks] = *(const bf16x8*)(af + (size_t)ks * 512);
#pragma unroll
                for (int e = 0; e < 16; ++e) sc[kt][e] = 0.f;
#pragma unroll
                for (int ks = 0; ks < 8; ++ks) sc[kt] = __builtin_amdgcn_mfma_f32_32x32x16_bf16(a[ks], qf[ks], sc[kt], 0, 0, 0);
            }
#pragma unroll
            for (int kt = 0; kt < 4; ++kt) {
#pragma unroll
                for (int e = 0; e < 16; ++e) {
                    const unsigned key = (unsigned)(32 * kt + (e & 3) + 8 * (e >> 2)) + 4u * (unsigned)hh;
                    sc[kt][e] = __uint_as_float((__float_as_uint(sc[kt][e]) & 0xffffff80u) | key);
                }
                sort16_desc(sc[kt]);
            }
            f32x16 m = merge_top16(merge_top16(sc[0], sc[1]), merge_top16(sc[2], sc[3]));
            f32x16 oth;
#pragma unroll
            for (int i = 0; i < 16; ++i) oth[i] = __shfl_xor(m[i], 32);
            top[pp] = merge_top16(m, oth);
        }
        int ia[16], ib[16];
#pragma unroll
        for (int i = 0; i < 16; ++i) { ia[i] = (int)(__float_as_uint(top[0][i]) & 127u); ib[i] = (int)(__float_as_uint(top[1][i]) & 127u); }
        float cv0[16], cv1[16]; int cd0[16], cd1[16];
#pragma unroll
        for (int c = 0; c < 32; ++c) {
            float v = -INFINITY; int id = 0;
            if (c < 25) {
                const float v0 = top[0][CI[2 * c]] + top[1][CJ[2 * c]], v1 = top[0][CI[2 * c + 1]] + top[1][CJ[2 * c + 1]];
                const int d0 = (ia[CI[2 * c]] << 7) | ib[CJ[2 * c]], d1 = (ia[CI[2 * c + 1]] << 7) | ib[CJ[2 * c + 1]];
                v = hh ? v1 : v0; id = hh ? d1 : d0;
            }
            if (c < 16) { cv0[c] = v; cd0[c] = id; } else { cv1[c - 16] = v; cd1[c - 16] = id; }
        }
        psort16_desc(cv0, cd0); psort16_desc(cv1, cd1);
        pmerge_top16(cv0, cd0, cv1, cd1);
        float ov[16]; int od[16];
#pragma unroll
        for (int i = 0; i < 16; ++i) { ov[i] = __shfl_xor(cv0[i], 32); od[i] = __shfl_xor(cd0[i], 32); }
        pmerge_top16(cv0, cd0, ov, od);
        float ex[16], den = 0.f;
#pragma unroll
        for (int i = 0; i < 16; ++i) { ex[i] = __expf(cv0[i] - cv0[0]); den += ex[i]; }
        const float inv = 1.f / den;
        if (hh == 0) {
            int* idp = p.ids + (size_t)(tok0 + r) * 128 + h * 16; float* gp = p.gates + (size_t)(tok0 + r) * 128 + h * 16;
#pragma unroll
            for (int q = 0; q < 4; ++q) {
                *(int4*)(idp + 4 * q) = make_int4(cd0[4 * q], cd0[4 * q + 1], cd0[4 * q + 2], cd0[4 * q + 3]);
                *(float4*)(gp + 4 * q) = make_float4(ex[4 * q] * inv, ex[4 * q + 1] * inv, ex[4 * q + 2] * inv, ex[4 * q + 3] * inv);
            }
        }
    }
}


typedef float f32x2 __attribute__((ext_vector_type(2)));
__device__ __forceinline__ void phase_tables8(const Params& p, int first_block) {
    const int lane = threadIdx.x & 63, gw = (blockIdx.x - first_block) * (NTHREADS / 64) + (threadIdx.x >> 6), GW = (gridDim.x - first_block) * (NTHREADS / 64);
    for (int row0 = gw * 4; row0 < 2 * 16384; row0 += GW * 4) {
        float v[4][16];
#pragma unroll
        for (int rr = 0; rr < 4; ++rr) {
            const int row = row0 + rr, table = row >> 14, e = row & 16383;
            const float* src = (table ? p.peer_v : p.peer_u) + (size_t)e * 1024 + lane * 16;
#pragma unroll
            for (int q = 0; q < 4; ++q) { const float4 a = *(const float4*)(src + 4 * q); v[rr][4 * q] = a.x; v[rr][4 * q + 1] = a.y; v[rr][4 * q + 2] = a.z; v[rr][4 * q + 3] = a.w; }
        }
#pragma unroll
        for (int rr = 0; rr < 4; ++rr) {
            const int row = row0 + rr, table = row >> 14, e = row & 16383;
            float am = 0.f;
#pragma unroll
            for (int c = 0; c < 16; ++c) am = fmaxf(am, fabsf(v[rr][c]));
            am = wave_max(am);
            float sc = am > 0.f ? exp2f(floorf(log2f(448.f / am))) : 1.f;
            if (am * sc > 448.f) sc *= 0.5f;
            u32x4 o; int w;
            w = 0; w = __builtin_amdgcn_cvt_pk_fp8_f32(v[rr][0] * sc, v[rr][1] * sc, w, false); w = __builtin_amdgcn_cvt_pk_fp8_f32(v[rr][2] * sc, v[rr][3] * sc, w, true); o.x = (unsigned)w;
            w = 0; w = __builtin_amdgcn_cvt_pk_fp8_f32(v[rr][4] * sc, v[rr][5] * sc, w, false); w = __builtin_amdgcn_cvt_pk_fp8_f32(v[rr][6] * sc, v[rr][7] * sc, w, true); o.y = (unsigned)w;
            w = 0; w = __builtin_amdgcn_cvt_pk_fp8_f32(v[rr][8] * sc, v[rr][9] * sc, w, false); w = __builtin_amdgcn_cvt_pk_fp8_f32(v[rr][10] * sc, v[rr][11] * sc, w, true); o.z = (unsigned)w;
            w = 0; w = __builtin_amdgcn_cvt_pk_fp8_f32(v[rr][12] * sc, v[rr][13] * sc, w, false); w = __builtin_amdgcn_cvt_pk_fp8_f32(v[rr][14] * sc, v[rr][15] * sc, w, true); o.w = (unsigned)w;
            *(u32x4*)(p.tab8 + ((size_t)((table * 8 + (lane >> 3)) * 16384 + e)) * 128 + (lane & 7) * 16) = o;
            if (lane == 0) p.isc[row] = 1.f / sc;
        }
    }
}
typedef int i32x16 __attribute__((ext_vector_type(16)));
struct PeerBuf { u32x4 rows[16]; u32x4 xa, xb; f32x16 w; };
__device__ __forceinline__ float dpp_xor1(float v) { return __uint_as_float(__builtin_amdgcn_update_dpp(0u, __float_as_uint(v), 0xB1, 0xF, 0xF, true)); }
__device__ __forceinline__ float dpp_xor2(float v) { return __uint_as_float(__builtin_amdgcn_update_dpp(0u, __float_as_uint(v), 0x4E, 0xF, 0xF, true)); }
__device__ __forceinline__ float dpp_xor8(float v) { return __uint_as_float(__builtin_amdgcn_update_dpp(0u, __float_as_uint(v), 0x128, 0xF, 0xF, true)); }
__device__ __forceinline__ float swz_xor4(float v) { return __uint_as_float(__builtin_amdgcn_ds_swizzle(__float_as_uint(v), 0x101F)); }
__device__ __forceinline__ float swz_xor16(float v) { return __uint_as_float(__builtin_amdgcn_ds_swizzle(__float_as_uint(v), 0x401F)); }
__device__ __forceinline__ void peer_gather(PeerBuf& B, const unsigned char* tab, const i32x16& id, int j) {
#pragma unroll
    for (int i = 0; i < 16; ++i) B.rows[i] = *(const u32x4*)(tab + (size_t)id[i] * 128 + j * 16);
}
__device__ __forceinline__ void phase_peer_u(const Params& p, const bf16_t* x1b, float* ph) {
    const int lane0 = threadIdx.x & 63, wave = threadIdx.x >> 6;
    const int x = blockIdx.x & 7, nloc = (gridDim.x - x + 7) >> 3, wl = (blockIdx.x >> 3) * (NTHREADS / 64) + wave, NW = nloc * (NTHREADS / 64);
    const unsigned char* tab = p.tab8 + (size_t)x * 16384 * 128;
    int lane = lane0; asm volatile("" : "+v"(lane));
    const int j = lane & 7, g = lane >> 3;
    const bool b0 = j & 1, b1 = j & 2, b2 = j & 4;
    auto tok = [&](int t) { return t < M_TOK ? t : M_TOK - 1; };
    auto load_ids = [&](i32x16& id, int t) {
#pragma unroll
        for (int q = 0; q < 4; ++q) { const int4 v = *(const int4*)(p.ids + (size_t)t * 128 + 16 * g + 4 * q); id[4 * q] = v.x; id[4 * q + 1] = v.y; id[4 * q + 2] = v.z; id[4 * q + 3] = v.w; }
    };
    auto issue = [&](PeerBuf& B, int t, const i32x16& id) {
        const bf16_t* xs = x1b + (size_t)t * 1024 + 128 * x + 16 * j;
        B.xa = *(const u32x4*)xs; B.xb = *(const u32x4*)(xs + 8);
        peer_gather(B, tab, id, j);
    };
    auto compute = [&](const PeerBuf& B, int t) {
        const f32x2 xf[8] = {{bflo(B.xa.x), bfhi(B.xa.x)}, {bflo(B.xa.y), bfhi(B.xa.y)}, {bflo(B.xa.z), bfhi(B.xa.z)}, {bflo(B.xa.w), bfhi(B.xa.w)},
                             {bflo(B.xb.x), bfhi(B.xb.x)}, {bflo(B.xb.y), bfhi(B.xb.y)}, {bflo(B.xb.z), bfhi(B.xb.z)}, {bflo(B.xb.w), bfhi(B.xb.w)}};
        float res[16];
#pragma unroll
        for (int i = 0; i < 16; ++i) {
            const unsigned dw[4] = {B.rows[i].x, B.rows[i].y, B.rows[i].z, B.rows[i].w};
            f32x2 d2 = {0.f, 0.f};
#pragma unroll
            for (int q = 0; q < 4; ++q) {
                const f32x2 lo = __builtin_amdgcn_cvt_pk_f32_fp8((int)dw[q], false), hi = __builtin_amdgcn_cvt_pk_f32_fp8((int)dw[q], true);
                d2 = lo * xf[2 * q] + d2; d2 = hi * xf[2 * q + 1] + d2;
            }
            res[i] = d2.x + d2.y;
        }
        float r8[8], r4[4], r2[2];
#pragma unroll
        for (int m = 0; m < 8; ++m) { const float keep = b0 ? res[8 + m] : res[m], send = b0 ? res[m] : res[8 + m]; r8[m] = keep + dpp_xor1(send); }
#pragma unroll
        for (int m = 0; m < 4; ++m) { const float keep = b1 ? r8[4 + m] : r8[m], send = b1 ? r8[m] : r8[4 + m]; r4[m] = keep + dpp_xor2(send); }
#pragma unroll
        for (int m = 0; m < 2; ++m) { const float keep = b2 ? r4[2 + m] : r4[m], send = b2 ? r4[m] : r4[2 + m]; r2[m] = keep + swz_xor4(send); }
        const int i0 = 8 * (int)b0 + 4 * (int)b1 + 2 * (int)b2;
        *(float2*)(ph + ((size_t)x * M_TOK + t) * 128 + 16 * g + i0) = make_float2(r2[0], r2[1]);
    };
    PeerBuf A, Bb;
    int t = wl;
    if (t >= M_TOK) return;
    i32x16 idn;
    load_ids(idn, t);
    issue(A, t, idn);
    load_ids(idn, tok(t + NW));
    for (; t < M_TOK; t += 2 * NW) {
        issue(Bb, tok(t + NW), idn);
        load_ids(idn, tok(t + 2 * NW));
        compute(A, t);
        issue(A, tok(t + 2 * NW), idn);
        load_ids(idn, tok(t + 3 * NW));
        if (t + NW < M_TOK) compute(Bb, t + NW);
    }
}
__device__ __forceinline__ void phase_peer_w(const Params& p, const float* ph, float* wbuf) {
    const size_t gt = (size_t)blockIdx.x * NTHREADS + threadIdx.x, GT = (size_t)gridDim.x * NTHREADS;
    for (size_t i0 = gt; i0 < (size_t)M_TOK * 128; i0 += GT * 4) {
        int e[4]; float h[4], gg[4];
#pragma unroll
        for (int u = 0; u < 4; ++u) {
            const size_t idx = i0 + u * GT;
            e[u] = p.ids[idx]; gg[u] = p.gates[idx]; h[u] = 0.f;
#pragma unroll
            for (int x = 0; x < 8; ++x) h[u] += ph[(size_t)x * M_TOK * 128 + idx];
        }
#pragma unroll
        for (int u = 0; u < 4; ++u) {
            const float hv = h[u] * p.isc[e[u]];
            wbuf[i0 + u * GT] = 0.5f * hv * (1.f + erff(hv * 0.7071067811865476f)) * gg[u] * p.isc[16384 + e[u]];
        }
    }
}
__device__ __forceinline__ void phase_peer_v(const Params& p, const float* wbuf, bf16_t* ffn) {
    const int lane0 = threadIdx.x & 63, wave = threadIdx.x >> 6;
    const int x = blockIdx.x & 7, nloc = (gridDim.x - x + 7) >> 3, wl = (blockIdx.x >> 3) * (NTHREADS / 64) + wave, NW = nloc * (NTHREADS / 64);
    const unsigned char* tab = p.tab8 + (size_t)(8 + x) * 16384 * 128;
    int lane = lane0; asm volatile("" : "+v"(lane));
    const int j = lane & 7, g = lane >> 3;
    const bool b3 = g & 1, b4 = g & 2, b5 = g & 4;
    auto tok = [&](int t) { return t < M_TOK ? t : M_TOK - 1; };
    auto load_ids = [&](i32x16& id, int t) {
#pragma unroll
        for (int q = 0; q < 4; ++q) { const int4 v = *(const int4*)(p.ids + (size_t)t * 128 + 16 * g + 4 * q); id[4 * q] = v.x; id[4 * q + 1] = v.y; id[4 * q + 2] = v.z; id[4 * q + 3] = v.w; }
    };
    auto issue = [&](PeerBuf& B, int t, const i32x16& id) {
#pragma unroll
        for (int q = 0; q < 4; ++q) { const float4 v = *(const float4*)(wbuf + (size_t)t * 128 + 16 * g + 4 * q); B.w[4 * q] = v.x; B.w[4 * q + 1] = v.y; B.w[4 * q + 2] = v.z; B.w[4 * q + 3] = v.w; }
        peer_gather(B, tab, id, j);
    };
    auto compute = [&](const PeerBuf& B, int t) {
        f32x2 acc[8];
#pragma unroll
        for (int c = 0; c < 8; ++c) acc[c] = (f32x2){0.f, 0.f};
#pragma unroll
        for (int i = 0; i < 16; ++i) {
            const f32x2 w2 = {B.w[i], B.w[i]};
            const unsigned dw[4] = {B.rows[i].x, B.rows[i].y, B.rows[i].z, B.rows[i].w};
#pragma unroll
            for (int q = 0; q < 4; ++q) {
                const f32x2 lo = __builtin_amdgcn_cvt_pk_f32_fp8((int)dw[q], false), hi = __builtin_amdgcn_cvt_pk_f32_fp8((int)dw[q], true);
                acc[2 * q] = lo * w2 + acc[2 * q]; acc[2 * q + 1] = hi * w2 + acc[2 * q + 1];
            }
        }
        f32x2 a4[4], a2[2], a1;
#pragma unroll
        for (int m = 0; m < 4; ++m) { const f32x2 keep = b3 ? acc[4 + m] : acc[m], send = b3 ? acc[m] : acc[4 + m]; a4[m] = (f32x2){keep.x + dpp_xor8(send.x), keep.y + dpp_xor8(send.y)}; }
#pragma unroll
        for (int m = 0; m < 2; ++m) { const f32x2 keep = b4 ? a4[2 + m] : a4[m], send = b4 ? a4[m] : a4[2 + m]; a2[m] = (f32x2){keep.x + swz_xor16(send.x), keep.y + swz_xor16(send.y)}; }
        { const f32x2 keep = b5 ? a2[1] : a2[0], send = b5 ? a2[0] : a2[1]; a1 = (f32x2){keep.x + __shfl_xor(send.x, 32), keep.y + __shfl_xor(send.y, 32)}; }
        const int c0 = 8 * (int)b3 + 4 * (int)b4 + 2 * (int)b5;
        *(unsigned*)(ffn + (size_t)t * 1024 + 128 * x + 16 * j + c0) = pk_bf16(a1.x, a1.y);
    };
    PeerBuf A, Bb;
    int t = wl;
    if (t >= M_TOK) return;
    i32x16 idn;
    load_ids(idn, t);
    issue(A, t, idn);
    load_ids(idn, tok(t + NW));
    for (; t < M_TOK; t += 2 * NW) {
        issue(Bb, tok(t + NW), idn);
        load_ids(idn, tok(t + 2 * NW));
        compute(A, t);
        issue(A, tok(t + 2 * NW), idn);
        load_ids(idn, tok(t + 3 * NW));
        if (t + NW < M_TOK) compute(Bb, t + NW);
    }
}
__device__ __forceinline__ void phase_ln2(const Params& p, const bf16_t* ffn) {
    const int lane = threadIdx.x & 63, gw = blockIdx.x * (NTHREADS / 64) + (threadIdx.x >> 6), GW = gridDim.x * (NTHREADS / 64);
    for (int m0 = gw * 2; m0 < M_TOK; m0 += GW * 2) {
        float4 a[2][4]; u32x2 f[2][4]; float2 st[2];
#pragma unroll
        for (int rr = 0; rr < 2; ++rr) {
            st[rr] = *(const float2*)(p.ln1_stats + (size_t)(m0 + rr) * 2);
#pragma unroll
            for (int j = 0; j < 4; ++j) { a[rr][j] = *(const float4*)(p.out + (size_t)(m0 + rr) * D_MODEL + j * 256 + lane * 4); f[rr][j] = *(const u32x2*)(ffn + (size_t)(m0 + rr) * D_MODEL + j * 256 + lane * 4); }
        }
#pragma unroll
        for (int rr = 0; rr < 2; ++rr) {
            float* row = p.out + (size_t)(m0 + rr) * D_MODEL;
            float4 v[4]; float s = 0.f;
#pragma unroll
            for (int j = 0; j < 4; ++j) {
                const float4 g1 = *(const float4*)(p.ln1_g + j * 256 + lane * 4), b1 = *(const float4*)(p.ln1_b + j * 256 + lane * 4);
                v[j] = make_float4(ALPHA * ((a[rr][j].x - st[rr].x) * st[rr].y * g1.x + b1.x) + bflo(f[rr][j].x), ALPHA * ((a[rr][j].y - st[rr].x) * st[rr].y * g1.y + b1.y) + bfhi(f[rr][j].x),
                                   ALPHA * ((a[rr][j].z - st[rr].x) * st[rr].y * g1.z + b1.z) + bflo(f[rr][j].y), ALPHA * ((a[rr][j].w - st[rr].x) * st[rr].y * g1.w + b1.w) + bfhi(f[rr][j].y));
                s += (v[j].x + v[j].y) + (v[j].z + v[j].w);
            }
            const float mean = wave_sum(s) * (1.f / D_MODEL); float q = 0.f;
#pragma unroll
            for (int j = 0; j < 4; ++j) { v[j].x -= mean; v[j].y -= mean; v[j].z -= mean; v[j].w -= mean; q += (v[j].x * v[j].x + v[j].y * v[j].y) + (v[j].z * v[j].z + v[j].w * v[j].w); }
            const float rstd = rsqrtf(wave_sum(q) * (1.f / D_MODEL) + LN_EPS);
#pragma unroll
            for (int j = 0; j < 4; ++j) {
                const float4 g = *(const float4*)(p.ln2_g + j * 256 + lane * 4), bb = *(const float4*)(p.ln2_b + j * 256 + lane * 4);
                *(float4*)(row + j * 256 + lane * 4) = make_float4(v[j].x * rstd * g.x + bb.x, v[j].y * rstd * g.y + bb.y, v[j].z * rstd * g.z + bb.z, v[j].w * rstd * g.w + bb.w);
            }
        }
    }
}

constexpr int N_PHASES = 14;
__global__ void __launch_bounds__(NTHREADS) mega_fwd(Params p) {
    __shared__ __attribute__((aligned(1024))) unsigned char smem[SMEM_BYTES + 16];
    if (threadIdx.x == 0) *(uint4*)(smem + SMEM_BYTES) = make_uint4(0u, 0u, 0u, 0u);
    __syncthreads();
    XcdBarrier bar; bar.bar = p.bar; bar.x = 0; bar.st = (volatile LAS unsigned*)(smem + SMEM_BYTES);
    if (p.ph_hi - p.ph_lo > 1) bar = xcd_barrier_post(p.bar, (volatile LAS unsigned*)(smem + SMEM_BYTES));
    bf16_t* qb = p.proj_b;
    bf16_t* x1b = p.proj_b + (size_t)M_TOK * 2048;
#ifndef DUP_PHASE
#define DUP_PHASE -1
#endif
#define PH(k) (p.ph_lo <= (k) && (k) < p.ph_hi)
#define SYNC(k) do { if (PH(k) && PH((k) + 1)) xcd_barrier(bar); } while (0)
#define RUN(k, ...) do { if (PH(k)) { __VA_ARGS__; if (DUP_PHASE == (k)) { xcd_barrier(bar); __VA_ARGS__; } } SYNC(k); } while (0)
    float* ph = (float*)qb;
    RUN(0, phase_prep(p, smem));
    RUN(1, { EpiInProj e{p.proj_b, p.rope_cs}; gemm_phase(p.xb, p.wt_in, M_TOK, NP_IN, e, smem); });
    RUN(2, phase_dn_prep(p, smem));
    RUN(3, { if (blockIdx.x < 96) { const int j = blockIdx.x, rem = j % 6; dn_scan_seg<1>(p, smem, j / 6, rem >> 1, rem & 1); } else { phase_attn(p, smem, 96); } });
    RUN(4, { if (blockIdx.x < 64) dn_scan_seg<0>(p, smem, blockIdx.x >> 2, blockIdx.x & 3, 0); else { phase_scan_l2_helper(p); phase_tables8(p, 64); } });
    RUN(5, phase_dn_norm(p));
    RUN(6, { EpiOutProj e{p.out, p.x}; gemm_phase(p.xb, p.wt_out, M_TOK, 1024, e, smem); });
    RUN(7, phase_ln1(p, x1b));
    RUN(8, { EpiBf16 e{qb, 2048}; gemm_phase(x1b, p.wt_q, M_TOK, 2048, e, smem); });
    RUN(9, phase_route(p, qb));
    RUN(10, phase_peer_u(p, x1b, ph));
    RUN(11, phase_peer_w(p, ph, p.wbuf));
    RUN(12, phase_peer_v(p, p.wbuf, (bf16_t*)ph));
    RUN(13, phase_ln2(p, (const bf16_t*)ph));
#undef RUN
#undef SYNC
#undef PH
}
}

#ifndef MK_LAUNCHES
#define MK_LAUNCHES 1
#endif

extern "C" void kernel_launch(void* const* d_in, const int* in_sizes, int n_in, void* d_out, int out_size, void* d_ws, size_t ws_size, hipStream_t stream) {
    static int grid_blocks = 0;
    if (!grid_blocks) {
        int dev = 0, cus = 0, per_cu = 0;
        (void)hipGetDevice(&dev);
        (void)hipDeviceGetAttribute(&cus, hipDeviceAttributeMultiprocessorCount, dev);
        (void)hipOccupancyMaxActiveBlocksPerMultiprocessor(&per_cu, mega_fwd, NTHREADS, 0);
        if (per_cu < 1) { fprintf(stderr, "kernel_launch: occupancy query reports %d blocks per CU\n", per_cu); per_cu = 1; }
        grid_blocks = cus * 1;
        (void)hipGetLastError();
    }
    Params p{};
    p.x = (const float*)d_in[0]; p.positions = (const int*)d_in[1]; p.w_in = (const float*)d_in[2]; p.sinks = (const float*)d_in[3];
    p.conv_w = (const float*)d_in[4]; p.a_log = (const float*)d_in[5]; p.dt_bias = (const float*)d_in[6]; p.dn_norm_g = (const float*)d_in[7];
    p.w_out = (const float*)d_in[8]; p.ln1_g = (const float*)d_in[9]; p.ln1_b = (const float*)d_in[10]; p.w_query = (const float*)d_in[11];
    p.sub_keys = (const float*)d_in[12]; p.peer_u = (const float*)d_in[13]; p.peer_v = (const float*)d_in[14]; p.ln2_g = (const float*)d_in[15]; p.ln2_b = (const float*)d_in[16];
    p.out = (float*)d_out;
    char* ws = (char*)d_ws; size_t off = 0;
    auto take = [&](size_t bytes) { char* r = ws + off; off += (bytes + 255) & ~(size_t)255; return r; };
    p.xb = (bf16_t*)take((size_t)M_TOK * 1024 * 2);
    p.proj_b = (bf16_t*)take((size_t)M_TOK * NP_IN * 2);
    p.odn_raw = (bf16_t*)d_out;
    {
        char* dn = take((size_t)2048 * (16384 * 3 + 8192 + 32768) + 8192);
        p.ids = (int*)dn; p.gates = (float*)(dn + (size_t)M_TOK * 128 * 4);
        p.wbuf = (float*)(dn + (size_t)M_TOK * 128 * 8);
        p.dn_negw = (bf16_t*)dn; p.dn_qd = (bf16_t*)(dn + (size_t)2048 * 16384); p.dn_kdt = (bf16_t*)(dn + (size_t)2048 * 16384 * 2);
        p.dn_qk = (bf16_t*)(dn + (size_t)2048 * 16384 * 3); p.dn_u = (bf16_t*)(dn + (size_t)2048 * (16384 * 3 + 8192)); p.dn_gl = (float*)(dn + (size_t)2048 * (16384 * 3 + 8192 + 32768));
    }
    p.wt_in = (bf16_t*)take((size_t)NP_IN * 1024 * 2);
    p.wt_out = (bf16_t*)take((size_t)1024 * 1024 * 2);
    p.wt_q = (bf16_t*)take((size_t)2048 * 1024 * 2);
    p.rope_cs = (float*)take((size_t)M_TOK * 64 * 4);
    p.sk_frag = (bf16_t*)take((size_t)16 * 128 * 128 * 2);
    p.tab8 = (unsigned char*)take((size_t)2 * 16384 * 1024);
    p.isc = (float*)take((size_t)2 * 16384 * 4);
    p.ln1_stats = (float*)take((size_t)M_TOK * 2 * 4);
    p.dn_PB = (float*)take((size_t)48 * 128 * 256 * 4);
    p.dn_S0 = (float*)take((size_t)64 * 128 * 128 * 4);
    p.bar = (unsigned*)take((size_t)(XCD_BAR_WORDS + 16 * 64) * 4);
    if (off > ws_size) { fprintf(stderr, "kernel_launch: workspace too small (%zu < %zu)\n", ws_size, off); return; }
    if (hipMemsetAsync(p.bar, 0, (size_t)(XCD_BAR_WORDS + 16 * 64) * 4, stream) != hipSuccess) { fprintf(stderr, "kernel_launch: memset of barrier words failed\n"); return; }
#if MK_LAUNCHES == 1
    p.ph_lo = 0; p.ph_hi = N_PHASES;
    void* args[] = {&p};
    hipError_t e = hipLaunchCooperativeKernel((void*)mega_fwd, dim3(grid_blocks), dim3(NTHREADS), args, 0, stream);
    if (e != hipSuccess) fprintf(stderr, "cooperative launch failed: %s (grid %d)\n", hipGetErrorString(e), grid_blocks);
#else
    for (int k = 0; k < N_PHASES; ++k) { p.ph_lo = k; p.ph_hi = k + 1; hipLaunchKernelGGL(mega_fwd, dim3(grid_blocks), dim3(NTHREADS), 0, stream, p); }
#endif
}
```

```cpp
#include <hip/hip_runtime.h>
#include <cstdio>
#include <cstdint>
#include <math.h>

namespace {
constexpr int D_MODEL = 1024, BATCH = 4, SEQ = 8192, M_TOK = BATCH * SEQ;
constexpr int IN_WIDTH = 2824, NP_IN = 3072;
constexpr int P_AQ = 0, P_AK = 512, P_AV = 640, P_DQ = 768, P_DK = 1280, P_DV = 1792, P_Z = 2304, P_B = 2816, P_A = 2820;
constexpr float ALPHA = 1.189207115002721f;
constexpr float LN_EPS = 1e-5f, RMS_EPS = 1e-6f, L2_EPS = 1e-6f;
constexpr int NTHREADS = 512;

typedef unsigned short bf16_t;
typedef short bf16x8 __attribute__((ext_vector_type(8)));
typedef float f32x16 __attribute__((ext_vector_type(16)));
typedef float f32x4 __attribute__((ext_vector_type(4)));
typedef unsigned u32x4 __attribute__((ext_vector_type(4)));
typedef unsigned u32x2 __attribute__((ext_vector_type(2)));

struct Params {
    const float* x; const int* positions; const float* w_in; const float* sinks; const float* conv_w; const float* a_log; const float* dt_bias;
    const float* dn_norm_g; const float* w_out; const float* ln1_g; const float* ln1_b; const float* w_query; const float* sub_keys;
    const float* peer_u; const float* peer_v; const float* ln2_g; const float* ln2_b;
    float* out;
    bf16_t* xb;
    bf16_t* proj_b;
    bf16_t* odn_raw;
    int* ids; float* gates;
    bf16_t* wt_in; bf16_t* wt_out; bf16_t* wt_q;
    float* rope_cs;
    bf16_t* dn_negw; bf16_t* dn_qd; bf16_t* dn_kdt; bf16_t* dn_qk; bf16_t* dn_u; float* dn_gl; float* dn_PB; float* dn_S0;
    bf16_t* sk_frag;
    float* ln1_stats;
    unsigned char* tab8; float* isc; float* wbuf;
    unsigned* bar;
    int ph_lo, ph_hi;
};

__device__ __forceinline__ float wave_sum(float v) {
#pragma unroll
    for (int o = 1; o < 64; o <<= 1) v += __shfl_xor(v, o);
    return v;
}
__device__ __forceinline__ float wave_max(float v) {
#pragma unroll
    for (int o = 1; o < 64; o <<= 1) v = fmaxf(v, __shfl_xor(v, o));
    return v;
}
__device__ __forceinline__ float bf2f(bf16_t u) { return __uint_as_float((unsigned)u << 16); }
__device__ __forceinline__ float bflo(unsigned u) { return __uint_as_float(u << 16); }
__device__ __forceinline__ float bfhi(unsigned u) { return __uint_as_float(u & 0xffff0000u); }
typedef __bf16 bf16x2_n __attribute__((ext_vector_type(2)));
__device__ __forceinline__ unsigned pk_bf16(float lo, float hi) { bf16x2_n v; v.x = (__bf16)lo; v.y = (__bf16)hi; return __builtin_bit_cast(unsigned, v); }
__device__ __forceinline__ float silu_f(float y) { return y * __builtin_amdgcn_rcpf(1.f + __expf(-y)); }


#define XB_TMO      128
#define XB_XCNT(j)  (256  + 64 * (j))
#define XB_XSUB(j)  (1280 + 64 * (j))
#define XB_XGEN(j)  (2304 + 64 * (j))
#define XB_TOP      3328
#define XB_TOPGEN   3392
#define XCD_BAR_WORDS 3456
#define XB_SPIN_CAP (1u << 27)
#define LAS __attribute__((address_space(3)))
__device__ __forceinline__ unsigned xb_ld(unsigned* p)              { return __hip_atomic_load(p, __ATOMIC_RELAXED, __HIP_MEMORY_SCOPE_AGENT); }
__device__ __forceinline__ unsigned xb_add(unsigned* p, unsigned v) { return __hip_atomic_fetch_add(p, v, __ATOMIC_RELAXED, __HIP_MEMORY_SCOPE_AGENT); }
__device__ __forceinline__ unsigned xb_xcc_id() { return (unsigned)__builtin_amdgcn_s_getreg((3 << 11) | 20) & 0xFu; }
#define XB_SPIN(cond, bar) do { unsigned _sp = 0; while (cond) { __builtin_amdgcn_s_sleep(1); \
    if ((++_sp & 255u) == 0u) { if (xb_ld(&(bar)[XB_TMO])) break; if (_sp > XB_SPIN_CAP) { atomicAdd(&(bar)[XB_TMO], 1u); break; } } } } while (0)
struct XcdBarrier { unsigned* bar; unsigned x; volatile LAS unsigned* st; };
__device__ __forceinline__ XcdBarrier xcd_barrier_post(unsigned* bar, volatile LAS unsigned* st) {
    XcdBarrier b; b.bar = bar; b.x = xb_xcc_id(); b.st = st;
    if (threadIdx.x == 0) (void)xb_add(&bar[XB_XCNT(b.x)], 1u);
    return b;
}
__device__ __forceinline__ void xcd_barrier_complete(unsigned* bar, unsigned x, unsigned& nloc, unsigned& nx) {
    const unsigned G = gridDim.x * gridDim.y * gridDim.z;
    unsigned sum, cnt, mine, sp = 0u;
    for (;;) {
        sum = 0u; cnt = 0u; mine = 0u;
#pragma unroll
        for (unsigned j = 0; j < 16; ++j) { const unsigned c = xb_ld(&bar[XB_XCNT(j)]); sum += c; cnt += (c > 0u) ? 1u : 0u; mine = (j == x) ? c : mine; }
        if (sum == G) break;
        __builtin_amdgcn_s_sleep(1);
        if ((++sp & 255u) == 0u) { if (xb_ld(&bar[XB_TMO])) break; if (sp > XB_SPIN_CAP) { atomicAdd(&bar[XB_TMO], 1u); break; } }
    }
    nloc = mine > 0u ? mine : 1u; nx = cnt > 0u ? cnt : 1u;
}
__device__ __forceinline__ void xcd_barrier(const XcdBarrier& b) {
    asm volatile("s_waitcnt vmcnt(0)" ::: "memory");
    __syncthreads();
    if (threadIdx.x == 0) {
        unsigned* bar = b.bar;
        __builtin_amdgcn_s_waitcnt(0);
        unsigned nloc = b.st[0], nx = b.st[1];
        if (nloc == 0u) { xcd_barrier_complete(bar, b.x, nloc, nx); b.st[0] = nloc; b.st[1] = nx; }
        const unsigned old = xb_add(&bar[XB_XSUB(b.x)], 1u);
        const unsigned gen = old / nloc;
        if (old + 1u == (gen + 1u) * nloc) {
            __builtin_amdgcn_fence(__ATOMIC_RELEASE, "agent");
            asm volatile("s_waitcnt vmcnt(0)" ::: "memory");
            const unsigned og = xb_add(&bar[XB_TOP], 1u);
            const unsigned tg = og / nx;
            if (og + 1u == (tg + 1u) * nx) xb_add(&bar[XB_TOPGEN], 1u);
            else XB_SPIN(xb_ld(&bar[XB_TOPGEN]) == tg, bar);
            __builtin_amdgcn_fence(__ATOMIC_ACQUIRE, "agent");
            xb_add(&bar[XB_XGEN(b.x)], 1u);
            asm volatile("s_waitcnt vmcnt(0)" ::: "memory");
        } else {
            XB_SPIN(xb_ld(&bar[XB_XGEN(b.x)]) == gen, bar);
            __builtin_amdgcn_fence(__ATOMIC_ACQUIRE, "agent");
            asm volatile("s_waitcnt vmcnt(0)" ::: "memory");
        }
    }
    __syncthreads();
}

__device__ __forceinline__ int inproj_old_col(int n) {
    if (n < 2304) return n;
    if (n < 2816) return 2312 + (n - 2304);
    if (n < 2824) return 2304 + (n - 2816);
    return -1;
}
__device__ __forceinline__ void transpose_item(const float* __restrict__ W, int N_src, bf16_t* __restrict__ WT, int K, int kb, int nb, bool permute, float* scr) {
    const int tid = threadIdx.x;
    const int nn = tid & 63, k8 = tid >> 6;
    const int n = nb * 64 + nn;
    const int oc = permute ? inproj_old_col(n) : n;
#pragma unroll
    for (int i = 0; i < 8; ++i) { const int kk = k8 + 8 * i; scr[kk * 65 + nn] = (oc >= 0) ? W[(size_t)(kb * 64 + kk) * N_src + oc] : 0.f; }
    __syncthreads();
    const int n2 = tid >> 3, c = tid & 7;
    const float* s = scr + (c * 8) * 65 + n2;
    u32x4 o; o.x = pk_bf16(s[0], s[65]); o.y = pk_bf16(s[2 * 65], s[3 * 65]); o.z = pk_bf16(s[4 * 65], s[5 * 65]); o.w = pk_bf16(s[6 * 65], s[7 * 65]);
    *(u32x4*)(WT + (size_t)(nb * 64 + n2) * K + kb * 64 + c * 8) = o;
    __syncthreads();
}
__device__ __forceinline__ void phase_prep(const Params& p, unsigned char* smem) {
    const int tid = threadIdx.x, G = gridDim.x, bid = blockIdx.x;
    float* scr = (float*)smem;
    constexpr int I_IN = 16 * (NP_IN / 64), I_OUT = 16 * 16, I_Q = 16 * 32;
    for (int it = bid; it < I_IN + I_OUT + I_Q; it += G) {
        int r = it;
        if (r < I_IN) { transpose_item(p.w_in, IN_WIDTH, p.wt_in, 1024, r / (NP_IN / 64), r % (NP_IN / 64), true, scr); continue; } r -= I_IN;
        if (r < I_OUT) { transpose_item(p.w_out, 1024, p.wt_out, 1024, r / 16, r % 16, false, scr); continue; } r -= I_OUT;
        transpose_item(p.w_query, 2048, p.wt_q, 1024, r / 32, r % 32, false, scr);
    }
    const size_t gt = (size_t)bid * NTHREADS + tid, GT = (size_t)G * NTHREADS;
    for (size_t i0 = gt; i0 < (size_t)M_TOK * 1024 / 8; i0 += GT * 4) {
        float4 a[4], b[4];
#pragma unroll
        for (int u = 0; u < 4; ++u) { const size_t i = i0 + u * GT; if (i < (size_t)M_TOK * 1024 / 8) { a[u] = *(const float4*)(p.x + i * 8); b[u] = *(const float4*)(p.x + i * 8 + 4); } }
#pragma unroll
        for (int u = 0; u < 4; ++u) { const size_t i = i0 + u * GT; if (i < (size_t)M_TOK * 1024 / 8) {
            u32x4 o; o.x = pk_bf16(a[u].x, a[u].y); o.y = pk_bf16(a[u].z, a[u].w); o.z = pk_bf16(b[u].x, b[u].y); o.w = pk_bf16(b[u].z, b[u].w);
            *(u32x4*)(p.xb + i * 8) = o; } }
    }
    for (size_t i = gt; i < (size_t)16 * 4 * 8 * 64; i += GT) {
        const int ln = (int)(i & 63), ks = (int)((i >> 6) & 7), kt = (int)((i >> 9) & 3), hp = (int)(i >> 11);
        const float* src = p.sub_keys + ((size_t)(hp * 128 + 32 * kt + (ln & 31))) * 128 + 16 * ks + 8 * (ln >> 5);
        const float4 a = *(const float4*)src, b = *(const float4*)(src + 4);
        u32x4 o; o.x = pk_bf16(a.x, a.y); o.y = pk_bf16(a.z, a.w); o.z = pk_bf16(b.x, b.y); o.w = pk_bf16(b.z, b.w);
        *(u32x4*)(p.sk_frag + i * 8) = o;
    }
    for (size_t i = gt; i < (size_t)M_TOK * 32; i += GT) {
        const int m = (int)(i >> 5), j = (int)(i & 31);
        const float inv_freq = powf(10000.0f, -(float)j / 32.0f);
        const float ang = (float)p.positions[m] * inv_freq;
        p.rope_cs[i] = cosf(ang); p.rope_cs[(size_t)M_TOK * 32 + i] = sinf(ang);
    }
}

constexpr int GK = 1024, GBK = 64, G_TILE_BYTES = 256 * 128;
constexpr int STG_STRIDE = 260;
constexpr int SMEM_BYTES = 147456;

__device__ __forceinline__ int swz(int row, int chunk) { return row * 128 + ((chunk ^ ((row >> 1) & 7)) << 4); }

struct EpiInProj {
    bf16_t* out; const float* cs;
    __device__ __forceinline__ void operator()(int m, int pn, int c8, const unsigned char* stg_row) const {
        const int col = pn * 256 + c8 * 8;
        u32x2 a0 = *(const u32x2*)(stg_row + c8 * 16), a1 = *(const u32x2*)(stg_row + c8 * 16 + 8);
        u32x4 o; o.x = a0.x; o.y = a0.y; o.z = a1.x; o.w = a1.y;
        if (col < P_AV) {
            const int d0 = col & 63, i0 = d0 & 31; const bool second = d0 >= 32;
            const int pc8 = second ? c8 - 4 : c8 + 4;
            const u32x2 b0 = *(const u32x2*)(stg_row + pc8 * 16), b1 = *(const u32x2*)(stg_row + pc8 * 16 + 8);
            const unsigned mine[4] = {a0.x, a0.y, a1.x, a1.y}, oth[4] = {b0.x, b0.y, b1.x, b1.y};
            const float* cp = cs + (size_t)m * 32 + i0; const float* sp = cs + (size_t)M_TOK * 32 + (size_t)m * 32 + i0;
            const float4 c0 = *(const float4*)cp, c1 = *(const float4*)(cp + 4), s0 = *(const float4*)sp, s1 = *(const float4*)(sp + 4);
            const float cc[8] = {c0.x, c0.y, c0.z, c0.w, c1.x, c1.y, c1.z, c1.w}, ss[8] = {s0.x, s0.y, s0.z, s0.w, s1.x, s1.y, s1.z, s1.w};
            const float scale = col < P_AK ? 0.125f : 1.f;
            float r[8];
#pragma unroll
            for (int j = 0; j < 8; ++j) {
                const float me = (j & 1) ? bfhi(mine[j >> 1]) : bflo(mine[j >> 1]);
                const float ot = (j & 1) ? bfhi(oth[j >> 1]) : bflo(oth[j >> 1]);
                r[j] = (second ? (me * cc[j] + ot * ss[j]) : (me * cc[j] - ot * ss[j])) * scale;
            }
            o.x = pk_bf16(r[0], r[1]); o.y = pk_bf16(r[2], r[3]); o.z = pk_bf16(r[4], r[5]); o.w = pk_bf16(r[6], r[7]);
        }
        *(u32x4*)(out + (size_t)m * NP_IN + col) = o;
    }
};
struct EpiOutProj {
    float* y; const float* x;
    __device__ __forceinline__ void operator()(int m, int pn, int c8, const unsigned char* stg_row) const {
        const int col = pn * 256 + c8 * 8;
        const u32x2 a0 = *(const u32x2*)(stg_row + c8 * 16), a1 = *(const u32x2*)(stg_row + c8 * 16 + 8);
        const float4 x0 = *(const float4*)(x + (size_t)m * 1024 + col), x1 = *(const float4*)(x + (size_t)m * 1024 + col + 4);
        *(float4*)(y + (size_t)m * 1024 + col) = make_float4(ALPHA * x0.x + bflo(a0.x), ALPHA * x0.y + bfhi(a0.x), ALPHA * x0.z + bflo(a0.y), ALPHA * x0.w + bfhi(a0.y));
        *(float4*)(y + (size_t)m * 1024 + col + 4) = make_float4(ALPHA * x1.x + bflo(a1.x), ALPHA * x1.y + bfhi(a1.x), ALPHA * x1.z + bflo(a1.y), ALPHA * x1.w + bfhi(a1.y));
    }
};
struct EpiBf16 {
    bf16_t* out; int ldc;
    __device__ __forceinline__ void operator()(int m, int pn, int c8, const unsigned char* stg_row) const {
        const int col = pn * 256 + c8 * 8;
        const u32x2 a0 = *(const u32x2*)(stg_row + c8 * 16), a1 = *(const u32x2*)(stg_row + c8 * 16 + 8);
        u32x4 o; o.x = a0.x; o.y = a0.y; o.z = a1.x; o.w = a1.y;
        *(u32x4*)(out + (size_t)m * ldc + col) = o;
    }
};

template <class EPI>
__device__ __forceinline__ void gemm_phase(const bf16_t* __restrict__ A, const bf16_t* __restrict__ Bt, int M, int N, const EPI& epi, unsigned char* smem) {
    const int tid = threadIdx.x, lane = tid & 63, wave = tid >> 6, r = lane & 31, h = lane >> 5;
    const int wm = wave >> 2, wn = wave & 3;
    const int nM = M / 256, nN = N / 256, ntiles = nM * nN;
    const int gx = gridDim.x, nxg = (gx % 8 == 0 && ntiles % 8 == 0) ? 8 : 1, bpg = gx / nxg, tpg = ntiles / nxg;
    const int grp = blockIdx.x % nxg, bin = blockIdx.x / nxg;
    const int grow = 16 * wave + (lane >> 2), gch = (lane & 3) ^ ((grow >> 2) & 3);
    const unsigned goff = (unsigned)(grow * GK + gch * 8) * 2u;
    constexpr int NKT = GK / 32, STG = 32768;
#define G_DMA1(kt_, Ag_, Bg_, op_, i_) do { const unsigned char* sb_ = (const unsigned char*)((op_) ? (Bg_) : (Ag_)) + (kt_) * 64; \
            __builtin_amdgcn_global_load_lds((const unsigned*)(sb_ + (i_) * (128 * GK * 2) + goff), (unsigned*)(smem + ((kt_) & 3) * STG + wave * 1024 + (op_) * 16384 + (i_) * 8192), 16, 0, 0); } while (0)
#define G_STAGE(kt_, Ag_, Bg_) do { G_DMA1(kt_, Ag_, Bg_, 0, 0); G_DMA1(kt_, Ag_, Bg_, 1, 0); G_DMA1(kt_, Ag_, Bg_, 0, 1); G_DMA1(kt_, Ag_, Bg_, 1, 1); } while (0)
#define G_SWZ32(row_, c_) ((row_) * 64 + ((((c_) ^ ((row_) >> 2)) & 3) << 4))
#define G_COMPUTE(kt_, Ag_, Bg_, pf_) do { const unsigned char* la_ = smem + ((kt_) & 3) * STG; const unsigned char* lb_ = la_ + 16384; \
            bf16x8 af_[2][4], bf_[2][2]; \
            _Pragma("unroll") for (int ks_ = 0; ks_ < 2; ++ks_) { \
                _Pragma("unroll") for (int i_ = 0; i_ < 4; ++i_) af_[ks_][i_] = *(const bf16x8*)(la_ + G_SWZ32(wm * 128 + i_ * 32 + r, ks_ * 2 + h)); \
                _Pragma("unroll") for (int j_ = 0; j_ < 2; ++j_) bf_[ks_][j_] = *(const bf16x8*)(lb_ + G_SWZ32(wn * 64 + j_ * 32 + r, ks_ * 2 + h)); } \
            __builtin_amdgcn_sched_barrier(0); \
            _Pragma("unroll") for (int g_ = 0; g_ < 4; ++g_) { const int ks_ = g_ >> 1, j_ = g_ & 1; \
                _Pragma("unroll") for (int i_ = 0; i_ < 4; ++i_) acc[j_][i_] = __builtin_amdgcn_mfma_f32_32x32x16_bf16(bf_[ks_][j_], af_[ks_][i_], acc[j_][i_], 0, 0, 0); \
                __builtin_amdgcn_sched_barrier(0); \
                if (pf_) G_DMA1((kt_) + 3, Ag_, Bg_, g_ & 1, g_ >> 1); \
                __builtin_amdgcn_sched_barrier(0); } } while (0)
#define G_RAWBAR() do { asm volatile("s_waitcnt lgkmcnt(0)" ::: "memory"); __builtin_amdgcn_s_barrier(); asm volatile("" ::: "memory"); } while (0)
    for (int tt = bin; tt < tpg; tt += bpg) {
        const int t = grp * tpg + tt;
        const int pm = t / nN, pn = t % nN;
        const bf16_t* Ag = A + (size_t)pm * 256 * GK; const bf16_t* Bg = Bt + (size_t)pn * 256 * GK;
        f32x16 acc[2][4];
#pragma unroll
        for (int j = 0; j < 2; ++j)
#pragma unroll
            for (int i = 0; i < 4; ++i)
#pragma unroll
                for (int e = 0; e < 16; ++e) acc[j][i][e] = 0.f;
        G_RAWBAR();
        G_STAGE(0, Ag, Bg); G_STAGE(1, Ag, Bg); G_STAGE(2, Ag, Bg);
        for (int kt = 0; kt < NKT; ++kt) {
            if (kt + 2 < NKT) asm volatile("s_waitcnt vmcnt(8)" ::: "memory");
            else if (kt + 1 < NKT) asm volatile("s_waitcnt vmcnt(4)" ::: "memory");
            else asm volatile("s_waitcnt vmcnt(0)" ::: "memory");
            G_RAWBAR();
            G_COMPUTE(kt, Ag, Bg, kt + 3 < NKT);
        }
        G_RAWBAR();
#pragma unroll
        for (int j = 0; j < 2; ++j)
#pragma unroll
            for (int i = 0; i < 4; ++i)
#pragma unroll
                for (int g = 0; g < 4; ++g) {
                    u32x2 v; v.x = pk_bf16(acc[j][i][4 * g], acc[j][i][4 * g + 1]); v.y = pk_bf16(acc[j][i][4 * g + 2], acc[j][i][4 * g + 3]);
                    *(u32x2*)(smem + (size_t)(wm * 128 + i * 32 + r) * (STG_STRIDE * 2) + (wn * 64 + j * 32 + 8 * g + 4 * h) * 2) = v;
                }
        __syncthreads();
        const int erow = tid >> 5, ec8 = tid & 31;
#pragma unroll 4
        for (int ps = 0; ps < 16; ++ps) { const int row = ps * 16 + erow; epi(pm * 256 + row, pn, ec8, smem + (size_t)row * (STG_STRIDE * 2)); }
    }
#undef G_DMA1
#undef G_STAGE
#undef G_COMPUTE
#undef G_SWZ32
#undef G_RAWBAR
    __syncthreads();
}


constexpr int DN_CH_BYTES = 73728;

constexpr int DP_QS = 0, DP_KS = 16384, DP_TI = 0, DP_Q = 17408, DP_TB = 21632;
constexpr int DP_RT = 32768;
constexpr int DP_AM = 69632;
constexpr int DP_KDT = 87040;
constexpr int DP_QK = 104448;
constexpr int DP_WI = 113152;
constexpr int DP_SM = 130048;

__device__ __forceinline__ void phase_dn_prep(const Params& p, unsigned char* smem) {
    const int tid0 = threadIdx.x;
    float* sbeta = (float*)(smem + DP_SM); float* sgc = sbeta + 64; float* segc = sbeta + 128; float* sekd = sbeta + 192;
    float* Am = (float*)(smem + DP_AM); float* Ti = (float*)(smem + DP_TI); float* Qb = (float*)(smem + DP_Q);
    bf16_t* Tb = (bf16_t*)(smem + DP_TB); bf16_t* Rt = (bf16_t*)(smem + DP_RT);
    bf16_t* kdt = (bf16_t*)(smem + DP_KDT); bf16_t* qki = (bf16_t*)(smem + DP_QK); bf16_t* wim = (bf16_t*)(smem + DP_WI);
    u32x4 xin[7][2]; float pre_b = 0.f, pre_a = 0.f;
    auto dn_fetch = [&](int cj) {
        const int tq = tid0, bhj = cj >> 7, nj = cj & 127, hj = bhj & 3;
        const bf16_t* prj = p.proj_b + (size_t)(bhj >> 2) * SEQ * NP_IN;
        if (tq < 384) {
            const int mat = tq >> 7, rg = (tq >> 3) & 15, sg = tq & 7;
            const int colbase = (mat == 0 ? P_DQ : (mat == 1 ? P_DK : P_DV)) + hj * 128 + sg * 16;
#pragma unroll
            for (int rr = 0; rr < 7; ++rr) {
                const int tt = nj * 64 + 4 * rg - 3 + rr;
                if (tt >= 0) { xin[rr][0] = *(const u32x4*)(prj + (size_t)tt * NP_IN + colbase); xin[rr][1] = *(const u32x4*)(prj + (size_t)tt * NP_IN + colbase + 8); }
                else { xin[rr][0] = (u32x4){0u, 0u, 0u, 0u}; xin[rr][1] = (u32x4){0u, 0u, 0u, 0u}; }
            }
        }
        if (tq < 64) { const size_t m = (size_t)(nj * 64 + tq); pre_b = bf2f(prj[m * NP_IN + P_B + hj]); pre_a = bf2f(prj[m * NP_IN + P_A + hj]); }
    };
    if (blockIdx.x < 16 * 128) dn_fetch(blockIdx.x);
    for (int ci = blockIdx.x; ci < 16 * 128; ci += gridDim.x) {
        int tid = tid0; asm volatile("" : "+v"(tid));
        const int lane = tid & 63, wave = tid >> 6;
        const int bh = ci >> 7, n = ci & 127, b = bh >> 2, h = bh & 3;
        const bf16_t* prow = p.proj_b + (size_t)b * SEQ * NP_IN;
        if (wave == 0) {
            const float braw = pre_b, araw = pre_a;
            const float beta = 1.f / (1.f + expf(-braw));
            const float xx = araw + p.dt_bias[h];
            const float sp = xx > 20.f ? xx : log1pf(expf(xx));
            float g = -expf(p.a_log[h]) * sp;
#pragma unroll
            for (int o = 1; o < 64; o <<= 1) { const float up = __shfl_up(g, o); if (lane >= o) g += up; }
            const float g63 = __shfl(g, 63);
            sbeta[lane] = beta; sgc[lane] = g; segc[lane] = expf(g); sekd[lane] = expf(g63 - g);
            if (lane == 63) p.dn_gl[ci] = expf(g63);
        }
        __syncthreads();
        if (tid < 384) {
            const int mat = tid >> 7, rg = (tid >> 3) & 15, sg = tid & 7, c0 = sg * 16, i0 = 4 * rg;
            const int colbase = (mat == 0 ? P_DQ : (mat == 1 ? P_DK : P_DV)) + h * 128 + c0;
            float wgt[4][16];
#pragma unroll
            for (int j = 0; j < 4; ++j) {
                const float* wp = p.conv_w + j * 1536 + mat * 512 + h * 128 + c0;
#pragma unroll
                for (int q4 = 0; q4 < 4; ++q4) { const float4 w4 = *(const float4*)(wp + 4 * q4); wgt[j][4 * q4] = w4.x; wgt[j][4 * q4 + 1] = w4.y; wgt[j][4 * q4 + 2] = w4.z; wgt[j][4 * q4 + 3] = w4.w; }
            }
#pragma unroll
            for (int ro = 0; ro < 4; ++ro) {
                const int i = i0 + ro, ix = i ^ (sg << 3);
                float acc[16];
#pragma unroll
                for (int cc = 0; cc < 16; ++cc) acc[cc] = 0.f;
#pragma unroll
                for (int j = 0; j < 4; ++j) {
                    const u32x4 x0 = xin[ro + j][0], x1 = xin[ro + j][1];
                    const unsigned xs[8] = {x0.x, x0.y, x0.z, x0.w, x1.x, x1.y, x1.z, x1.w};
#pragma unroll
                    for (int c2 = 0; c2 < 8; ++c2) { acc[2 * c2] = fmaf(wgt[j][2 * c2], bflo(xs[c2]), acc[2 * c2]); acc[2 * c2 + 1] = fmaf(wgt[j][2 * c2 + 1], bfhi(xs[c2]), acc[2 * c2 + 1]); }
                }
                float ss = 0.f;
#pragma unroll
                for (int cc = 0; cc < 16; ++cc) { acc[cc] = silu_f(acc[cc]); ss = fmaf(acc[cc], acc[cc], ss); }
                const float beta_i = sbeta[i], egc_i = segc[i], ekd_i = sekd[i];
                if (mat < 2) {
                    ss += __shfl_xor(ss, 1); ss += __shfl_xor(ss, 2); ss += __shfl_xor(ss, 4);
                    const float rs = rsqrtf(ss + L2_EPS) * (mat == 0 ? 0.08838834764831845f : 1.f);
#pragma unroll
                    for (int cc = 0; cc < 16; ++cc) acc[cc] *= rs;
                    unsigned char* img = smem + (mat == 0 ? DP_QS : DP_KS) + i * 256;
                    u32x4 c0v, c1v;
                    c0v.x = pk_bf16(acc[0], acc[1]); c0v.y = pk_bf16(acc[2], acc[3]); c0v.z = pk_bf16(acc[4], acc[5]); c0v.w = pk_bf16(acc[6], acc[7]);
                    c1v.x = pk_bf16(acc[8], acc[9]); c1v.y = pk_bf16(acc[10], acc[11]); c1v.z = pk_bf16(acc[12], acc[13]); c1v.w = pk_bf16(acc[14], acc[15]);
                    *(u32x4*)(img + (((2 * sg) ^ (i & 15)) << 4)) = c0v;
                    *(u32x4*)(img + (((2 * sg + 1) ^ (i & 15)) << 4)) = c1v;
                }
                if (mat == 0) {
                    u32x4 p0, p1;
                    p0.x = pk_bf16(acc[0] * egc_i, acc[1] * egc_i); p0.y = pk_bf16(acc[2] * egc_i, acc[3] * egc_i); p0.z = pk_bf16(acc[8] * egc_i, acc[9] * egc_i); p0.w = pk_bf16(acc[10] * egc_i, acc[11] * egc_i);
                    p1.x = pk_bf16(acc[4] * egc_i, acc[5] * egc_i); p1.y = pk_bf16(acc[6] * egc_i, acc[7] * egc_i); p1.z = pk_bf16(acc[12] * egc_i, acc[13] * egc_i); p1.w = pk_bf16(acc[14] * egc_i, acc[15] * egc_i);
                    bf16_t* dst = p.dn_qd + ((size_t)(ci * 16 + (i >> 5) * 8 + sg) * 64) * 8;
                    *(u32x4*)(dst + (size_t)(i & 31) * 8) = p0;
                    *(u32x4*)(dst + (size_t)(32 + (i & 31)) * 8) = p1;
                } else if (mat == 1) {
                    const float sc = beta_i * egc_i;
#pragma unroll
                    for (int cc = 0; cc < 16; ++cc) {
                        Rt[(128 + c0 + cc) * 72 + ix] = (bf16_t)(pk_bf16(acc[cc] * sc, 0.f) & 0xffffu);
                        kdt[(c0 + cc) * 68 + ix] = (bf16_t)(pk_bf16(acc[cc] * ekd_i, 0.f) & 0xffffu);
                    }
                } else {
#pragma unroll
                    for (int cc = 0; cc < 16; ++cc) Rt[(c0 + cc) * 72 + ix] = (bf16_t)(pk_bf16(acc[cc] * beta_i, 0.f) & 0xffffu);
                }
            }
        }
        if (ci + (int)gridDim.x < 16 * 128) dn_fetch(ci + (int)gridDim.x);
        __syncthreads();
        {
            const int mat = wave >> 2, ti = (wave >> 1) & 1, tj = wave & 1, r = lane & 31, hh = lane >> 5;
            const unsigned char* ai = smem + (mat ? DP_QS : DP_KS) + (ti * 32 + r) * 256;
            const unsigned char* bi = smem + DP_KS + (tj * 32 + r) * 256;
            f32x16 d;
#pragma unroll
            for (int e = 0; e < 16; ++e) d[e] = 0.f;
#pragma unroll
            for (int ks = 0; ks < 8; ++ks) {
                const bf16x8 af = *(const bf16x8*)(ai + (((2 * ks + hh) ^ (r & 15)) << 4));
                const bf16x8 bf = *(const bf16x8*)(bi + (((2 * ks + hh) ^ (r & 15)) << 4));
                d = __builtin_amdgcn_mfma_f32_32x32x16_bf16(af, bf, d, 0, 0, 0);
            }
            const int j = tj * 32 + r; const float gcj = sgc[j];
#pragma unroll
            for (int e = 0; e < 16; ++e) {
                const int i = ti * 32 + (e & 3) + 8 * (e >> 2) + 4 * hh;
                const float dec = __expf(fminf(sgc[i] - gcj, 0.f));
                if (mat == 0) Am[i * 68 + j] = (j < i) ? sbeta[i] * d[e] * dec : 0.f;
                else qki[i * 68 + j] = (bf16_t)(pk_bf16((j <= i) ? d[e] * dec : 0.f, 0.f) & 0xffffu);
            }
        }
        __syncthreads();
        if (tid < 64) {
            const int bk = tid >> 4, c = tid & 15;
            const float* Ab = Am + (16 * bk) * 68 + 16 * bk;
            float X[16];
#pragma unroll
            for (int i = 0; i < 16; ++i) {
                float sacc = 0.f;
#pragma unroll
                for (int j = 0; j < i; ++j) sacc = fmaf(Ab[i * 68 + j], X[j], sacc);
                X[i] = ((i == c) ? 1.f : 0.f) - sacc;
            }
#pragma unroll
            for (int i = 0; i < 16; ++i) Ti[(16 * bk + i) * 68 + 16 * bk + c] = X[i];
        } else {
            for (int z = tid - 64; z < 6 * 256; z += 448) {
                const int blk = z >> 8, e2 = z & 255, bi = blk < 3 ? 0 : (blk < 5 ? 1 : 2), bj = blk < 3 ? blk + 1 : (blk < 5 ? blk - 1 : 3);
                Ti[(16 * bi + (e2 >> 4)) * 68 + 16 * bj + (e2 & 15)] = 0.f;
            }
        }
        __syncthreads();
        {
            const int w2 = tid >> 8, o = tid & 255, ri = o >> 4, cj = o & 15, r0 = 16 * (2 * w2 + 1), c0 = 16 * (2 * w2);
            float sacc = 0.f;
#pragma unroll
            for (int k = 0; k < 16; ++k) sacc = fmaf(Am[(r0 + ri) * 68 + c0 + k], Ti[(c0 + k) * 68 + c0 + cj], sacc);
            Qb[w2 * 272 + ri * 17 + cj] = sacc;
        }
        __syncthreads();
        {
            const int w2 = tid >> 8, o = tid & 255, ri = o >> 4, cj = o & 15, r0 = 16 * (2 * w2 + 1), c0 = 16 * (2 * w2);
            float sacc = 0.f;
#pragma unroll
            for (int k = 0; k < 16; ++k) sacc = fmaf(Ti[(r0 + ri) * 68 + r0 + k], Qb[w2 * 272 + k * 17 + cj], sacc);
            Ti[(r0 + ri) * 68 + c0 + cj] = -sacc;
        }
        __syncthreads();
        float q3[2];
#pragma unroll
        for (int q = 0; q < 2; ++q) {
            const int o = tid + 512 * q, ri = o >> 5, cj = o & 31;
            float sacc = 0.f;
#pragma unroll
            for (int k = 0; k < 32; ++k) sacc = fmaf(Am[(32 + ri) * 68 + k], Ti[k * 68 + cj], sacc);
            q3[q] = sacc;
        }
#pragma unroll
        for (int q = 0; q < 2; ++q) { const int o = tid + 512 * q; Qb[(o >> 5) * 33 + (o & 31)] = q3[q]; }
        __syncthreads();
#pragma unroll
        for (int q = 0; q < 2; ++q) {
            const int o = tid + 512 * q, ri = o >> 5, cj = o & 31;
            float sacc = 0.f;
#pragma unroll
            for (int k = 0; k < 32; ++k) sacc = fmaf(Ti[(32 + ri) * 68 + 32 + k], Qb[k * 33 + cj], sacc);
            q3[q] = -sacc;
        }
        __syncthreads();
#pragma unroll
        for (int q = 0; q < 2; ++q) { const int o = tid + 512 * q; Ti[(32 + (o >> 5)) * 68 + (o & 31)] = q3[q]; }
        __syncthreads();
#pragma unroll
        for (int q = 0; q < 4; ++q) {
            const int o2 = tid + 512 * q, ri = o2 >> 5, c2 = (o2 & 31) * 2;
            *(unsigned*)(Tb + ri * 72 + c2) = pk_bf16(Ti[ri * 68 + c2], Ti[ri * 68 + c2 + 1]);
        }
        __syncthreads();
        {
            const int ct = wave, r = lane & 31, hh = lane >> 5;
            f32x16 xacc[2];
#pragma unroll
            for (int T = 0; T < 2; ++T)
#pragma unroll
                for (int e = 0; e < 16; ++e) xacc[T][e] = 0.f;
#pragma unroll
            for (int ks = 0; ks < 4; ++ks) {
                const bf16x8 bfr = *(const bf16x8*)(Rt + (32 * ct + r) * 72 + (((2 * ks + hh) ^ (((32 * ct + r) >> 4) & 7)) << 3));
#pragma unroll
                for (int T = 0; T < 2; ++T) {
                    const bf16x8 afr = *(const bf16x8*)(Tb + (32 * T + r) * 72 + 16 * ks + 8 * hh);
                    xacc[T] = __builtin_amdgcn_mfma_f32_32x32x16_bf16(afr, bfr, xacc[T], 0, 0, 0);
                }
            }
            if (ct < 4) {
#pragma unroll
                for (int T = 0; T < 2; ++T)
#pragma unroll
                    for (int hf = 0; hf < 2; ++hf) {
                        u32x4 o; o.x = pk_bf16(xacc[T][8 * hf], xacc[T][8 * hf + 1]); o.y = pk_bf16(xacc[T][8 * hf + 2], xacc[T][8 * hf + 3]);
                        o.z = pk_bf16(xacc[T][8 * hf + 4], xacc[T][8 * hf + 5]); o.w = pk_bf16(xacc[T][8 * hf + 6], xacc[T][8 * hf + 7]);
                        *(u32x4*)(p.dn_u + ((size_t)(((ci * 4 + ct) * 2 + T) * 2 + hf) * 64 + lane) * 8) = o;
                    }
            } else {
                const int dd = 32 * (ct - 4) + r;
#pragma unroll
                for (int T = 0; T < 2; ++T)
#pragma unroll
                    for (int e = 0; e < 16; ++e) wim[(32 * T + (e & 3) + 8 * (e >> 2) + 4 * hh) * 132 + dd] = (bf16_t)(pk_bf16(-xacc[T][e], 0.f) & 0xffffu);
            }
#pragma unroll
            for (int q = 0; q < 3; ++q) {
                const int pc = tid + 512 * q;
                if (pc < 512) {
                    const int f = pc >> 6, ln = pc & 63, r2 = ln & 31, h2 = ln >> 5, rt = f >> 2, ks = f & 3;
                    const bf16_t* src = qki + (32 * rt + r2) * 68 + 16 * ks + 4 * h2;
                    const u32x2 lo = *(const u32x2*)src, hi = *(const u32x2*)(src + 8);
                    u32x4 o; o.x = lo.x; o.y = lo.y; o.z = hi.x; o.w = hi.y;
                    *(u32x4*)(p.dn_qk + ((size_t)(ci * 8 + f) * 64 + ln) * 8) = o;
                } else {
                    const int pc2 = pc - 512, f = pc2 >> 6, ln = pc2 & 63, r2 = ln & 31, h2 = ln >> 5, rt = f >> 2, ks = f & 3;
                    const int dd2 = 32 * rt + r2, sx = ((dd2 >> 4) & 7) << 3, i0 = 16 * ks + 4 * h2;
                    const u32x2 lo = *(const u32x2*)(kdt + dd2 * 68 + (i0 ^ sx)), hi = *(const u32x2*)(kdt + dd2 * 68 + ((i0 + 8) ^ sx));
                    u32x4 o; o.x = lo.x; o.y = lo.y; o.z = hi.x; o.w = hi.y;
                    *(u32x4*)(p.dn_kdt + ((size_t)(ci * 16 + f) * 64 + ln) * 8) = o;
                }
            }
        }
        __syncthreads();
#pragma unroll
        for (int q = 0; q < 2; ++q) {
            const int pc = tid + 512 * q, f = pc >> 6, ln = pc & 63, r = ln & 31, hh = ln >> 5, rt = f >> 3, ks = f & 7;
            const bf16_t* src = wim + (32 * rt + r) * 132 + 16 * ks + 4 * hh;
            const u32x2 lo = *(const u32x2*)src, hi = *(const u32x2*)(src + 8);
            u32x4 o; o.x = lo.x; o.y = lo.y; o.z = hi.x; o.w = hi.y;
            *(u32x4*)(p.dn_negw + ((size_t)(ci * 16 + f) * 64 + ln) * 8) = o;
        }
    }
    __syncthreads();
}

__device__ __forceinline__ bf16x8 pack8(const f32x16& x, int s) {
    u32x4 v;
    v.x = pk_bf16(x[8 * s], x[8 * s + 1]); v.y = pk_bf16(x[8 * s + 2], x[8 * s + 3]); v.z = pk_bf16(x[8 * s + 4], x[8 * s + 5]); v.w = pk_bf16(x[8 * s + 6], x[8 * s + 7]);
    return __builtin_bit_cast(bf16x8, v);
}
#define LDS_BARRIER() do { asm volatile("s_waitcnt lgkmcnt(0)" ::: "memory"); __builtin_amdgcn_s_barrier(); asm volatile("" ::: "memory"); } while (0)
__device__ __forceinline__ const bf16_t* dn_piece_src(const Params& p, int ci, int pc) {
    return pc < 1024 ? p.dn_negw + ((size_t)ci * 1024 + pc) * 8 : pc < 2048 ? p.dn_qd + ((size_t)ci * 1024 + (pc - 1024)) * 8
         : pc < 3072 ? p.dn_kdt + ((size_t)ci * 1024 + (pc - 2048)) * 8 : pc < 3584 ? p.dn_qk + ((size_t)ci * 512 + (pc - 3072)) * 8 : p.dn_u + ((size_t)ci * 1024 + (pc - 3584)) * 8;
}
constexpr int DN_SEG = 32;
template <int PASS> __device__ __forceinline__ int dn_lpiece(int q) { return PASS == 0 ? q : (q < 1024 ? q : (q < 2048 ? q + 1024 : q + 1536)); }
template <int PASS>
__device__ __forceinline__ void dn_scan_seg(const Params& p, unsigned char* smem, int bh, int seg, int half) {
    constexpr int NPC = PASS == 0 ? 4608 : 3072, LPT = NPC / 256, PPT = NPC / 512;
    const int tid = threadIdx.x, lane = tid & 63, wave = tid >> 6, r = lane & 31, hh = lane >> 5;
    const int b = bh >> 2, h = bh & 3, ci0 = bh * 128 + seg * DN_SEG;
#pragma unroll
    for (int q = 0; q < PPT; ++q) { const int pc = dn_lpiece<PASS>(tid + 512 * q); *(u32x4*)(smem + pc * 16) = *(const u32x4*)dn_piece_src(p, ci0, pc); }
    __syncthreads();
    if (wave >= 4) {
        const int t2 = tid - 256;
        u32x4 sa[LPT], sb[LPT], sc[LPT];
#define DN_LD(dst, chunk) do { const int c_ = ci0 + ((chunk) < DN_SEG - 1 ? (chunk) : DN_SEG - 1); _Pragma("unroll") for (int q_ = 0; q_ < LPT; ++q_) dst[q_] = *(const u32x4*)dn_piece_src(p, c_, dn_lpiece<PASS>(t2 + 256 * q_)); } while (0)
#define DN_WR(src, chunk) do { if ((chunk) < DN_SEG) { unsigned char* nb_ = smem + ((chunk) & 1) * DN_CH_BYTES; _Pragma("unroll") for (int q_ = 0; q_ < LPT; ++q_) *(u32x4*)(nb_ + dn_lpiece<PASS>(t2 + 256 * q_) * 16) = src[q_]; } } while (0)
        DN_LD(sa, 1); DN_LD(sb, 2); DN_LD(sc, 3);
        unsigned* prog = p.bar + XCD_BAR_WORDS + 64 * (bh * 4 + seg);
#define DN_PUB(v) do { if (PASS == 0 && t2 == 0) __hip_atomic_store(prog, (unsigned)(v), __ATOMIC_RELAXED, __HIP_MEMORY_SCOPE_AGENT); } while (0)
        for (int n = 0; n < DN_SEG + 1; n += 3) {
            if (n < DN_SEG) { DN_WR(sa, n + 1); DN_LD(sa, n + 4); DN_PUB(n + 1); LDS_BARRIER(); }
            if (n + 1 < DN_SEG) { DN_WR(sb, n + 2); DN_LD(sb, n + 5); DN_PUB(n + 2); LDS_BARRIER(); }
            if (n + 2 < DN_SEG) { DN_WR(sc, n + 3); DN_LD(sc, n + 6); DN_PUB(n + 3); LDS_BARRIER(); }
        }
#undef DN_PUB
#undef DN_LD
#undef DN_WR
    } else {
        const int e = __builtin_amdgcn_readfirstlane(wave);
        const int sl = 4 * half + e;
        const bool isP = sl < 4;
        f32x16 S[4];
#pragma unroll
        for (int T = 0; T < 4; ++T)
#pragma unroll
            for (int e2 = 0; e2 < 16; ++e2) {
                const int row = 32 * T + (e2 & 3) + 8 * (e2 >> 2) + 4 * hh;
                if (PASS == 0) S[T][e2] = seg > 0 ? p.dn_PB[((size_t)(bh * 3 + 0) * 128 + row) * 256 + 128 + 32 * e + r] : 0.f;
                else S[T][e2] = (isP && row == 32 * sl + r) ? 1.f : 0.f;
            }
        if (PASS == 0) {
            for (int sg = 1; sg < seg; ++sg) {
                const float* pseg = p.dn_PB + (size_t)(bh * 3 + sg) * 128 * 256;
                bf16x8 Xb[8];
#pragma unroll
                for (int T = 0; T < 4; ++T) { Xb[2 * T] = pack8(S[T], 0); Xb[2 * T + 1] = pack8(S[T], 1); }
#pragma unroll
                for (int T = 0; T < 4; ++T) {
                    f32x16 xn;
#pragma unroll
                    for (int e2 = 0; e2 < 16; ++e2) xn[e2] = pseg[(size_t)(32 * T + (e2 & 3) + 8 * (e2 >> 2) + 4 * hh) * 256 + 128 + 32 * e + r];
#pragma unroll
                    for (int ks = 0; ks < 8; ++ks) {
                        const float* pr = pseg + (size_t)(32 * T + r) * 256 + 16 * ks + 4 * hh;
                        const float4 lo = *(const float4*)pr, hi = *(const float4*)(pr + 8);
                        u32x4 av; av.x = pk_bf16(lo.x, lo.y); av.y = pk_bf16(lo.z, lo.w); av.z = pk_bf16(hi.x, hi.y); av.w = pk_bf16(hi.z, hi.w);
                        xn = __builtin_amdgcn_mfma_f32_32x32x16_bf16(__builtin_bit_cast(bf16x8, av), Xb[ks], xn, 0, 0, 0);
                        if (ks & 1) __builtin_amdgcn_sched_barrier(0);
                    }
                    S[T] = xn;
                    __builtin_amdgcn_sched_barrier(0);
                }
            }
        }
        const float glr = p.dn_gl[ci0 + (lane & 31)];
#define DN_SB() __builtin_amdgcn_sched_barrier(0)
#define DN_RD8(dst, off) do { _Pragma("unroll") for (int q_ = 0; q_ < 8; ++q_) dst[q_] = *(const bf16x8*)(buf + (off) + q_ * 1024 + lane * 16); } while (0)
        bf16x8 Sb[8];
#pragma unroll
        for (int T = 0; T < 4; ++T) { Sb[2 * T] = pack8(S[T], 0); Sb[2 * T + 1] = pack8(S[T], 1); }
        const unsigned ooff = (unsigned)(4 * hh * 512 + r);
        for (int n = 0; n < DN_SEG; ++n) {
            const unsigned char* buf = smem + (n & 1) * DN_CH_BYTES;
            const float gl = __uint_as_float(__builtin_amdgcn_readlane(__float_as_uint(glr), n));
            bf16x8 fa[8], fb[8];
            DN_RD8(fa, 0);
            DN_RD8(fb, 8192);
            f32x16 vn0, vn1;
            if (PASS == 0 || !isP) {
                const unsigned char* ub = buf + 57344 + (PASS == 0 ? e : sl - 4) * 4096 + lane * 16;
                const u32x4 u00 = *(const u32x4*)ub, u01 = *(const u32x4*)(ub + 1024), u10 = *(const u32x4*)(ub + 2048), u11 = *(const u32x4*)(ub + 3072);
                vn0[0] = bflo(u00.x); vn0[1] = bfhi(u00.x); vn0[2] = bflo(u00.y); vn0[3] = bfhi(u00.y); vn0[4] = bflo(u00.z); vn0[5] = bfhi(u00.z); vn0[6] = bflo(u00.w); vn0[7] = bfhi(u00.w);
                vn0[8] = bflo(u01.x); vn0[9] = bfhi(u01.x); vn0[10] = bflo(u01.y); vn0[11] = bfhi(u01.y); vn0[12] = bflo(u01.z); vn0[13] = bfhi(u01.z); vn0[14] = bflo(u01.w); vn0[15] = bfhi(u01.w);
                vn1[0] = bflo(u10.x); vn1[1] = bfhi(u10.x); vn1[2] = bflo(u10.y); vn1[3] = bfhi(u10.y); vn1[4] = bflo(u10.z); vn1[5] = bfhi(u10.z); vn1[6] = bflo(u10.w); vn1[7] = bfhi(u10.w);
                vn1[8] = bflo(u11.x); vn1[9] = bfhi(u11.x); vn1[10] = bflo(u11.y); vn1[11] = bfhi(u11.y); vn1[12] = bflo(u11.z); vn1[13] = bfhi(u11.z); vn1[14] = bflo(u11.w); vn1[15] = bfhi(u11.w);
            } else {
#pragma unroll
                for (int e2 = 0; e2 < 16; ++e2) { vn0[e2] = 0.f; vn1[e2] = 0.f; }
            }
            DN_SB();
#pragma unroll
            for (int ks = 0; ks < 8; ++ks) vn0 = __builtin_amdgcn_mfma_f32_32x32x16_bf16(fa[ks], Sb[ks], vn0, 0, 0, 0);
            DN_SB();
            if (PASS == 0) DN_RD8(fa, 16384); else DN_RD8(fa, 32768);
            DN_SB();
#pragma unroll
            for (int ks = 0; ks < 8; ++ks) vn1 = __builtin_amdgcn_mfma_f32_32x32x16_bf16(fb[ks], Sb[ks], vn1, 0, 0, 0);
            DN_SB();
            if (PASS == 0) DN_RD8(fb, 16384 + 8192); else DN_RD8(fb, 32768 + 8192);
            DN_SB();
            f32x16 o0, o1;
            if (PASS == 0) {
#pragma unroll
                for (int e2 = 0; e2 < 16; ++e2) { o0[e2] = 0.f; o1[e2] = 0.f; }
#pragma unroll
                for (int ks = 0; ks < 8; ++ks) o0 = __builtin_amdgcn_mfma_f32_32x32x16_bf16(fa[ks], Sb[ks], o0, 0, 0, 0);
                DN_SB();
                DN_RD8(fa, 32768);
            }
            bf16x8 vb[4];
            vb[0] = pack8(vn0, 0); vb[1] = pack8(vn0, 1); vb[2] = pack8(vn1, 0); vb[3] = pack8(vn1, 1);
            DN_SB();
            if (PASS == 0) {
#pragma unroll
                for (int ks = 0; ks < 8; ++ks) o1 = __builtin_amdgcn_mfma_f32_32x32x16_bf16(fb[ks], Sb[ks], o1, 0, 0, 0);
                DN_SB();
                DN_RD8(fb, 32768 + 8192);
            }
#pragma unroll
            for (int e2 = 0; e2 < 16; ++e2) { S[0][e2] *= gl; S[1][e2] *= gl; }
            DN_SB();
#pragma unroll
            for (int ks = 0; ks < 4; ++ks) S[0] = __builtin_amdgcn_mfma_f32_32x32x16_bf16(fa[ks], vb[ks], S[0], 0, 0, 0);
#pragma unroll
            for (int ks = 0; ks < 4; ++ks) S[1] = __builtin_amdgcn_mfma_f32_32x32x16_bf16(fa[4 + ks], vb[ks], S[1], 0, 0, 0);
            DN_SB();
            if (PASS == 0) DN_RD8(fa, 49152);
#pragma unroll
            for (int e2 = 0; e2 < 16; ++e2) { S[2][e2] *= gl; S[3][e2] *= gl; }
            DN_SB();
#pragma unroll
            for (int ks = 0; ks < 4; ++ks) S[2] = __builtin_amdgcn_mfma_f32_32x32x16_bf16(fb[ks], vb[ks], S[2], 0, 0, 0);
#pragma unroll
            for (int ks = 0; ks < 4; ++ks) S[3] = __builtin_amdgcn_mfma_f32_32x32x16_bf16(fb[4 + ks], vb[ks], S[3], 0, 0, 0);
            DN_SB();
            if (PASS == 0) {
#pragma unroll
                for (int ks = 0; ks < 4; ++ks) o0 = __builtin_amdgcn_mfma_f32_32x32x16_bf16(fa[ks], vb[ks], o0, 0, 0, 0);
#pragma unroll
                for (int ks = 0; ks < 4; ++ks) o1 = __builtin_amdgcn_mfma_f32_32x32x16_bf16(fa[4 + ks], vb[ks], o1, 0, 0, 0);
                DN_SB();
            }
#pragma unroll
            for (int T = 0; T < 4; ++T) { Sb[2 * T] = pack8(S[T], 0); Sb[2 * T + 1] = pack8(S[T], 1); }
            if (PASS == 0) {
                bf16_t* ob = p.odn_raw + ((size_t)b * SEQ + (seg * DN_SEG + n) * 64) * 512 + h * 128 + 32 * e;
#pragma unroll
                for (int e2 = 0; e2 < 16; e2 += 2) {
                    const unsigned w0 = pk_bf16(o0[e2], o0[e2 + 1]), w1 = pk_bf16(o1[e2], o1[e2 + 1]);
                    (ob + ((e2 & 3) + 8 * (e2 >> 2)) * 512)[ooff] = (bf16_t)(w0 & 0xffffu); (ob + ((e2 & 3) + 1 + 8 * (e2 >> 2)) * 512)[ooff] = (bf16_t)(w0 >> 16);
                    (ob + (32 + (e2 & 3) + 8 * (e2 >> 2)) * 512)[ooff] = (bf16_t)(w1 & 0xffffu); (ob + (32 + (e2 & 3) + 1 + 8 * (e2 >> 2)) * 512)[ooff] = (bf16_t)(w1 >> 16);
                }
            }
            LDS_BARRIER();
        }
#undef DN_RD8
#undef DN_SB
        if (PASS == 1) {
            float* pb = p.dn_PB + (size_t)(bh * 3 + seg) * 128 * 256 + 32 * sl + r;
#pragma unroll
            for (int T = 0; T < 4; ++T)
#pragma unroll
                for (int e2 = 0; e2 < 16; ++e2) pb[(size_t)(32 * T + (e2 & 3) + 8 * (e2 >> 2) + 4 * hh) * 256] = S[T][e2];
        }
    }
    __syncthreads();
}
__device__ __forceinline__ void phase_scan_l2_helper(const Params& p) {
    const int sj = blockIdx.x - 64, tid = threadIdx.x;
    const int bh = sj >> 2, seg = sj & 3, ci0 = bh * 128 + seg * DN_SEG;
    unsigned* prog = p.bar + XCD_BAR_WORDS + 64 * sj;
    unsigned acc = 0u;
    for (int m = 7; m < DN_SEG; ++m) {
        unsigned spins = 0, pr;
        for (;;) {
            pr = __hip_atomic_load(prog, __ATOMIC_RELAXED, __HIP_MEMORY_SCOPE_AGENT);
            if ((int)pr + 8 >= m || ++spins > 100000u) break;
            __builtin_amdgcn_s_sleep(16);
        }
        if ((int)pr + 4 >= m) continue;
#pragma unroll
        for (int q = 0; q < 9; ++q) { const u32x4 v = *(const u32x4*)dn_piece_src(p, ci0 + m, tid + 512 * q); acc ^= v.x ^ v.y ^ v.z ^ v.w; }
    }
    asm volatile("" :: "v"(acc));
}

constexpr int AT_VT = 32768, AT_VT_STRIDE = 260;
__device__ __forceinline__ void phase_attn(const Params& p, unsigned char* smem, int first_block) {
    const int tid0 = threadIdx.x;
    const int nblk = gridDim.x - first_block;
    const bf16_t* pb = p.proj_b;
    bf16_t* vt = (bf16_t*)(smem + AT_VT);
    u32x4 kvr[4], vvr[4]; bf16x8 qfn[4];
    auto at_fetch = [&](int it) {
        const int tq = tid0, ln = tq & 63, wv = tq >> 6;
        const int hp = it & 1, kvh = (it >> 1) & 1, nb = (it >> 2) & 63, b = it >> 8, m0 = b * SEQ + nb * 128;
#pragma unroll
        for (int i = 0; i < 4; ++i) {
            const int idx = tq + 512 * i, key = idx >> 3, ch = idx & 7;
            kvr[i] = (u32x4){0u, 0u, 0u, 0u}; vvr[i] = (u32x4){0u, 0u, 0u, 0u};
            if ((nb > 0) || (key >= 128)) { const bf16_t* src = pb + (size_t)(m0 - 128 + key) * NP_IN + kvh * 64 + ch * 8; kvr[i] = *(const u32x4*)(src + P_AK); vvr[i] = *(const u32x4*)(src + P_AV); }
        }
        const int head = kvh * 4 + hp * 2 + (wv >> 2), qo = (wv & 3) * 32;
        const bf16_t* qrow = pb + (size_t)(m0 + qo + (ln & 31)) * NP_IN + P_AQ + head * 64 + 8 * (ln >> 5);
#pragma unroll
        for (int ks = 0; ks < 4; ++ks) qfn[ks] = *(const bf16x8*)(qrow + 16 * ks);
    };
    if ((int)blockIdx.x - first_block < 1024) at_fetch((int)blockIdx.x - first_block);
    for (int item = blockIdx.x - first_block; item < 1024; item += nblk) {
        int tid = tid0; asm volatile("" : "+v"(tid));
        const int lane = tid & 63, wave = tid >> 6, r = lane & 31, hh = lane >> 5;
        const int hp = item & 1, kvh = (item >> 1) & 1, nb = (item >> 2) & 63, b = item >> 8;
        const int m0 = b * SEQ + nb * 128;
        __syncthreads();
#pragma unroll
        for (int i = 0; i < 4; ++i) {
            const int idx = tid + 512 * i, key = idx >> 3, ch = idx & 7;
            const u32x4 vv = vvr[i];
            *(u32x4*)(smem + swz(key, ch)) = kvr[i];
            bf16_t* vd = vt + (ch * 8) * AT_VT_STRIDE + (key ^ (ch << 3));
            vd[0] = (bf16_t)(vv.x & 0xffffu); vd[AT_VT_STRIDE] = (bf16_t)(vv.x >> 16); vd[2 * AT_VT_STRIDE] = (bf16_t)(vv.y & 0xffffu); vd[3 * AT_VT_STRIDE] = (bf16_t)(vv.y >> 16);
            vd[4 * AT_VT_STRIDE] = (bf16_t)(vv.z & 0xffffu); vd[5 * AT_VT_STRIDE] = (bf16_t)(vv.z >> 16); vd[6 * AT_VT_STRIDE] = (bf16_t)(vv.w & 0xffffu); vd[7 * AT_VT_STRIDE] = (bf16_t)(vv.w >> 16);
        }
        bf16x8 qf[4];
#pragma unroll
        for (int ks = 0; ks < 4; ++ks) qf[ks] = qfn[ks];
        __syncthreads();
        if (item + nblk < 1024) at_fetch(item + nblk);
        const int head = kvh * 4 + hp * 2 + (wave >> 2), qt = wave & 3, qo = qt * 32;
        f32x16 sc[5];
#pragma unroll
        for (int t = 0; t < 5; ++t) {
#pragma unroll
            for (int e = 0; e < 16; ++e) sc[t][e] = 0.f;
#pragma unroll
            for (int ks = 0; ks < 4; ++ks) sc[t] = __builtin_amdgcn_mfma_f32_32x32x16_bf16(*(const bf16x8*)(smem + swz((qt + t) * 32 + r, 2 * ks + hh)), qf[ks], sc[t], 0, 0, 0);
        }
        const float sink = p.sinks[head];
        float mx = -1e30f;
#pragma unroll
        for (int t = 0; t < 5; ++t)
#pragma unroll
            for (int e = 0; e < 16; ++e) {
                const int kf = 32 * (qt + t) + (e & 3) + 8 * (e >> 2) + 4 * hh;
                const bool ok = (kf >= qo + r + 1) && (kf <= qo + r + 128) && ((nb > 0) || (kf >= 128));
                sc[t][e] = ok ? sc[t][e] : -1e30f;
                mx = fmaxf(mx, sc[t][e]);
            }
        mx = fmaxf(mx, __shfl_xor(mx, 32));
        mx = fmaxf(mx, sink);
        float sum = 0.f;
#pragma unroll
        for (int t = 0; t < 5; ++t)
#pragma unroll
            for (int e = 0; e < 16; ++e) { const float pe = (sc[t][e] > -1e29f) ? __expf(sc[t][e] - mx) : 0.f; sc[t][e] = pe; sum += pe; }
        sum += __shfl_xor(sum, 32);
        const float inv = 1.f / (sum + __expf(sink - mx));
        f32x16 o[2];
#pragma unroll
        for (int dt = 0; dt < 2; ++dt)
#pragma unroll
            for (int e = 0; e < 16; ++e) o[dt][e] = 0.f;
#pragma unroll
        for (int t = 0; t < 5; ++t)
#pragma unroll
            for (int s2 = 0; s2 < 2; ++s2) {
                const bf16x8 pbv = pack8(sc[t], s2);
                const int kb = 32 * (qt + t) + 16 * s2 + 4 * hh;
#pragma unroll
                for (int dt = 0; dt < 2; ++dt) {
                    const int dvr = dt * 32 + r, vx = ((dvr >> 3) & 7) << 3;
                    const u32x2 lo = *(const u32x2*)(vt + dvr * AT_VT_STRIDE + (kb ^ vx)), hi = *(const u32x2*)(vt + dvr * AT_VT_STRIDE + ((kb + 8) ^ vx));
                    u32x4 av; av.x = lo.x; av.y = lo.y; av.z = hi.x; av.w = hi.y;
                    o[dt] = __builtin_amdgcn_mfma_f32_32x32x16_bf16(__builtin_bit_cast(bf16x8, av), pbv, o[dt], 0, 0, 0);
                }
            }
        bf16_t* orow = p.xb + (size_t)(m0 + qo + r) * D_MODEL + head * 64 + 4 * hh;
#pragma unroll
        for (int dt = 0; dt < 2; ++dt)
#pragma unroll
            for (int q4 = 0; q4 < 4; ++q4) {
                u32x2 v; v.x = pk_bf16(o[dt][4 * q4] * inv, o[dt][4 * q4 + 1] * inv); v.y = pk_bf16(o[dt][4 * q4 + 2] * inv, o[dt][4 * q4 + 3] * inv);
                *(u32x2*)(orow + dt * 32 + 8 * q4) = v;
            }
    }
    __syncthreads();
}

__device__ __forceinline__ void phase_dn_norm(const Params& p) {
    const int lane = threadIdx.x & 63, gw = blockIdx.x * (NTHREADS / 64) + (threadIdx.x >> 6), GW = gridDim.x * (NTHREADS / 64);
    const float2 g = *(const float2*)(p.dn_norm_g + lane * 2);
    for (int m = gw; m < M_TOK; m += GW) {
        float2 o[4]; unsigned z[4];
#pragma unroll
        for (int h = 0; h < 4; ++h) { const unsigned ow = *(const unsigned*)(p.odn_raw + (size_t)m * 512 + h * 128 + lane * 2); o[h] = make_float2(bflo(ow), bfhi(ow)); z[h] = *(const unsigned*)(p.proj_b + (size_t)m * NP_IN + P_Z + h * 128 + lane * 2); }
#pragma unroll
        for (int h = 0; h < 4; ++h) {
            const float ss = wave_sum(o[h].x * o[h].x + o[h].y * o[h].y);
            const float rr = rsqrtf(ss * (1.f / 128.f) + RMS_EPS);
            *(unsigned*)(p.xb + (size_t)m * D_MODEL + 512 + h * 128 + lane * 2) = pk_bf16(o[h].x * rr * g.x * silu_f(bflo(z[h])), o[h].y * rr * g.y * silu_f(bfhi(z[h])));
        }
    }
}

__device__ __forceinline__ void phase_ln1(const Params& p, bf16_t* x1b) {
    const int lane = threadIdx.x & 63, gw = blockIdx.x * (NTHREADS / 64) + (threadIdx.x >> 6), GW = gridDim.x * (NTHREADS / 64);
    float4 g[4], bb[4];
#pragma unroll
    for (int j = 0; j < 4; ++j) { g[j] = *(const float4*)(p.ln1_g + j * 256 + lane * 4); bb[j] = *(const float4*)(p.ln1_b + j * 256 + lane * 4); }
    for (int m0 = gw * 4; m0 < M_TOK; m0 += GW * 4) {
        float4 v[4][4];
#pragma unroll
        for (int rr = 0; rr < 4; ++rr)
#pragma unroll
            for (int j = 0; j < 4; ++j) v[rr][j] = *(const float4*)(p.out + (size_t)(m0 + rr) * D_MODEL + j * 256 + lane * 4);
#pragma unroll
        for (int rr = 0; rr < 4; ++rr) {
            float s = 0.f;
#pragma unroll
            for (int j = 0; j < 4; ++j) s += (v[rr][j].x + v[rr][j].y) + (v[rr][j].z + v[rr][j].w);
            const float mean = wave_sum(s) * (1.f / D_MODEL); float q = 0.f;
#pragma unroll
            for (int j = 0; j < 4; ++j) { v[rr][j].x -= mean; v[rr][j].y -= mean; v[rr][j].z -= mean; v[rr][j].w -= mean; q += (v[rr][j].x * v[rr][j].x + v[rr][j].y * v[rr][j].y) + (v[rr][j].z * v[rr][j].z + v[rr][j].w * v[rr][j].w); }
            const float rstd = rsqrtf(wave_sum(q) * (1.f / D_MODEL) + LN_EPS);
            if (lane == 0) *(float2*)(p.ln1_stats + (size_t)(m0 + rr) * 2) = make_float2(mean, rstd);
#pragma unroll
            for (int j = 0; j < 4; ++j) {
                u32x2 ob; ob.x = pk_bf16(v[rr][j].x * rstd * g[j].x + bb[j].x, v[rr][j].y * rstd * g[j].y + bb[j].y); ob.y = pk_bf16(v[rr][j].z * rstd * g[j].z + bb[j].z, v[rr][j].w * rstd * g[j].w + bb[j].w);
                *(u32x2*)(x1b + (size_t)(m0 + rr) * D_MODEL + j * 256 + lane * 4) = ob;
            }
        }
    }
}

__device__ __forceinline__ void cas_d(float& a, float& b) { const float hi = fmaxf(a, b), lo = fminf(a, b); a = hi; b = lo; }
__device__ __forceinline__ void cas_a(float& a, float& b) { const float hi = fmaxf(a, b), lo = fminf(a, b); a = lo; b = hi; }
__device__ __forceinline__ void sort16_desc(f32x16& v) {
#pragma unroll
    for (int k = 2; k <= 16; k <<= 1)
#pragma unroll
        for (int j = k >> 1; j > 0; j >>= 1)
#pragma unroll
            for (int i = 0; i < 16; ++i) {
                const int l = i ^ j;
                if (l > i) { float a = v[i], b = v[l]; if ((i & k) == 0) cas_d(a, b); else cas_a(a, b); v[i] = a; v[l] = b; }
            }
}
__device__ __forceinline__ void bmerge16_desc(f32x16& v) {
#pragma unroll
    for (int j = 8; j > 0; j >>= 1)
#pragma unroll
        for (int i = 0; i < 16; ++i) { const int l = i ^ j; if (l > i) { float a = v[i], b = v[l]; cas_d(a, b); v[i] = a; v[l] = b; } }
}
__device__ __forceinline__ f32x16 merge_top16(const f32x16& a, const f32x16& b) {
    f32x16 c;
#pragma unroll
    for (int i = 0; i < 16; ++i) c[i] = fmaxf(a[i], b[15 - i]);
    bmerge16_desc(c);
    return c;
}
__device__ __forceinline__ void pcas_d(float& va, int& ia, float& vb, int& ib) {
    const bool sw = vb > va; const float tv = sw ? vb : va; const int ti = sw ? ib : ia;
    vb = sw ? va : vb; ib = sw ? ia : ib; va = tv; ia = ti;
}
__device__ __forceinline__ void psort16_desc(float (&v)[16], int (&id)[16]) {
#pragma unroll
    for (int k = 2; k <= 16; k <<= 1)
#pragma unroll
        for (int j = k >> 1; j > 0; j >>= 1)
#pragma unroll
            for (int i = 0; i < 16; ++i) {
                const int l = i ^ j;
                if (l > i) { if ((i & k) == 0) pcas_d(v[i], id[i], v[l], id[l]); else pcas_d(v[l], id[l], v[i], id[i]); }
            }
}
__device__ __forceinline__ void pmerge_top16(float (&a)[16], int (&ia)[16], const float (&b)[16], const int (&ib)[16]) {
#pragma unroll
    for (int i = 0; i < 16; ++i) { const bool sw = b[15 - i] > a[i]; a[i] = sw ? b[15 - i] : a[i]; ia[i] = sw ? ib[15 - i] : ia[i]; }
#pragma unroll
    for (int j = 8; j > 0; j >>= 1)
#pragma unroll
        for (int i = 0; i < 16; ++i) { const int l = i ^ j; if (l > i) pcas_d(a[i], ia[i], a[l], ia[l]); }
}
__device__ __forceinline__ void phase_route(const Params& p, const bf16_t* qb) {
    constexpr int CI[50] = {0,0,0,0,0,0,0,0,0,0,0,0,0,0,0,0,1,1,1,1,1,1,1,1,2,2,2,2,2,3,3,3,3,4,4,4,5,5,6,6,7,7,8,9,10,11,12,13,14,15};
    constexpr int CJ[50] = {0,1,2,3,4,5,6,7,8,9,10,11,12,13,14,15,0,1,2,3,4,5,6,7,0,1,2,3,4,0,1,2,3,0,1,2,0,1,0,1,0,1,0,0,0,0,0,0,0,0};
    const int lane0 = threadIdx.x & 63, gw = blockIdx.x * (NTHREADS / 64) + (threadIdx.x >> 6), GW = gridDim.x * (NTHREADS / 64);
    for (int task = gw; task < (M_TOK / 32) * 8; task += GW) {
        int lane = lane0; asm volatile("" : "+v"(lane));
        const int r = lane & 31, hh = lane >> 5;
        const int h = task & 7, tok0 = (task >> 3) * 32;
        f32x16 top[2];
#pragma unroll
        for (int pp = 0; pp < 2; ++pp) {
            const bf16_t* qrow = qb + (size_t)(tok0 + r) * 2048 + h * 256 + pp * 128 + 8 * hh;
            bf16x8 qf[8];
#pragma unroll
            for (int ks = 0; ks < 8; ++ks) qf[ks] = *(const bf16x8*)(qrow + 16 * ks);
            f32x16 sc[4];
#pragma unroll
            for (int kt = 0; kt < 4; ++kt) {
                const bf16_t* af = p.sk_frag + ((size_t)(((h * 2 + pp) * 4 + kt) * 8) * 64 + lane) * 8;
                bf16x8 a[8];
#pragma unroll
                for (int ks = 0; ks < 8; ++ks) a[ks] = *(const bf16x8*)(af + (size_t)ks * 512);
#pragma unroll
                for (int e = 0; e < 16; ++e) sc[kt][e] = 0.f;
#pragma unroll
                for (int ks = 0; ks < 8; ++ks) sc[kt] = __builtin_amdgcn_mfma_f32_32x32x16_bf16(a[ks], qf[ks], sc[kt], 0, 0, 0);
            }
#pragma unroll
            for (int kt = 0; kt < 4; ++kt) {
#pragma unroll
                for (int e = 0; e < 16; ++e) {
                    const unsigned key = (unsigned)(32 * kt + (e & 3) + 8 * (e >> 2)) + 4u * (unsigned)hh;
                    sc[kt][e] = __uint_as_float((__float_as_uint(sc[kt][e]) & 0xffffff80u) | key);
                }
                sort16_desc(sc[kt]);
            }
            f32x16 m = merge_top16(merge_top16(sc[0], sc[1]), merge_top16(sc[2], sc[3]));
            f32x16 oth;
#pragma unroll
            for (int i = 0; i < 16; ++i) oth[i] = __shfl_xor(m[i], 32);
            top[pp] = merge_top16(m, oth);
        }
        int ia[16], ib[16];
#pragma unroll
        for (int i = 0; i < 16; ++i) { ia[i] = (int)(__float_as_uint(top[0][i]) & 127u); ib[i] = (int)(__float_as_uint(top[1][i]) & 127u); }
        float cv0[16], cv1[16]; int cd0[16], cd1[16];
#pragma unroll
        for (int c = 0; c < 32; ++c) {
            float v = -INFINITY; int id = 0;
            if (c < 25) {
                const float v0 = top[0][CI[2 * c]] + top[1][CJ[2 * c]], v1 = top[0][CI[2 * c + 1]] + top[1][CJ[2 * c + 1]];
                const int d0 = (ia[CI[2 * c]] << 7) | ib[CJ[2 * c]], d1 = (ia[CI[2 * c + 1]] << 7) | ib[CJ[2 * c + 1]];
                v = hh ? v1 : v0; id = hh ? d1 : d0;
            }
            if (c < 16) { cv0[c] = v; cd0[c] = id; } else { cv1[c - 16] = v; cd1[c - 16] = id; }
        }
        psort16_desc(cv0, cd0); psort16_desc(cv1, cd1);
        pmerge_top16(cv0, cd0, cv1, cd1);
        float ov[16]; int od[16];
#pragma unroll
        for (int i = 0; i < 16; ++i) { ov[i] = __shfl_xor(cv0[i], 32); od[i] = __shfl_xor(cd0[i], 32); }
        pmerge_top16(cv0, cd0, ov, od);
        float ex[16], den = 0.f;
#pragma unroll
        for (int i = 0; i < 16; ++i) { ex[i] = __expf(cv0[i] - cv0[0]); den += ex[i]; }
        const float inv = 1.f / den;
        if (hh == 0) {
            int* idp = p.ids + (size_t)(tok0 + r) * 128 + h * 16; float* gp = p.gates + (size_t)(tok0 + r) * 128 + h * 16;
#pragma unroll
            for (int q = 0; q < 4; ++q) {
                *(int4*)(idp + 4 * q) = make_int4(cd0[4 * q], cd0[4 * q + 1], cd0[4 * q + 2], cd0[4 * q + 3]);
                *(float4*)(gp + 4 * q) = make_float4(ex[4 * q] * inv, ex[4 * q + 1] * inv, ex[4 * q + 2] * inv, ex[4 * q + 3] * inv);
            }
        }
    }
}


typedef float f32x2 __attribute__((ext_vector_type(2)));
__device__ __forceinline__ void phase_tables8(const Params& p, int first_block) {
    const int lane = threadIdx.x & 63, gw = (blockIdx.x - first_block) * (NTHREADS / 64) + (threadIdx.x >> 6), GW = (gridDim.x - first_block) * (NTHREADS / 64);
    for (int row0 = gw * 4; row0 < 2 * 16384; row0 += GW * 4) {
        float v[4][16];
#pragma unroll
        for (int rr = 0; rr < 4; ++rr) {
            const int row = row0 + rr, table = row >> 14, e = row & 16383;
            const float* src = (table ? p.peer_v : p.peer_u) + (size_t)e * 1024 + lane * 16;
#pragma unroll
            for (int q = 0; q < 4; ++q) { const float4 a = *(const float4*)(src + 4 * q); v[rr][4 * q] = a.x; v[rr][4 * q + 1] = a.y; v[rr][4 * q + 2] = a.z; v[rr][4 * q + 3] = a.w; }
        }
#pragma unroll
        for (int rr = 0; rr < 4; ++rr) {
            const int row = row0 + rr, table = row >> 14, e = row & 16383;
            float am = 0.f;
#pragma unroll
            for (int c = 0; c < 16; ++c) am = fmaxf(am, fabsf(v[rr][c]));
            am = wave_max(am);
            float sc = am > 0.f ? exp2f(floorf(log2f(448.f / am))) : 1.f;
            if (am * sc > 448.f) sc *= 0.5f;
            u32x4 o; int w;
            w = 0; w = __builtin_amdgcn_cvt_pk_fp8_f32(v[rr][0] * sc, v[rr][1] * sc, w, false); w = __builtin_amdgcn_cvt_pk_fp8_f32(v[rr][2] * sc, v[rr][3] * sc, w, true); o.x = (unsigned)w;
            w = 0; w = __builtin_amdgcn_cvt_pk_fp8_f32(v[rr][4] * sc, v[rr][5] * sc, w, false); w = __builtin_amdgcn_cvt_pk_fp8_f32(v[rr][6] * sc, v[rr][7] * sc, w, true); o.y = (unsigned)w;
            w = 0; w = __builtin_amdgcn_cvt_pk_fp8_f32(v[rr][8] * sc, v[rr][9] * sc, w, false); w = __builtin_amdgcn_cvt_pk_fp8_f32(v[rr][10] * sc, v[rr][11] * sc, w, true); o.z = (unsigned)w;
            w = 0; w = __builtin_amdgcn_cvt_pk_fp8_f32(v[rr][12] * sc, v[rr][13] * sc, w, false); w = __builtin_amdgcn_cvt_pk_fp8_f32(v[rr][14] * sc, v[rr][15] * sc, w, true); o.w = (unsigned)w;
            *(u32x4*)(p.tab8 + ((size_t)((table * 8 + (lane >> 3)) * 16384 + e)) * 128 + (lane & 7) * 16) = o;
            if (lane == 0) p.isc[row] = 1.f / sc;
        }
    }
}
typedef int i32x16 __attribute__((ext_vector_type(16)));
struct PeerBuf { u32x4 rows[16]; u32x4 xa, xb; f32x16 w; };
__device__ __forceinline__ float dpp_xor1(float v) { return __uint_as_float(__builtin_amdgcn_update_dpp(0u, __float_as_uint(v), 0xB1, 0xF, 0xF, true)); }
__device__ __forceinline__ float dpp_xor2(float v) { return __uint_as_float(__builtin_amdgcn_update_dpp(0u, __float_as_uint(v), 0x4E, 0xF, 0xF, true)); }
__device__ __forceinline__ float dpp_xor8(float v) { return __uint_as_float(__builtin_amdgcn_update_dpp(0u, __float_as_uint(v), 0x128, 0xF, 0xF, true)); }
__device__ __forceinline__ float swz_xor4(float v) { return __uint_as_float(__builtin_amdgcn_ds_swizzle(__float_as_uint(v), 0x101F)); }
__device__ __forceinline__ float swz_xor16(float v) { return __uint_as_float(__builtin_amdgcn_ds_swizzle(__float_as_uint(v), 0x401F)); }
__device__ __forceinline__ void peer_gather(PeerBuf& B, const unsigned char* tab, const i32x16& id, int j) {
#pragma unroll
    for (int i = 0; i < 16; ++i) B.rows[i] = *(const u32x4*)(tab + (size_t)id[i] * 128 + j * 16);
}
__device__ __forceinline__ void phase_peer_u(const Params& p, const bf16_t* x1b, float* ph) {
    const int lane0 = threadIdx.x & 63, wave = threadIdx.x >> 6;
    const int x = blockIdx.x & 7, nloc = (gridDim.x - x + 7) >> 3, wl = (blockIdx.x >> 3) * (NTHREADS / 64) + wave, NW = nloc * (NTHREADS / 64);
    const unsigned char* tab = p.tab8 + (size_t)x * 16384 * 128;
    int lane = lane0; asm volatile("" : "+v"(lane));
    const int j = lane & 7, g = lane >> 3;
    const bool b0 = j & 1, b1 = j & 2, b2 = j & 4;
    auto tok = [&](int t) { return t < M_TOK ? t : M_TOK - 1; };
    auto load_ids = [&](i32x16& id, int t) {
#pragma unroll
        for (int q = 0; q < 4; ++q) { const int4 v = *(const int4*)(p.ids + (size_t)t * 128 + 16 * g + 4 * q); id[4 * q] = v.x; id[4 * q + 1] = v.y; id[4 * q + 2] = v.z; id[4 * q + 3] = v.w; }
    };
    auto issue = [&](PeerBuf& B, int t, const i32x16& id) {
        const bf16_t* xs = x1b + (size_t)t * 1024 + 128 * x + 16 * j;
        B.xa = *(const u32x4*)xs; B.xb = *(const u32x4*)(xs + 8);
        peer_gather(B, tab, id, j);
    };
    auto compute = [&](const PeerBuf& B, int t) {
        const f32x2 xf[8] = {{bflo(B.xa.x), bfhi(B.xa.x)}, {bflo(B.xa.y), bfhi(B.xa.y)}, {bflo(B.xa.z), bfhi(B.xa.z)}, {bflo(B.xa.w), bfhi(B.xa.w)},
                             {bflo(B.xb.x), bfhi(B.xb.x)}, {bflo(B.xb.y), bfhi(B.xb.y)}, {bflo(B.xb.z), bfhi(B.xb.z)}, {bflo(B.xb.w), bfhi(B.xb.w)}};
        float res[16];
#pragma unroll
        for (int i = 0; i < 16; ++i) {
            const unsigned dw[4] = {B.rows[i].x, B.rows[i].y, B.rows[i].z, B.rows[i].w};
            f32x2 d2 = {0.f, 0.f};
#pragma unroll
            for (int q = 0; q < 4; ++q) {
                const f32x2 lo = __builtin_amdgcn_cvt_pk_f32_fp8((int)dw[q], false), hi = __builtin_amdgcn_cvt_pk_f32_fp8((int)dw[q], true);
                d2 = lo * xf[2 * q] + d2; d2 = hi * xf[2 * q + 1] + d2;
            }
            res[i] = d2.x + d2.y;
        }
        float r8[8], r4[4], r2[2];
#pragma unroll
        for (int m = 0; m < 8; ++m) { const float keep = b0 ? res[8 + m] : res[m], send = b0 ? res[m] : res[8 + m]; r8[m] = keep + dpp_xor1(send); }
#pragma unroll
        for (int m = 0; m < 4; ++m) { const float keep = b1 ? r8[4 + m] : r8[m], send = b1 ? r8[m] : r8[4 + m]; r4[m] = keep + dpp_xor2(send); }
#pragma unroll
        for (int m = 0; m < 2; ++m) { const float keep = b2 ? r4[2 + m] : r4[m], send = b2 ? r4[m] : r4[2 + m]; r2[m] = keep + swz_xor4(send); }
        const int i0 = 8 * (int)b0 + 4 * (int)b1 + 2 * (int)b2;
        *(float2*)(ph + ((size_t)x * M_TOK + t) * 128 + 16 * g + i0) = make_float2(r2[0], r2[1]);
    };
    PeerBuf A, Bb;
    int t = wl;
    if (t >= M_TOK) return;
    i32x16 idn;
    load_ids(idn, t);
    issue(A, t, idn);
    load_ids(idn, tok(t + NW));
    for (; t < M_TOK; t += 2 * NW) {
        issue(Bb, tok(t + NW), idn);
        load_ids(idn, tok(t + 2 * NW));
        compute(A, t);
        issue(A, tok(t + 2 * NW), idn);
        load_ids(idn, tok(t + 3 * NW));
        if (t + NW < M_TOK) compute(Bb, t + NW);
    }
}
__device__ __forceinline__ void phase_peer_w(const Params& p, const float* ph, float* wbuf) {
    const size_t gt = (size_t)blockIdx.x * NTHREADS + threadIdx.x, GT = (size_t)gridDim.x * NTHREADS;
    for (size_t i0 = gt; i0 < (size_t)M_TOK * 128; i0 += GT * 4) {
        int e[4]; float h[4], gg[4];
#pragma unroll
        for (int u = 0; u < 4; ++u) {
            const size_t idx = i0 + u * GT;
            e[u] = p.ids[idx]; gg[u] = p.gates[idx]; h[u] = 0.f;
#pragma unroll
            for (int x = 0; x < 8; ++x) h[u] += ph[(size_t)x * M_TOK * 128 + idx];
        }
#pragma unroll
        for (int u = 0; u < 4; ++u) {
            const float hv = h[u] * p.isc[e[u]];
            wbuf[i0 + u * GT] = 0.5f * hv * (1.f + erff(hv * 0.7071067811865476f)) * gg[u] * p.isc[16384 + e[u]];
        }
    }
}
__device__ __forceinline__ void phase_peer_v(const Params& p, const float* wbuf, bf16_t* ffn) {
    const int lane0 = threadIdx.x & 63, wave = threadIdx.x >> 6;
    const int x = blockIdx.x & 7, nloc = (gridDim.x - x + 7) >> 3, wl = (blockIdx.x >> 3) * (NTHREADS / 64) + wave, NW = nloc * (NTHREADS / 64);
    const unsigned char* tab = p.tab8 + (size_t)(8 + x) * 16384 * 128;
    int lane = lane0; asm volatile("" : "+v"(lane));
    const int j = lane & 7, g = lane >> 3;
    const bool b3 = g & 1, b4 = g & 2, b5 = g & 4;
    auto tok = [&](int t) { return t < M_TOK ? t : M_TOK - 1; };
    auto load_ids = [&](i32x16& id, int t) {
#pragma unroll
        for (int q = 0; q < 4; ++q) { const int4 v = *(const int4*)(p.ids + (size_t)t * 128 + 16 * g + 4 * q); id[4 * q] = v.x; id[4 * q + 1] = v.y; id[4 * q + 2] = v.z; id[4 * q + 3] = v.w; }
    };
    auto issue = [&](PeerBuf& B, int t, const i32x16& id) {
#pragma unroll
        for (int q = 0; q < 4; ++q) { const float4 v = *(const float4*)(wbuf + (size_t)t * 128 + 16 * g + 4 * q); B.w[4 * q] = v.x; B.w[4 * q + 1] = v.y; B.w[4 * q + 2] = v.z; B.w[4 * q + 3] = v.w; }
        peer_gather(B, tab, id, j);
    };
    auto compute = [&](const PeerBuf& B, int t) {
        f32x2 acc[8];
#pragma unroll
        for (int c = 0; c < 8; ++c) acc[c] = (f32x2){0.f, 0.f};
#pragma unroll
        for (int i = 0; i < 16; ++i) {
            const f32x2 w2 = {B.w[i], B.w[i]};
            const unsigned dw[4] = {B.rows[i].x, B.rows[i].y, B.rows[i].z, B.rows[i].w};
#pragma unroll
            for (int q = 0; q < 4; ++q) {
                const f32x2 lo = __builtin_amdgcn_cvt_pk_f32_fp8((int)dw[q], false), hi = __builtin_amdgcn_cvt_pk_f32_fp8((int)dw[q], true);
                acc[2 * q] = lo * w2 + acc[2 * q]; acc[2 * q + 1] = hi * w2 + acc[2 * q + 1];
            }
        }
        f32x2 a4[4], a2[2], a1;
#pragma unroll
        for (int m = 0; m < 4; ++m) { const f32x2 keep = b3 ? acc[4 + m] : acc[m], send = b3 ? acc[m] : acc[4 + m]; a4[m] = (f32x2){keep.x + dpp_xor8(send.x), keep.y + dpp_xor8(send.y)}; }
#pragma unroll
        for (int m = 0; m < 2; ++m) { const f32x2 keep = b4 ? a4[2 + m] : a4[m], send = b4 ? a4[m] : a4[2 + m]; a2[m] = (f32x2){keep.x + swz_xor16(send.x), keep.y + swz_xor16(send.y)}; }
        { const f32x2 keep = b5 ? a2[1] : a2[0], send = b5 ? a2[0] : a2[1]; a1 = (f32x2){keep.x + __shfl_xor(send.x, 32), keep.y + __shfl_xor(send.y, 32)}; }
        const int c0 = 8 * (int)b3 + 4 * (int)b4 + 2 * (int)b5;
        *(unsigned*)(ffn + (size_t)t * 1024 + 128 * x + 16 * j + c0) = pk_bf16(a1.x, a1.y);
    };
    PeerBuf A, Bb;
    int t = wl;
    if (t >= M_TOK) return;
    i32x16 idn;
    load_ids(idn, t);
    issue(A, t, idn);
    load_ids(idn, tok(t + NW));
    for (; t < M_TOK; t += 2 * NW) {
        issue(Bb, tok(t + NW), idn);
        load_ids(idn, tok(t + 2 * NW));
        compute(A, t);
        issue(A, tok(t + 2 * NW), idn);
        load_ids(idn, tok(t + 3 * NW));
        if (t + NW < M_TOK) compute(Bb, t + NW);
    }
}
__device__ __forceinline__ void phase_ln2(const Params& p, const bf16_t* ffn) {
    const int lane = threadIdx.x & 63, gw = blockIdx.x * (NTHREADS / 64) + (threadIdx.x >> 6), GW = gridDim.x * (NTHREADS / 64);
    for (int m0 = gw * 2; m0 < M_TOK; m0 += GW * 2) {
        float4 a[2][4]; u32x2 f[2][4]; float2 st[2];
#pragma unroll
        for (int rr = 0; rr < 2; ++rr) {
            st[rr] = *(const float2*)(p.ln1_stats + (size_t)(m0 + rr) * 2);
#pragma unroll
            for (int j = 0; j < 4; ++j) { a[rr][j] = *(const float4*)(p.out + (size_t)(m0 + rr) * D_MODEL + j * 256 + lane * 4); f[rr][j] = *(const u32x2*)(ffn + (size_t)(m0 + rr) * D_MODEL + j * 256 + lane * 4); }
        }
#pragma unroll
        for (int rr = 0; rr < 2; ++rr) {
            float* row = p.out + (size_t)(m0 + rr) * D_MODEL;
            float4 v[4]; float s = 0.f;
#pragma unroll
            for (int j = 0; j < 4; ++j) {
                const float4 g1 = *(const float4*)(p.ln1_g + j * 256 + lane * 4), b1 = *(const float4*)(p.ln1_b + j * 256 + lane * 4);
                v[j] = make_float4(ALPHA * ((a[rr][j].x - st[rr].x) * st[rr].y * g1.x + b1.x) + bflo(f[rr][j].x), ALPHA * ((a[rr][j].y - st[rr].x) * st[rr].y * g1.y + b1.y) + bfhi(f[rr][j].x),
                                   ALPHA * ((a[rr][j].z - st[rr].x) * st[rr].y * g1.z + b1.z) + bflo(f[rr][j].y), ALPHA * ((a[rr][j].w - st[rr].x) * st[rr].y * g1.w + b1.w) + bfhi(f[rr][j].y));
                s += (v[j].x + v[j].y) + (v[j].z + v[j].w);
            }
            const float mean = wave_sum(s) * (1.f / D_MODEL); float q = 0.f;
#pragma unroll
            for (int j = 0; j < 4; ++j) { v[j].x -= mean; v[j].y -= mean; v[j].z -= mean; v[j].w -= mean; q += (v[j].x * v[j].x + v[j].y * v[j].y) + (v[j].z * v[j].z + v[j].w * v[j].w); }
            const float rstd = rsqrtf(wave_sum(q) * (1.f / D_MODEL) + LN_EPS);
#pragma unroll
            for (int j = 0; j < 4; ++j) {
                const float4 g = *(const float4*)(p.ln2_g + j * 256 + lane * 4), bb = *(const float4*)(p.ln2_b + j * 256 + lane * 4);
                *(float4*)(row + j * 256 + lane * 4) = make_float4(v[j].x * rstd * g.x + bb.x, v[j].y * rstd * g.y + bb.y, v[j].z * rstd * g.z + bb.z, v[j].w * rstd * g.w + bb.w);
            }
        }
    }
}

constexpr int N_PHASES = 14;
__global__ void __launch_bounds__(NTHREADS) mega_fwd(Params p) {
    __shared__ __attribute__((aligned(1024))) unsigned char smem[SMEM_BYTES + 16];
    if (threadIdx.x == 0) *(uint4*)(smem + SMEM_BYTES) = make_uint4(0u, 0u, 0u, 0u);
    __syncthreads();
    XcdBarrier bar; bar.bar = p.bar; bar.x = 0; bar.st = (volatile LAS unsigned*)(smem + SMEM_BYTES);
    if (p.ph_hi - p.ph_lo > 1) bar = xcd_barrier_post(p.bar, (volatile LAS unsigned*)(smem + SMEM_BYTES));
    bf16_t* qb = p.proj_b;
    bf16_t* x1b = p.proj_b + (size_t)M_TOK * 2048;
#ifndef DUP_PHASE
#define DUP_PHASE -1
#endif
#define PH(k) (p.ph_lo <= (k) && (k) < p.ph_hi)
#define SYNC(k) do { if (PH(k) && PH((k) + 1)) xcd_barrier(bar); } while (0)
#define RUN(k, ...) do { if (PH(k)) { __VA_ARGS__; if (DUP_PHASE == (k)) { xcd_barrier(bar); __VA_ARGS__; } } SYNC(k); } while (0)
    float* ph = (float*)qb;
    RUN(0, phase_prep(p, smem));
    RUN(1, { EpiInProj e{p.proj_b, p.rope_cs}; gemm_phase(p.xb, p.wt_in, M_TOK, NP_IN, e, smem); });
    RUN(2, phase_dn_prep(p, smem));
    RUN(3, { if (blockIdx.x < 96) { const int j = blockIdx.x, y = j >> 3, cs = (y >> 1) * 8 + (j & 7);
                                    dn_scan_seg<1>(p, smem, cs / 3, cs % 3, y & 1); } else { phase_attn(p, smem, 96); } });
    RUN(4, { if (blockIdx.x < 64) dn_scan_seg<0>(p, smem, blockIdx.x >> 2, blockIdx.x & 3, 0); else if (blockIdx.x < 128) phase_scan_l2_helper(p); else phase_tables8(p, 128); });
    RUN(5, phase_dn_norm(p));
    RUN(6, { EpiOutProj e{p.out, p.x}; gemm_phase(p.xb, p.wt_out, M_TOK, 1024, e, smem); });
    RUN(7, phase_ln1(p, x1b));
    RUN(8, { EpiBf16 e{qb, 2048}; gemm_phase(x1b, p.wt_q, M_TOK, 2048, e, smem); });
    RUN(9, phase_route(p, qb));
    RUN(10, phase_peer_u(p, x1b, ph));
    RUN(11, phase_peer_w(p, ph, p.wbuf));
    RUN(12, phase_peer_v(p, p.wbuf, (bf16_t*)ph));
    RUN(13, phase_ln2(p, (const bf16_t*)ph));
#undef RUN
#undef SYNC
#undef PH
}
}

#ifndef MK_LAUNCHES
#define MK_LAUNCHES 1
#endif

extern "C" void kernel_launch(void* const* d_in, const int* in_sizes, int n_in, void* d_out, int out_size, void* d_ws, size_t ws_size, hipStream_t stream) {
    static int grid_blocks = 0;
    if (!grid_blocks) {
        int dev = 0, cus = 0, per_cu = 0;
        (void)hipGetDevice(&dev);
        (void)hipDeviceGetAttribute(&cus, hipDeviceAttributeMultiprocessorCount, dev);
        (void)hipOccupancyMaxActiveBlocksPerMultiprocessor(&per_cu, mega_fwd, NTHREADS, 0);
        if (per_cu < 1) { fprintf(stderr, "kernel_launch: occupancy query reports %d blocks per CU\n", per_cu); per_cu = 1; }
        grid_blocks = cus * 1;
        (void)hipGetLastError();
    }
    Params p{};
    p.x = (const float*)d_in[0]; p.positions = (const int*)d_in[1]; p.w_in = (const float*)d_in[2]; p.sinks = (const float*)d_in[3];
    p.conv_w = (const float*)d_in[4]; p.a_log = (const float*)d_in[5]; p.dt_bias = (const float*)d_in[6]; p.dn_norm_g = (const float*)d_in[7];
    p.w_out = (const float*)d_in[8]; p.ln1_g = (const float*)d_in[9]; p.ln1_b = (const float*)d_in[10]; p.w_query = (const float*)d_in[11];
    p.sub_keys = (const float*)d_in[12]; p.peer_u = (const float*)d_in[13]; p.peer_v = (const float*)d_in[14]; p.ln2_g = (const float*)d_in[15]; p.ln2_b = (const float*)d_in[16];
    p.out = (float*)d_out;
    char* ws = (char*)d_ws; size_t off = 0;
    auto take = [&](size_t bytes) { char* r = ws + off; off += (bytes + 255) & ~(size_t)255; return r; };
    p.xb = (bf16_t*)take((size_t)M_TOK * 1024 * 2);
    p.proj_b = (bf16_t*)take((size_t)M_TOK * NP_IN * 2);
    p.odn_raw = (bf16_t*)d_out;
    {
        char* dn = take((size_t)2048 * (16384 * 3 + 8192 + 32768) + 8192);
        p.ids = (int*)dn; p.gates = (float*)(dn + (size_t)M_TOK * 128 * 4);
        p.wbuf = (float*)(dn + (size_t)M_TOK * 128 * 8);
        p.dn_negw = (bf16_t*)dn; p.dn_qd = (bf16_t*)(dn + (size_t)2048 * 16384); p.dn_kdt = (bf16_t*)(dn + (size_t)2048 * 16384 * 2);
        p.dn_qk = (bf16_t*)(dn + (size_t)2048 * 16384 * 3); p.dn_u = (bf16_t*)(dn + (size_t)2048 * (16384 * 3 + 8192)); p.dn_gl = (float*)(dn + (size_t)2048 * (16384 * 3 + 8192 + 32768));
    }
    p.wt_in = (bf16_t*)take((size_t)NP_IN * 1024 * 2);
    p.wt_out = (bf16_t*)take((size_t)1024 * 1024 * 2);
    p.wt_q = (bf16_t*)take((size_t)2048 * 1024 * 2);
    p.rope_cs = (float*)take((size_t)M_TOK * 64 * 4);
    p.sk_frag = (bf16_t*)take((size_t)16 * 128 * 128 * 2);
    p.tab8 = (unsigned char*)take((size_t)2 * 16384 * 1024);
    p.isc = (float*)take((size_t)2 * 16384 * 4);
    p.ln1_stats = (float*)take((size_t)M_TOK * 2 * 4);
    p.dn_PB = (float*)take((size_t)48 * 128 * 256 * 4);
    p.dn_S0 = (float*)take((size_t)64 * 128 * 128 * 4);
    p.bar = (unsigned*)take((size_t)(XCD_BAR_WORDS + 64 * 64) * 4);
    if (off > ws_size) { fprintf(stderr, "kernel_launch: workspace too small (%zu < %zu)\n", ws_size, off); return; }
    if (hipMemsetAsync(p.bar, 0, (size_t)(XCD_BAR_WORDS + 64 * 64) * 4, stream) != hipSuccess) { fprintf(stderr, "kernel_launch: memset of barrier words failed\n"); return; }
#if MK_LAUNCHES == 1
    p.ph_lo = 0; p.ph_hi = N_PHASES;
    void* args[] = {&p};
    hipError_t e = hipLaunchCooperativeKernel((void*)mega_fwd, dim3(grid_blocks), dim3(NTHREADS), args, 0, stream);
    if (e != hipSuccess) fprintf(stderr, "cooperative launch failed: %s (grid %d)\n", hipGetErrorString(e), grid_blocks);
#else
    for (int k = 0; k < N_PHASES; ++k) { p.ph_lo = k; p.ph_hi = k + 1; hipLaunchKernelGGL(mega_fwd, dim3(grid_blocks), dim3(NTHREADS), 0, stream, p); }
#endif
}
```

```cpp
#include <hip/hip_runtime.h>
#include <cstdio>
#include <cstdint>
#include <math.h>

namespace {
constexpr int D_MODEL = 1024, BATCH = 4, SEQ = 8192, M_TOK = BATCH * SEQ;
constexpr int IN_WIDTH = 2824, NP_IN = 3072;
constexpr int P_AQ = 0, P_AK = 512, P_AV = 640, P_DQ = 768, P_DK = 1280, P_DV = 1792, P_Z = 2304, P_B = 2816, P_A = 2820;
constexpr float ALPHA = 1.189207115002721f;
constexpr float LN_EPS = 1e-5f, RMS_EPS = 1e-6f, L2_EPS = 1e-6f;
constexpr int NTHREADS = 512;

typedef unsigned short bf16_t;
typedef short bf16x8 __attribute__((ext_vector_type(8)));
typedef float f32x16 __attribute__((ext_vector_type(16)));
typedef float f32x4 __attribute__((ext_vector_type(4)));
typedef unsigned u32x4 __attribute__((ext_vector_type(4)));
typedef unsigned u32x2 __attribute__((ext_vector_type(2)));

struct Params {
    const float* x; const int* positions; const float* w_in; const float* sinks; const float* conv_w; const float* a_log; const float* dt_bias;
    const float* dn_norm_g; const float* w_out; const float* ln1_g; const float* ln1_b; const float* w_query; const float* sub_keys;
    const float* peer_u; const float* peer_v; const float* ln2_g; const float* ln2_b;
    float* out;
    bf16_t* xb;
    bf16_t* proj_b;
    bf16_t* odn_raw;
    int* ids; float* gates;
    bf16_t* wt_in; bf16_t* wt_out; bf16_t* wt_q;
    float* rope_cs;
    bf16_t* dn_negw; bf16_t* dn_qd; bf16_t* dn_kdt; bf16_t* dn_qk; bf16_t* dn_u; float* dn_gl; float* dn_PB; float* dn_S0;
    bf16_t* sk_frag;
    float* ln1_stats;
    unsigned char* tab8; float* isc; float* wbuf;
    unsigned* bar;
    int ph_lo, ph_hi;
};

__device__ __forceinline__ float wave_sum(float v) {
#pragma unroll
    for (int o = 1; o < 64; o <<= 1) v += __shfl_xor(v, o);
    return v;
}
__device__ __forceinline__ float wave_max(float v) {
#pragma unroll
    for (int o = 1; o < 64; o <<= 1) v = fmaxf(v, __shfl_xor(v, o));
    return v;
}
__device__ __forceinline__ float bf2f(bf16_t u) { return __uint_as_float((unsigned)u << 16); }
__device__ __forceinline__ float bflo(unsigned u) { return __uint_as_float(u << 16); }
__device__ __forceinline__ float bfhi(unsigned u) { return __uint_as_float(u & 0xffff0000u); }
typedef __bf16 bf16x2_n __attribute__((ext_vector_type(2)));
__device__ __forceinline__ unsigned pk_bf16(float lo, float hi) { bf16x2_n v; v.x = (__bf16)lo; v.y = (__bf16)hi; return __builtin_bit_cast(unsigned, v); }
__device__ __forceinline__ float silu_f(float y) { return y * __builtin_amdgcn_rcpf(1.f + __expf(-y)); }


#define XB_TMO      128
#define XB_XCNT(j)  (256  + 64 * (j))
#define XB_XSUB(j)  (1280 + 64 * (j))
#define XB_XGEN(j)  (2304 + 64 * (j))
#define XB_TOP      3328
#define XB_TOPGEN   3392
#define XCD_BAR_WORDS 3456
#define XB_SPIN_CAP (1u << 27)
#define LAS __attribute__((address_space(3)))
__device__ __forceinline__ unsigned xb_ld(unsigned* p)              { return __hip_atomic_load(p, __ATOMIC_RELAXED, __HIP_MEMORY_SCOPE_AGENT); }
__device__ __forceinline__ unsigned xb_add(unsigned* p, unsigned v) { return __hip_atomic_fetch_add(p, v, __ATOMIC_RELAXED, __HIP_MEMORY_SCOPE_AGENT); }
__device__ __forceinline__ unsigned xb_xcc_id() { return (unsigned)__builtin_amdgcn_s_getreg((3 << 11) | 20) & 0xFu; }
#define XB_SPIN(cond, bar) do { unsigned _sp = 0; while (cond) { __builtin_amdgcn_s_sleep(1); \
    if ((++_sp & 255u) == 0u) { if (xb_ld(&(bar)[XB_TMO])) break; if (_sp > XB_SPIN_CAP) { atomicAdd(&(bar)[XB_TMO], 1u); break; } } } } while (0)
struct XcdBarrier { unsigned* bar; unsigned x; volatile LAS unsigned* st; };
__device__ __forceinline__ XcdBarrier xcd_barrier_post(unsigned* bar, volatile LAS unsigned* st) {
    XcdBarrier b; b.bar = bar; b.x = xb_xcc_id(); b.st = st;
    if (threadIdx.x == 0) (void)xb_add(&bar[XB_XCNT(b.x)], 1u);
    return b;
}
__device__ __forceinline__ void xcd_barrier_complete(unsigned* bar, unsigned x, unsigned& nloc, unsigned& nx) {
    const unsigned G = gridDim.x * gridDim.y * gridDim.z;
    unsigned sum, cnt, mine, sp = 0u;
    for (;;) {
        sum = 0u; cnt = 0u; mine = 0u;
#pragma unroll
        for (unsigned j = 0; j < 16; ++j) { const unsigned c = xb_ld(&bar[XB_XCNT(j)]); sum += c; cnt += (c > 0u) ? 1u : 0u; mine = (j == x) ? c : mine; }
        if (sum == G) break;
        __builtin_amdgcn_s_sleep(1);
        if ((++sp & 255u) == 0u) { if (xb_ld(&bar[XB_TMO])) break; if (sp > XB_SPIN_CAP) { atomicAdd(&bar[XB_TMO], 1u); break; } }
    }
    nloc = mine > 0u ? mine : 1u; nx = cnt > 0u ? cnt : 1u;
}
__device__ __forceinline__ void xcd_barrier(const XcdBarrier& b) {
    asm volatile("s_waitcnt vmcnt(0)" ::: "memory");
    __syncthreads();
    if (threadIdx.x == 0) {
        unsigned* bar = b.bar;
        __builtin_amdgcn_s_waitcnt(0);
        unsigned nloc = b.st[0], nx = b.st[1];
        if (nloc == 0u) { xcd_barrier_complete(bar, b.x, nloc, nx); b.st[0] = nloc; b.st[1] = nx; }
        const unsigned old = xb_add(&bar[XB_XSUB(b.x)], 1u);
        const unsigned gen = old / nloc;
        if (old + 1u == (gen + 1u) * nloc) {
            __builtin_amdgcn_fence(__ATOMIC_RELEASE, "agent");
            asm volatile("s_waitcnt vmcnt(0)" ::: "memory");
            const unsigned og = xb_add(&bar[XB_TOP], 1u);
            const unsigned tg = og / nx;
            if (og + 1u == (tg + 1u) * nx) xb_add(&bar[XB_TOPGEN], 1u);
            else XB_SPIN(xb_ld(&bar[XB_TOPGEN]) == tg, bar);
            __builtin_amdgcn_fence(__ATOMIC_ACQUIRE, "agent");
            xb_add(&bar[XB_XGEN(b.x)], 1u);
            asm volatile("s_waitcnt vmcnt(0)" ::: "memory");
        } else {
            XB_SPIN(xb_ld(&bar[XB_XGEN(b.x)]) == gen, bar);
            __builtin_amdgcn_fence(__ATOMIC_ACQUIRE, "agent");
            asm volatile("s_waitcnt vmcnt(0)" ::: "memory");
        }
    }
    __syncthreads();
}

__device__ __forceinline__ int inproj_old_col(int n) {
    if (n < 2304) return n;
    if (n < 2816) return 2312 + (n - 2304);
    if (n < 2824) return 2304 + (n - 2816);
    return -1;
}
__device__ __forceinline__ void transpose_item(const float* __restrict__ W, int N_src, bf16_t* __restrict__ WT, int K, int kb, int nb, bool permute, float* scr) {
    const int tid = threadIdx.x;
    const int nn = tid & 63, k8 = tid >> 6;
    const int n = nb * 64 + nn;
    const int oc = permute ? inproj_old_col(n) : n;
#pragma unroll
    for (int i = 0; i < 8; ++i) { const int kk = k8 + 8 * i; scr[kk * 65 + nn] = (oc >= 0) ? W[(size_t)(kb * 64 + kk) * N_src + oc] : 0.f; }
    __syncthreads();
    const int n2 = tid >> 3, c = tid & 7;
    const float* s = scr + (c * 8) * 65 + n2;
    u32x4 o; o.x = pk_bf16(s[0], s[65]); o.y = pk_bf16(s[2 * 65], s[3 * 65]); o.z = pk_bf16(s[4 * 65], s[5 * 65]); o.w = pk_bf16(s[6 * 65], s[7 * 65]);
    *(u32x4*)(WT + (size_t)(nb * 64 + n2) * K + kb * 64 + c * 8) = o;
    __syncthreads();
}
__device__ __forceinline__ void phase_prep(const Params& p, unsigned char* smem) {
    const int tid = threadIdx.x, G = gridDim.x, bid = blockIdx.x;
    float* scr = (float*)smem;
    constexpr int I_IN = 16 * (NP_IN / 64), I_OUT = 16 * 16, I_Q = 16 * 32;
    for (int it = bid; it < I_IN + I_OUT + I_Q; it += G) {
        int r = it;
        if (r < I_IN) { transpose_item(p.w_in, IN_WIDTH, p.wt_in, 1024, r / (NP_IN / 64), r % (NP_IN / 64), true, scr); continue; } r -= I_IN;
        if (r < I_OUT) { transpose_item(p.w_out, 1024, p.wt_out, 1024, r / 16, r % 16, false, scr); continue; } r -= I_OUT;
        transpose_item(p.w_query, 2048, p.wt_q, 1024, r / 32, r % 32, false, scr);
    }
    const size_t gt = (size_t)bid * NTHREADS + tid, GT = (size_t)G * NTHREADS;
    for (size_t i0 = gt; i0 < (size_t)M_TOK * 1024 / 8; i0 += GT * 4) {
        float4 a[4], b[4];
#pragma unroll
        for (int u = 0; u < 4; ++u) { const size_t i = i0 + u * GT; if (i < (size_t)M_TOK * 1024 / 8) { a[u] = *(const float4*)(p.x + i * 8); b[u] = *(const float4*)(p.x + i * 8 + 4); } }
#pragma unroll
        for (int u = 0; u < 4; ++u) { const size_t i = i0 + u * GT; if (i < (size_t)M_TOK * 1024 / 8) {
            u32x4 o; o.x = pk_bf16(a[u].x, a[u].y); o.y = pk_bf16(a[u].z, a[u].w); o.z = pk_bf16(b[u].x, b[u].y); o.w = pk_bf16(b[u].z, b[u].w);
            *(u32x4*)(p.xb + i * 8) = o; } }
    }
    for (size_t i = gt; i < (size_t)16 * 4 * 8 * 64; i += GT) {
        const int ln = (int)(i & 63), ks = (int)((i >> 6) & 7), kt = (int)((i >> 9) & 3), hp = (int)(i >> 11);
        const float* src = p.sub_keys + ((size_t)(hp * 128 + 32 * kt + (ln & 31))) * 128 + 16 * ks + 8 * (ln >> 5);
        const float4 a = *(const float4*)src, b = *(const float4*)(src + 4);
        u32x4 o; o.x = pk_bf16(a.x, a.y); o.y = pk_bf16(a.z, a.w); o.z = pk_bf16(b.x, b.y); o.w = pk_bf16(b.z, b.w);
        *(u32x4*)(p.sk_frag + i * 8) = o;
    }
    for (size_t i = gt; i < (size_t)M_TOK * 32; i += GT) {
        const int m = (int)(i >> 5), j = (int)(i & 31);
        const float inv_freq = powf(10000.0f, -(float)j / 32.0f);
        const float ang = (float)p.positions[m] * inv_freq;
        p.rope_cs[i] = cosf(ang); p.rope_cs[(size_t)M_TOK * 32 + i] = sinf(ang);
    }
}

constexpr int GK = 1024, GBK = 64, G_TILE_BYTES = 256 * 128;
constexpr int STG_STRIDE = 260;
constexpr int SMEM_BYTES = 147456;

__device__ __forceinline__ int swz(int row, int chunk) { return row * 128 + ((chunk ^ ((row >> 1) & 7)) << 4); }

struct EpiInProj {
    bf16_t* out; const float* cs;
    __device__ __forceinline__ void operator()(int m, int pn, int c8, const unsigned char* stg_row) const {
        const int col = pn * 256 + c8 * 8;
        u32x2 a0 = *(const u32x2*)(stg_row + c8 * 16), a1 = *(const u32x2*)(stg_row + c8 * 16 + 8);
        u32x4 o; o.x = a0.x; o.y = a0.y; o.z = a1.x; o.w = a1.y;
        if (col < P_AV) {
            const int d0 = col & 63, i0 = d0 & 31; const bool second = d0 >= 32;
            const int pc8 = second ? c8 - 4 : c8 + 4;
            const u32x2 b0 = *(const u32x2*)(stg_row + pc8 * 16), b1 = *(const u32x2*)(stg_row + pc8 * 16 + 8);
            const unsigned mine[4] = {a0.x, a0.y, a1.x, a1.y}, oth[4] = {b0.x, b0.y, b1.x, b1.y};
            const float* cp = cs + (size_t)m * 32 + i0; const float* sp = cs + (size_t)M_TOK * 32 + (size_t)m * 32 + i0;
            const float4 c0 = *(const float4*)cp, c1 = *(const float4*)(cp + 4), s0 = *(const float4*)sp, s1 = *(const float4*)(sp + 4);
            const float cc[8] = {c0.x, c0.y, c0.z, c0.w, c1.x, c1.y, c1.z, c1.w}, ss[8] = {s0.x, s0.y, s0.z, s0.w, s1.x, s1.y, s1.z, s1.w};
            const float scale = col < P_AK ? 0.125f : 1.f;
            float r[8];
#pragma unroll
            for (int j = 0; j < 8; ++j) {
                const float me = (j & 1) ? bfhi(mine[j >> 1]) : bflo(mine[j >> 1]);
                const float ot = (j & 1) ? bfhi(oth[j >> 1]) : bflo(oth[j >> 1]);
                r[j] = (second ? (me * cc[j] + ot * ss[j]) : (me * cc[j] - ot * ss[j])) * scale;
            }
            o.x = pk_bf16(r[0], r[1]); o.y = pk_bf16(r[2], r[3]); o.z = pk_bf16(r[4], r[5]); o.w = pk_bf16(r[6], r[7]);
        }
        *(u32x4*)(out + (size_t)m * NP_IN + col) = o;
    }
};
struct EpiOutProj {
    float* y; const float* x;
    __device__ __forceinline__ void operator()(int m, int pn, int c8, const unsigned char* stg_row) const {
        const int col = pn * 256 + c8 * 8;
        const u32x2 a0 = *(const u32x2*)(stg_row + c8 * 16), a1 = *(const u32x2*)(stg_row + c8 * 16 + 8);
        const float4 x0 = *(const float4*)(x + (size_t)m * 1024 + col), x1 = *(const float4*)(x + (size_t)m * 1024 + col + 4);
        *(float4*)(y + (size_t)m * 1024 + col) = make_float4(ALPHA * x0.x + bflo(a0.x), ALPHA * x0.y + bfhi(a0.x), ALPHA * x0.z + bflo(a0.y), ALPHA * x0.w + bfhi(a0.y));
        *(float4*)(y + (size_t)m * 1024 + col + 4) = make_float4(ALPHA * x1.x + bflo(a1.x), ALPHA * x1.y + bfhi(a1.x), ALPHA * x1.z + bflo(a1.y), ALPHA * x1.w + bfhi(a1.y));
    }
};
struct EpiBf16 {
    bf16_t* out; int ldc;
    __device__ __forceinline__ void operator()(int m, int pn, int c8, const unsigned char* stg_row) const {
        const int col = pn * 256 + c8 * 8;
        const u32x2 a0 = *(const u32x2*)(stg_row + c8 * 16), a1 = *(const u32x2*)(stg_row + c8 * 16 + 8);
        u32x4 o; o.x = a0.x; o.y = a0.y; o.z = a1.x; o.w = a1.y;
        *(u32x4*)(out + (size_t)m * ldc + col) = o;
    }
};

template <class EPI>
__device__ __forceinline__ void gemm_phase(const bf16_t* __restrict__ A, const bf16_t* __restrict__ Bt, int M, int N, const EPI& epi, unsigned char* smem) {
    const int tid = threadIdx.x, lane = tid & 63, wave = tid >> 6, r = lane & 31, h = lane >> 5;
    const int wm = wave >> 2, wn = wave & 3;
    const int nM = M / 256, nN = N / 256, ntiles = nM * nN;
    const int gx = gridDim.x, nxg = (gx % 8 == 0 && ntiles % 8 == 0) ? 8 : 1, bpg = gx / nxg, tpg = ntiles / nxg;
    const int grp = blockIdx.x % nxg, bin = blockIdx.x / nxg;
    const int grow = 16 * wave + (lane >> 2), gch = (lane & 3) ^ ((grow >> 2) & 3);
    const unsigned goff = (unsigned)(grow * GK + gch * 8) * 2u;
    constexpr int NKT = GK / 32, STG = 32768;
#define G_DMA1(kt_, Ag_, Bg_, op_, i_) do { const unsigned char* sb_ = (const unsigned char*)((op_) ? (Bg_) : (Ag_)) + (kt_) * 64; \
            __builtin_amdgcn_global_load_lds((const unsigned*)(sb_ + (i_) * (128 * GK * 2) + goff), (unsigned*)(smem + ((kt_) & 3) * STG + wave * 1024 + (op_) * 16384 + (i_) * 8192), 16, 0, 0); } while (0)
#define G_STAGE(kt_, Ag_, Bg_) do { G_DMA1(kt_, Ag_, Bg_, 0, 0); G_DMA1(kt_, Ag_, Bg_, 1, 0); G_DMA1(kt_, Ag_, Bg_, 0, 1); G_DMA1(kt_, Ag_, Bg_, 1, 1); } while (0)
#define G_SWZ32(row_, c_) ((row_) * 64 + ((((c_) ^ ((row_) >> 2)) & 3) << 4))
#define G_COMPUTE(kt_, Ag_, Bg_, pf_) do { const unsigned char* la_ = smem + ((kt_) & 3) * STG; const unsigned char* lb_ = la_ + 16384; \
            bf16x8 af_[2][4], bf_[2][2]; \
            _Pragma("unroll") for (int ks_ = 0; ks_ < 2; ++ks_) { \
                _Pragma("unroll") for (int i_ = 0; i_ < 4; ++i_) af_[ks_][i_] = *(const bf16x8*)(la_ + G_SWZ32(wm * 128 + i_ * 32 + r, ks_ * 2 + h)); \
                _Pragma("unroll") for (int j_ = 0; j_ < 2; ++j_) bf_[ks_][j_] = *(const bf16x8*)(lb_ + G_SWZ32(wn * 64 + j_ * 32 + r, ks_ * 2 + h)); } \
            __builtin_amdgcn_sched_barrier(0); \
            _Pragma("unroll") for (int g_ = 0; g_ < 4; ++g_) { const int ks_ = g_ >> 1, j_ = g_ & 1; \
                _Pragma("unroll") for (int i_ = 0; i_ < 4; ++i_) acc[j_][i_] = __builtin_amdgcn_mfma_f32_32x32x16_bf16(bf_[ks_][j_], af_[ks_][i_], acc[j_][i_], 0, 0, 0); \
                __builtin_amdgcn_sched_barrier(0); \
                if (pf_) G_DMA1((kt_) + 3, Ag_, Bg_, g_ & 1, g_ >> 1); \
                __builtin_amdgcn_sched_barrier(0); } } while (0)
#define G_RAWBAR() do { asm volatile("s_waitcnt lgkmcnt(0)" ::: "memory"); __builtin_amdgcn_s_barrier(); asm volatile("" ::: "memory"); } while (0)
    for (int tt = bin; tt < tpg; tt += bpg) {
        const int t = grp * tpg + tt;
        const int pm = t / nN, pn = t % nN;
        const bf16_t* Ag = A + (size_t)pm * 256 * GK; const bf16_t* Bg = Bt + (size_t)pn * 256 * GK;
        f32x16 acc[2][4];
#pragma unroll
        for (int j = 0; j < 2; ++j)
#pragma unroll
            for (int i = 0; i < 4; ++i)
#pragma unroll
                for (int e = 0; e < 16; ++e) acc[j][i][e] = 0.f;
        G_RAWBAR();
        G_STAGE(0, Ag, Bg); G_STAGE(1, Ag, Bg); G_STAGE(2, Ag, Bg);
        for (int kt = 0; kt < NKT; ++kt) {
            if (kt + 2 < NKT) asm volatile("s_waitcnt vmcnt(8)" ::: "memory");
            else if (kt + 1 < NKT) asm volatile("s_waitcnt vmcnt(4)" ::: "memory");
            else asm volatile("s_waitcnt vmcnt(0)" ::: "memory");
            G_RAWBAR();
            G_COMPUTE(kt, Ag, Bg, kt + 3 < NKT);
        }
        G_RAWBAR();
#pragma unroll
        for (int j = 0; j < 2; ++j)
#pragma unroll
            for (int i = 0; i < 4; ++i)
#pragma unroll
                for (int g = 0; g < 4; ++g) {
                    u32x2 v; v.x = pk_bf16(acc[j][i][4 * g], acc[j][i][4 * g + 1]); v.y = pk_bf16(acc[j][i][4 * g + 2], acc[j][i][4 * g + 3]);
                    *(u32x2*)(smem + (size_t)(wm * 128 + i * 32 + r) * (STG_STRIDE * 2) + (wn * 64 + j * 32 + 8 * g + 4 * h) * 2) = v;
                }
        __syncthreads();
        const int erow = tid >> 5, ec8 = tid & 31;
#pragma unroll 4
        for (int ps = 0; ps < 16; ++ps) { const int row = ps * 16 + erow; epi(pm * 256 + row, pn, ec8, smem + (size_t)row * (STG_STRIDE * 2)); }
    }
#undef G_DMA1
#undef G_STAGE
#undef G_COMPUTE
#undef G_SWZ32
#undef G_RAWBAR
    __syncthreads();
}


constexpr int DN_CH_BYTES = 73728;

constexpr int DP_QS = 0, DP_KS = 16384, DP_TI = 0, DP_Q = 17408, DP_TB = 21632;
constexpr int DP_RT = 32768;
constexpr int DP_AM = 69632;
constexpr int DP_KDT = 87040;
constexpr int DP_QK = 104448;
constexpr int DP_WI = 113152;
constexpr int DP_SM = 130048;

__device__ __forceinline__ void phase_dn_prep(const Params& p, unsigned char* smem) {
    const int tid0 = threadIdx.x;
    float* sbeta = (float*)(smem + DP_SM); float* sgc = sbeta + 64; float* segc = sbeta + 128; float* sekd = sbeta + 192;
    float* Am = (float*)(smem + DP_AM); float* Ti = (float*)(smem + DP_TI); float* Qb = (float*)(smem + DP_Q);
    bf16_t* Tb = (bf16_t*)(smem + DP_TB); bf16_t* Rt = (bf16_t*)(smem + DP_RT);
    bf16_t* kdt = (bf16_t*)(smem + DP_KDT); bf16_t* qki = (bf16_t*)(smem + DP_QK); bf16_t* wim = (bf16_t*)(smem + DP_WI);
    u32x4 xin[7][2]; float pre_b = 0.f, pre_a = 0.f;
    auto dn_fetch = [&](int cj) {
        const int tq = tid0, bhj = cj >> 7, nj = cj & 127, hj = bhj & 3;
        const bf16_t* prj = p.proj_b + (size_t)(bhj >> 2) * SEQ * NP_IN;
        if (tq < 384) {
            const int mat = tq >> 7, rg = (tq >> 3) & 15, sg = tq & 7;
            const int colbase = (mat == 0 ? P_DQ : (mat == 1 ? P_DK : P_DV)) + hj * 128 + sg * 16;
#pragma unroll
            for (int rr = 0; rr < 7; ++rr) {
                const int tt = nj * 64 + 4 * rg - 3 + rr;
                if (tt >= 0) { xin[rr][0] = *(const u32x4*)(prj + (size_t)tt * NP_IN + colbase); xin[rr][1] = *(const u32x4*)(prj + (size_t)tt * NP_IN + colbase + 8); }
                else { xin[rr][0] = (u32x4){0u, 0u, 0u, 0u}; xin[rr][1] = (u32x4){0u, 0u, 0u, 0u}; }
            }
        }
        if (tq < 64) { const size_t m = (size_t)(nj * 64 + tq); pre_b = bf2f(prj[m * NP_IN + P_B + hj]); pre_a = bf2f(prj[m * NP_IN + P_A + hj]); }
    };
    if (blockIdx.x < 16 * 128) dn_fetch(blockIdx.x);
    for (int ci = blockIdx.x; ci < 16 * 128; ci += gridDim.x) {
        int tid = tid0; asm volatile("" : "+v"(tid));
        const int lane = tid & 63, wave = tid >> 6;
        const int bh = ci >> 7, n = ci & 127, b = bh >> 2, h = bh & 3;
        const bf16_t* prow = p.proj_b + (size_t)b * SEQ * NP_IN;
        if (wave == 0) {
            const float braw = pre_b, araw = pre_a;
            const float beta = 1.f / (1.f + expf(-braw));
            const float xx = araw + p.dt_bias[h];
            const float sp = xx > 20.f ? xx : log1pf(expf(xx));
            float g = -expf(p.a_log[h]) * sp;
#pragma unroll
            for (int o = 1; o < 64; o <<= 1) { const float up = __shfl_up(g, o); if (lane >= o) g += up; }
            const float g63 = __shfl(g, 63);
            sbeta[lane] = beta; sgc[lane] = g; segc[lane] = expf(g); sekd[lane] = expf(g63 - g);
            if (lane == 63) p.dn_gl[ci] = expf(g63);
        }
        __syncthreads();
        if (tid < 384) {
            const int mat = tid >> 7, rg = (tid >> 3) & 15, sg = tid & 7, c0 = sg * 16, i0 = 4 * rg;
            const int colbase = (mat == 0 ? P_DQ : (mat == 1 ? P_DK : P_DV)) + h * 128 + c0;
            float wgt[4][16];
#pragma unroll
            for (int j = 0; j < 4; ++j) {
                const float* wp = p.conv_w + j * 1536 + mat * 512 + h * 128 + c0;
#pragma unroll
                for (int q4 = 0; q4 < 4; ++q4) { const float4 w4 = *(const float4*)(wp + 4 * q4); wgt[j][4 * q4] = w4.x; wgt[j][4 * q4 + 1] = w4.y; wgt[j][4 * q4 + 2] = w4.z; wgt[j][4 * q4 + 3] = w4.w; }
            }
#pragma unroll
            for (int ro = 0; ro < 4; ++ro) {
                const int i = i0 + ro, ix = i ^ (sg << 3);
                float acc[16];
#pragma unroll
                for (int cc = 0; cc < 16; ++cc) acc[cc] = 0.f;
#pragma unroll
                for (int j = 0; j < 4; ++j) {
                    const u32x4 x0 = xin[ro + j][0], x1 = xin[ro + j][1];
                    const unsigned xs[8] = {x0.x, x0.y, x0.z, x0.w, x1.x, x1.y, x1.z, x1.w};
#pragma unroll
                    for (int c2 = 0; c2 < 8; ++c2) { acc[2 * c2] = fmaf(wgt[j][2 * c2], bflo(xs[c2]), acc[2 * c2]); acc[2 * c2 + 1] = fmaf(wgt[j][2 * c2 + 1], bfhi(xs[c2]), acc[2 * c2 + 1]); }
                }
                float ss = 0.f;
#pragma unroll
                for (int cc = 0; cc < 16; ++cc) { acc[cc] = silu_f(acc[cc]); ss = fmaf(acc[cc], acc[cc], ss); }
                const float beta_i = sbeta[i], egc_i = segc[i], ekd_i = sekd[i];
                if (mat < 2) {
                    ss += __shfl_xor(ss, 1); ss += __shfl_xor(ss, 2); ss += __shfl_xor(ss, 4);
                    const float rs = rsqrtf(ss + L2_EPS) * (mat == 0 ? 0.08838834764831845f : 1.f);
#pragma unroll
                    for (int cc = 0; cc < 16; ++cc) acc[cc] *= rs;
                    unsigned char* img = smem + (mat == 0 ? DP_QS : DP_KS) + i * 256;
                    u32x4 c0v, c1v;
                    c0v.x = pk_bf16(acc[0], acc[1]); c0v.y = pk_bf16(acc[2], acc[3]); c0v.z = pk_bf16(acc[4], acc[5]); c0v.w = pk_bf16(acc[6], acc[7]);
                    c1v.x = pk_bf16(acc[8], acc[9]); c1v.y = pk_bf16(acc[10], acc[11]); c1v.z = pk_bf16(acc[12], acc[13]); c1v.w = pk_bf16(acc[14], acc[15]);
                    *(u32x4*)(img + (((2 * sg) ^ (i & 15)) << 4)) = c0v;
                    *(u32x4*)(img + (((2 * sg + 1) ^ (i & 15)) << 4)) = c1v;
                }
                if (mat == 0) {
                    u32x4 p0, p1;
                    p0.x = pk_bf16(acc[0] * egc_i, acc[1] * egc_i); p0.y = pk_bf16(acc[2] * egc_i, acc[3] * egc_i); p0.z = pk_bf16(acc[8] * egc_i, acc[9] * egc_i); p0.w = pk_bf16(acc[10] * egc_i, acc[11] * egc_i);
                    p1.x = pk_bf16(acc[4] * egc_i, acc[5] * egc_i); p1.y = pk_bf16(acc[6] * egc_i, acc[7] * egc_i); p1.z = pk_bf16(acc[12] * egc_i, acc[13] * egc_i); p1.w = pk_bf16(acc[14] * egc_i, acc[15] * egc_i);
                    bf16_t* dst = p.dn_qd + ((size_t)(ci * 16 + (i >> 5) * 8 + sg) * 64) * 8;
                    *(u32x4*)(dst + (size_t)(i & 31) * 8) = p0;
                    *(u32x4*)(dst + (size_t)(32 + (i & 31)) * 8) = p1;
                } else if (mat == 1) {
                    const float sc = beta_i * egc_i;
#pragma unroll
                    for (int cc = 0; cc < 16; ++cc) {
                        Rt[(128 + c0 + cc) * 72 + ix] = (bf16_t)(pk_bf16(acc[cc] * sc, 0.f) & 0xffffu);
                        kdt[(c0 + cc) * 68 + ix] = (bf16_t)(pk_bf16(acc[cc] * ekd_i, 0.f) & 0xffffu);
                    }
                } else {
#pragma unroll
                    for (int cc = 0; cc < 16; ++cc) Rt[(c0 + cc) * 72 + ix] = (bf16_t)(pk_bf16(acc[cc] * beta_i, 0.f) & 0xffffu);
                }
            }
        }
        if (ci + (int)gridDim.x < 16 * 128) dn_fetch(ci + (int)gridDim.x);
        __syncthreads();
        {
            const int mat = wave >> 2, ti = (wave >> 1) & 1, tj = wave & 1, r = lane & 31, hh = lane >> 5;
            const unsigned char* ai = smem + (mat ? DP_QS : DP_KS) + (ti * 32 + r) * 256;
            const unsigned char* bi = smem + DP_KS + (tj * 32 + r) * 256;
            f32x16 d;
#pragma unroll
            for (int e = 0; e < 16; ++e) d[e] = 0.f;
#pragma unroll
            for (int ks = 0; ks < 8; ++ks) {
                const bf16x8 af = *(const bf16x8*)(ai + (((2 * ks + hh) ^ (r & 15)) << 4));
                const bf16x8 bf = *(const bf16x8*)(bi + (((2 * ks + hh) ^ (r & 15)) << 4));
                d = __builtin_amdgcn_mfma_f32_32x32x16_bf16(af, bf, d, 0, 0, 0);
            }
            const int j = tj * 32 + r; const float gcj = sgc[j];
#pragma unroll
            for (int e = 0; e < 16; ++e) {
                const int i = ti * 32 + (e & 3) + 8 * (e >> 2) + 4 * hh;
                const float dec = __expf(fminf(sgc[i] - gcj, 0.f));
                if (mat == 0) Am[i * 68 + j] = (j < i) ? sbeta[i] * d[e] * dec : 0.f;
                else qki[i * 68 + j] = (bf16_t)(pk_bf16((j <= i) ? d[e] * dec : 0.f, 0.f) & 0xffffu);
            }
        }
        __syncthreads();
        if (tid < 64) {
            const int bk = tid >> 4, c = tid & 15;
            const float* Ab = Am + (16 * bk) * 68 + 16 * bk;
            float X[16];
#pragma unroll
            for (int i = 0; i < 16; ++i) {
                float sacc = 0.f;
#pragma unroll
                for (int j = 0; j < i; ++j) sacc = fmaf(Ab[i * 68 + j], X[j], sacc);
                X[i] = ((i == c) ? 1.f : 0.f) - sacc;
            }
#pragma unroll
            for (int i = 0; i < 16; ++i) Ti[(16 * bk + i) * 68 + 16 * bk + c] = X[i];
        } else {
            for (int z = tid - 64; z < 6 * 256; z += 448) {
                const int blk = z >> 8, e2 = z & 255, bi = blk < 3 ? 0 : (blk < 5 ? 1 : 2), bj = blk < 3 ? blk + 1 : (blk < 5 ? blk - 1 : 3);
                Ti[(16 * bi + (e2 >> 4)) * 68 + 16 * bj + (e2 & 15)] = 0.f;
            }
        }
        __syncthreads();
        {
            const int w2 = tid >> 8, o = tid & 255, ri = o >> 4, cj = o & 15, r0 = 16 * (2 * w2 + 1), c0 = 16 * (2 * w2);
            float sacc = 0.f;
#pragma unroll
            for (int k = 0; k < 16; ++k) sacc = fmaf(Am[(r0 + ri) * 68 + c0 + k], Ti[(c0 + k) * 68 + c0 + cj], sacc);
            Qb[w2 * 272 + ri * 17 + cj] = sacc;
        }
        __syncthreads();
        {
            const int w2 = tid >> 8, o = tid & 255, ri = o >> 4, cj = o & 15, r0 = 16 * (2 * w2 + 1), c0 = 16 * (2 * w2);
            float sacc = 0.f;
#pragma unroll
            for (int k = 0; k < 16; ++k) sacc = fmaf(Ti[(r0 + ri) * 68 + r0 + k], Qb[w2 * 272 + k * 17 + cj], sacc);
            Ti[(r0 + ri) * 68 + c0 + cj] = -sacc;
        }
        __syncthreads();
        float q3[2];
#pragma unroll
        for (int q = 0; q < 2; ++q) {
            const int o = tid + 512 * q, ri = o >> 5, cj = o & 31;
            float sacc = 0.f;
#pragma unroll
            for (int k = 0; k < 32; ++k) sacc = fmaf(Am[(32 + ri) * 68 + k], Ti[k * 68 + cj], sacc);
            q3[q] = sacc;
        }
#pragma unroll
        for (int q = 0; q < 2; ++q) { const int o = tid + 512 * q; Qb[(o >> 5) * 33 + (o & 31)] = q3[q]; }
        __syncthreads();
#pragma unroll
        for (int q = 0; q < 2; ++q) {
            const int o = tid + 512 * q, ri = o >> 5, cj = o & 31;
            float sacc = 0.f;
#pragma unroll
            for (int k = 0; k < 32; ++k) sacc = fmaf(Ti[(32 + ri) * 68 + 32 + k], Qb[k * 33 + cj], sacc);
            q3[q] = -sacc;
        }
        __syncthreads();
#pragma unroll
        for (int q = 0; q < 2; ++q) { const int o = tid + 512 * q; Ti[(32 + (o >> 5)) * 68 + (o & 31)] = q3[q]; }
        __syncthreads();
#pragma unroll
        for (int q = 0; q < 4; ++q) {
            const int o2 = tid + 512 * q, ri = o2 >> 5, c2 = (o2 & 31) * 2;
            *(unsigned*)(Tb + ri * 72 + c2) = pk_bf16(Ti[ri * 68 + c2], Ti[ri * 68 + c2 + 1]);
        }
        __syncthreads();
        {
            const int ct = wave, r = lane & 31, hh = lane >> 5;
            f32x16 xacc[2];
#pragma unroll
            for (int T = 0; T < 2; ++T)
#pragma unroll
                for (int e = 0; e < 16; ++e) xacc[T][e] = 0.f;
#pragma unroll
            for (int ks = 0; ks < 4; ++ks) {
                const bf16x8 bfr = *(const bf16x8*)(Rt + (32 * ct + r) * 72 + (((2 * ks + hh) ^ (((32 * ct + r) >> 4) & 7)) << 3));
#pragma unroll
                for (int T = 0; T < 2; ++T) {
                    const bf16x8 afr = *(const bf16x8*)(Tb + (32 * T + r) * 72 + 16 * ks + 8 * hh);
                    xacc[T] = __builtin_amdgcn_mfma_f32_32x32x16_bf16(afr, bfr, xacc[T], 0, 0, 0);
                }
            }
            if (ct < 4) {
#pragma unroll
                for (int T = 0; T < 2; ++T)
#pragma unroll
                    for (int hf = 0; hf < 2; ++hf) {
                        u32x4 o; o.x = pk_bf16(xacc[T][8 * hf], xacc[T][8 * hf + 1]); o.y = pk_bf16(xacc[T][8 * hf + 2], xacc[T][8 * hf + 3]);
                        o.z = pk_bf16(xacc[T][8 * hf + 4], xacc[T][8 * hf + 5]); o.w = pk_bf16(xacc[T][8 * hf + 6], xacc[T][8 * hf + 7]);
                        *(u32x4*)(p.dn_u + ((size_t)(((ci * 4 + ct) * 2 + T) * 2 + hf) * 64 + lane) * 8) = o;
                    }
            } else {
                const int dd = 32 * (ct - 4) + r;
#pragma unroll
                for (int T = 0; T < 2; ++T)
#pragma unroll
                    for (int e = 0; e < 16; ++e) wim[(32 * T + (e & 3) + 8 * (e >> 2) + 4 * hh) * 132 + dd] = (bf16_t)(pk_bf16(-xacc[T][e], 0.f) & 0xffffu);
            }
#pragma unroll
            for (int q = 0; q < 3; ++q) {
                const int pc = tid + 512 * q;
                if (pc < 512) {
                    const int f = pc >> 6, ln = pc & 63, r2 = ln & 31, h2 = ln >> 5, rt = f >> 2, ks = f & 3;
                    const bf16_t* src = qki + (32 * rt + r2) * 68 + 16 * ks + 4 * h2;
                    const u32x2 lo = *(const u32x2*)src, hi = *(const u32x2*)(src + 8);
                    u32x4 o; o.x = lo.x; o.y = lo.y; o.z = hi.x; o.w = hi.y;
                    *(u32x4*)(p.dn_qk + ((size_t)(ci * 8 + f) * 64 + ln) * 8) = o;
                } else {
                    const int pc2 = pc - 512, f = pc2 >> 6, ln = pc2 & 63, r2 = ln & 31, h2 = ln >> 5, rt = f >> 2, ks = f & 3;
                    const int dd2 = 32 * rt + r2, sx = ((dd2 >> 4) & 7) << 3, i0 = 16 * ks + 4 * h2;
                    const u32x2 lo = *(const u32x2*)(kdt + dd2 * 68 + (i0 ^ sx)), hi = *(const u32x2*)(kdt + dd2 * 68 + ((i0 + 8) ^ sx));
                    u32x4 o; o.x = lo.x; o.y = lo.y; o.z = hi.x; o.w = hi.y;
                    *(u32x4*)(p.dn_kdt + ((size_t)(ci * 16 + f) * 64 + ln) * 8) = o;
                }
            }
        }
        __syncthreads();
#pragma unroll
        for (int q = 0; q < 2; ++q) {
            const int pc = tid + 512 * q, f = pc >> 6, ln = pc & 63, r = ln & 31, hh = ln >> 5, rt = f >> 3, ks = f & 7;
            const bf16_t* src = wim + (32 * rt + r) * 132 + 16 * ks + 4 * hh;
            const u32x2 lo = *(const u32x2*)src, hi = *(const u32x2*)(src + 8);
            u32x4 o; o.x = lo.x; o.y = lo.y; o.z = hi.x; o.w = hi.y;
            *(u32x4*)(p.dn_negw + ((size_t)(ci * 16 + f) * 64 + ln) * 8) = o;
        }
    }
    __syncthreads();
}

__device__ __forceinline__ bf16x8 pack8(const f32x16& x, int s) {
    u32x4 v;
    v.x = pk_bf16(x[8 * s], x[8 * s + 1]); v.y = pk_bf16(x[8 * s + 2], x[8 * s + 3]); v.z = pk_bf16(x[8 * s + 4], x[8 * s + 5]); v.w = pk_bf16(x[8 * s + 6], x[8 * s + 7]);
    return __builtin_bit_cast(bf16x8, v);
}
#define LDS_BARRIER() do { asm volatile("s_waitcnt lgkmcnt(0)" ::: "memory"); __builtin_amdgcn_s_barrier(); asm volatile("" ::: "memory"); } while (0)
__device__ __forceinline__ const bf16_t* dn_piece_src(const Params& p, int ci, int pc) {
    return pc < 1024 ? p.dn_negw + ((size_t)ci * 1024 + pc) * 8 : pc < 2048 ? p.dn_qd + ((size_t)ci * 1024 + (pc - 1024)) * 8
         : pc < 3072 ? p.dn_kdt + ((size_t)ci * 1024 + (pc - 2048)) * 8 : pc < 3584 ? p.dn_qk + ((size_t)ci * 512 + (pc - 3072)) * 8 : p.dn_u + ((size_t)ci * 1024 + (pc - 3584)) * 8;
}
constexpr int DN_SEG = 32;
template <int PASS> __device__ __forceinline__ int dn_lpiece(int q) { return PASS == 0 ? q : (q < 1024 ? q : (q < 2048 ? q + 1024 : q + 1536)); }
template <int PASS>
__device__ __forceinline__ void dn_scan_seg(const Params& p, unsigned char* smem, int bh, int seg, int half) {
    constexpr int NPC = PASS == 0 ? 4608 : 3072, LPT = NPC / 256, PPT = NPC / 512;
    const int tid = threadIdx.x, lane = tid & 63, wave = tid >> 6, r = lane & 31, hh = lane >> 5;
    const int b = bh >> 2, h = bh & 3, ci0 = bh * 128 + seg * DN_SEG;
#pragma unroll
    for (int q = 0; q < PPT; ++q) { const int pc = dn_lpiece<PASS>(tid + 512 * q); *(u32x4*)(smem + pc * 16) = *(const u32x4*)dn_piece_src(p, ci0, pc); }
    __syncthreads();
    if (wave >= 4) {
        const int t2 = tid - 256;
        u32x4 sa[LPT], sb[LPT], sc[LPT];
#define DN_LD(dst, chunk) do { const int c_ = ci0 + ((chunk) < DN_SEG - 1 ? (chunk) : DN_SEG - 1); _Pragma("unroll") for (int q_ = 0; q_ < LPT; ++q_) dst[q_] = *(const u32x4*)dn_piece_src(p, c_, dn_lpiece<PASS>(t2 + 256 * q_)); } while (0)
#define DN_WR(src, chunk) do { if ((chunk) < DN_SEG) { unsigned char* nb_ = smem + ((chunk) & 1) * DN_CH_BYTES; _Pragma("unroll") for (int q_ = 0; q_ < LPT; ++q_) *(u32x4*)(nb_ + dn_lpiece<PASS>(t2 + 256 * q_) * 16) = src[q_]; } } while (0)
        DN_LD(sa, 1); DN_LD(sb, 2); DN_LD(sc, 3);
        unsigned* prog = p.bar + XCD_BAR_WORDS + 64 * (bh * 4 + seg);
#define DN_PUB(v) do { if (PASS == 0 && t2 == 0) __hip_atomic_store(prog, (unsigned)(v), __ATOMIC_RELAXED, __HIP_MEMORY_SCOPE_AGENT); } while (0)
        for (int n = 0; n < DN_SEG + 1; n += 3) {
            if (n < DN_SEG) { DN_WR(sa, n + 1); DN_LD(sa, n + 4); DN_PUB(n + 1); LDS_BARRIER(); }
            if (n + 1 < DN_SEG) { DN_WR(sb, n + 2); DN_LD(sb, n + 5); DN_PUB(n + 2); LDS_BARRIER(); }
            if (n + 2 < DN_SEG) { DN_WR(sc, n + 3); DN_LD(sc, n + 6); DN_PUB(n + 3); LDS_BARRIER(); }
        }
#undef DN_PUB
#undef DN_LD
#undef DN_WR
    } else {
        const int e = __builtin_amdgcn_readfirstlane(wave);
        const int sl = 4 * half + e;
        const bool isP = sl < 4;
        f32x16 S[4];
#pragma unroll
        for (int T = 0; T < 4; ++T)
#pragma unroll
            for (int e2 = 0; e2 < 16; ++e2) {
                const int row = 32 * T + (e2 & 3) + 8 * (e2 >> 2) + 4 * hh;
                if (PASS == 0) S[T][e2] = seg > 0 ? p.dn_PB[((size_t)(bh * 3 + 0) * 128 + row) * 256 + 128 + 32 * e + r] : 0.f;
                else S[T][e2] = (isP && row == 32 * sl + r) ? 1.f : 0.f;
            }
        if (PASS == 0) {
            for (int sg = 1; sg < seg; ++sg) {
                const float* pseg = p.dn_PB + (size_t)(bh * 3 + sg) * 128 * 256;
                bf16x8 Xb[8];
#pragma unroll
                for (int T = 0; T < 4; ++T) { Xb[2 * T] = pack8(S[T], 0); Xb[2 * T + 1] = pack8(S[T], 1); }
#pragma unroll
                for (int T = 0; T < 4; ++T) {
                    f32x16 xn;
#pragma unroll
                    for (int e2 = 0; e2 < 16; ++e2) xn[e2] = pseg[(size_t)(32 * T + (e2 & 3) + 8 * (e2 >> 2) + 4 * hh) * 256 + 128 + 32 * e + r];
#pragma unroll
                    for (int ks = 0; ks < 8; ++ks) {
                        const float* pr = pseg + (size_t)(32 * T + r) * 256 + 16 * ks + 4 * hh;
                        const float4 lo = *(const float4*)pr, hi = *(const float4*)(pr + 8);
                        u32x4 av; av.x = pk_bf16(lo.x, lo.y); av.y = pk_bf16(lo.z, lo.w); av.z = pk_bf16(hi.x, hi.y); av.w = pk_bf16(hi.z, hi.w);
                        xn = __builtin_amdgcn_mfma_f32_32x32x16_bf16(__builtin_bit_cast(bf16x8, av), Xb[ks], xn, 0, 0, 0);
                        if (ks & 1) __builtin_amdgcn_sched_barrier(0);
                    }
                    S[T] = xn;
                    __builtin_amdgcn_sched_barrier(0);
                }
            }
        }
        const float glr = p.dn_gl[ci0 + (lane & 31)];
#define DN_SB() __builtin_amdgcn_sched_barrier(0)
#define DN_RD8(dst, off) do { _Pragma("unroll") for (int q_ = 0; q_ < 8; ++q_) dst[q_] = *(const bf16x8*)(buf + (off) + q_ * 1024 + lane * 16); } while (0)
        bf16x8 Sb[8];
#pragma unroll
        for (int T = 0; T < 4; ++T) { Sb[2 * T] = pack8(S[T], 0); Sb[2 * T + 1] = pack8(S[T], 1); }
        const unsigned ooff = (unsigned)(4 * hh * 512 + r);
        for (int n = 0; n < DN_SEG; ++n) {
            const unsigned char* buf = smem + (n & 1) * DN_CH_BYTES;
            const float gl = __uint_as_float(__builtin_amdgcn_readlane(__float_as_uint(glr), n));
            bf16x8 fa[8], fb[8];
            DN_RD8(fa, 0);
            DN_RD8(fb, 8192);
            f32x16 vn0, vn1;
            if (PASS == 0 || !isP) {
                const unsigned char* ub = buf + 57344 + (PASS == 0 ? e : sl - 4) * 4096 + lane * 16;
                const u32x4 u00 = *(const u32x4*)ub, u01 = *(const u32x4*)(ub + 1024), u10 = *(const u32x4*)(ub + 2048), u11 = *(const u32x4*)(ub + 3072);
                vn0[0] = bflo(u00.x); vn0[1] = bfhi(u00.x); vn0[2] = bflo(u00.y); vn0[3] = bfhi(u00.y); vn0[4] = bflo(u00.z); vn0[5] = bfhi(u00.z); vn0[6] = bflo(u00.w); vn0[7] = bfhi(u00.w);
                vn0[8] = bflo(u01.x); vn0[9] = bfhi(u01.x); vn0[10] = bflo(u01.y); vn0[11] = bfhi(u01.y); vn0[12] = bflo(u01.z); vn0[13] = bfhi(u01.z); vn0[14] = bflo(u01.w); vn0[15] = bfhi(u01.w);
                vn1[0] = bflo(u10.x); vn1[1] = bfhi(u10.x); vn1[2] = bflo(u10.y); vn1[3] = bfhi(u10.y); vn1[4] = bflo(u10.z); vn1[5] = bfhi(u10.z); vn1[6] = bflo(u10.w); vn1[7] = bfhi(u10.w);
                vn1[8] = bflo(u11.x); vn1[9] = bfhi(u11.x); vn1[10] = bflo(u11.y); vn1[11] = bfhi(u11.y); vn1[12] = bflo(u11.z); vn1[13] = bfhi(u11.z); vn1[14] = bflo(u11.w); vn1[15] = bfhi(u11.w);
            } else {
#pragma unroll
                for (int e2 = 0; e2 < 16; ++e2) { vn0[e2] = 0.f; vn1[e2] = 0.f; }
            }
            DN_SB();
#pragma unroll
            for (int ks = 0; ks < 8; ++ks) vn0 = __builtin_amdgcn_mfma_f32_32x32x16_bf16(fa[ks], Sb[ks], vn0, 0, 0, 0);
            DN_SB();
            if (PASS == 0) DN_RD8(fa, 16384); else DN_RD8(fa, 32768);
            DN_SB();
#pragma unroll
            for (int ks = 0; ks < 8; ++ks) vn1 = __builtin_amdgcn_mfma_f32_32x32x16_bf16(fb[ks], Sb[ks], vn1, 0, 0, 0);
            DN_SB();
            if (PASS == 0) DN_RD8(fb, 16384 + 8192); else DN_RD8(fb, 32768 + 8192);
            DN_SB();
            f32x16 o0, o1;
            if (PASS == 0) {
#pragma unroll
                for (int e2 = 0; e2 < 16; ++e2) { o0[e2] = 0.f; o1[e2] = 0.f; }
#pragma unroll
                for (int ks = 0; ks < 8; ++ks) o0 = __builtin_amdgcn_mfma_f32_32x32x16_bf16(fa[ks], Sb[ks], o0, 0, 0, 0);
                DN_SB();
                DN_RD8(fa, 32768);
            }
            bf16x8 vb[4];
            vb[0] = pack8(vn0, 0); vb[1] = pack8(vn0, 1); vb[2] = pack8(vn1, 0); vb[3] = pack8(vn1, 1);
            DN_SB();
            if (PASS == 0) {
#pragma unroll
                for (int ks = 0; ks < 8; ++ks) o1 = __builtin_amdgcn_mfma_f32_32x32x16_bf16(fb[ks], Sb[ks], o1, 0, 0, 0);
                DN_SB();
                DN_RD8(fb, 32768 + 8192);
            }
#pragma unroll
            for (int e2 = 0; e2 < 16; ++e2) { S[0][e2] *= gl; S[1][e2] *= gl; }
            DN_SB();
#pragma unroll
            for (int ks = 0; ks < 4; ++ks) S[0] = __builtin_amdgcn_mfma_f32_32x32x16_bf16(fa[ks], vb[ks], S[0], 0, 0, 0);
#pragma unroll
            for (int ks = 0; ks < 4; ++ks) S[1] = __builtin_amdgcn_mfma_f32_32x32x16_bf16(fa[4 + ks], vb[ks], S[1], 0, 0, 0);
            DN_SB();
            if (PASS == 0) DN_RD8(fa, 49152);
#pragma unroll
            for (int e2 = 0; e2 < 16; ++e2) { S[2][e2] *= gl; S[3][e2] *= gl; }
            DN_SB();
#pragma unroll
            for (int ks = 0; ks < 4; ++ks) S[2] = __builtin_amdgcn_mfma_f32_32x32x16_bf16(fb[ks], vb[ks], S[2], 0, 0, 0);
#pragma unroll
            for (int ks = 0; ks < 4; ++ks) S[3] = __builtin_amdgcn_mfma_f32_32x32x16_bf16(fb[4 + ks], vb[ks], S[3], 0, 0, 0);
            DN_SB();
            if (PASS == 0) {
#pragma unroll
                for (int ks = 0; ks < 4; ++ks) o0 = __builtin_amdgcn_mfma_f32_32x32x16_bf16(fa[ks], vb[ks], o0, 0, 0, 0);
#pragma unroll
                for (int ks = 0; ks < 4; ++ks) o1 = __builtin_amdgcn_mfma_f32_32x32x16_bf16(fa[4 + ks], vb[ks], o1, 0, 0, 0);
                DN_SB();
            }
#pragma unroll
            for (int T = 0; T < 4; ++T) { Sb[2 * T] = pack8(S[T], 0); Sb[2 * T + 1] = pack8(S[T], 1); }
            if (PASS == 0) {
                bf16_t* ob = p.odn_raw + ((size_t)b * SEQ + (seg * DN_SEG + n) * 64) * 512 + h * 128 + 32 * e;
#pragma unroll
                for (int e2 = 0; e2 < 16; e2 += 2) {
                    const unsigned w0 = pk_bf16(o0[e2], o0[e2 + 1]), w1 = pk_bf16(o1[e2], o1[e2 + 1]);
                    (ob + ((e2 & 3) + 8 * (e2 >> 2)) * 512)[ooff] = (bf16_t)(w0 & 0xffffu); (ob + ((e2 & 3) + 1 + 8 * (e2 >> 2)) * 512)[ooff] = (bf16_t)(w0 >> 16);
                    (ob + (32 + (e2 & 3) + 8 * (e2 >> 2)) * 512)[ooff] = (bf16_t)(w1 & 0xffffu); (ob + (32 + (e2 & 3) + 1 + 8 * (e2 >> 2)) * 512)[ooff] = (bf16_t)(w1 >> 16);
                }
            }
            LDS_BARRIER();
        }
#undef DN_RD8
#undef DN_SB
        if (PASS == 1) {
            float* pb = p.dn_PB + (size_t)(bh * 3 + seg) * 128 * 256 + 32 * sl + r;
#pragma unroll
            for (int T = 0; T < 4; ++T)
#pragma unroll
                for (int e2 = 0; e2 < 16; ++e2) pb[(size_t)(32 * T + (e2 & 3) + 8 * (e2 >> 2) + 4 * hh) * 256] = S[T][e2];
        }
    }
    __syncthreads();
}
__device__ __forceinline__ void phase_scan_l2_helper(const Params& p) {
    const int sj = blockIdx.x - 64, tid = threadIdx.x;
    const int bh = sj >> 2, seg = sj & 3, ci0 = bh * 128 + seg * DN_SEG;
    unsigned* prog = p.bar + XCD_BAR_WORDS + 64 * sj;
    unsigned acc = 0u;
    for (int m = 7; m < DN_SEG; ++m) {
        unsigned spins = 0, pr;
        for (;;) {
            pr = __hip_atomic_load(prog, __ATOMIC_RELAXED, __HIP_MEMORY_SCOPE_AGENT);
            if ((int)pr + 8 >= m || ++spins > 100000u) break;
            __builtin_amdgcn_s_sleep(16);
        }
        if ((int)pr + 4 >= m) continue;
#pragma unroll
        for (int q = 0; q < 9; ++q) { const u32x4 v = *(const u32x4*)dn_piece_src(p, ci0 + m, tid + 512 * q); acc ^= v.x ^ v.y ^ v.z ^ v.w; }
    }
    asm volatile("" :: "v"(acc));
}

constexpr int AT_VT = 32768, AT_VT_STRIDE = 260;
__device__ __forceinline__ void phase_attn(const Params& p, unsigned char* smem, int first_block) {
    const int tid0 = threadIdx.x;
    const int nblk = gridDim.x - first_block;
    const bf16_t* pb = p.proj_b;
    bf16_t* vt = (bf16_t*)(smem + AT_VT);
    u32x4 kvr[4], vvr[4]; bf16x8 qfn[4];
    auto at_fetch = [&](int it) {
        const int tq = tid0, ln = tq & 63, wv = tq >> 6;
        const int hp = it & 1, kvh = (it >> 1) & 1, nb = (it >> 2) & 63, b = it >> 8, m0 = b * SEQ + nb * 128;
#pragma unroll
        for (int i = 0; i < 4; ++i) {
            const int idx = tq + 512 * i, key = idx >> 3, ch = idx & 7;
            kvr[i] = (u32x4){0u, 0u, 0u, 0u}; vvr[i] = (u32x4){0u, 0u, 0u, 0u};
            if ((nb > 0) || (key >= 128)) { const bf16_t* src = pb + (size_t)(m0 - 128 + key) * NP_IN + kvh * 64 + ch * 8; kvr[i] = *(const u32x4*)(src + P_AK); vvr[i] = *(const u32x4*)(src + P_AV); }
        }
        const int head = kvh * 4 + hp * 2 + (wv >> 2), qo = (wv & 3) * 32;
        const bf16_t* qrow = pb + (size_t)(m0 + qo + (ln & 31)) * NP_IN + P_AQ + head * 64 + 8 * (ln >> 5);
#pragma unroll
        for (int ks = 0; ks < 4; ++ks) qfn[ks] = *(const bf16x8*)(qrow + 16 * ks);
    };
    if ((int)blockIdx.x - first_block < 1024) at_fetch((int)blockIdx.x - first_block);
    for (int item = blockIdx.x - first_block; item < 1024; item += nblk) {
        int tid = tid0; asm volatile("" : "+v"(tid));
        const int lane = tid & 63, wave = tid >> 6, r = lane & 31, hh = lane >> 5;
        const int hp = item & 1, kvh = (item >> 1) & 1, nb = (item >> 2) & 63, b = item >> 8;
        const int m0 = b * SEQ + nb * 128;
        __syncthreads();
#pragma unroll
        for (int i = 0; i < 4; ++i) {
            const int idx = tid + 512 * i, key = idx >> 3, ch = idx & 7;
            const u32x4 vv = vvr[i];
            *(u32x4*)(smem + swz(key, ch)) = kvr[i];
            bf16_t* vd = vt + (ch * 8) * AT_VT_STRIDE + (key ^ (ch << 3));
            vd[0] = (bf16_t)(vv.x & 0xffffu); vd[AT_VT_STRIDE] = (bf16_t)(vv.x >> 16); vd[2 * AT_VT_STRIDE] = (bf16_t)(vv.y & 0xffffu); vd[3 * AT_VT_STRIDE] = (bf16_t)(vv.y >> 16);
            vd[4 * AT_VT_STRIDE] = (bf16_t)(vv.z & 0xffffu); vd[5 * AT_VT_STRIDE] = (bf16_t)(vv.z >> 16); vd[6 * AT_VT_STRIDE] = (bf16_t)(vv.w & 0xffffu); vd[7 * AT_VT_STRIDE] = (bf16_t)(vv.w >> 16);
        }
        bf16x8 qf[4];
#pragma unroll
        for (int ks = 0; ks < 4; ++ks) qf[ks] = qfn[ks];
        __syncthreads();
        if (item + nblk < 1024) at_fetch(item + nblk);
        const int head = kvh * 4 + hp * 2 + (wave >> 2), qt = wave & 3, qo = qt * 32;
        f32x16 sc[5];
#pragma unroll
        for (int t = 0; t < 5; ++t) {
#pragma unroll
            for (int e = 0; e < 16; ++e) sc[t][e] = 0.f;
#pragma unroll
            for (int ks = 0; ks < 4; ++ks) sc[t] = __builtin_amdgcn_mfma_f32_32x32x16_bf16(*(const bf16x8*)(smem + swz((qt + t) * 32 + r, 2 * ks + hh)), qf[ks], sc[t], 0, 0, 0);
        }
        const float sink = p.sinks[head];
        float mx = -1e30f;
#pragma unroll
        for (int t = 0; t < 5; ++t)
#pragma unroll
            for (int e = 0; e < 16; ++e) {
                const int kf = 32 * (qt + t) + (e & 3) + 8 * (e >> 2) + 4 * hh;
                const bool ok = (kf >= qo + r + 1) && (kf <= qo + r + 128) && ((nb > 0) || (kf >= 128));
                sc[t][e] = ok ? sc[t][e] : -1e30f;
                mx = fmaxf(mx, sc[t][e]);
            }
        mx = fmaxf(mx, __shfl_xor(mx, 32));
        mx = fmaxf(mx, sink);
        float sum = 0.f;
#pragma unroll
        for (int t = 0; t < 5; ++t)
#pragma unroll
            for (int e = 0; e < 16; ++e) { const float pe = (sc[t][e] > -1e29f) ? __expf(sc[t][e] - mx) : 0.f; sc[t][e] = pe; sum += pe; }
        sum += __shfl_xor(sum, 32);
        const float inv = 1.f / (sum + __expf(sink - mx));
        f32x16 o[2];
#pragma unroll
        for (int dt = 0; dt < 2; ++dt)
#pragma unroll
            for (int e = 0; e < 16; ++e) o[dt][e] = 0.f;
#pragma unroll
        for (int t = 0; t < 5; ++t)
#pragma unroll
            for (int s2 = 0; s2 < 2; ++s2) {
                const bf16x8 pbv = pack8(sc[t], s2);
                const int kb = 32 * (qt + t) + 16 * s2 + 4 * hh;
#pragma unroll
                for (int dt = 0; dt < 2; ++dt) {
                    const int dvr = dt * 32 + r, vx = ((dvr >> 3) & 7) << 3;
                    const u32x2 lo = *(const u32x2*)(vt + dvr * AT_VT_STRIDE + (kb ^ vx)), hi = *(const u32x2*)(vt + dvr * AT_VT_STRIDE + ((kb + 8) ^ vx));
                    u32x4 av; av.x = lo.x; av.y = lo.y; av.z = hi.x; av.w = hi.y;
                    o[dt] = __builtin_amdgcn_mfma_f32_32x32x16_bf16(__builtin_bit_cast(bf16x8, av), pbv, o[dt], 0, 0, 0);
                }
            }
        bf16_t* orow = p.xb + (size_t)(m0 + qo + r) * D_MODEL + head * 64 + 4 * hh;
#pragma unroll
        for (int dt = 0; dt < 2; ++dt)
#pragma unroll
            for (int q4 = 0; q4 < 4; ++q4) {
                u32x2 v; v.x = pk_bf16(o[dt][4 * q4] * inv, o[dt][4 * q4 + 1] * inv); v.y = pk_bf16(o[dt][4 * q4 + 2] * inv, o[dt][4 * q4 + 3] * inv);
                *(u32x2*)(orow + dt * 32 + 8 * q4) = v;
            }
    }
    __syncthreads();
}

__device__ __forceinline__ void phase_dn_norm(const Params& p) {
    const int lane = threadIdx.x & 63, gw = blockIdx.x * (NTHREADS / 64) + (threadIdx.x >> 6), GW = gridDim.x * (NTHREADS / 64);
    const float2 g = *(const float2*)(p.dn_norm_g + lane * 2);
    for (int m = gw; m < M_TOK; m += GW) {
        float2 o[4]; unsigned z[4];
#pragma unroll
        for (int h = 0; h < 4; ++h) { const unsigned ow = *(const unsigned*)(p.odn_raw + (size_t)m * 512 + h * 128 + lane * 2); o[h] = make_float2(bflo(ow), bfhi(ow)); z[h] = *(const unsigned*)(p.proj_b + (size_t)m * NP_IN + P_Z + h * 128 + lane * 2); }
#pragma unroll
        for (int h = 0; h < 4; ++h) {
            const float ss = wave_sum(o[h].x * o[h].x + o[h].y * o[h].y);
            const float rr = rsqrtf(ss * (1.f / 128.f) + RMS_EPS);
            *(unsigned*)(p.xb + (size_t)m * D_MODEL + 512 + h * 128 + lane * 2) = pk_bf16(o[h].x * rr * g.x * silu_f(bflo(z[h])), o[h].y * rr * g.y * silu_f(bfhi(z[h])));
        }
    }
}

__device__ __forceinline__ void phase_ln1(const Params& p, bf16_t* x1b) {
    const int lane = threadIdx.x & 63, gw = blockIdx.x * (NTHREADS / 64) + (threadIdx.x >> 6), GW = gridDim.x * (NTHREADS / 64);
    float4 g[4], bb[4];
#pragma unroll
    for (int j = 0; j < 4; ++j) { g[j] = *(const float4*)(p.ln1_g + j * 256 + lane * 4); bb[j] = *(const float4*)(p.ln1_b + j * 256 + lane * 4); }
    for (int m0 = gw * 4; m0 < M_TOK; m0 += GW * 4) {
        float4 v[4][4];
#pragma unroll
        for (int rr = 0; rr < 4; ++rr)
#pragma unroll
            for (int j = 0; j < 4; ++j) v[rr][j] = *(const float4*)(p.out + (size_t)(m0 + rr) * D_MODEL + j * 256 + lane * 4);
#pragma unroll
        for (int rr = 0; rr < 4; ++rr) {
            float s = 0.f;
#pragma unroll
            for (int j = 0; j < 4; ++j) s += (v[rr][j].x + v[rr][j].y) + (v[rr][j].z + v[rr][j].w);
            const float mean = wave_sum(s) * (1.f / D_MODEL); float q = 0.f;
#pragma unroll
            for (int j = 0; j < 4; ++j) { v[rr][j].x -= mean; v[rr][j].y -= mean; v[rr][j].z -= mean; v[rr][j].w -= mean; q += (v[rr][j].x * v[rr][j].x + v[rr][j].y * v[rr][j].y) + (v[rr][j].z * v[rr][j].z + v[rr][j].w * v[rr][j].w); }
            const float rstd = rsqrtf(wave_sum(q) * (1.f / D_MODEL) + LN_EPS);
            if (lane == 0) *(float2*)(p.ln1_stats + (size_t)(m0 + rr) * 2) = make_float2(mean, rstd);
#pragma unroll
            for (int j = 0; j < 4; ++j) {
                u32x2 ob; ob.x = pk_bf16(v[rr][j].x * rstd * g[j].x + bb[j].x, v[rr][j].y * rstd * g[j].y + bb[j].y); ob.y = pk_bf16(v[rr][j].z * rstd * g[j].z + bb[j].z, v[rr][j].w * rstd * g[j].w + bb[j].w);
                *(u32x2*)(x1b + (size_t)(m0 + rr) * D_MODEL + j * 256 + lane * 4) = ob;
            }
        }
    }
}

__device__ __forceinline__ void cas_d(float& a, float& b) { const float hi = fmaxf(a, b), lo = fminf(a, b); a = hi; b = lo; }
__device__ __forceinline__ void cas_a(float& a, float& b) { const float hi = fmaxf(a, b), lo = fminf(a, b); a = lo; b = hi; }
__device__ __forceinline__ void sort16_desc(f32x16& v) {
#pragma unroll
    for (int k = 2; k <= 16; k <<= 1)
#pragma unroll
        for (int j = k >> 1; j > 0; j >>= 1)
#pragma unroll
            for (int i = 0; i < 16; ++i) {
                const int l = i ^ j;
                if (l > i) { float a = v[i], b = v[l]; if ((i & k) == 0) cas_d(a, b); else cas_a(a, b); v[i] = a; v[l] = b; }
            }
}
__device__ __forceinline__ void bmerge16_desc(f32x16& v) {
#pragma unroll
    for (int j = 8; j > 0; j >>= 1)
#pragma unroll
        for (int i = 0; i < 16; ++i) { const int l = i ^ j; if (l > i) { float a = v[i], b = v[l]; cas_d(a, b); v[i] = a; v[l] = b; } }
}
__device__ __forceinline__ f32x16 merge_top16(const f32x16& a, const f32x16& b) {
    f32x16 c;
#pragma unroll
    for (int i = 0; i < 16; ++i) c[i] = fmaxf(a[i], b[15 - i]);
    bmerge16_desc(c);
    return c;
}
__device__ __forceinline__ void pcas_d(float& va, int& ia, float& vb, int& ib) {
    const bool sw = vb > va; const float tv = sw ? vb : va; const int ti = sw ? ib : ia;
    vb = sw ? va : vb; ib = sw ? ia : ib; va = tv; ia = ti;
}
__device__ __forceinline__ void psort16_desc(float (&v)[16], int (&id)[16]) {
#pragma unroll
    for (int k = 2; k <= 16; k <<= 1)
#pragma unroll
        for (int j = k >> 1; j > 0; j >>= 1)
#pragma unroll
            for (int i = 0; i < 16; ++i) {
                const int l = i ^ j;
                if (l > i) { if ((i & k) == 0) pcas_d(v[i], id[i], v[l], id[l]); else pcas_d(v[l], id[l], v[i], id[i]); }
            }
}
__device__ __forceinline__ void pmerge_top16(float (&a)[16], int (&ia)[16], const float (&b)[16], const int (&ib)[16]) {
#pragma unroll
    for (int i = 0; i < 16; ++i) { const bool sw = b[15 - i] > a[i]; a[i] = sw ? b[15 - i] : a[i]; ia[i] = sw ? ib[15 - i] : ia[i]; }
#pragma unroll
    for (int j = 8; j > 0; j >>= 1)
#pragma unroll
        for (int i = 0; i < 16; ++i) { const int l = i ^ j; if (l > i) pcas_d(a[i], ia[i], a[l], ia[l]); }
}
__device__ __forceinline__ void phase_route(const Params& p, const bf16_t* qb) {
    constexpr int CI[50] = {0,0,0,0,0,0,0,0,0,0,0,0,0,0,0,0,1,1,1,1,1,1,1,1,2,2,2,2,2,3,3,3,3,4,4,4,5,5,6,6,7,7,8,9,10,11,12,13,14,15};
    constexpr int CJ[50] = {0,1,2,3,4,5,6,7,8,9,10,11,12,13,14,15,0,1,2,3,4,5,6,7,0,1,2,3,4,0,1,2,3,0,1,2,0,1,0,1,0,1,0,0,0,0,0,0,0,0};
    const int lane0 = threadIdx.x & 63, gw = blockIdx.x * (NTHREADS / 64) + (threadIdx.x >> 6), GW = gridDim.x * (NTHREADS / 64);
    for (int task = gw; task < (M_TOK / 32) * 8; task += GW) {
        int lane = lane0; asm volatile("" : "+v"(lane));
        const int r = lane & 31, hh = lane >> 5;
        const int h = task & 7, tok0 = (task >> 3) * 32;
        f32x16 top[2];
#pragma unroll
        for (int pp = 0; pp < 2; ++pp) {
            const bf16_t* qrow = qb + (size_t)(tok0 + r) * 2048 + h * 256 + pp * 128 + 8 * hh;
            bf16x8 qf[8];
#pragma unroll
            for (int ks = 0; ks < 8; ++ks) qf[ks] = *(const bf16x8*)(qrow + 16 * ks);
            f32x16 sc[4];
#pragma unroll
            for (int kt = 0; kt < 4; ++kt) {
                const bf16_t* af = p.sk_frag + ((size_t)(((h * 2 + pp) * 4 + kt) * 8) * 64 + lane) * 8;
                bf16x8 a[8];
#pragma unroll
                for (int ks = 0; ks < 8; ++ks) a[ks] = *(const bf16x8*)(af + (size_t)ks * 512);
#pragma unroll
                for (int e = 0; e < 16; ++e) sc[kt][e] = 0.f;
#pragma unroll
                for (int ks = 0; ks < 8; ++ks) sc[kt] = __builtin_amdgcn_mfma_f32_32x32x16_bf16(a[ks], qf[ks], sc[kt], 0, 0, 0);
            }
#pragma unroll
            for (int kt = 0; kt < 4; ++kt) {
#pragma unroll
                for (int e = 0; e < 16; ++e) {
                    const unsigned key = (unsigned)(32 * kt + (e & 3) + 8 * (e >> 2)) + 4u * (unsigned)hh;
                    sc[kt][e] = __uint_as_float((__float_as_uint(sc[kt][e]) & 0xffffff80u) | key);
                }
                sort16_desc(sc[kt]);
            }
            f32x16 m = merge_top16(merge_top16(sc[0], sc[1]), merge_top16(sc[2], sc[3]));
            f32x16 oth;
#pragma unroll
            for (int i = 0; i < 16; ++i) oth[i] = __shfl_xor(m[i], 32);
            top[pp] = merge_top16(m, oth);
        }
        int ia[16], ib[16];
#pragma unroll
        for (int i = 0; i < 16; ++i) { ia[i] = (int)(__float_as_uint(top[0][i]) & 127u); ib[i] = (int)(__float_as_uint(top[1][i]) & 127u); }
        float cv0[16], cv1[16]; int cd0[16], cd1[16];
#pragma unroll
        for (int c = 0; c < 32; ++c) {
            float v = -INFINITY; int id = 0;
            if (c < 25) {
                const float v0 = top[0][CI[2 * c]] + top[1][CJ[2 * c]], v1 = top[0][CI[2 * c + 1]] + top[1][CJ[2 * c + 1]];
                const int d0 = (ia[CI[2 * c]] << 7) | ib[CJ[2 * c]], d1 = (ia[CI[2 * c + 1]] << 7) | ib[CJ[2 * c + 1]];
                v = hh ? v1 : v0; id = hh ? d1 : d0;
            }
            if (c < 16) { cv0[c] = v; cd0[c] = id; } else { cv1[c - 16] = v; cd1[c - 16] = id; }
        }
        psort16_desc(cv0, cd0); psort16_desc(cv1, cd1);
        pmerge_top16(cv0, cd0, cv1, cd1);
        float ov[16]; int od[16];
#pragma unroll
        for (int i = 0; i < 16; ++i) { ov[i] = __shfl_xor(cv0[i], 32); od[i] = __shfl_xor(cd0[i], 32); }
        pmerge_top16(cv0, cd0, ov, od);
        float ex[16], den = 0.f;
#pragma unroll
        for (int i = 0; i < 16; ++i) { ex[i] = __expf(cv0[i] - cv0[0]); den += ex[i]; }
        const float inv = 1.f / den;
        if (hh == 0) {
            int* idp = p.ids + (size_t)(tok0 + r) * 128 + h * 16; float* gp = p.gates + (size_t)(tok0 + r) * 128 + h * 16;
#pragma unroll
            for (int q = 0; q < 4; ++q) {
                *(int4*)(idp + 4 * q) = make_int4(cd0[4 * q], cd0[4 * q + 1], cd0[4 * q + 2], cd0[4 * q + 3]);
                *(float4*)(gp + 4 * q) = make_float4(ex[4 * q] * inv, ex[4 * q + 1] * inv, ex[4 * q + 2] * inv, ex[4 * q + 3] * inv);
            }
        }
    }
}


typedef float f32x2 __attribute__((ext_vector_type(2)));
__device__ __forceinline__ void phase_tables8(const Params& p, int first_block) {
    const int lane = threadIdx.x & 63, gw = (blockIdx.x - first_block) * (NTHREADS / 64) + (threadIdx.x >> 6), GW = (gridDim.x - first_block) * (NTHREADS / 64);
    for (int row0 = gw * 4; row0 < 2 * 16384; row0 += GW * 4) {
        float v[4][16];
#pragma unroll
        for (int rr = 0; rr < 4; ++rr) {
            const int row = row0 + rr, table = row >> 14, e = row & 16383;
            const float* src = (table ? p.peer_v : p.peer_u) + (size_t)e * 1024 + lane * 16;
#pragma unroll
            for (int q = 0; q < 4; ++q) { const float4 a = *(const float4*)(src + 4 * q); v[rr][4 * q] = a.x; v[rr][4 * q + 1] = a.y; v[rr][4 * q + 2] = a.z; v[rr][4 * q + 3] = a.w; }
        }
#pragma unroll
        for (int rr = 0; rr < 4; ++rr) {
            const int row = row0 + rr, table = row >> 14, e = row & 16383;
            float am = 0.f;
#pragma unroll
            for (int c = 0; c < 16; ++c) am = fmaxf(am, fabsf(v[rr][c]));
            am = wave_max(am);
            float sc = am > 0.f ? exp2f(floorf(log2f(448.f / am))) : 1.f;
            if (am * sc > 448.f) sc *= 0.5f;
            u32x4 o; int w;
            w = 0; w = __builtin_amdgcn_cvt_pk_fp8_f32(v[rr][0] * sc, v[rr][1] * sc, w, false); w = __builtin_amdgcn_cvt_pk_fp8_f32(v[rr][2] * sc, v[rr][3] * sc, w, true); o.x = (unsigned)w;
            w = 0; w = __builtin_amdgcn_cvt_pk_fp8_f32(v[rr][4] * sc, v[rr][5] * sc, w, false); w = __builtin_amdgcn_cvt_pk_fp8_f32(v[rr][6] * sc, v[rr][7] * sc, w, true); o.y = (unsigned)w;
            w = 0; w = __builtin_amdgcn_cvt_pk_fp8_f32(v[rr][8] * sc, v[rr][9] * sc, w, false); w = __builtin_amdgcn_cvt_pk_fp8_f32(v[rr][10] * sc, v[rr][11] * sc, w, true); o.z = (unsigned)w;
            w = 0; w = __builtin_amdgcn_cvt_pk_fp8_f32(v[rr][12] * sc, v[rr][13] * sc, w, false); w = __builtin_amdgcn_cvt_pk_fp8_f32(v[rr][14] * sc, v[rr][15] * sc, w, true); o.w = (unsigned)w;
            *(u32x4*)(p.tab8 + ((size_t)((table * 8 + (lane >> 3)) * 16384 + e)) * 128 + (lane & 7) * 16) = o;
            if (lane == 0) p.isc[row] = 1.f / sc;
        }
    }
}
typedef int i32x16 __attribute__((ext_vector_type(16)));
struct PeerBuf { u32x4 rows[16]; u32x4 xa, xb; f32x16 w; };
__device__ __forceinline__ float dpp_xor1(float v) { return __uint_as_float(__builtin_amdgcn_update_dpp(0u, __float_as_uint(v), 0xB1, 0xF, 0xF, true)); }
__device__ __forceinline__ float dpp_xor2(float v) { return __uint_as_float(__builtin_amdgcn_update_dpp(0u, __float_as_uint(v), 0x4E, 0xF, 0xF, true)); }
__device__ __forceinline__ float dpp_xor8(float v) { return __uint_as_float(__builtin_amdgcn_update_dpp(0u, __float_as_uint(v), 0x128, 0xF, 0xF, true)); }
__device__ __forceinline__ float swz_xor4(float v) { return __uint_as_float(__builtin_amdgcn_ds_swizzle(__float_as_uint(v), 0x101F)); }
__device__ __forceinline__ float swz_xor16(float v) { return __uint_as_float(__builtin_amdgcn_ds_swizzle(__float_as_uint(v), 0x401F)); }
__device__ __forceinline__ void peer_gather(PeerBuf& B, const unsigned char* tab, const i32x16& id, int j) {
#pragma unroll
    for (int i = 0; i < 16; ++i) B.rows[i] = *(const u32x4*)(tab + (size_t)id[i] * 128 + j * 16);
}
__device__ __forceinline__ void phase_peer_u(const Params& p, const bf16_t* x1b, float* ph) {
    const int lane0 = threadIdx.x & 63, wave = threadIdx.x >> 6;
    const int x = blockIdx.x & 7, nloc = (gridDim.x - x + 7) >> 3, wl = (blockIdx.x >> 3) * (NTHREADS / 64) + wave, NW = nloc * (NTHREADS / 64);
    const unsigned char* tab = p.tab8 + (size_t)x * 16384 * 128;
    int lane = lane0; asm volatile("" : "+v"(lane));
    const int j = lane & 7, g = lane >> 3;
    const bool b0 = j & 1, b1 = j & 2, b2 = j & 4;
    auto tok = [&](int t) { return t < M_TOK ? t : M_TOK - 1; };
    auto load_ids = [&](i32x16& id, int t) {
#pragma unroll
        for (int q = 0; q < 4; ++q) { const int4 v = *(const int4*)(p.ids + (size_t)t * 128 + 16 * g + 4 * q); id[4 * q] = v.x; id[4 * q + 1] = v.y; id[4 * q + 2] = v.z; id[4 * q + 3] = v.w; }
    };
    auto issue = [&](PeerBuf& B, int t, const i32x16& id) {
        const bf16_t* xs = x1b + (size_t)t * 1024 + 128 * x + 16 * j;
        B.xa = *(const u32x4*)xs; B.xb = *(const u32x4*)(xs + 8);
        peer_gather(B, tab, id, j);
    };
    auto compute = [&](const PeerBuf& B, int t) {
        const f32x2 xf[8] = {{bflo(B.xa.x), bfhi(B.xa.x)}, {bflo(B.xa.y), bfhi(B.xa.y)}, {bflo(B.xa.z), bfhi(B.xa.z)}, {bflo(B.xa.w), bfhi(B.xa.w)},
                             {bflo(B.xb.x), bfhi(B.xb.x)}, {bflo(B.xb.y), bfhi(B.xb.y)}, {bflo(B.xb.z), bfhi(B.xb.z)}, {bflo(B.xb.w), bfhi(B.xb.w)}};
        float res[16];
#pragma unroll
        for (int i = 0; i < 16; ++i) {
            const unsigned dw[4] = {B.rows[i].x, B.rows[i].y, B.rows[i].z, B.rows[i].w};
            f32x2 d2 = {0.f, 0.f};
#pragma unroll
            for (int q = 0; q < 4; ++q) {
                const f32x2 lo = __builtin_amdgcn_cvt_pk_f32_fp8((int)dw[q], false), hi = __builtin_amdgcn_cvt_pk_f32_fp8((int)dw[q], true);
                d2 = lo * xf[2 * q] + d2; d2 = hi * xf[2 * q + 1] + d2;
            }
            res[i] = d2.x + d2.y;
        }
        float r8[8], r4[4], r2[2];
#pragma unroll
        for (int m = 0; m < 8; ++m) { const float keep = b0 ? res[8 + m] : res[m], send = b0 ? res[m] : res[8 + m]; r8[m] = keep + dpp_xor1(send); }
#pragma unroll
        for (int m = 0; m < 4; ++m) { const float keep = b1 ? r8[4 + m] : r8[m], send = b1 ? r8[m] : r8[4 + m]; r4[m] = keep + dpp_xor2(send); }
#pragma unroll
        for (int m = 0; m < 2; ++m) { const float keep = b2 ? r4[2 + m] : r4[m], send = b2 ? r4[m] : r4[2 + m]; r2[m] = keep + swz_xor4(send); }
        const int i0 = 8 * (int)b0 + 4 * (int)b1 + 2 * (int)b2;
        *(float2*)(ph + ((size_t)x * M_TOK + t) * 128 + 16 * g + i0) = make_float2(r2[0], r2[1]);
    };
    PeerBuf A, Bb;
    int t = wl;
    if (t >= M_TOK) return;
    i32x16 idn;
    load_ids(idn, t);
    issue(A, t, idn);
    load_ids(idn, tok(t + NW));
    for (; t < M_TOK; t += 2 * NW) {
        issue(Bb, tok(t + NW), idn);
        load_ids(idn, tok(t + 2 * NW));
        compute(A, t);
        issue(A, tok(t + 2 * NW), idn);
        load_ids(idn, tok(t + 3 * NW));
        if (t + NW < M_TOK) compute(Bb, t + NW);
    }
}
__device__ __forceinline__ void phase_peer_w(const Params& p, const float* ph, float* wbuf) {
    const size_t gt = (size_t)blockIdx.x * NTHREADS + threadIdx.x, GT = (size_t)gridDim.x * NTHREADS;
    for (size_t i0 = gt; i0 < (size_t)M_TOK * 128; i0 += GT * 4) {
        int e[4]; float h[4], gg[4];
#pragma unroll
        for (int u = 0; u < 4; ++u) {
            const size_t idx = i0 + u * GT;
            e[u] = p.ids[idx]; gg[u] = p.gates[idx]; h[u] = 0.f;
#pragma unroll
            for (int x = 0; x < 8; ++x) h[u] += ph[(size_t)x * M_TOK * 128 + idx];
        }
#pragma unroll
        for (int u = 0; u < 4; ++u) {
            const float hv = h[u] * p.isc[e[u]];
            wbuf[i0 + u * GT] = 0.5f * hv * (1.f + erff(hv * 0.7071067811865476f)) * gg[u] * p.isc[16384 + e[u]];
        }
    }
}
__device__ __forceinline__ void phase_peer_v(const Params& p, const float* wbuf, bf16_t* ffn) {
    const int lane0 = threadIdx.x & 63, wave = threadIdx.x >> 6;
    const int x = blockIdx.x & 7, nloc = (gridDim.x - x + 7) >> 3, wl = (blockIdx.x >> 3) * (NTHREADS / 64) + wave, NW = nloc * (NTHREADS / 64);
    const unsigned char* tab = p.tab8 + (size_t)(8 + x) * 16384 * 128;
    int lane = lane0; asm volatile("" : "+v"(lane));
    const int j = lane & 7, g = lane >> 3;
    const bool b3 = g & 1, b4 = g & 2, b5 = g & 4;
    auto tok = [&](int t) { return t < M_TOK ? t : M_TOK - 1; };
    auto load_ids = [&](i32x16& id, int t) {
#pragma unroll
        for (int q = 0; q < 4; ++q) { const int4 v = *(const int4*)(p.ids + (size_t)t * 128 + 16 * g + 4 * q); id[4 * q] = v.x; id[4 * q + 1] = v.y; id[4 * q + 2] = v.z; id[4 * q + 3] = v.w; }
    };
    auto issue = [&](PeerBuf& B, int t, const i32x16& id) {
#pragma unroll
        for (int q = 0; q < 4; ++q) { const float4 v = *(const float4*)(wbuf + (size_t)t * 128 + 16 * g + 4 * q); B.w[4 * q] = v.x; B.w[4 * q + 1] = v.y; B.w[4 * q + 2] = v.z; B.w[4 * q + 3] = v.w; }
        peer_gather(B, tab, id, j);
    };
    auto compute = [&](const PeerBuf& B, int t) {
        f32x2 acc[8];
#pragma unroll
        for (int c = 0; c < 8; ++c) acc[c] = (f32x2){0.f, 0.f};
#pragma unroll
        for (int i = 0; i < 16; ++i) {
            const f32x2 w2 = {B.w[i], B.w[i]};
            const unsigned dw[4] = {B.rows[i].x, B.rows[i].y, B.rows[i].z, B.rows[i].w};
#pragma unroll
            for (int q = 0; q < 4; ++q) {
                const f32x2 lo = __builtin_amdgcn_cvt_pk_f32_fp8((int)dw[q], false), hi = __builtin_amdgcn_cvt_pk_f32_fp8((int)dw[q], true);
                acc[2 * q] = lo * w2 + acc[2 * q]; acc[2 * q + 1] = hi * w2 + acc[2 * q + 1];
            }
        }
        f32x2 a4[4], a2[2], a1;
#pragma unroll
        for (int m = 0; m < 4; ++m) { const f32x2 keep = b3 ? acc[4 + m] : acc[m], send = b3 ? acc[m] : acc[4 + m]; a4[m] = (f32x2){keep.x + dpp_xor8(send.x), keep.y + dpp_xor8(send.y)}; }
#pragma unroll
        for (int m = 0; m < 2; ++m) { const f32x2 keep = b4 ? a4[2 + m] : a4[m], send = b4 ? a4[m] : a4[2 + m]; a2[m] = (f32x2){keep.x + swz_xor16(send.x), keep.y + swz_xor16(send.y)}; }
        { const f32x2 keep = b5 ? a2[1] : a2[0], send = b5 ? a2[0] : a2[1]; a1 = (f32x2){keep.x + __shfl_xor(send.x, 32), keep.y + __shfl_xor(send.y, 32)}; }
        const int c0 = 8 * (int)b3 + 4 * (int)b4 + 2 * (int)b5;
        *(unsigned*)(ffn + (size_t)t * 1024 + 128 * x + 16 * j + c0) = pk_bf16(a1.x, a1.y);
    };
    PeerBuf A, Bb;
    int t = wl;
    if (t >= M_TOK) return;
    i32x16 idn;
    load_ids(idn, t);
    issue(A, t, idn);
    load_ids(idn, tok(t + NW));
    for (; t < M_TOK; t += 2 * NW) {
        issue(Bb, tok(t + NW), idn);
        load_ids(idn, tok(t + 2 * NW));
        compute(A, t);
        issue(A, tok(t + 2 * NW), idn);
        load_ids(idn, tok(t + 3 * NW));
        if (t + NW < M_TOK) compute(Bb, t + NW);
    }
}
__device__ __forceinline__ void phase_ln2(const Params& p, const bf16_t* ffn) {
    const int lane = threadIdx.x & 63, gw = blockIdx.x * (NTHREADS / 64) + (threadIdx.x >> 6), GW = gridDim.x * (NTHREADS / 64);
    for (int m0 = gw * 2; m0 < M_TOK; m0 += GW * 2) {
        float4 a[2][4]; u32x2 f[2][4]; float2 st[2];
#pragma unroll
        for (int rr = 0; rr < 2; ++rr) {
            st[rr] = *(const float2*)(p.ln1_stats + (size_t)(m0 + rr) * 2);
#pragma unroll
            for (int j = 0; j < 4; ++j) { a[rr][j] = *(const float4*)(p.out + (size_t)(m0 + rr) * D_MODEL + j * 256 + lane * 4); f[rr][j] = *(const u32x2*)(ffn + (size_t)(m0 + rr) * D_MODEL + j * 256 + lane * 4); }
        }
#pragma unroll
        for (int rr = 0; rr < 2; ++rr) {
            float* row = p.out + (size_t)(m0 + rr) * D_MODEL;
            float4 v[4]; float s = 0.f;
#pragma unroll
            for (int j = 0; j < 4; ++j) {
                const float4 g1 = *(const float4*)(p.ln1_g + j * 256 + lane * 4), b1 = *(const float4*)(p.ln1_b + j * 256 + lane * 4);
                v[j] = make_float4(ALPHA * ((a[rr][j].x - st[rr].x) * st[rr].y * g1.x + b1.x) + bflo(f[rr][j].x), ALPHA * ((a[rr][j].y - st[rr].x) * st[rr].y * g1.y + b1.y) + bfhi(f[rr][j].x),
                                   ALPHA * ((a[rr][j].z - st[rr].x) * st[rr].y * g1.z + b1.z) + bflo(f[rr][j].y), ALPHA * ((a[rr][j].w - st[rr].x) * st[rr].y * g1.w + b1.w) + bfhi(f[rr][j].y));
                s += (v[j].x + v[j].y) + (v[j].z + v[j].w);
            }
            const float mean = wave_sum(s) * (1.f / D_MODEL); float q = 0.f;
#pragma unroll
            for (int j = 0; j < 4; ++j) { v[j].x -= mean; v[j].y -= mean; v[j].z -= mean; v[j].w -= mean; q += (v[j].x * v[j].x + v[j].y * v[j].y) + (v[j].z * v[j].z + v[j].w * v[j].w); }
            const float rstd = rsqrtf(wave_sum(q) * (1.f / D_MODEL) + LN_EPS);
#pragma unroll
            for (int j = 0; j < 4; ++j) {
                const float4 g = *(const float4*)(p.ln2_g + j * 256 + lane * 4), bb = *(const float4*)(p.ln2_b + j * 256 + lane * 4);
                *(float4*)(row + j * 256 + lane * 4) = make_float4(v[j].x * rstd * g.x + bb.x, v[j].y * rstd * g.y + bb.y, v[j].z * rstd * g.z + bb.z, v[j].w * rstd * g.w + bb.w);
            }
        }
    }
}

constexpr int N_PHASES = 14;

namespace pg8 {
#define PG8_LAS __attribute__((address_space(3)))
constexpr int BM = 256, BK = 64, HALF = 128, HTB = HALF * BK * 2  , STAGE_BYTES = 8 * HTB, NXCD = 8, WGM = 8;

__host__ __device__ __forceinline__ int lds_byte(int r, int c) { const int st = (r >> 4) * 2 + (c >> 5), rr = r & 15, cc = c & 31, ob = rr * 64 + cc * 2; return st * 1024 + (ob ^ (((ob >> 9) & 1) << 5)); }
__host__ __device__ __forceinline__ void stage_rc(int b, int& R, int& C) { const int st = b / 1024, sb = b % 1024, swz = sb ^ (((sb >> 9) & 1) << 5); R = (st >> 1) * 16 + swz / 64; C = (st & 1) * 32 + (swz % 64) / 2; }
__host__ __device__ __forceinline__ int perm32(int rho) { const int n = rho >> 4, i = rho & 15; return 8 * (i >> 2) + 4 * n + (i & 3); }
struct Unit { int pm, pn; };
struct Gemm { const bf16_t* A; const bf16_t* Bt; int M, N, K; };
struct StaticOrder {
    int nM, nN, nwg, G, c;
    __host__ __device__ void init(int M, int N, int G_, int c_) { nM = M / BM; nN = N / BM; nwg = nM * nN; G = G_; c = c_; }
    __host__ __device__ bool next(int i, Unit& u) const {
        const long L = (long)i * G + c; if (L >= nwg) return false;
        int wgid = (int)L; { const int q = nwg / NXCD, r = nwg % NXCD, xcd = wgid % NXCD, off = wgid / NXCD; wgid = (xcd < r ? xcd * (q + 1) : r * (q + 1) + (xcd - r) * q) + off; }
        const int nig = WGM * nN, gid = wgid / nig, fm = gid * WGM, gsz = (nM - fm) < WGM ? (nM - fm) : WGM;
        u.pm = fm + ((wgid % nig) % gsz); u.pn = (wgid % nig) / gsz; return true;
    }
    __device__ __forceinline__ void a_ready(const Unit&) const {}
    __device__ __forceinline__ void done(const Unit&) const {}
};
struct EpiRope {
    static constexpr bool PERM = true, AFTER_DRAIN = false;
    bf16_t* O; const float* cs;
    __device__ __forceinline__ void operator()(const f32x4 (&acc)[2][2][4][2], const Unit& u, int wr, int wc, int fr, int fq) const {
        const int row0 = u.pm * BM + wr * 64 + fr, colb = u.pn * BM + wc * 32 + 8 * fq;
#pragma unroll
        for (int ai = 0; ai < 2; ++ai)
#pragma unroll
            for (int m = 0; m < 4; ++m) {
                const int row = row0 + ai * HALF + m * 16;
#pragma unroll
                for (int bj = 0; bj < 2; ++bj) {
                    const int col0 = colb + bj * HALF;
                    f32x4 v0 = acc[ai][bj][m][0], v1 = acc[ai][bj][m][1];
                    if (col0 < P_AV) {
                        const int i0 = (col0 & 63) >> 1;
                        const float4 c = *(const float4*)(cs + (size_t)row * 32 + i0), s = *(const float4*)(cs + (size_t)M_TOK * 32 + (size_t)row * 32 + i0);
                        const float sc = col0 < P_AK ? 0.125f : 1.f;
                        const f32x4 w0 = {(v0[0] * c.x - v0[1] * s.x) * sc, (v0[1] * c.x + v0[0] * s.x) * sc, (v0[2] * c.y - v0[3] * s.y) * sc, (v0[3] * c.y + v0[2] * s.y) * sc};
                        const f32x4 w1 = {(v1[0] * c.z - v1[1] * s.z) * sc, (v1[1] * c.z + v1[0] * s.z) * sc, (v1[2] * c.w - v1[3] * s.w) * sc, (v1[3] * c.w + v1[2] * s.w) * sc};
                        v0 = w0; v1 = w1;
                    }
                    u32x4 w; w.x = pk_bf16(v0[0], v0[1]); w.y = pk_bf16(v0[2], v0[3]); w.z = pk_bf16(v1[0], v1[1]); w.w = pk_bf16(v1[2], v1[3]);
                    *(u32x4*)(O + (size_t)row * NP_IN + col0) = w;
                }
            }
    }
};
struct EpiResid {
    static constexpr bool PERM = false, AFTER_DRAIN = false;
    float* Y; const float* X;
    __device__ __forceinline__ void operator()(const f32x4 (&acc)[2][2][4][2], const Unit& u, int wr, int wc, int fr, int fq) const {
        const int row0 = u.pm * BM + wr * 64 + fr, col0 = u.pn * BM + wc * 32 + 4 * fq;
#pragma unroll
        for (int ai = 0; ai < 2; ++ai)
#pragma unroll
            for (int m = 0; m < 4; ++m) {
                const size_t ro = (size_t)(row0 + ai * HALF + m * 16) * D_MODEL + col0;
#pragma unroll
                for (int bj = 0; bj < 2; ++bj)
#pragma unroll
                    for (int n = 0; n < 2; ++n) { const f32x4 xv = *(const f32x4*)(X + ro + bj * HALF + n * 16); *(f32x4*)(Y + ro + bj * HALF + n * 16) = xv * ALPHA + acc[ai][bj][m][n]; }
            }
    }
};
struct EpiPlainBf16 {
    static constexpr bool PERM = true, AFTER_DRAIN = false;
    bf16_t* O; int ldc;
    __device__ __forceinline__ void operator()(const f32x4 (&acc)[2][2][4][2], const Unit& u, int wr, int wc, int fr, int fq) const {
        const int row0 = u.pm * BM + wr * 64 + fr, col0 = u.pn * BM + wc * 32 + 8 * fq;
#pragma unroll
        for (int ai = 0; ai < 2; ++ai)
#pragma unroll
            for (int m = 0; m < 4; ++m) { bf16_t* rowp = O + (size_t)(row0 + ai * HALF + m * 16) * ldc + col0;
#pragma unroll
                for (int bj = 0; bj < 2; ++bj) { const f32x4 v0 = acc[ai][bj][m][0], v1 = acc[ai][bj][m][1];
                    u32x4 w; w.x = pk_bf16(v0[0], v0[1]); w.y = pk_bf16(v0[2], v0[3]); w.z = pk_bf16(v1[0], v1[1]); w.w = pk_bf16(v1[2], v1[3]);
                    *(u32x4*)(rowp + bj * HALF) = w; } }
    }
};
template <class Epi, class Sched>
__device__ __forceinline__ void gemm_phase(PG8_LAS unsigned char* lds, const Gemm g, const Sched& S, const Epi& E) {
    const int tid = threadIdx.x, wid = __builtin_amdgcn_readfirstlane(tid >> 6), lane = tid & 63, wr = wid >> 2, wc = wid & 3, fr = lane & 15, fq = lane >> 4;
    const int K = g.K, nt = K / BK;
    unsigned voffA[2], voffB[2];
#pragma unroll
    for (int i = 0; i < 2; ++i) { int R, C; stage_rc(tid * 16 + i * 8192, R, C); const int Rb = Epi::PERM ? ((R & ~31) + perm32(R & 31)) : R;
        voffA[i] = (unsigned)(R * K + C) * 2u; voffB[i] = (unsigned)(Rb * K + C) * 2u; }
    const size_t kstep = (size_t)(BK * 2);
    const size_t hstep = (size_t)HALF * K * 2;
    const size_t tstep = 2 * hstep;
    const unsigned ldsw = (unsigned)wid * 1024u;
    const int aoff = lds_byte(wr * 64 + fr, fq * 8), boff = lds_byte(wc * 32 + fr, fq * 8);
#define PG8_SA(b, h) (((b) * 2 + (h)) * HTB)
#define PG8_SB(b, h) ((4 + (b) * 2 + (h)) * HTB)
#define PG8_STAGE(bufoff, gbase, voff) do { _Pragma("unroll") for (int _i = 0; _i < 2; ++_i) \
        __builtin_amdgcn_global_load_lds((const unsigned*)((const char*)(gbase) + (voff)[_i]), (PG8_LAS unsigned*)(lds + (bufoff) + ldsw + _i * 8192), 16, 0, 0); } while (0)
#define PG8_LDA(dst, b, h) do { _Pragma("unroll") for (int m = 0; m < 4; ++m) _Pragma("unroll") for (int k = 0; k < 2; ++k) dst[m][k] = *(const PG8_LAS bf16x8*)(lds + PG8_SA(b, h) + aoff + m * 2048 + k * 1024); } while (0)
#define PG8_LDB(dst, b, h) do { _Pragma("unroll") for (int n = 0; n < 2; ++n) _Pragma("unroll") for (int k = 0; k < 2; ++k) dst[n][k] = *(const PG8_LAS bf16x8*)(lds + PG8_SB(b, h) + boff + n * 2048 + k * 1024); } while (0)
#define PG8_MMA(ai, bj, At, Bt) do { __builtin_amdgcn_s_setprio(1); _Pragma("unroll") for (int m = 0; m < 4; ++m) _Pragma("unroll") for (int n = 0; n < 2; ++n) _Pragma("unroll") for (int k = 0; k < 2; ++k) \
        acc[ai][bj][m][n] = __builtin_amdgcn_mfma_f32_16x16x32_bf16(Bt[n][k], At[m][k], acc[ai][bj][m][n], 0, 0, 0); __builtin_amdgcn_s_setprio(0); } while (0)
#define PG8_WAIT_V(n) asm volatile("s_waitcnt vmcnt(" #n ")" ::: "memory")
#define PG8_WAIT_L(n) asm volatile("s_waitcnt lgkmcnt(" #n ")" ::: "memory")
#define PG8_BAR __builtin_amdgcn_s_barrier()
#define PG8_SCHED __builtin_amdgcn_sched_barrier(0)
    Unit cur, nxt; int ui = 0;
    if (!S.next(0, cur)) return;
    f32x4 acc[2][2][4][2];
#pragma unroll
    for (int a = 0; a < 2; ++a)
#pragma unroll
        for (int b = 0; b < 2; ++b)
#pragma unroll
            for (int m = 0; m < 4; ++m)
#pragma unroll
                for (int n = 0; n < 2; ++n) acc[a][b][m][n] = (f32x4){0.f, 0.f, 0.f, 0.f};
    bf16x8 At[4][2], B0[2][2], B1[2][2];
    const char* cA = (const char*)g.A + (size_t)cur.pm * tstep; const char* cB = (const char*)g.Bt + (size_t)cur.pn * tstep;
    S.a_ready(cur);
    PG8_STAGE(PG8_SB(0, 0), cB, voffB); PG8_STAGE(PG8_SA(0, 0), cA, voffA); PG8_STAGE(PG8_SB(0, 1), cB + hstep, voffB); PG8_STAGE(PG8_SA(0, 1), cA + hstep, voffA);
    if (wr == 1) PG8_BAR;
    PG8_WAIT_V(4); PG8_BAR;
    PG8_STAGE(PG8_SB(1, 0), cB + kstep, voffB); PG8_STAGE(PG8_SA(1, 0), cA + kstep, voffA); PG8_STAGE(PG8_SB(1, 1), cB + hstep + kstep, voffB);
    PG8_WAIT_V(6); PG8_BAR;
    for (;;) {
        const bool has_next = S.next(ui + 1, nxt);
        const char* nA = has_next ? (const char*)g.A + (size_t)nxt.pm * tstep : cA; const char* nB = has_next ? (const char*)g.Bt + (size_t)nxt.pn * tstep : cB;
        for (int t = 0; t < nt; t += 2) {
            const bool last = (t == nt - 2);
            const char* a1 = cA + (size_t)(t + 1) * kstep;
            const char* a2 = last ? nA : cA + (size_t)(t + 2) * kstep; const char* b2 = last ? nB : cB + (size_t)(t + 2) * kstep;
            const char* a3 = a2 + kstep; const char* b3 = b2 + kstep;
            if (last && has_next) S.a_ready(nxt);
            PG8_LDB(B0, 0, 0); PG8_SCHED; PG8_LDA(At, 0, 0); PG8_STAGE(PG8_SA(1, 1), a1 + hstep, voffA);
            PG8_WAIT_L(8); PG8_BAR; PG8_WAIT_L(0); PG8_MMA(0, 0, At, B0); PG8_BAR; PG8_SCHED;
            PG8_LDB(B1, 0, 1); PG8_STAGE(PG8_SB(0, 0), b2, voffB);
            PG8_BAR; PG8_WAIT_L(0); PG8_MMA(0, 1, At, B1); PG8_BAR;
            PG8_LDA(At, 0, 1); PG8_STAGE(PG8_SA(0, 0), a2, voffA);
            PG8_BAR; PG8_WAIT_L(0); PG8_MMA(1, 0, At, B0); PG8_BAR; PG8_SCHED;
            PG8_STAGE(PG8_SB(0, 1), b2 + hstep, voffB);
            PG8_WAIT_V(6); PG8_BAR; PG8_MMA(1, 1, At, B1); PG8_BAR;
            PG8_LDB(B0, 1, 0); PG8_SCHED; PG8_LDA(At, 1, 0); PG8_STAGE(PG8_SA(0, 1), a2 + hstep, voffA);
            PG8_WAIT_L(8); PG8_BAR; PG8_WAIT_L(0); PG8_MMA(0, 0, At, B0); PG8_BAR; PG8_SCHED;
            PG8_LDB(B1, 1, 1); PG8_STAGE(PG8_SB(1, 0), b3, voffB);
            PG8_BAR; PG8_WAIT_L(0); PG8_MMA(0, 1, At, B1); PG8_BAR;
            PG8_LDA(At, 1, 1); PG8_STAGE(PG8_SA(1, 0), a3, voffA);
            PG8_BAR; PG8_WAIT_L(0); PG8_MMA(1, 0, At, B0); PG8_BAR; PG8_SCHED;
            PG8_STAGE(PG8_SB(1, 1), b3 + hstep, voffB);
            PG8_WAIT_V(6); PG8_BAR; PG8_MMA(1, 1, At, B1); PG8_BAR;
        }
        if constexpr (!Epi::AFTER_DRAIN) { E(acc, cur, wr, wc, fr, fq); S.done(cur); }
        if (!has_next) break;
#pragma unroll
        for (int a = 0; a < 2; ++a)
#pragma unroll
            for (int b = 0; b < 2; ++b)
#pragma unroll
                for (int m = 0; m < 4; ++m)
#pragma unroll
                    for (int n = 0; n < 2; ++n) acc[a][b][m][n] = (f32x4){0.f, 0.f, 0.f, 0.f};
        cur = nxt; cA = nA; cB = nB; ++ui;
    }
    PG8_WAIT_V(0);
    if (wr == 0) PG8_BAR;
    PG8_BAR;
    if constexpr (Epi::AFTER_DRAIN) { E.fused(acc, cur, wr, wc, fr, fq, lds, wid, lane); S.done(cur); }
#undef PG8_SA
#undef PG8_SB
#undef PG8_STAGE
#undef PG8_LDA
#undef PG8_LDB
#undef PG8_MMA
#undef PG8_WAIT_V
#undef PG8_WAIT_L
#undef PG8_BAR
#undef PG8_SCHED
}
}

__global__ void __launch_bounds__(NTHREADS) mega_fwd(Params p) {
    __shared__ __attribute__((aligned(1024))) unsigned char smem[SMEM_BYTES + 16];
    if (threadIdx.x == 0) *(uint4*)(smem + SMEM_BYTES) = make_uint4(0u, 0u, 0u, 0u);
    __syncthreads();
    XcdBarrier bar; bar.bar = p.bar; bar.x = 0; bar.st = (volatile LAS unsigned*)(smem + SMEM_BYTES);
    if (p.ph_hi - p.ph_lo > 1) bar = xcd_barrier_post(p.bar, (volatile LAS unsigned*)(smem + SMEM_BYTES));
    bf16_t* qb = p.proj_b;
    bf16_t* x1b = p.proj_b + (size_t)M_TOK * 2048;
#ifndef DUP_PHASE
#define DUP_PHASE -1
#endif
#define PH(k) (p.ph_lo <= (k) && (k) < p.ph_hi)
#define SYNC(k) do { if (PH(k) && PH((k) + 1)) xcd_barrier(bar); } while (0)
#define RUN(k, ...) do { if (PH(k)) { __VA_ARGS__; if (DUP_PHASE == (k)) { xcd_barrier(bar); __VA_ARGS__; } } SYNC(k); } while (0)
    float* ph = (float*)qb;
    RUN(0, phase_prep(p, smem));
    RUN(1, { EpiInProj e{p.proj_b, p.rope_cs}; gemm_phase(p.xb, p.wt_in, M_TOK, NP_IN, e, smem); });
    RUN(2, phase_dn_prep(p, smem));
    RUN(3, { if (blockIdx.x < 96) { const int j = blockIdx.x, y = j >> 3, cs = (y >> 1) * 8 + (j & 7);
                                    dn_scan_seg<1>(p, smem, cs / 3, cs % 3, y & 1); } else { phase_attn(p, smem, 96); } });
    RUN(4, { if (blockIdx.x < 64) dn_scan_seg<0>(p, smem, blockIdx.x >> 2, blockIdx.x & 3, 0); else if (blockIdx.x < 128) phase_scan_l2_helper(p); else phase_tables8(p, 128); });
    RUN(5, phase_dn_norm(p));
    RUN(6, { EpiOutProj e{p.out, p.x}; gemm_phase(p.xb, p.wt_out, M_TOK, 1024, e, smem); });
    RUN(7, phase_ln1(p, x1b));
    RUN(8, { pg8::StaticOrder S; S.init(M_TOK, 2048, gridDim.x, blockIdx.x); pg8::EpiPlainBf16 e{qb, 2048}; pg8::gemm_phase((PG8_LAS unsigned char*)smem, pg8::Gemm{x1b, p.wt_q, M_TOK, 2048, 1024}, S, e); });
    RUN(9, phase_route(p, qb));
    RUN(10, phase_peer_u(p, x1b, ph));
    RUN(11, phase_peer_w(p, ph, p.wbuf));
    RUN(12, phase_peer_v(p, p.wbuf, (bf16_t*)ph));
    RUN(13, phase_ln2(p, (const bf16_t*)ph));
#undef RUN
#undef SYNC
#undef PH
}
}

#ifndef MK_LAUNCHES
#define MK_LAUNCHES 1
#endif

extern "C" void kernel_launch(void* const* d_in, const int* in_sizes, int n_in, void* d_out, int out_size, void* d_ws, size_t ws_size, hipStream_t stream) {
    static int grid_blocks = 0;
    if (!grid_blocks) {
        int dev = 0, cus = 0, per_cu = 0;
        (void)hipGetDevice(&dev);
        (void)hipDeviceGetAttribute(&cus, hipDeviceAttributeMultiprocessorCount, dev);
        (void)hipOccupancyMaxActiveBlocksPerMultiprocessor(&per_cu, mega_fwd, NTHREADS, 0);
        if (per_cu < 1) { fprintf(stderr, "kernel_launch: occupancy query reports %d blocks per CU\n", per_cu); per_cu = 1; }
        grid_blocks = cus * 1;
        (void)hipGetLastError();
    }
    Params p{};
    p.x = (const float*)d_in[0]; p.positions = (const int*)d_in[1]; p.w_in = (const float*)d_in[2]; p.sinks = (const float*)d_in[3];
    p.conv_w = (const float*)d_in[4]; p.a_log = (const float*)d_in[5]; p.dt_bias = (const float*)d_in[6]; p.dn_norm_g = (const float*)d_in[7];
    p.w_out = (const float*)d_in[8]; p.ln1_g = (const float*)d_in[9]; p.ln1_b = (const float*)d_in[10]; p.w_query = (const float*)d_in[11];
    p.sub_keys = (const float*)d_in[12]; p.peer_u = (const float*)d_in[13]; p.peer_v = (const float*)d_in[14]; p.ln2_g = (const float*)d_in[15]; p.ln2_b = (const float*)d_in[16];
    p.out = (float*)d_out;
    char* ws = (char*)d_ws; size_t off = 0;
    auto take = [&](size_t bytes) { char* r = ws + off; off += (bytes + 255) & ~(size_t)255; return r; };
    p.xb = (bf16_t*)take((size_t)M_TOK * 1024 * 2);
    p.proj_b = (bf16_t*)take((size_t)M_TOK * NP_IN * 2);
    p.odn_raw = (bf16_t*)d_out;
    {
        char* dn = take((size_t)2048 * (16384 * 3 + 8192 + 32768) + 8192);
        p.ids = (int*)dn; p.gates = (float*)(dn + (size_t)M_TOK * 128 * 4);
        p.wbuf = (float*)(dn + (size_t)M_TOK * 128 * 8);
        p.dn_negw = (bf16_t*)dn; p.dn_qd = (bf16_t*)(dn + (size_t)2048 * 16384); p.dn_kdt = (bf16_t*)(dn + (size_t)2048 * 16384 * 2);
        p.dn_qk = (bf16_t*)(dn + (size_t)2048 * 16384 * 3); p.dn_u = (bf16_t*)(dn + (size_t)2048 * (16384 * 3 + 8192)); p.dn_gl = (float*)(dn + (size_t)2048 * (16384 * 3 + 8192 + 32768));
    }
    p.wt_in = (bf16_t*)take((size_t)NP_IN * 1024 * 2);
    p.wt_out = (bf16_t*)take((size_t)1024 * 1024 * 2);
    p.wt_q = (bf16_t*)take((size_t)2048 * 1024 * 2);
    p.rope_cs = (float*)take((size_t)M_TOK * 64 * 4);
    p.sk_frag = (bf16_t*)take((size_t)16 * 128 * 128 * 2);
    p.tab8 = (unsigned char*)take((size_t)2 * 16384 * 1024);
    p.isc = (float*)take((size_t)2 * 16384 * 4);
    p.ln1_stats = (float*)take((size_t)M_TOK * 2 * 4);
    p.dn_PB = (float*)take((size_t)48 * 128 * 256 * 4);
    p.dn_S0 = (float*)take((size_t)64 * 128 * 128 * 4);
    p.bar = (unsigned*)take((size_t)(XCD_BAR_WORDS + 64 * 64) * 4);
    if (off > ws_size) { fprintf(stderr, "kernel_launch: workspace too small (%zu < %zu)\n", ws_size, off); return; }
    if (hipMemsetAsync(p.bar, 0, (size_t)(XCD_BAR_WORDS + 64 * 64) * 4, stream) != hipSuccess) { fprintf(stderr, "kernel_launch: memset of barrier words failed\n"); return; }
#if MK_LAUNCHES == 1
    p.ph_lo = 0; p.ph_hi = N_PHASES;
    void* args[] = {&p};
    hipError_t e = hipLaunchCooperativeKernel((void*)mega_fwd, dim3(grid_blocks), dim3(NTHREADS), args, 0, stream);
    if (e != hipSuccess) fprintf(stderr, "cooperative launch failed: %s (grid %d)\n", hipGetErrorString(e), grid_blocks);
#else
    for (int k = 0; k < N_PHASES; ++k) { p.ph_lo = k; p.ph_hi = k + 1; hipLaunchKernelGGL(mega_fwd, dim3(grid_blocks), dim3(NTHREADS), 0, stream, p); }
#endif
}
```

```cpp
#include <hip/hip_runtime.h>
#include <cstdio>
#include <cstdint>
#include <math.h>

namespace {
constexpr int D_MODEL = 1024, BATCH = 4, SEQ = 8192, M_TOK = BATCH * SEQ;
constexpr int IN_WIDTH = 2824, NP_IN = 3072;
constexpr int P_AQ = 0, P_AK = 512, P_AV = 640, P_DQ = 768, P_DK = 1280, P_DV = 1792, P_Z = 2304, P_B = 2816, P_A = 2820;
constexpr float ALPHA = 1.189207115002721f;
constexpr float LN_EPS = 1e-5f, RMS_EPS = 1e-6f, L2_EPS = 1e-6f;
constexpr int NTHREADS = 512;

typedef unsigned short bf16_t;
typedef short bf16x8 __attribute__((ext_vector_type(8)));
typedef float f32x16 __attribute__((ext_vector_type(16)));
typedef float f32x4 __attribute__((ext_vector_type(4)));
typedef unsigned u32x4 __attribute__((ext_vector_type(4)));
typedef unsigned u32x2 __attribute__((ext_vector_type(2)));

struct Params {
    const float* x; const int* positions; const float* w_in; const float* sinks; const float* conv_w; const float* a_log; const float* dt_bias;
    const float* dn_norm_g; const float* w_out; const float* ln1_g; const float* ln1_b; const float* w_query; const float* sub_keys;
    const float* peer_u; const float* peer_v; const float* ln2_g; const float* ln2_b;
    float* out;
    bf16_t* xb;
    bf16_t* proj_b;
    bf16_t* odn_raw;
    int* ids; float* gates;
    bf16_t* wt_in; bf16_t* wt_out; bf16_t* wt_q;
    float* rope_cs;
    bf16_t* dn_negw; bf16_t* dn_qd; bf16_t* dn_kdt; bf16_t* dn_qk; bf16_t* dn_u; float* dn_gl; float* dn_PB; float* dn_S0;
    bf16_t* sk_frag;
    float* ln1_stats;
    unsigned char* tab8; float* isc; float* wbuf;
    unsigned* bar;
    int ph_lo, ph_hi;
};

__device__ __forceinline__ float wave_sum(float v) {
#pragma unroll
    for (int o = 1; o < 64; o <<= 1) v += __shfl_xor(v, o);
    return v;
}
__device__ __forceinline__ float wave_max(float v) {
#pragma unroll
    for (int o = 1; o < 64; o <<= 1) v = fmaxf(v, __shfl_xor(v, o));
    return v;
}
__device__ __forceinline__ float bf2f(bf16_t u) { return __uint_as_float((unsigned)u << 16); }
__device__ __forceinline__ float bflo(unsigned u) { return __uint_as_float(u << 16); }
__device__ __forceinline__ float bfhi(unsigned u) { return __uint_as_float(u & 0xffff0000u); }
typedef __bf16 bf16x2_n __attribute__((ext_vector_type(2)));
__device__ __forceinline__ unsigned pk_bf16(float lo, float hi) { bf16x2_n v; v.x = (__bf16)lo; v.y = (__bf16)hi; return __builtin_bit_cast(unsigned, v); }
__device__ __forceinline__ float silu_f(float y) { return y * __builtin_amdgcn_rcpf(1.f + __expf(-y)); }


#define XB_TMO      128
#define XB_XCNT(j)  (256  + 64 * (j))
#define XB_XSUB(j)  (1280 + 64 * (j))
#define XB_XGEN(j)  (2304 + 64 * (j))
#define XB_TOP      3328
#define XB_TOPGEN   3392
#define XCD_BAR_WORDS 3456
#define XB_SPIN_CAP (1u << 27)
#define LAS __attribute__((address_space(3)))
__device__ __forceinline__ unsigned xb_ld(unsigned* p)              { return __hip_atomic_load(p, __ATOMIC_RELAXED, __HIP_MEMORY_SCOPE_AGENT); }
__device__ __forceinline__ unsigned xb_add(unsigned* p, unsigned v) { return __hip_atomic_fetch_add(p, v, __ATOMIC_RELAXED, __HIP_MEMORY_SCOPE_AGENT); }
__device__ __forceinline__ unsigned xb_xcc_id() { return (unsigned)__builtin_amdgcn_s_getreg((3 << 11) | 20) & 0xFu; }
#define XB_SPIN(cond, bar) do { unsigned _sp = 0; while (cond) { __builtin_amdgcn_s_sleep(1); \
    if ((++_sp & 255u) == 0u) { if (xb_ld(&(bar)[XB_TMO])) break; if (_sp > XB_SPIN_CAP) { atomicAdd(&(bar)[XB_TMO], 1u); break; } } } } while (0)
struct XcdBarrier { unsigned* bar; unsigned x; volatile LAS unsigned* st; };
__device__ __forceinline__ XcdBarrier xcd_barrier_post(unsigned* bar, volatile LAS unsigned* st) {
    XcdBarrier b; b.bar = bar; b.x = xb_xcc_id(); b.st = st;
    if (threadIdx.x == 0) (void)xb_add(&bar[XB_XCNT(b.x)], 1u);
    return b;
}
__device__ __forceinline__ void xcd_barrier_complete(unsigned* bar, unsigned x, unsigned& nloc, unsigned& nx) {
    const unsigned G = gridDim.x * gridDim.y * gridDim.z;
    unsigned sum, cnt, mine, sp = 0u;
    for (;;) {
        sum = 0u; cnt = 0u; mine = 0u;
#pragma unroll
        for (unsigned j = 0; j < 16; ++j) { const unsigned c = xb_ld(&bar[XB_XCNT(j)]); sum += c; cnt += (c > 0u) ? 1u : 0u; mine = (j == x) ? c : mine; }
        if (sum == G) break;
        __builtin_amdgcn_s_sleep(1);
        if ((++sp & 255u) == 0u) { if (xb_ld(&bar[XB_TMO])) break; if (sp > XB_SPIN_CAP) { atomicAdd(&bar[XB_TMO], 1u); break; } }
    }
    nloc = mine > 0u ? mine : 1u; nx = cnt > 0u ? cnt : 1u;
}
__device__ __forceinline__ void xcd_barrier(const XcdBarrier& b) {
    asm volatile("s_waitcnt vmcnt(0)" ::: "memory");
    __syncthreads();
    if (threadIdx.x == 0) {
        unsigned* bar = b.bar;
        __builtin_amdgcn_s_waitcnt(0);
        unsigned nloc = b.st[0], nx = b.st[1];
        if (nloc == 0u) { xcd_barrier_complete(bar, b.x, nloc, nx); b.st[0] = nloc; b.st[1] = nx; }
        const unsigned old = xb_add(&bar[XB_XSUB(b.x)], 1u);
        const unsigned gen = old / nloc;
        if (old + 1u == (gen + 1u) * nloc) {
            __builtin_amdgcn_fence(__ATOMIC_RELEASE, "agent");
            asm volatile("s_waitcnt vmcnt(0)" ::: "memory");
            const unsigned og = xb_add(&bar[XB_TOP], 1u);
            const unsigned tg = og / nx;
            if (og + 1u == (tg + 1u) * nx) xb_add(&bar[XB_TOPGEN], 1u);
            else XB_SPIN(xb_ld(&bar[XB_TOPGEN]) == tg, bar);
            __builtin_amdgcn_fence(__ATOMIC_ACQUIRE, "agent");
            xb_add(&bar[XB_XGEN(b.x)], 1u);
            asm volatile("s_waitcnt vmcnt(0)" ::: "memory");
        } else {
            XB_SPIN(xb_ld(&bar[XB_XGEN(b.x)]) == gen, bar);
            __builtin_amdgcn_fence(__ATOMIC_ACQUIRE, "agent");
            asm volatile("s_waitcnt vmcnt(0)" ::: "memory");
        }
    }
    __syncthreads();
}

__device__ __forceinline__ int inproj_old_col(int n) {
    if (n < P_AV) { const int pos = n & 63; return (n & ~63) + ((pos & 1) ? (pos >> 1) + 32 : (pos >> 1)); }
    if (n < 2304) return n;
    if (n < 2816) return 2312 + (n - 2304);
    if (n < 2824) return 2304 + (n - 2816);
    return -1;
}
__device__ __forceinline__ void transpose_item(const float* __restrict__ W, int N_src, bf16_t* __restrict__ WT, int K, int kb, int nb, bool permute, float* scr) {
    const int tid = threadIdx.x;
    const int nn = tid & 63, k8 = tid >> 6;
    const int n = nb * 64 + nn;
    const int oc = permute ? inproj_old_col(n) : n;
#pragma unroll
    for (int i = 0; i < 8; ++i) { const int kk = k8 + 8 * i; scr[kk * 65 + nn] = (oc >= 0) ? W[(size_t)(kb * 64 + kk) * N_src + oc] : 0.f; }
    __syncthreads();
    const int n2 = tid >> 3, c = tid & 7;
    const float* s = scr + (c * 8) * 65 + n2;
    u32x4 o; o.x = pk_bf16(s[0], s[65]); o.y = pk_bf16(s[2 * 65], s[3 * 65]); o.z = pk_bf16(s[4 * 65], s[5 * 65]); o.w = pk_bf16(s[6 * 65], s[7 * 65]);
    *(u32x4*)(WT + (size_t)(nb * 64 + n2) * K + kb * 64 + c * 8) = o;
    __syncthreads();
}
__device__ __forceinline__ void phase_prep(const Params& p, unsigned char* smem) {
    const int tid = threadIdx.x, G = gridDim.x, bid = blockIdx.x;
    float* scr = (float*)smem;
    constexpr int I_IN = 16 * (NP_IN / 64), I_OUT = 16 * 16, I_Q = 16 * 32;
    for (int it = bid; it < I_IN + I_OUT + I_Q; it += G) {
        int r = it;
        if (r < I_IN) { transpose_item(p.w_in, IN_WIDTH, p.wt_in, 1024, r / (NP_IN / 64), r % (NP_IN / 64), true, scr); continue; } r -= I_IN;
        if (r < I_OUT) { transpose_item(p.w_out, 1024, p.wt_out, 1024, r / 16, r % 16, false, scr); continue; } r -= I_OUT;
        transpose_item(p.w_query, 2048, p.wt_q, 1024, r / 32, r % 32, false, scr);
    }
    const size_t gt = (size_t)bid * NTHREADS + tid, GT = (size_t)G * NTHREADS;
    for (size_t i0 = gt; i0 < (size_t)M_TOK * 1024 / 8; i0 += GT * 4) {
        float4 a[4], b[4];
#pragma unroll
        for (int u = 0; u < 4; ++u) { const size_t i = i0 + u * GT; if (i < (size_t)M_TOK * 1024 / 8) { a[u] = *(const float4*)(p.x + i * 8); b[u] = *(const float4*)(p.x + i * 8 + 4); } }
#pragma unroll
        for (int u = 0; u < 4; ++u) { const size_t i = i0 + u * GT; if (i < (size_t)M_TOK * 1024 / 8) {
            u32x4 o; o.x = pk_bf16(a[u].x, a[u].y); o.y = pk_bf16(a[u].z, a[u].w); o.z = pk_bf16(b[u].x, b[u].y); o.w = pk_bf16(b[u].z, b[u].w);
            *(u32x4*)(p.xb + i * 8) = o; } }
    }
    for (size_t i = gt; i < (size_t)16 * 4 * 8 * 64; i += GT) {
        const int ln = (int)(i & 63), ks = (int)((i >> 6) & 7), kt = (int)((i >> 9) & 3), hp = (int)(i >> 11);
        const float* src = p.sub_keys + ((size_t)(hp * 128 + 32 * kt + (ln & 31))) * 128 + 16 * ks + 8 * (ln >> 5);
        const float4 a = *(const float4*)src, b = *(const float4*)(src + 4);
        u32x4 o; o.x = pk_bf16(a.x, a.y); o.y = pk_bf16(a.z, a.w); o.z = pk_bf16(b.x, b.y); o.w = pk_bf16(b.z, b.w);
        *(u32x4*)(p.sk_frag + i * 8) = o;
    }
    for (size_t i = gt; i < (size_t)M_TOK * 32; i += GT) {
        const int m = (int)(i >> 5), j = (int)(i & 31);
        const float inv_freq = powf(10000.0f, -(float)j / 32.0f);
        const float ang = (float)p.positions[m] * inv_freq;
        p.rope_cs[i] = cosf(ang); p.rope_cs[(size_t)M_TOK * 32 + i] = sinf(ang);
    }
}

constexpr int GK = 1024, GBK = 64, G_TILE_BYTES = 256 * 128;
constexpr int STG_STRIDE = 260;
constexpr int SMEM_BYTES = 147456;

__device__ __forceinline__ int swz(int row, int chunk) { return row * 128 + ((chunk ^ ((row >> 1) & 7)) << 4); }

struct EpiInProj {
    bf16_t* out; const float* cs;
    __device__ __forceinline__ void operator()(int m, int pn, int c8, const unsigned char* stg_row) const {
        const int col = pn * 256 + c8 * 8;
        u32x2 a0 = *(const u32x2*)(stg_row + c8 * 16), a1 = *(const u32x2*)(stg_row + c8 * 16 + 8);
        u32x4 o; o.x = a0.x; o.y = a0.y; o.z = a1.x; o.w = a1.y;
        if (col < P_AV) {
            const int d0 = col & 63, i0 = d0 & 31; const bool second = d0 >= 32;
            const int pc8 = second ? c8 - 4 : c8 + 4;
            const u32x2 b0 = *(const u32x2*)(stg_row + pc8 * 16), b1 = *(const u32x2*)(stg_row + pc8 * 16 + 8);
            const unsigned mine[4] = {a0.x, a0.y, a1.x, a1.y}, oth[4] = {b0.x, b0.y, b1.x, b1.y};
            const float* cp = cs + (size_t)m * 32 + i0; const float* sp = cs + (size_t)M_TOK * 32 + (size_t)m * 32 + i0;
            const float4 c0 = *(const float4*)cp, c1 = *(const float4*)(cp + 4), s0 = *(const float4*)sp, s1 = *(const float4*)(sp + 4);
            const float cc[8] = {c0.x, c0.y, c0.z, c0.w, c1.x, c1.y, c1.z, c1.w}, ss[8] = {s0.x, s0.y, s0.z, s0.w, s1.x, s1.y, s1.z, s1.w};
            const float scale = col < P_AK ? 0.125f : 1.f;
            float r[8];
#pragma unroll
            for (int j = 0; j < 8; ++j) {
                const float me = (j & 1) ? bfhi(mine[j >> 1]) : bflo(mine[j >> 1]);
                const float ot = (j & 1) ? bfhi(oth[j >> 1]) : bflo(oth[j >> 1]);
                r[j] = (second ? (me * cc[j] + ot * ss[j]) : (me * cc[j] - ot * ss[j])) * scale;
            }
            o.x = pk_bf16(r[0], r[1]); o.y = pk_bf16(r[2], r[3]); o.z = pk_bf16(r[4], r[5]); o.w = pk_bf16(r[6], r[7]);
        }
        *(u32x4*)(out + (size_t)m * NP_IN + col) = o;
    }
};
struct EpiOutProj {
    float* y; const float* x;
    __device__ __forceinline__ void operator()(int m, int pn, int c8, const unsigned char* stg_row) const {
        const int col = pn * 256 + c8 * 8;
        const u32x2 a0 = *(const u32x2*)(stg_row + c8 * 16), a1 = *(const u32x2*)(stg_row + c8 * 16 + 8);
        const float4 x0 = *(const float4*)(x + (size_t)m * 1024 + col), x1 = *(const float4*)(x + (size_t)m * 1024 + col + 4);
        *(float4*)(y + (size_t)m * 1024 + col) = make_float4(ALPHA * x0.x + bflo(a0.x), ALPHA * x0.y + bfhi(a0.x), ALPHA * x0.z + bflo(a0.y), ALPHA * x0.w + bfhi(a0.y));
        *(float4*)(y + (size_t)m * 1024 + col + 4) = make_float4(ALPHA * x1.x + bflo(a1.x), ALPHA * x1.y + bfhi(a1.x), ALPHA * x1.z + bflo(a1.y), ALPHA * x1.w + bfhi(a1.y));
    }
};
struct EpiBf16 {
    bf16_t* out; int ldc;
    __device__ __forceinline__ void operator()(int m, int pn, int c8, const unsigned char* stg_row) const {
        const int col = pn * 256 + c8 * 8;
        const u32x2 a0 = *(const u32x2*)(stg_row + c8 * 16), a1 = *(const u32x2*)(stg_row + c8 * 16 + 8);
        u32x4 o; o.x = a0.x; o.y = a0.y; o.z = a1.x; o.w = a1.y;
        *(u32x4*)(out + (size_t)m * ldc + col) = o;
    }
};

template <class EPI>
__device__ __forceinline__ void gemm_phase(const bf16_t* __restrict__ A, const bf16_t* __restrict__ Bt, int M, int N, const EPI& epi, unsigned char* smem) {
    const int tid = threadIdx.x, lane = tid & 63, wave = tid >> 6, r = lane & 31, h = lane >> 5;
    const int wm = wave >> 2, wn = wave & 3;
    const int nM = M / 256, nN = N / 256, ntiles = nM * nN;
    const int gx = gridDim.x, nxg = (gx % 8 == 0 && ntiles % 8 == 0) ? 8 : 1, bpg = gx / nxg, tpg = ntiles / nxg;
    const int grp = blockIdx.x % nxg, bin = blockIdx.x / nxg;
    const int grow = 16 * wave + (lane >> 2), gch = (lane & 3) ^ ((grow >> 2) & 3);
    const unsigned goff = (unsigned)(grow * GK + gch * 8) * 2u;
    constexpr int NKT = GK / 32, STG = 32768;
#define G_DMA1(kt_, Ag_, Bg_, op_, i_) do { const unsigned char* sb_ = (const unsigned char*)((op_) ? (Bg_) : (Ag_)) + (kt_) * 64; \
            __builtin_amdgcn_global_load_lds((const unsigned*)(sb_ + (i_) * (128 * GK * 2) + goff), (unsigned*)(smem + ((kt_) & 3) * STG + wave * 1024 + (op_) * 16384 + (i_) * 8192), 16, 0, 0); } while (0)
#define G_STAGE(kt_, Ag_, Bg_) do { G_DMA1(kt_, Ag_, Bg_, 0, 0); G_DMA1(kt_, Ag_, Bg_, 1, 0); G_DMA1(kt_, Ag_, Bg_, 0, 1); G_DMA1(kt_, Ag_, Bg_, 1, 1); } while (0)
#define G_SWZ32(row_, c_) ((row_) * 64 + ((((c_) ^ ((row_) >> 2)) & 3) << 4))
#define G_COMPUTE(kt_, Ag_, Bg_, pf_) do { const unsigned char* la_ = smem + ((kt_) & 3) * STG; const unsigned char* lb_ = la_ + 16384; \
            bf16x8 af_[2][4], bf_[2][2]; \
            _Pragma("unroll") for (int ks_ = 0; ks_ < 2; ++ks_) { \
                _Pragma("unroll") for (int i_ = 0; i_ < 4; ++i_) af_[ks_][i_] = *(const bf16x8*)(la_ + G_SWZ32(wm * 128 + i_ * 32 + r, ks_ * 2 + h)); \
                _Pragma("unroll") for (int j_ = 0; j_ < 2; ++j_) bf_[ks_][j_] = *(const bf16x8*)(lb_ + G_SWZ32(wn * 64 + j_ * 32 + r, ks_ * 2 + h)); } \
            __builtin_amdgcn_sched_barrier(0); \
            _Pragma("unroll") for (int g_ = 0; g_ < 4; ++g_) { const int ks_ = g_ >> 1, j_ = g_ & 1; \
                _Pragma("unroll") for (int i_ = 0; i_ < 4; ++i_) acc[j_][i_] = __builtin_amdgcn_mfma_f32_32x32x16_bf16(bf_[ks_][j_], af_[ks_][i_], acc[j_][i_], 0, 0, 0); \
                __builtin_amdgcn_sched_barrier(0); \
                if (pf_) G_DMA1((kt_) + 3, Ag_, Bg_, g_ & 1, g_ >> 1); \
                __builtin_amdgcn_sched_barrier(0); } } while (0)
#define G_RAWBAR() do { asm volatile("s_waitcnt lgkmcnt(0)" ::: "memory"); __builtin_amdgcn_s_barrier(); asm volatile("" ::: "memory"); } while (0)
    for (int tt = bin; tt < tpg; tt += bpg) {
        const int t = grp * tpg + tt;
        const int pm = t / nN, pn = t % nN;
        const bf16_t* Ag = A + (size_t)pm * 256 * GK; const bf16_t* Bg = Bt + (size_t)pn * 256 * GK;
        f32x16 acc[2][4];
#pragma unroll
        for (int j = 0; j < 2; ++j)
#pragma unroll
            for (int i = 0; i < 4; ++i)
#pragma unroll
                for (int e = 0; e < 16; ++e) acc[j][i][e] = 0.f;
        G_RAWBAR();
        G_STAGE(0, Ag, Bg); G_STAGE(1, Ag, Bg); G_STAGE(2, Ag, Bg);
        for (int kt = 0; kt < NKT; ++kt) {
            if (kt + 2 < NKT) asm volatile("s_waitcnt vmcnt(8)" ::: "memory");
            else if (kt + 1 < NKT) asm volatile("s_waitcnt vmcnt(4)" ::: "memory");
            else asm volatile("s_waitcnt vmcnt(0)" ::: "memory");
            G_RAWBAR();
            G_COMPUTE(kt, Ag, Bg, kt + 3 < NKT);
        }
        G_RAWBAR();
#pragma unroll
        for (int j = 0; j < 2; ++j)
#pragma unroll
            for (int i = 0; i < 4; ++i)
#pragma unroll
                for (int g = 0; g < 4; ++g) {
                    u32x2 v; v.x = pk_bf16(acc[j][i][4 * g], acc[j][i][4 * g + 1]); v.y = pk_bf16(acc[j][i][4 * g + 2], acc[j][i][4 * g + 3]);
                    *(u32x2*)(smem + (size_t)(wm * 128 + i * 32 + r) * (STG_STRIDE * 2) + (wn * 64 + j * 32 + 8 * g + 4 * h) * 2) = v;
                }
        __syncthreads();
        const int erow = tid >> 5, ec8 = tid & 31;
#pragma unroll 4
        for (int ps = 0; ps < 16; ++ps) { const int row = ps * 16 + erow; epi(pm * 256 + row, pn, ec8, smem + (size_t)row * (STG_STRIDE * 2)); }
    }
#undef G_DMA1
#undef G_STAGE
#undef G_COMPUTE
#undef G_SWZ32
#undef G_RAWBAR
    __syncthreads();
}


constexpr int DN_CH_BYTES = 73728;

constexpr int DP_QS = 0, DP_KS = 16384, DP_TI = 0, DP_Q = 17408, DP_TB = 21632;
constexpr int DP_RT = 32768;
constexpr int DP_AM = 69632;
constexpr int DP_KDT = 87040;
constexpr int DP_QK = 104448;
constexpr int DP_WI = 113152;
constexpr int DP_SM = 130048;

__device__ __forceinline__ void phase_dn_prep(const Params& p, unsigned char* smem) {
    const int tid0 = threadIdx.x;
    float* sbeta = (float*)(smem + DP_SM); float* sgc = sbeta + 64; float* segc = sbeta + 128; float* sekd = sbeta + 192;
    float* Am = (float*)(smem + DP_AM); float* Ti = (float*)(smem + DP_TI); float* Qb = (float*)(smem + DP_Q);
    bf16_t* Tb = (bf16_t*)(smem + DP_TB); bf16_t* Rt = (bf16_t*)(smem + DP_RT);
    bf16_t* kdt = (bf16_t*)(smem + DP_KDT); bf16_t* qki = (bf16_t*)(smem + DP_QK); bf16_t* wim = (bf16_t*)(smem + DP_WI);
    u32x4 xin[7][2]; float pre_b = 0.f, pre_a = 0.f;
    auto dn_fetch = [&](int cj) {
        const int tq = tid0, bhj = cj >> 7, nj = cj & 127, hj = bhj & 3;
        const bf16_t* prj = p.proj_b + (size_t)(bhj >> 2) * SEQ * NP_IN;
        if (tq < 384) {
            const int mat = tq >> 7, rg = (tq >> 3) & 15, sg = tq & 7;
            const int colbase = (mat == 0 ? P_DQ : (mat == 1 ? P_DK : P_DV)) + hj * 128 + sg * 16;
#pragma unroll
            for (int rr = 0; rr < 7; ++rr) {
                const int tt = nj * 64 + 4 * rg - 3 + rr;
                if (tt >= 0) { xin[rr][0] = *(const u32x4*)(prj + (size_t)tt * NP_IN + colbase); xin[rr][1] = *(const u32x4*)(prj + (size_t)tt * NP_IN + colbase + 8); }
                else { xin[rr][0] = (u32x4){0u, 0u, 0u, 0u}; xin[rr][1] = (u32x4){0u, 0u, 0u, 0u}; }
            }
        }
        if (tq < 64) { const size_t m = (size_t)(nj * 64 + tq); pre_b = bf2f(prj[m * NP_IN + P_B + hj]); pre_a = bf2f(prj[m * NP_IN + P_A + hj]); }
    };
    if (blockIdx.x < 16 * 128) dn_fetch(blockIdx.x);
    for (int ci = blockIdx.x; ci < 16 * 128; ci += gridDim.x) {
        int tid = tid0; asm volatile("" : "+v"(tid));
        const int lane = tid & 63, wave = tid >> 6;
        const int bh = ci >> 7, n = ci & 127, b = bh >> 2, h = bh & 3;
        const bf16_t* prow = p.proj_b + (size_t)b * SEQ * NP_IN;
        if (wave == 0) {
            const float braw = pre_b, araw = pre_a;
            const float beta = 1.f / (1.f + expf(-braw));
            const float xx = araw + p.dt_bias[h];
            const float sp = xx > 20.f ? xx : log1pf(expf(xx));
            float g = -expf(p.a_log[h]) * sp;
#pragma unroll
            for (int o = 1; o < 64; o <<= 1) { const float up = __shfl_up(g, o); if (lane >= o) g += up; }
            const float g63 = __shfl(g, 63);
            sbeta[lane] = beta; sgc[lane] = g; segc[lane] = expf(g); sekd[lane] = expf(g63 - g);
            if (lane == 63) p.dn_gl[ci] = expf(g63);
        }
        __syncthreads();
        if (tid < 384) {
            const int mat = tid >> 7, rg = (tid >> 3) & 15, sg = tid & 7, c0 = sg * 16, i0 = 4 * rg;
            const int colbase = (mat == 0 ? P_DQ : (mat == 1 ? P_DK : P_DV)) + h * 128 + c0;
            float wgt[4][16];
#pragma unroll
            for (int j = 0; j < 4; ++j) {
                const float* wp = p.conv_w + j * 1536 + mat * 512 + h * 128 + c0;
#pragma unroll
                for (int q4 = 0; q4 < 4; ++q4) { const float4 w4 = *(const float4*)(wp + 4 * q4); wgt[j][4 * q4] = w4.x; wgt[j][4 * q4 + 1] = w4.y; wgt[j][4 * q4 + 2] = w4.z; wgt[j][4 * q4 + 3] = w4.w; }
            }
#pragma unroll
            for (int ro = 0; ro < 4; ++ro) {
                const int i = i0 + ro, ix = i ^ (sg << 3);
                float acc[16];
#pragma unroll
                for (int cc = 0; cc < 16; ++cc) acc[cc] = 0.f;
#pragma unroll
                for (int j = 0; j < 4; ++j) {
                    const u32x4 x0 = xin[ro + j][0], x1 = xin[ro + j][1];
                    const unsigned xs[8] = {x0.x, x0.y, x0.z, x0.w, x1.x, x1.y, x1.z, x1.w};
#pragma unroll
                    for (int c2 = 0; c2 < 8; ++c2) { acc[2 * c2] = fmaf(wgt[j][2 * c2], bflo(xs[c2]), acc[2 * c2]); acc[2 * c2 + 1] = fmaf(wgt[j][2 * c2 + 1], bfhi(xs[c2]), acc[2 * c2 + 1]); }
                }
                float ss = 0.f;
#pragma unroll
                for (int cc = 0; cc < 16; ++cc) { acc[cc] = silu_f(acc[cc]); ss = fmaf(acc[cc], acc[cc], ss); }
                const float beta_i = sbeta[i], egc_i = segc[i], ekd_i = sekd[i];
                if (mat < 2) {
                    ss += __shfl_xor(ss, 1); ss += __shfl_xor(ss, 2); ss += __shfl_xor(ss, 4);
                    const float rs = rsqrtf(ss + L2_EPS) * (mat == 0 ? 0.08838834764831845f : 1.f);
#pragma unroll
                    for (int cc = 0; cc < 16; ++cc) acc[cc] *= rs;
                    unsigned char* img = smem + (mat == 0 ? DP_QS : DP_KS) + i * 256;
                    u32x4 c0v, c1v;
                    c0v.x = pk_bf16(acc[0], acc[1]); c0v.y = pk_bf16(acc[2], acc[3]); c0v.z = pk_bf16(acc[4], acc[5]); c0v.w = pk_bf16(acc[6], acc[7]);
                    c1v.x = pk_bf16(acc[8], acc[9]); c1v.y = pk_bf16(acc[10], acc[11]); c1v.z = pk_bf16(acc[12], acc[13]); c1v.w = pk_bf16(acc[14], acc[15]);
                    *(u32x4*)(img + (((2 * sg) ^ (i & 15)) << 4)) = c0v;
                    *(u32x4*)(img + (((2 * sg + 1) ^ (i & 15)) << 4)) = c1v;
                }
                if (mat == 0) {
                    u32x4 p0, p1;
                    p0.x = pk_bf16(acc[0] * egc_i, acc[1] * egc_i); p0.y = pk_bf16(acc[2] * egc_i, acc[3] * egc_i); p0.z = pk_bf16(acc[8] * egc_i, acc[9] * egc_i); p0.w = pk_bf16(acc[10] * egc_i, acc[11] * egc_i);
                    p1.x = pk_bf16(acc[4] * egc_i, acc[5] * egc_i); p1.y = pk_bf16(acc[6] * egc_i, acc[7] * egc_i); p1.z = pk_bf16(acc[12] * egc_i, acc[13] * egc_i); p1.w = pk_bf16(acc[14] * egc_i, acc[15] * egc_i);
                    bf16_t* dst = p.dn_qd + ((size_t)(ci * 16 + (i >> 5) * 8 + sg) * 64) * 8;
                    *(u32x4*)(dst + (size_t)(i & 31) * 8) = p0;
                    *(u32x4*)(dst + (size_t)(32 + (i & 31)) * 8) = p1;
                } else if (mat == 1) {
                    const float sc = beta_i * egc_i;
#pragma unroll
                    for (int cc = 0; cc < 16; ++cc) {
                        Rt[(128 + c0 + cc) * 72 + ix] = (bf16_t)(pk_bf16(acc[cc] * sc, 0.f) & 0xffffu);
                        kdt[(c0 + cc) * 68 + ix] = (bf16_t)(pk_bf16(acc[cc] * ekd_i, 0.f) & 0xffffu);
                    }
                } else {
#pragma unroll
                    for (int cc = 0; cc < 16; ++cc) Rt[(c0 + cc) * 72 + ix] = (bf16_t)(pk_bf16(acc[cc] * beta_i, 0.f) & 0xffffu);
                }
            }
        }
        if (ci + (int)gridDim.x < 16 * 128) dn_fetch(ci + (int)gridDim.x);
        __syncthreads();
        {
            const int mat = wave >> 2, ti = (wave >> 1) & 1, tj = wave & 1, r = lane & 31, hh = lane >> 5;
            const unsigned char* ai = smem + (mat ? DP_QS : DP_KS) + (ti * 32 + r) * 256;
            const unsigned char* bi = smem + DP_KS + (tj * 32 + r) * 256;
            f32x16 d;
#pragma unroll
            for (int e = 0; e < 16; ++e) d[e] = 0.f;
#pragma unroll
            for (int ks = 0; ks < 8; ++ks) {
                const bf16x8 af = *(const bf16x8*)(ai + (((2 * ks + hh) ^ (r & 15)) << 4));
                const bf16x8 bf = *(const bf16x8*)(bi + (((2 * ks + hh) ^ (r & 15)) << 4));
                d = __builtin_amdgcn_mfma_f32_32x32x16_bf16(af, bf, d, 0, 0, 0);
            }
            const int j = tj * 32 + r; const float gcj = sgc[j];
#pragma unroll
            for (int e = 0; e < 16; ++e) {
                const int i = ti * 32 + (e & 3) + 8 * (e >> 2) + 4 * hh;
                const float dec = __expf(fminf(sgc[i] - gcj, 0.f));
                if (mat == 0) Am[i * 68 + j] = (j < i) ? sbeta[i] * d[e] * dec : 0.f;
                else qki[i * 68 + j] = (bf16_t)(pk_bf16((j <= i) ? d[e] * dec : 0.f, 0.f) & 0xffffu);
            }
        }
        __syncthreads();
        if (tid < 64) {
            const int bk = tid >> 4, c = tid & 15;
            const float* Ab = Am + (16 * bk) * 68 + 16 * bk;
            float X[16];
#pragma unroll
            for (int i = 0; i < 16; ++i) {
                float sacc = 0.f;
#pragma unroll
                for (int j = 0; j < i; ++j) sacc = fmaf(Ab[i * 68 + j], X[j], sacc);
                X[i] = ((i == c) ? 1.f : 0.f) - sacc;
            }
#pragma unroll
            for (int i = 0; i < 16; ++i) Ti[(16 * bk + i) * 68 + 16 * bk + c] = X[i];
        } else {
            for (int z = tid - 64; z < 6 * 256; z += 448) {
                const int blk = z >> 8, e2 = z & 255, bi = blk < 3 ? 0 : (blk < 5 ? 1 : 2), bj = blk < 3 ? blk + 1 : (blk < 5 ? blk - 1 : 3);
                Ti[(16 * bi + (e2 >> 4)) * 68 + 16 * bj + (e2 & 15)] = 0.f;
            }
        }
        __syncthreads();
        {
            const int w2 = tid >> 8, o = tid & 255, ri = o >> 4, cj = o & 15, r0 = 16 * (2 * w2 + 1), c0 = 16 * (2 * w2);
            float sacc = 0.f;
#pragma unroll
            for (int k = 0; k < 16; ++k) sacc = fmaf(Am[(r0 + ri) * 68 + c0 + k], Ti[(c0 + k) * 68 + c0 + cj], sacc);
            Qb[w2 * 272 + ri * 17 + cj] = sacc;
        }
        __syncthreads();
        {
            const int w2 = tid >> 8, o = tid & 255, ri = o >> 4, cj = o & 15, r0 = 16 * (2 * w2 + 1), c0 = 16 * (2 * w2);
            float sacc = 0.f;
#pragma unroll
            for (int k = 0; k < 16; ++k) sacc = fmaf(Ti[(r0 + ri) * 68 + r0 + k], Qb[w2 * 272 + k * 17 + cj], sacc);
            Ti[(r0 + ri) * 68 + c0 + cj] = -sacc;
        }
        __syncthreads();
        float q3[2];
#pragma unroll
        for (int q = 0; q < 2; ++q) {
            const int o = tid + 512 * q, ri = o >> 5, cj = o & 31;
            float sacc = 0.f;
#pragma unroll
            for (int k = 0; k < 32; ++k) sacc = fmaf(Am[(32 + ri) * 68 + k], Ti[k * 68 + cj], sacc);
            q3[q] = sacc;
        }
#pragma unroll
        for (int q = 0; q < 2; ++q) { const int o = tid + 512 * q; Qb[(o >> 5) * 33 + (o & 31)] = q3[q]; }
        __syncthreads();
#pragma unroll
        for (int q = 0; q < 2; ++q) {
            const int o = tid + 512 * q, ri = o >> 5, cj = o & 31;
            float sacc = 0.f;
#pragma unroll
            for (int k = 0; k < 32; ++k) sacc = fmaf(Ti[(32 + ri) * 68 + 32 + k], Qb[k * 33 + cj], sacc);
            q3[q] = -sacc;
        }
        __syncthreads();
#pragma unroll
        for (int q = 0; q < 2; ++q) { const int o = tid + 512 * q; Ti[(32 + (o >> 5)) * 68 + (o & 31)] = q3[q]; }
        __syncthreads();
#pragma unroll
        for (int q = 0; q < 4; ++q) {
            const int o2 = tid + 512 * q, ri = o2 >> 5, c2 = (o2 & 31) * 2;
            *(unsigned*)(Tb + ri * 72 + c2) = pk_bf16(Ti[ri * 68 + c2], Ti[ri * 68 + c2 + 1]);
        }
        __syncthreads();
        {
            const int ct = wave, r = lane & 31, hh = lane >> 5;
            f32x16 xacc[2];
#pragma unroll
            for (int T = 0; T < 2; ++T)
#pragma unroll
                for (int e = 0; e < 16; ++e) xacc[T][e] = 0.f;
#pragma unroll
            for (int ks = 0; ks < 4; ++ks) {
                const bf16x8 bfr = *(const bf16x8*)(Rt + (32 * ct + r) * 72 + (((2 * ks + hh) ^ (((32 * ct + r) >> 4) & 7)) << 3));
#pragma unroll
                for (int T = 0; T < 2; ++T) {
                    const bf16x8 afr = *(const bf16x8*)(Tb + (32 * T + r) * 72 + 16 * ks + 8 * hh);
                    xacc[T] = __builtin_amdgcn_mfma_f32_32x32x16_bf16(afr, bfr, xacc[T], 0, 0, 0);
                }
            }
            if (ct < 4) {
#pragma unroll
                for (int T = 0; T < 2; ++T)
#pragma unroll
                    for (int hf = 0; hf < 2; ++hf) {
                        u32x4 o; o.x = pk_bf16(xacc[T][8 * hf], xacc[T][8 * hf + 1]); o.y = pk_bf16(xacc[T][8 * hf + 2], xacc[T][8 * hf + 3]);
                        o.z = pk_bf16(xacc[T][8 * hf + 4], xacc[T][8 * hf + 5]); o.w = pk_bf16(xacc[T][8 * hf + 6], xacc[T][8 * hf + 7]);
                        *(u32x4*)(p.dn_u + ((size_t)(((ci * 4 + ct) * 2 + T) * 2 + hf) * 64 + lane) * 8) = o;
                    }
            } else {
                const int dd = 32 * (ct - 4) + r;
#pragma unroll
                for (int T = 0; T < 2; ++T)
#pragma unroll
                    for (int e = 0; e < 16; ++e) wim[(32 * T + (e & 3) + 8 * (e >> 2) + 4 * hh) * 132 + dd] = (bf16_t)(pk_bf16(-xacc[T][e], 0.f) & 0xffffu);
            }
#pragma unroll
            for (int q = 0; q < 3; ++q) {
                const int pc = tid + 512 * q;
                if (pc < 512) {
                    const int f = pc >> 6, ln = pc & 63, r2 = ln & 31, h2 = ln >> 5, rt = f >> 2, ks = f & 3;
                    const bf16_t* src = qki + (32 * rt + r2) * 68 + 16 * ks + 4 * h2;
                    const u32x2 lo = *(const u32x2*)src, hi = *(const u32x2*)(src + 8);
                    u32x4 o; o.x = lo.x; o.y = lo.y; o.z = hi.x; o.w = hi.y;
                    *(u32x4*)(p.dn_qk + ((size_t)(ci * 8 + f) * 64 + ln) * 8) = o;
                } else {
                    const int pc2 = pc - 512, f = pc2 >> 6, ln = pc2 & 63, r2 = ln & 31, h2 = ln >> 5, rt = f >> 2, ks = f & 3;
                    const int dd2 = 32 * rt + r2, sx = ((dd2 >> 4) & 7) << 3, i0 = 16 * ks + 4 * h2;
                    const u32x2 lo = *(const u32x2*)(kdt + dd2 * 68 + (i0 ^ sx)), hi = *(const u32x2*)(kdt + dd2 * 68 + ((i0 + 8) ^ sx));
                    u32x4 o; o.x = lo.x; o.y = lo.y; o.z = hi.x; o.w = hi.y;
                    *(u32x4*)(p.dn_kdt + ((size_t)(ci * 16 + f) * 64 + ln) * 8) = o;
                }
            }
        }
        __syncthreads();
#pragma unroll
        for (int q = 0; q < 2; ++q) {
            const int pc = tid + 512 * q, f = pc >> 6, ln = pc & 63, r = ln & 31, hh = ln >> 5, rt = f >> 3, ks = f & 7;
            const bf16_t* src = wim + (32 * rt + r) * 132 + 16 * ks + 4 * hh;
            const u32x2 lo = *(const u32x2*)src, hi = *(const u32x2*)(src + 8);
            u32x4 o; o.x = lo.x; o.y = lo.y; o.z = hi.x; o.w = hi.y;
            *(u32x4*)(p.dn_negw + ((size_t)(ci * 16 + f) * 64 + ln) * 8) = o;
        }
    }
    __syncthreads();
}

__device__ __forceinline__ bf16x8 pack8(const f32x16& x, int s) {
    u32x4 v;
    v.x = pk_bf16(x[8 * s], x[8 * s + 1]); v.y = pk_bf16(x[8 * s + 2], x[8 * s + 3]); v.z = pk_bf16(x[8 * s + 4], x[8 * s + 5]); v.w = pk_bf16(x[8 * s + 6], x[8 * s + 7]);
    return __builtin_bit_cast(bf16x8, v);
}
#define LDS_BARRIER() do { asm volatile("s_waitcnt lgkmcnt(0)" ::: "memory"); __builtin_amdgcn_s_barrier(); asm volatile("" ::: "memory"); } while (0)
__device__ __forceinline__ const bf16_t* dn_piece_src(const Params& p, int ci, int pc) {
    return pc < 1024 ? p.dn_negw + ((size_t)ci * 1024 + pc) * 8 : pc < 2048 ? p.dn_qd + ((size_t)ci * 1024 + (pc - 1024)) * 8
         : pc < 3072 ? p.dn_kdt + ((size_t)ci * 1024 + (pc - 2048)) * 8 : pc < 3584 ? p.dn_qk + ((size_t)ci * 512 + (pc - 3072)) * 8 : p.dn_u + ((size_t)ci * 1024 + (pc - 3584)) * 8;
}
constexpr int DN_SEG = 32;
template <int PASS> __device__ __forceinline__ int dn_lpiece(int q) { return PASS == 0 ? q : (q < 1024 ? q : (q < 2048 ? q + 1024 : q + 1536)); }
template <int PASS>
__device__ __forceinline__ void dn_scan_seg(const Params& p, unsigned char* smem, int bh, int seg, int half) {
    constexpr int NPC = PASS == 0 ? 4608 : 3072, LPT = NPC / 256, PPT = NPC / 512;
    const int tid = threadIdx.x, lane = tid & 63, wave = tid >> 6, r = lane & 31, hh = lane >> 5;
    const int b = bh >> 2, h = bh & 3, ci0 = bh * 128 + seg * DN_SEG;
#pragma unroll
    for (int q = 0; q < PPT; ++q) { const int pc = dn_lpiece<PASS>(tid + 512 * q); *(u32x4*)(smem + pc * 16) = *(const u32x4*)dn_piece_src(p, ci0, pc); }
    __syncthreads();
    if (wave >= 4) {
        const int t2 = tid - 256;
        u32x4 sa[LPT], sb[LPT], sc[LPT];
#define DN_LD(dst, chunk) do { const int c_ = ci0 + ((chunk) < DN_SEG - 1 ? (chunk) : DN_SEG - 1); _Pragma("unroll") for (int q_ = 0; q_ < LPT; ++q_) dst[q_] = *(const u32x4*)dn_piece_src(p, c_, dn_lpiece<PASS>(t2 + 256 * q_)); } while (0)
#define DN_WR(src, chunk) do { if ((chunk) < DN_SEG) { unsigned char* nb_ = smem + ((chunk) & 1) * DN_CH_BYTES; _Pragma("unroll") for (int q_ = 0; q_ < LPT; ++q_) *(u32x4*)(nb_ + dn_lpiece<PASS>(t2 + 256 * q_) * 16) = src[q_]; } } while (0)
        DN_LD(sa, 1); DN_LD(sb, 2); DN_LD(sc, 3);
        unsigned* prog = p.bar + XCD_BAR_WORDS + 64 * (bh * 4 + seg);
#define DN_PUB(v) do { if (PASS == 0 && t2 == 0) __hip_atomic_store(prog, (unsigned)(v), __ATOMIC_RELAXED, __HIP_MEMORY_SCOPE_AGENT); } while (0)
        for (int n = 0; n < DN_SEG + 1; n += 3) {
            if (n < DN_SEG) { DN_WR(sa, n + 1); DN_LD(sa, n + 4); DN_PUB(n + 1); LDS_BARRIER(); }
            if (n + 1 < DN_SEG) { DN_WR(sb, n + 2); DN_LD(sb, n + 5); DN_PUB(n + 2); LDS_BARRIER(); }
            if (n + 2 < DN_SEG) { DN_WR(sc, n + 3); DN_LD(sc, n + 6); DN_PUB(n + 3); LDS_BARRIER(); }
        }
#undef DN_PUB
#undef DN_LD
#undef DN_WR
    } else {
        const int e = __builtin_amdgcn_readfirstlane(wave);
        const int sl = 4 * half + e;
        const bool isP = sl < 4;
        f32x16 S[4];
#pragma unroll
        for (int T = 0; T < 4; ++T)
#pragma unroll
            for (int e2 = 0; e2 < 16; ++e2) {
                const int row = 32 * T + (e2 & 3) + 8 * (e2 >> 2) + 4 * hh;
                if (PASS == 0) S[T][e2] = seg > 0 ? p.dn_PB[((size_t)(bh * 3 + 0) * 128 + row) * 256 + 128 + 32 * e + r] : 0.f;
                else S[T][e2] = (isP && row == 32 * sl + r) ? 1.f : 0.f;
            }
        if (PASS == 0) {
            for (int sg = 1; sg < seg; ++sg) {
                const float* pseg = p.dn_PB + (size_t)(bh * 3 + sg) * 128 * 256;
                bf16x8 Xb[8];
#pragma unroll
                for (int T = 0; T < 4; ++T) { Xb[2 * T] = pack8(S[T], 0); Xb[2 * T + 1] = pack8(S[T], 1); }
#pragma unroll
                for (int T = 0; T < 4; ++T) {
                    f32x16 xn;
#pragma unroll
                    for (int e2 = 0; e2 < 16; ++e2) xn[e2] = pseg[(size_t)(32 * T + (e2 & 3) + 8 * (e2 >> 2) + 4 * hh) * 256 + 128 + 32 * e + r];
#pragma unroll
                    for (int ks = 0; ks < 8; ++ks) {
                        const float* pr = pseg + (size_t)(32 * T + r) * 256 + 16 * ks + 4 * hh;
                        const float4 lo = *(const float4*)pr, hi = *(const float4*)(pr + 8);
                        u32x4 av; av.x = pk_bf16(lo.x, lo.y); av.y = pk_bf16(lo.z, lo.w); av.z = pk_bf16(hi.x, hi.y); av.w = pk_bf16(hi.z, hi.w);
                        xn = __builtin_amdgcn_mfma_f32_32x32x16_bf16(__builtin_bit_cast(bf16x8, av), Xb[ks], xn, 0, 0, 0);
                        if (ks & 1) __builtin_amdgcn_sched_barrier(0);
                    }
                    S[T] = xn;
                    __builtin_amdgcn_sched_barrier(0);
                }
            }
        }
        const float glr = p.dn_gl[ci0 + (lane & 31)];
#define DN_SB() __builtin_amdgcn_sched_barrier(0)
#define DN_RD8(dst, off) do { _Pragma("unroll") for (int q_ = 0; q_ < 8; ++q_) dst[q_] = *(const bf16x8*)(buf + (off) + q_ * 1024 + lane * 16); } while (0)
        bf16x8 Sb[8];
#pragma unroll
        for (int T = 0; T < 4; ++T) { Sb[2 * T] = pack8(S[T], 0); Sb[2 * T + 1] = pack8(S[T], 1); }
        const unsigned ooff = (unsigned)(4 * hh * 512 + r);
        for (int n = 0; n < DN_SEG; ++n) {
            const unsigned char* buf = smem + (n & 1) * DN_CH_BYTES;
            const float gl = __uint_as_float(__builtin_amdgcn_readlane(__float_as_uint(glr), n));
            bf16x8 fa[8], fb[8];
            DN_RD8(fa, 0);
            DN_RD8(fb, 8192);
            f32x16 vn0, vn1;
            if (PASS == 0 || !isP) {
                const unsigned char* ub = buf + 57344 + (PASS == 0 ? e : sl - 4) * 4096 + lane * 16;
                const u32x4 u00 = *(const u32x4*)ub, u01 = *(const u32x4*)(ub + 1024), u10 = *(const u32x4*)(ub + 2048), u11 = *(const u32x4*)(ub + 3072);
                vn0[0] = bflo(u00.x); vn0[1] = bfhi(u00.x); vn0[2] = bflo(u00.y); vn0[3] = bfhi(u00.y); vn0[4] = bflo(u00.z); vn0[5] = bfhi(u00.z); vn0[6] = bflo(u00.w); vn0[7] = bfhi(u00.w);
                vn0[8] = bflo(u01.x); vn0[9] = bfhi(u01.x); vn0[10] = bflo(u01.y); vn0[11] = bfhi(u01.y); vn0[12] = bflo(u01.z); vn0[13] = bfhi(u01.z); vn0[14] = bflo(u01.w); vn0[15] = bfhi(u01.w);
                vn1[0] = bflo(u10.x); vn1[1] = bfhi(u10.x); vn1[2] = bflo(u10.y); vn1[3] = bfhi(u10.y); vn1[4] = bflo(u10.z); vn1[5] = bfhi(u10.z); vn1[6] = bflo(u10.w); vn1[7] = bfhi(u10.w);
                vn1[8] = bflo(u11.x); vn1[9] = bfhi(u11.x); vn1[10] = bflo(u11.y); vn1[11] = bfhi(u11.y); vn1[12] = bflo(u11.z); vn1[13] = bfhi(u11.z); vn1[14] = bflo(u11.w); vn1[15] = bfhi(u11.w);
            } else {
#pragma unroll
                for (int e2 = 0; e2 < 16; ++e2) { vn0[e2] = 0.f; vn1[e2] = 0.f; }
            }
            DN_SB();
#pragma unroll
            for (int ks = 0; ks < 8; ++ks) vn0 = __builtin_amdgcn_mfma_f32_32x32x16_bf16(fa[ks], Sb[ks], vn0, 0, 0, 0);
            DN_SB();
            if (PASS == 0) DN_RD8(fa, 16384); else DN_RD8(fa, 32768);
            DN_SB();
#pragma unroll
            for (int ks = 0; ks < 8; ++ks) vn1 = __builtin_amdgcn_mfma_f32_32x32x16_bf16(fb[ks], Sb[ks], vn1, 0, 0, 0);
            DN_SB();
            if (PASS == 0) DN_RD8(fb, 16384 + 8192); else DN_RD8(fb, 32768 + 8192);
            DN_SB();
            f32x16 o0, o1;
            if (PASS == 0) {
#pragma unroll
                for (int e2 = 0; e2 < 16; ++e2) { o0[e2] = 0.f; o1[e2] = 0.f; }
#pragma unroll
                for (int ks = 0; ks < 8; ++ks) o0 = __builtin_amdgcn_mfma_f32_32x32x16_bf16(fa[ks], Sb[ks], o0, 0, 0, 0);
                DN_SB();
                DN_RD8(fa, 32768);
            }
            bf16x8 vb[4];
            vb[0] = pack8(vn0, 0); vb[1] = pack8(vn0, 1); vb[2] = pack8(vn1, 0); vb[3] = pack8(vn1, 1);
            DN_SB();
            if (PASS == 0) {
#pragma unroll
                for (int ks = 0; ks < 8; ++ks) o1 = __builtin_amdgcn_mfma_f32_32x32x16_bf16(fb[ks], Sb[ks], o1, 0, 0, 0);
                DN_SB();
                DN_RD8(fb, 32768 + 8192);
            }
#pragma unroll
            for (int e2 = 0; e2 < 16; ++e2) { S[0][e2] *= gl; S[1][e2] *= gl; }
            DN_SB();
#pragma unroll
            for (int ks = 0; ks < 4; ++ks) S[0] = __builtin_amdgcn_mfma_f32_32x32x16_bf16(fa[ks], vb[ks], S[0], 0, 0, 0);
#pragma unroll
            for (int ks = 0; ks < 4; ++ks) S[1] = __builtin_amdgcn_mfma_f32_32x32x16_bf16(fa[4 + ks], vb[ks], S[1], 0, 0, 0);
            DN_SB();
            if (PASS == 0) DN_RD8(fa, 49152);
#pragma unroll
            for (int e2 = 0; e2 < 16; ++e2) { S[2][e2] *= gl; S[3][e2] *= gl; }
            DN_SB();
#pragma unroll
            for (int ks = 0; ks < 4; ++ks) S[2] = __builtin_amdgcn_mfma_f32_32x32x16_bf16(fb[ks], vb[ks], S[2], 0, 0, 0);
#pragma unroll
            for (int ks = 0; ks < 4; ++ks) S[3] = __builtin_amdgcn_mfma_f32_32x32x16_bf16(fb[4 + ks], vb[ks], S[3], 0, 0, 0);
            DN_SB();
            if (PASS == 0) {
#pragma unroll
                for (int ks = 0; ks < 4; ++ks) o0 = __builtin_amdgcn_mfma_f32_32x32x16_bf16(fa[ks], vb[ks], o0, 0, 0, 0);
#pragma unroll
                for (int ks = 0; ks < 4; ++ks) o1 = __builtin_amdgcn_mfma_f32_32x32x16_bf16(fa[4 + ks], vb[ks], o1, 0, 0, 0);
                DN_SB();
            }
#pragma unroll
            for (int T = 0; T < 4; ++T) { Sb[2 * T] = pack8(S[T], 0); Sb[2 * T + 1] = pack8(S[T], 1); }
            if (PASS == 0) {
                bf16_t* ob = p.odn_raw + ((size_t)b * SEQ + (seg * DN_SEG + n) * 64) * 512 + h * 128 + 32 * e;
#pragma unroll
                for (int e2 = 0; e2 < 16; e2 += 2) {
                    const unsigned w0 = pk_bf16(o0[e2], o0[e2 + 1]), w1 = pk_bf16(o1[e2], o1[e2 + 1]);
                    (ob + ((e2 & 3) + 8 * (e2 >> 2)) * 512)[ooff] = (bf16_t)(w0 & 0xffffu); (ob + ((e2 & 3) + 1 + 8 * (e2 >> 2)) * 512)[ooff] = (bf16_t)(w0 >> 16);
                    (ob + (32 + (e2 & 3) + 8 * (e2 >> 2)) * 512)[ooff] = (bf16_t)(w1 & 0xffffu); (ob + (32 + (e2 & 3) + 1 + 8 * (e2 >> 2)) * 512)[ooff] = (bf16_t)(w1 >> 16);
                }
            }
            LDS_BARRIER();
        }
#undef DN_RD8
#undef DN_SB
        if (PASS == 1) {
            float* pb = p.dn_PB + (size_t)(bh * 3 + seg) * 128 * 256 + 32 * sl + r;
#pragma unroll
            for (int T = 0; T < 4; ++T)
#pragma unroll
                for (int e2 = 0; e2 < 16; ++e2) pb[(size_t)(32 * T + (e2 & 3) + 8 * (e2 >> 2) + 4 * hh) * 256] = S[T][e2];
        }
    }
    __syncthreads();
}
__device__ __forceinline__ void phase_scan_l2_helper(const Params& p) {
    const int sj = blockIdx.x - 64, tid = threadIdx.x;
    const int bh = sj >> 2, seg = sj & 3, ci0 = bh * 128 + seg * DN_SEG;
    unsigned* prog = p.bar + XCD_BAR_WORDS + 64 * sj;
    unsigned acc = 0u;
    for (int m = 7; m < DN_SEG; ++m) {
        unsigned spins = 0, pr;
        for (;;) {
            pr = __hip_atomic_load(prog, __ATOMIC_RELAXED, __HIP_MEMORY_SCOPE_AGENT);
            if ((int)pr + 8 >= m || ++spins > 100000u) break;
            __builtin_amdgcn_s_sleep(16);
        }
        if ((int)pr + 4 >= m) continue;
#pragma unroll
        for (int q = 0; q < 9; ++q) { const u32x4 v = *(const u32x4*)dn_piece_src(p, ci0 + m, tid + 512 * q); acc ^= v.x ^ v.y ^ v.z ^ v.w; }
    }
    asm volatile("" :: "v"(acc));
}

constexpr int AT_VT = 32768, AT_VT_STRIDE = 260;
__device__ __forceinline__ void phase_attn(const Params& p, unsigned char* smem, int first_block) {
    const int tid0 = threadIdx.x;
    const int nblk = gridDim.x - first_block;
    const bf16_t* pb = p.proj_b;
    bf16_t* vt = (bf16_t*)(smem + AT_VT);
    u32x4 kvr[4], vvr[4]; bf16x8 qfn[4];
    auto at_fetch = [&](int it) {
        const int tq = tid0, ln = tq & 63, wv = tq >> 6;
        const int hp = it & 1, kvh = (it >> 1) & 1, nb = (it >> 2) & 63, b = it >> 8, m0 = b * SEQ + nb * 128;
#pragma unroll
        for (int i = 0; i < 4; ++i) {
            const int idx = tq + 512 * i, key = idx >> 3, ch = idx & 7;
            kvr[i] = (u32x4){0u, 0u, 0u, 0u}; vvr[i] = (u32x4){0u, 0u, 0u, 0u};
            if ((nb > 0) || (key >= 128)) { const bf16_t* src = pb + (size_t)(m0 - 128 + key) * NP_IN + kvh * 64 + ch * 8; kvr[i] = *(const u32x4*)(src + P_AK); vvr[i] = *(const u32x4*)(src + P_AV); }
        }
        const int head = kvh * 4 + hp * 2 + (wv >> 2), qo = (wv & 3) * 32;
        const bf16_t* qrow = pb + (size_t)(m0 + qo + (ln & 31)) * NP_IN + P_AQ + head * 64 + 8 * (ln >> 5);
#pragma unroll
        for (int ks = 0; ks < 4; ++ks) qfn[ks] = *(const bf16x8*)(qrow + 16 * ks);
    };
    if ((int)blockIdx.x - first_block < 1024) at_fetch((int)blockIdx.x - first_block);
    for (int item = blockIdx.x - first_block; item < 1024; item += nblk) {
        int tid = tid0; asm volatile("" : "+v"(tid));
        const int lane = tid & 63, wave = tid >> 6, r = lane & 31, hh = lane >> 5;
        const int hp = item & 1, kvh = (item >> 1) & 1, nb = (item >> 2) & 63, b = item >> 8;
        const int m0 = b * SEQ + nb * 128;
        __syncthreads();
#pragma unroll
        for (int i = 0; i < 4; ++i) {
            const int idx = tid + 512 * i, key = idx >> 3, ch = idx & 7;
            const u32x4 vv = vvr[i];
            *(u32x4*)(smem + swz(key, ch)) = kvr[i];
            bf16_t* vd = vt + (ch * 8) * AT_VT_STRIDE + (key ^ (ch << 3));
            vd[0] = (bf16_t)(vv.x & 0xffffu); vd[AT_VT_STRIDE] = (bf16_t)(vv.x >> 16); vd[2 * AT_VT_STRIDE] = (bf16_t)(vv.y & 0xffffu); vd[3 * AT_VT_STRIDE] = (bf16_t)(vv.y >> 16);
            vd[4 * AT_VT_STRIDE] = (bf16_t)(vv.z & 0xffffu); vd[5 * AT_VT_STRIDE] = (bf16_t)(vv.z >> 16); vd[6 * AT_VT_STRIDE] = (bf16_t)(vv.w & 0xffffu); vd[7 * AT_VT_STRIDE] = (bf16_t)(vv.w >> 16);
        }
        bf16x8 qf[4];
#pragma unroll
        for (int ks = 0; ks < 4; ++ks) qf[ks] = qfn[ks];
        __syncthreads();
        if (item + nblk < 1024) at_fetch(item + nblk);
        const int head = kvh * 4 + hp * 2 + (wave >> 2), qt = wave & 3, qo = qt * 32;
        f32x16 sc[5];
#pragma unroll
        for (int t = 0; t < 5; ++t) {
#pragma unroll
            for (int e = 0; e < 16; ++e) sc[t][e] = 0.f;
#pragma unroll
            for (int ks = 0; ks < 4; ++ks) sc[t] = __builtin_amdgcn_mfma_f32_32x32x16_bf16(*(const bf16x8*)(smem + swz((qt + t) * 32 + r, 2 * ks + hh)), qf[ks], sc[t], 0, 0, 0);
        }
        const float sink = p.sinks[head];
        float mx = -1e30f;
#pragma unroll
        for (int t = 0; t < 5; ++t)
#pragma unroll
            for (int e = 0; e < 16; ++e) {
                const int kf = 32 * (qt + t) + (e & 3) + 8 * (e >> 2) + 4 * hh;
                const bool ok = (kf >= qo + r + 1) && (kf <= qo + r + 128) && ((nb > 0) || (kf >= 128));
                sc[t][e] = ok ? sc[t][e] : -1e30f;
                mx = fmaxf(mx, sc[t][e]);
            }
        mx = fmaxf(mx, __shfl_xor(mx, 32));
        mx = fmaxf(mx, sink);
        float sum = 0.f;
#pragma unroll
        for (int t = 0; t < 5; ++t)
#pragma unroll
            for (int e = 0; e < 16; ++e) { const float pe = (sc[t][e] > -1e29f) ? __expf(sc[t][e] - mx) : 0.f; sc[t][e] = pe; sum += pe; }
        sum += __shfl_xor(sum, 32);
        const float inv = 1.f / (sum + __expf(sink - mx));
        f32x16 o[2];
#pragma unroll
        for (int dt = 0; dt < 2; ++dt)
#pragma unroll
            for (int e = 0; e < 16; ++e) o[dt][e] = 0.f;
#pragma unroll
        for (int t = 0; t < 5; ++t)
#pragma unroll
            for (int s2 = 0; s2 < 2; ++s2) {
                const bf16x8 pbv = pack8(sc[t], s2);
                const int kb = 32 * (qt + t) + 16 * s2 + 4 * hh;
#pragma unroll
                for (int dt = 0; dt < 2; ++dt) {
                    const int dvr = dt * 32 + r, vx = ((dvr >> 3) & 7) << 3;
                    const u32x2 lo = *(const u32x2*)(vt + dvr * AT_VT_STRIDE + (kb ^ vx)), hi = *(const u32x2*)(vt + dvr * AT_VT_STRIDE + ((kb + 8) ^ vx));
                    u32x4 av; av.x = lo.x; av.y = lo.y; av.z = hi.x; av.w = hi.y;
                    o[dt] = __builtin_amdgcn_mfma_f32_32x32x16_bf16(__builtin_bit_cast(bf16x8, av), pbv, o[dt], 0, 0, 0);
                }
            }
        bf16_t* orow = p.xb + (size_t)(m0 + qo + r) * D_MODEL + head * 64 + 4 * hh;
#pragma unroll
        for (int dt = 0; dt < 2; ++dt)
#pragma unroll
            for (int q4 = 0; q4 < 4; ++q4) {
                u32x2 v; v.x = pk_bf16(o[dt][4 * q4] * inv, o[dt][4 * q4 + 1] * inv); v.y = pk_bf16(o[dt][4 * q4 + 2] * inv, o[dt][4 * q4 + 3] * inv);
                *(u32x2*)(orow + dt * 32 + 8 * q4) = v;
            }
    }
    __syncthreads();
}

__device__ __forceinline__ void phase_dn_norm(const Params& p) {
    const int lane = threadIdx.x & 63, gw = blockIdx.x * (NTHREADS / 64) + (threadIdx.x >> 6), GW = gridDim.x * (NTHREADS / 64);
    const float2 g = *(const float2*)(p.dn_norm_g + lane * 2);
    for (int m = gw; m < M_TOK; m += GW) {
        float2 o[4]; unsigned z[4];
#pragma unroll
        for (int h = 0; h < 4; ++h) { const unsigned ow = *(const unsigned*)(p.odn_raw + (size_t)m * 512 + h * 128 + lane * 2); o[h] = make_float2(bflo(ow), bfhi(ow)); z[h] = *(const unsigned*)(p.proj_b + (size_t)m * NP_IN + P_Z + h * 128 + lane * 2); }
#pragma unroll
        for (int h = 0; h < 4; ++h) {
            const float ss = wave_sum(o[h].x * o[h].x + o[h].y * o[h].y);
            const float rr = rsqrtf(ss * (1.f / 128.f) + RMS_EPS);
            *(unsigned*)(p.xb + (size_t)m * D_MODEL + 512 + h * 128 + lane * 2) = pk_bf16(o[h].x * rr * g.x * silu_f(bflo(z[h])), o[h].y * rr * g.y * silu_f(bfhi(z[h])));
        }
    }
}

__device__ __forceinline__ void phase_ln1(const Params& p, bf16_t* x1b) {
    const int lane = threadIdx.x & 63, gw = blockIdx.x * (NTHREADS / 64) + (threadIdx.x >> 6), GW = gridDim.x * (NTHREADS / 64);
    float4 g[4], bb[4];
#pragma unroll
    for (int j = 0; j < 4; ++j) { g[j] = *(const float4*)(p.ln1_g + j * 256 + lane * 4); bb[j] = *(const float4*)(p.ln1_b + j * 256 + lane * 4); }
    for (int m0 = gw * 4; m0 < M_TOK; m0 += GW * 4) {
        float4 v[4][4];
#pragma unroll
        for (int rr = 0; rr < 4; ++rr)
#pragma unroll
            for (int j = 0; j < 4; ++j) v[rr][j] = *(const float4*)(p.out + (size_t)(m0 + rr) * D_MODEL + j * 256 + lane * 4);
#pragma unroll
        for (int rr = 0; rr < 4; ++rr) {
            float s = 0.f;
#pragma unroll
            for (int j = 0; j < 4; ++j) s += (v[rr][j].x + v[rr][j].y) + (v[rr][j].z + v[rr][j].w);
            const float mean = wave_sum(s) * (1.f / D_MODEL); float q = 0.f;
#pragma unroll
            for (int j = 0; j < 4; ++j) { v[rr][j].x -= mean; v[rr][j].y -= mean; v[rr][j].z -= mean; v[rr][j].w -= mean; q += (v[rr][j].x * v[rr][j].x + v[rr][j].y * v[rr][j].y) + (v[rr][j].z * v[rr][j].z + v[rr][j].w * v[rr][j].w); }
            const float rstd = rsqrtf(wave_sum(q) * (1.f / D_MODEL) + LN_EPS);
            if (lane == 0) *(float2*)(p.ln1_stats + (size_t)(m0 + rr) * 2) = make_float2(mean, rstd);
#pragma unroll
            for (int j = 0; j < 4; ++j) {
                u32x2 ob; ob.x = pk_bf16(v[rr][j].x * rstd * g[j].x + bb[j].x, v[rr][j].y * rstd * g[j].y + bb[j].y); ob.y = pk_bf16(v[rr][j].z * rstd * g[j].z + bb[j].z, v[rr][j].w * rstd * g[j].w + bb[j].w);
                *(u32x2*)(x1b + (size_t)(m0 + rr) * D_MODEL + j * 256 + lane * 4) = ob;
            }
        }
    }
}

__device__ __forceinline__ void cas_d(float& a, float& b) { const float hi = fmaxf(a, b), lo = fminf(a, b); a = hi; b = lo; }
__device__ __forceinline__ void cas_a(float& a, float& b) { const float hi = fmaxf(a, b), lo = fminf(a, b); a = lo; b = hi; }
__device__ __forceinline__ void sort16_desc(f32x16& v) {
#pragma unroll
    for (int k = 2; k <= 16; k <<= 1)
#pragma unroll
        for (int j = k >> 1; j > 0; j >>= 1)
#pragma unroll
            for (int i = 0; i < 16; ++i) {
                const int l = i ^ j;
                if (l > i) { float a = v[i], b = v[l]; if ((i & k) == 0) cas_d(a, b); else cas_a(a, b); v[i] = a; v[l] = b; }
            }
}
__device__ __forceinline__ void bmerge16_desc(f32x16& v) {
#pragma unroll
    for (int j = 8; j > 0; j >>= 1)
#pragma unroll
        for (int i = 0; i < 16; ++i) { const int l = i ^ j; if (l > i) { float a = v[i], b = v[l]; cas_d(a, b); v[i] = a; v[l] = b; } }
}
__device__ __forceinline__ f32x16 merge_top16(const f32x16& a, const f32x16& b) {
    f32x16 c;
#pragma unroll
    for (int i = 0; i < 16; ++i) c[i] = fmaxf(a[i], b[15 - i]);
    bmerge16_desc(c);
    return c;
}
__device__ __forceinline__ void pcas_d(float& va, int& ia, float& vb, int& ib) {
    const bool sw = vb > va; const float tv = sw ? vb : va; const int ti = sw ? ib : ia;
    vb = sw ? va : vb; ib = sw ? ia : ib; va = tv; ia = ti;
}
__device__ __forceinline__ void psort16_desc(float (&v)[16], int (&id)[16]) {
#pragma unroll
    for (int k = 2; k <= 16; k <<= 1)
#pragma unroll
        for (int j = k >> 1; j > 0; j >>= 1)
#pragma unroll
            for (int i = 0; i < 16; ++i) {
                const int l = i ^ j;
                if (l > i) { if ((i & k) == 0) pcas_d(v[i], id[i], v[l], id[l]); else pcas_d(v[l], id[l], v[i], id[i]); }
            }
}
__device__ __forceinline__ void pmerge_top16(float (&a)[16], int (&ia)[16], const float (&b)[16], const int (&ib)[16]) {
#pragma unroll
    for (int i = 0; i < 16; ++i) { const bool sw = b[15 - i] > a[i]; a[i] = sw ? b[15 - i] : a[i]; ia[i] = sw ? ib[15 - i] : ia[i]; }
#pragma unroll
    for (int j = 8; j > 0; j >>= 1)
#pragma unroll
        for (int i = 0; i < 16; ++i) { const int l = i ^ j; if (l > i) pcas_d(a[i], ia[i], a[l], ia[l]); }
}
__device__ __forceinline__ void phase_route(const Params& p, const bf16_t* qb) {
    constexpr int CI[50] = {0,0,0,0,0,0,0,0,0,0,0,0,0,0,0,0,1,1,1,1,1,1,1,1,2,2,2,2,2,3,3,3,3,4,4,4,5,5,6,6,7,7,8,9,10,11,12,13,14,15};
    constexpr int CJ[50] = {0,1,2,3,4,5,6,7,8,9,10,11,12,13,14,15,0,1,2,3,4,5,6,7,0,1,2,3,4,0,1,2,3,0,1,2,0,1,0,1,0,1,0,0,0,0,0,0,0,0};
    const int lane0 = threadIdx.x & 63, gw = blockIdx.x * (NTHREADS / 64) + (threadIdx.x >> 6), GW = gridDim.x * (NTHREADS / 64);
    for (int task = gw; task < (M_TOK / 32) * 8; task += GW) {
        int lane = lane0; asm volatile("" : "+v"(lane));
        const int r = lane & 31, hh = lane >> 5;
        const int h = task & 7, tok0 = (task >> 3) * 32;
        f32x16 top[2];
#pragma unroll
        for (int pp = 0; pp < 2; ++pp) {
            const bf16_t* qrow = qb + (size_t)(tok0 + r) * 2048 + h * 256 + pp * 128 + 8 * hh;
            bf16x8 qf[8];
#pragma unroll
            for (int ks = 0; ks < 8; ++ks) qf[ks] = *(const bf16x8*)(qrow + 16 * ks);
            f32x16 sc[4];
#pragma unroll
            for (int kt = 0; kt < 4; ++kt) {
                const bf16_t* af = p.sk_frag + ((size_t)(((h * 2 + pp) * 4 + kt) * 8) * 64 + lane) * 8;
                bf16x8 a[8];
#pragma unroll
                for (int ks = 0; ks < 8; ++ks) a[ks] = *(const bf16x8*)(af + (size_t)ks * 512);
#pragma unroll
                for (int e = 0; e < 16; ++e) sc[kt][e] = 0.f;
#pragma unroll
                for (int ks = 0; ks < 8; ++ks) sc[kt] = __builtin_amdgcn_mfma_f32_32x32x16_bf16(a[ks], qf[ks], sc[kt], 0, 0, 0);
            }
#pragma unroll
            for (int kt = 0; kt < 4; ++kt) {
#pragma unroll
                for (int e = 0; e < 16; ++e) {
                    const unsigned key = (unsigned)(32 * kt + (e & 3) + 8 * (e >> 2)) + 4u * (unsigned)hh;
                    sc[kt][e] = __uint_as_float((__float_as_uint(sc[kt][e]) & 0xffffff80u) | key);
                }
                sort16_desc(sc[kt]);
            }
            f32x16 m = merge_top16(merge_top16(sc[0], sc[1]), merge_top16(sc[2], sc[3]));
            f32x16 oth;
#pragma unroll
            for (int i = 0; i < 16; ++i) oth[i] = __shfl_xor(m[i], 32);
            top[pp] = merge_top16(m, oth);
        }
        int ia[16], ib[16];
#pragma unroll
        for (int i = 0; i < 16; ++i) { ia[i] = (int)(__float_as_uint(top[0][i]) & 127u); ib[i] = (int)(__float_as_uint(top[1][i]) & 127u); }
        float cv0[16], cv1[16]; int cd0[16], cd1[16];
#pragma unroll
        for (int c = 0; c < 32; ++c) {
            float v = -INFINITY; int id = 0;
            if (c < 25) {
                const float v0 = top[0][CI[2 * c]] + top[1][CJ[2 * c]], v1 = top[0][CI[2 * c + 1]] + top[1][CJ[2 * c + 1]];
                const int d0 = (ia[CI[2 * c]] << 7) | ib[CJ[2 * c]], d1 = (ia[CI[2 * c + 1]] << 7) | ib[CJ[2 * c + 1]];
                v = hh ? v1 : v0; id = hh ? d1 : d0;
            }
            if (c < 16) { cv0[c] = v; cd0[c] = id; } else { cv1[c - 16] = v; cd1[c - 16] = id; }
        }
        psort16_desc(cv0, cd0); psort16_desc(cv1, cd1);
        pmerge_top16(cv0, cd0, cv1, cd1);
        float ov[16]; int od[16];
#pragma unroll
        for (int i = 0; i < 16; ++i) { ov[i] = __shfl_xor(cv0[i], 32); od[i] = __shfl_xor(cd0[i], 32); }
        pmerge_top16(cv0, cd0, ov, od);
        float ex[16], den = 0.f;
#pragma unroll
        for (int i = 0; i < 16; ++i) { ex[i] = __expf(cv0[i] - cv0[0]); den += ex[i]; }
        const float inv = 1.f / den;
        if (hh == 0) {
            int* idp = p.ids + (size_t)(tok0 + r) * 128 + h * 16; float* gp = p.gates + (size_t)(tok0 + r) * 128 + h * 16;
#pragma unroll
            for (int q = 0; q < 4; ++q) {
                *(int4*)(idp + 4 * q) = make_int4(cd0[4 * q], cd0[4 * q + 1], cd0[4 * q + 2], cd0[4 * q + 3]);
                *(float4*)(gp + 4 * q) = make_float4(ex[4 * q] * inv, ex[4 * q + 1] * inv, ex[4 * q + 2] * inv, ex[4 * q + 3] * inv);
            }
        }
    }
}


typedef float f32x2 __attribute__((ext_vector_type(2)));
__device__ __forceinline__ void phase_tables8(const Params& p, int first_block) {
    const int lane = threadIdx.x & 63, gw = (blockIdx.x - first_block) * (NTHREADS / 64) + (threadIdx.x >> 6), GW = (gridDim.x - first_block) * (NTHREADS / 64);
    for (int row0 = gw * 4; row0 < 2 * 16384; row0 += GW * 4) {
        float v[4][16];
#pragma unroll
        for (int rr = 0; rr < 4; ++rr) {
            const int row = row0 + rr, table = row >> 14, e = row & 16383;
            const float* src = (table ? p.peer_v : p.peer_u) + (size_t)e * 1024 + lane * 16;
#pragma unroll
            for (int q = 0; q < 4; ++q) { const float4 a = *(const float4*)(src + 4 * q); v[rr][4 * q] = a.x; v[rr][4 * q + 1] = a.y; v[rr][4 * q + 2] = a.z; v[rr][4 * q + 3] = a.w; }
        }
#pragma unroll
        for (int rr = 0; rr < 4; ++rr) {
            const int row = row0 + rr, table = row >> 14, e = row & 16383;
            float am = 0.f;
#pragma unroll
            for (int c = 0; c < 16; ++c) am = fmaxf(am, fabsf(v[rr][c]));
            am = wave_max(am);
            float sc = am > 0.f ? exp2f(floorf(log2f(448.f / am))) : 1.f;
            if (am * sc > 448.f) sc *= 0.5f;
            u32x4 o; int w;
            w = 0; w = __builtin_amdgcn_cvt_pk_fp8_f32(v[rr][0] * sc, v[rr][1] * sc, w, false); w = __builtin_amdgcn_cvt_pk_fp8_f32(v[rr][2] * sc, v[rr][3] * sc, w, true); o.x = (unsigned)w;
            w = 0; w = __builtin_amdgcn_cvt_pk_fp8_f32(v[rr][4] * sc, v[rr][5] * sc, w, false); w = __builtin_amdgcn_cvt_pk_fp8_f32(v[rr][6] * sc, v[rr][7] * sc, w, true); o.y = (unsigned)w;
            w = 0; w = __builtin_amdgcn_cvt_pk_fp8_f32(v[rr][8] * sc, v[rr][9] * sc, w, false); w = __builtin_amdgcn_cvt_pk_fp8_f32(v[rr][10] * sc, v[rr][11] * sc, w, true); o.z = (unsigned)w;
            w = 0; w = __builtin_amdgcn_cvt_pk_fp8_f32(v[rr][12] * sc, v[rr][13] * sc, w, false); w = __builtin_amdgcn_cvt_pk_fp8_f32(v[rr][14] * sc, v[rr][15] * sc, w, true); o.w = (unsigned)w;
            *(u32x4*)(p.tab8 + ((size_t)((table * 8 + (lane >> 3)) * 16384 + e)) * 128 + (lane & 7) * 16) = o;
            if (lane == 0) p.isc[row] = 1.f / sc;
        }
    }
}
typedef int i32x16 __attribute__((ext_vector_type(16)));
struct PeerBuf { u32x4 rows[16]; u32x4 xa, xb; f32x16 w; };
__device__ __forceinline__ float dpp_xor1(float v) { return __uint_as_float(__builtin_amdgcn_update_dpp(0u, __float_as_uint(v), 0xB1, 0xF, 0xF, true)); }
__device__ __forceinline__ float dpp_xor2(float v) { return __uint_as_float(__builtin_amdgcn_update_dpp(0u, __float_as_uint(v), 0x4E, 0xF, 0xF, true)); }
__device__ __forceinline__ float dpp_xor8(float v) { return __uint_as_float(__builtin_amdgcn_update_dpp(0u, __float_as_uint(v), 0x128, 0xF, 0xF, true)); }
__device__ __forceinline__ float swz_xor4(float v) { return __uint_as_float(__builtin_amdgcn_ds_swizzle(__float_as_uint(v), 0x101F)); }
__device__ __forceinline__ float swz_xor16(float v) { return __uint_as_float(__builtin_amdgcn_ds_swizzle(__float_as_uint(v), 0x401F)); }
__device__ __forceinline__ void peer_gather(PeerBuf& B, const unsigned char* tab, const i32x16& id, int j) {
#pragma unroll
    for (int i = 0; i < 16; ++i) B.rows[i] = *(const u32x4*)(tab + (size_t)id[i] * 128 + j * 16);
}
__device__ __forceinline__ void phase_peer_u(const Params& p, const bf16_t* x1b, float* ph) {
    const int lane0 = threadIdx.x & 63, wave = threadIdx.x >> 6;
    const int x = blockIdx.x & 7, nloc = (gridDim.x - x + 7) >> 3, wl = (blockIdx.x >> 3) * (NTHREADS / 64) + wave, NW = nloc * (NTHREADS / 64);
    const unsigned char* tab = p.tab8 + (size_t)x * 16384 * 128;
    int lane = lane0; asm volatile("" : "+v"(lane));
    const int j = lane & 7, g = lane >> 3;
    const bool b0 = j & 1, b1 = j & 2, b2 = j & 4;
    auto tok = [&](int t) { return t < M_TOK ? t : M_TOK - 1; };
    auto load_ids = [&](i32x16& id, int t) {
#pragma unroll
        for (int q = 0; q < 4; ++q) { const int4 v = *(const int4*)(p.ids + (size_t)t * 128 + 16 * g + 4 * q); id[4 * q] = v.x; id[4 * q + 1] = v.y; id[4 * q + 2] = v.z; id[4 * q + 3] = v.w; }
    };
    auto issue = [&](PeerBuf& B, int t, const i32x16& id) {
        const bf16_t* xs = x1b + (size_t)t * 1024 + 128 * x + 16 * j;
        B.xa = *(const u32x4*)xs; B.xb = *(const u32x4*)(xs + 8);
        peer_gather(B, tab, id, j);
    };
    auto compute = [&](const PeerBuf& B, int t) {
        const f32x2 xf[8] = {{bflo(B.xa.x), bfhi(B.xa.x)}, {bflo(B.xa.y), bfhi(B.xa.y)}, {bflo(B.xa.z), bfhi(B.xa.z)}, {bflo(B.xa.w), bfhi(B.xa.w)},
                             {bflo(B.xb.x), bfhi(B.xb.x)}, {bflo(B.xb.y), bfhi(B.xb.y)}, {bflo(B.xb.z), bfhi(B.xb.z)}, {bflo(B.xb.w), bfhi(B.xb.w)}};
        float res[16];
#pragma unroll
        for (int i = 0; i < 16; ++i) {
            const unsigned dw[4] = {B.rows[i].x, B.rows[i].y, B.rows[i].z, B.rows[i].w};
            f32x2 d2 = {0.f, 0.f};
#pragma unroll
            for (int q = 0; q < 4; ++q) {
                const f32x2 lo = __builtin_amdgcn_cvt_pk_f32_fp8((int)dw[q], false), hi = __builtin_amdgcn_cvt_pk_f32_fp8((int)dw[q], true);
                d2 = lo * xf[2 * q] + d2; d2 = hi * xf[2 * q + 1] + d2;
            }
            res[i] = d2.x + d2.y;
        }
        float r8[8], r4[4], r2[2];
#pragma unroll
        for (int m = 0; m < 8; ++m) { const float keep = b0 ? res[8 + m] : res[m], send = b0 ? res[m] : res[8 + m]; r8[m] = keep + dpp_xor1(send); }
#pragma unroll
        for (int m = 0; m < 4; ++m) { const float keep = b1 ? r8[4 + m] : r8[m], send = b1 ? r8[m] : r8[4 + m]; r4[m] = keep + dpp_xor2(send); }
#pragma unroll
        for (int m = 0; m < 2; ++m) { const float keep = b2 ? r4[2 + m] : r4[m], send = b2 ? r4[m] : r4[2 + m]; r2[m] = keep + swz_xor4(send); }
        const int i0 = 8 * (int)b0 + 4 * (int)b1 + 2 * (int)b2;
        *(float2*)(ph + ((size_t)x * M_TOK + t) * 128 + 16 * g + i0) = make_float2(r2[0], r2[1]);
    };
    PeerBuf A, Bb;
    int t = wl;
    if (t >= M_TOK) return;
    i32x16 idn;
    load_ids(idn, t);
    issue(A, t, idn);
    load_ids(idn, tok(t + NW));
    for (; t < M_TOK; t += 2 * NW) {
        issue(Bb, tok(t + NW), idn);
        load_ids(idn, tok(t + 2 * NW));
        compute(A, t);
        issue(A, tok(t + 2 * NW), idn);
        load_ids(idn, tok(t + 3 * NW));
        if (t + NW < M_TOK) compute(Bb, t + NW);
    }
}
__device__ __forceinline__ void phase_peer_w(const Params& p, const float* ph, float* wbuf) {
    const size_t gt = (size_t)blockIdx.x * NTHREADS + threadIdx.x, GT = (size_t)gridDim.x * NTHREADS;
    for (size_t i0 = gt; i0 < (size_t)M_TOK * 128; i0 += GT * 4) {
        int e[4]; float h[4], gg[4];
#pragma unroll
        for (int u = 0; u < 4; ++u) {
            const size_t idx = i0 + u * GT;
            e[u] = p.ids[idx]; gg[u] = p.gates[idx]; h[u] = 0.f;
#pragma unroll
            for (int x = 0; x < 8; ++x) h[u] += ph[(size_t)x * M_TOK * 128 + idx];
        }
#pragma unroll
        for (int u = 0; u < 4; ++u) {
            const float hv = h[u] * p.isc[e[u]];
            wbuf[i0 + u * GT] = 0.5f * hv * (1.f + erff(hv * 0.7071067811865476f)) * gg[u] * p.isc[16384 + e[u]];
        }
    }
}
__device__ __forceinline__ void phase_peer_v(const Params& p, const float* wbuf, bf16_t* ffn) {
    const int lane0 = threadIdx.x & 63, wave = threadIdx.x >> 6;
    const int x = blockIdx.x & 7, nloc = (gridDim.x - x + 7) >> 3, wl = (blockIdx.x >> 3) * (NTHREADS / 64) + wave, NW = nloc * (NTHREADS / 64);
    const unsigned char* tab = p.tab8 + (size_t)(8 + x) * 16384 * 128;
    int lane = lane0; asm volatile("" : "+v"(lane));
    const int j = lane & 7, g = lane >> 3;
    const bool b3 = g & 1, b4 = g & 2, b5 = g & 4;
    auto tok = [&](int t) { return t < M_TOK ? t : M_TOK - 1; };
    auto load_ids = [&](i32x16& id, int t) {
#pragma unroll
        for (int q = 0; q < 4; ++q) { const int4 v = *(const int4*)(p.ids + (size_t)t * 128 + 16 * g + 4 * q); id[4 * q] = v.x; id[4 * q + 1] = v.y; id[4 * q + 2] = v.z; id[4 * q + 3] = v.w; }
    };
    auto issue = [&](PeerBuf& B, int t, const i32x16& id) {
#pragma unroll
        for (int q = 0; q < 4; ++q) { const float4 v = *(const float4*)(wbuf + (size_t)t * 128 + 16 * g + 4 * q); B.w[4 * q] = v.x; B.w[4 * q + 1] = v.y; B.w[4 * q + 2] = v.z; B.w[4 * q + 3] = v.w; }
        peer_gather(B, tab, id, j);
    };
    auto compute = [&](const PeerBuf& B, int t) {
        f32x2 acc[8];
#pragma unroll
        for (int c = 0; c < 8; ++c) acc[c] = (f32x2){0.f, 0.f};
#pragma unroll
        for (int i = 0; i < 16; ++i) {
            const f32x2 w2 = {B.w[i], B.w[i]};
            const unsigned dw[4] = {B.rows[i].x, B.rows[i].y, B.rows[i].z, B.rows[i].w};
#pragma unroll
            for (int q = 0; q < 4; ++q) {
                const f32x2 lo = __builtin_amdgcn_cvt_pk_f32_fp8((int)dw[q], false), hi = __builtin_amdgcn_cvt_pk_f32_fp8((int)dw[q], true);
                acc[2 * q] = lo * w2 + acc[2 * q]; acc[2 * q + 1] = hi * w2 + acc[2 * q + 1];
            }
        }
        f32x2 a4[4], a2[2], a1;
#pragma unroll
        for (int m = 0; m < 4; ++m) { const f32x2 keep = b3 ? acc[4 + m] : acc[m], send = b3 ? acc[m] : acc[4 + m]; a4[m] = (f32x2){keep.x + dpp_xor8(send.x), keep.y + dpp_xor8(send.y)}; }
#pragma unroll
        for (int m = 0; m < 2; ++m) { const f32x2 keep = b4 ? a4[2 + m] : a4[m], send = b4 ? a4[m] : a4[2 + m]; a2[m] = (f32x2){keep.x + swz_xor16(send.x), keep.y + swz_xor16(send.y)}; }
        { const f32x2 keep = b5 ? a2[1] : a2[0], send = b5 ? a2[0] : a2[1]; a1 = (f32x2){keep.x + __shfl_xor(send.x, 32), keep.y + __shfl_xor(send.y, 32)}; }
        const int c0 = 8 * (int)b3 + 4 * (int)b4 + 2 * (int)b5;
        *(unsigned*)(ffn + (size_t)t * 1024 + 128 * x + 16 * j + c0) = pk_bf16(a1.x, a1.y);
    };
    PeerBuf A, Bb;
    int t = wl;
    if (t >= M_TOK) return;
    i32x16 idn;
    load_ids(idn, t);
    issue(A, t, idn);
    load_ids(idn, tok(t + NW));
    for (; t < M_TOK; t += 2 * NW) {
        issue(Bb, tok(t + NW), idn);
        load_ids(idn, tok(t + 2 * NW));
        compute(A, t);
        issue(A, tok(t + 2 * NW), idn);
        load_ids(idn, tok(t + 3 * NW));
        if (t + NW < M_TOK) compute(Bb, t + NW);
    }
}
__device__ __forceinline__ void phase_ln2(const Params& p, const bf16_t* ffn) {
    const int lane = threadIdx.x & 63, gw = blockIdx.x * (NTHREADS / 64) + (threadIdx.x >> 6), GW = gridDim.x * (NTHREADS / 64);
    for (int m0 = gw * 2; m0 < M_TOK; m0 += GW * 2) {
        float4 a[2][4]; u32x2 f[2][4]; float2 st[2];
#pragma unroll
        for (int rr = 0; rr < 2; ++rr) {
            st[rr] = *(const float2*)(p.ln1_stats + (size_t)(m0 + rr) * 2);
#pragma unroll
            for (int j = 0; j < 4; ++j) { a[rr][j] = *(const float4*)(p.out + (size_t)(m0 + rr) * D_MODEL + j * 256 + lane * 4); f[rr][j] = *(const u32x2*)(ffn + (size_t)(m0 + rr) * D_MODEL + j * 256 + lane * 4); }
        }
#pragma unroll
        for (int rr = 0; rr < 2; ++rr) {
            float* row = p.out + (size_t)(m0 + rr) * D_MODEL;
            float4 v[4]; float s = 0.f;
#pragma unroll
            for (int j = 0; j < 4; ++j) {
                const float4 g1 = *(const float4*)(p.ln1_g + j * 256 + lane * 4), b1 = *(const float4*)(p.ln1_b + j * 256 + lane * 4);
                v[j] = make_float4(ALPHA * ((a[rr][j].x - st[rr].x) * st[rr].y * g1.x + b1.x) + bflo(f[rr][j].x), ALPHA * ((a[rr][j].y - st[rr].x) * st[rr].y * g1.y + b1.y) + bfhi(f[rr][j].x),
                                   ALPHA * ((a[rr][j].z - st[rr].x) * st[rr].y * g1.z + b1.z) + bflo(f[rr][j].y), ALPHA * ((a[rr][j].w - st[rr].x) * st[rr].y * g1.w + b1.w) + bfhi(f[rr][j].y));
                s += (v[j].x + v[j].y) + (v[j].z + v[j].w);
            }
            const float mean = wave_sum(s) * (1.f / D_MODEL); float q = 0.f;
#pragma unroll
            for (int j = 0; j < 4; ++j) { v[j].x -= mean; v[j].y -= mean; v[j].z -= mean; v[j].w -= mean; q += (v[j].x * v[j].x + v[j].y * v[j].y) + (v[j].z * v[j].z + v[j].w * v[j].w); }
            const float rstd = rsqrtf(wave_sum(q) * (1.f / D_MODEL) + LN_EPS);
#pragma unroll
            for (int j = 0; j < 4; ++j) {
                const float4 g = *(const float4*)(p.ln2_g + j * 256 + lane * 4), bb = *(const float4*)(p.ln2_b + j * 256 + lane * 4);
                *(float4*)(row + j * 256 + lane * 4) = make_float4(v[j].x * rstd * g.x + bb.x, v[j].y * rstd * g.y + bb.y, v[j].z * rstd * g.z + bb.z, v[j].w * rstd * g.w + bb.w);
            }
        }
    }
}

constexpr int N_PHASES = 14;

namespace pg8 {
#define PG8_LAS __attribute__((address_space(3)))
constexpr int BM = 256, BK = 64, HALF = 128, HTB = HALF * BK * 2  , STAGE_BYTES = 8 * HTB, NXCD = 8, WGM = 8;

__host__ __device__ __forceinline__ int lds_byte(int r, int c) { const int st = (r >> 4) * 2 + (c >> 5), rr = r & 15, cc = c & 31, ob = rr * 64 + cc * 2; return st * 1024 + (ob ^ (((ob >> 9) & 1) << 5)); }
__host__ __device__ __forceinline__ void stage_rc(int b, int& R, int& C) { const int st = b / 1024, sb = b % 1024, swz = sb ^ (((sb >> 9) & 1) << 5); R = (st >> 1) * 16 + swz / 64; C = (st & 1) * 32 + (swz % 64) / 2; }
__host__ __device__ __forceinline__ int perm32(int rho) { const int n = rho >> 4, i = rho & 15; return 8 * (i >> 2) + 4 * n + (i & 3); }
struct Unit { int pm, pn; };
struct Gemm { const bf16_t* A; const bf16_t* Bt; int M, N, K; };
struct StaticOrder {
    int nM, nN, nwg, G, c;
    __host__ __device__ void init(int M, int N, int G_, int c_) { nM = M / BM; nN = N / BM; nwg = nM * nN; G = G_; c = c_; }
    __host__ __device__ bool next(int i, Unit& u) const {
        const long L = (long)i * G + c; if (L >= nwg) return false;
        int wgid = (int)L; { const int q = nwg / NXCD, r = nwg % NXCD, xcd = wgid % NXCD, off = wgid / NXCD; wgid = (xcd < r ? xcd * (q + 1) : r * (q + 1) + (xcd - r) * q) + off; }
        const int nig = WGM * nN, gid = wgid / nig, fm = gid * WGM, gsz = (nM - fm) < WGM ? (nM - fm) : WGM;
        u.pm = fm + ((wgid % nig) % gsz); u.pn = (wgid % nig) / gsz; return true;
    }
    __device__ __forceinline__ void a_ready(const Unit&) const {}
    __device__ __forceinline__ void done(const Unit&) const {}
};
struct EpiRope {
    static constexpr bool PERM = true, AFTER_DRAIN = false;
    bf16_t* O; const float* cs;
    __device__ __forceinline__ void operator()(const f32x4 (&acc)[2][2][4][2], const Unit& u, int wr, int wc, int fr, int fq) const {
        const int row0 = u.pm * BM + wr * 64 + fr, colb = u.pn * BM + wc * 32 + 8 * fq;
#pragma unroll
        for (int ai = 0; ai < 2; ++ai)
#pragma unroll
            for (int m = 0; m < 4; ++m) {
                const int row = row0 + ai * HALF + m * 16;
#pragma unroll
                for (int bj = 0; bj < 2; ++bj) {
                    const int col0 = colb + bj * HALF;
                    f32x4 v0 = acc[ai][bj][m][0], v1 = acc[ai][bj][m][1];
                    if (col0 < P_AV) {
                        const int i0 = (col0 & 63) >> 1;
                        const float4 c = *(const float4*)(cs + (size_t)row * 32 + i0), s = *(const float4*)(cs + (size_t)M_TOK * 32 + (size_t)row * 32 + i0);
                        const float sc = col0 < P_AK ? 0.125f : 1.f;
                        const f32x4 w0 = {(v0[0] * c.x - v0[1] * s.x) * sc, (v0[1] * c.x + v0[0] * s.x) * sc, (v0[2] * c.y - v0[3] * s.y) * sc, (v0[3] * c.y + v0[2] * s.y) * sc};
                        const f32x4 w1 = {(v1[0] * c.z - v1[1] * s.z) * sc, (v1[1] * c.z + v1[0] * s.z) * sc, (v1[2] * c.w - v1[3] * s.w) * sc, (v1[3] * c.w + v1[2] * s.w) * sc};
                        v0 = w0; v1 = w1;
                    }
                    u32x4 w; w.x = pk_bf16(v0[0], v0[1]); w.y = pk_bf16(v0[2], v0[3]); w.z = pk_bf16(v1[0], v1[1]); w.w = pk_bf16(v1[2], v1[3]);
                    *(u32x4*)(O + (size_t)row * NP_IN + col0) = w;
                }
            }
    }
};
struct EpiResid {
    static constexpr bool PERM = false, AFTER_DRAIN = false;
    float* Y; const float* X;
    __device__ __forceinline__ void operator()(const f32x4 (&acc)[2][2][4][2], const Unit& u, int wr, int wc, int fr, int fq) const {
        const int row0 = u.pm * BM + wr * 64 + fr, col0 = u.pn * BM + wc * 32 + 4 * fq;
#pragma unroll
        for (int ai = 0; ai < 2; ++ai)
#pragma unroll
            for (int m = 0; m < 4; ++m) {
                const size_t ro = (size_t)(row0 + ai * HALF + m * 16) * D_MODEL + col0;
#pragma unroll
                for (int bj = 0; bj < 2; ++bj)
#pragma unroll
                    for (int n = 0; n < 2; ++n) { const f32x4 xv = *(const f32x4*)(X + ro + bj * HALF + n * 16); *(f32x4*)(Y + ro + bj * HALF + n * 16) = xv * ALPHA + acc[ai][bj][m][n]; }
            }
    }
};
struct EpiPlainBf16 {
    static constexpr bool PERM = true, AFTER_DRAIN = false;
    bf16_t* O; int ldc;
    __device__ __forceinline__ void operator()(const f32x4 (&acc)[2][2][4][2], const Unit& u, int wr, int wc, int fr, int fq) const {
        const int row0 = u.pm * BM + wr * 64 + fr, col0 = u.pn * BM + wc * 32 + 8 * fq;
#pragma unroll
        for (int ai = 0; ai < 2; ++ai)
#pragma unroll
            for (int m = 0; m < 4; ++m) { bf16_t* rowp = O + (size_t)(row0 + ai * HALF + m * 16) * ldc + col0;
#pragma unroll
                for (int bj = 0; bj < 2; ++bj) { const f32x4 v0 = acc[ai][bj][m][0], v1 = acc[ai][bj][m][1];
                    u32x4 w; w.x = pk_bf16(v0[0], v0[1]); w.y = pk_bf16(v0[2], v0[3]); w.z = pk_bf16(v1[0], v1[1]); w.w = pk_bf16(v1[2], v1[3]);
                    *(u32x4*)(rowp + bj * HALF) = w; } }
    }
};
template <class Epi, class Sched>
__device__ __forceinline__ void gemm_phase(PG8_LAS unsigned char* lds, const Gemm g, const Sched& S, const Epi& E) {
    const int tid = threadIdx.x, wid = __builtin_amdgcn_readfirstlane(tid >> 6), lane = tid & 63, wr = wid >> 2, wc = wid & 3, fr = lane & 15, fq = lane >> 4;
    const int K = g.K, nt = K / BK;
    unsigned voffA[2], voffB[2];
#pragma unroll
    for (int i = 0; i < 2; ++i) { int R, C; stage_rc(tid * 16 + i * 8192, R, C); const int Rb = Epi::PERM ? ((R & ~31) + perm32(R & 31)) : R;
        voffA[i] = (unsigned)(R * K + C) * 2u; voffB[i] = (unsigned)(Rb * K + C) * 2u; }
    const size_t kstep = (size_t)(BK * 2);
    const size_t hstep = (size_t)HALF * K * 2;
    const size_t tstep = 2 * hstep;
    const unsigned ldsw = (unsigned)wid * 1024u;
    const int aoff = lds_byte(wr * 64 + fr, fq * 8), boff = lds_byte(wc * 32 + fr, fq * 8);
#define PG8_SA(b, h) (((b) * 2 + (h)) * HTB)
#define PG8_SB(b, h) ((4 + (b) * 2 + (h)) * HTB)
#define PG8_STAGE(bufoff, gbase, voff) do { _Pragma("unroll") for (int _i = 0; _i < 2; ++_i) \
        __builtin_amdgcn_global_load_lds((const unsigned*)((const char*)(gbase) + (voff)[_i]), (PG8_LAS unsigned*)(lds + (bufoff) + ldsw + _i * 8192), 16, 0, 0); } while (0)
#define PG8_LDA(dst, b, h) do { _Pragma("unroll") for (int m = 0; m < 4; ++m) _Pragma("unroll") for (int k = 0; k < 2; ++k) dst[m][k] = *(const PG8_LAS bf16x8*)(lds + PG8_SA(b, h) + aoff + m * 2048 + k * 1024); } while (0)
#define PG8_LDB(dst, b, h) do { _Pragma("unroll") for (int n = 0; n < 2; ++n) _Pragma("unroll") for (int k = 0; k < 2; ++k) dst[n][k] = *(const PG8_LAS bf16x8*)(lds + PG8_SB(b, h) + boff + n * 2048 + k * 1024); } while (0)
#define PG8_MMA(ai, bj, At, Bt) do { __builtin_amdgcn_s_setprio(1); _Pragma("unroll") for (int m = 0; m < 4; ++m) _Pragma("unroll") for (int n = 0; n < 2; ++n) _Pragma("unroll") for (int k = 0; k < 2; ++k) \
        acc[ai][bj][m][n] = __builtin_amdgcn_mfma_f32_16x16x32_bf16(Bt[n][k], At[m][k], acc[ai][bj][m][n], 0, 0, 0); __builtin_amdgcn_s_setprio(0); } while (0)
#define PG8_WAIT_V(n) asm volatile("s_waitcnt vmcnt(" #n ")" ::: "memory")
#define PG8_WAIT_L(n) asm volatile("s_waitcnt lgkmcnt(" #n ")" ::: "memory")
#define PG8_BAR __builtin_amdgcn_s_barrier()
#define PG8_SCHED __builtin_amdgcn_sched_barrier(0)
    Unit cur, nxt; int ui = 0;
    if (!S.next(0, cur)) return;
    f32x4 acc[2][2][4][2];
#pragma unroll
    for (int a = 0; a < 2; ++a)
#pragma unroll
        for (int b = 0; b < 2; ++b)
#pragma unroll
            for (int m = 0; m < 4; ++m)
#pragma unroll
                for (int n = 0; n < 2; ++n) acc[a][b][m][n] = (f32x4){0.f, 0.f, 0.f, 0.f};
    bf16x8 At[4][2], B0[2][2], B1[2][2];
    const char* cA = (const char*)g.A + (size_t)cur.pm * tstep; const char* cB = (const char*)g.Bt + (size_t)cur.pn * tstep;
    S.a_ready(cur);
    PG8_STAGE(PG8_SB(0, 0), cB, voffB); PG8_STAGE(PG8_SA(0, 0), cA, voffA); PG8_STAGE(PG8_SB(0, 1), cB + hstep, voffB); PG8_STAGE(PG8_SA(0, 1), cA + hstep, voffA);
    if (wr == 1) PG8_BAR;
    PG8_WAIT_V(4); PG8_BAR;
    PG8_STAGE(PG8_SB(1, 0), cB + kstep, voffB); PG8_STAGE(PG8_SA(1, 0), cA + kstep, voffA); PG8_STAGE(PG8_SB(1, 1), cB + hstep + kstep, voffB);
    PG8_WAIT_V(6); PG8_BAR;
    for (;;) {
        const bool has_next = S.next(ui + 1, nxt);
        const char* nA = has_next ? (const char*)g.A + (size_t)nxt.pm * tstep : cA; const char* nB = has_next ? (const char*)g.Bt + (size_t)nxt.pn * tstep : cB;
        for (int t = 0; t < nt; t += 2) {
            const bool last = (t == nt - 2);
            const char* a1 = cA + (size_t)(t + 1) * kstep;
            const char* a2 = last ? nA : cA + (size_t)(t + 2) * kstep; const char* b2 = last ? nB : cB + (size_t)(t + 2) * kstep;
            const char* a3 = a2 + kstep; const char* b3 = b2 + kstep;
            if (last && has_next) S.a_ready(nxt);
            PG8_LDB(B0, 0, 0); PG8_SCHED; PG8_LDA(At, 0, 0); PG8_STAGE(PG8_SA(1, 1), a1 + hstep, voffA);
            PG8_WAIT_L(8); PG8_BAR; PG8_WAIT_L(0); PG8_MMA(0, 0, At, B0); PG8_BAR; PG8_SCHED;
            PG8_LDB(B1, 0, 1); PG8_STAGE(PG8_SB(0, 0), b2, voffB);
            PG8_BAR; PG8_WAIT_L(0); PG8_MMA(0, 1, At, B1); PG8_BAR;
            PG8_LDA(At, 0, 1); PG8_STAGE(PG8_SA(0, 0), a2, voffA);
            PG8_BAR; PG8_WAIT_L(0); PG8_MMA(1, 0, At, B0); PG8_BAR; PG8_SCHED;
            PG8_STAGE(PG8_SB(0, 1), b2 + hstep, voffB);
            PG8_WAIT_V(6); PG8_BAR; PG8_MMA(1, 1, At, B1); PG8_BAR;
            PG8_LDB(B0, 1, 0); PG8_SCHED; PG8_LDA(At, 1, 0); PG8_STAGE(PG8_SA(0, 1), a2 + hstep, voffA);
            PG8_WAIT_L(8); PG8_BAR; PG8_WAIT_L(0); PG8_MMA(0, 0, At, B0); PG8_BAR; PG8_SCHED;
            PG8_LDB(B1, 1, 1); PG8_STAGE(PG8_SB(1, 0), b3, voffB);
            PG8_BAR; PG8_WAIT_L(0); PG8_MMA(0, 1, At, B1); PG8_BAR;
            PG8_LDA(At, 1, 1); PG8_STAGE(PG8_SA(1, 0), a3, voffA);
            PG8_BAR; PG8_WAIT_L(0); PG8_MMA(1, 0, At, B0); PG8_BAR; PG8_SCHED;
            PG8_STAGE(PG8_SB(1, 1), b3 + hstep, voffB);
            PG8_WAIT_V(6); PG8_BAR; PG8_MMA(1, 1, At, B1); PG8_BAR;
        }
        if constexpr (!Epi::AFTER_DRAIN) { E(acc, cur, wr, wc, fr, fq); S.done(cur); }
        if (!has_next) break;
#pragma unroll
        for (int a = 0; a < 2; ++a)
#pragma unroll
            for (int b = 0; b < 2; ++b)
#pragma unroll
                for (int m = 0; m < 4; ++m)
#pragma unroll
                    for (int n = 0; n < 2; ++n) acc[a][b][m][n] = (f32x4){0.f, 0.f, 0.f, 0.f};
        cur = nxt; cA = nA; cB = nB; ++ui;
    }
    PG8_WAIT_V(0);
    if (wr == 0) PG8_BAR;
    PG8_BAR;
    if constexpr (Epi::AFTER_DRAIN) { E.fused(acc, cur, wr, wc, fr, fq, lds, wid, lane); S.done(cur); }
#undef PG8_SA
#undef PG8_SB
#undef PG8_STAGE
#undef PG8_LDA
#undef PG8_LDB
#undef PG8_MMA
#undef PG8_WAIT_V
#undef PG8_WAIT_L
#undef PG8_BAR
#undef PG8_SCHED
}
}

__global__ void __launch_bounds__(NTHREADS) mega_fwd(Params p) {
    __shared__ __attribute__((aligned(1024))) unsigned char smem[SMEM_BYTES + 16];
    if (threadIdx.x == 0) *(uint4*)(smem + SMEM_BYTES) = make_uint4(0u, 0u, 0u, 0u);
    __syncthreads();
    XcdBarrier bar; bar.bar = p.bar; bar.x = 0; bar.st = (volatile LAS unsigned*)(smem + SMEM_BYTES);
    if (p.ph_hi - p.ph_lo > 1) bar = xcd_barrier_post(p.bar, (volatile LAS unsigned*)(smem + SMEM_BYTES));
    bf16_t* qb = p.proj_b;
    bf16_t* x1b = p.proj_b + (size_t)M_TOK * 2048;
#ifndef DUP_PHASE
#define DUP_PHASE -1
#endif
#define PH(k) (p.ph_lo <= (k) && (k) < p.ph_hi)
#define SYNC(k) do { if (PH(k) && PH((k) + 1)) xcd_barrier(bar); } while (0)
#define RUN(k, ...) do { if (PH(k)) { __VA_ARGS__; if (DUP_PHASE == (k)) { xcd_barrier(bar); __VA_ARGS__; } } SYNC(k); } while (0)
    float* ph = (float*)qb;
    RUN(0, phase_prep(p, smem));
    RUN(1, { pg8::StaticOrder S; S.init(M_TOK, NP_IN, gridDim.x, blockIdx.x); pg8::EpiRope e{p.proj_b, p.rope_cs}; pg8::gemm_phase((PG8_LAS unsigned char*)smem, pg8::Gemm{p.xb, p.wt_in, M_TOK, NP_IN, 1024}, S, e); });
    RUN(2, phase_dn_prep(p, smem));
    RUN(3, { if (blockIdx.x < 96) { const int j = blockIdx.x, y = j >> 3, cs = (y >> 1) * 8 + (j & 7);
                                    dn_scan_seg<1>(p, smem, cs / 3, cs % 3, y & 1); } else { phase_attn(p, smem, 96); } });
    RUN(4, { if (blockIdx.x < 64) dn_scan_seg<0>(p, smem, blockIdx.x >> 2, blockIdx.x & 3, 0); else if (blockIdx.x < 128) phase_scan_l2_helper(p); else phase_tables8(p, 128); });
    RUN(5, phase_dn_norm(p));
    RUN(6, { pg8::StaticOrder S; S.init(M_TOK, 1024, gridDim.x, blockIdx.x); pg8::EpiResid e{p.out, p.x}; pg8::gemm_phase((PG8_LAS unsigned char*)smem, pg8::Gemm{p.xb, p.wt_out, M_TOK, 1024, 1024}, S, e); });
    RUN(7, phase_ln1(p, x1b));
    RUN(8, { pg8::StaticOrder S; S.init(M_TOK, 2048, gridDim.x, blockIdx.x); pg8::EpiPlainBf16 e{qb, 2048}; pg8::gemm_phase((PG8_LAS unsigned char*)smem, pg8::Gemm{x1b, p.wt_q, M_TOK, 2048, 1024}, S, e); });
    RUN(9, phase_route(p, qb));
    RUN(10, phase_peer_u(p, x1b, ph));
    RUN(11, phase_peer_w(p, ph, p.wbuf));
    RUN(12, phase_peer_v(p, p.wbuf, (bf16_t*)ph));
    RUN(13, phase_ln2(p, (const bf16_t*)ph));
#undef RUN
#undef SYNC
#undef PH
}
}

#ifndef MK_LAUNCHES
#define MK_LAUNCHES 1
#endif

extern "C" void kernel_launch(void* const* d_in, const int* in_sizes, int n_in, void* d_out, int out_size, void* d_ws, size_t ws_size, hipStream_t stream) {
    static int grid_blocks = 0;
    if (!grid_blocks) {
        int dev = 0, cus = 0, per_cu = 0;
        (void)hipGetDevice(&dev);
        (void)hipDeviceGetAttribute(&cus, hipDeviceAttributeMultiprocessorCount, dev);
        (void)hipOccupancyMaxActiveBlocksPerMultiprocessor(&per_cu, mega_fwd, NTHREADS, 0);
        if (per_cu < 1) { fprintf(stderr, "kernel_launch: occupancy query reports %d blocks per CU\n", per_cu); per_cu = 1; }
        grid_blocks = cus * 1;
        (void)hipGetLastError();
    }
    Params p{};
    p.x = (const float*)d_in[0]; p.positions = (const int*)d_in[1]; p.w_in = (const float*)d_in[2]; p.sinks = (const float*)d_in[3];
    p.conv_w = (const float*)d_in[4]; p.a_log = (const float*)d_in[5]; p.dt_bias = (const float*)d_in[6]; p.dn_norm_g = (const float*)d_in[7];
    p.w_out = (const float*)d_in[8]; p.ln1_g = (const float*)d_in[9]; p.ln1_b = (const float*)d_in[10]; p.w_query = (const float*)d_in[11];
    p.sub_keys = (const float*)d_in[12]; p.peer_u = (const float*)d_in[13]; p.peer_v = (const float*)d_in[14]; p.ln2_g = (const float*)d_in[15]; p.ln2_b = (const float*)d_in[16];
    p.out = (float*)d_out;
    char* ws = (char*)d_ws; size_t off = 0;
    auto take = [&](size_t bytes) { char* r = ws + off; off += (bytes + 255) & ~(size_t)255; return r; };
    p.xb = (bf16_t*)take((size_t)M_TOK * 1024 * 2);
    p.proj_b = (bf16_t*)take((size_t)M_TOK * NP_IN * 2);
    p.odn_raw = (bf16_t*)d_out;
    {
        char* dn = take((size_t)2048 * (16384 * 3 + 8192 + 32768) + 8192);
        p.ids = (int*)dn; p.gates = (float*)(dn + (size_t)M_TOK * 128 * 4);
        p.wbuf = (float*)(dn + (size_t)M_TOK * 128 * 8);
        p.dn_negw = (bf16_t*)dn; p.dn_qd = (bf16_t*)(dn + (size_t)2048 * 16384); p.dn_kdt = (bf16_t*)(dn + (size_t)2048 * 16384 * 2);
        p.dn_qk = (bf16_t*)(dn + (size_t)2048 * 16384 * 3); p.dn_u = (bf16_t*)(dn + (size_t)2048 * (16384 * 3 + 8192)); p.dn_gl = (float*)(dn + (size_t)2048 * (16384 * 3 + 8192 + 32768));
    }
    p.wt_in = (bf16_t*)take((size_t)NP_IN * 1024 * 2);
    p.wt_out = (bf16_t*)take((size_t)1024 * 1024 * 2);
    p.wt_q = (bf16_t*)take((size_t)2048 * 1024 * 2);
    p.rope_cs = (float*)take((size_t)M_TOK * 64 * 4);
    p.sk_frag = (bf16_t*)take((size_t)16 * 128 * 128 * 2);
    p.tab8 = (unsigned char*)take((size_t)2 * 16384 * 1024);
    p.isc = (float*)take((size_t)2 * 16384 * 4);
    p.ln1_stats = (float*)take((size_t)M_TOK * 2 * 4);
    p.dn_PB = (float*)take((size_t)48 * 128 * 256 * 4);
    p.dn_S0 = (float*)take((size_t)64 * 128 * 128 * 4);
    p.bar = (unsigned*)take((size_t)(XCD_BAR_WORDS + 64 * 64) * 4);
    if (off > ws_size) { fprintf(stderr, "kernel_launch: workspace too small (%zu < %zu)\n", ws_size, off); return; }
    if (hipMemsetAsync(p.bar, 0, (size_t)(XCD_BAR_WORDS + 64 * 64) * 4, stream) != hipSuccess) { fprintf(stderr, "kernel_launch: memset of barrier words failed\n"); return; }
#if MK_LAUNCHES == 1
    p.ph_lo = 0; p.ph_hi = N_PHASES;
    void* args[] = {&p};
    hipError_t e = hipLaunchCooperativeKernel((void*)mega_fwd, dim3(grid_blocks), dim3(NTHREADS), args, 0, stream);
    if (e != hipSuccess) fprintf(stderr, "cooperative launch failed: %s (grid %d)\n", hipGetErrorString(e), grid_blocks);
#else
    for (int k = 0; k < N_PHASES; ++k) { p.ph_lo = k; p.ph_hi = k + 1; hipLaunchKernelGGL(mega_fwd, dim3(grid_blocks), dim3(NTHREADS), 0, stream, p); }
#endif
}
```

```cpp
#include <hip/hip_runtime.h>
#include <cstdio>
#include <cstdint>
#include <math.h>

namespace {
constexpr int D_MODEL = 1024, BATCH = 4, SEQ = 8192, M_TOK = BATCH * SEQ;
constexpr int IN_WIDTH = 2824, NP_IN = 3072;
constexpr int P_AQ = 0, P_AK = 512, P_AV = 640, P_DQ = 768, P_DK = 1280, P_DV = 1792, P_Z = 2304, P_B = 2816, P_A = 2820;
constexpr float ALPHA = 1.189207115002721f;
constexpr float LN_EPS = 1e-5f, RMS_EPS = 1e-6f, L2_EPS = 1e-6f;
constexpr int NTHREADS = 512;

typedef unsigned short bf16_t;
typedef short bf16x8 __attribute__((ext_vector_type(8)));
typedef float f32x16 __attribute__((ext_vector_type(16)));
typedef float f32x4 __attribute__((ext_vector_type(4)));
typedef unsigned u32x4 __attribute__((ext_vector_type(4)));
typedef unsigned u32x2 __attribute__((ext_vector_type(2)));

struct Params {
    const float* x; const int* positions; const float* w_in; const float* sinks; const float* conv_w; const float* a_log; const float* dt_bias;
    const float* dn_norm_g; const float* w_out; const float* ln1_g; const float* ln1_b; const float* w_query; const float* sub_keys;
    const float* peer_u; const float* peer_v; const float* ln2_g; const float* ln2_b;
    float* out;
    bf16_t* xb;
    bf16_t* proj_b;
    bf16_t* odn_raw;
    int* ids; float* gates;
    bf16_t* wt_in; bf16_t* wt_out; bf16_t* wt_q;
    float* rope_cs;
    bf16_t* dn_negw; bf16_t* dn_qd; bf16_t* dn_kdt; bf16_t* dn_qk; bf16_t* dn_u; float* dn_gl; float* dn_PB; float* dn_S0;
    bf16_t* sk_frag;
    float* ln1_stats;
    unsigned char* tab8; float* isc; float* wbuf;
    unsigned* bar;
    int ph_lo, ph_hi;
};

__device__ __forceinline__ float wave_sum(float v) {
#pragma unroll
    for (int o = 1; o < 64; o <<= 1) v += __shfl_xor(v, o);
    return v;
}
__device__ __forceinline__ float wave_max(float v) {
#pragma unroll
    for (int o = 1; o < 64; o <<= 1) v = fmaxf(v, __shfl_xor(v, o));
    return v;
}
__device__ __forceinline__ float bf2f(bf16_t u) { return __uint_as_float((unsigned)u << 16); }
__device__ __forceinline__ float bflo(unsigned u) { return __uint_as_float(u << 16); }
__device__ __forceinline__ float bfhi(unsigned u) { return __uint_as_float(u & 0xffff0000u); }
typedef __bf16 bf16x2_n __attribute__((ext_vector_type(2)));
__device__ __forceinline__ unsigned pk_bf16(float lo, float hi) { bf16x2_n v; v.x = (__bf16)lo; v.y = (__bf16)hi; return __builtin_bit_cast(unsigned, v); }
__device__ __forceinline__ float silu_f(float y) { return y * __builtin_amdgcn_rcpf(1.f + __expf(-y)); }


#define XB_TMO      128
#define XB_XCNT(j)  (256  + 64 * (j))
#define XB_XSUB(j)  (1280 + 64 * (j))
#define XB_XGEN(j)  (2304 + 64 * (j))
#define XB_TOP      3328
#define XB_TOPGEN   3392
#define XCD_BAR_WORDS 3456
#define XB_SPIN_CAP (1u << 27)
#define LAS __attribute__((address_space(3)))
__device__ __forceinline__ unsigned xb_ld(unsigned* p)              { return __hip_atomic_load(p, __ATOMIC_RELAXED, __HIP_MEMORY_SCOPE_AGENT); }
__device__ __forceinline__ unsigned xb_add(unsigned* p, unsigned v) { return __hip_atomic_fetch_add(p, v, __ATOMIC_RELAXED, __HIP_MEMORY_SCOPE_AGENT); }
__device__ __forceinline__ unsigned xb_xcc_id() { return (unsigned)__builtin_amdgcn_s_getreg((3 << 11) | 20) & 0xFu; }
#define XB_SPIN(cond, bar) do { unsigned _sp = 0; while (cond) { __builtin_amdgcn_s_sleep(1); \
    if ((++_sp & 255u) == 0u) { if (xb_ld(&(bar)[XB_TMO])) break; if (_sp > XB_SPIN_CAP) { atomicAdd(&(bar)[XB_TMO], 1u); break; } } } } while (0)
struct XcdBarrier { unsigned* bar; unsigned x; volatile LAS unsigned* st; };
__device__ __forceinline__ XcdBarrier xcd_barrier_post(unsigned* bar, volatile LAS unsigned* st) {
    XcdBarrier b; b.bar = bar; b.x = xb_xcc_id(); b.st = st;
    if (threadIdx.x == 0) (void)xb_add(&bar[XB_XCNT(b.x)], 1u);
    return b;
}
__device__ __forceinline__ void xcd_barrier_complete(unsigned* bar, unsigned x, unsigned& nloc, unsigned& nx) {
    const unsigned G = gridDim.x * gridDim.y * gridDim.z;
    unsigned sum, cnt, mine, sp = 0u;
    for (;;) {
        sum = 0u; cnt = 0u; mine = 0u;
#pragma unroll
        for (unsigned j = 0; j < 16; ++j) { const unsigned c = xb_ld(&bar[XB_XCNT(j)]); sum += c; cnt += (c > 0u) ? 1u : 0u; mine = (j == x) ? c : mine; }
        if (sum == G) break;
        __builtin_amdgcn_s_sleep(1);
        if ((++sp & 255u) == 0u) { if (xb_ld(&bar[XB_TMO])) break; if (sp > XB_SPIN_CAP) { atomicAdd(&bar[XB_TMO], 1u); break; } }
    }
    nloc = mine > 0u ? mine : 1u; nx = cnt > 0u ? cnt : 1u;
}
__device__ __forceinline__ void xcd_barrier(const XcdBarrier& b) {
    asm volatile("s_waitcnt vmcnt(0)" ::: "memory");
    __syncthreads();
    if (threadIdx.x == 0) {
        unsigned* bar = b.bar;
        __builtin_amdgcn_s_waitcnt(0);
        unsigned nloc = b.st[0], nx = b.st[1];
        if (nloc == 0u) { xcd_barrier_complete(bar, b.x, nloc, nx); b.st[0] = nloc; b.st[1] = nx; }
        const unsigned old = xb_add(&bar[XB_XSUB(b.x)], 1u);
        const unsigned gen = old / nloc;
        if (old + 1u == (gen + 1u) * nloc) {
            __builtin_amdgcn_fence(__ATOMIC_RELEASE, "agent");
            asm volatile("s_waitcnt vmcnt(0)" ::: "memory");
            const unsigned og = xb_add(&bar[XB_TOP], 1u);
            const unsigned tg = og / nx;
            if (og + 1u == (tg + 1u) * nx) xb_add(&bar[XB_TOPGEN], 1u);
            else XB_SPIN(xb_ld(&bar[XB_TOPGEN]) == tg, bar);
            __builtin_amdgcn_fence(__ATOMIC_ACQUIRE, "agent");
            xb_add(&bar[XB_XGEN(b.x)], 1u);
            asm volatile("s_waitcnt vmcnt(0)" ::: "memory");
        } else {
            XB_SPIN(xb_ld(&bar[XB_XGEN(b.x)]) == gen, bar);
            __builtin_amdgcn_fence(__ATOMIC_ACQUIRE, "agent");
            asm volatile("s_waitcnt vmcnt(0)" ::: "memory");
        }
    }
    __syncthreads();
}

__device__ __forceinline__ int inproj_old_col(int n) {
    if (n < P_AV) { const int pos = n & 63; return (n & ~63) + ((pos & 1) ? (pos >> 1) + 32 : (pos >> 1)); }
    if (n < 2304) return n;
    if (n < 2816) return 2312 + (n - 2304);
    if (n < 2824) return 2304 + (n - 2816);
    return -1;
}
__device__ __forceinline__ void transpose_item(const float* __restrict__ W, int N_src, bf16_t* __restrict__ WT, int K, int kb, int nb, bool permute, float* scr) {
    const int tid = threadIdx.x;
    const int nn = tid & 63, k8 = tid >> 6;
    const int n = nb * 64 + nn;
    const int oc = permute ? inproj_old_col(n) : n;
#pragma unroll
    for (int i = 0; i < 8; ++i) { const int kk = k8 + 8 * i; scr[kk * 65 + nn] = (oc >= 0) ? W[(size_t)(kb * 64 + kk) * N_src + oc] : 0.f; }
    __syncthreads();
    const int n2 = tid >> 3, c = tid & 7;
    const float* s = scr + (c * 8) * 65 + n2;
    u32x4 o; o.x = pk_bf16(s[0], s[65]); o.y = pk_bf16(s[2 * 65], s[3 * 65]); o.z = pk_bf16(s[4 * 65], s[5 * 65]); o.w = pk_bf16(s[6 * 65], s[7 * 65]);
    *(u32x4*)(WT + (size_t)(nb * 64 + n2) * K + kb * 64 + c * 8) = o;
    __syncthreads();
}
__device__ __forceinline__ void phase_prep(const Params& p, unsigned char* smem) {
    const int tid = threadIdx.x, G = gridDim.x, bid = blockIdx.x;
    float* scr = (float*)smem;
    constexpr int I_IN = 16 * (NP_IN / 64), I_OUT = 16 * 16, I_Q = 16 * 32;
    for (int it = bid; it < I_IN + I_OUT + I_Q; it += G) {
        int r = it;
        if (r < I_IN) { transpose_item(p.w_in, IN_WIDTH, p.wt_in, 1024, r / (NP_IN / 64), r % (NP_IN / 64), true, scr); continue; } r -= I_IN;
        if (r < I_OUT) { transpose_item(p.w_out, 1024, p.wt_out, 1024, r / 16, r % 16, false, scr); continue; } r -= I_OUT;
        transpose_item(p.w_query, 2048, p.wt_q, 1024, r / 32, r % 32, false, scr);
    }
    const size_t gt = (size_t)bid * NTHREADS + tid, GT = (size_t)G * NTHREADS;
    for (size_t i0 = gt; i0 < (size_t)M_TOK * 1024 / 8; i0 += GT * 4) {
        float4 a[4], b[4];
#pragma unroll
        for (int u = 0; u < 4; ++u) { const size_t i = i0 + u * GT; if (i < (size_t)M_TOK * 1024 / 8) { a[u] = *(const float4*)(p.x + i * 8); b[u] = *(const float4*)(p.x + i * 8 + 4); } }
#pragma unroll
        for (int u = 0; u < 4; ++u) { const size_t i = i0 + u * GT; if (i < (size_t)M_TOK * 1024 / 8) {
            u32x4 o; o.x = pk_bf16(a[u].x, a[u].y); o.y = pk_bf16(a[u].z, a[u].w); o.z = pk_bf16(b[u].x, b[u].y); o.w = pk_bf16(b[u].z, b[u].w);
            *(u32x4*)(p.xb + i * 8) = o; } }
    }
    for (size_t i = gt; i < (size_t)16 * 4 * 8 * 64; i += GT) {
        const int ln = (int)(i & 63), ks = (int)((i >> 6) & 7), kt = (int)((i >> 9) & 3), hp = (int)(i >> 11);
        const float* src = p.sub_keys + ((size_t)(hp * 128 + 32 * kt + (ln & 31))) * 128 + 16 * ks + 8 * (ln >> 5);
        const float4 a = *(const float4*)src, b = *(const float4*)(src + 4);
        u32x4 o; o.x = pk_bf16(a.x, a.y); o.y = pk_bf16(a.z, a.w); o.z = pk_bf16(b.x, b.y); o.w = pk_bf16(b.z, b.w);
        *(u32x4*)(p.sk_frag + i * 8) = o;
    }
    for (size_t i = gt; i < (size_t)M_TOK * 32; i += GT) {
        const int m = (int)(i >> 5), j = (int)(i & 31);
        const float inv_freq = powf(10000.0f, -(float)j / 32.0f);
        const float ang = (float)p.positions[m] * inv_freq;
        p.rope_cs[i] = cosf(ang); p.rope_cs[(size_t)M_TOK * 32 + i] = sinf(ang);
    }
}

constexpr int GK = 1024, GBK = 64, G_TILE_BYTES = 256 * 128;
constexpr int STG_STRIDE = 260;
constexpr int SMEM_BYTES = 147456;

__device__ __forceinline__ int swz(int row, int chunk) { return row * 128 + ((chunk ^ ((row >> 1) & 7)) << 4); }

struct EpiInProj {
    bf16_t* out; const float* cs;
    __device__ __forceinline__ void operator()(int m, int pn, int c8, const unsigned char* stg_row) const {
        const int col = pn * 256 + c8 * 8;
        u32x2 a0 = *(const u32x2*)(stg_row + c8 * 16), a1 = *(const u32x2*)(stg_row + c8 * 16 + 8);
        u32x4 o; o.x = a0.x; o.y = a0.y; o.z = a1.x; o.w = a1.y;
        if (col < P_AV) {
            const int d0 = col & 63, i0 = d0 & 31; const bool second = d0 >= 32;
            const int pc8 = second ? c8 - 4 : c8 + 4;
            const u32x2 b0 = *(const u32x2*)(stg_row + pc8 * 16), b1 = *(const u32x2*)(stg_row + pc8 * 16 + 8);
            const unsigned mine[4] = {a0.x, a0.y, a1.x, a1.y}, oth[4] = {b0.x, b0.y, b1.x, b1.y};
            const float* cp = cs + (size_t)m * 32 + i0; const float* sp = cs + (size_t)M_TOK * 32 + (size_t)m * 32 + i0;
            const float4 c0 = *(const float4*)cp, c1 = *(const float4*)(cp + 4), s0 = *(const float4*)sp, s1 = *(const float4*)(sp + 4);
            const float cc[8] = {c0.x, c0.y, c0.z, c0.w, c1.x, c1.y, c1.z, c1.w}, ss[8] = {s0.x, s0.y, s0.z, s0.w, s1.x, s1.y, s1.z, s1.w};
            const float scale = col < P_AK ? 0.125f : 1.f;
            float r[8];
#pragma unroll
            for (int j = 0; j < 8; ++j) {
                const float me = (j & 1) ? bfhi(mine[j >> 1]) : bflo(mine[j >> 1]);
                const float ot = (j & 1) ? bfhi(oth[j >> 1]) : bflo(oth[j >> 1]);
                r[j] = (second ? (me * cc[j] + ot * ss[j]) : (me * cc[j] - ot * ss[j])) * scale;
            }
            o.x = pk_bf16(r[0], r[1]); o.y = pk_bf16(r[2], r[3]); o.z = pk_bf16(r[4], r[5]); o.w = pk_bf16(r[6], r[7]);
        }
        *(u32x4*)(out + (size_t)m * NP_IN + col) = o;
    }
};
struct EpiOutProj {
    float* y; const float* x;
    __device__ __forceinline__ void operator()(int m, int pn, int c8, const unsigned char* stg_row) const {
        const int col = pn * 256 + c8 * 8;
        const u32x2 a0 = *(const u32x2*)(stg_row + c8 * 16), a1 = *(const u32x2*)(stg_row + c8 * 16 + 8);
        const float4 x0 = *(const float4*)(x + (size_t)m * 1024 + col), x1 = *(const float4*)(x + (size_t)m * 1024 + col + 4);
        *(float4*)(y + (size_t)m * 1024 + col) = make_float4(ALPHA * x0.x + bflo(a0.x), ALPHA * x0.y + bfhi(a0.x), ALPHA * x0.z + bflo(a0.y), ALPHA * x0.w + bfhi(a0.y));
        *(float4*)(y + (size_t)m * 1024 + col + 4) = make_float4(ALPHA * x1.x + bflo(a1.x), ALPHA * x1.y + bfhi(a1.x), ALPHA * x1.z + bflo(a1.y), ALPHA * x1.w + bfhi(a1.y));
    }
};
struct EpiBf16 {
    bf16_t* out; int ldc;
    __device__ __forceinline__ void operator()(int m, int pn, int c8, const unsigned char* stg_row) const {
        const int col = pn * 256 + c8 * 8;
        const u32x2 a0 = *(const u32x2*)(stg_row + c8 * 16), a1 = *(const u32x2*)(stg_row + c8 * 16 + 8);
        u32x4 o; o.x = a0.x; o.y = a0.y; o.z = a1.x; o.w = a1.y;
        *(u32x4*)(out + (size_t)m * ldc + col) = o;
    }
};

template <class EPI>
__device__ __forceinline__ void gemm_phase(const bf16_t* __restrict__ A, const bf16_t* __restrict__ Bt, int M, int N, const EPI& epi, unsigned char* smem) {
    const int tid = threadIdx.x, lane = tid & 63, wave = tid >> 6, r = lane & 31, h = lane >> 5;
    const int wm = wave >> 2, wn = wave & 3;
    const int nM = M / 256, nN = N / 256, ntiles = nM * nN;
    const int gx = gridDim.x, nxg = (gx % 8 == 0 && ntiles % 8 == 0) ? 8 : 1, bpg = gx / nxg, tpg = ntiles / nxg;
    const int grp = blockIdx.x % nxg, bin = blockIdx.x / nxg;
    const int grow = 16 * wave + (lane >> 2), gch = (lane & 3) ^ ((grow >> 2) & 3);
    const unsigned goff = (unsigned)(grow * GK + gch * 8) * 2u;
    constexpr int NKT = GK / 32, STG = 32768;
#define G_DMA1(kt_, Ag_, Bg_, op_, i_) do { const unsigned char* sb_ = (const unsigned char*)((op_) ? (Bg_) : (Ag_)) + (kt_) * 64; \
            __builtin_amdgcn_global_load_lds((const unsigned*)(sb_ + (i_) * (128 * GK * 2) + goff), (unsigned*)(smem + ((kt_) & 3) * STG + wave * 1024 + (op_) * 16384 + (i_) * 8192), 16, 0, 0); } while (0)
#define G_STAGE(kt_, Ag_, Bg_) do { G_DMA1(kt_, Ag_, Bg_, 0, 0); G_DMA1(kt_, Ag_, Bg_, 1, 0); G_DMA1(kt_, Ag_, Bg_, 0, 1); G_DMA1(kt_, Ag_, Bg_, 1, 1); } while (0)
#define G_SWZ32(row_, c_) ((row_) * 64 + ((((c_) ^ ((row_) >> 2)) & 3) << 4))
#define G_COMPUTE(kt_, Ag_, Bg_, pf_) do { const unsigned char* la_ = smem + ((kt_) & 3) * STG; const unsigned char* lb_ = la_ + 16384; \
            bf16x8 af_[2][4], bf_[2][2]; \
            _Pragma("unroll") for (int ks_ = 0; ks_ < 2; ++ks_) { \
                _Pragma("unroll") for (int i_ = 0; i_ < 4; ++i_) af_[ks_][i_] = *(const bf16x8*)(la_ + G_SWZ32(wm * 128 + i_ * 32 + r, ks_ * 2 + h)); \
                _Pragma("unroll") for (int j_ = 0; j_ < 2; ++j_) bf_[ks_][j_] = *(const bf16x8*)(lb_ + G_SWZ32(wn * 64 + j_ * 32 + r, ks_ * 2 + h)); } \
            __builtin_amdgcn_sched_barrier(0); \
            _Pragma("unroll") for (int g_ = 0; g_ < 4; ++g_) { const int ks_ = g_ >> 1, j_ = g_ & 1; \
                _Pragma("unroll") for (int i_ = 0; i_ < 4; ++i_) acc[j_][i_] = __builtin_amdgcn_mfma_f32_32x32x16_bf16(bf_[ks_][j_], af_[ks_][i_], acc[j_][i_], 0, 0, 0); \
                __builtin_amdgcn_sched_barrier(0); \
                if (pf_) G_DMA1((kt_) + 3, Ag_, Bg_, g_ & 1, g_ >> 1); \
                __builtin_amdgcn_sched_barrier(0); } } while (0)
#define G_RAWBAR() do { asm volatile("s_waitcnt lgkmcnt(0)" ::: "memory"); __builtin_amdgcn_s_barrier(); asm volatile("" ::: "memory"); } while (0)
    for (int tt = bin; tt < tpg; tt += bpg) {
        const int t = grp * tpg + tt;
        const int pm = t / nN, pn = t % nN;
        const bf16_t* Ag = A + (size_t)pm * 256 * GK; const bf16_t* Bg = Bt + (size_t)pn * 256 * GK;
        f32x16 acc[2][4];
#pragma unroll
        for (int j = 0; j < 2; ++j)
#pragma unroll
            for (int i = 0; i < 4; ++i)
#pragma unroll
                for (int e = 0; e < 16; ++e) acc[j][i][e] = 0.f;
        G_RAWBAR();
        G_STAGE(0, Ag, Bg); G_STAGE(1, Ag, Bg); G_STAGE(2, Ag, Bg);
        for (int kt = 0; kt < NKT; ++kt) {
            if (kt + 2 < NKT) asm volatile("s_waitcnt vmcnt(8)" ::: "memory");
            else if (kt + 1 < NKT) asm volatile("s_waitcnt vmcnt(4)" ::: "memory");
            else asm volatile("s_waitcnt vmcnt(0)" ::: "memory");
            G_RAWBAR();
            G_COMPUTE(kt, Ag, Bg, kt + 3 < NKT);
        }
        G_RAWBAR();
#pragma unroll
        for (int j = 0; j < 2; ++j)
#pragma unroll
            for (int i = 0; i < 4; ++i)
#pragma unroll
                for (int g = 0; g < 4; ++g) {
                    u32x2 v; v.x = pk_bf16(acc[j][i][4 * g], acc[j][i][4 * g + 1]); v.y = pk_bf16(acc[j][i][4 * g + 2], acc[j][i][4 * g + 3]);
                    *(u32x2*)(smem + (size_t)(wm * 128 + i * 32 + r) * (STG_STRIDE * 2) + (wn * 64 + j * 32 + 8 * g + 4 * h) * 2) = v;
                }
        __syncthreads();
        const int erow = tid >> 5, ec8 = tid & 31;
#pragma unroll 4
        for (int ps = 0; ps < 16; ++ps) { const int row = ps * 16 + erow; epi(pm * 256 + row, pn, ec8, smem + (size_t)row * (STG_STRIDE * 2)); }
    }
#undef G_DMA1
#undef G_STAGE
#undef G_COMPUTE
#undef G_SWZ32
#undef G_RAWBAR
    __syncthreads();
}


constexpr int DN_CH_BYTES = 73728;

constexpr int DP_QS = 0, DP_KS = 16384, DP_TI = 0, DP_Q = 17408, DP_TB = 21632;
constexpr int DP_RT = 32768;
constexpr int DP_AM = 69632;
constexpr int DP_KDT = 87040;
constexpr int DP_QK = 104448;
constexpr int DP_WI = 113152;
constexpr int DP_SM = 130048;

__device__ __forceinline__ void phase_dn_prep(const Params& p, unsigned char* smem) {
    const int tid0 = threadIdx.x;
    float* sbeta = (float*)(smem + DP_SM); float* sgc = sbeta + 64; float* segc = sbeta + 128; float* sekd = sbeta + 192;
    float* Am = (float*)(smem + DP_AM); float* Ti = (float*)(smem + DP_TI); float* Qb = (float*)(smem + DP_Q);
    bf16_t* Tb = (bf16_t*)(smem + DP_TB); bf16_t* Rt = (bf16_t*)(smem + DP_RT);
    bf16_t* kdt = (bf16_t*)(smem + DP_KDT); bf16_t* qki = (bf16_t*)(smem + DP_QK); bf16_t* wim = (bf16_t*)(smem + DP_WI);
    u32x4 xin[7][2]; float pre_b = 0.f, pre_a = 0.f;
    auto dn_fetch = [&](int cj) {
        const int tq = tid0, bhj = cj >> 7, nj = cj & 127, hj = bhj & 3;
        const bf16_t* prj = p.proj_b + (size_t)(bhj >> 2) * SEQ * NP_IN;
        if (tq < 384) {
            const int mat = tq >> 7, rg = (tq >> 3) & 15, sg = tq & 7;
            const int colbase = (mat == 0 ? P_DQ : (mat == 1 ? P_DK : P_DV)) + hj * 128 + sg * 16;
#pragma unroll
            for (int rr = 0; rr < 7; ++rr) {
                const int tt = nj * 64 + 4 * rg - 3 + rr;
                if (tt >= 0) { xin[rr][0] = *(const u32x4*)(prj + (size_t)tt * NP_IN + colbase); xin[rr][1] = *(const u32x4*)(prj + (size_t)tt * NP_IN + colbase + 8); }
                else { xin[rr][0] = (u32x4){0u, 0u, 0u, 0u}; xin[rr][1] = (u32x4){0u, 0u, 0u, 0u}; }
            }
        }
        if (tq < 64) { const size_t m = (size_t)(nj * 64 + tq); pre_b = bf2f(prj[m * NP_IN + P_B + hj]); pre_a = bf2f(prj[m * NP_IN + P_A + hj]); }
    };
    if (blockIdx.x < 16 * 128) dn_fetch(blockIdx.x);
    for (int ci = blockIdx.x; ci < 16 * 128; ci += gridDim.x) {
        int tid = tid0; asm volatile("" : "+v"(tid));
        const int lane = tid & 63, wave = tid >> 6;
        const int bh = ci >> 7, n = ci & 127, b = bh >> 2, h = bh & 3;
        const bf16_t* prow = p.proj_b + (size_t)b * SEQ * NP_IN;
        if (wave == 0) {
            const float braw = pre_b, araw = pre_a;
            const float beta = 1.f / (1.f + expf(-braw));
            const float xx = araw + p.dt_bias[h];
            const float sp = xx > 20.f ? xx : log1pf(expf(xx));
            float g = -expf(p.a_log[h]) * sp;
#pragma unroll
            for (int o = 1; o < 64; o <<= 1) { const float up = __shfl_up(g, o); if (lane >= o) g += up; }
            const float g63 = __shfl(g, 63);
            sbeta[lane] = beta; sgc[lane] = g; segc[lane] = expf(g); sekd[lane] = expf(g63 - g);
            if (lane == 63) p.dn_gl[ci] = expf(g63);
        }
        __syncthreads();
        if (tid < 384) {
            const int mat = tid >> 7, rg = (tid >> 3) & 15, sg = tid & 7, c0 = sg * 16, i0 = 4 * rg;
            const int colbase = (mat == 0 ? P_DQ : (mat == 1 ? P_DK : P_DV)) + h * 128 + c0;
            float wgt[4][16];
#pragma unroll
            for (int j = 0; j < 4; ++j) {
                const float* wp = p.conv_w + j * 1536 + mat * 512 + h * 128 + c0;
#pragma unroll
                for (int q4 = 0; q4 < 4; ++q4) { const float4 w4 = *(const float4*)(wp + 4 * q4); wgt[j][4 * q4] = w4.x; wgt[j][4 * q4 + 1] = w4.y; wgt[j][4 * q4 + 2] = w4.z; wgt[j][4 * q4 + 3] = w4.w; }
            }
#pragma unroll
            for (int ro = 0; ro < 4; ++ro) {
                const int i = i0 + ro, ix = i ^ (sg << 3);
                float acc[16];
#pragma unroll
                for (int cc = 0; cc < 16; ++cc) acc[cc] = 0.f;
#pragma unroll
                for (int j = 0; j < 4; ++j) {
                    const u32x4 x0 = xin[ro + j][0], x1 = xin[ro + j][1];
                    const unsigned xs[8] = {x0.x, x0.y, x0.z, x0.w, x1.x, x1.y, x1.z, x1.w};
#pragma unroll
                    for (int c2 = 0; c2 < 8; ++c2) { acc[2 * c2] = fmaf(wgt[j][2 * c2], bflo(xs[c2]), acc[2 * c2]); acc[2 * c2 + 1] = fmaf(wgt[j][2 * c2 + 1], bfhi(xs[c2]), acc[2 * c2 + 1]); }
                }
                float ss = 0.f;
#pragma unroll
                for (int cc = 0; cc < 16; ++cc) { acc[cc] = silu_f(acc[cc]); ss = fmaf(acc[cc], acc[cc], ss); }
                const float beta_i = sbeta[i], egc_i = segc[i], ekd_i = sekd[i];
                if (mat < 2) {
                    ss += __shfl_xor(ss, 1); ss += __shfl_xor(ss, 2); ss += __shfl_xor(ss, 4);
                    const float rs = rsqrtf(ss + L2_EPS) * (mat == 0 ? 0.08838834764831845f : 1.f);
#pragma unroll
                    for (int cc = 0; cc < 16; ++cc) acc[cc] *= rs;
                    unsigned char* img = smem + (mat == 0 ? DP_QS : DP_KS) + i * 256;
                    u32x4 c0v, c1v;
                    c0v.x = pk_bf16(acc[0], acc[1]); c0v.y = pk_bf16(acc[2], acc[3]); c0v.z = pk_bf16(acc[4], acc[5]); c0v.w = pk_bf16(acc[6], acc[7]);
                    c1v.x = pk_bf16(acc[8], acc[9]); c1v.y = pk_bf16(acc[10], acc[11]); c1v.z = pk_bf16(acc[12], acc[13]); c1v.w = pk_bf16(acc[14], acc[15]);
                    *(u32x4*)(img + (((2 * sg) ^ (i & 15)) << 4)) = c0v;
                    *(u32x4*)(img + (((2 * sg + 1) ^ (i & 15)) << 4)) = c1v;
                }
                if (mat == 0) {
                    u32x4 p0, p1;
                    p0.x = pk_bf16(acc[0] * egc_i, acc[1] * egc_i); p0.y = pk_bf16(acc[2] * egc_i, acc[3] * egc_i); p0.z = pk_bf16(acc[8] * egc_i, acc[9] * egc_i); p0.w = pk_bf16(acc[10] * egc_i, acc[11] * egc_i);
                    p1.x = pk_bf16(acc[4] * egc_i, acc[5] * egc_i); p1.y = pk_bf16(acc[6] * egc_i, acc[7] * egc_i); p1.z = pk_bf16(acc[12] * egc_i, acc[13] * egc_i); p1.w = pk_bf16(acc[14] * egc_i, acc[15] * egc_i);
                    bf16_t* dst = p.dn_qd + ((size_t)(ci * 16 + (i >> 5) * 8 + sg) * 64) * 8;
                    *(u32x4*)(dst + (size_t)(i & 31) * 8) = p0;
                    *(u32x4*)(dst + (size_t)(32 + (i & 31)) * 8) = p1;
                } else if (mat == 1) {
                    const float sc = beta_i * egc_i;
#pragma unroll
                    for (int cc = 0; cc < 16; ++cc) {
                        Rt[(128 + c0 + cc) * 72 + ix] = (bf16_t)(pk_bf16(acc[cc] * sc, 0.f) & 0xffffu);
                        kdt[(c0 + cc) * 68 + ix] = (bf16_t)(pk_bf16(acc[cc] * ekd_i, 0.f) & 0xffffu);
                    }
                } else {
#pragma unroll
                    for (int cc = 0; cc < 16; ++cc) Rt[(c0 + cc) * 72 + ix] = (bf16_t)(pk_bf16(acc[cc] * beta_i, 0.f) & 0xffffu);
                }
            }
        }
        if (ci + (int)gridDim.x < 16 * 128) dn_fetch(ci + (int)gridDim.x);
        __syncthreads();
        {
            const int mat = wave >> 2, ti = (wave >> 1) & 1, tj = wave & 1, r = lane & 31, hh = lane >> 5;
            const unsigned char* ai = smem + (mat ? DP_QS : DP_KS) + (ti * 32 + r) * 256;
            const unsigned char* bi = smem + DP_KS + (tj * 32 + r) * 256;
            f32x16 d;
#pragma unroll
            for (int e = 0; e < 16; ++e) d[e] = 0.f;
#pragma unroll
            for (int ks = 0; ks < 8; ++ks) {
                const bf16x8 af = *(const bf16x8*)(ai + (((2 * ks + hh) ^ (r & 15)) << 4));
                const bf16x8 bf = *(const bf16x8*)(bi + (((2 * ks + hh) ^ (r & 15)) << 4));
                d = __builtin_amdgcn_mfma_f32_32x32x16_bf16(af, bf, d, 0, 0, 0);
            }
            const int j = tj * 32 + r; const float gcj = sgc[j];
#pragma unroll
            for (int e = 0; e < 16; ++e) {
                const int i = ti * 32 + (e & 3) + 8 * (e >> 2) + 4 * hh;
                const float dec = __expf(fminf(sgc[i] - gcj, 0.f));
                if (mat == 0) Am[i * 68 + j] = (j < i) ? sbeta[i] * d[e] * dec : 0.f;
                else qki[i * 68 + j] = (bf16_t)(pk_bf16((j <= i) ? d[e] * dec : 0.f, 0.f) & 0xffffu);
            }
        }
        __syncthreads();
        if (tid < 64) {
            const int bk = tid >> 4, c = tid & 15;
            const float* Ab = Am + (16 * bk) * 68 + 16 * bk;
            float X[16];
#pragma unroll
            for (int i = 0; i < 16; ++i) {
                float sacc = 0.f;
#pragma unroll
                for (int j = 0; j < i; ++j) sacc = fmaf(Ab[i * 68 + j], X[j], sacc);
                X[i] = ((i == c) ? 1.f : 0.f) - sacc;
            }
#pragma unroll
            for (int i = 0; i < 16; ++i) Ti[(16 * bk + i) * 68 + 16 * bk + c] = X[i];
        } else {
            for (int z = tid - 64; z < 6 * 256; z += 448) {
                const int blk = z >> 8, e2 = z & 255, bi = blk < 3 ? 0 : (blk < 5 ? 1 : 2), bj = blk < 3 ? blk + 1 : (blk < 5 ? blk - 1 : 3);
                Ti[(16 * bi + (e2 >> 4)) * 68 + 16 * bj + (e2 & 15)] = 0.f;
            }
        }
        __syncthreads();
        {
            const int w2 = tid >> 8, o = tid & 255, ri = o >> 4, cj = o & 15, r0 = 16 * (2 * w2 + 1), c0 = 16 * (2 * w2);
            float sacc = 0.f;
#pragma unroll
            for (int k = 0; k < 16; ++k) sacc = fmaf(Am[(r0 + ri) * 68 + c0 + k], Ti[(c0 + k) * 68 + c0 + cj], sacc);
            Qb[w2 * 272 + ri * 17 + cj] = sacc;
        }
        __syncthreads();
        {
            const int w2 = tid >> 8, o = tid & 255, ri = o >> 4, cj = o & 15, r0 = 16 * (2 * w2 + 1), c0 = 16 * (2 * w2);
            float sacc = 0.f;
#pragma unroll
            for (int k = 0; k < 16; ++k) sacc = fmaf(Ti[(r0 + ri) * 68 + r0 + k], Qb[w2 * 272 + k * 17 + cj], sacc);
            Ti[(r0 + ri) * 68 + c0 + cj] = -sacc;
        }
        __syncthreads();
        float q3[2];
#pragma unroll
        for (int q = 0; q < 2; ++q) {
            const int o = tid + 512 * q, ri = o >> 5, cj = o & 31;
            float sacc = 0.f;
#pragma unroll
            for (int k = 0; k < 32; ++k) sacc = fmaf(Am[(32 + ri) * 68 + k], Ti[k * 68 + cj], sacc);
            q3[q] = sacc;
        }
#pragma unroll
        for (int q = 0; q < 2; ++q) { const int o = tid + 512 * q; Qb[(o >> 5) * 33 + (o & 31)] = q3[q]; }
        __syncthreads();
#pragma unroll
        for (int q = 0; q < 2; ++q) {
            const int o = tid + 512 * q, ri = o >> 5, cj = o & 31;
            float sacc = 0.f;
#pragma unroll
            for (int k = 0; k < 32; ++k) sacc = fmaf(Ti[(32 + ri) * 68 + 32 + k], Qb[k * 33 + cj], sacc);
            q3[q] = -sacc;
        }
        __syncthreads();
#pragma unroll
        for (int q = 0; q < 2; ++q) { const int o = tid + 512 * q; Ti[(32 + (o >> 5)) * 68 + (o & 31)] = q3[q]; }
        __syncthreads();
#pragma unroll
        for (int q = 0; q < 4; ++q) {
            const int o2 = tid + 512 * q, ri = o2 >> 5, c2 = (o2 & 31) * 2;
            *(unsigned*)(Tb + ri * 72 + c2) = pk_bf16(Ti[ri * 68 + c2], Ti[ri * 68 + c2 + 1]);
        }
        __syncthreads();
        {
            const int ct = wave, r = lane & 31, hh = lane >> 5;
            f32x16 xacc[2];
#pragma unroll
            for (int T = 0; T < 2; ++T)
#pragma unroll
                for (int e = 0; e < 16; ++e) xacc[T][e] = 0.f;
#pragma unroll
            for (int ks = 0; ks < 4; ++ks) {
                const bf16x8 bfr = *(const bf16x8*)(Rt + (32 * ct + r) * 72 + (((2 * ks + hh) ^ (((32 * ct + r) >> 4) & 7)) << 3));
#pragma unroll
                for (int T = 0; T < 2; ++T) {
                    const bf16x8 afr = *(const bf16x8*)(Tb + (32 * T + r) * 72 + 16 * ks + 8 * hh);
                    xacc[T] = __builtin_amdgcn_mfma_f32_32x32x16_bf16(afr, bfr, xacc[T], 0, 0, 0);
                }
            }
            if (ct < 4) {
#pragma unroll
                for (int T = 0; T < 2; ++T)
#pragma unroll
                    for (int hf = 0; hf < 2; ++hf) {
                        u32x4 o; o.x = pk_bf16(xacc[T][8 * hf], xacc[T][8 * hf + 1]); o.y = pk_bf16(xacc[T][8 * hf + 2], xacc[T][8 * hf + 3]);
                        o.z = pk_bf16(xacc[T][8 * hf + 4], xacc[T][8 * hf + 5]); o.w = pk_bf16(xacc[T][8 * hf + 6], xacc[T][8 * hf + 7]);
                        *(u32x4*)(p.dn_u + ((size_t)(((ci * 4 + ct) * 2 + T) * 2 + hf) * 64 + lane) * 8) = o;
                    }
            } else {
                const int dd = 32 * (ct - 4) + r;
#pragma unroll
                for (int T = 0; T < 2; ++T)
#pragma unroll
                    for (int e = 0; e < 16; ++e) wim[(32 * T + (e & 3) + 8 * (e >> 2) + 4 * hh) * 132 + dd] = (bf16_t)(pk_bf16(-xacc[T][e], 0.f) & 0xffffu);
            }
#pragma unroll
            for (int q = 0; q < 3; ++q) {
                const int pc = tid + 512 * q;
                if (pc < 512) {
                    const int f = pc >> 6, ln = pc & 63, r2 = ln & 31, h2 = ln >> 5, rt = f >> 2, ks = f & 3;
                    const bf16_t* src = qki + (32 * rt + r2) * 68 + 16 * ks + 4 * h2;
                    const u32x2 lo = *(const u32x2*)src, hi = *(const u32x2*)(src + 8);
                    u32x4 o; o.x = lo.x; o.y = lo.y; o.z = hi.x; o.w = hi.y;
                    *(u32x4*)(p.dn_qk + ((size_t)(ci * 8 + f) * 64 + ln) * 8) = o;
                } else {
                    const int pc2 = pc - 512, f = pc2 >> 6, ln = pc2 & 63, r2 = ln & 31, h2 = ln >> 5, rt = f >> 2, ks = f & 3;
                    const int dd2 = 32 * rt + r2, sx = ((dd2 >> 4) & 7) << 3, i0 = 16 * ks + 4 * h2;
                    const u32x2 lo = *(const u32x2*)(kdt + dd2 * 68 + (i0 ^ sx)), hi = *(const u32x2*)(kdt + dd2 * 68 + ((i0 + 8) ^ sx));
                    u32x4 o; o.x = lo.x; o.y = lo.y; o.z = hi.x; o.w = hi.y;
                    *(u32x4*)(p.dn_kdt + ((size_t)(ci * 16 + f) * 64 + ln) * 8) = o;
                }
            }
        }
        __syncthreads();
#pragma unroll
        for (int q = 0; q < 2; ++q) {
            const int pc = tid + 512 * q, f = pc >> 6, ln = pc & 63, r = ln & 31, hh = ln >> 5, rt = f >> 3, ks = f & 7;
            const bf16_t* src = wim + (32 * rt + r) * 132 + 16 * ks + 4 * hh;
            const u32x2 lo = *(const u32x2*)src, hi = *(const u32x2*)(src + 8);
            u32x4 o; o.x = lo.x; o.y = lo.y; o.z = hi.x; o.w = hi.y;
            *(u32x4*)(p.dn_negw + ((size_t)(ci * 16 + f) * 64 + ln) * 8) = o;
        }
    }
    __syncthreads();
}

__device__ __forceinline__ bf16x8 pack8(const f32x16& x, int s) {
    u32x4 v;
    v.x = pk_bf16(x[8 * s], x[8 * s + 1]); v.y = pk_bf16(x[8 * s + 2], x[8 * s + 3]); v.z = pk_bf16(x[8 * s + 4], x[8 * s + 5]); v.w = pk_bf16(x[8 * s + 6], x[8 * s + 7]);
    return __builtin_bit_cast(bf16x8, v);
}
#define LDS_BARRIER() do { asm volatile("s_waitcnt lgkmcnt(0)" ::: "memory"); __builtin_amdgcn_s_barrier(); asm volatile("" ::: "memory"); } while (0)
__device__ __forceinline__ const bf16_t* dn_piece_src(const Params& p, int ci, int pc) {
    return pc < 1024 ? p.dn_negw + ((size_t)ci * 1024 + pc) * 8 : pc < 2048 ? p.dn_qd + ((size_t)ci * 1024 + (pc - 1024)) * 8
         : pc < 3072 ? p.dn_kdt + ((size_t)ci * 1024 + (pc - 2048)) * 8 : pc < 3584 ? p.dn_qk + ((size_t)ci * 512 + (pc - 3072)) * 8 : p.dn_u + ((size_t)ci * 1024 + (pc - 3584)) * 8;
}
constexpr int DN_SEG = 32;
template <int PASS> __device__ __forceinline__ int dn_lpiece(int q) { return PASS == 0 ? q : (q < 1024 ? q : (q < 2048 ? q + 1024 : q + 1536)); }
template <int PASS>
__device__ __forceinline__ void dn_scan_seg(const Params& p, unsigned char* smem, int bh, int seg, int half) {
    constexpr int NPC = PASS == 0 ? 4608 : 3072, LPT = NPC / 256, PPT = NPC / 512;
    const int tid = threadIdx.x, lane = tid & 63, wave = tid >> 6, r = lane & 31, hh = lane >> 5;
    const int b = bh >> 2, h = bh & 3, ci0 = bh * 128 + seg * DN_SEG;
#pragma unroll
    for (int q = 0; q < PPT; ++q) { const int pc = dn_lpiece<PASS>(tid + 512 * q); *(u32x4*)(smem + pc * 16) = *(const u32x4*)dn_piece_src(p, ci0, pc); }
    __syncthreads();
    if (wave >= 4) {
        const int t2 = tid - 256;
        u32x4 sa[LPT], sb[LPT], sc[LPT];
#define DN_LD(dst, chunk) do { const int c_ = ci0 + ((chunk) < DN_SEG - 1 ? (chunk) : DN_SEG - 1); _Pragma("unroll") for (int q_ = 0; q_ < LPT; ++q_) dst[q_] = *(const u32x4*)dn_piece_src(p, c_, dn_lpiece<PASS>(t2 + 256 * q_)); } while (0)
#define DN_WR(src, chunk) do { if ((chunk) < DN_SEG) { unsigned char* nb_ = smem + ((chunk) & 1) * DN_CH_BYTES; _Pragma("unroll") for (int q_ = 0; q_ < LPT; ++q_) *(u32x4*)(nb_ + dn_lpiece<PASS>(t2 + 256 * q_) * 16) = src[q_]; } } while (0)
        DN_LD(sa, 1); DN_LD(sb, 2); DN_LD(sc, 3);
        unsigned* prog = p.bar + XCD_BAR_WORDS + 64 * (bh * 4 + seg);
#define DN_PUB(v) do { if (PASS == 0 && t2 == 0) __hip_atomic_store(prog, (unsigned)(v), __ATOMIC_RELAXED, __HIP_MEMORY_SCOPE_AGENT); } while (0)
        for (int n = 0; n < DN_SEG + 1; n += 3) {
            if (n < DN_SEG) { DN_WR(sa, n + 1); DN_LD(sa, n + 4); DN_PUB(n + 1); LDS_BARRIER(); }
            if (n + 1 < DN_SEG) { DN_WR(sb, n + 2); DN_LD(sb, n + 5); DN_PUB(n + 2); LDS_BARRIER(); }
            if (n + 2 < DN_SEG) { DN_WR(sc, n + 3); DN_LD(sc, n + 6); DN_PUB(n + 3); LDS_BARRIER(); }
        }
#undef DN_PUB
#undef DN_LD
#undef DN_WR
    } else {
        const int e = __builtin_amdgcn_readfirstlane(wave);
        const int sl = 4 * half + e;
        const bool isP = sl < 4;
        f32x16 S[4];
#pragma unroll
        for (int T = 0; T < 4; ++T)
#pragma unroll
            for (int e2 = 0; e2 < 16; ++e2) {
                const int row = 32 * T + (e2 & 3) + 8 * (e2 >> 2) + 4 * hh;
                if (PASS == 0) S[T][e2] = seg > 0 ? p.dn_PB[((size_t)(bh * 3 + 0) * 128 + row) * 256 + 128 + 32 * e + r] : 0.f;
                else S[T][e2] = (isP && row == 32 * sl + r) ? 1.f : 0.f;
            }
        if (PASS == 0) {
            for (int sg = 1; sg < seg; ++sg) {
                const float* pseg = p.dn_PB + (size_t)(bh * 3 + sg) * 128 * 256;
                bf16x8 Xb[8];
#pragma unroll
                for (int T = 0; T < 4; ++T) { Xb[2 * T] = pack8(S[T], 0); Xb[2 * T + 1] = pack8(S[T], 1); }
#pragma unroll
                for (int T = 0; T < 4; ++T) {
                    f32x16 xn;
#pragma unroll
                    for (int e2 = 0; e2 < 16; ++e2) xn[e2] = pseg[(size_t)(32 * T + (e2 & 3) + 8 * (e2 >> 2) + 4 * hh) * 256 + 128 + 32 * e + r];
#pragma unroll
                    for (int ks = 0; ks < 8; ++ks) {
                        const float* pr = pseg + (size_t)(32 * T + r) * 256 + 16 * ks + 4 * hh;
                        const float4 lo = *(const float4*)pr, hi = *(const float4*)(pr + 8);
                        u32x4 av; av.x = pk_bf16(lo.x, lo.y); av.y = pk_bf16(lo.z, lo.w); av.z = pk_bf16(hi.x, hi.y); av.w = pk_bf16(hi.z, hi.w);
                        xn = __builtin_amdgcn_mfma_f32_32x32x16_bf16(__builtin_bit_cast(bf16x8, av), Xb[ks], xn, 0, 0, 0);
                        if (ks & 1) __builtin_amdgcn_sched_barrier(0);
                    }
                    S[T] = xn;
                    __builtin_amdgcn_sched_barrier(0);
                }
            }
        }
        const float glr = p.dn_gl[ci0 + (lane & 31)];
#define DN_SB() __builtin_amdgcn_sched_barrier(0)
#define DN_RD8(dst, off) do { _Pragma("unroll") for (int q_ = 0; q_ < 8; ++q_) dst[q_] = *(const bf16x8*)(buf + (off) + q_ * 1024 + lane * 16); } while (0)
        bf16x8 Sb[8];
#pragma unroll
        for (int T = 0; T < 4; ++T) { Sb[2 * T] = pack8(S[T], 0); Sb[2 * T + 1] = pack8(S[T], 1); }
        const unsigned ooff = (unsigned)(4 * hh * 512 + r);
        for (int n = 0; n < DN_SEG; ++n) {
            const unsigned char* buf = smem + (n & 1) * DN_CH_BYTES;
            const float gl = __uint_as_float(__builtin_amdgcn_readlane(__float_as_uint(glr), n));
            bf16x8 fa[8], fb[8];
            DN_RD8(fa, 0);
            DN_RD8(fb, 8192);
            f32x16 vn0, vn1;
            if (PASS == 0 || !isP) {
                const unsigned char* ub = buf + 57344 + (PASS == 0 ? e : sl - 4) * 4096 + lane * 16;
                const u32x4 u00 = *(const u32x4*)ub, u01 = *(const u32x4*)(ub + 1024), u10 = *(const u32x4*)(ub + 2048), u11 = *(const u32x4*)(ub + 3072);
                vn0[0] = bflo(u00.x); vn0[1] = bfhi(u00.x); vn0[2] = bflo(u00.y); vn0[3] = bfhi(u00.y); vn0[4] = bflo(u00.z); vn0[5] = bfhi(u00.z); vn0[6] = bflo(u00.w); vn0[7] = bfhi(u00.w);
                vn0[8] = bflo(u01.x); vn0[9] = bfhi(u01.x); vn0[10] = bflo(u01.y); vn0[11] = bfhi(u01.y); vn0[12] = bflo(u01.z); vn0[13] = bfhi(u01.z); vn0[14] = bflo(u01.w); vn0[15] = bfhi(u01.w);
                vn1[0] = bflo(u10.x); vn1[1] = bfhi(u10.x); vn1[2] = bflo(u10.y); vn1[3] = bfhi(u10.y); vn1[4] = bflo(u10.z); vn1[5] = bfhi(u10.z); vn1[6] = bflo(u10.w); vn1[7] = bfhi(u10.w);
                vn1[8] = bflo(u11.x); vn1[9] = bfhi(u11.x); vn1[10] = bflo(u11.y); vn1[11] = bfhi(u11.y); vn1[12] = bflo(u11.z); vn1[13] = bfhi(u11.z); vn1[14] = bflo(u11.w); vn1[15] = bfhi(u11.w);
            } else {
#pragma unroll
                for (int e2 = 0; e2 < 16; ++e2) { vn0[e2] = 0.f; vn1[e2] = 0.f; }
            }
            DN_SB();
#pragma unroll
            for (int ks = 0; ks < 8; ++ks) vn0 = __builtin_amdgcn_mfma_f32_32x32x16_bf16(fa[ks], Sb[ks], vn0, 0, 0, 0);
            DN_SB();
            if (PASS == 0) DN_RD8(fa, 16384); else DN_RD8(fa, 32768);
            DN_SB();
#pragma unroll
            for (int ks = 0; ks < 8; ++ks) vn1 = __builtin_amdgcn_mfma_f32_32x32x16_bf16(fb[ks], Sb[ks], vn1, 0, 0, 0);
            DN_SB();
            if (PASS == 0) DN_RD8(fb, 16384 + 8192); else DN_RD8(fb, 32768 + 8192);
            DN_SB();
            f32x16 o0, o1;
            if (PASS == 0) {
#pragma unroll
                for (int e2 = 0; e2 < 16; ++e2) { o0[e2] = 0.f; o1[e2] = 0.f; }
#pragma unroll
                for (int ks = 0; ks < 8; ++ks) o0 = __builtin_amdgcn_mfma_f32_32x32x16_bf16(fa[ks], Sb[ks], o0, 0, 0, 0);
                DN_SB();
                DN_RD8(fa, 32768);
            }
            bf16x8 vb[4];
            vb[0] = pack8(vn0, 0); vb[1] = pack8(vn0, 1); vb[2] = pack8(vn1, 0); vb[3] = pack8(vn1, 1);
            DN_SB();
            if (PASS == 0) {
#pragma unroll
                for (int ks = 0; ks < 8; ++ks) o1 = __builtin_amdgcn_mfma_f32_32x32x16_bf16(fb[ks], Sb[ks], o1, 0, 0, 0);
                DN_SB();
                DN_RD8(fb, 32768 + 8192);
            }
#pragma unroll
            for (int e2 = 0; e2 < 16; ++e2) { S[0][e2] *= gl; S[1][e2] *= gl; }
            DN_SB();
#pragma unroll
            for (int ks = 0; ks < 4; ++ks) S[0] = __builtin_amdgcn_mfma_f32_32x32x16_bf16(fa[ks], vb[ks], S[0], 0, 0, 0);
#pragma unroll
            for (int ks = 0; ks < 4; ++ks) S[1] = __builtin_amdgcn_mfma_f32_32x32x16_bf16(fa[4 + ks], vb[ks], S[1], 0, 0, 0);
            DN_SB();
            if (PASS == 0) DN_RD8(fa, 49152);
#pragma unroll
            for (int e2 = 0; e2 < 16; ++e2) { S[2][e2] *= gl; S[3][e2] *= gl; }
            DN_SB();
#pragma unroll
            for (int ks = 0; ks < 4; ++ks) S[2] = __builtin_amdgcn_mfma_f32_32x32x16_bf16(fb[ks], vb[ks], S[2], 0, 0, 0);
#pragma unroll
            for (int ks = 0; ks < 4; ++ks) S[3] = __builtin_amdgcn_mfma_f32_32x32x16_bf16(fb[4 + ks], vb[ks], S[3], 0, 0, 0);
            DN_SB();
            if (PASS == 0) {
#pragma unroll
                for (int ks = 0; ks < 4; ++ks) o0 = __builtin_amdgcn_mfma_f32_32x32x16_bf16(fa[ks], vb[ks], o0, 0, 0, 0);
#pragma unroll
                for (int ks = 0; ks < 4; ++ks) o1 = __builtin_amdgcn_mfma_f32_32x32x16_bf16(fa[4 + ks], vb[ks], o1, 0, 0, 0);
                DN_SB();
            }
#pragma unroll
            for (int T = 0; T < 4; ++T) { Sb[2 * T] = pack8(S[T], 0); Sb[2 * T + 1] = pack8(S[T], 1); }
            if (PASS == 0) {
                bf16_t* ob = p.odn_raw + ((size_t)b * SEQ + (seg * DN_SEG + n) * 64) * 512 + h * 128 + 32 * e;
#pragma unroll
                for (int e2 = 0; e2 < 16; e2 += 2) {
                    const unsigned w0 = pk_bf16(o0[e2], o0[e2 + 1]), w1 = pk_bf16(o1[e2], o1[e2 + 1]);
                    (ob + ((e2 & 3) + 8 * (e2 >> 2)) * 512)[ooff] = (bf16_t)(w0 & 0xffffu); (ob + ((e2 & 3) + 1 + 8 * (e2 >> 2)) * 512)[ooff] = (bf16_t)(w0 >> 16);
                    (ob + (32 + (e2 & 3) + 8 * (e2 >> 2)) * 512)[ooff] = (bf16_t)(w1 & 0xffffu); (ob + (32 + (e2 & 3) + 1 + 8 * (e2 >> 2)) * 512)[ooff] = (bf16_t)(w1 >> 16);
                }
            }
            LDS_BARRIER();
        }
#undef DN_RD8
#undef DN_SB
        if (PASS == 1) {
            float* pb = p.dn_PB + (size_t)(bh * 3 + seg) * 128 * 256 + 32 * sl + r;
#pragma unroll
            for (int T = 0; T < 4; ++T)
#pragma unroll
                for (int e2 = 0; e2 < 16; ++e2) pb[(size_t)(32 * T + (e2 & 3) + 8 * (e2 >> 2) + 4 * hh) * 256] = S[T][e2];
        }
    }
    __syncthreads();
}
__device__ __forceinline__ void phase_scan_l2_helper(const Params& p) {
    const int sj = blockIdx.x - 64, tid = threadIdx.x;
    const int bh = sj >> 2, seg = sj & 3, ci0 = bh * 128 + seg * DN_SEG;
    unsigned* prog = p.bar + XCD_BAR_WORDS + 64 * sj;
    unsigned acc = 0u;
    for (int m = 7; m < DN_SEG; ++m) {
        unsigned spins = 0, pr;
        for (;;) {
            pr = __hip_atomic_load(prog, __ATOMIC_RELAXED, __HIP_MEMORY_SCOPE_AGENT);
            if ((int)pr + 8 >= m || ++spins > 100000u) break;
            __builtin_amdgcn_s_sleep(16);
        }
        if ((int)pr + 4 >= m) continue;
#pragma unroll
        for (int q = 0; q < 9; ++q) { const u32x4 v = *(const u32x4*)dn_piece_src(p, ci0 + m, tid + 512 * q); acc ^= v.x ^ v.y ^ v.z ^ v.w; }
    }
    asm volatile("" :: "v"(acc));
}

constexpr int AT_VT = 32768, AT_VT_STRIDE = 260;
__device__ __forceinline__ void phase_attn(const Params& p, unsigned char* smem, int first_block) {
    const int tid0 = threadIdx.x;
    const int nblk = gridDim.x - first_block;
    const bf16_t* pb = p.proj_b;
    bf16_t* vt = (bf16_t*)(smem + AT_VT);
    u32x4 kvr[4], vvr[4]; bf16x8 qfn[4];
    auto at_fetch = [&](int it) {
        const int tq = tid0, ln = tq & 63, wv = tq >> 6;
        const int hp = it & 1, kvh = (it >> 1) & 1, nb = (it >> 2) & 63, b = it >> 8, m0 = b * SEQ + nb * 128;
#pragma unroll
        for (int i = 0; i < 4; ++i) {
            const int idx = tq + 512 * i, key = idx >> 3, ch = idx & 7;
            kvr[i] = (u32x4){0u, 0u, 0u, 0u}; vvr[i] = (u32x4){0u, 0u, 0u, 0u};
            if ((nb > 0) || (key >= 128)) { const bf16_t* src = pb + (size_t)(m0 - 128 + key) * NP_IN + kvh * 64 + ch * 8; kvr[i] = *(const u32x4*)(src + P_AK); vvr[i] = *(const u32x4*)(src + P_AV); }
        }
        const int head = kvh * 4 + hp * 2 + (wv >> 2), qo = (wv & 3) * 32;
        const bf16_t* qrow = pb + (size_t)(m0 + qo + (ln & 31)) * NP_IN + P_AQ + head * 64 + 8 * (ln >> 5);
#pragma unroll
        for (int ks = 0; ks < 4; ++ks) qfn[ks] = *(const bf16x8*)(qrow + 16 * ks);
    };
    if ((int)blockIdx.x - first_block < 1024) at_fetch((int)blockIdx.x - first_block);
    for (int item = blockIdx.x - first_block; item < 1024; item += nblk) {
        int tid = tid0; asm volatile("" : "+v"(tid));
        const int lane = tid & 63, wave = tid >> 6, r = lane & 31, hh = lane >> 5;
        const int hp = item & 1, kvh = (item >> 1) & 1, nb = (item >> 2) & 63, b = item >> 8;
        const int m0 = b * SEQ + nb * 128;
        __syncthreads();
#pragma unroll
        for (int i = 0; i < 4; ++i) {
            const int idx = tid + 512 * i, key = idx >> 3, ch = idx & 7;
            const u32x4 vv = vvr[i];
            *(u32x4*)(smem + swz(key, ch)) = kvr[i];
            bf16_t* vd = vt + (ch * 8) * AT_VT_STRIDE + (key ^ (ch << 3));
            vd[0] = (bf16_t)(vv.x & 0xffffu); vd[AT_VT_STRIDE] = (bf16_t)(vv.x >> 16); vd[2 * AT_VT_STRIDE] = (bf16_t)(vv.y & 0xffffu); vd[3 * AT_VT_STRIDE] = (bf16_t)(vv.y >> 16);
            vd[4 * AT_VT_STRIDE] = (bf16_t)(vv.z & 0xffffu); vd[5 * AT_VT_STRIDE] = (bf16_t)(vv.z >> 16); vd[6 * AT_VT_STRIDE] = (bf16_t)(vv.w & 0xffffu); vd[7 * AT_VT_STRIDE] = (bf16_t)(vv.w >> 16);
        }
        bf16x8 qf[4];
#pragma unroll
        for (int ks = 0; ks < 4; ++ks) qf[ks] = qfn[ks];
        __syncthreads();
        if (item + nblk < 1024) at_fetch(item + nblk);
        const int head = kvh * 4 + hp * 2 + (wave >> 2), qt = wave & 3, qo = qt * 32;
        f32x16 sc[5];
#pragma unroll
        for (int t = 0; t < 5; ++t) {
#pragma unroll
            for (int e = 0; e < 16; ++e) sc[t][e] = 0.f;
#pragma unroll
            for (int ks = 0; ks < 4; ++ks) sc[t] = __builtin_amdgcn_mfma_f32_32x32x16_bf16(*(const bf16x8*)(smem + swz((qt + t) * 32 + r, 2 * ks + hh)), qf[ks], sc[t], 0, 0, 0);
        }
        const float sink = p.sinks[head];
        float mx = -1e30f;
#pragma unroll
        for (int t = 0; t < 5; ++t)
#pragma unroll
            for (int e = 0; e < 16; ++e) {
                const int kf = 32 * (qt + t) + (e & 3) + 8 * (e >> 2) + 4 * hh;
                const bool ok = (kf >= qo + r + 1) && (kf <= qo + r + 128) && ((nb > 0) || (kf >= 128));
                sc[t][e] = ok ? sc[t][e] : -1e30f;
                mx = fmaxf(mx, sc[t][e]);
            }
        mx = fmaxf(mx, __shfl_xor(mx, 32));
        mx = fmaxf(mx, sink);
        float sum = 0.f;
#pragma unroll
        for (int t = 0; t < 5; ++t)
#pragma unroll
            for (int e = 0; e < 16; ++e) { const float pe = (sc[t][e] > -1e29f) ? __expf(sc[t][e] - mx) : 0.f; sc[t][e] = pe; sum += pe; }
        sum += __shfl_xor(sum, 32);
        const float inv = 1.f / (sum + __expf(sink - mx));
        f32x16 o[2];
#pragma unroll
        for (int dt = 0; dt < 2; ++dt)
#pragma unroll
            for (int e = 0; e < 16; ++e) o[dt][e] = 0.f;
#pragma unroll
        for (int t = 0; t < 5; ++t)
#pragma unroll
            for (int s2 = 0; s2 < 2; ++s2) {
                const bf16x8 pbv = pack8(sc[t], s2);
                const int kb = 32 * (qt + t) + 16 * s2 + 4 * hh;
#pragma unroll
                for (int dt = 0; dt < 2; ++dt) {
                    const int dvr = dt * 32 + r, vx = ((dvr >> 3) & 7) << 3;
                    const u32x2 lo = *(const u32x2*)(vt + dvr * AT_VT_STRIDE + (kb ^ vx)), hi = *(const u32x2*)(vt + dvr * AT_VT_STRIDE + ((kb + 8) ^ vx));
                    u32x4 av; av.x = lo.x; av.y = lo.y; av.z = hi.x; av.w = hi.y;
                    o[dt] = __builtin_amdgcn_mfma_f32_32x32x16_bf16(__builtin_bit_cast(bf16x8, av), pbv, o[dt], 0, 0, 0);
                }
            }
        bf16_t* orow = p.xb + (size_t)(m0 + qo + r) * D_MODEL + head * 64 + 4 * hh;
#pragma unroll
        for (int dt = 0; dt < 2; ++dt)
#pragma unroll
            for (int q4 = 0; q4 < 4; ++q4) {
                u32x2 v; v.x = pk_bf16(o[dt][4 * q4] * inv, o[dt][4 * q4 + 1] * inv); v.y = pk_bf16(o[dt][4 * q4 + 2] * inv, o[dt][4 * q4 + 3] * inv);
                *(u32x2*)(orow + dt * 32 + 8 * q4) = v;
            }
    }
    __syncthreads();
}

__device__ __forceinline__ void phase_dn_norm(const Params& p) {
    const int lane = threadIdx.x & 63, gw = blockIdx.x * (NTHREADS / 64) + (threadIdx.x >> 6), GW = gridDim.x * (NTHREADS / 64);
    const float2 g = *(const float2*)(p.dn_norm_g + lane * 2);
    for (int m = gw; m < M_TOK; m += GW) {
        float2 o[4]; unsigned z[4];
#pragma unroll
        for (int h = 0; h < 4; ++h) { const unsigned ow = *(const unsigned*)(p.odn_raw + (size_t)m * 512 + h * 128 + lane * 2); o[h] = make_float2(bflo(ow), bfhi(ow)); z[h] = *(const unsigned*)(p.proj_b + (size_t)m * NP_IN + P_Z + h * 128 + lane * 2); }
#pragma unroll
        for (int h = 0; h < 4; ++h) {
            const float ss = wave_sum(o[h].x * o[h].x + o[h].y * o[h].y);
            const float rr = rsqrtf(ss * (1.f / 128.f) + RMS_EPS);
            *(unsigned*)(p.xb + (size_t)m * D_MODEL + 512 + h * 128 + lane * 2) = pk_bf16(o[h].x * rr * g.x * silu_f(bflo(z[h])), o[h].y * rr * g.y * silu_f(bfhi(z[h])));
        }
    }
}

__device__ __forceinline__ f32x4 bf4_lo(const u32x4 w) { return (f32x4){bflo(w.x), bfhi(w.x), bflo(w.y), bfhi(w.y)}; }
__device__ __forceinline__ f32x4 bf4_hi(const u32x4 w) { return (f32x4){bflo(w.z), bfhi(w.z), bflo(w.w), bfhi(w.w)}; }
__device__ __forceinline__ float sum4(const f32x4 v) { return (v[0] + v[1]) + (v[2] + v[3]); }
__device__ __forceinline__ void phase_ln1(const Params& p, const bf16_t* yb, bf16_t* x1b) {
    const int lane = threadIdx.x & 63, gw = blockIdx.x * (NTHREADS / 64) + (threadIdx.x >> 6), GW = gridDim.x * (NTHREADS / 64);
    f32x4 g[4], bb[4];
#pragma unroll
    for (int j = 0; j < 4; ++j) { g[j] = *(const f32x4*)(p.ln1_g + (j >> 1) * 512 + lane * 8 + (j & 1) * 4); bb[j] = *(const f32x4*)(p.ln1_b + (j >> 1) * 512 + lane * 8 + (j & 1) * 4); }
    for (int m0 = gw * 4; m0 < M_TOK; m0 += GW * 4) {
        u32x4 w[4][2];
#pragma unroll
        for (int rr = 0; rr < 4; ++rr)
#pragma unroll
            for (int j = 0; j < 2; ++j) w[rr][j] = *(const u32x4*)(yb + (size_t)(m0 + rr) * D_MODEL + j * 512 + lane * 8);
#pragma unroll
        for (int rr = 0; rr < 4; ++rr) {
            f32x4 v[4] = {bf4_lo(w[rr][0]), bf4_hi(w[rr][0]), bf4_lo(w[rr][1]), bf4_hi(w[rr][1])};
            const float mean = wave_sum((sum4(v[0]) + sum4(v[1])) + (sum4(v[2]) + sum4(v[3]))) * (1.f / D_MODEL);
            float q = 0.f;
#pragma unroll
            for (int j = 0; j < 4; ++j) { v[j] -= mean; q += sum4(v[j] * v[j]); }
            const float rstd = rsqrtf(wave_sum(q) * (1.f / D_MODEL) + LN_EPS);
#pragma unroll
            for (int j = 0; j < 4; ++j) v[j] = v[j] * rstd * g[j] + bb[j];
#pragma unroll
            for (int j = 0; j < 2; ++j) {
                u32x4 ob; ob.x = pk_bf16(v[2 * j][0], v[2 * j][1]); ob.y = pk_bf16(v[2 * j][2], v[2 * j][3]); ob.z = pk_bf16(v[2 * j + 1][0], v[2 * j + 1][1]); ob.w = pk_bf16(v[2 * j + 1][2], v[2 * j + 1][3]);
                *(u32x4*)(x1b + (size_t)(m0 + rr) * D_MODEL + j * 512 + lane * 8) = ob;
            }
        }
    }
}

__device__ __forceinline__ void cas_d(float& a, float& b) { const float hi = fmaxf(a, b), lo = fminf(a, b); a = hi; b = lo; }
__device__ __forceinline__ void cas_a(float& a, float& b) { const float hi = fmaxf(a, b), lo = fminf(a, b); a = lo; b = hi; }
__device__ __forceinline__ void sort16_desc(f32x16& v) {
#pragma unroll
    for (int k = 2; k <= 16; k <<= 1)
#pragma unroll
        for (int j = k >> 1; j > 0; j >>= 1)
#pragma unroll
            for (int i = 0; i < 16; ++i) {
                const int l = i ^ j;
                if (l > i) { float a = v[i], b = v[l]; if ((i & k) == 0) cas_d(a, b); else cas_a(a, b); v[i] = a; v[l] = b; }
            }
}
__device__ __forceinline__ void bmerge16_desc(f32x16& v) {
#pragma unroll
    for (int j = 8; j > 0; j >>= 1)
#pragma unroll
        for (int i = 0; i < 16; ++i) { const int l = i ^ j; if (l > i) { float a = v[i], b = v[l]; cas_d(a, b); v[i] = a; v[l] = b; } }
}
__device__ __forceinline__ f32x16 merge_top16(const f32x16& a, const f32x16& b) {
    f32x16 c;
#pragma unroll
    for (int i = 0; i < 16; ++i) c[i] = fmaxf(a[i], b[15 - i]);
    bmerge16_desc(c);
    return c;
}
__device__ __forceinline__ void pcas_d(float& va, int& ia, float& vb, int& ib) {
    const bool sw = vb > va; const float tv = sw ? vb : va; const int ti = sw ? ib : ia;
    vb = sw ? va : vb; ib = sw ? ia : ib; va = tv; ia = ti;
}
__device__ __forceinline__ void psort16_desc(float (&v)[16], int (&id)[16]) {
#pragma unroll
    for (int k = 2; k <= 16; k <<= 1)
#pragma unroll
        for (int j = k >> 1; j > 0; j >>= 1)
#pragma unroll
            for (int i = 0; i < 16; ++i) {
                const int l = i ^ j;
                if (l > i) { if ((i & k) == 0) pcas_d(v[i], id[i], v[l], id[l]); else pcas_d(v[l], id[l], v[i], id[i]); }
            }
}
__device__ __forceinline__ void pmerge_top16(float (&a)[16], int (&ia)[16], const float (&b)[16], const int (&ib)[16]) {
#pragma unroll
    for (int i = 0; i < 16; ++i) { const bool sw = b[15 - i] > a[i]; a[i] = sw ? b[15 - i] : a[i]; ia[i] = sw ? ib[15 - i] : ia[i]; }
#pragma unroll
    for (int j = 8; j > 0; j >>= 1)
#pragma unroll
        for (int i = 0; i < 16; ++i) { const int l = i ^ j; if (l > i) pcas_d(a[i], ia[i], a[l], ia[l]); }
}
__device__ __forceinline__ void phase_route(const Params& p, const bf16_t* qb) {
    constexpr int CI[50] = {0,0,0,0,0,0,0,0,0,0,0,0,0,0,0,0,1,1,1,1,1,1,1,1,2,2,2,2,2,3,3,3,3,4,4,4,5,5,6,6,7,7,8,9,10,11,12,13,14,15};
    constexpr int CJ[50] = {0,1,2,3,4,5,6,7,8,9,10,11,12,13,14,15,0,1,2,3,4,5,6,7,0,1,2,3,4,0,1,2,3,0,1,2,0,1,0,1,0,1,0,0,0,0,0,0,0,0};
    const int lane0 = threadIdx.x & 63, gw = blockIdx.x * (NTHREADS / 64) + (threadIdx.x >> 6), GW = gridDim.x * (NTHREADS / 64);
    for (int task = gw; task < (M_TOK / 32) * 8; task += GW) {
        int lane = lane0; asm volatile("" : "+v"(lane));
        const int r = lane & 31, hh = lane >> 5;
        const int h = task & 7, tok0 = (task >> 3) * 32;
        f32x16 top[2];
#pragma unroll
        for (int pp = 0; pp < 2; ++pp) {
            const bf16_t* qrow = qb + (size_t)(tok0 + r) * 2048 + h * 256 + pp * 128 + 8 * hh;
            bf16x8 qf[8];
#pragma unroll
            for (int ks = 0; ks < 8; ++ks) qf[ks] = *(const bf16x8*)(qrow + 16 * ks);
            f32x16 sc[4];
#pragma unroll
            for (int kt = 0; kt < 4; ++kt) {
                const bf16_t* af = p.sk_frag + ((size_t)(((h * 2 + pp) * 4 + kt) * 8) * 64 + lane) * 8;
                bf16x8 a[8];
#pragma unroll
                for (int ks = 0; ks < 8; ++ks) a[ks] = *(const bf16x8*)(af + (size_t)ks * 512);
#pragma unroll
                for (int e = 0; e < 16; ++e) sc[kt][e] = 0.f;
#pragma unroll
                for (int ks = 0; ks < 8; ++ks) sc[kt] = __builtin_amdgcn_mfma_f32_32x32x16_bf16(a[ks], qf[ks], sc[kt], 0, 0, 0);
            }
#pragma unroll
            for (int kt = 0; kt < 4; ++kt) {
#pragma unroll
                for (int e = 0; e < 16; ++e) {
                    const unsigned key = (unsigned)(32 * kt + (e & 3) + 8 * (e >> 2)) + 4u * (unsigned)hh;
                    sc[kt][e] = __uint_as_float((__float_as_uint(sc[kt][e]) & 0xffffff80u) | key);
                }
                sort16_desc(sc[kt]);
            }
            f32x16 m = merge_top16(merge_top16(sc[0], sc[1]), merge_top16(sc[2], sc[3]));
            f32x16 oth;
#pragma unroll
            for (int i = 0; i < 16; ++i) oth[i] = __shfl_xor(m[i], 32);
            top[pp] = merge_top16(m, oth);
        }
        int ia[16], ib[16];
#pragma unroll
        for (int i = 0; i < 16; ++i) { ia[i] = (int)(__float_as_uint(top[0][i]) & 127u); ib[i] = (int)(__float_as_uint(top[1][i]) & 127u); }
        float cv0[16], cv1[16]; int cd0[16], cd1[16];
#pragma unroll
        for (int c = 0; c < 32; ++c) {
            float v = -INFINITY; int id = 0;
            if (c < 25) {
                const float v0 = top[0][CI[2 * c]] + top[1][CJ[2 * c]], v1 = top[0][CI[2 * c + 1]] + top[1][CJ[2 * c + 1]];
                const int d0 = (ia[CI[2 * c]] << 7) | ib[CJ[2 * c]], d1 = (ia[CI[2 * c + 1]] << 7) | ib[CJ[2 * c + 1]];
                v = hh ? v1 : v0; id = hh ? d1 : d0;
            }
            if (c < 16) { cv0[c] = v; cd0[c] = id; } else { cv1[c - 16] = v; cd1[c - 16] = id; }
        }
        psort16_desc(cv0, cd0); psort16_desc(cv1, cd1);
        pmerge_top16(cv0, cd0, cv1, cd1);
        float ov[16]; int od[16];
#pragma unroll
        for (int i = 0; i < 16; ++i) { ov[i] = __shfl_xor(cv0[i], 32); od[i] = __shfl_xor(cd0[i], 32); }
        pmerge_top16(cv0, cd0, ov, od);
        float ex[16], den = 0.f;
#pragma unroll
        for (int i = 0; i < 16; ++i) { ex[i] = __expf(cv0[i] - cv0[0]); den += ex[i]; }
        const float inv = 1.f / den;
        if (hh == 0) {
            int* idp = p.ids + (size_t)(tok0 + r) * 128 + h * 16; float* gp = p.gates + (size_t)(tok0 + r) * 128 + h * 16;
#pragma unroll
            for (int q = 0; q < 4; ++q) {
                *(int4*)(idp + 4 * q) = make_int4(cd0[4 * q], cd0[4 * q + 1], cd0[4 * q + 2], cd0[4 * q + 3]);
                *(float4*)(gp + 4 * q) = make_float4(ex[4 * q] * inv, ex[4 * q + 1] * inv, ex[4 * q + 2] * inv, ex[4 * q + 3] * inv);
            }
        }
    }
}


typedef float f32x2 __attribute__((ext_vector_type(2)));
__device__ __forceinline__ void phase_tables8(const Params& p, int first_block) {
    const int lane = threadIdx.x & 63, gw = (blockIdx.x - first_block) * (NTHREADS / 64) + (threadIdx.x >> 6), GW = (gridDim.x - first_block) * (NTHREADS / 64);
    for (int row0 = gw * 4; row0 < 2 * 16384; row0 += GW * 4) {
        float v[4][16];
#pragma unroll
        for (int rr = 0; rr < 4; ++rr) {
            const int row = row0 + rr, table = row >> 14, e = row & 16383;
            const float* src = (table ? p.peer_v : p.peer_u) + (size_t)e * 1024 + lane * 16;
#pragma unroll
            for (int q = 0; q < 4; ++q) { const float4 a = *(const float4*)(src + 4 * q); v[rr][4 * q] = a.x; v[rr][4 * q + 1] = a.y; v[rr][4 * q + 2] = a.z; v[rr][4 * q + 3] = a.w; }
        }
#pragma unroll
        for (int rr = 0; rr < 4; ++rr) {
            const int row = row0 + rr, table = row >> 14, e = row & 16383;
            float am = 0.f;
#pragma unroll
            for (int c = 0; c < 16; ++c) am = fmaxf(am, fabsf(v[rr][c]));
            am = wave_max(am);
            float sc = am > 0.f ? exp2f(floorf(log2f(448.f / am))) : 1.f;
            if (am * sc > 448.f) sc *= 0.5f;
            u32x4 o; int w;
            w = 0; w = __builtin_amdgcn_cvt_pk_fp8_f32(v[rr][0] * sc, v[rr][1] * sc, w, false); w = __builtin_amdgcn_cvt_pk_fp8_f32(v[rr][2] * sc, v[rr][3] * sc, w, true); o.x = (unsigned)w;
            w = 0; w = __builtin_amdgcn_cvt_pk_fp8_f32(v[rr][4] * sc, v[rr][5] * sc, w, false); w = __builtin_amdgcn_cvt_pk_fp8_f32(v[rr][6] * sc, v[rr][7] * sc, w, true); o.y = (unsigned)w;
            w = 0; w = __builtin_amdgcn_cvt_pk_fp8_f32(v[rr][8] * sc, v[rr][9] * sc, w, false); w = __builtin_amdgcn_cvt_pk_fp8_f32(v[rr][10] * sc, v[rr][11] * sc, w, true); o.z = (unsigned)w;
            w = 0; w = __builtin_amdgcn_cvt_pk_fp8_f32(v[rr][12] * sc, v[rr][13] * sc, w, false); w = __builtin_amdgcn_cvt_pk_fp8_f32(v[rr][14] * sc, v[rr][15] * sc, w, true); o.w = (unsigned)w;
            *(u32x4*)(p.tab8 + ((size_t)((table * 8 + (lane >> 3)) * 16384 + e)) * 128 + (lane & 7) * 16) = o;
            if (lane == 0) p.isc[row] = 1.f / sc;
        }
    }
}
typedef int i32x16 __attribute__((ext_vector_type(16)));
struct PeerBuf { u32x4 rows[16]; u32x4 xa, xb; f32x16 w; };
__device__ __forceinline__ float dpp_xor1(float v) { return __uint_as_float(__builtin_amdgcn_update_dpp(0u, __float_as_uint(v), 0xB1, 0xF, 0xF, true)); }
__device__ __forceinline__ float dpp_xor2(float v) { return __uint_as_float(__builtin_amdgcn_update_dpp(0u, __float_as_uint(v), 0x4E, 0xF, 0xF, true)); }
__device__ __forceinline__ float dpp_xor8(float v) { return __uint_as_float(__builtin_amdgcn_update_dpp(0u, __float_as_uint(v), 0x128, 0xF, 0xF, true)); }
__device__ __forceinline__ float swz_xor4(float v) { return __uint_as_float(__builtin_amdgcn_ds_swizzle(__float_as_uint(v), 0x101F)); }
__device__ __forceinline__ float swz_xor16(float v) { return __uint_as_float(__builtin_amdgcn_ds_swizzle(__float_as_uint(v), 0x401F)); }
__device__ __forceinline__ void peer_gather(PeerBuf& B, const unsigned char* tab, const i32x16& id, int j) {
#pragma unroll
    for (int i = 0; i < 16; ++i) B.rows[i] = *(const u32x4*)(tab + (size_t)id[i] * 128 + j * 16);
}
__device__ __forceinline__ void phase_peer_u(const Params& p, const bf16_t* x1b, float* ph) {
    const int lane0 = threadIdx.x & 63, wave = threadIdx.x >> 6;
    const int x = blockIdx.x & 7, nloc = (gridDim.x - x + 7) >> 3, wl = (blockIdx.x >> 3) * (NTHREADS / 64) + wave, NW = nloc * (NTHREADS / 64);
    const unsigned char* tab = p.tab8 + (size_t)x * 16384 * 128;
    int lane = lane0; asm volatile("" : "+v"(lane));
    const int j = lane & 7, g = lane >> 3;
    const bool b0 = j & 1, b1 = j & 2, b2 = j & 4;
    auto tok = [&](int t) { return t < M_TOK ? t : M_TOK - 1; };
    auto load_ids = [&](i32x16& id, int t) {
#pragma unroll
        for (int q = 0; q < 4; ++q) { const int4 v = *(const int4*)(p.ids + (size_t)t * 128 + 16 * g + 4 * q); id[4 * q] = v.x; id[4 * q + 1] = v.y; id[4 * q + 2] = v.z; id[4 * q + 3] = v.w; }
    };
    auto issue = [&](PeerBuf& B, int t, const i32x16& id) {
        const bf16_t* xs = x1b + (size_t)t * 1024 + 128 * x + 16 * j;
        B.xa = *(const u32x4*)xs; B.xb = *(const u32x4*)(xs + 8);
        peer_gather(B, tab, id, j);
    };
    auto compute = [&](const PeerBuf& B, int t) {
        const f32x2 xf[8] = {{bflo(B.xa.x), bfhi(B.xa.x)}, {bflo(B.xa.y), bfhi(B.xa.y)}, {bflo(B.xa.z), bfhi(B.xa.z)}, {bflo(B.xa.w), bfhi(B.xa.w)},
                             {bflo(B.xb.x), bfhi(B.xb.x)}, {bflo(B.xb.y), bfhi(B.xb.y)}, {bflo(B.xb.z), bfhi(B.xb.z)}, {bflo(B.xb.w), bfhi(B.xb.w)}};
        float res[16];
#pragma unroll
        for (int i = 0; i < 16; ++i) {
            const unsigned dw[4] = {B.rows[i].x, B.rows[i].y, B.rows[i].z, B.rows[i].w};
            f32x2 d2 = {0.f, 0.f};
#pragma unroll
            for (int q = 0; q < 4; ++q) {
                const f32x2 lo = __builtin_amdgcn_cvt_pk_f32_fp8((int)dw[q], false), hi = __builtin_amdgcn_cvt_pk_f32_fp8((int)dw[q], true);
                d2 = lo * xf[2 * q] + d2; d2 = hi * xf[2 * q + 1] + d2;
            }
            res[i] = d2.x + d2.y;
        }
        float r8[8], r4[4], r2[2];
#pragma unroll
        for (int m = 0; m < 8; ++m) { const float keep = b0 ? res[8 + m] : res[m], send = b0 ? res[m] : res[8 + m]; r8[m] = keep + dpp_xor1(send); }
#pragma unroll
        for (int m = 0; m < 4; ++m) { const float keep = b1 ? r8[4 + m] : r8[m], send = b1 ? r8[m] : r8[4 + m]; r4[m] = keep + dpp_xor2(send); }
#pragma unroll
        for (int m = 0; m < 2; ++m) { const float keep = b2 ? r4[2 + m] : r4[m], send = b2 ? r4[m] : r4[2 + m]; r2[m] = keep + swz_xor4(send); }
        const int i0 = 8 * (int)b0 + 4 * (int)b1 + 2 * (int)b2;
        *(float2*)(ph + ((size_t)x * M_TOK + t) * 128 + 16 * g + i0) = make_float2(r2[0], r2[1]);
    };
    PeerBuf A, Bb;
    int t = wl;
    if (t >= M_TOK) return;
    i32x16 idn;
    load_ids(idn, t);
    issue(A, t, idn);
    load_ids(idn, tok(t + NW));
    for (; t < M_TOK; t += 2 * NW) {
        issue(Bb, tok(t + NW), idn);
        load_ids(idn, tok(t + 2 * NW));
        compute(A, t);
        issue(A, tok(t + 2 * NW), idn);
        load_ids(idn, tok(t + 3 * NW));
        if (t + NW < M_TOK) compute(Bb, t + NW);
    }
}
__device__ __forceinline__ void phase_peer_w(const Params& p, const float* ph, float* wbuf) {
    const size_t gt = (size_t)blockIdx.x * NTHREADS + threadIdx.x, GT = (size_t)gridDim.x * NTHREADS;
    for (size_t i0 = gt; i0 < (size_t)M_TOK * 128; i0 += GT * 4) {
        int e[4]; float h[4], gg[4];
#pragma unroll
        for (int u = 0; u < 4; ++u) {
            const size_t idx = i0 + u * GT;
            e[u] = p.ids[idx]; gg[u] = p.gates[idx]; h[u] = 0.f;
#pragma unroll
            for (int x = 0; x < 8; ++x) h[u] += ph[(size_t)x * M_TOK * 128 + idx];
        }
#pragma unroll
        for (int u = 0; u < 4; ++u) {
            const float hv = h[u] * p.isc[e[u]];
            wbuf[i0 + u * GT] = 0.5f * hv * (1.f + erff(hv * 0.7071067811865476f)) * gg[u] * p.isc[16384 + e[u]];
        }
    }
}
__device__ __forceinline__ void phase_peer_v(const Params& p, const float* wbuf, bf16_t* ffn) {
    const int lane0 = threadIdx.x & 63, wave = threadIdx.x >> 6;
    const int x = blockIdx.x & 7, nloc = (gridDim.x - x + 7) >> 3, wl = (blockIdx.x >> 3) * (NTHREADS / 64) + wave, NW = nloc * (NTHREADS / 64);
    const unsigned char* tab = p.tab8 + (size_t)(8 + x) * 16384 * 128;
    int lane = lane0; asm volatile("" : "+v"(lane));
    const int j = lane & 7, g = lane >> 3;
    const bool b3 = g & 1, b4 = g & 2, b5 = g & 4;
    auto tok = [&](int t) { return t < M_TOK ? t : M_TOK - 1; };
    auto load_ids = [&](i32x16& id, int t) {
#pragma unroll
        for (int q = 0; q < 4; ++q) { const int4 v = *(const int4*)(p.ids + (size_t)t * 128 + 16 * g + 4 * q); id[4 * q] = v.x; id[4 * q + 1] = v.y; id[4 * q + 2] = v.z; id[4 * q + 3] = v.w; }
    };
    auto issue = [&](PeerBuf& B, int t, const i32x16& id) {
#pragma unroll
        for (int q = 0; q < 4; ++q) { const float4 v = *(const float4*)(wbuf + (size_t)t * 128 + 16 * g + 4 * q); B.w[4 * q] = v.x; B.w[4 * q + 1] = v.y; B.w[4 * q + 2] = v.z; B.w[4 * q + 3] = v.w; }
        peer_gather(B, tab, id, j);
    };
    auto compute = [&](const PeerBuf& B, int t) {
        f32x2 acc[8];
#pragma unroll
        for (int c = 0; c < 8; ++c) acc[c] = (f32x2){0.f, 0.f};
#pragma unroll
        for (int i = 0; i < 16; ++i) {
            const f32x2 w2 = {B.w[i], B.w[i]};
            const unsigned dw[4] = {B.rows[i].x, B.rows[i].y, B.rows[i].z, B.rows[i].w};
#pragma unroll
            for (int q = 0; q < 4; ++q) {
                const f32x2 lo = __builtin_amdgcn_cvt_pk_f32_fp8((int)dw[q], false), hi = __builtin_amdgcn_cvt_pk_f32_fp8((int)dw[q], true);
                acc[2 * q] = lo * w2 + acc[2 * q]; acc[2 * q + 1] = hi * w2 + acc[2 * q + 1];
            }
        }
        f32x2 a4[4], a2[2], a1;
#pragma unroll
        for (int m = 0; m < 4; ++m) { const f32x2 keep = b3 ? acc[4 + m] : acc[m], send = b3 ? acc[m] : acc[4 + m]; a4[m] = (f32x2){keep.x + dpp_xor8(send.x), keep.y + dpp_xor8(send.y)}; }
#pragma unroll
        for (int m = 0; m < 2; ++m) { const f32x2 keep = b4 ? a4[2 + m] : a4[m], send = b4 ? a4[m] : a4[2 + m]; a2[m] = (f32x2){keep.x + swz_xor16(send.x), keep.y + swz_xor16(send.y)}; }
        { const f32x2 keep = b5 ? a2[1] : a2[0], send = b5 ? a2[0] : a2[1]; a1 = (f32x2){keep.x + __shfl_xor(send.x, 32), keep.y + __shfl_xor(send.y, 32)}; }
        const int c0 = 8 * (int)b3 + 4 * (int)b4 + 2 * (int)b5;
        *(unsigned*)(ffn + (size_t)t * 1024 + 128 * x + 16 * j + c0) = pk_bf16(a1.x, a1.y);
    };
    PeerBuf A, Bb;
    int t = wl;
    if (t >= M_TOK) return;
    i32x16 idn;
    load_ids(idn, t);
    issue(A, t, idn);
    load_ids(idn, tok(t + NW));
    for (; t < M_TOK; t += 2 * NW) {
        issue(Bb, tok(t + NW), idn);
        load_ids(idn, tok(t + 2 * NW));
        compute(A, t);
        issue(A, tok(t + 2 * NW), idn);
        load_ids(idn, tok(t + 3 * NW));
        if (t + NW < M_TOK) compute(Bb, t + NW);
    }
}
__device__ __forceinline__ void phase_ln2(const Params& p, const bf16_t* x1b, const bf16_t* ffn) {
    const int lane = threadIdx.x & 63, gw = blockIdx.x * (NTHREADS / 64) + (threadIdx.x >> 6), GW = gridDim.x * (NTHREADS / 64);
    f32x4 g[4], bb[4];
#pragma unroll
    for (int j = 0; j < 4; ++j) { g[j] = *(const f32x4*)(p.ln2_g + (j >> 1) * 512 + lane * 8 + (j & 1) * 4); bb[j] = *(const f32x4*)(p.ln2_b + (j >> 1) * 512 + lane * 8 + (j & 1) * 4); }
    for (int m0 = gw * 4; m0 < M_TOK; m0 += GW * 4) {
        u32x4 a[4][2], f[4][2];
#pragma unroll
        for (int rr = 0; rr < 4; ++rr)
#pragma unroll
            for (int j = 0; j < 2; ++j) { a[rr][j] = *(const u32x4*)(x1b + (size_t)(m0 + rr) * D_MODEL + j * 512 + lane * 8); f[rr][j] = *(const u32x4*)(ffn + (size_t)(m0 + rr) * D_MODEL + j * 512 + lane * 8); }
#pragma unroll
        for (int rr = 0; rr < 4; ++rr) {
            float* row = p.out + (size_t)(m0 + rr) * D_MODEL;
            f32x4 v[4] = {bf4_lo(a[rr][0]) * ALPHA + bf4_lo(f[rr][0]), bf4_hi(a[rr][0]) * ALPHA + bf4_hi(f[rr][0]), bf4_lo(a[rr][1]) * ALPHA + bf4_lo(f[rr][1]), bf4_hi(a[rr][1]) * ALPHA + bf4_hi(f[rr][1])};
            const float mean = wave_sum((sum4(v[0]) + sum4(v[1])) + (sum4(v[2]) + sum4(v[3]))) * (1.f / D_MODEL);
            float q = 0.f;
#pragma unroll
            for (int j = 0; j < 4; ++j) { v[j] -= mean; q += sum4(v[j] * v[j]); }
            const float rstd = rsqrtf(wave_sum(q) * (1.f / D_MODEL) + LN_EPS);
#pragma unroll
            for (int j = 0; j < 4; ++j) *(f32x4*)(row + (j >> 1) * 512 + lane * 8 + (j & 1) * 4) = v[j] * rstd * g[j] + bb[j];
        }
    }
}

constexpr int N_PHASES = 14;

namespace pg8 {
#define PG8_LAS __attribute__((address_space(3)))
constexpr int BM = 256, BK = 64, HALF = 128, HTB = HALF * BK * 2  , STAGE_BYTES = 8 * HTB, NXCD = 8, WGM = 8;

__host__ __device__ __forceinline__ int lds_byte(int r, int c) { const int st = (r >> 4) * 2 + (c >> 5), rr = r & 15, cc = c & 31, ob = rr * 64 + cc * 2; return st * 1024 + (ob ^ (((ob >> 9) & 1) << 5)); }
__host__ __device__ __forceinline__ void stage_rc(int b, int& R, int& C) { const int st = b / 1024, sb = b % 1024, swz = sb ^ (((sb >> 9) & 1) << 5); R = (st >> 1) * 16 + swz / 64; C = (st & 1) * 32 + (swz % 64) / 2; }
__host__ __device__ __forceinline__ int perm32(int rho) { const int n = rho >> 4, i = rho & 15; return 8 * (i >> 2) + 4 * n + (i & 3); }
struct Unit { int pm, pn; };
struct Gemm { const bf16_t* A; const bf16_t* Bt; int M, N, K; };
struct StaticOrder {
    int nM, nN, nwg, G, c;
    __host__ __device__ void init(int M, int N, int G_, int c_) { nM = M / BM; nN = N / BM; nwg = nM * nN; G = G_; c = c_; }
    __host__ __device__ bool next(int i, Unit& u) const {
        const long L = (long)i * G + c; if (L >= nwg) return false;
        int wgid = (int)L; { const int q = nwg / NXCD, r = nwg % NXCD, xcd = wgid % NXCD, off = wgid / NXCD; wgid = (xcd < r ? xcd * (q + 1) : r * (q + 1) + (xcd - r) * q) + off; }
        const int nig = WGM * nN, gid = wgid / nig, fm = gid * WGM, gsz = (nM - fm) < WGM ? (nM - fm) : WGM;
        u.pm = fm + ((wgid % nig) % gsz); u.pn = (wgid % nig) / gsz; return true;
    }
    __device__ __forceinline__ void a_ready(const Unit&) const {}
    __device__ __forceinline__ void done(const Unit&) const {}
};
struct EpiRope {
    static constexpr bool PERM = true, AFTER_DRAIN = false;
    bf16_t* O; const float* cs;
    __device__ __forceinline__ void operator()(const f32x4 (&acc)[2][2][4][2], const Unit& u, int wr, int wc, int fr, int fq) const {
        const int row0 = u.pm * BM + wr * 64 + fr, colb = u.pn * BM + wc * 32 + 8 * fq;
#pragma unroll
        for (int ai = 0; ai < 2; ++ai)
#pragma unroll
            for (int m = 0; m < 4; ++m) {
                const int row = row0 + ai * HALF + m * 16;
#pragma unroll
                for (int bj = 0; bj < 2; ++bj) {
                    const int col0 = colb + bj * HALF;
                    f32x4 v0 = acc[ai][bj][m][0], v1 = acc[ai][bj][m][1];
                    if (col0 < P_AV) {
                        const int i0 = (col0 & 63) >> 1;
                        const float4 c = *(const float4*)(cs + (size_t)row * 32 + i0), s = *(const float4*)(cs + (size_t)M_TOK * 32 + (size_t)row * 32 + i0);
                        const float sc = col0 < P_AK ? 0.125f : 1.f;
                        const f32x4 w0 = {(v0[0] * c.x - v0[1] * s.x) * sc, (v0[1] * c.x + v0[0] * s.x) * sc, (v0[2] * c.y - v0[3] * s.y) * sc, (v0[3] * c.y + v0[2] * s.y) * sc};
                        const f32x4 w1 = {(v1[0] * c.z - v1[1] * s.z) * sc, (v1[1] * c.z + v1[0] * s.z) * sc, (v1[2] * c.w - v1[3] * s.w) * sc, (v1[3] * c.w + v1[2] * s.w) * sc};
                        v0 = w0; v1 = w1;
                    }
                    u32x4 w; w.x = pk_bf16(v0[0], v0[1]); w.y = pk_bf16(v0[2], v0[3]); w.z = pk_bf16(v1[0], v1[1]); w.w = pk_bf16(v1[2], v1[3]);
                    *(u32x4*)(O + (size_t)row * NP_IN + col0) = w;
                }
            }
    }
};
struct EpiResid {
    static constexpr bool PERM = true, AFTER_DRAIN = false;
    bf16_t* Y; const float* X;
    __device__ __forceinline__ void operator()(const f32x4 (&acc)[2][2][4][2], const Unit& u, int wr, int wc, int fr, int fq) const {
        const int row0 = u.pm * BM + wr * 64 + fr, col0 = u.pn * BM + wc * 32 + 8 * fq;
#pragma unroll
        for (int ai = 0; ai < 2; ++ai)
#pragma unroll
            for (int m = 0; m < 4; ++m) {
                const size_t ro = (size_t)(row0 + ai * HALF + m * 16) * D_MODEL + col0;
#pragma unroll
                for (int bj = 0; bj < 2; ++bj) {
                    const f32x4 v0 = *(const f32x4*)(X + ro + bj * HALF) * ALPHA + acc[ai][bj][m][0], v1 = *(const f32x4*)(X + ro + bj * HALF + 4) * ALPHA + acc[ai][bj][m][1];
                    u32x4 w; w.x = pk_bf16(v0[0], v0[1]); w.y = pk_bf16(v0[2], v0[3]); w.z = pk_bf16(v1[0], v1[1]); w.w = pk_bf16(v1[2], v1[3]);
                    *(u32x4*)(Y + ro + bj * HALF) = w;
                }
            }
    }
};
struct EpiPlainBf16 {
    static constexpr bool PERM = true, AFTER_DRAIN = false;
    bf16_t* O; int ldc;
    __device__ __forceinline__ void operator()(const f32x4 (&acc)[2][2][4][2], const Unit& u, int wr, int wc, int fr, int fq) const {
        const int row0 = u.pm * BM + wr * 64 + fr, col0 = u.pn * BM + wc * 32 + 8 * fq;
#pragma unroll
        for (int ai = 0; ai < 2; ++ai)
#pragma unroll
            for (int m = 0; m < 4; ++m) { bf16_t* rowp = O + (size_t)(row0 + ai * HALF + m * 16) * ldc + col0;
#pragma unroll
                for (int bj = 0; bj < 2; ++bj) { const f32x4 v0 = acc[ai][bj][m][0], v1 = acc[ai][bj][m][1];
                    u32x4 w; w.x = pk_bf16(v0[0], v0[1]); w.y = pk_bf16(v0[2], v0[3]); w.z = pk_bf16(v1[0], v1[1]); w.w = pk_bf16(v1[2], v1[3]);
                    *(u32x4*)(rowp + bj * HALF) = w; } }
    }
};
template <class Epi, class Sched>
__device__ __forceinline__ void gemm_phase(PG8_LAS unsigned char* lds, const Gemm g, const Sched& S, const Epi& E) {
    const int tid = threadIdx.x, wid = __builtin_amdgcn_readfirstlane(tid >> 6), lane = tid & 63, wr = wid >> 2, wc = wid & 3, fr = lane & 15, fq = lane >> 4;
    const int K = g.K, nt = K / BK;
    unsigned voffA[2], voffB[2];
#pragma unroll
    for (int i = 0; i < 2; ++i) { int R, C; stage_rc(tid * 16 + i * 8192, R, C); const int Rb = Epi::PERM ? ((R & ~31) + perm32(R & 31)) : R;
        voffA[i] = (unsigned)(R * K + C) * 2u; voffB[i] = (unsigned)(Rb * K + C) * 2u; }
    const size_t kstep = (size_t)(BK * 2);
    const size_t hstep = (size_t)HALF * K * 2;
    const size_t tstep = 2 * hstep;
    const unsigned ldsw = (unsigned)wid * 1024u;
    const int aoff = lds_byte(wr * 64 + fr, fq * 8), boff = lds_byte(wc * 32 + fr, fq * 8);
#define PG8_SA(b, h) (((b) * 2 + (h)) * HTB)
#define PG8_SB(b, h) ((4 + (b) * 2 + (h)) * HTB)
#define PG8_STAGE(bufoff, gbase, voff) do { _Pragma("unroll") for (int _i = 0; _i < 2; ++_i) \
        __builtin_amdgcn_global_load_lds((const unsigned*)((const char*)(gbase) + (voff)[_i]), (PG8_LAS unsigned*)(lds + (bufoff) + ldsw + _i * 8192), 16, 0, 0); } while (0)
#define PG8_LDA(dst, b, h) do { _Pragma("unroll") for (int m = 0; m < 4; ++m) _Pragma("unroll") for (int k = 0; k < 2; ++k) dst[m][k] = *(const PG8_LAS bf16x8*)(lds + PG8_SA(b, h) + aoff + m * 2048 + k * 1024); } while (0)
#define PG8_LDB(dst, b, h) do { _Pragma("unroll") for (int n = 0; n < 2; ++n) _Pragma("unroll") for (int k = 0; k < 2; ++k) dst[n][k] = *(const PG8_LAS bf16x8*)(lds + PG8_SB(b, h) + boff + n * 2048 + k * 1024); } while (0)
#define PG8_MMA(ai, bj, At, Bt) do { __builtin_amdgcn_s_setprio(1); _Pragma("unroll") for (int m = 0; m < 4; ++m) _Pragma("unroll") for (int n = 0; n < 2; ++n) _Pragma("unroll") for (int k = 0; k < 2; ++k) \
        acc[ai][bj][m][n] = __builtin_amdgcn_mfma_f32_16x16x32_bf16(Bt[n][k], At[m][k], acc[ai][bj][m][n], 0, 0, 0); __builtin_amdgcn_s_setprio(0); } while (0)
#define PG8_WAIT_V(n) asm volatile("s_waitcnt vmcnt(" #n ")" ::: "memory")
#define PG8_WAIT_L(n) asm volatile("s_waitcnt lgkmcnt(" #n ")" ::: "memory")
#define PG8_BAR __builtin_amdgcn_s_barrier()
#define PG8_SCHED __builtin_amdgcn_sched_barrier(0)
    Unit cur, nxt; int ui = 0;
    if (!S.next(0, cur)) return;
    f32x4 acc[2][2][4][2];
#pragma unroll
    for (int a = 0; a < 2; ++a)
#pragma unroll
        for (int b = 0; b < 2; ++b)
#pragma unroll
            for (int m = 0; m < 4; ++m)
#pragma unroll
                for (int n = 0; n < 2; ++n) acc[a][b][m][n] = (f32x4){0.f, 0.f, 0.f, 0.f};
    bf16x8 At[4][2], B0[2][2], B1[2][2];
    const char* cA = (const char*)g.A + (size_t)cur.pm * tstep; const char* cB = (const char*)g.Bt + (size_t)cur.pn * tstep;
    S.a_ready(cur);
    PG8_STAGE(PG8_SB(0, 0), cB, voffB); PG8_STAGE(PG8_SA(0, 0), cA, voffA); PG8_STAGE(PG8_SB(0, 1), cB + hstep, voffB); PG8_STAGE(PG8_SA(0, 1), cA + hstep, voffA);
    if (wr == 1) PG8_BAR;
    PG8_WAIT_V(4); PG8_BAR;
    PG8_STAGE(PG8_SB(1, 0), cB + kstep, voffB); PG8_STAGE(PG8_SA(1, 0), cA + kstep, voffA); PG8_STAGE(PG8_SB(1, 1), cB + hstep + kstep, voffB);
    PG8_WAIT_V(6); PG8_BAR;
    for (;;) {
        const bool has_next = S.next(ui + 1, nxt);
        const char* nA = has_next ? (const char*)g.A + (size_t)nxt.pm * tstep : cA; const char* nB = has_next ? (const char*)g.Bt + (size_t)nxt.pn * tstep : cB;
        for (int t = 0; t < nt; t += 2) {
            const bool last = (t == nt - 2);
            const char* a1 = cA + (size_t)(t + 1) * kstep;
            const char* a2 = last ? nA : cA + (size_t)(t + 2) * kstep; const char* b2 = last ? nB : cB + (size_t)(t + 2) * kstep;
            const char* a3 = a2 + kstep; const char* b3 = b2 + kstep;
            if (last && has_next) S.a_ready(nxt);
            PG8_LDB(B0, 0, 0); PG8_SCHED; PG8_LDA(At, 0, 0); PG8_STAGE(PG8_SA(1, 1), a1 + hstep, voffA);
            PG8_WAIT_L(8); PG8_BAR; PG8_WAIT_L(0); PG8_MMA(0, 0, At, B0); PG8_BAR; PG8_SCHED;
            PG8_LDB(B1, 0, 1); PG8_STAGE(PG8_SB(0, 0), b2, voffB);
            PG8_BAR; PG8_WAIT_L(0); PG8_MMA(0, 1, At, B1); PG8_BAR;
            PG8_LDA(At, 0, 1); PG8_STAGE(PG8_SA(0, 0), a2, voffA);
            PG8_BAR; PG8_WAIT_L(0); PG8_MMA(1, 0, At, B0); PG8_BAR; PG8_SCHED;
            PG8_STAGE(PG8_SB(0, 1), b2 + hstep, voffB);
            PG8_WAIT_V(6); PG8_BAR; PG8_MMA(1, 1, At, B1); PG8_BAR;
            PG8_LDB(B0, 1, 0); PG8_SCHED; PG8_LDA(At, 1, 0); PG8_STAGE(PG8_SA(0, 1), a2 + hstep, voffA);
            PG8_WAIT_L(8); PG8_BAR; PG8_WAIT_L(0); PG8_MMA(0, 0, At, B0); PG8_BAR; PG8_SCHED;
            PG8_LDB(B1, 1, 1); PG8_STAGE(PG8_SB(1, 0), b3, voffB);
            PG8_BAR; PG8_WAIT_L(0); PG8_MMA(0, 1, At, B1); PG8_BAR;
            PG8_LDA(At, 1, 1); PG8_STAGE(PG8_SA(1, 0), a3, voffA);
            PG8_BAR; PG8_WAIT_L(0); PG8_MMA(1, 0, At, B0); PG8_BAR; PG8_SCHED;
            PG8_STAGE(PG8_SB(1, 1), b3 + hstep, voffB);
            PG8_WAIT_V(6); PG8_BAR; PG8_MMA(1, 1, At, B1); PG8_BAR;
        }
        if constexpr (!Epi::AFTER_DRAIN) { E(acc, cur, wr, wc, fr, fq); S.done(cur); }
        if (!has_next) break;
#pragma unroll
        for (int a = 0; a < 2; ++a)
#pragma unroll
            for (int b = 0; b < 2; ++b)
#pragma unroll
                for (int m = 0; m < 4; ++m)
#pragma unroll
                    for (int n = 0; n < 2; ++n) acc[a][b][m][n] = (f32x4){0.f, 0.f, 0.f, 0.f};
        cur = nxt; cA = nA; cB = nB; ++ui;
    }
    PG8_WAIT_V(0);
    if (wr == 0) PG8_BAR;
    PG8_BAR;
    if constexpr (Epi::AFTER_DRAIN) { E.fused(acc, cur, wr, wc, fr, fq, lds, wid, lane); S.done(cur); }
#undef PG8_SA
#undef PG8_SB
#undef PG8_STAGE
#undef PG8_LDA
#undef PG8_LDB
#undef PG8_MMA
#undef PG8_WAIT_V
#undef PG8_WAIT_L
#undef PG8_BAR
#undef PG8_SCHED
}
}

__global__ void __launch_bounds__(NTHREADS) mega_fwd(Params p) {
    __shared__ __attribute__((aligned(1024))) unsigned char smem[SMEM_BYTES + 16];
    if (threadIdx.x == 0) *(uint4*)(smem + SMEM_BYTES) = make_uint4(0u, 0u, 0u, 0u);
    __syncthreads();
    XcdBarrier bar; bar.bar = p.bar; bar.x = 0; bar.st = (volatile LAS unsigned*)(smem + SMEM_BYTES);
    if (p.ph_hi - p.ph_lo > 1) bar = xcd_barrier_post(p.bar, (volatile LAS unsigned*)(smem + SMEM_BYTES));
    bf16_t* qb = p.proj_b;
    bf16_t* x1b = p.proj_b + (size_t)M_TOK * 2048;
#ifndef DUP_PHASE
#define DUP_PHASE -1
#endif
#define PH(k) (p.ph_lo <= (k) && (k) < p.ph_hi)
#define SYNC(k) do { if (PH(k) && PH((k) + 1)) xcd_barrier(bar); } while (0)
#define RUN(k, ...) do { if (PH(k)) { __VA_ARGS__; if (DUP_PHASE == (k)) { xcd_barrier(bar); __VA_ARGS__; } } SYNC(k); } while (0)
    float* ph = (float*)qb;
    RUN(0, phase_prep(p, smem));
    RUN(1, { pg8::StaticOrder S; S.init(M_TOK, NP_IN, gridDim.x, blockIdx.x); pg8::EpiRope e{p.proj_b, p.rope_cs}; pg8::gemm_phase((PG8_LAS unsigned char*)smem, pg8::Gemm{p.xb, p.wt_in, M_TOK, NP_IN, 1024}, S, e); });
    RUN(2, phase_dn_prep(p, smem));
    RUN(3, { if (blockIdx.x < 96) { const int j = blockIdx.x, y = j >> 3, cs = (y >> 1) * 8 + (j & 7);
                                    dn_scan_seg<1>(p, smem, cs / 3, cs % 3, y & 1); } else { phase_attn(p, smem, 96); } });
    RUN(4, { if (blockIdx.x < 64) dn_scan_seg<0>(p, smem, blockIdx.x >> 2, blockIdx.x & 3, 0); else if (blockIdx.x < 128) phase_scan_l2_helper(p); else phase_tables8(p, 128); });
    RUN(5, phase_dn_norm(p));
    RUN(6, { pg8::StaticOrder S; S.init(M_TOK, 1024, gridDim.x, blockIdx.x); pg8::EpiResid e{(bf16_t*)p.out, p.x}; pg8::gemm_phase((PG8_LAS unsigned char*)smem, pg8::Gemm{p.xb, p.wt_out, M_TOK, 1024, 1024}, S, e); });
    RUN(7, phase_ln1(p, (const bf16_t*)p.out, x1b));
    RUN(8, { pg8::StaticOrder S; S.init(M_TOK, 2048, gridDim.x, blockIdx.x); pg8::EpiPlainBf16 e{qb, 2048}; pg8::gemm_phase((PG8_LAS unsigned char*)smem, pg8::Gemm{x1b, p.wt_q, M_TOK, 2048, 1024}, S, e); });
    RUN(9, phase_route(p, qb));
    RUN(10, phase_peer_u(p, x1b, ph));
    RUN(11, phase_peer_w(p, ph, p.wbuf));
    RUN(12, phase_peer_v(p, p.wbuf, (bf16_t*)ph));
    RUN(13, phase_ln2(p, x1b, (const bf16_t*)ph));
#undef RUN
#undef SYNC
#undef PH
}
}

#ifndef MK_LAUNCHES
#define MK_LAUNCHES 1
#endif

extern "C" void kernel_launch(void* const* d_in, const int* in_sizes, int n_in, void* d_out, int out_size, void* d_ws, size_t ws_size, hipStream_t stream) {
    static int grid_blocks = 0;
    if (!grid_blocks) {
        int dev = 0, cus = 0, per_cu = 0;
        (void)hipGetDevice(&dev);
        (void)hipDeviceGetAttribute(&cus, hipDeviceAttributeMultiprocessorCount, dev);
        (void)hipOccupancyMaxActiveBlocksPerMultiprocessor(&per_cu, mega_fwd, NTHREADS, 0);
        if (per_cu < 1) { fprintf(stderr, "kernel_launch: occupancy query reports %d blocks per CU\n", per_cu); per_cu = 1; }
        grid_blocks = cus * 1;
        (void)hipGetLastError();
    }
    Params p{};
    p.x = (const float*)d_in[0]; p.positions = (const int*)d_in[1]; p.w_in = (const float*)d_in[2]; p.sinks = (const float*)d_in[3];
    p.conv_w = (const float*)d_in[4]; p.a_log = (const float*)d_in[5]; p.dt_bias = (const float*)d_in[6]; p.dn_norm_g = (const float*)d_in[7];
    p.w_out = (const float*)d_in[8]; p.ln1_g = (const float*)d_in[9]; p.ln1_b = (const float*)d_in[10]; p.w_query = (const float*)d_in[11];
    p.sub_keys = (const float*)d_in[12]; p.peer_u = (const float*)d_in[13]; p.peer_v = (const float*)d_in[14]; p.ln2_g = (const float*)d_in[15]; p.ln2_b = (const float*)d_in[16];
    p.out = (float*)d_out;
    char* ws = (char*)d_ws; size_t off = 0;
    auto take = [&](size_t bytes) { char* r = ws + off; off += (bytes + 255) & ~(size_t)255; return r; };
    p.xb = (bf16_t*)take((size_t)M_TOK * 1024 * 2);
    p.proj_b = (bf16_t*)take((size_t)M_TOK * NP_IN * 2);
    p.odn_raw = (bf16_t*)d_out;
    {
        char* dn = take((size_t)2048 * (16384 * 3 + 8192 + 32768) + 8192);
        p.ids = (int*)dn; p.gates = (float*)(dn + (size_t)M_TOK * 128 * 4);
        p.wbuf = (float*)(dn + (size_t)M_TOK * 128 * 8);
        p.dn_negw = (bf16_t*)dn; p.dn_qd = (bf16_t*)(dn + (size_t)2048 * 16384); p.dn_kdt = (bf16_t*)(dn + (size_t)2048 * 16384 * 2);
        p.dn_qk = (bf16_t*)(dn + (size_t)2048 * 16384 * 3); p.dn_u = (bf16_t*)(dn + (size_t)2048 * (16384 * 3 + 8192)); p.dn_gl = (float*)(dn + (size_t)2048 * (16384 * 3 + 8192 + 32768));
    }
    p.wt_in = (bf16_t*)take((size_t)NP_IN * 1024 * 2);
    p.wt_out = (bf16_t*)take((size_t)1024 * 1024 * 2);
    p.wt_q = (bf16_t*)take((size_t)2048 * 1024 * 2);
    p.rope_cs = (float*)take((size_t)M_TOK * 64 * 4);
    p.sk_frag = (bf16_t*)take((size_t)16 * 128 * 128 * 2);
    p.tab8 = (unsigned char*)take((size_t)2 * 16384 * 1024);
    p.isc = (float*)take((size_t)2 * 16384 * 4);
    p.ln1_stats = (float*)take((size_t)M_TOK * 2 * 4);
    p.dn_PB = (float*)take((size_t)48 * 128 * 256 * 4);
    p.dn_S0 = (float*)take((size_t)64 * 128 * 128 * 4);
    p.bar = (unsigned*)take((size_t)(XCD_BAR_WORDS + 64 * 64) * 4);
    if (off > ws_size) { fprintf(stderr, "kernel_launch: workspace too small (%zu < %zu)\n", ws_size, off); return; }
    if (hipMemsetAsync(p.bar, 0, (size_t)(XCD_BAR_WORDS + 64 * 64) * 4, stream) != hipSuccess) { fprintf(stderr, "kernel_launch: memset of barrier words failed\n"); return; }
#if MK_LAUNCHES == 1
    p.ph_lo = 0; p.ph_hi = N_PHASES;
    void* args[] = {&p};
    hipError_t e = hipLaunchCooperativeKernel((void*)mega_fwd, dim3(grid_blocks), dim3(NTHREADS), args, 0, stream);
    if (e != hipSuccess) fprintf(stderr, "cooperative launch failed: %s (grid %d)\n", hipGetErrorString(e), grid_blocks);
#else
    for (int k = 0; k < N_PHASES; ++k) { p.ph_lo = k; p.ph_hi = k + 1; hipLaunchKernelGGL(mega_fwd, dim3(grid_blocks), dim3(NTHREADS), 0, stream, p); }
#endif
}
```

```cpp
#include <hip/hip_runtime.h>
#include <cstdio>
#include <cstdint>
#include <math.h>

namespace {
constexpr int D_MODEL = 1024, BATCH = 4, SEQ = 8192, M_TOK = BATCH * SEQ;
constexpr int IN_WIDTH = 2824, NP_IN = 3072;
constexpr int P_AQ = 0, P_AK = 512, P_AV = 640, P_DQ = 768, P_DK = 1280, P_DV = 1792, P_Z = 2304, P_B = 2816, P_A = 2820;
constexpr float ALPHA = 1.189207115002721f;
constexpr float LN_EPS = 1e-5f, RMS_EPS = 1e-6f, L2_EPS = 1e-6f;
constexpr int NTHREADS = 512;

typedef unsigned short bf16_t;
typedef short bf16x8 __attribute__((ext_vector_type(8)));
typedef float f32x16 __attribute__((ext_vector_type(16)));
typedef float f32x4 __attribute__((ext_vector_type(4)));
typedef unsigned u32x4 __attribute__((ext_vector_type(4)));
typedef unsigned u32x2 __attribute__((ext_vector_type(2)));

struct Params {
    const float* x; const int* positions; const float* w_in; const float* sinks; const float* conv_w; const float* a_log; const float* dt_bias;
    const float* dn_norm_g; const float* w_out; const float* ln1_g; const float* ln1_b; const float* w_query; const float* sub_keys;
    const float* peer_u; const float* peer_v; const float* ln2_g; const float* ln2_b;
    float* out;
    bf16_t* xb;
    bf16_t* proj_b;
    bf16_t* odn_raw;
    int* ids; float* gates;
    bf16_t* wt_in; bf16_t* wt_out; bf16_t* wt_q;
    float* rope_cs;
    bf16_t* dn_negw; bf16_t* dn_qd; bf16_t* dn_kdt; bf16_t* dn_qk; bf16_t* dn_u; float* dn_gl; float* dn_PB; float* dn_S0;
    bf16_t* sk_frag;
    float* ln1_stats;
    unsigned char* tab8; float* isc; float* wbuf;
    unsigned* bar;
    int ph_lo, ph_hi;
};

__device__ __forceinline__ float wave_sum(float v) {
#pragma unroll
    for (int o = 1; o < 64; o <<= 1) v += __shfl_xor(v, o);
    return v;
}
__device__ __forceinline__ float wave_max(float v) {
#pragma unroll
    for (int o = 1; o < 64; o <<= 1) v = fmaxf(v, __shfl_xor(v, o));
    return v;
}
__device__ __forceinline__ float bf2f(bf16_t u) { return __uint_as_float((unsigned)u << 16); }
__device__ __forceinline__ float bflo(unsigned u) { return __uint_as_float(u << 16); }
__device__ __forceinline__ float bfhi(unsigned u) { return __uint_as_float(u & 0xffff0000u); }
typedef __bf16 bf16x2_n __attribute__((ext_vector_type(2)));
__device__ __forceinline__ unsigned pk_bf16(float lo, float hi) { bf16x2_n v; v.x = (__bf16)lo; v.y = (__bf16)hi; return __builtin_bit_cast(unsigned, v); }
__device__ __forceinline__ float silu_f(float y) { return y * __builtin_amdgcn_rcpf(1.f + __expf(-y)); }


#define XB_TMO      128
#define XB_XCNT(j)  (256  + 64 * (j))
#define XB_XSUB(j)  (1280 + 64 * (j))
#define XB_XGEN(j)  (2304 + 64 * (j))
#define XB_TOP      3328
#define XB_TOPGEN   3392
#define XCD_BAR_WORDS 3456
#define XB_SPIN_CAP (1u << 27)
#define LAS __attribute__((address_space(3)))
__device__ __forceinline__ unsigned xb_ld(unsigned* p)              { return __hip_atomic_load(p, __ATOMIC_RELAXED, __HIP_MEMORY_SCOPE_AGENT); }
__device__ __forceinline__ unsigned xb_add(unsigned* p, unsigned v) { return __hip_atomic_fetch_add(p, v, __ATOMIC_RELAXED, __HIP_MEMORY_SCOPE_AGENT); }
__device__ __forceinline__ unsigned xb_xcc_id() { return (unsigned)__builtin_amdgcn_s_getreg((3 << 11) | 20) & 0xFu; }
#define XB_SPIN(cond, bar) do { unsigned _sp = 0; while (cond) { __builtin_amdgcn_s_sleep(1); \
    if ((++_sp & 255u) == 0u) { if (xb_ld(&(bar)[XB_TMO])) break; if (_sp > XB_SPIN_CAP) { atomicAdd(&(bar)[XB_TMO], 1u); break; } } } } while (0)
struct XcdBarrier { unsigned* bar; unsigned x; volatile LAS unsigned* st; };
__device__ __forceinline__ XcdBarrier xcd_barrier_post(unsigned* bar, volatile LAS unsigned* st) {
    XcdBarrier b; b.bar = bar; b.x = xb_xcc_id(); b.st = st;
    if (threadIdx.x == 0) (void)xb_add(&bar[XB_XCNT(b.x)], 1u);
    return b;
}
__device__ __forceinline__ void xcd_barrier_complete(unsigned* bar, unsigned x, unsigned& nloc, unsigned& nx) {
    const unsigned G = gridDim.x * gridDim.y * gridDim.z;
    unsigned sum, cnt, mine, sp = 0u;
    for (;;) {
        sum = 0u; cnt = 0u; mine = 0u;
#pragma unroll
        for (unsigned j = 0; j < 16; ++j) { const unsigned c = xb_ld(&bar[XB_XCNT(j)]); sum += c; cnt += (c > 0u) ? 1u : 0u; mine = (j == x) ? c : mine; }
        if (sum == G) break;
        __builtin_amdgcn_s_sleep(1);
        if ((++sp & 255u) == 0u) { if (xb_ld(&bar[XB_TMO])) break; if (sp > XB_SPIN_CAP) { atomicAdd(&bar[XB_TMO], 1u); break; } }
    }
    nloc = mine > 0u ? mine : 1u; nx = cnt > 0u ? cnt : 1u;
}
__device__ __forceinline__ void xcd_barrier(const XcdBarrier& b) {
    asm volatile("s_waitcnt vmcnt(0)" ::: "memory");
    __syncthreads();
    if (threadIdx.x == 0) {
        unsigned* bar = b.bar;
        __builtin_amdgcn_s_waitcnt(0);
        unsigned nloc = b.st[0], nx = b.st[1];
        if (nloc == 0u) { xcd_barrier_complete(bar, b.x, nloc, nx); b.st[0] = nloc; b.st[1] = nx; }
        const unsigned old = xb_add(&bar[XB_XSUB(b.x)], 1u);
        const unsigned gen = old / nloc;
        if (old + 1u == (gen + 1u) * nloc) {
            __builtin_amdgcn_fence(__ATOMIC_RELEASE, "agent");
            asm volatile("s_waitcnt vmcnt(0)" ::: "memory");
            const unsigned og = xb_add(&bar[XB_TOP], 1u);
            const unsigned tg = og / nx;
            if (og + 1u == (tg + 1u) * nx) xb_add(&bar[XB_TOPGEN], 1u);
            else XB_SPIN(xb_ld(&bar[XB_TOPGEN]) == tg, bar);
            __builtin_amdgcn_fence(__ATOMIC_ACQUIRE, "agent");
            xb_add(&bar[XB_XGEN(b.x)], 1u);
            asm volatile("s_waitcnt vmcnt(0)" ::: "memory");
        } else {
            XB_SPIN(xb_ld(&bar[XB_XGEN(b.x)]) == gen, bar);
            __builtin_amdgcn_fence(__ATOMIC_ACQUIRE, "agent");
            asm volatile("s_waitcnt vmcnt(0)" ::: "memory");
        }
    }
    __syncthreads();
}

__device__ __forceinline__ int inproj_old_col(int n) {
    if (n < P_AV) { const int pos = n & 63; return (n & ~63) + ((pos & 1) ? (pos >> 1) + 32 : (pos >> 1)); }
    if (n < 2304) return n;
    if (n < 2816) return 2312 + (n - 2304);
    if (n < 2824) return 2304 + (n - 2816);
    return -1;
}
__device__ __forceinline__ void transpose_item(const float* __restrict__ W, int N_src, bf16_t* __restrict__ WT, int K, int kb, int nb, bool permute, float* scr) {
    const int tid = threadIdx.x;
    const int nn = tid & 63, k8 = tid >> 6;
    const int n = nb * 64 + nn;
    const int oc = permute ? inproj_old_col(n) : n;
#pragma unroll
    for (int i = 0; i < 8; ++i) { const int kk = k8 + 8 * i; scr[kk * 65 + nn] = (oc >= 0) ? W[(size_t)(kb * 64 + kk) * N_src + oc] : 0.f; }
    __syncthreads();
    const int n2 = tid >> 3, c = tid & 7;
    const float* s = scr + (c * 8) * 65 + n2;
    u32x4 o; o.x = pk_bf16(s[0], s[65]); o.y = pk_bf16(s[2 * 65], s[3 * 65]); o.z = pk_bf16(s[4 * 65], s[5 * 65]); o.w = pk_bf16(s[6 * 65], s[7 * 65]);
    *(u32x4*)(WT + (size_t)(nb * 64 + n2) * K + kb * 64 + c * 8) = o;
    __syncthreads();
}
__device__ __forceinline__ void phase_prep(const Params& p, unsigned char* smem) {
    const int tid = threadIdx.x, G = gridDim.x, bid = blockIdx.x;
    float* scr = (float*)smem;
    constexpr int I_IN = 16 * (NP_IN / 64), I_OUT = 16 * 16, I_Q = 16 * 32;
    for (int it = bid; it < I_IN + I_OUT + I_Q; it += G) {
        int r = it;
        if (r < I_IN) { transpose_item(p.w_in, IN_WIDTH, p.wt_in, 1024, r / (NP_IN / 64), r % (NP_IN / 64), true, scr); continue; } r -= I_IN;
        if (r < I_OUT) { transpose_item(p.w_out, 1024, p.wt_out, 1024, r / 16, r % 16, false, scr); continue; } r -= I_OUT;
        transpose_item(p.w_query, 2048, p.wt_q, 1024, r / 32, r % 32, false, scr);
    }
    const size_t gt = (size_t)bid * NTHREADS + tid, GT = (size_t)G * NTHREADS;
    for (size_t i0 = gt; i0 < (size_t)M_TOK * 1024 / 8; i0 += GT * 4) {
        float4 a[4], b[4];
#pragma unroll
        for (int u = 0; u < 4; ++u) { const size_t i = i0 + u * GT; if (i < (size_t)M_TOK * 1024 / 8) { a[u] = *(const float4*)(p.x + i * 8); b[u] = *(const float4*)(p.x + i * 8 + 4); } }
#pragma unroll
        for (int u = 0; u < 4; ++u) { const size_t i = i0 + u * GT; if (i < (size_t)M_TOK * 1024 / 8) {
            u32x4 o; o.x = pk_bf16(a[u].x, a[u].y); o.y = pk_bf16(a[u].z, a[u].w); o.z = pk_bf16(b[u].x, b[u].y); o.w = pk_bf16(b[u].z, b[u].w);
            *(u32x4*)(p.xb + i * 8) = o; } }
    }
    for (size_t i = gt; i < (size_t)16 * 4 * 8 * 64; i += GT) {
        const int ln = (int)(i & 63), ks = (int)((i >> 6) & 7), kt = (int)((i >> 9) & 3), hp = (int)(i >> 11);
        const float* src = p.sub_keys + ((size_t)(hp * 128 + 32 * kt + (ln & 31))) * 128 + 16 * ks + 8 * (ln >> 5);
        const float4 a = *(const float4*)src, b = *(const float4*)(src + 4);
        u32x4 o; o.x = pk_bf16(a.x, a.y); o.y = pk_bf16(a.z, a.w); o.z = pk_bf16(b.x, b.y); o.w = pk_bf16(b.z, b.w);
        *(u32x4*)(p.sk_frag + i * 8) = o;
    }
    for (size_t i = gt; i < (size_t)M_TOK * 32; i += GT) {
        const int m = (int)(i >> 5), j = (int)(i & 31);
        const float inv_freq = powf(10000.0f, -(float)j / 32.0f);
        const float ang = (float)p.positions[m] * inv_freq;
        p.rope_cs[i] = cosf(ang); p.rope_cs[(size_t)M_TOK * 32 + i] = sinf(ang);
    }
}

constexpr int GK = 1024, GBK = 64, G_TILE_BYTES = 256 * 128;
constexpr int STG_STRIDE = 260;
constexpr int SMEM_BYTES = 147456;

__device__ __forceinline__ int swz(int row, int chunk) { return row * 128 + ((chunk ^ ((row >> 1) & 7)) << 4); }

struct EpiInProj {
    bf16_t* out; const float* cs;
    __device__ __forceinline__ void operator()(int m, int pn, int c8, const unsigned char* stg_row) const {
        const int col = pn * 256 + c8 * 8;
        u32x2 a0 = *(const u32x2*)(stg_row + c8 * 16), a1 = *(const u32x2*)(stg_row + c8 * 16 + 8);
        u32x4 o; o.x = a0.x; o.y = a0.y; o.z = a1.x; o.w = a1.y;
        if (col < P_AV) {
            const int d0 = col & 63, i0 = d0 & 31; const bool second = d0 >= 32;
            const int pc8 = second ? c8 - 4 : c8 + 4;
            const u32x2 b0 = *(const u32x2*)(stg_row + pc8 * 16), b1 = *(const u32x2*)(stg_row + pc8 * 16 + 8);
            const unsigned mine[4] = {a0.x, a0.y, a1.x, a1.y}, oth[4] = {b0.x, b0.y, b1.x, b1.y};
            const float* cp = cs + (size_t)m * 32 + i0; const float* sp = cs + (size_t)M_TOK * 32 + (size_t)m * 32 + i0;
            const float4 c0 = *(const float4*)cp, c1 = *(const float4*)(cp + 4), s0 = *(const float4*)sp, s1 = *(const float4*)(sp + 4);
            const float cc[8] = {c0.x, c0.y, c0.z, c0.w, c1.x, c1.y, c1.z, c1.w}, ss[8] = {s0.x, s0.y, s0.z, s0.w, s1.x, s1.y, s1.z, s1.w};
            const float scale = col < P_AK ? 0.125f : 1.f;
            float r[8];
#pragma unroll
            for (int j = 0; j < 8; ++j) {
                const float me = (j & 1) ? bfhi(mine[j >> 1]) : bflo(mine[j >> 1]);
                const float ot = (j & 1) ? bfhi(oth[j >> 1]) : bflo(oth[j >> 1]);
                r[j] = (second ? (me * cc[j] + ot * ss[j]) : (me * cc[j] - ot * ss[j])) * scale;
            }
            o.x = pk_bf16(r[0], r[1]); o.y = pk_bf16(r[2], r[3]); o.z = pk_bf16(r[4], r[5]); o.w = pk_bf16(r[6], r[7]);
        }
        *(u32x4*)(out + (size_t)m * NP_IN + col) = o;
    }
};
struct EpiOutProj {
    float* y; const float* x;
    __device__ __forceinline__ void operator()(int m, int pn, int c8, const unsigned char* stg_row) const {
        const int col = pn * 256 + c8 * 8;
        const u32x2 a0 = *(const u32x2*)(stg_row + c8 * 16), a1 = *(const u32x2*)(stg_row + c8 * 16 + 8);
        const float4 x0 = *(const float4*)(x + (size_t)m * 1024 + col), x1 = *(const float4*)(x + (size_t)m * 1024 + col + 4);
        *(float4*)(y + (size_t)m * 1024 + col) = make_float4(ALPHA * x0.x + bflo(a0.x), ALPHA * x0.y + bfhi(a0.x), ALPHA * x0.z + bflo(a0.y), ALPHA * x0.w + bfhi(a0.y));
        *(float4*)(y + (size_t)m * 1024 + col + 4) = make_float4(ALPHA * x1.x + bflo(a1.x), ALPHA * x1.y + bfhi(a1.x), ALPHA * x1.z + bflo(a1.y), ALPHA * x1.w + bfhi(a1.y));
    }
};
struct EpiBf16 {
    bf16_t* out; int ldc;
    __device__ __forceinline__ void operator()(int m, int pn, int c8, const unsigned char* stg_row) const {
        const int col = pn * 256 + c8 * 8;
        const u32x2 a0 = *(const u32x2*)(stg_row + c8 * 16), a1 = *(const u32x2*)(stg_row + c8 * 16 + 8);
        u32x4 o; o.x = a0.x; o.y = a0.y; o.z = a1.x; o.w = a1.y;
        *(u32x4*)(out + (size_t)m * ldc + col) = o;
    }
};

template <class EPI>
__device__ __forceinline__ void gemm_phase(const bf16_t* __restrict__ A, const bf16_t* __restrict__ Bt, int M, int N, const EPI& epi, unsigned char* smem) {
    const int tid = threadIdx.x, lane = tid & 63, wave = tid >> 6, r = lane & 31, h = lane >> 5;
    const int wm = wave >> 2, wn = wave & 3;
    const int nM = M / 256, nN = N / 256, ntiles = nM * nN;
    const int gx = gridDim.x, nxg = (gx % 8 == 0 && ntiles % 8 == 0) ? 8 : 1, bpg = gx / nxg, tpg = ntiles / nxg;
    const int grp = blockIdx.x % nxg, bin = blockIdx.x / nxg;
    const int grow = 16 * wave + (lane >> 2), gch = (lane & 3) ^ ((grow >> 2) & 3);
    const unsigned goff = (unsigned)(grow * GK + gch * 8) * 2u;
    constexpr int NKT = GK / 32, STG = 32768;
#define G_DMA1(kt_, Ag_, Bg_, op_, i_) do { const unsigned char* sb_ = (const unsigned char*)((op_) ? (Bg_) : (Ag_)) + (kt_) * 64; \
            __builtin_amdgcn_global_load_lds((const unsigned*)(sb_ + (i_) * (128 * GK * 2) + goff), (unsigned*)(smem + ((kt_) & 3) * STG + wave * 1024 + (op_) * 16384 + (i_) * 8192), 16, 0, 0); } while (0)
#define G_STAGE(kt_, Ag_, Bg_) do { G_DMA1(kt_, Ag_, Bg_, 0, 0); G_DMA1(kt_, Ag_, Bg_, 1, 0); G_DMA1(kt_, Ag_, Bg_, 0, 1); G_DMA1(kt_, Ag_, Bg_, 1, 1); } while (0)
#define G_SWZ32(row_, c_) ((row_) * 64 + ((((c_) ^ ((row_) >> 2)) & 3) << 4))
#define G_COMPUTE(kt_, Ag_, Bg_, pf_) do { const unsigned char* la_ = smem + ((kt_) & 3) * STG; const unsigned char* lb_ = la_ + 16384; \
            bf16x8 af_[2][4], bf_[2][2]; \
            _Pragma("unroll") for (int ks_ = 0; ks_ < 2; ++ks_) { \
                _Pragma("unroll") for (int i_ = 0; i_ < 4; ++i_) af_[ks_][i_] = *(const bf16x8*)(la_ + G_SWZ32(wm * 128 + i_ * 32 + r, ks_ * 2 + h)); \
                _Pragma("unroll") for (int j_ = 0; j_ < 2; ++j_) bf_[ks_][j_] = *(const bf16x8*)(lb_ + G_SWZ32(wn * 64 + j_ * 32 + r, ks_ * 2 + h)); } \
            __builtin_amdgcn_sched_barrier(0); \
            _Pragma("unroll") for (int g_ = 0; g_ < 4; ++g_) { const int ks_ = g_ >> 1, j_ = g_ & 1; \
                _Pragma("unroll") for (int i_ = 0; i_ < 4; ++i_) acc[j_][i_] = __builtin_amdgcn_mfma_f32_32x32x16_bf16(bf_[ks_][j_], af_[ks_][i_], acc[j_][i_], 0, 0, 0); \
                __builtin_amdgcn_sched_barrier(0); \
                if (pf_) G_DMA1((kt_) + 3, Ag_, Bg_, g_ & 1, g_ >> 1); \
                __builtin_amdgcn_sched_barrier(0); } } while (0)
#define G_RAWBAR() do { asm volatile("s_waitcnt lgkmcnt(0)" ::: "memory"); __builtin_amdgcn_s_barrier(); asm volatile("" ::: "memory"); } while (0)
    for (int tt = bin; tt < tpg; tt += bpg) {
        const int t = grp * tpg + tt;
        const int pm = t / nN, pn = t % nN;
        const bf16_t* Ag = A + (size_t)pm * 256 * GK; const bf16_t* Bg = Bt + (size_t)pn * 256 * GK;
        f32x16 acc[2][4];
#pragma unroll
        for (int j = 0; j < 2; ++j)
#pragma unroll
            for (int i = 0; i < 4; ++i)
#pragma unroll
                for (int e = 0; e < 16; ++e) acc[j][i][e] = 0.f;
        G_RAWBAR();
        G_STAGE(0, Ag, Bg); G_STAGE(1, Ag, Bg); G_STAGE(2, Ag, Bg);
        for (int kt = 0; kt < NKT; ++kt) {
            if (kt + 2 < NKT) asm volatile("s_waitcnt vmcnt(8)" ::: "memory");
            else if (kt + 1 < NKT) asm volatile("s_waitcnt vmcnt(4)" ::: "memory");
            else asm volatile("s_waitcnt vmcnt(0)" ::: "memory");
            G_RAWBAR();
            G_COMPUTE(kt, Ag, Bg, kt + 3 < NKT);
        }
        G_RAWBAR();
#pragma unroll
        for (int j = 0; j < 2; ++j)
#pragma unroll
            for (int i = 0; i < 4; ++i)
#pragma unroll
                for (int g = 0; g < 4; ++g) {
                    u32x2 v; v.x = pk_bf16(acc[j][i][4 * g], acc[j][i][4 * g + 1]); v.y = pk_bf16(acc[j][i][4 * g + 2], acc[j][i][4 * g + 3]);
                    *(u32x2*)(smem + (size_t)(wm * 128 + i * 32 + r) * (STG_STRIDE * 2) + (wn * 64 + j * 32 + 8 * g + 4 * h) * 2) = v;
                }
        __syncthreads();
        const int erow = tid >> 5, ec8 = tid & 31;
#pragma unroll 4
        for (int ps = 0; ps < 16; ++ps) { const int row = ps * 16 + erow; epi(pm * 256 + row, pn, ec8, smem + (size_t)row * (STG_STRIDE * 2)); }
    }
#undef G_DMA1
#undef G_STAGE
#undef G_COMPUTE
#undef G_SWZ32
#undef G_RAWBAR
    __syncthreads();
}


constexpr int DN_CH_BYTES = 73728;

constexpr int DP_QS = 0, DP_KS = 16384, DP_TI = 0, DP_Q = 17408, DP_TB = 21632;
constexpr int DP_RT = 32768;
constexpr int DP_AM = 69632;
constexpr int DP_KDT = 87040;
constexpr int DP_QK = 104448;
constexpr int DP_WI = 113152;
constexpr int DP_SM = 130048;

__device__ __forceinline__ void phase_dn_prep(const Params& p, unsigned char* smem) {
    const int tid0 = threadIdx.x;
    float* sbeta = (float*)(smem + DP_SM); float* sgc = sbeta + 64; float* segc = sbeta + 128; float* sekd = sbeta + 192;
    float* Am = (float*)(smem + DP_AM); float* Ti = (float*)(smem + DP_TI); float* Qb = (float*)(smem + DP_Q);
    bf16_t* Tb = (bf16_t*)(smem + DP_TB); bf16_t* Rt = (bf16_t*)(smem + DP_RT);
    bf16_t* kdt = (bf16_t*)(smem + DP_KDT); bf16_t* qki = (bf16_t*)(smem + DP_QK); bf16_t* wim = (bf16_t*)(smem + DP_WI);
    u32x4 xin[7][2]; float pre_b = 0.f, pre_a = 0.f;
    auto dn_fetch = [&](int cj) {
        const int tq = tid0, bhj = cj >> 7, nj = cj & 127, hj = bhj & 3;
        const bf16_t* prj = p.proj_b + (size_t)(bhj >> 2) * SEQ * NP_IN;
        if (tq < 384) {
            const int mat = tq >> 7, rg = (tq >> 3) & 15, sg = tq & 7;
            const int colbase = (mat == 0 ? P_DQ : (mat == 1 ? P_DK : P_DV)) + hj * 128 + sg * 16;
#pragma unroll
            for (int rr = 0; rr < 7; ++rr) {
                const int tt = nj * 64 + 4 * rg - 3 + rr;
                if (tt >= 0) { xin[rr][0] = *(const u32x4*)(prj + (size_t)tt * NP_IN + colbase); xin[rr][1] = *(const u32x4*)(prj + (size_t)tt * NP_IN + colbase + 8); }
                else { xin[rr][0] = (u32x4){0u, 0u, 0u, 0u}; xin[rr][1] = (u32x4){0u, 0u, 0u, 0u}; }
            }
        }
        if (tq < 64) { const size_t m = (size_t)(nj * 64 + tq); pre_b = bf2f(prj[m * NP_IN + P_B + hj]); pre_a = bf2f(prj[m * NP_IN + P_A + hj]); }
    };
    if (blockIdx.x < 16 * 128) dn_fetch(blockIdx.x);
    for (int ci = blockIdx.x; ci < 16 * 128; ci += gridDim.x) {
        int tid = tid0; asm volatile("" : "+v"(tid));
        const int lane = tid & 63, wave = tid >> 6;
        const int bh = ci >> 7, n = ci & 127, b = bh >> 2, h = bh & 3;
        const bf16_t* prow = p.proj_b + (size_t)b * SEQ * NP_IN;
        if (wave == 0) {
            const float braw = pre_b, araw = pre_a;
            const float beta = 1.f / (1.f + expf(-braw));
            const float xx = araw + p.dt_bias[h];
            const float sp = xx > 20.f ? xx : log1pf(expf(xx));
            float g = -expf(p.a_log[h]) * sp;
#pragma unroll
            for (int o = 1; o < 64; o <<= 1) { const float up = __shfl_up(g, o); if (lane >= o) g += up; }
            const float g63 = __shfl(g, 63);
            sbeta[lane] = beta; sgc[lane] = g; segc[lane] = expf(g); sekd[lane] = expf(g63 - g);
            if (lane == 63) p.dn_gl[ci] = expf(g63);
        }
        __syncthreads();
        if (tid < 384) {
            const int mat = tid >> 7, rg = (tid >> 3) & 15, sg = tid & 7, c0 = sg * 16, i0 = 4 * rg;
            const int colbase = (mat == 0 ? P_DQ : (mat == 1 ? P_DK : P_DV)) + h * 128 + c0;
            float wgt[4][16];
#pragma unroll
            for (int j = 0; j < 4; ++j) {
                const float* wp = p.conv_w + j * 1536 + mat * 512 + h * 128 + c0;
#pragma unroll
                for (int q4 = 0; q4 < 4; ++q4) { const float4 w4 = *(const float4*)(wp + 4 * q4); wgt[j][4 * q4] = w4.x; wgt[j][4 * q4 + 1] = w4.y; wgt[j][4 * q4 + 2] = w4.z; wgt[j][4 * q4 + 3] = w4.w; }
            }
#pragma unroll
            for (int ro = 0; ro < 4; ++ro) {
                const int i = i0 + ro, ix = i ^ (sg << 3);
                float acc[16];
#pragma unroll
                for (int cc = 0; cc < 16; ++cc) acc[cc] = 0.f;
#pragma unroll
                for (int j = 0; j < 4; ++j) {
                    const u32x4 x0 = xin[ro + j][0], x1 = xin[ro + j][1];
                    const unsigned xs[8] = {x0.x, x0.y, x0.z, x0.w, x1.x, x1.y, x1.z, x1.w};
#pragma unroll
                    for (int c2 = 0; c2 < 8; ++c2) { acc[2 * c2] = fmaf(wgt[j][2 * c2], bflo(xs[c2]), acc[2 * c2]); acc[2 * c2 + 1] = fmaf(wgt[j][2 * c2 + 1], bfhi(xs[c2]), acc[2 * c2 + 1]); }
                }
                float ss = 0.f;
#pragma unroll
                for (int cc = 0; cc < 16; ++cc) { acc[cc] = silu_f(acc[cc]); ss = fmaf(acc[cc], acc[cc], ss); }
                const float beta_i = sbeta[i], egc_i = segc[i], ekd_i = sekd[i];
                if (mat < 2) {
                    ss += __shfl_xor(ss, 1); ss += __shfl_xor(ss, 2); ss += __shfl_xor(ss, 4);
                    const float rs = rsqrtf(ss + L2_EPS) * (mat == 0 ? 0.08838834764831845f : 1.f);
#pragma unroll
                    for (int cc = 0; cc < 16; ++cc) acc[cc] *= rs;
                    unsigned char* img = smem + (mat == 0 ? DP_QS : DP_KS) + i * 256;
                    u32x4 c0v, c1v;
                    c0v.x = pk_bf16(acc[0], acc[1]); c0v.y = pk_bf16(acc[2], acc[3]); c0v.z = pk_bf16(acc[4], acc[5]); c0v.w = pk_bf16(acc[6], acc[7]);
                    c1v.x = pk_bf16(acc[8], acc[9]); c1v.y = pk_bf16(acc[10], acc[11]); c1v.z = pk_bf16(acc[12], acc[13]); c1v.w = pk_bf16(acc[14], acc[15]);
                    *(u32x4*)(img + (((2 * sg) ^ (i & 15)) << 4)) = c0v;
                    *(u32x4*)(img + (((2 * sg + 1) ^ (i & 15)) << 4)) = c1v;
                }
                if (mat == 0) {
                    u32x4 p0, p1;
                    p0.x = pk_bf16(acc[0] * egc_i, acc[1] * egc_i); p0.y = pk_bf16(acc[2] * egc_i, acc[3] * egc_i); p0.z = pk_bf16(acc[8] * egc_i, acc[9] * egc_i); p0.w = pk_bf16(acc[10] * egc_i, acc[11] * egc_i);
                    p1.x = pk_bf16(acc[4] * egc_i, acc[5] * egc_i); p1.y = pk_bf16(acc[6] * egc_i, acc[7] * egc_i); p1.z = pk_bf16(acc[12] * egc_i, acc[13] * egc_i); p1.w = pk_bf16(acc[14] * egc_i, acc[15] * egc_i);
                    bf16_t* dst = p.dn_qd + ((size_t)(ci * 16 + (i >> 5) * 8 + sg) * 64) * 8;
                    *(u32x4*)(dst + (size_t)(i & 31) * 8) = p0;
                    *(u32x4*)(dst + (size_t)(32 + (i & 31)) * 8) = p1;
                } else if (mat == 1) {
                    const float sc = beta_i * egc_i;
#pragma unroll
                    for (int cc = 0; cc < 16; ++cc) {
                        Rt[(128 + c0 + cc) * 72 + ix] = (bf16_t)(pk_bf16(acc[cc] * sc, 0.f) & 0xffffu);
                        kdt[(c0 + cc) * 68 + ix] = (bf16_t)(pk_bf16(acc[cc] * ekd_i, 0.f) & 0xffffu);
                    }
                } else {
#pragma unroll
                    for (int cc = 0; cc < 16; ++cc) Rt[(c0 + cc) * 72 + ix] = (bf16_t)(pk_bf16(acc[cc] * beta_i, 0.f) & 0xffffu);
                }
            }
        }
        if (ci + (int)gridDim.x < 16 * 128) dn_fetch(ci + (int)gridDim.x);
        __syncthreads();
        {
            const int mat = wave >> 2, ti = (wave >> 1) & 1, tj = wave & 1, r = lane & 31, hh = lane >> 5;
            const unsigned char* ai = smem + (mat ? DP_QS : DP_KS) + (ti * 32 + r) * 256;
            const unsigned char* bi = smem + DP_KS + (tj * 32 + r) * 256;
            f32x16 d;
#pragma unroll
            for (int e = 0; e < 16; ++e) d[e] = 0.f;
#pragma unroll
            for (int ks = 0; ks < 8; ++ks) {
                const bf16x8 af = *(const bf16x8*)(ai + (((2 * ks + hh) ^ (r & 15)) << 4));
                const bf16x8 bf = *(const bf16x8*)(bi + (((2 * ks + hh) ^ (r & 15)) << 4));
                d = __builtin_amdgcn_mfma_f32_32x32x16_bf16(af, bf, d, 0, 0, 0);
            }
            const int j = tj * 32 + r; const float gcj = sgc[j];
#pragma unroll
            for (int e = 0; e < 16; ++e) {
                const int i = ti * 32 + (e & 3) + 8 * (e >> 2) + 4 * hh;
                const float dec = __expf(fminf(sgc[i] - gcj, 0.f));
                if (mat == 0) Am[i * 68 + j] = (j < i) ? sbeta[i] * d[e] * dec : 0.f;
                else qki[i * 68 + j] = (bf16_t)(pk_bf16((j <= i) ? d[e] * dec : 0.f, 0.f) & 0xffffu);
            }
        }
        __syncthreads();
        if (tid < 64) {
            const int bk = tid >> 4, c = tid & 15;
            const float* Ab = Am + (16 * bk) * 68 + 16 * bk;
            float X[16];
#pragma unroll
            for (int i = 0; i < 16; ++i) {
                float sacc = 0.f;
#pragma unroll
                for (int j = 0; j < i; ++j) sacc = fmaf(Ab[i * 68 + j], X[j], sacc);
                X[i] = ((i == c) ? 1.f : 0.f) - sacc;
            }
#pragma unroll
            for (int i = 0; i < 16; ++i) Ti[(16 * bk + i) * 68 + 16 * bk + c] = X[i];
        } else {
            for (int z = tid - 64; z < 6 * 256; z += 448) {
                const int blk = z >> 8, e2 = z & 255, bi = blk < 3 ? 0 : (blk < 5 ? 1 : 2), bj = blk < 3 ? blk + 1 : (blk < 5 ? blk - 1 : 3);
                Ti[(16 * bi + (e2 >> 4)) * 68 + 16 * bj + (e2 & 15)] = 0.f;
            }
        }
        __syncthreads();
        {
            const int w2 = tid >> 8, o = tid & 255, ri = o >> 4, cj = o & 15, r0 = 16 * (2 * w2 + 1), c0 = 16 * (2 * w2);
            float sacc = 0.f;
#pragma unroll
            for (int k = 0; k < 16; ++k) sacc = fmaf(Am[(r0 + ri) * 68 + c0 + k], Ti[(c0 + k) * 68 + c0 + cj], sacc);
            Qb[w2 * 272 + ri * 17 + cj] = sacc;
        }
        __syncthreads();
        {
            const int w2 = tid >> 8, o = tid & 255, ri = o >> 4, cj = o & 15, r0 = 16 * (2 * w2 + 1), c0 = 16 * (2 * w2);
            float sacc = 0.f;
#pragma unroll
            for (int k = 0; k < 16; ++k) sacc = fmaf(Ti[(r0 + ri) * 68 + r0 + k], Qb[w2 * 272 + k * 17 + cj], sacc);
            Ti[(r0 + ri) * 68 + c0 + cj] = -sacc;
        }
        __syncthreads();
        float q3[2];
#pragma unroll
        for (int q = 0; q < 2; ++q) {
            const int o = tid + 512 * q, ri = o >> 5, cj = o & 31;
            float sacc = 0.f;
#pragma unroll
            for (int k = 0; k < 32; ++k) sacc = fmaf(Am[(32 + ri) * 68 + k], Ti[k * 68 + cj], sacc);
            q3[q] = sacc;
        }
#pragma unroll
        for (int q = 0; q < 2; ++q) { const int o = tid + 512 * q; Qb[(o >> 5) * 33 + (o & 31)] = q3[q]; }
        __syncthreads();
#pragma unroll
        for (int q = 0; q < 2; ++q) {
            const int o = tid + 512 * q, ri = o >> 5, cj = o & 31;
            float sacc = 0.f;
#pragma unroll
            for (int k = 0; k < 32; ++k) sacc = fmaf(Ti[(32 + ri) * 68 + 32 + k], Qb[k * 33 + cj], sacc);
            q3[q] = -sacc;
        }
        __syncthreads();
#pragma unroll
        for (int q = 0; q < 2; ++q) { const int o = tid + 512 * q; Ti[(32 + (o >> 5)) * 68 + (o & 31)] = q3[q]; }
        __syncthreads();
#pragma unroll
        for (int q = 0; q < 4; ++q) {
            const int o2 = tid + 512 * q, ri = o2 >> 5, c2 = (o2 & 31) * 2;
            *(unsigned*)(Tb + ri * 72 + c2) = pk_bf16(Ti[ri * 68 + c2], Ti[ri * 68 + c2 + 1]);
        }
        __syncthreads();
        {
            const int ct = wave, r = lane & 31, hh = lane >> 5;
            f32x16 xacc[2];
#pragma unroll
            for (int T = 0; T < 2; ++T)
#pragma unroll
                for (int e = 0; e < 16; ++e) xacc[T][e] = 0.f;
#pragma unroll
            for (int ks = 0; ks < 4; ++ks) {
                const bf16x8 bfr = *(const bf16x8*)(Rt + (32 * ct + r) * 72 + (((2 * ks + hh) ^ (((32 * ct + r) >> 4) & 7)) << 3));
#pragma unroll
                for (int T = 0; T < 2; ++T) {
                    const bf16x8 afr = *(const bf16x8*)(Tb + (32 * T + r) * 72 + 16 * ks + 8 * hh);
                    xacc[T] = __builtin_amdgcn_mfma_f32_32x32x16_bf16(afr, bfr, xacc[T], 0, 0, 0);
                }
            }
            if (ct < 4) {
#pragma unroll
                for (int T = 0; T < 2; ++T)
#pragma unroll
                    for (int hf = 0; hf < 2; ++hf) {
                        u32x4 o; o.x = pk_bf16(xacc[T][8 * hf], xacc[T][8 * hf + 1]); o.y = pk_bf16(xacc[T][8 * hf + 2], xacc[T][8 * hf + 3]);
                        o.z = pk_bf16(xacc[T][8 * hf + 4], xacc[T][8 * hf + 5]); o.w = pk_bf16(xacc[T][8 * hf + 6], xacc[T][8 * hf + 7]);
                        *(u32x4*)(p.dn_u + ((size_t)(((ci * 4 + ct) * 2 + T) * 2 + hf) * 64 + lane) * 8) = o;
                    }
            } else {
                const int dd = 32 * (ct - 4) + r;
#pragma unroll
                for (int T = 0; T < 2; ++T)
#pragma unroll
                    for (int e = 0; e < 16; ++e) wim[(32 * T + (e & 3) + 8 * (e >> 2) + 4 * hh) * 132 + dd] = (bf16_t)(pk_bf16(-xacc[T][e], 0.f) & 0xffffu);
            }
#pragma unroll
            for (int q = 0; q < 3; ++q) {
                const int pc = tid + 512 * q;
                if (pc < 512) {
                    const int f = pc >> 6, ln = pc & 63, r2 = ln & 31, h2 = ln >> 5, rt = f >> 2, ks = f & 3;
                    const bf16_t* src = qki + (32 * rt + r2) * 68 + 16 * ks + 4 * h2;
                    const u32x2 lo = *(const u32x2*)src, hi = *(const u32x2*)(src + 8);
                    u32x4 o; o.x = lo.x; o.y = lo.y; o.z = hi.x; o.w = hi.y;
                    *(u32x4*)(p.dn_qk + ((size_t)(ci * 8 + f) * 64 + ln) * 8) = o;
                } else {
                    const int pc2 = pc - 512, f = pc2 >> 6, ln = pc2 & 63, r2 = ln & 31, h2 = ln >> 5, rt = f >> 2, ks = f & 3;
                    const int dd2 = 32 * rt + r2, sx = ((dd2 >> 4) & 7) << 3, i0 = 16 * ks + 4 * h2;
                    const u32x2 lo = *(const u32x2*)(kdt + dd2 * 68 + (i0 ^ sx)), hi = *(const u32x2*)(kdt + dd2 * 68 + ((i0 + 8) ^ sx));
                    u32x4 o; o.x = lo.x; o.y = lo.y; o.z = hi.x; o.w = hi.y;
                    *(u32x4*)(p.dn_kdt + ((size_t)(ci * 16 + f) * 64 + ln) * 8) = o;
                }
            }
        }
        __syncthreads();
#pragma unroll
        for (int q = 0; q < 2; ++q) {
            const int pc = tid + 512 * q, f = pc >> 6, ln = pc & 63, r = ln & 31, hh = ln >> 5, rt = f >> 3, ks = f & 7;
            const bf16_t* src = wim + (32 * rt + r) * 132 + 16 * ks + 4 * hh;
            const u32x2 lo = *(const u32x2*)src, hi = *(const u32x2*)(src + 8);
            u32x4 o; o.x = lo.x; o.y = lo.y; o.z = hi.x; o.w = hi.y;
            *(u32x4*)(p.dn_negw + ((size_t)(ci * 16 + f) * 64 + ln) * 8) = o;
        }
    }
    __syncthreads();
}

__device__ __forceinline__ bf16x8 pack8(const f32x16& x, int s) {
    u32x4 v;
    v.x = pk_bf16(x[8 * s], x[8 * s + 1]); v.y = pk_bf16(x[8 * s + 2], x[8 * s + 3]); v.z = pk_bf16(x[8 * s + 4], x[8 * s + 5]); v.w = pk_bf16(x[8 * s + 6], x[8 * s + 7]);
    return __builtin_bit_cast(bf16x8, v);
}
#define LDS_BARRIER() do { asm volatile("s_waitcnt lgkmcnt(0)" ::: "memory"); __builtin_amdgcn_s_barrier(); asm volatile("" ::: "memory"); } while (0)
__device__ __forceinline__ const bf16_t* dn_piece_src(const Params& p, int ci, int pc) {
    return pc < 1024 ? p.dn_negw + ((size_t)ci * 1024 + pc) * 8 : pc < 2048 ? p.dn_qd + ((size_t)ci * 1024 + (pc - 1024)) * 8
         : pc < 3072 ? p.dn_kdt + ((size_t)ci * 1024 + (pc - 2048)) * 8 : pc < 3584 ? p.dn_qk + ((size_t)ci * 512 + (pc - 3072)) * 8 : p.dn_u + ((size_t)ci * 1024 + (pc - 3584)) * 8;
}
constexpr int DN_SEG = 32;
template <int PASS> __device__ __forceinline__ int dn_lpiece(int q) { return PASS == 0 ? q : (q < 1024 ? q : (q < 2048 ? q + 1024 : q + 1536)); }
template <int PASS>
__device__ __forceinline__ void dn_scan_seg(const Params& p, unsigned char* smem, int bh, int seg, int half) {
    constexpr int NPC = PASS == 0 ? 4608 : 3072, LPT = NPC / 256, PPT = NPC / 512;
    const int tid = threadIdx.x, lane = tid & 63, wave = tid >> 6, r = lane & 31, hh = lane >> 5;
    const int b = bh >> 2, h = bh & 3, ci0 = bh * 128 + seg * DN_SEG;
#pragma unroll
    for (int q = 0; q < PPT; ++q) { const int pc = dn_lpiece<PASS>(tid + 512 * q); *(u32x4*)(smem + pc * 16) = *(const u32x4*)dn_piece_src(p, ci0, pc); }
    __syncthreads();
    if (wave >= 4) {
        const int t2 = tid - 256;
        u32x4 sa[LPT], sb[LPT], sc[LPT];
#define DN_LD(dst, chunk) do { const int c_ = ci0 + ((chunk) < DN_SEG - 1 ? (chunk) : DN_SEG - 1); _Pragma("unroll") for (int q_ = 0; q_ < LPT; ++q_) dst[q_] = *(const u32x4*)dn_piece_src(p, c_, dn_lpiece<PASS>(t2 + 256 * q_)); } while (0)
#define DN_WR(src, chunk) do { if ((chunk) < DN_SEG) { unsigned char* nb_ = smem + ((chunk) & 1) * DN_CH_BYTES; _Pragma("unroll") for (int q_ = 0; q_ < LPT; ++q_) *(u32x4*)(nb_ + dn_lpiece<PASS>(t2 + 256 * q_) * 16) = src[q_]; } } while (0)
        DN_LD(sa, 1); DN_LD(sb, 2); DN_LD(sc, 3);
        unsigned* prog = p.bar + XCD_BAR_WORDS + 64 * (bh * 4 + seg);
#define DN_PUB(v) do { if (PASS == 0 && t2 == 0) __hip_atomic_store(prog, (unsigned)(v), __ATOMIC_RELAXED, __HIP_MEMORY_SCOPE_AGENT); } while (0)
        for (int n = 0; n < DN_SEG + 1; n += 3) {
            if (n < DN_SEG) { DN_WR(sa, n + 1); DN_LD(sa, n + 4); DN_PUB(n + 1); LDS_BARRIER(); }
            if (n + 1 < DN_SEG) { DN_WR(sb, n + 2); DN_LD(sb, n + 5); DN_PUB(n + 2); LDS_BARRIER(); }
            if (n + 2 < DN_SEG) { DN_WR(sc, n + 3); DN_LD(sc, n + 6); DN_PUB(n + 3); LDS_BARRIER(); }
        }
#undef DN_PUB
#undef DN_LD
#undef DN_WR
    } else {
        const int e = __builtin_amdgcn_readfirstlane(wave);
        const int sl = 4 * half + e;
        const bool isP = sl < 4;
        f32x16 S[4];
#pragma unroll
        for (int T = 0; T < 4; ++T)
#pragma unroll
            for (int e2 = 0; e2 < 16; ++e2) {
                const int row = 32 * T + (e2 & 3) + 8 * (e2 >> 2) + 4 * hh;
                if (PASS == 0) S[T][e2] = seg > 0 ? p.dn_PB[((size_t)(bh * 3 + 0) * 128 + row) * 256 + 128 + 32 * e + r] : 0.f;
                else S[T][e2] = (isP && row == 32 * sl + r) ? 1.f : 0.f;
            }
        if (PASS == 0) {
            for (int sg = 1; sg < seg; ++sg) {
                const float* pseg = p.dn_PB + (size_t)(bh * 3 + sg) * 128 * 256;
                bf16x8 Xb[8];
#pragma unroll
                for (int T = 0; T < 4; ++T) { Xb[2 * T] = pack8(S[T], 0); Xb[2 * T + 1] = pack8(S[T], 1); }
#pragma unroll
                for (int T = 0; T < 4; ++T) {
                    f32x16 xn;
#pragma unroll
                    for (int e2 = 0; e2 < 16; ++e2) xn[e2] = pseg[(size_t)(32 * T + (e2 & 3) + 8 * (e2 >> 2) + 4 * hh) * 256 + 128 + 32 * e + r];
#pragma unroll
                    for (int ks = 0; ks < 8; ++ks) {
                        const float* pr = pseg + (size_t)(32 * T + r) * 256 + 16 * ks + 4 * hh;
                        const float4 lo = *(const float4*)pr, hi = *(const float4*)(pr + 8);
                        u32x4 av; av.x = pk_bf16(lo.x, lo.y); av.y = pk_bf16(lo.z, lo.w); av.z = pk_bf16(hi.x, hi.y); av.w = pk_bf16(hi.z, hi.w);
                        xn = __builtin_amdgcn_mfma_f32_32x32x16_bf16(__builtin_bit_cast(bf16x8, av), Xb[ks], xn, 0, 0, 0);
                        if (ks & 1) __builtin_amdgcn_sched_barrier(0);
                    }
                    S[T] = xn;
                    __builtin_amdgcn_sched_barrier(0);
                }
            }
        }
        const float glr = p.dn_gl[ci0 + (lane & 31)];
#define DN_SB() __builtin_amdgcn_sched_barrier(0)
#define DN_RD8(dst, off) do { _Pragma("unroll") for (int q_ = 0; q_ < 8; ++q_) dst[q_] = *(const bf16x8*)(buf + (off) + q_ * 1024 + lane * 16); } while (0)
        bf16x8 Sb[8];
#pragma unroll
        for (int T = 0; T < 4; ++T) { Sb[2 * T] = pack8(S[T], 0); Sb[2 * T + 1] = pack8(S[T], 1); }
        const unsigned ooff = (unsigned)(4 * hh * 512 + r);
        for (int n = 0; n < DN_SEG; ++n) {
            const unsigned char* buf = smem + (n & 1) * DN_CH_BYTES;
            const float gl = __uint_as_float(__builtin_amdgcn_readlane(__float_as_uint(glr), n));
            bf16x8 fa[8], fb[8];
            DN_RD8(fa, 0);
            DN_RD8(fb, 8192);
            f32x16 vn0, vn1;
            if (PASS == 0 || !isP) {
                const unsigned char* ub = buf + 57344 + (PASS == 0 ? e : sl - 4) * 4096 + lane * 16;
                const u32x4 u00 = *(const u32x4*)ub, u01 = *(const u32x4*)(ub + 1024), u10 = *(const u32x4*)(ub + 2048), u11 = *(const u32x4*)(ub + 3072);
                vn0[0] = bflo(u00.x); vn0[1] = bfhi(u00.x); vn0[2] = bflo(u00.y); vn0[3] = bfhi(u00.y); vn0[4] = bflo(u00.z); vn0[5] = bfhi(u00.z); vn0[6] = bflo(u00.w); vn0[7] = bfhi(u00.w);
                vn0[8] = bflo(u01.x); vn0[9] = bfhi(u01.x); vn0[10] = bflo(u01.y); vn0[11] = bfhi(u01.y); vn0[12] = bflo(u01.z); vn0[13] = bfhi(u01.z); vn0[14] = bflo(u01.w); vn0[15] = bfhi(u01.w);
                vn1[0] = bflo(u10.x); vn1[1] = bfhi(u10.x); vn1[2] = bflo(u10.y); vn1[3] = bfhi(u10.y); vn1[4] = bflo(u10.z); vn1[5] = bfhi(u10.z); vn1[6] = bflo(u10.w); vn1[7] = bfhi(u10.w);
                vn1[8] = bflo(u11.x); vn1[9] = bfhi(u11.x); vn1[10] = bflo(u11.y); vn1[11] = bfhi(u11.y); vn1[12] = bflo(u11.z); vn1[13] = bfhi(u11.z); vn1[14] = bflo(u11.w); vn1[15] = bfhi(u11.w);
            } else {
#pragma unroll
                for (int e2 = 0; e2 < 16; ++e2) { vn0[e2] = 0.f; vn1[e2] = 0.f; }
            }
            DN_SB();
#pragma unroll
            for (int ks = 0; ks < 8; ++ks) vn0 = __builtin_amdgcn_mfma_f32_32x32x16_bf16(fa[ks], Sb[ks], vn0, 0, 0, 0);
            DN_SB();
            if (PASS == 0) DN_RD8(fa, 16384); else DN_RD8(fa, 32768);
            DN_SB();
#pragma unroll
            for (int ks = 0; ks < 8; ++ks) vn1 = __builtin_amdgcn_mfma_f32_32x32x16_bf16(fb[ks], Sb[ks], vn1, 0, 0, 0);
            DN_SB();
            if (PASS == 0) DN_RD8(fb, 16384 + 8192); else DN_RD8(fb, 32768 + 8192);
            DN_SB();
            f32x16 o0, o1;
            if (PASS == 0) {
#pragma unroll
                for (int e2 = 0; e2 < 16; ++e2) { o0[e2] = 0.f; o1[e2] = 0.f; }
#pragma unroll
                for (int ks = 0; ks < 8; ++ks) o0 = __builtin_amdgcn_mfma_f32_32x32x16_bf16(fa[ks], Sb[ks], o0, 0, 0, 0);
                DN_SB();
                DN_RD8(fa, 32768);
            }
            bf16x8 vb[4];
            vb[0] = pack8(vn0, 0); vb[1] = pack8(vn0, 1); vb[2] = pack8(vn1, 0); vb[3] = pack8(vn1, 1);
            DN_SB();
            if (PASS == 0) {
#pragma unroll
                for (int ks = 0; ks < 8; ++ks) o1 = __builtin_amdgcn_mfma_f32_32x32x16_bf16(fb[ks], Sb[ks], o1, 0, 0, 0);
                DN_SB();
                DN_RD8(fb, 32768 + 8192);
            }
#pragma unroll
            for (int e2 = 0; e2 < 16; ++e2) { S[0][e2] *= gl; S[1][e2] *= gl; }
            DN_SB();
#pragma unroll
            for (int ks = 0; ks < 4; ++ks) S[0] = __builtin_amdgcn_mfma_f32_32x32x16_bf16(fa[ks], vb[ks], S[0], 0, 0, 0);
#pragma unroll
            for (int ks = 0; ks < 4; ++ks) S[1] = __builtin_amdgcn_mfma_f32_32x32x16_bf16(fa[4 + ks], vb[ks], S[1], 0, 0, 0);
            DN_SB();
            if (PASS == 0) DN_RD8(fa, 49152);
#pragma unroll
            for (int e2 = 0; e2 < 16; ++e2) { S[2][e2] *= gl; S[3][e2] *= gl; }
            DN_SB();
#pragma unroll
            for (int ks = 0; ks < 4; ++ks) S[2] = __builtin_amdgcn_mfma_f32_32x32x16_bf16(fb[ks], vb[ks], S[2], 0, 0, 0);
#pragma unroll
            for (int ks = 0; ks < 4; ++ks) S[3] = __builtin_amdgcn_mfma_f32_32x32x16_bf16(fb[4 + ks], vb[ks], S[3], 0, 0, 0);
            DN_SB();
            if (PASS == 0) {
#pragma unroll
                for (int ks = 0; ks < 4; ++ks) o0 = __builtin_amdgcn_mfma_f32_32x32x16_bf16(fa[ks], vb[ks], o0, 0, 0, 0);
#pragma unroll
                for (int ks = 0; ks < 4; ++ks) o1 = __builtin_amdgcn_mfma_f32_32x32x16_bf16(fa[4 + ks], vb[ks], o1, 0, 0, 0);
                DN_SB();
            }
#pragma unroll
            for (int T = 0; T < 4; ++T) { Sb[2 * T] = pack8(S[T], 0); Sb[2 * T + 1] = pack8(S[T], 1); }
            if (PASS == 0) {
                bf16_t* ob = p.odn_raw + ((size_t)b * SEQ + (seg * DN_SEG + n) * 64) * 512 + h * 128 + 32 * e;
#pragma unroll
                for (int e2 = 0; e2 < 16; e2 += 2) {
                    const unsigned w0 = pk_bf16(o0[e2], o0[e2 + 1]), w1 = pk_bf16(o1[e2], o1[e2 + 1]);
                    (ob + ((e2 & 3) + 8 * (e2 >> 2)) * 512)[ooff] = (bf16_t)(w0 & 0xffffu); (ob + ((e2 & 3) + 1 + 8 * (e2 >> 2)) * 512)[ooff] = (bf16_t)(w0 >> 16);
                    (ob + (32 + (e2 & 3) + 8 * (e2 >> 2)) * 512)[ooff] = (bf16_t)(w1 & 0xffffu); (ob + (32 + (e2 & 3) + 1 + 8 * (e2 >> 2)) * 512)[ooff] = (bf16_t)(w1 >> 16);
                }
            }
            LDS_BARRIER();
        }
#undef DN_RD8
#undef DN_SB
        if (PASS == 1) {
            float* pb = p.dn_PB + (size_t)(bh * 3 + seg) * 128 * 256 + 32 * sl + r;
#pragma unroll
            for (int T = 0; T < 4; ++T)
#pragma unroll
                for (int e2 = 0; e2 < 16; ++e2) pb[(size_t)(32 * T + (e2 & 3) + 8 * (e2 >> 2) + 4 * hh) * 256] = S[T][e2];
        }
    }
    __syncthreads();
}
__device__ __forceinline__ void phase_scan_l2_helper(const Params& p) {
    const int sj = blockIdx.x - 64, tid = threadIdx.x;
    const int bh = sj >> 2, seg = sj & 3, ci0 = bh * 128 + seg * DN_SEG;
    unsigned* prog = p.bar + XCD_BAR_WORDS + 64 * sj;
    unsigned acc = 0u;
    for (int m = 7; m < DN_SEG; ++m) {
        unsigned spins = 0, pr;
        for (;;) {
            pr = __hip_atomic_load(prog, __ATOMIC_RELAXED, __HIP_MEMORY_SCOPE_AGENT);
            if ((int)pr + 8 >= m || ++spins > 100000u) break;
            __builtin_amdgcn_s_sleep(16);
        }
        if ((int)pr + 4 >= m) continue;
#pragma unroll
        for (int q = 0; q < 9; ++q) { const u32x4 v = *(const u32x4*)dn_piece_src(p, ci0 + m, tid + 512 * q); acc ^= v.x ^ v.y ^ v.z ^ v.w; }
    }
    asm volatile("" :: "v"(acc));
}

constexpr int AT_VT = 32768, AT_VT_STRIDE = 260;
__device__ __forceinline__ void phase_attn(const Params& p, unsigned char* smem, int first_block) {
    const int tid0 = threadIdx.x;
    const int nblk = gridDim.x - first_block;
    const bf16_t* pb = p.proj_b;
    bf16_t* vt = (bf16_t*)(smem + AT_VT);
    u32x4 kvr[4], vvr[4]; bf16x8 qfn[4];
    auto at_fetch = [&](int it) {
        const int tq = tid0, ln = tq & 63, wv = tq >> 6;
        const int hp = it & 1, kvh = (it >> 1) & 1, nb = (it >> 2) & 63, b = it >> 8, m0 = b * SEQ + nb * 128;
#pragma unroll
        for (int i = 0; i < 4; ++i) {
            const int idx = tq + 512 * i, key = idx >> 3, ch = idx & 7;
            kvr[i] = (u32x4){0u, 0u, 0u, 0u}; vvr[i] = (u32x4){0u, 0u, 0u, 0u};
            if ((nb > 0) || (key >= 128)) { const bf16_t* src = pb + (size_t)(m0 - 128 + key) * NP_IN + kvh * 64 + ch * 8; kvr[i] = *(const u32x4*)(src + P_AK); vvr[i] = *(const u32x4*)(src + P_AV); }
        }
        const int head = kvh * 4 + hp * 2 + (wv >> 2), qo = (wv & 3) * 32;
        const bf16_t* qrow = pb + (size_t)(m0 + qo + (ln & 31)) * NP_IN + P_AQ + head * 64 + 8 * (ln >> 5);
#pragma unroll
        for (int ks = 0; ks < 4; ++ks) qfn[ks] = *(const bf16x8*)(qrow + 16 * ks);
    };
    if ((int)blockIdx.x - first_block < 1024) at_fetch((int)blockIdx.x - first_block);
    for (int item = blockIdx.x - first_block; item < 1024; item += nblk) {
        int tid = tid0; asm volatile("" : "+v"(tid));
        const int lane = tid & 63, wave = tid >> 6, r = lane & 31, hh = lane >> 5;
        const int hp = item & 1, kvh = (item >> 1) & 1, nb = (item >> 2) & 63, b = item >> 8;
        const int m0 = b * SEQ + nb * 128;
        __syncthreads();
#pragma unroll
        for (int i = 0; i < 4; ++i) {
            const int idx = tid + 512 * i, key = idx >> 3, ch = idx & 7;
            const u32x4 vv = vvr[i];
            *(u32x4*)(smem + swz(key, ch)) = kvr[i];
            bf16_t* vd = vt + (ch * 8) * AT_VT_STRIDE + (key ^ (ch << 3));
            vd[0] = (bf16_t)(vv.x & 0xffffu); vd[AT_VT_STRIDE] = (bf16_t)(vv.x >> 16); vd[2 * AT_VT_STRIDE] = (bf16_t)(vv.y & 0xffffu); vd[3 * AT_VT_STRIDE] = (bf16_t)(vv.y >> 16);
            vd[4 * AT_VT_STRIDE] = (bf16_t)(vv.z & 0xffffu); vd[5 * AT_VT_STRIDE] = (bf16_t)(vv.z >> 16); vd[6 * AT_VT_STRIDE] = (bf16_t)(vv.w & 0xffffu); vd[7 * AT_VT_STRIDE] = (bf16_t)(vv.w >> 16);
        }
        bf16x8 qf[4];
#pragma unroll
        for (int ks = 0; ks < 4; ++ks) qf[ks] = qfn[ks];
        __syncthreads();
        if (item + nblk < 1024) at_fetch(item + nblk);
        const int head = kvh * 4 + hp * 2 + (wave >> 2), qt = wave & 3, qo = qt * 32;
        f32x16 sc[5];
#pragma unroll
        for (int t = 0; t < 5; ++t) {
#pragma unroll
            for (int e = 0; e < 16; ++e) sc[t][e] = 0.f;
#pragma unroll
            for (int ks = 0; ks < 4; ++ks) sc[t] = __builtin_amdgcn_mfma_f32_32x32x16_bf16(*(const bf16x8*)(smem + swz((qt + t) * 32 + r, 2 * ks + hh)), qf[ks], sc[t], 0, 0, 0);
        }
        const float sink = p.sinks[head];
        float mx = -1e30f;
#pragma unroll
        for (int t = 0; t < 5; ++t)
#pragma unroll
            for (int e = 0; e < 16; ++e) {
                const int kf = 32 * (qt + t) + (e & 3) + 8 * (e >> 2) + 4 * hh;
                const bool ok = (kf >= qo + r + 1) && (kf <= qo + r + 128) && ((nb > 0) || (kf >= 128));
                sc[t][e] = ok ? sc[t][e] : -1e30f;
                mx = fmaxf(mx, sc[t][e]);
            }
        mx = fmaxf(mx, __shfl_xor(mx, 32));
        mx = fmaxf(mx, sink);
        float sum = 0.f;
#pragma unroll
        for (int t = 0; t < 5; ++t)
#pragma unroll
            for (int e = 0; e < 16; ++e) { const float pe = (sc[t][e] > -1e29f) ? __expf(sc[t][e] - mx) : 0.f; sc[t][e] = pe; sum += pe; }
        sum += __shfl_xor(sum, 32);
        const float inv = 1.f / (sum + __expf(sink - mx));
        f32x16 o[2];
#pragma unroll
        for (int dt = 0; dt < 2; ++dt)
#pragma unroll
            for (int e = 0; e < 16; ++e) o[dt][e] = 0.f;
#pragma unroll
        for (int t = 0; t < 5; ++t)
#pragma unroll
            for (int s2 = 0; s2 < 2; ++s2) {
                const bf16x8 pbv = pack8(sc[t], s2);
                const int kb = 32 * (qt + t) + 16 * s2 + 4 * hh;
#pragma unroll
                for (int dt = 0; dt < 2; ++dt) {
                    const int dvr = dt * 32 + r, vx = ((dvr >> 3) & 7) << 3;
                    const u32x2 lo = *(const u32x2*)(vt + dvr * AT_VT_STRIDE + (kb ^ vx)), hi = *(const u32x2*)(vt + dvr * AT_VT_STRIDE + ((kb + 8) ^ vx));
                    u32x4 av; av.x = lo.x; av.y = lo.y; av.z = hi.x; av.w = hi.y;
                    o[dt] = __builtin_amdgcn_mfma_f32_32x32x16_bf16(__builtin_bit_cast(bf16x8, av), pbv, o[dt], 0, 0, 0);
                }
            }
        bf16_t* orow = p.xb + (size_t)(m0 + qo + r) * D_MODEL + head * 64 + 4 * hh;
#pragma unroll
        for (int dt = 0; dt < 2; ++dt)
#pragma unroll
            for (int q4 = 0; q4 < 4; ++q4) {
                u32x2 v; v.x = pk_bf16(o[dt][4 * q4] * inv, o[dt][4 * q4 + 1] * inv); v.y = pk_bf16(o[dt][4 * q4 + 2] * inv, o[dt][4 * q4 + 3] * inv);
                *(u32x2*)(orow + dt * 32 + 8 * q4) = v;
            }
    }
    __syncthreads();
}

__device__ __forceinline__ void phase_dn_norm(const Params& p) {
    const int lane = threadIdx.x & 63, gw = blockIdx.x * (NTHREADS / 64) + (threadIdx.x >> 6), GW = gridDim.x * (NTHREADS / 64);
    const float2 g = *(const float2*)(p.dn_norm_g + lane * 2);
    for (int m = gw; m < M_TOK; m += GW) {
        float2 o[4]; unsigned z[4];
#pragma unroll
        for (int h = 0; h < 4; ++h) { const unsigned ow = *(const unsigned*)(p.odn_raw + (size_t)m * 512 + h * 128 + lane * 2); o[h] = make_float2(bflo(ow), bfhi(ow)); z[h] = *(const unsigned*)(p.proj_b + (size_t)m * NP_IN + P_Z + h * 128 + lane * 2); }
#pragma unroll
        for (int h = 0; h < 4; ++h) {
            const float ss = wave_sum(o[h].x * o[h].x + o[h].y * o[h].y);
            const float rr = rsqrtf(ss * (1.f / 128.f) + RMS_EPS);
            *(unsigned*)(p.xb + (size_t)m * D_MODEL + 512 + h * 128 + lane * 2) = pk_bf16(o[h].x * rr * g.x * silu_f(bflo(z[h])), o[h].y * rr * g.y * silu_f(bfhi(z[h])));
        }
    }
}

__device__ __forceinline__ f32x4 bf4_lo(const u32x4 w) { return (f32x4){bflo(w.x), bfhi(w.x), bflo(w.y), bfhi(w.y)}; }
__device__ __forceinline__ f32x4 bf4_hi(const u32x4 w) { return (f32x4){bflo(w.z), bfhi(w.z), bflo(w.w), bfhi(w.w)}; }
__device__ __forceinline__ float sum4(const f32x4 v) { return (v[0] + v[1]) + (v[2] + v[3]); }
__device__ __forceinline__ void phase_ln1(const Params& p, const bf16_t* yb, bf16_t* x1b) {
    const int lane = threadIdx.x & 63, gw = blockIdx.x * (NTHREADS / 64) + (threadIdx.x >> 6), GW = gridDim.x * (NTHREADS / 64);
    f32x4 g[4], bb[4];
#pragma unroll
    for (int j = 0; j < 4; ++j) { g[j] = *(const f32x4*)(p.ln1_g + (j >> 1) * 512 + lane * 8 + (j & 1) * 4); bb[j] = *(const f32x4*)(p.ln1_b + (j >> 1) * 512 + lane * 8 + (j & 1) * 4); }
    for (int m0 = gw * 4; m0 < M_TOK; m0 += GW * 4) {
        u32x4 w[4][2];
#pragma unroll
        for (int rr = 0; rr < 4; ++rr)
#pragma unroll
            for (int j = 0; j < 2; ++j) w[rr][j] = *(const u32x4*)(yb + (size_t)(m0 + rr) * D_MODEL + j * 512 + lane * 8);
#pragma unroll
        for (int rr = 0; rr < 4; ++rr) {
            f32x4 v[4] = {bf4_lo(w[rr][0]), bf4_hi(w[rr][0]), bf4_lo(w[rr][1]), bf4_hi(w[rr][1])};
            const float mean = wave_sum((sum4(v[0]) + sum4(v[1])) + (sum4(v[2]) + sum4(v[3]))) * (1.f / D_MODEL);
            float q = 0.f;
#pragma unroll
            for (int j = 0; j < 4; ++j) { v[j] -= mean; q += sum4(v[j] * v[j]); }
            const float rstd = rsqrtf(wave_sum(q) * (1.f / D_MODEL) + LN_EPS);
#pragma unroll
            for (int j = 0; j < 4; ++j) v[j] = v[j] * rstd * g[j] + bb[j];
#pragma unroll
            for (int j = 0; j < 2; ++j) {
                u32x4 ob; ob.x = pk_bf16(v[2 * j][0], v[2 * j][1]); ob.y = pk_bf16(v[2 * j][2], v[2 * j][3]); ob.z = pk_bf16(v[2 * j + 1][0], v[2 * j + 1][1]); ob.w = pk_bf16(v[2 * j + 1][2], v[2 * j + 1][3]);
                *(u32x4*)(x1b + (size_t)(m0 + rr) * D_MODEL + j * 512 + lane * 8) = ob;
            }
        }
    }
}

__device__ __forceinline__ void cas_d(float& a, float& b) { const float hi = fmaxf(a, b), lo = fminf(a, b); a = hi; b = lo; }
__device__ __forceinline__ void cas_a(float& a, float& b) { const float hi = fmaxf(a, b), lo = fminf(a, b); a = lo; b = hi; }
__device__ __forceinline__ void sort16_desc(f32x16& v) {
#pragma unroll
    for (int k = 2; k <= 16; k <<= 1)
#pragma unroll
        for (int j = k >> 1; j > 0; j >>= 1)
#pragma unroll
            for (int i = 0; i < 16; ++i) {
                const int l = i ^ j;
                if (l > i) { float a = v[i], b = v[l]; if ((i & k) == 0) cas_d(a, b); else cas_a(a, b); v[i] = a; v[l] = b; }
            }
}
__device__ __forceinline__ void bmerge16_desc(f32x16& v) {
#pragma unroll
    for (int j = 8; j > 0; j >>= 1)
#pragma unroll
        for (int i = 0; i < 16; ++i) { const int l = i ^ j; if (l > i) { float a = v[i], b = v[l]; cas_d(a, b); v[i] = a; v[l] = b; } }
}
__device__ __forceinline__ f32x16 merge_top16(const f32x16& a, const f32x16& b) {
    f32x16 c;
#pragma unroll
    for (int i = 0; i < 16; ++i) c[i] = fmaxf(a[i], b[15 - i]);
    bmerge16_desc(c);
    return c;
}
__device__ __forceinline__ void pcas_d(float& va, int& ia, float& vb, int& ib) {
    const bool sw = vb > va; const float tv = sw ? vb : va; const int ti = sw ? ib : ia;
    vb = sw ? va : vb; ib = sw ? ia : ib; va = tv; ia = ti;
}
__device__ __forceinline__ void psort16_desc(float (&v)[16], int (&id)[16]) {
#pragma unroll
    for (int k = 2; k <= 16; k <<= 1)
#pragma unroll
        for (int j = k >> 1; j > 0; j >>= 1)
#pragma unroll
            for (int i = 0; i < 16; ++i) {
                const int l = i ^ j;
                if (l > i) { if ((i & k) == 0) pcas_d(v[i], id[i], v[l], id[l]); else pcas_d(v[l], id[l], v[i], id[i]); }
            }
}
__device__ __forceinline__ void pmerge_top16(float (&a)[16], int (&ia)[16], const float (&b)[16], const int (&ib)[16]) {
#pragma unroll
    for (int i = 0; i < 16; ++i) { const bool sw = b[15 - i] > a[i]; a[i] = sw ? b[15 - i] : a[i]; ia[i] = sw ? ib[15 - i] : ia[i]; }
#pragma unroll
    for (int j = 8; j > 0; j >>= 1)
#pragma unroll
        for (int i = 0; i < 16; ++i) { const int l = i ^ j; if (l > i) pcas_d(a[i], ia[i], a[l], ia[l]); }
}
__device__ __forceinline__ void phase_route(const Params& p, const bf16_t* qb) {
    constexpr int CI[50] = {0,0,0,0,0,0,0,0,0,0,0,0,0,0,0,0,1,1,1,1,1,1,1,1,2,2,2,2,2,3,3,3,3,4,4,4,5,5,6,6,7,7,8,9,10,11,12,13,14,15};
    constexpr int CJ[50] = {0,1,2,3,4,5,6,7,8,9,10,11,12,13,14,15,0,1,2,3,4,5,6,7,0,1,2,3,4,0,1,2,3,0,1,2,0,1,0,1,0,1,0,0,0,0,0,0,0,0};
    const int lane0 = threadIdx.x & 63, gw = blockIdx.x * (NTHREADS / 64) + (threadIdx.x >> 6), GW = gridDim.x * (NTHREADS / 64);
    for (int task = gw; task < (M_TOK / 32) * 8; task += GW) {
        int lane = lane0; asm volatile("" : "+v"(lane));
        const int r = lane & 31, hh = lane >> 5;
        const int h = task & 7, tok0 = (task >> 3) * 32;
        f32x16 top[2];
#pragma unroll
        for (int pp = 0; pp < 2; ++pp) {
            const bf16_t* qrow = qb + (size_t)(tok0 + r) * 2048 + h * 256 + pp * 128 + 8 * hh;
            bf16x8 qf[8];
#pragma unroll
            for (int ks = 0; ks < 8; ++ks) qf[ks] = *(const bf16x8*)(qrow + 16 * ks);
            f32x16 sc[4];
#pragma unroll
            for (int kt = 0; kt < 4; ++kt) {
                const bf16_t* af = p.sk_frag + ((size_t)(((h * 2 + pp) * 4 + kt) * 8) * 64 + lane) * 8;
                bf16x8 a[8];
#pragma unroll
                for (int ks = 0; ks < 8; ++ks) a[ks] = *(const bf16x8*)(af + (size_t)ks * 512);
#pragma unroll
                for (int e = 0; e < 16; ++e) sc[kt][e] = 0.f;
#pragma unroll
                for (int ks = 0; ks < 8; ++ks) sc[kt] = __builtin_amdgcn_mfma_f32_32x32x16_bf16(a[ks], qf[ks], sc[kt], 0, 0, 0);
            }
#pragma unroll
            for (int kt = 0; kt < 4; ++kt) {
#pragma unroll
                for (int e = 0; e < 16; ++e) {
                    const unsigned key = (unsigned)(32 * kt + (e & 3) + 8 * (e >> 2)) + 4u * (unsigned)hh;
                    sc[kt][e] = __uint_as_float((__float_as_uint(sc[kt][e]) & 0xffffff80u) | key);
                }
                sort16_desc(sc[kt]);
            }
            f32x16 m = merge_top16(merge_top16(sc[0], sc[1]), merge_top16(sc[2], sc[3]));
            f32x16 oth;
#pragma unroll
            for (int i = 0; i < 16; ++i) oth[i] = __shfl_xor(m[i], 32);
            top[pp] = merge_top16(m, oth);
        }
        int ia[16], ib[16];
#pragma unroll
        for (int i = 0; i < 16; ++i) { ia[i] = (int)(__float_as_uint(top[0][i]) & 127u); ib[i] = (int)(__float_as_uint(top[1][i]) & 127u); }
        float cv0[16], cv1[16]; int cd0[16], cd1[16];
#pragma unroll
        for (int c = 0; c < 32; ++c) {
            float v = -INFINITY; int id = 0;
            if (c < 25) {
                const float v0 = top[0][CI[2 * c]] + top[1][CJ[2 * c]], v1 = top[0][CI[2 * c + 1]] + top[1][CJ[2 * c + 1]];
                const int d0 = (ia[CI[2 * c]] << 7) | ib[CJ[2 * c]], d1 = (ia[CI[2 * c + 1]] << 7) | ib[CJ[2 * c + 1]];
                v = hh ? v1 : v0; id = hh ? d1 : d0;
            }
            if (c < 16) { cv0[c] = v; cd0[c] = id; } else { cv1[c - 16] = v; cd1[c - 16] = id; }
        }
        psort16_desc(cv0, cd0); psort16_desc(cv1, cd1);
        pmerge_top16(cv0, cd0, cv1, cd1);
        float ov[16]; int od[16];
#pragma unroll
        for (int i = 0; i < 16; ++i) { ov[i] = __shfl_xor(cv0[i], 32); od[i] = __shfl_xor(cd0[i], 32); }
        pmerge_top16(cv0, cd0, ov, od);
        float ex[16], den = 0.f;
#pragma unroll
        for (int i = 0; i < 16; ++i) { ex[i] = __expf(cv0[i] - cv0[0]); den += ex[i]; }
        const float inv = 1.f / den;
        if (hh == 0) {
            int* idp = p.ids + (size_t)(tok0 + r) * 128 + h * 16; float* gp = p.gates + (size_t)(tok0 + r) * 128 + h * 16;
#pragma unroll
            for (int q = 0; q < 4; ++q) {
                *(int4*)(idp + 4 * q) = make_int4(cd0[4 * q], cd0[4 * q + 1], cd0[4 * q + 2], cd0[4 * q + 3]);
                *(float4*)(gp + 4 * q) = make_float4(ex[4 * q] * inv, ex[4 * q + 1] * inv, ex[4 * q + 2] * inv, ex[4 * q + 3] * inv);
            }
        }
    }
}


typedef float f32x2 __attribute__((ext_vector_type(2)));
__device__ __forceinline__ void phase_tables8(const Params& p, int first_block) {
    const int lane = threadIdx.x & 63, gw = (blockIdx.x - first_block) * (NTHREADS / 64) + (threadIdx.x >> 6), GW = (gridDim.x - first_block) * (NTHREADS / 64);
    for (int row0 = gw * 4; row0 < 2 * 16384; row0 += GW * 4) {
        float v[4][16];
#pragma unroll
        for (int rr = 0; rr < 4; ++rr) {
            const int row = row0 + rr, table = row >> 14, e = row & 16383;
            const float* src = (table ? p.peer_v : p.peer_u) + (size_t)e * 1024 + lane * 16;
#pragma unroll
            for (int q = 0; q < 4; ++q) { const float4 a = *(const float4*)(src + 4 * q); v[rr][4 * q] = a.x; v[rr][4 * q + 1] = a.y; v[rr][4 * q + 2] = a.z; v[rr][4 * q + 3] = a.w; }
        }
#pragma unroll
        for (int rr = 0; rr < 4; ++rr) {
            const int row = row0 + rr, table = row >> 14, e = row & 16383;
            float am = 0.f;
#pragma unroll
            for (int c = 0; c < 16; ++c) am = fmaxf(am, fabsf(v[rr][c]));
            am = wave_max(am);
            float sc = am > 0.f ? exp2f(floorf(log2f(448.f / am))) : 1.f;
            if (am * sc > 448.f) sc *= 0.5f;
            u32x4 o; int w;
            w = 0; w = __builtin_amdgcn_cvt_pk_fp8_f32(v[rr][0] * sc, v[rr][1] * sc, w, false); w = __builtin_amdgcn_cvt_pk_fp8_f32(v[rr][2] * sc, v[rr][3] * sc, w, true); o.x = (unsigned)w;
            w = 0; w = __builtin_amdgcn_cvt_pk_fp8_f32(v[rr][4] * sc, v[rr][5] * sc, w, false); w = __builtin_amdgcn_cvt_pk_fp8_f32(v[rr][6] * sc, v[rr][7] * sc, w, true); o.y = (unsigned)w;
            w = 0; w = __builtin_amdgcn_cvt_pk_fp8_f32(v[rr][8] * sc, v[rr][9] * sc, w, false); w = __builtin_amdgcn_cvt_pk_fp8_f32(v[rr][10] * sc, v[rr][11] * sc, w, true); o.z = (unsigned)w;
            w = 0; w = __builtin_amdgcn_cvt_pk_fp8_f32(v[rr][12] * sc, v[rr][13] * sc, w, false); w = __builtin_amdgcn_cvt_pk_fp8_f32(v[rr][14] * sc, v[rr][15] * sc, w, true); o.w = (unsigned)w;
            *(u32x4*)(p.tab8 + ((size_t)((table * 8 + (lane >> 3)) * 16384 + e)) * 128 + (lane & 7) * 16) = o;
            if (lane == 0) p.isc[row] = 1.f / sc;
        }
    }
}
typedef int i32x16 __attribute__((ext_vector_type(16)));
struct PeerBuf { u32x4 rows[16]; u32x4 xa, xb; f32x16 w; };
__device__ __forceinline__ float dpp_xor1(float v) { return __uint_as_float(__builtin_amdgcn_update_dpp(0u, __float_as_uint(v), 0xB1, 0xF, 0xF, true)); }
__device__ __forceinline__ float dpp_xor2(float v) { return __uint_as_float(__builtin_amdgcn_update_dpp(0u, __float_as_uint(v), 0x4E, 0xF, 0xF, true)); }
__device__ __forceinline__ float dpp_xor8(float v) { return __uint_as_float(__builtin_amdgcn_update_dpp(0u, __float_as_uint(v), 0x128, 0xF, 0xF, true)); }
__device__ __forceinline__ float swz_xor4(float v) { return __uint_as_float(__builtin_amdgcn_ds_swizzle(__float_as_uint(v), 0x101F)); }
__device__ __forceinline__ float swz_xor16(float v) { return __uint_as_float(__builtin_amdgcn_ds_swizzle(__float_as_uint(v), 0x401F)); }
__device__ __forceinline__ void peer_gather(PeerBuf& B, const unsigned char* tab, const i32x16& id, int j) {
#pragma unroll
    for (int i = 0; i < 16; ++i) B.rows[i] = *(const u32x4*)(tab + (size_t)id[i] * 128 + j * 16);
}
__device__ __forceinline__ void phase_peer_u(const Params& p, const bf16_t* x1b, bf16_t* ph) {
    const int lane0 = threadIdx.x & 63, wave = threadIdx.x >> 6;
    const int x = blockIdx.x & 7, nloc = (gridDim.x - x + 7) >> 3, wl = (blockIdx.x >> 3) * (NTHREADS / 64) + wave, NW = nloc * (NTHREADS / 64);
    const unsigned char* tab = p.tab8 + (size_t)x * 16384 * 128;
    int lane = lane0; asm volatile("" : "+v"(lane));
    const int j = lane & 7, g = lane >> 3;
    const bool b0 = j & 1, b1 = j & 2, b2 = j & 4;
    auto tok = [&](int t) { return t < M_TOK ? t : M_TOK - 1; };
    auto load_ids = [&](i32x16& id, int t) {
#pragma unroll
        for (int q = 0; q < 4; ++q) { const int4 v = *(const int4*)(p.ids + (size_t)t * 128 + 16 * g + 4 * q); id[4 * q] = v.x; id[4 * q + 1] = v.y; id[4 * q + 2] = v.z; id[4 * q + 3] = v.w; }
    };
    auto issue = [&](PeerBuf& B, int t, const i32x16& id) {
        const bf16_t* xs = x1b + (size_t)t * 1024 + 128 * x + 16 * j;
        B.xa = *(const u32x4*)xs; B.xb = *(const u32x4*)(xs + 8);
        peer_gather(B, tab, id, j);
    };
    auto compute = [&](const PeerBuf& B, int t) {
        const f32x2 xf[8] = {{bflo(B.xa.x), bfhi(B.xa.x)}, {bflo(B.xa.y), bfhi(B.xa.y)}, {bflo(B.xa.z), bfhi(B.xa.z)}, {bflo(B.xa.w), bfhi(B.xa.w)},
                             {bflo(B.xb.x), bfhi(B.xb.x)}, {bflo(B.xb.y), bfhi(B.xb.y)}, {bflo(B.xb.z), bfhi(B.xb.z)}, {bflo(B.xb.w), bfhi(B.xb.w)}};
        float res[16];
#pragma unroll
        for (int i = 0; i < 16; ++i) {
            const unsigned dw[4] = {B.rows[i].x, B.rows[i].y, B.rows[i].z, B.rows[i].w};
            f32x2 d2 = {0.f, 0.f};
#pragma unroll
            for (int q = 0; q < 4; ++q) {
                const f32x2 lo = __builtin_amdgcn_cvt_pk_f32_fp8((int)dw[q], false), hi = __builtin_amdgcn_cvt_pk_f32_fp8((int)dw[q], true);
                d2 = lo * xf[2 * q] + d2; d2 = hi * xf[2 * q + 1] + d2;
            }
            res[i] = d2.x + d2.y;
        }
        float r8[8], r4[4], r2[2];
#pragma unroll
        for (int m = 0; m < 8; ++m) { const float keep = b0 ? res[8 + m] : res[m], send = b0 ? res[m] : res[8 + m]; r8[m] = keep + dpp_xor1(send); }
#pragma unroll
        for (int m = 0; m < 4; ++m) { const float keep = b1 ? r8[4 + m] : r8[m], send = b1 ? r8[m] : r8[4 + m]; r4[m] = keep + dpp_xor2(send); }
#pragma unroll
        for (int m = 0; m < 2; ++m) { const float keep = b2 ? r4[2 + m] : r4[m], send = b2 ? r4[m] : r4[2 + m]; r2[m] = keep + swz_xor4(send); }
        const int i0 = 8 * (int)b0 + 4 * (int)b1 + 2 * (int)b2;
        *(unsigned*)(ph + ((size_t)x * M_TOK + t) * 128 + 16 * g + i0) = pk_bf16(r2[0], r2[1]);
    };
    PeerBuf A, Bb;
    int t = wl;
    if (t >= M_TOK) return;
    i32x16 idn;
    load_ids(idn, t);
    issue(A, t, idn);
    load_ids(idn, tok(t + NW));
    for (; t < M_TOK; t += 2 * NW) {
        issue(Bb, tok(t + NW), idn);
        load_ids(idn, tok(t + 2 * NW));
        compute(A, t);
        issue(A, tok(t + 2 * NW), idn);
        load_ids(idn, tok(t + 3 * NW));
        if (t + NW < M_TOK) compute(Bb, t + NW);
    }
}
__device__ __forceinline__ void phase_peer_w(const Params& p, const bf16_t* ph, float* wbuf) {
    const size_t gt = (size_t)blockIdx.x * NTHREADS + threadIdx.x, GT = (size_t)gridDim.x * NTHREADS, NP = (size_t)M_TOK * 64;
    for (size_t i0 = gt; i0 < NP; i0 += GT * 4) {
        int2 e[4]; float2 h[4], gg[4];
#pragma unroll
        for (int u = 0; u < 4; ++u) {
            const size_t idx = (i0 + u * GT < NP) ? i0 + u * GT : i0;
            e[u] = *(const int2*)(p.ids + 2 * idx); gg[u] = *(const float2*)(p.gates + 2 * idx); h[u] = make_float2(0.f, 0.f);
#pragma unroll
            for (int x = 0; x < 8; ++x) { const unsigned w = *(const unsigned*)(ph + (size_t)x * M_TOK * 128 + 2 * idx); h[u].x += bflo(w); h[u].y += bfhi(w); }
        }
#pragma unroll
        for (int u = 0; u < 4; ++u) {
            if (i0 + u * GT >= NP) continue;
            const float h0 = h[u].x * p.isc[e[u].x], h1 = h[u].y * p.isc[e[u].y];
            *(float2*)(wbuf + 2 * (i0 + u * GT)) = make_float2(0.5f * h0 * (1.f + erff(h0 * 0.7071067811865476f)) * gg[u].x * p.isc[16384 + e[u].x],
                                                               0.5f * h1 * (1.f + erff(h1 * 0.7071067811865476f)) * gg[u].y * p.isc[16384 + e[u].y]);
        }
    }
}
__device__ __forceinline__ void phase_peer_v(const Params& p, const float* wbuf, bf16_t* ffn) {
    const int lane0 = threadIdx.x & 63, wave = threadIdx.x >> 6;
    const int x = blockIdx.x & 7, nloc = (gridDim.x - x + 7) >> 3, wl = (blockIdx.x >> 3) * (NTHREADS / 64) + wave, NW = nloc * (NTHREADS / 64);
    const unsigned char* tab = p.tab8 + (size_t)(8 + x) * 16384 * 128;
    int lane = lane0; asm volatile("" : "+v"(lane));
    const int j = lane & 7, g = lane >> 3;
    const bool b3 = g & 1, b4 = g & 2, b5 = g & 4;
    auto tok = [&](int t) { return t < M_TOK ? t : M_TOK - 1; };
    auto load_ids = [&](i32x16& id, int t) {
#pragma unroll
        for (int q = 0; q < 4; ++q) { const int4 v = *(const int4*)(p.ids + (size_t)t * 128 + 16 * g + 4 * q); id[4 * q] = v.x; id[4 * q + 1] = v.y; id[4 * q + 2] = v.z; id[4 * q + 3] = v.w; }
    };
    auto issue = [&](PeerBuf& B, int t, const i32x16& id) {
#pragma unroll
        for (int q = 0; q < 4; ++q) { const float4 v = *(const float4*)(wbuf + (size_t)t * 128 + 16 * g + 4 * q); B.w[4 * q] = v.x; B.w[4 * q + 1] = v.y; B.w[4 * q + 2] = v.z; B.w[4 * q + 3] = v.w; }
        peer_gather(B, tab, id, j);
    };
    auto compute = [&](const PeerBuf& B, int t) {
        f32x2 acc[8];
#pragma unroll
        for (int c = 0; c < 8; ++c) acc[c] = (f32x2){0.f, 0.f};
#pragma unroll
        for (int i = 0; i < 16; ++i) {
            const f32x2 w2 = {B.w[i], B.w[i]};
            const unsigned dw[4] = {B.rows[i].x, B.rows[i].y, B.rows[i].z, B.rows[i].w};
#pragma unroll
            for (int q = 0; q < 4; ++q) {
                const f32x2 lo = __builtin_amdgcn_cvt_pk_f32_fp8((int)dw[q], false), hi = __builtin_amdgcn_cvt_pk_f32_fp8((int)dw[q], true);
                acc[2 * q] = lo * w2 + acc[2 * q]; acc[2 * q + 1] = hi * w2 + acc[2 * q + 1];
            }
        }
        f32x2 a4[4], a2[2], a1;
#pragma unroll
        for (int m = 0; m < 4; ++m) { const f32x2 keep = b3 ? acc[4 + m] : acc[m], send = b3 ? acc[m] : acc[4 + m]; a4[m] = (f32x2){keep.x + dpp_xor8(send.x), keep.y + dpp_xor8(send.y)}; }
#pragma unroll
        for (int m = 0; m < 2; ++m) { const f32x2 keep = b4 ? a4[2 + m] : a4[m], send = b4 ? a4[m] : a4[2 + m]; a2[m] = (f32x2){keep.x + swz_xor16(send.x), keep.y + swz_xor16(send.y)}; }
        { const f32x2 keep = b5 ? a2[1] : a2[0], send = b5 ? a2[0] : a2[1]; a1 = (f32x2){keep.x + __shfl_xor(send.x, 32), keep.y + __shfl_xor(send.y, 32)}; }
        const int c0 = 8 * (int)b3 + 4 * (int)b4 + 2 * (int)b5;
        *(unsigned*)(ffn + (size_t)t * 1024 + 128 * x + 16 * j + c0) = pk_bf16(a1.x, a1.y);
    };
    PeerBuf A, Bb;
    int t = wl;
    if (t >= M_TOK) return;
    i32x16 idn;
    load_ids(idn, t);
    issue(A, t, idn);
    load_ids(idn, tok(t + NW));
    for (; t < M_TOK; t += 2 * NW) {
        issue(Bb, tok(t + NW), idn);
        load_ids(idn, tok(t + 2 * NW));
        compute(A, t);
        issue(A, tok(t + 2 * NW), idn);
        load_ids(idn, tok(t + 3 * NW));
        if (t + NW < M_TOK) compute(Bb, t + NW);
    }
}
__device__ __forceinline__ void phase_ln2(const Params& p, const bf16_t* x1b, const bf16_t* ffn) {
    const int lane = threadIdx.x & 63, gw = blockIdx.x * (NTHREADS / 64) + (threadIdx.x >> 6), GW = gridDim.x * (NTHREADS / 64);
    f32x4 g[4], bb[4];
#pragma unroll
    for (int j = 0; j < 4; ++j) { g[j] = *(const f32x4*)(p.ln2_g + (j >> 1) * 512 + lane * 8 + (j & 1) * 4); bb[j] = *(const f32x4*)(p.ln2_b + (j >> 1) * 512 + lane * 8 + (j & 1) * 4); }
    for (int m0 = gw * 4; m0 < M_TOK; m0 += GW * 4) {
        u32x4 a[4][2], f[4][2];
#pragma unroll
        for (int rr = 0; rr < 4; ++rr)
#pragma unroll
            for (int j = 0; j < 2; ++j) { a[rr][j] = *(const u32x4*)(x1b + (size_t)(m0 + rr) * D_MODEL + j * 512 + lane * 8); f[rr][j] = *(const u32x4*)(ffn + (size_t)(m0 + rr) * D_MODEL + j * 512 + lane * 8); }
#pragma unroll
        for (int rr = 0; rr < 4; ++rr) {
            float* row = p.out + (size_t)(m0 + rr) * D_MODEL;
            f32x4 v[4] = {bf4_lo(a[rr][0]) * ALPHA + bf4_lo(f[rr][0]), bf4_hi(a[rr][0]) * ALPHA + bf4_hi(f[rr][0]), bf4_lo(a[rr][1]) * ALPHA + bf4_lo(f[rr][1]), bf4_hi(a[rr][1]) * ALPHA + bf4_hi(f[rr][1])};
            const float mean = wave_sum((sum4(v[0]) + sum4(v[1])) + (sum4(v[2]) + sum4(v[3]))) * (1.f / D_MODEL);
            float q = 0.f;
#pragma unroll
            for (int j = 0; j < 4; ++j) { v[j] -= mean; q += sum4(v[j] * v[j]); }
            const float rstd = rsqrtf(wave_sum(q) * (1.f / D_MODEL) + LN_EPS);
#pragma unroll
            for (int j = 0; j < 4; ++j) *(f32x4*)(row + (j >> 1) * 512 + lane * 8 + (j & 1) * 4) = v[j] * rstd * g[j] + bb[j];
        }
    }
}

constexpr int N_PHASES = 14;

namespace pg8 {
#define PG8_LAS __attribute__((address_space(3)))
constexpr int BM = 256, BK = 64, HALF = 128, HTB = HALF * BK * 2  , STAGE_BYTES = 8 * HTB, NXCD = 8, WGM = 8;

__host__ __device__ __forceinline__ int lds_byte(int r, int c) { const int st = (r >> 4) * 2 + (c >> 5), rr = r & 15, cc = c & 31, ob = rr * 64 + cc * 2; return st * 1024 + (ob ^ (((ob >> 9) & 1) << 5)); }
__host__ __device__ __forceinline__ void stage_rc(int b, int& R, int& C) { const int st = b / 1024, sb = b % 1024, swz = sb ^ (((sb >> 9) & 1) << 5); R = (st >> 1) * 16 + swz / 64; C = (st & 1) * 32 + (swz % 64) / 2; }
__host__ __device__ __forceinline__ int perm32(int rho) { const int n = rho >> 4, i = rho & 15; return 8 * (i >> 2) + 4 * n + (i & 3); }
struct Unit { int pm, pn; };
struct Gemm { const bf16_t* A; const bf16_t* Bt; int M, N, K; };
struct StaticOrder {
    int nM, nN, nwg, G, c;
    __host__ __device__ void init(int M, int N, int G_, int c_) { nM = M / BM; nN = N / BM; nwg = nM * nN; G = G_; c = c_; }
    __host__ __device__ bool next(int i, Unit& u) const {
        const long L = (long)i * G + c; if (L >= nwg) return false;
        int wgid = (int)L; { const int q = nwg / NXCD, r = nwg % NXCD, xcd = wgid % NXCD, off = wgid / NXCD; wgid = (xcd < r ? xcd * (q + 1) : r * (q + 1) + (xcd - r) * q) + off; }
        const int nig = WGM * nN, gid = wgid / nig, fm = gid * WGM, gsz = (nM - fm) < WGM ? (nM - fm) : WGM;
        u.pm = fm + ((wgid % nig) % gsz); u.pn = (wgid % nig) / gsz; return true;
    }
    __device__ __forceinline__ void a_ready(const Unit&) const {}
    __device__ __forceinline__ void done(const Unit&) const {}
};
struct EpiRope {
    static constexpr bool PERM = true, AFTER_DRAIN = false;
    bf16_t* O; const float* cs;
    __device__ __forceinline__ void operator()(const f32x4 (&acc)[2][2][4][2], const Unit& u, int wr, int wc, int fr, int fq) const {
        const int row0 = u.pm * BM + wr * 64 + fr, colb = u.pn * BM + wc * 32 + 8 * fq;
#pragma unroll
        for (int ai = 0; ai < 2; ++ai)
#pragma unroll
            for (int m = 0; m < 4; ++m) {
                const int row = row0 + ai * HALF + m * 16;
#pragma unroll
                for (int bj = 0; bj < 2; ++bj) {
                    const int col0 = colb + bj * HALF;
                    f32x4 v0 = acc[ai][bj][m][0], v1 = acc[ai][bj][m][1];
                    if (col0 < P_AV) {
                        const int i0 = (col0 & 63) >> 1;
                        const float4 c = *(const float4*)(cs + (size_t)row * 32 + i0), s = *(const float4*)(cs + (size_t)M_TOK * 32 + (size_t)row * 32 + i0);
                        const float sc = col0 < P_AK ? 0.125f : 1.f;
                        const f32x4 w0 = {(v0[0] * c.x - v0[1] * s.x) * sc, (v0[1] * c.x + v0[0] * s.x) * sc, (v0[2] * c.y - v0[3] * s.y) * sc, (v0[3] * c.y + v0[2] * s.y) * sc};
                        const f32x4 w1 = {(v1[0] * c.z - v1[1] * s.z) * sc, (v1[1] * c.z + v1[0] * s.z) * sc, (v1[2] * c.w - v1[3] * s.w) * sc, (v1[3] * c.w + v1[2] * s.w) * sc};
                        v0 = w0; v1 = w1;
                    }
                    u32x4 w; w.x = pk_bf16(v0[0], v0[1]); w.y = pk_bf16(v0[2], v0[3]); w.z = pk_bf16(v1[0], v1[1]); w.w = pk_bf16(v1[2], v1[3]);
                    *(u32x4*)(O + (size_t)row * NP_IN + col0) = w;
                }
            }
    }
};
struct EpiResid {
    static constexpr bool PERM = true, AFTER_DRAIN = false;
    bf16_t* Y; const float* X;
    __device__ __forceinline__ void operator()(const f32x4 (&acc)[2][2][4][2], const Unit& u, int wr, int wc, int fr, int fq) const {
        const int row0 = u.pm * BM + wr * 64 + fr, col0 = u.pn * BM + wc * 32 + 8 * fq;
#pragma unroll
        for (int ai = 0; ai < 2; ++ai)
#pragma unroll
            for (int m = 0; m < 4; ++m) {
                const size_t ro = (size_t)(row0 + ai * HALF + m * 16) * D_MODEL + col0;
#pragma unroll
                for (int bj = 0; bj < 2; ++bj) {
                    const f32x4 v0 = *(const f32x4*)(X + ro + bj * HALF) * ALPHA + acc[ai][bj][m][0], v1 = *(const f32x4*)(X + ro + bj * HALF + 4) * ALPHA + acc[ai][bj][m][1];
                    u32x4 w; w.x = pk_bf16(v0[0], v0[1]); w.y = pk_bf16(v0[2], v0[3]); w.z = pk_bf16(v1[0], v1[1]); w.w = pk_bf16(v1[2], v1[3]);
                    *(u32x4*)(Y + ro + bj * HALF) = w;
                }
            }
    }
};
struct EpiPlainBf16 {
    static constexpr bool PERM = true, AFTER_DRAIN = false;
    bf16_t* O; int ldc;
    __device__ __forceinline__ void operator()(const f32x4 (&acc)[2][2][4][2], const Unit& u, int wr, int wc, int fr, int fq) const {
        const int row0 = u.pm * BM + wr * 64 + fr, col0 = u.pn * BM + wc * 32 + 8 * fq;
#pragma unroll
        for (int ai = 0; ai < 2; ++ai)
#pragma unroll
            for (int m = 0; m < 4; ++m) { bf16_t* rowp = O + (size_t)(row0 + ai * HALF + m * 16) * ldc + col0;
#pragma unroll
                for (int bj = 0; bj < 2; ++bj) { const f32x4 v0 = acc[ai][bj][m][0], v1 = acc[ai][bj][m][1];
                    u32x4 w; w.x = pk_bf16(v0[0], v0[1]); w.y = pk_bf16(v0[2], v0[3]); w.z = pk_bf16(v1[0], v1[1]); w.w = pk_bf16(v1[2], v1[3]);
                    *(u32x4*)(rowp + bj * HALF) = w; } }
    }
};
template <class Epi, class Sched>
__device__ __forceinline__ void gemm_phase(PG8_LAS unsigned char* lds, const Gemm g, const Sched& S, const Epi& E) {
    const int tid = threadIdx.x, wid = __builtin_amdgcn_readfirstlane(tid >> 6), lane = tid & 63, wr = wid >> 2, wc = wid & 3, fr = lane & 15, fq = lane >> 4;
    const int K = g.K, nt = K / BK;
    unsigned voffA[2], voffB[2];
#pragma unroll
    for (int i = 0; i < 2; ++i) { int R, C; stage_rc(tid * 16 + i * 8192, R, C); const int Rb = Epi::PERM ? ((R & ~31) + perm32(R & 31)) : R;
        voffA[i] = (unsigned)(R * K + C) * 2u; voffB[i] = (unsigned)(Rb * K + C) * 2u; }
    const size_t kstep = (size_t)(BK * 2);
    const size_t hstep = (size_t)HALF * K * 2;
    const size_t tstep = 2 * hstep;
    const unsigned ldsw = (unsigned)wid * 1024u;
    const int aoff = lds_byte(wr * 64 + fr, fq * 8), boff = lds_byte(wc * 32 + fr, fq * 8);
#define PG8_SA(b, h) (((b) * 2 + (h)) * HTB)
#define PG8_SB(b, h) ((4 + (b) * 2 + (h)) * HTB)
#define PG8_STAGE(bufoff, gbase, voff) do { _Pragma("unroll") for (int _i = 0; _i < 2; ++_i) \
        __builtin_amdgcn_global_load_lds((const unsigned*)((const char*)(gbase) + (voff)[_i]), (PG8_LAS unsigned*)(lds + (bufoff) + ldsw + _i * 8192), 16, 0, 0); } while (0)
#define PG8_LDA(dst, b, h) do { _Pragma("unroll") for (int m = 0; m < 4; ++m) _Pragma("unroll") for (int k = 0; k < 2; ++k) dst[m][k] = *(const PG8_LAS bf16x8*)(lds + PG8_SA(b, h) + aoff + m * 2048 + k * 1024); } while (0)
#define PG8_LDB(dst, b, h) do { _Pragma("unroll") for (int n = 0; n < 2; ++n) _Pragma("unroll") for (int k = 0; k < 2; ++k) dst[n][k] = *(const PG8_LAS bf16x8*)(lds + PG8_SB(b, h) + boff + n * 2048 + k * 1024); } while (0)
#define PG8_MMA(ai, bj, At, Bt) do { __builtin_amdgcn_s_setprio(1); _Pragma("unroll") for (int m = 0; m < 4; ++m) _Pragma("unroll") for (int n = 0; n < 2; ++n) _Pragma("unroll") for (int k = 0; k < 2; ++k) \
        acc[ai][bj][m][n] = __builtin_amdgcn_mfma_f32_16x16x32_bf16(Bt[n][k], At[m][k], acc[ai][bj][m][n], 0, 0, 0); __builtin_amdgcn_s_setprio(0); } while (0)
#define PG8_WAIT_V(n) asm volatile("s_waitcnt vmcnt(" #n ")" ::: "memory")
#define PG8_WAIT_L(n) asm volatile("s_waitcnt lgkmcnt(" #n ")" ::: "memory")
#define PG8_BAR __builtin_amdgcn_s_barrier()
#define PG8_SCHED __builtin_amdgcn_sched_barrier(0)
    Unit cur, nxt; int ui = 0;
    if (!S.next(0, cur)) return;
    f32x4 acc[2][2][4][2];
#pragma unroll
    for (int a = 0; a < 2; ++a)
#pragma unroll
        for (int b = 0; b < 2; ++b)
#pragma unroll
            for (int m = 0; m < 4; ++m)
#pragma unroll
                for (int n = 0; n < 2; ++n) acc[a][b][m][n] = (f32x4){0.f, 0.f, 0.f, 0.f};
    bf16x8 At[4][2], B0[2][2], B1[2][2];
    const char* cA = (const char*)g.A + (size_t)cur.pm * tstep; const char* cB = (const char*)g.Bt + (size_t)cur.pn * tstep;
    S.a_ready(cur);
    PG8_STAGE(PG8_SB(0, 0), cB, voffB); PG8_STAGE(PG8_SA(0, 0), cA, voffA); PG8_STAGE(PG8_SB(0, 1), cB + hstep, voffB); PG8_STAGE(PG8_SA(0, 1), cA + hstep, voffA);
    if (wr == 1) PG8_BAR;
    PG8_WAIT_V(4); PG8_BAR;
    PG8_STAGE(PG8_SB(1, 0), cB + kstep, voffB); PG8_STAGE(PG8_SA(1, 0), cA + kstep, voffA); PG8_STAGE(PG8_SB(1, 1), cB + hstep + kstep, voffB);
    PG8_WAIT_V(6); PG8_BAR;
    for (;;) {
        const bool has_next = S.next(ui + 1, nxt);
        const char* nA = has_next ? (const char*)g.A + (size_t)nxt.pm * tstep : cA; const char* nB = has_next ? (const char*)g.Bt + (size_t)nxt.pn * tstep : cB;
        for (int t = 0; t < nt; t += 2) {
            const bool last = (t == nt - 2);
            const char* a1 = cA + (size_t)(t + 1) * kstep;
            const char* a2 = last ? nA : cA + (size_t)(t + 2) * kstep; const char* b2 = last ? nB : cB + (size_t)(t + 2) * kstep;
            const char* a3 = a2 + kstep; const char* b3 = b2 + kstep;
            if (last && has_next) S.a_ready(nxt);
            PG8_LDB(B0, 0, 0); PG8_SCHED; PG8_LDA(At, 0, 0); PG8_STAGE(PG8_SA(1, 1), a1 + hstep, voffA);
            PG8_WAIT_L(8); PG8_BAR; PG8_WAIT_L(0); PG8_MMA(0, 0, At, B0); PG8_BAR; PG8_SCHED;
            PG8_LDB(B1, 0, 1); PG8_STAGE(PG8_SB(0, 0), b2, voffB);
            PG8_BAR; PG8_WAIT_L(0); PG8_MMA(0, 1, At, B1); PG8_BAR;
            PG8_LDA(At, 0, 1); PG8_STAGE(PG8_SA(0, 0), a2, voffA);
            PG8_BAR; PG8_WAIT_L(0); PG8_MMA(1, 0, At, B0); PG8_BAR; PG8_SCHED;
            PG8_STAGE(PG8_SB(0, 1), b2 + hstep, voffB);
            PG8_WAIT_V(6); PG8_BAR; PG8_MMA(1, 1, At, B1); PG8_BAR;
            PG8_LDB(B0, 1, 0); PG8_SCHED; PG8_LDA(At, 1, 0); PG8_STAGE(PG8_SA(0, 1), a2 + hstep, voffA);
            PG8_WAIT_L(8); PG8_BAR; PG8_WAIT_L(0); PG8_MMA(0, 0, At, B0); PG8_BAR; PG8_SCHED;
            PG8_LDB(B1, 1, 1); PG8_STAGE(PG8_SB(1, 0), b3, voffB);
            PG8_BAR; PG8_WAIT_L(0); PG8_MMA(0, 1, At, B1); PG8_BAR;
            PG8_LDA(At, 1, 1); PG8_STAGE(PG8_SA(1, 0), a3, voffA);
            PG8_BAR; PG8_WAIT_L(0); PG8_MMA(1, 0, At, B0); PG8_BAR; PG8_SCHED;
            PG8_STAGE(PG8_SB(1, 1), b3 + hstep, voffB);
            PG8_WAIT_V(6); PG8_BAR; PG8_MMA(1, 1, At, B1); PG8_BAR;
        }
        if constexpr (!Epi::AFTER_DRAIN) { E(acc, cur, wr, wc, fr, fq); S.done(cur); }
        if (!has_next) break;
#pragma unroll
        for (int a = 0; a < 2; ++a)
#pragma unroll
            for (int b = 0; b < 2; ++b)
#pragma unroll
                for (int m = 0; m < 4; ++m)
#pragma unroll
                    for (int n = 0; n < 2; ++n) acc[a][b][m][n] = (f32x4){0.f, 0.f, 0.f, 0.f};
        cur = nxt; cA = nA; cB = nB; ++ui;
    }
    PG8_WAIT_V(0);
    if (wr == 0) PG8_BAR;
    PG8_BAR;
    if constexpr (Epi::AFTER_DRAIN) { E.fused(acc, cur, wr, wc, fr, fq, lds, wid, lane); S.done(cur); }
#undef PG8_SA
#undef PG8_SB
#undef PG8_STAGE
#undef PG8_LDA
#undef PG8_LDB
#undef PG8_MMA
#undef PG8_WAIT_V
#undef PG8_WAIT_L
#undef PG8_BAR
#undef PG8_SCHED
}
}

__global__ void __launch_bounds__(NTHREADS) mega_fwd(Params p) {
    __shared__ __attribute__((aligned(1024))) unsigned char smem[SMEM_BYTES + 16];
    if (threadIdx.x == 0) *(uint4*)(smem + SMEM_BYTES) = make_uint4(0u, 0u, 0u, 0u);
    __syncthreads();
    XcdBarrier bar; bar.bar = p.bar; bar.x = 0; bar.st = (volatile LAS unsigned*)(smem + SMEM_BYTES);
    if (p.ph_hi - p.ph_lo > 1) bar = xcd_barrier_post(p.bar, (volatile LAS unsigned*)(smem + SMEM_BYTES));
    bf16_t* qb = p.proj_b;
    bf16_t* x1b = p.proj_b + (size_t)M_TOK * 2048;
#ifndef DUP_PHASE
#define DUP_PHASE -1
#endif
#define PH(k) (p.ph_lo <= (k) && (k) < p.ph_hi)
#define SYNC(k) do { if (PH(k) && PH((k) + 1)) xcd_barrier(bar); } while (0)
#define RUN(k, ...) do { if (PH(k)) { __VA_ARGS__; if (DUP_PHASE == (k)) { xcd_barrier(bar); __VA_ARGS__; } } SYNC(k); } while (0)
    float* ph = (float*)qb;
    RUN(0, phase_prep(p, smem));
    RUN(1, { pg8::StaticOrder S; S.init(M_TOK, NP_IN, gridDim.x, blockIdx.x); pg8::EpiRope e{p.proj_b, p.rope_cs}; pg8::gemm_phase((PG8_LAS unsigned char*)smem, pg8::Gemm{p.xb, p.wt_in, M_TOK, NP_IN, 1024}, S, e); });
    RUN(2, phase_dn_prep(p, smem));
    RUN(3, { if (blockIdx.x < 96) { const int j = blockIdx.x, y = j >> 3, cs = (y >> 1) * 8 + (j & 7);
                                    dn_scan_seg<1>(p, smem, cs / 3, cs % 3, y & 1); } else { phase_attn(p, smem, 96); } });
    RUN(4, { if (blockIdx.x < 64) dn_scan_seg<0>(p, smem, blockIdx.x >> 2, blockIdx.x & 3, 0); else if (blockIdx.x < 128) phase_scan_l2_helper(p); else phase_tables8(p, 128); });
    RUN(5, phase_dn_norm(p));
    RUN(6, { pg8::StaticOrder S; S.init(M_TOK, 1024, gridDim.x, blockIdx.x); pg8::EpiResid e{(bf16_t*)p.out, p.x}; pg8::gemm_phase((PG8_LAS unsigned char*)smem, pg8::Gemm{p.xb, p.wt_out, M_TOK, 1024, 1024}, S, e); });
    RUN(7, phase_ln1(p, (const bf16_t*)p.out, x1b));
    RUN(8, { pg8::StaticOrder S; S.init(M_TOK, 2048, gridDim.x, blockIdx.x); pg8::EpiPlainBf16 e{qb, 2048}; pg8::gemm_phase((PG8_LAS unsigned char*)smem, pg8::Gemm{x1b, p.wt_q, M_TOK, 2048, 1024}, S, e); });
    RUN(9, phase_route(p, qb));
    RUN(10, phase_peer_u(p, x1b, (bf16_t*)ph));
    RUN(11, phase_peer_w(p, (const bf16_t*)ph, p.wbuf));
    RUN(12, phase_peer_v(p, p.wbuf, (bf16_t*)ph));
    RUN(13, phase_ln2(p, x1b, (const bf16_t*)ph));
#undef RUN
#undef SYNC
#undef PH
}
}

#ifndef MK_LAUNCHES
#define MK_LAUNCHES 1
#endif

extern "C" void kernel_launch(void* const* d_in, const int* in_sizes, int n_in, void* d_out, int out_size, void* d_ws, size_t ws_size, hipStream_t stream) {
    static int grid_blocks = 0;
    if (!grid_blocks) {
        int dev = 0, cus = 0, per_cu = 0;
        (void)hipGetDevice(&dev);
        (void)hipDeviceGetAttribute(&cus, hipDeviceAttributeMultiprocessorCount, dev);
        (void)hipOccupancyMaxActiveBlocksPerMultiprocessor(&per_cu, mega_fwd, NTHREADS, 0);
        if (per_cu < 1) { fprintf(stderr, "kernel_launch: occupancy query reports %d blocks per CU\n", per_cu); per_cu = 1; }
        grid_blocks = cus * 1;
        (void)hipGetLastError();
    }
    Params p{};
    p.x = (const float*)d_in[0]; p.positions = (const int*)d_in[1]; p.w_in = (const float*)d_in[2]; p.sinks = (const float*)d_in[3];
    p.conv_w = (const float*)d_in[4]; p.a_log = (const float*)d_in[5]; p.dt_bias = (const float*)d_in[6]; p.dn_norm_g = (const float*)d_in[7];
    p.w_out = (const float*)d_in[8]; p.ln1_g = (const float*)d_in[9]; p.ln1_b = (const float*)d_in[10]; p.w_query = (const float*)d_in[11];
    p.sub_keys = (const float*)d_in[12]; p.peer_u = (const float*)d_in[13]; p.peer_v = (const float*)d_in[14]; p.ln2_g = (const float*)d_in[15]; p.ln2_b = (const float*)d_in[16];
    p.out = (float*)d_out;
    char* ws = (char*)d_ws; size_t off = 0;
    auto take = [&](size_t bytes) { char* r = ws + off; off += (bytes + 255) & ~(size_t)255; return r; };
    p.xb = (bf16_t*)take((size_t)M_TOK * 1024 * 2);
    p.proj_b = (bf16_t*)take((size_t)M_TOK * NP_IN * 2);
    p.odn_raw = (bf16_t*)d_out;
    {
        char* dn = take((size_t)2048 * (16384 * 3 + 8192 + 32768) + 8192);
        p.ids = (int*)dn; p.gates = (float*)(dn + (size_t)M_TOK * 128 * 4);
        p.wbuf = (float*)(dn + (size_t)M_TOK * 128 * 8);
        p.dn_negw = (bf16_t*)dn; p.dn_qd = (bf16_t*)(dn + (size_t)2048 * 16384); p.dn_kdt = (bf16_t*)(dn + (size_t)2048 * 16384 * 2);
        p.dn_qk = (bf16_t*)(dn + (size_t)2048 * 16384 * 3); p.dn_u = (bf16_t*)(dn + (size_t)2048 * (16384 * 3 + 8192)); p.dn_gl = (float*)(dn + (size_t)2048 * (16384 * 3 + 8192 + 32768));
    }
    p.wt_in = (bf16_t*)take((size_t)NP_IN * 1024 * 2);
    p.wt_out = (bf16_t*)take((size_t)1024 * 1024 * 2);
    p.wt_q = (bf16_t*)take((size_t)2048 * 1024 * 2);
    p.rope_cs = (float*)take((size_t)M_TOK * 64 * 4);
    p.sk_frag = (bf16_t*)take((size_t)16 * 128 * 128 * 2);
    p.tab8 = (unsigned char*)take((size_t)2 * 16384 * 1024);
    p.isc = (float*)take((size_t)2 * 16384 * 4);
    p.ln1_stats = (float*)take((size_t)M_TOK * 2 * 4);
    p.dn_PB = (float*)take((size_t)48 * 128 * 256 * 4);
    p.dn_S0 = (float*)take((size_t)64 * 128 * 128 * 4);
    p.bar = (unsigned*)take((size_t)(XCD_BAR_WORDS + 64 * 64) * 4);
    if (off > ws_size) { fprintf(stderr, "kernel_launch: workspace too small (%zu < %zu)\n", ws_size, off); return; }
    if (hipMemsetAsync(p.bar, 0, (size_t)(XCD_BAR_WORDS + 64 * 64) * 4, stream) != hipSuccess) { fprintf(stderr, "kernel_launch: memset of barrier words failed\n"); return; }
#if MK_LAUNCHES == 1
    p.ph_lo = 0; p.ph_hi = N_PHASES;
    void* args[] = {&p};
    hipError_t e = hipLaunchCooperativeKernel((void*)mega_fwd, dim3(grid_blocks), dim3(NTHREADS), args, 0, stream);
    if (e != hipSuccess) fprintf(stderr, "cooperative launch failed: %s (grid %d)\n", hipGetErrorString(e), grid_blocks);
#else
    for (int k = 0; k < N_PHASES; ++k) { p.ph_lo = k; p.ph_hi = k + 1; hipLaunchKernelGGL(mega_fwd, dim3(grid_blocks), dim3(NTHREADS), 0, stream, p); }
#endif
}
```
